# Optimizing an MI355X kernel written in HIP

```python
import jax, jax.numpy as jnp
from jax import lax
import numpy as np

D_MODEL = 1024
BATCH = 8
SEQ = 4096
DEPTH = 1

MIX_WIDTH = D_MODEL
GMLP_WIDTH = MIX_WIDTH // 2
RWKV_WIDTH = MIX_WIDTH - GMLP_WIDTH
HEAD_DIM = 64
GMLP_HEADS = GMLP_WIDTH // HEAD_DIM
RWKV_HEADS = RWKV_WIDTH // HEAD_DIM
CHUNK = 128
DECAY_LORA = 32
ICLR_LORA = 32
GATE_LORA = 96
RWKV_PROJ = 3 * RWKV_WIDTH + DECAY_LORA + ICLR_LORA + GATE_LORA
IN_WIDTH = 2 * GMLP_WIDTH + RWKV_PROJ
N_GROUPS = 4
EXPERTS_PER_GROUP = 8
N_EXPERTS = N_GROUPS * EXPERTS_PER_GROUP
TOP_K = 2
EXPERT_HIDDEN = 512
MOE_BLOCK = 128
RMS_EPS = 1e-6
LN_EPS = 1e-5
GN_EPS = 64e-5

kernel_name = "hybrid_gmlp_rwkv7_hmoe_block"


def _rmsnorm(x, g):
    x32 = x.astype(jnp.float32)
    y = x32 * lax.rsqrt(jnp.mean(x32 * x32, axis=-1, keepdims=True) + RMS_EPS)
    return y.astype(x.dtype) * g


def _modulate(h, shift, scale):
    return h * (1 + scale[:, None, :]) + shift[:, None, :]


def _token_shift(z):
    return jnp.pad(z, ((0, 0), (1, 0), (0, 0)))[:, :-1]


def _gmlp_mixer(zu, zv, ln_w, ln_b, ws, bs):
    B, S, _ = zu.shape
    u = jax.nn.gelu(zu)
    v = jax.nn.gelu(zv)
    v32 = v.astype(jnp.float32)
    m = jnp.mean(v32, axis=-1, keepdims=True)
    var = jnp.mean(jnp.square(v32 - m), axis=-1, keepdims=True)
    v = ((v32 - m) * lax.rsqrt(var + LN_EPS)).astype(zu.dtype) * ln_w + ln_b
    vc = v.reshape(B, S // CHUNK, CHUNK, GMLP_HEADS, HEAD_DIM)
    w_causal = jnp.tril(ws)
    mixed = jnp.einsum('hts,bcshd->bcthd', w_causal, vc) + bs.T[None, None, :, :, None]
    return u * mixed.reshape(B, S, GMLP_WIDTH)


def _wkv7_scan(r, w, k, v, a, b):
    Bn, S, H, N = r.shape
    seq = tuple(jnp.moveaxis(t, 1, 0) for t in (r, w, k, v, a, b))

    def step(state, inp):
        r_t, w_t, k_t, v_t, a_t, b_t = inp
        sa = jnp.einsum('bhvk,bhk->bhv', state, a_t)
        state = (state * w_t[:, :, None, :] + sa[..., None] * b_t[:, :, None, :]
                 + v_t[..., None] * k_t[:, :, None, :])
        return state, jnp.einsum('bhvk,bhk->bhv', state, r_t)

    s0 = jnp.zeros((Bn, H, N, N), jnp.float32)
    _, y = lax.scan(step, s0, seq)
    return jnp.moveaxis(y, 0, 1)


def _rwkv7_mixer(z, mu, w0, w2, a0, a2, g2, k_k, k_a, r_k, gn_w, gn_b):
    B, S, _ = z.shape
    f32 = jnp.float32
    z = z + (_token_shift(z) - z) * mu
    W = RWKV_WIDTH
    r, k, v, xw, xa, xg = jnp.split(
        z, [W, 2 * W, 3 * W, 3 * W + DECAY_LORA, 3 * W + DECAY_LORA + ICLR_LORA], axis=-1)
    w_log = -jax.nn.softplus(-(w0 + jnp.tanh(xw) @ w2).astype(f32)) - 0.5
    decay = jnp.exp(-jnp.exp(w_log))
    a = jax.nn.sigmoid(a0 + xa @ a2)
    g = jax.nn.sigmoid(xg) @ g2
    hv = lambda t: t.reshape(B, S, RWKV_HEADS, HEAD_DIM)
    kk = hv(k * k_k).astype(f32)
    kk = kk / jnp.maximum(jnp.sqrt(jnp.sum(kk * kk, axis=-1, keepdims=True)), 1e-12)
    k = k * (1 + (a - 1) * k_a)
    r4, k4, v4, a4 = hv(r), hv(k), hv(v), hv(a)
    y = _wkv7_scan(r4.astype(f32), hv(decay), k4.astype(f32), v4.astype(f32),
                   -kk, kk * a4.astype(f32))
    m = jnp.mean(y, axis=-1, keepdims=True)
    var = jnp.mean(jnp.square(y - m), axis=-1, keepdims=True)
    y = ((y - m) * lax.rsqrt(var + GN_EPS)).reshape(B, S, W).astype(z.dtype) * gn_w + gn_b
    bonus = jnp.sum(r4 * k4 * r_k, axis=-1, keepdims=True) * v4
    return (y + bonus.reshape(B, S, W)) * g


def _hier_moe(h, rg_w, rg_b, re_w, re_b, w_gate, w_up, w_down):
    B, S, D = h.shape
    N = B * S
    f32 = jnp.float32
    ht = h.reshape(N, D)
    group_prob = jax.nn.softmax((ht @ rg_w + rg_b).astype(f32), axis=-1)
    g_p, g_idx = lax.top_k(group_prob, 1)
    exp_logits = (ht @ re_w + re_b).astype(f32).reshape(N, N_GROUPS, EXPERTS_PER_GROUP)
    sel = jnp.take_along_axis(exp_logits, g_idx[:, :, None], axis=1)[:, 0]
    e_p, e_idx = lax.top_k(jax.nn.softmax(sel, axis=-1), TOP_K)
    e_p = e_p / jnp.sum(e_p, axis=-1, keepdims=True)
    weights = g_p * e_p
    expert = g_idx * EXPERTS_PER_GROUP + e_idx
    A = N * TOP_K
    flat_e = expert.reshape(A)
    flat_w = weights.reshape(A)
    flat_tok = jnp.repeat(jnp.arange(N, dtype=jnp.int32), TOP_K)
    order = jnp.argsort(flat_e)
    se, stok, sw = flat_e[order], flat_tok[order], flat_w[order]
    counts = jnp.bincount(flat_e, length=N_EXPERTS)
    padded = (counts + MOE_BLOCK - 1) // MOE_BLOCK * MOE_BLOCK
    pad_end = jnp.cumsum(padded)
    pad_start = pad_end - padded
    start = jnp.cumsum(counts) - counts
    dest = pad_start[se] + jnp.arange(A) - start[se]
    n_blocks = -(-A // MOE_BLOCK) + N_EXPERTS
    P = n_blocks * MOE_BLOCK
    tok_buf = jnp.full((P,), N, jnp.int32).at[dest].set(stok)
    w_buf = jnp.zeros((P,), f32).at[dest].set(sw)
    block_e = jnp.minimum(
        jnp.searchsorted(pad_end, jnp.arange(n_blocks) * MOE_BLOCK, side='right'), N_EXPERTS - 1)
    x_pad = jnp.concatenate([ht, jnp.zeros((1, D), ht.dtype)], axis=0)
    xb = x_pad[tok_buf].reshape(n_blocks, MOE_BLOCK, D)

    def expert_block(args):
        xbk, e = args
        return (jax.nn.silu(xbk @ w_gate[e]) * (xbk @ w_up[e])) @ w_down[e]

    yb = lax.map(expert_block, (xb, block_e)).reshape(P, D)
    y = jnp.zeros((N + 1, D), yb.dtype).at[tok_buf].add(yb * w_buf[:, None].astype(yb.dtype))
    return y[:N].reshape(B, S, D)


def setup_inputs(seed: int = 0) -> dict:
    key = jax.random.key(seed)
    ks = jax.random.split(key, 40)
    L, D = DEPTH, D_MODEL
    nrm = lambda k, shape, s: jax.random.normal(k, shape, jnp.float32) * s
    uni = lambda k, shape, lo, hi: jax.random.uniform(k, shape, jnp.float32, lo, hi)
    return {
        "x": nrm(ks[0], (BATCH, SEQ, D), 1.0),
        "c": nrm(ks[1], (BATCH, D), 1.0),
        "ada_w": nrm(ks[2], (L, D, 6 * D), 0.3 * D ** -0.5),
        "ada_b": nrm(ks[3], (L, 6 * D), 0.01),
        "norm1_g": 1.0 + nrm(ks[4], (L, D), 0.05),
        "w_in": nrm(ks[5], (L, D, IN_WIDTH), D ** -0.5),
        "gmlp_ln_w": 1.0 + nrm(ks[6], (L, GMLP_WIDTH), 0.05),
        "gmlp_ln_b": nrm(ks[7], (L, GMLP_WIDTH), 0.02),
        "gmlp_ws": nrm(ks[8], (L, GMLP_HEADS, CHUNK, CHUNK), CHUNK ** -0.5),
        "gmlp_bs": 1.0 + nrm(ks[9], (L, GMLP_HEADS, CHUNK), 0.1),
        "rwkv_mu": uni(ks[10], (L, RWKV_PROJ), 0.0, 1.0),
        "rwkv_w0": uni(ks[11], (L, RWKV_WIDTH), -6.0, 0.0),
        "rwkv_w2": nrm(ks[12], (L, DECAY_LORA, RWKV_WIDTH), 0.1),
        "rwkv_a0": nrm(ks[13], (L, RWKV_WIDTH), 0.5),
        "rwkv_a2": nrm(ks[14], (L, ICLR_LORA, RWKV_WIDTH), ICLR_LORA ** -0.5),
        "rwkv_g2": nrm(ks[15], (L, GATE_LORA, RWKV_WIDTH), GATE_LORA ** -0.5),
        "rwkv_k_k": 0.85 + nrm(ks[16], (L, RWKV_WIDTH), 0.05),
        "rwkv_k_a": 1.0 + nrm(ks[17], (L, RWKV_WIDTH), 0.05),
        "rwkv_r_k": nrm(ks[18], (L, RWKV_HEADS, HEAD_DIM), 0.1),
        "rwkv_gn_w": 1.0 + nrm(ks[19], (L, RWKV_WIDTH), 0.05),
        "rwkv_gn_b": nrm(ks[20], (L, RWKV_WIDTH), 0.02),
        "w_out": nrm(ks[21], (L, MIX_WIDTH, D), MIX_WIDTH ** -0.5),
        "norm2_g": 1.0 + nrm(ks[22], (L, D), 0.05),
        "router_group_w": nrm(ks[23], (L, D, N_GROUPS), D ** -0.5),
        "router_group_b": nrm(ks[24], (L, N_GROUPS), 0.01),
        "router_expert_w": nrm(ks[25], (L, D, N_EXPERTS), D ** -0.5),
        "router_expert_b": nrm(ks[26], (L, N_EXPERTS), 0.01),
        "moe_w_gate": nrm(ks[27], (L, N_EXPERTS, D, EXPERT_HIDDEN), D ** -0.5),
        "moe_w_up": nrm(ks[28], (L, N_EXPERTS, D, EXPERT_HIDDEN), D ** -0.5),
        "moe_w_down": nrm(ks[29], (L, N_EXPERTS, EXPERT_HIDDEN, D), EXPERT_HIDDEN ** -0.5),
        "final_norm_g": 1.0 + nrm(ks[30], (D,), 0.05),
    }


def reference(x, c, ada_w, ada_b, norm1_g, w_in, gmlp_ln_w, gmlp_ln_b, gmlp_ws, gmlp_bs,
              rwkv_mu, rwkv_w0, rwkv_w2, rwkv_a0, rwkv_a2, rwkv_g2, rwkv_k_k, rwkv_k_a,
              rwkv_r_k, rwkv_gn_w, rwkv_gn_b, w_out, norm2_g, router_group_w, router_group_b,
              router_expert_w, router_expert_b, moe_w_gate, moe_w_up, moe_w_down,
              final_norm_g):
    for l in range(DEPTH):
        mod = c @ ada_w[l] + ada_b[l]
        shift1, scale1, gate1, shift2, scale2, gate2 = jnp.split(mod, 6, axis=-1)
        h = _modulate(_rmsnorm(x, norm1_g[l]), shift1, scale1)
        z = h @ w_in[l]
        zu, zv, zr = jnp.split(z, [GMLP_WIDTH, 2 * GMLP_WIDTH], axis=-1)
        y_a = _gmlp_mixer(zu, zv, gmlp_ln_w[l], gmlp_ln_b[l], gmlp_ws[l], gmlp_bs[l])
        y_b = _rwkv7_mixer(zr, rwkv_mu[l], rwkv_w0[l], rwkv_w2[l], rwkv_a0[l], rwkv_a2[l],
                           rwkv_g2[l], rwkv_k_k[l], rwkv_k_a[l], rwkv_r_k[l],
                           rwkv_gn_w[l], rwkv_gn_b[l])
        y = jnp.concatenate([y_a, y_b], axis=-1) @ w_out[l]
        x = x + gate1[:, None, :] * y
        h = _modulate(_rmsnorm(x, norm2_g[l]), shift2, scale2)
        y = _hier_moe(h, router_group_w[l], router_group_b[l], router_expert_w[l],
                      router_expert_b[l], moe_w_gate[l], moe_w_up[l], moe_w_down[l])
        x = x + gate2[:, None, :] * y
    return _rmsnorm(x, final_norm_g)
```

```cpp
#include <hip/hip_runtime.h>
#include <cstdio>
#include <cstdint>

constexpr int D = 1024, BATCH = 8, SEQ = 4096, NTOK = BATCH * SEQ;
constexpr int GW = 512, RW = 512, HD = 64, CHUNK = 128;
constexpr int RPROJ = 1696, INW = 2720;
constexpr int NG = 4, EPG = 8, NE = 32, EH = 512;
constexpr int NTHR = 512;

typedef float f32x16 __attribute__((ext_vector_type(16)));
typedef float f32x4 __attribute__((ext_vector_type(4)));

constexpr size_t MiB = 1u << 20;
constexpr size_t GW_ZR = 0;
constexpr size_t GW_ZUV = 212 * MiB;
constexpr size_t GW_H1 = 340 * MiB;
constexpr size_t GW_SC = 212 * MiB;
constexpr size_t GW_RK = 436 * MiB;
constexpr size_t GW_X1 = 0;
constexpr size_t GW_H2 = 128 * MiB;
constexpr size_t GW_HB = 256 * MiB;
constexpr size_t GW_SM = 468 * MiB;
constexpr size_t GW_MOD = GW_SM;
constexpr size_t GW_TOKE = GW_SM + 1 * MiB;
constexpr size_t GW_TOKW = GW_SM + 2 * MiB;
constexpr size_t GW_ROWTOK = GW_SM + 3 * MiB;
constexpr size_t GW_ROWAID = GW_SM + 4 * MiB;
constexpr size_t GW_ROWW = GW_SM + 5 * MiB;
constexpr size_t GW_TILEE = GW_SM + 6 * MiB;
constexpr size_t GW_CTL = GW_SM + 7 * MiB;
constexpr size_t WS_NEED = 512 * MiB;
constexpr int GT = 128;
constexpr int PROWS = NTOK * 2 + NE * GT;
constexpr int PTILES = PROWS / GT;

struct Params {
    const float* in[31];
    float* out;
    unsigned char* ws;
    int phase, sub;
};

enum { I_X = 0, I_C, I_ADAW, I_ADAB, I_N1G, I_WIN, I_GLNW, I_GLNB, I_GWS, I_GBS, I_MU, I_W0, I_W2, I_A0, I_A2, I_G2, I_KK, I_KA, I_RK, I_GNW, I_GNB, I_WOUT, I_N2G, I_RGW, I_RGB, I_REW, I_REB, I_WG, I_WU, I_WD, I_FNG };

__device__ __forceinline__ float wave_sum(float v) {
#pragma unroll
    for (int o = 1; o < 64; o <<= 1) v += __shfl_xor(v, o);
    return v;
}
__device__ __forceinline__ float gelu_tanh(float x) {
    const float u = 0.7978845608028654f * (x + 0.044715f * x * x * x);
    return 0.5f * x * (1.0f + tanhf(u));
}
__device__ __forceinline__ float sigmoidf_(float x) { return 1.0f / (1.0f + expf(-x)); }
__device__ __forceinline__ float softplusf_(float x) { return fmaxf(x, 0.f) + log1pf(expf(-fabsf(x))); }

template <class Epi>
__device__ __forceinline__ void gg_gemm(float* lds, const float* __restrict__ A, int lda, const int* rowidx, const float* __restrict__ B, int ldb, size_t bstride,
                        const int* tile_expert, int M, int N, int K, const Epi& epi, int bid, int nb) {
    float* As = lds;
    float* Bs = lds + 16 * 132;
    const int tid = threadIdx.x, lane = tid & 63, wid = tid >> 6, wm = wid >> 1, wn = wid & 1;
    const int tilesN = (N + 127) / 128, tilesM = M / 128;
    for (int tile = bid; tile < tilesM * tilesN; tile += nb) {
        const int tm = tile / tilesN, tn = tile % tilesN;
        const float* Bp = B;
        if (tile_expert) { const int e = tile_expert[tm]; if (e < 0) continue; Bp = B + (size_t)e * bstride; }
        f32x16 acc0, acc1;
#pragma unroll
        for (int i = 0; i < 16; ++i) { acc0[i] = 0.f; acc1[i] = 0.f; }
        const int arow = tid >> 2, akq = (tid & 3) * 4;
        int asrc = tm * 128 + arow;
        if (rowidx) asrc = rowidx[asrc];
        const int bk = tid >> 5, bn4 = (tid & 31) * 4, bcol = tn * 128 + bn4;
        for (int k0 = 0; k0 < K; k0 += 16) {
            f32x4 av = {0.f, 0.f, 0.f, 0.f};
            if (asrc >= 0) av = *(const f32x4*)(A + (size_t)asrc * lda + k0 + akq);
            f32x4 bv = {0.f, 0.f, 0.f, 0.f};
            if (bcol < N) bv = *(const f32x4*)(Bp + (size_t)(k0 + bk) * ldb + bcol);
            __syncthreads();
            As[(akq + 0) * 132 + arow] = av[0]; As[(akq + 1) * 132 + arow] = av[1]; As[(akq + 2) * 132 + arow] = av[2]; As[(akq + 3) * 132 + arow] = av[3];
            *(f32x4*)(Bs + bk * 128 + bn4) = bv;
            __syncthreads();
#pragma unroll
            for (int kk = 0; kk < 16; kk += 2) {
                const int kr = kk + (lane >> 5);
                const float a = As[kr * 132 + wm * 32 + (lane & 31)];
                const float b0 = Bs[kr * 128 + wn * 64 + (lane & 31)];
                const float b1 = Bs[kr * 128 + wn * 64 + 32 + (lane & 31)];
                acc0 = __builtin_amdgcn_mfma_f32_32x32x2f32(a, b0, acc0, 0, 0, 0);
                acc1 = __builtin_amdgcn_mfma_f32_32x32x2f32(a, b1, acc1, 0, 0, 0);
            }
        }
#pragma unroll
        for (int r = 0; r < 16; ++r) {
            const int row = tm * 128 + wm * 32 + (r & 3) + 8 * (r >> 2) + 4 * (lane >> 5);
            const int c0 = tn * 128 + wn * 64 + (lane & 31);
            if (c0 < N) epi(row, c0, acc0[r]);
            if (c0 + 32 < N) epi(row, c0 + 32, acc1[r]);
        }
    }
}

__device__ __forceinline__ void ph_mod(const Params& p, int bid, int nb) {
    float* mod = (float*)(p.ws + GW_MOD);
    const float* c = p.in[I_C]; const float* w = p.in[I_ADAW]; const float* bb = p.in[I_ADAB];
    for (int i = bid * NTHR + threadIdx.x; i < BATCH * 6 * D; i += nb * NTHR) {
        const int b = i / (6 * D), n = i % (6 * D);
        float s = 0.f;
        for (int k = 0; k < D; ++k) s = fmaf(c[b * D + k], w[(size_t)k * 6 * D + n], s);
        mod[i] = s + bb[n];
    }
}
__device__ __forceinline__ void ph_normmod(const float* __restrict__ x, const float* __restrict__ g, const float* mod, int shift_idx, int scale_idx, float* __restrict__ out, int bid, int nb) {
    const int lane = threadIdx.x & 63, wv = threadIdx.x >> 6;
    for (int row = bid * 8 + wv; row < NTOK; row += nb * 8) {
        const int b = row / SEQ;
        const f32x4* xr = (const f32x4*)(x + (size_t)row * D) + lane;
        f32x4 v[4]; float s = 0.f;
#pragma unroll
        for (int j = 0; j < 4; ++j) { v[j] = xr[64 * j]; s += v[j][0] * v[j][0] + v[j][1] * v[j][1] + v[j][2] * v[j][2] + v[j][3] * v[j][3]; }
        const float r = rsqrtf(wave_sum(s) * (1.0f / D) + 1e-6f);
        const float* sh = mod + b * 6 * D + shift_idx * D; const float* sc = mod + b * 6 * D + scale_idx * D;
        f32x4* o = (f32x4*)(out + (size_t)row * D) + lane;
#pragma unroll
        for (int j = 0; j < 4; ++j) {
            const int c0 = (lane + 64 * j) * 4; f32x4 y;
#pragma unroll
            for (int q = 0; q < 4; ++q) y[q] = v[j][q] * r * g[c0 + q] * (1.0f + sc[c0 + q]) + sh[c0 + q];
            o[64 * j] = y;
        }
    }
}
struct EpiInproj {
    float* zuv; float* zr;
    __device__ __forceinline__ void operator()(int row, int col, float v) const {
        if (col < 2 * GW) zuv[(size_t)row * 1024 + col] = gelu_tanh(v);
        else zr[(size_t)row * RPROJ + (col - 2 * GW)] = v;
    }
};
__device__ __forceinline__ void ph_gmlp_ln(const Params& p, int bid, int nb) {
    const float* zuv = (const float*)(p.ws + GW_ZUV); float* vln = (float*)(p.ws + GW_H1);
    const float* lw = p.in[I_GLNW]; const float* lb = p.in[I_GLNB];
    const int lane = threadIdx.x & 63, wv = threadIdx.x >> 6;
    for (int row = bid * 8 + wv; row < NTOK; row += nb * 8) {
        const float* vr = zuv + (size_t)row * 1024 + 512;
        float v[8]; float s = 0.f;
#pragma unroll
        for (int j = 0; j < 8; ++j) { v[j] = vr[lane + 64 * j]; s += v[j]; }
        const float m = wave_sum(s) * (1.0f / 512.f); float q = 0.f;
#pragma unroll
        for (int j = 0; j < 8; ++j) { const float d = v[j] - m; q += d * d; }
        const float rs = rsqrtf(wave_sum(q) * (1.0f / 512.f) + 1e-5f);
#pragma unroll
        for (int j = 0; j < 8; ++j) { const int c = lane + 64 * j; vln[(size_t)row * 512 + c] = (v[j] - m) * rs * lw[c] + lb[c]; }
    }
}
__device__ __forceinline__ void ph_gmlp_mix(const Params& p, int bid, int nb) {
    const float* zuv = (const float*)(p.ws + GW_ZUV); const float* vln = (const float*)(p.ws + GW_H1);
    const float* wsp = p.in[I_GWS]; const float* bsp = p.in[I_GBS];
    float* ycat = p.out;
    for (int t = bid; t < NTOK; t += nb) {
        const int c = threadIdx.x, h = c >> 6, tl = t & 127, t0 = t - tl;
        const float* wrow = wsp + ((size_t)h * CHUNK + tl) * CHUNK;
        float s = 0.f;
        for (int ss = 0; ss <= tl; ++ss) s = fmaf(wrow[ss], vln[(size_t)(t0 + ss) * 512 + c], s);
        s += bsp[h * CHUNK + tl];
        ycat[(size_t)t * 1024 + c] = zuv[(size_t)t * 1024 + c] * s;
    }
}
__device__ __forceinline__ void ph_rwkv_prep(const Params& p, float* lds, int half, int bid, int nb) {
    const float* zr = (const float*)(p.ws + GW_ZR);
    float* SC = (float*)(p.ws + GW_SC); float* RKo = (float*)(p.ws + GW_RK);
    constexpr size_t AS = (size_t)16384 * 512;
    float *Ro = SC, *Wo = SC + AS, *Ko = SC + 2 * AS, *Vo = SC + 3 * AS, *Ao = SC + 4 * AS, *Bo = SC + 5 * AS, *Go = SC + 6 * AS;
    const float* mu = p.in[I_MU];
    float* zs = lds;
    const int c = threadIdx.x, lane = c & 63, h = c >> 6;
    for (int tl = bid; tl < 16384; tl += nb) {
        const int t = half * 16384 + tl;
        __syncthreads();
        for (int j = c; j < RPROJ; j += NTHR) {
            const float cur = zr[(size_t)t * RPROJ + j];
            const float prev = (t % SEQ == 0) ? 0.f : zr[(size_t)(t - 1) * RPROJ + j];
            float z = cur + (prev - cur) * mu[j];
            if (j >= 1536 && j < 1568) z = tanhf(z);
            if (j >= 1600) z = sigmoidf_(z);
            zs[j] = z;
        }
        __syncthreads();
        const float r = zs[c], k = zs[512 + c], v = zs[1024 + c];
        float dw = 0.f, da = 0.f, g = 0.f;
#pragma unroll 4
        for (int j = 0; j < 32; ++j) dw = fmaf(zs[1536 + j], p.in[I_W2][j * 512 + c], dw);
#pragma unroll 4
        for (int j = 0; j < 32; ++j) da = fmaf(zs[1568 + j], p.in[I_A2][j * 512 + c], da);
#pragma unroll 4
        for (int j = 0; j < 96; ++j) g = fmaf(zs[1600 + j], p.in[I_G2][j * 512 + c], g);
        const float wlog = -softplusf_(-(p.in[I_W0][c] + dw)) - 0.5f;
        const float decay = expf(-expf(wlog));
        const float asig = sigmoidf_(p.in[I_A0][c] + da);
        const float kkv = k * p.in[I_KK][c];
        const float nrm = sqrtf(wave_sum(kkv * kkv));
        const float kk = kkv / fmaxf(nrm, 1e-12f);
        const float k2 = k * (1.0f + (asig - 1.0f) * p.in[I_KA][c]);
        const float rk = wave_sum(r * k2 * p.in[I_RK][c]);
        const size_t o = (size_t)tl * 512 + c;
        Ro[o] = r; Wo[o] = decay; Ko[o] = k2; Vo[o] = v; Ao[o] = -kk; Bo[o] = kk * asig; Go[o] = g;
        if (lane == 0) RKo[tl * 8 + h] = rk;
    }
}
__device__ __forceinline__ void ph_rwkv_scan(const Params& p, float* lds, int half, int bid, int nb) {
    const float* SC = (const float*)(p.ws + GW_SC); const float* RKi = (const float*)(p.ws + GW_RK);
    constexpr size_t AS = (size_t)16384 * 512;
    const float *Ri = SC, *Wi = SC + AS, *Ki = SC + 2 * AS, *Vi = SC + 3 * AS, *Ai = SC + 4 * AS, *Bi = SC + 5 * AS, *Gi = SC + 6 * AS;
    constexpr int TS = 16;
    float* vec = lds;
    float* vb = lds + 5 * TS * 64;
    float* yb = vb + TS * 64;
    const int tid = threadIdx.x, lane = tid & 63, wv = tid >> 6;
    for (int item = bid; item < 32; item += nb) {
        const int bl = item >> 3, h = item & 7;
        float S[64];
#pragma unroll
        for (int k = 0; k < 64; ++k) S[k] = 0.f;
        for (int c0 = 0; c0 < SEQ; c0 += TS) {
            __syncthreads();
            for (int i = tid; i < 6 * TS * 64; i += NTHR) {
                const int arr = i / (TS * 64), rem = i % (TS * 64), s = rem >> 6, d = rem & 63;
                const size_t src = ((size_t)(bl * SEQ + c0 + s)) * 512 + h * 64 + d;
                const float* ap = arr == 0 ? Ri : arr == 1 ? Wi : arr == 2 ? Ki : arr == 3 ? Ai : arr == 4 ? Bi : Vi;
                const float val = ap[src];
                if (arr < 5) vec[(arr * TS + s) * 64 + d] = val; else vb[s * 64 + d] = val;
            }
            __syncthreads();
            if (wv == 0) {
                for (int s = 0; s < TS; ++s) {
                    const float* rr = vec + (0 * TS + s) * 64; const float* ww = vec + (1 * TS + s) * 64; const float* kk = vec + (2 * TS + s) * 64;
                    const float* aa = vec + (3 * TS + s) * 64; const float* bb = vec + (4 * TS + s) * 64;
                    const float vv = vb[s * 64 + lane];
                    float sa = 0.f;
#pragma unroll
                    for (int k = 0; k < 64; ++k) sa = fmaf(S[k], aa[k], sa);
                    float y = 0.f;
#pragma unroll
                    for (int k = 0; k < 64; ++k) { S[k] = fmaf(S[k], ww[k], fmaf(sa, bb[k], vv * kk[k])); y = fmaf(S[k], rr[k], y); }
                    yb[s * 64 + lane] = y;
                }
            }
            __syncthreads();
            for (int s = wv; s < TS; s += 8) {
                const int tl = bl * SEQ + c0 + s; const int t = half * 16384 + tl; const int c = h * 64 + lane;
                const float y = yb[s * 64 + lane];
                const float m = wave_sum(y) * (1.0f / 64.f); const float dlt = y - m;
                const float var = wave_sum(dlt * dlt) * (1.0f / 64.f);
                float o = dlt * rsqrtf(var + 64e-5f) * p.in[I_GNW][c] + p.in[I_GNB][c];
                o += RKi[tl * 8 + h] * Vi[(size_t)tl * 512 + c];
                o *= Gi[(size_t)tl * 512 + c];
                p.out[(size_t)t * 1024 + 512 + c] = o;
            }
        }
    }
}
struct EpiOutproj {
    const float* x; const float* mod; float* x1;
    __device__ __forceinline__ void operator()(int row, int col, float v) const {
        const int b = row / SEQ;
        x1[(size_t)row * D + col] = x[(size_t)row * D + col] + mod[b * 6 * D + 2 * D + col] * v;
    }
};
__device__ __forceinline__ void ph_norm2_route(const Params& p, float* lds, int bid, int nb) {
    const float* x1 = (const float*)(p.ws + GW_X1); float* h2 = (float*)(p.ws + GW_H2); const float* mod = (const float*)(p.ws + GW_MOD);
    int* toke = (int*)(p.ws + GW_TOKE); float* tokw = (float*)(p.ws + GW_TOKW); int* cnt = (int*)(p.ws + GW_CTL);
    const float* g = p.in[I_N2G]; const float* rgw = p.in[I_RGW]; const float* rew = p.in[I_REW];
    const int lane = threadIdx.x & 63, wv = threadIdx.x >> 6;
    for (int row = bid * 8 + wv; row < NTOK; row += nb * 8) {
        const int b = row / SEQ;
        const float* xr = x1 + (size_t)row * D;
        float v[16]; float s = 0.f;
#pragma unroll
        for (int j = 0; j < 16; ++j) { v[j] = xr[lane + 64 * j]; s += v[j] * v[j]; }
        const float r = rsqrtf(wave_sum(s) * (1.0f / D) + 1e-6f);
        const float* sh = mod + b * 6 * D + 3 * D; const float* sc = mod + b * 6 * D + 4 * D;
        float lg[36];
#pragma unroll
        for (int j = 0; j < 36; ++j) lg[j] = 0.f;
#pragma unroll
        for (int j = 0; j < 16; ++j) {
            const int c = lane + 64 * j;
            const float hv = v[j] * r * g[c] * (1.0f + sc[c]) + sh[c];
            h2[(size_t)row * D + c] = hv;
#pragma unroll
            for (int q = 0; q < 4; ++q) lg[q] = fmaf(hv, rgw[c * 4 + q], lg[q]);
#pragma unroll
            for (int q = 0; q < 32; ++q) lg[4 + q] = fmaf(hv, rew[c * 32 + q], lg[4 + q]);
        }
#pragma unroll
        for (int j = 0; j < 36; ++j) lg[j] = wave_sum(lg[j]);
        float* wl = lds + wv * 64;
        if (lane == 0) {
#pragma unroll
            for (int j = 0; j < 36; ++j) wl[j] = lg[j];
            float gm = -1e30f; int gi = 0;
            for (int q = 0; q < 4; ++q) { const float t = wl[q] + p.in[I_RGB][q]; if (t > gm) { gm = t; gi = q; } }
            float gs = 0.f; for (int q = 0; q < 4; ++q) gs += expf(wl[q] + p.in[I_RGB][q] - gm);
            const float gp = 1.0f / gs;
            float* el = wl + 40;
            for (int q = 0; q < 8; ++q) el[q] = wl[4 + gi * 8 + q] + p.in[I_REB][gi * 8 + q];
            int i0 = 0; for (int q = 1; q < 8; ++q) if (el[q] > el[i0]) i0 = q;
            int i1 = (i0 == 0) ? 1 : 0; for (int q = 0; q < 8; ++q) if (q != i0 && el[q] > el[i1]) i1 = q;
            const float em = el[i0];
            const float p0 = 1.0f, p1 = expf(el[i1] - em);
            const float w0 = gp * p0 / (p0 + p1), w1 = gp * p1 / (p0 + p1);
            const int e0 = gi * 8 + i0, e1 = gi * 8 + i1;
            toke[row * 2] = e0; toke[row * 2 + 1] = e1; tokw[row * 2] = w0; tokw[row * 2 + 1] = w1;
            atomicAdd(&cnt[e0], 1); atomicAdd(&cnt[e1], 1);
        }
    }
}
__device__ __forceinline__ void ph_moe_init(const Params& p, int bid, int nb) {
    int* rowtok = (int*)(p.ws + GW_ROWTOK); int* rowaid = (int*)(p.ws + GW_ROWAID); float* roww = (float*)(p.ws + GW_ROWW); int* tilee = (int*)(p.ws + GW_TILEE);
    const int* cnt = (const int*)(p.ws + GW_CTL);
    for (int i = bid * NTHR + threadIdx.x; i < PROWS; i += nb * NTHR) { rowtok[i] = -1; rowaid[i] = -1; roww[i] = 0.f; }
    if (bid == 0 && threadIdx.x == 0) {
        int t = 0;
        for (int e = 0; e < NE; ++e) { const int nt = (cnt[e] + GT - 1) / GT; for (int j = 0; j < nt; ++j) tilee[t++] = e; }
        for (; t < PTILES; ++t) tilee[t] = -1;
    }
}
__device__ __forceinline__ void ph_moe_place(const Params& p, int bid, int nb) {
    int* rowtok = (int*)(p.ws + GW_ROWTOK); int* rowaid = (int*)(p.ws + GW_ROWAID); float* roww = (float*)(p.ws + GW_ROWW);
    const int* cnt = (const int*)(p.ws + GW_CTL); int* cursor = (int*)(p.ws + GW_CTL + 128);
    const int* toke = (const int*)(p.ws + GW_TOKE); const float* tokw = (const float*)(p.ws + GW_TOKW);
    for (int a = bid * NTHR + threadIdx.x; a < NTOK * 2; a += nb * NTHR) {
        const int e = toke[a];
        int start = 0; for (int q = 0; q < e; ++q) start += (cnt[q] + GT - 1) / GT * GT;
        const int pos = start + atomicAdd(&cursor[e], 1);
        rowtok[pos] = a >> 1; rowaid[pos] = a; roww[pos] = tokw[a];
    }
}
struct EpiGate { float* hb; __device__ __forceinline__ void operator()(int row, int col, float v) const { hb[(size_t)row * EH + col] = v; } };
struct EpiUp { float* hb; __device__ __forceinline__ void operator()(int row, int col, float v) const { const float g = hb[(size_t)row * EH + col]; hb[(size_t)row * EH + col] = g / (1.0f + expf(-g)) * v; } };
struct EpiDown {
    const int* rowaid; const float* roww; float* y0; float* y1;
    __device__ __forceinline__ void operator()(int row, int col, float v) const {
        const int a = rowaid[row]; if (a < 0) return;
        float* y = (a & 1) ? y1 : y0;
        y[(size_t)(a >> 1) * D + col] = roww[row] * v;
    }
};
__device__ __forceinline__ void ph_final(const Params& p, int bid, int nb) {
    const float* x1 = (const float*)(p.ws + GW_X1); const float* y1 = (const float*)(p.ws + GW_H2); const float* mod = (const float*)(p.ws + GW_MOD);
    float* out = p.out; const float* g = p.in[I_FNG];
    const int lane = threadIdx.x & 63, wv = threadIdx.x >> 6;
    for (int row = bid * 8 + wv; row < NTOK; row += nb * 8) {
        const int b = row / SEQ; const float* gt = mod + b * 6 * D + 5 * D;
        float v[16]; float s = 0.f;
#pragma unroll
        for (int j = 0; j < 16; ++j) { const int c = lane + 64 * j; const size_t o = (size_t)row * D + c; v[j] = x1[o] + gt[c] * (out[o] + y1[o]); s += v[j] * v[j]; }
        const float r = rsqrtf(wave_sum(s) * (1.0f / D) + 1e-6f);
#pragma unroll
        for (int j = 0; j < 16; ++j) { const int c = lane + 64 * j; out[(size_t)row * D + c] = v[j] * r * g[c]; }
    }
}

__global__ void __launch_bounds__(NTHR) k_phase(Params p) {
    __shared__ __attribute__((aligned(16))) float lds[8192];
    const int bid = blockIdx.x, nb = gridDim.x;
    switch (p.phase) {
    case 0: ph_mod(p, bid, nb); break;
    case 1: ph_normmod(p.in[I_X], p.in[I_N1G], (const float*)(p.ws + GW_MOD), 0, 1, (float*)(p.ws + GW_H1), bid, nb); break;
    case 2: { EpiInproj e{(float*)(p.ws + GW_ZUV), (float*)(p.ws + GW_ZR)};
              gg_gemm(lds, (const float*)(p.ws + GW_H1), D, nullptr, p.in[I_WIN], INW, 0, nullptr, NTOK, INW, D, e, bid, nb); } break;
    case 3: ph_gmlp_ln(p, bid, nb); break;
    case 4: ph_gmlp_mix(p, bid, nb); break;
    case 5: ph_rwkv_prep(p, lds, p.sub, bid, nb); break;
    case 6: ph_rwkv_scan(p, lds, p.sub, bid, nb); break;
    case 7: { EpiOutproj e{p.in[I_X], (const float*)(p.ws + GW_MOD), (float*)(p.ws + GW_X1)};
              gg_gemm(lds, p.out, D, nullptr, p.in[I_WOUT], D, 0, nullptr, NTOK, D, D, e, bid, nb); } break;
    case 8: ph_norm2_route(p, lds, bid, nb); break;
    case 9: ph_moe_init(p, bid, nb); break;
    case 10: ph_moe_place(p, bid, nb); break;
    case 11: { EpiGate e{(float*)(p.ws + GW_HB)};
               gg_gemm(lds, (const float*)(p.ws + GW_H2), D, (const int*)(p.ws + GW_ROWTOK), p.in[I_WG], EH, (size_t)D * EH, (const int*)(p.ws + GW_TILEE), PROWS, EH, D, e, bid, nb); } break;
    case 12: { EpiUp e{(float*)(p.ws + GW_HB)};
               gg_gemm(lds, (const float*)(p.ws + GW_H2), D, (const int*)(p.ws + GW_ROWTOK), p.in[I_WU], EH, (size_t)D * EH, (const int*)(p.ws + GW_TILEE), PROWS, EH, D, e, bid, nb); } break;
    case 13: { EpiDown e{(const int*)(p.ws + GW_ROWAID), (const float*)(p.ws + GW_ROWW), p.out, (float*)(p.ws + GW_H2)};
               gg_gemm(lds, (const float*)(p.ws + GW_HB), EH, nullptr, p.in[I_WD], D, (size_t)EH * D, (const int*)(p.ws + GW_TILEE), PROWS, D, EH, e, bid, nb); } break;
    case 14: ph_final(p, bid, nb); break;
    }
}

extern "C" void kernel_launch(void* const* d_in, const int* in_sizes, int n_in, void* d_out, int out_size, void* d_ws, size_t ws_size, hipStream_t stream) {
    if (n_in != 31 || ws_size < WS_NEED || out_size != NTOK * D) { fprintf(stderr, "kernel_launch: unexpected sizes n_in %d ws %zu out %d\n", n_in, ws_size, out_size); return; }
    Params p{};
    for (int i = 0; i < 31; ++i) p.in[i] = (const float*)d_in[i];
    p.out = (float*)d_out; p.ws = (unsigned char*)d_ws;
    (void)hipMemsetAsync((char*)d_ws + GW_CTL, 0, 4096, stream);
    auto L = [&](int phase, int sub, int grid) { p.phase = phase; p.sub = sub; hipLaunchKernelGGL(k_phase, dim3(grid), dim3(NTHR), 0, stream, p); };
    L(0, 0, 96);
    L(1, 0, 1024);
    L(2, 0, 2048);
    L(3, 0, 1024);
    L(4, 0, 2048);
    for (int half = 0; half < 2; ++half) { L(5, half, 2048); L(6, half, 32); }
    L(7, 0, 2048);
    L(8, 0, 1024);
    L(9, 0, 64);
    L(10, 0, 128);
    L(11, 0, 2048);
    L(12, 0, 2048);
    L(13, 0, 2048);
    L(14, 0, 1024);
}
```

```cpp
#include <hip/hip_runtime.h>
#include <hip/hip_cooperative_groups.h>
namespace cg = cooperative_groups;
#include <cstdio>
#include <cstdint>

constexpr int D = 1024, BATCH = 8, SEQ = 4096, NTOK = BATCH * SEQ;
constexpr int GW = 512, RW = 512, HD = 64, CHUNK = 128;
constexpr int RPROJ = 1696, INW = 2720;
constexpr int NG = 4, EPG = 8, NE = 32, EH = 512;
constexpr int NTHR = 512;

typedef float f32x16 __attribute__((ext_vector_type(16)));
typedef float f32x4 __attribute__((ext_vector_type(4)));

constexpr size_t MiB = 1u << 20;
constexpr size_t GW_ZR = 0;
constexpr size_t GW_ZUV = 212 * MiB;
constexpr size_t GW_H1 = 340 * MiB;
constexpr size_t GW_SC = 212 * MiB;
constexpr size_t GW_RK = 436 * MiB;
constexpr size_t GW_X1 = 0;
constexpr size_t GW_H2 = 128 * MiB;
constexpr size_t GW_HB = 256 * MiB;
constexpr size_t GW_SM = 468 * MiB;
constexpr size_t GW_MOD = GW_SM;
constexpr size_t GW_TOKE = GW_SM + 1 * MiB;
constexpr size_t GW_TOKW = GW_SM + 2 * MiB;
constexpr size_t GW_ROWTOK = GW_SM + 3 * MiB;
constexpr size_t GW_ROWAID = GW_SM + 4 * MiB;
constexpr size_t GW_ROWW = GW_SM + 5 * MiB;
constexpr size_t GW_TILEE = GW_SM + 6 * MiB;
constexpr size_t GW_CTL = GW_SM + 7 * MiB;
constexpr size_t WS_NEED = 512 * MiB;
constexpr int GT = 128;
constexpr int PROWS = NTOK * 2 + NE * GT;
constexpr int PTILES = PROWS / GT;

struct Params {
    const float* in[31];
    float* out;
    unsigned char* ws;
    int phase, sub;
};

enum { I_X = 0, I_C, I_ADAW, I_ADAB, I_N1G, I_WIN, I_GLNW, I_GLNB, I_GWS, I_GBS, I_MU, I_W0, I_W2, I_A0, I_A2, I_G2, I_KK, I_KA, I_RK, I_GNW, I_GNB, I_WOUT, I_N2G, I_RGW, I_RGB, I_REW, I_REB, I_WG, I_WU, I_WD, I_FNG };

__device__ __forceinline__ float wave_sum(float v) {
#pragma unroll
    for (int o = 1; o < 64; o <<= 1) v += __shfl_xor(v, o);
    return v;
}
__device__ __forceinline__ float gelu_tanh(float x) {
    const float u = 0.7978845608028654f * (x + 0.044715f * x * x * x);
    return 0.5f * x * (1.0f + tanhf(u));
}
__device__ __forceinline__ float sigmoidf_(float x) { return 1.0f / (1.0f + expf(-x)); }
__device__ __forceinline__ float softplusf_(float x) { return fmaxf(x, 0.f) + log1pf(expf(-fabsf(x))); }

template <class Epi>
__device__ __forceinline__ void gg_gemm(float* lds, const float* __restrict__ A, int lda, const int* rowidx, const float* __restrict__ B, int ldb, size_t bstride,
                        const int* tile_expert, int M, int N, int K, const Epi& epi, int bid, int nb) {
    float* As = lds;
    float* Bs = lds + 16 * 132;
    const int tid = threadIdx.x, lane = tid & 63, wid = tid >> 6, wm = wid >> 1, wn = wid & 1;
    const int tilesN = (N + 127) / 128, tilesM = M / 128;
    for (int tile = bid; tile < tilesM * tilesN; tile += nb) {
        const int tm = tile / tilesN, tn = tile % tilesN;
        const float* Bp = B;
        if (tile_expert) { const int e = tile_expert[tm]; if (e < 0) continue; Bp = B + (size_t)e * bstride; }
        f32x16 acc0, acc1;
#pragma unroll
        for (int i = 0; i < 16; ++i) { acc0[i] = 0.f; acc1[i] = 0.f; }
        const int arow = tid >> 2, akq = (tid & 3) * 4;
        int asrc = tm * 128 + arow;
        if (rowidx) asrc = rowidx[asrc];
        const int bk = tid >> 5, bn4 = (tid & 31) * 4, bcol = tn * 128 + bn4;
        for (int k0 = 0; k0 < K; k0 += 16) {
            f32x4 av = {0.f, 0.f, 0.f, 0.f};
            if (asrc >= 0) av = *(const f32x4*)(A + (size_t)asrc * lda + k0 + akq);
            f32x4 bv = {0.f, 0.f, 0.f, 0.f};
            if (bcol < N) bv = *(const f32x4*)(Bp + (size_t)(k0 + bk) * ldb + bcol);
            __syncthreads();
            As[(akq + 0) * 132 + arow] = av[0]; As[(akq + 1) * 132 + arow] = av[1]; As[(akq + 2) * 132 + arow] = av[2]; As[(akq + 3) * 132 + arow] = av[3];
            *(f32x4*)(Bs + bk * 128 + bn4) = bv;
            __syncthreads();
#pragma unroll
            for (int kk = 0; kk < 16; kk += 2) {
                const int kr = kk + (lane >> 5);
                const float a = As[kr * 132 + wm * 32 + (lane & 31)];
                const float b0 = Bs[kr * 128 + wn * 64 + (lane & 31)];
                const float b1 = Bs[kr * 128 + wn * 64 + 32 + (lane & 31)];
                acc0 = __builtin_amdgcn_mfma_f32_32x32x2f32(a, b0, acc0, 0, 0, 0);
                acc1 = __builtin_amdgcn_mfma_f32_32x32x2f32(a, b1, acc1, 0, 0, 0);
            }
        }
#pragma unroll
        for (int r = 0; r < 16; ++r) {
            const int row = tm * 128 + wm * 32 + (r & 3) + 8 * (r >> 2) + 4 * (lane >> 5);
            const int c0 = tn * 128 + wn * 64 + (lane & 31);
            if (c0 < N) epi(row, c0, acc0[r]);
            if (c0 + 32 < N) epi(row, c0 + 32, acc1[r]);
        }
    }
}

__device__ __forceinline__ void ph_mod(const Params& p, int bid, int nb) {
    float* mod = (float*)(p.ws + GW_MOD);
    const float* c = p.in[I_C]; const float* w = p.in[I_ADAW]; const float* bb = p.in[I_ADAB];
    for (int i = bid * NTHR + threadIdx.x; i < BATCH * 6 * D; i += nb * NTHR) {
        const int b = i / (6 * D), n = i % (6 * D);
        float s = 0.f;
        for (int k = 0; k < D; ++k) s = fmaf(c[b * D + k], w[(size_t)k * 6 * D + n], s);
        mod[i] = s + bb[n];
    }
}
__device__ __forceinline__ void ph_normmod(const float* __restrict__ x, const float* __restrict__ g, const float* mod, int shift_idx, int scale_idx, float* __restrict__ out, int bid, int nb) {
    const int lane = threadIdx.x & 63, wv = threadIdx.x >> 6;
    for (int row = bid * 8 + wv; row < NTOK; row += nb * 8) {
        const int b = row / SEQ;
        const f32x4* xr = (const f32x4*)(x + (size_t)row * D) + lane;
        f32x4 v[4]; float s = 0.f;
#pragma unroll
        for (int j = 0; j < 4; ++j) { v[j] = xr[64 * j]; s += v[j][0] * v[j][0] + v[j][1] * v[j][1] + v[j][2] * v[j][2] + v[j][3] * v[j][3]; }
        const float r = rsqrtf(wave_sum(s) * (1.0f / D) + 1e-6f);
        const float* sh = mod + b * 6 * D + shift_idx * D; const float* sc = mod + b * 6 * D + scale_idx * D;
        f32x4* o = (f32x4*)(out + (size_t)row * D) + lane;
#pragma unroll
        for (int j = 0; j < 4; ++j) {
            const int c0 = (lane + 64 * j) * 4; f32x4 y;
#pragma unroll
            for (int q = 0; q < 4; ++q) y[q] = v[j][q] * r * g[c0 + q] * (1.0f + sc[c0 + q]) + sh[c0 + q];
            o[64 * j] = y;
        }
    }
}
struct EpiInproj {
    float* zuv; float* zr;
    __device__ __forceinline__ void operator()(int row, int col, float v) const {
        if (col < 2 * GW) zuv[(size_t)row * 1024 + col] = gelu_tanh(v);
        else zr[(size_t)row * RPROJ + (col - 2 * GW)] = v;
    }
};
__device__ __forceinline__ void ph_gmlp_ln(const Params& p, int bid, int nb) {
    const float* zuv = (const float*)(p.ws + GW_ZUV); float* vln = (float*)(p.ws + GW_H1);
    const float* lw = p.in[I_GLNW]; const float* lb = p.in[I_GLNB];
    const int lane = threadIdx.x & 63, wv = threadIdx.x >> 6;
    for (int row = bid * 8 + wv; row < NTOK; row += nb * 8) {
        const float* vr = zuv + (size_t)row * 1024 + 512;
        float v[8]; float s = 0.f;
#pragma unroll
        for (int j = 0; j < 8; ++j) { v[j] = vr[lane + 64 * j]; s += v[j]; }
        const float m = wave_sum(s) * (1.0f / 512.f); float q = 0.f;
#pragma unroll
        for (int j = 0; j < 8; ++j) { const float d = v[j] - m; q += d * d; }
        const float rs = rsqrtf(wave_sum(q) * (1.0f / 512.f) + 1e-5f);
#pragma unroll
        for (int j = 0; j < 8; ++j) { const int c = lane + 64 * j; vln[(size_t)row * 512 + c] = (v[j] - m) * rs * lw[c] + lb[c]; }
    }
}
__device__ __forceinline__ void ph_gmlp_mix(const Params& p, int bid, int nb) {
    const float* zuv = (const float*)(p.ws + GW_ZUV); const float* vln = (const float*)(p.ws + GW_H1);
    const float* wsp = p.in[I_GWS]; const float* bsp = p.in[I_GBS];
    float* ycat = p.out;
    for (int t = bid; t < NTOK; t += nb) {
        const int c = threadIdx.x, h = c >> 6, tl = t & 127, t0 = t - tl;
        const float* wrow = wsp + ((size_t)h * CHUNK + tl) * CHUNK;
        float s = 0.f;
        for (int ss = 0; ss <= tl; ++ss) s = fmaf(wrow[ss], vln[(size_t)(t0 + ss) * 512 + c], s);
        s += bsp[h * CHUNK + tl];
        ycat[(size_t)t * 1024 + c] = zuv[(size_t)t * 1024 + c] * s;
    }
}
__device__ __forceinline__ void ph_rwkv_prep(const Params& p, float* lds, int half, int bid, int nb) {
    const float* zr = (const float*)(p.ws + GW_ZR);
    float* SC = (float*)(p.ws + GW_SC); float* RKo = (float*)(p.ws + GW_RK);
    constexpr size_t AS = (size_t)16384 * 512;
    float *Ro = SC, *Wo = SC + AS, *Ko = SC + 2 * AS, *Vo = SC + 3 * AS, *Ao = SC + 4 * AS, *Bo = SC + 5 * AS, *Go = SC + 6 * AS;
    const float* mu = p.in[I_MU];
    float* zs = lds;
    const int c = threadIdx.x, lane = c & 63, h = c >> 6;
    for (int tl = bid; tl < 16384; tl += nb) {
        const int t = half * 16384 + tl;
        __syncthreads();
        for (int j = c; j < RPROJ; j += NTHR) {
            const float cur = zr[(size_t)t * RPROJ + j];
            const float prev = (t % SEQ == 0) ? 0.f : zr[(size_t)(t - 1) * RPROJ + j];
            float z = cur + (prev - cur) * mu[j];
            if (j >= 1536 && j < 1568) z = tanhf(z);
            if (j >= 1600) z = sigmoidf_(z);
            zs[j] = z;
        }
        __syncthreads();
        const float r = zs[c], k = zs[512 + c], v = zs[1024 + c];
        float dw = 0.f, da = 0.f, g = 0.f;
#pragma unroll 4
        for (int j = 0; j < 32; ++j) dw = fmaf(zs[1536 + j], p.in[I_W2][j * 512 + c], dw);
#pragma unroll 4
        for (int j = 0; j < 32; ++j) da = fmaf(zs[1568 + j], p.in[I_A2][j * 512 + c], da);
#pragma unroll 4
        for (int j = 0; j < 96; ++j) g = fmaf(zs[1600 + j], p.in[I_G2][j * 512 + c], g);
        const float wlog = -softplusf_(-(p.in[I_W0][c] + dw)) - 0.5f;
        const float decay = expf(-expf(wlog));
        const float asig = sigmoidf_(p.in[I_A0][c] + da);
        const float kkv = k * p.in[I_KK][c];
        const float nrm = sqrtf(wave_sum(kkv * kkv));
        const float kk = kkv / fmaxf(nrm, 1e-12f);
        const float k2 = k * (1.0f + (asig - 1.0f) * p.in[I_KA][c]);
        const float rk = wave_sum(r * k2 * p.in[I_RK][c]);
        const size_t o = (size_t)tl * 512 + c;
        Ro[o] = r; Wo[o] = decay; Ko[o] = k2; Vo[o] = v; Ao[o] = -kk; Bo[o] = kk * asig; Go[o] = g;
        if (lane == 0) RKo[tl * 8 + h] = rk;
    }
}
__device__ __forceinline__ void ph_rwkv_scan(const Params& p, float* lds, int half, int bid, int nb) {
    const float* SC = (const float*)(p.ws + GW_SC); const float* RKi = (const float*)(p.ws + GW_RK);
    constexpr size_t AS = (size_t)16384 * 512;
    const float *Ri = SC, *Wi = SC + AS, *Ki = SC + 2 * AS, *Vi = SC + 3 * AS, *Ai = SC + 4 * AS, *Bi = SC + 5 * AS, *Gi = SC + 6 * AS;
    constexpr int TS = 16;
    float* vec = lds;
    float* vb = lds + 5 * TS * 64;
    float* yb = vb + TS * 64;
    const int tid = threadIdx.x, lane = tid & 63, wv = tid >> 6;
    for (int item = bid; item < 32; item += nb) {
        const int bl = item >> 3, h = item & 7;
        float S[64];
#pragma unroll
        for (int k = 0; k < 64; ++k) S[k] = 0.f;
        for (int c0 = 0; c0 < SEQ; c0 += TS) {
            __syncthreads();
            for (int i = tid; i < 6 * TS * 64; i += NTHR) {
                const int arr = i / (TS * 64), rem = i % (TS * 64), s = rem >> 6, d = rem & 63;
                const size_t src = ((size_t)(bl * SEQ + c0 + s)) * 512 + h * 64 + d;
                const float* ap = arr == 0 ? Ri : arr == 1 ? Wi : arr == 2 ? Ki : arr == 3 ? Ai : arr == 4 ? Bi : Vi;
                const float val = ap[src];
                if (arr < 5) vec[(arr * TS + s) * 64 + d] = val; else vb[s * 64 + d] = val;
            }
            __syncthreads();
            if (wv == 0) {
                for (int s = 0; s < TS; ++s) {
                    const float* rr = vec + (0 * TS + s) * 64; const float* ww = vec + (1 * TS + s) * 64; const float* kk = vec + (2 * TS + s) * 64;
                    const float* aa = vec + (3 * TS + s) * 64; const float* bb = vec + (4 * TS + s) * 64;
                    const float vv = vb[s * 64 + lane];
                    float sa = 0.f;
#pragma unroll
                    for (int k = 0; k < 64; ++k) sa = fmaf(S[k], aa[k], sa);
                    float y = 0.f;
#pragma unroll
                    for (int k = 0; k < 64; ++k) { S[k] = fmaf(S[k], ww[k], fmaf(sa, bb[k], vv * kk[k])); y = fmaf(S[k], rr[k], y); }
                    yb[s * 64 + lane] = y;
                }
            }
            __syncthreads();
            for (int s = wv; s < TS; s += 8) {
                const int tl = bl * SEQ + c0 + s; const int t = half * 16384 + tl; const int c = h * 64 + lane;
                const float y = yb[s * 64 + lane];
                const float m = wave_sum(y) * (1.0f / 64.f); const float dlt = y - m;
                const float var = wave_sum(dlt * dlt) * (1.0f / 64.f);
                float o = dlt * rsqrtf(var + 64e-5f) * p.in[I_GNW][c] + p.in[I_GNB][c];
                o += RKi[tl * 8 + h] * Vi[(size_t)tl * 512 + c];
                o *= Gi[(size_t)tl * 512 + c];
                p.out[(size_t)t * 1024 + 512 + c] = o;
            }
        }
    }
}
struct EpiOutproj {
    const float* x; const float* mod; float* x1;
    __device__ __forceinline__ void operator()(int row, int col, float v) const {
        const int b = row / SEQ;
        x1[(size_t)row * D + col] = x[(size_t)row * D + col] + mod[b * 6 * D + 2 * D + col] * v;
    }
};
__device__ __forceinline__ void ph_norm2_route(const Params& p, float* lds, int bid, int nb) {
    const float* x1 = (const float*)(p.ws + GW_X1); float* h2 = (float*)(p.ws + GW_H2); const float* mod = (const float*)(p.ws + GW_MOD);
    int* toke = (int*)(p.ws + GW_TOKE); float* tokw = (float*)(p.ws + GW_TOKW); int* cnt = (int*)(p.ws + GW_CTL);
    const float* g = p.in[I_N2G]; const float* rgw = p.in[I_RGW]; const float* rew = p.in[I_REW];
    const int lane = threadIdx.x & 63, wv = threadIdx.x >> 6;
    for (int row = bid * 8 + wv; row < NTOK; row += nb * 8) {
        const int b = row / SEQ;
        const float* xr = x1 + (size_t)row * D;
        float v[16]; float s = 0.f;
#pragma unroll
        for (int j = 0; j < 16; ++j) { v[j] = xr[lane + 64 * j]; s += v[j] * v[j]; }
        const float r = rsqrtf(wave_sum(s) * (1.0f / D) + 1e-6f);
        const float* sh = mod + b * 6 * D + 3 * D; const float* sc = mod + b * 6 * D + 4 * D;
        float lg[36];
#pragma unroll
        for (int j = 0; j < 36; ++j) lg[j] = 0.f;
#pragma unroll
        for (int j = 0; j < 16; ++j) {
            const int c = lane + 64 * j;
            const float hv = v[j] * r * g[c] * (1.0f + sc[c]) + sh[c];
            h2[(size_t)row * D + c] = hv;
#pragma unroll
            for (int q = 0; q < 4; ++q) lg[q] = fmaf(hv, rgw[c * 4 + q], lg[q]);
#pragma unroll
            for (int q = 0; q < 32; ++q) lg[4 + q] = fmaf(hv, rew[c * 32 + q], lg[4 + q]);
        }
#pragma unroll
        for (int j = 0; j < 36; ++j) lg[j] = wave_sum(lg[j]);
        float* wl = lds + wv * 64;
        if (lane == 0) {
#pragma unroll
            for (int j = 0; j < 36; ++j) wl[j] = lg[j];
            float gm = -1e30f; int gi = 0;
            for (int q = 0; q < 4; ++q) { const float t = wl[q] + p.in[I_RGB][q]; if (t > gm) { gm = t; gi = q; } }
            float gs = 0.f; for (int q = 0; q < 4; ++q) gs += expf(wl[q] + p.in[I_RGB][q] - gm);
            const float gp = 1.0f / gs;
            float* el = wl + 40;
            for (int q = 0; q < 8; ++q) el[q] = wl[4 + gi * 8 + q] + p.in[I_REB][gi * 8 + q];
            int i0 = 0; for (int q = 1; q < 8; ++q) if (el[q] > el[i0]) i0 = q;
            int i1 = (i0 == 0) ? 1 : 0; for (int q = 0; q < 8; ++q) if (q != i0 && el[q] > el[i1]) i1 = q;
            const float em = el[i0];
            const float p0 = 1.0f, p1 = expf(el[i1] - em);
            const float w0 = gp * p0 / (p0 + p1), w1 = gp * p1 / (p0 + p1);
            const int e0 = gi * 8 + i0, e1 = gi * 8 + i1;
            toke[row * 2] = e0; toke[row * 2 + 1] = e1; tokw[row * 2] = w0; tokw[row * 2 + 1] = w1;
            atomicAdd(&cnt[e0], 1); atomicAdd(&cnt[e1], 1);
        }
    }
}
__device__ __forceinline__ void ph_moe_init(const Params& p, int bid, int nb) {
    int* rowtok = (int*)(p.ws + GW_ROWTOK); int* rowaid = (int*)(p.ws + GW_ROWAID); float* roww = (float*)(p.ws + GW_ROWW); int* tilee = (int*)(p.ws + GW_TILEE);
    const int* cnt = (const int*)(p.ws + GW_CTL);
    for (int i = bid * NTHR + threadIdx.x; i < PROWS; i += nb * NTHR) { rowtok[i] = -1; rowaid[i] = -1; roww[i] = 0.f; }
    if (bid == 0 && threadIdx.x == 0) {
        int t = 0;
        for (int e = 0; e < NE; ++e) { const int nt = (cnt[e] + GT - 1) / GT; for (int j = 0; j < nt; ++j) tilee[t++] = e; }
        for (; t < PTILES; ++t) tilee[t] = -1;
    }
}
__device__ __forceinline__ void ph_moe_place(const Params& p, int bid, int nb) {
    int* rowtok = (int*)(p.ws + GW_ROWTOK); int* rowaid = (int*)(p.ws + GW_ROWAID); float* roww = (float*)(p.ws + GW_ROWW);
    const int* cnt = (const int*)(p.ws + GW_CTL); int* cursor = (int*)(p.ws + GW_CTL + 128);
    const int* toke = (const int*)(p.ws + GW_TOKE); const float* tokw = (const float*)(p.ws + GW_TOKW);
    for (int a = bid * NTHR + threadIdx.x; a < NTOK * 2; a += nb * NTHR) {
        const int e = toke[a];
        int start = 0; for (int q = 0; q < e; ++q) start += (cnt[q] + GT - 1) / GT * GT;
        const int pos = start + atomicAdd(&cursor[e], 1);
        rowtok[pos] = a >> 1; rowaid[pos] = a; roww[pos] = tokw[a];
    }
}
struct EpiGate { float* hb; __device__ __forceinline__ void operator()(int row, int col, float v) const { hb[(size_t)row * EH + col] = v; } };
struct EpiUp { float* hb; __device__ __forceinline__ void operator()(int row, int col, float v) const { const float g = hb[(size_t)row * EH + col]; hb[(size_t)row * EH + col] = g / (1.0f + expf(-g)) * v; } };
struct EpiDown {
    const int* rowaid; const float* roww; float* y0; float* y1;
    __device__ __forceinline__ void operator()(int row, int col, float v) const {
        const int a = rowaid[row]; if (a < 0) return;
        float* y = (a & 1) ? y1 : y0;
        y[(size_t)(a >> 1) * D + col] = roww[row] * v;
    }
};
__device__ __forceinline__ void ph_final(const Params& p, int bid, int nb) {
    const float* x1 = (const float*)(p.ws + GW_X1); const float* y1 = (const float*)(p.ws + GW_H2); const float* mod = (const float*)(p.ws + GW_MOD);
    float* out = p.out; const float* g = p.in[I_FNG];
    const int lane = threadIdx.x & 63, wv = threadIdx.x >> 6;
    for (int row = bid * 8 + wv; row < NTOK; row += nb * 8) {
        const int b = row / SEQ; const float* gt = mod + b * 6 * D + 5 * D;
        float v[16]; float s = 0.f;
#pragma unroll
        for (int j = 0; j < 16; ++j) { const int c = lane + 64 * j; const size_t o = (size_t)row * D + c; v[j] = x1[o] + gt[c] * (out[o] + y1[o]); s += v[j] * v[j]; }
        const float r = rsqrtf(wave_sum(s) * (1.0f / D) + 1e-6f);
#pragma unroll
        for (int j = 0; j < 16; ++j) { const int c = lane + 64 * j; out[(size_t)row * D + c] = v[j] * r * g[c]; }
    }
}


__device__ __forceinline__ void run_phase(const Params& p, float* lds, int phase, int sub, int bid, int nb) {
    switch (phase) {
    case 0: ph_mod(p, bid, nb); break;
    case 1: ph_normmod(p.in[I_X], p.in[I_N1G], (const float*)(p.ws + GW_MOD), 0, 1, (float*)(p.ws + GW_H1), bid, nb); break;
    case 2: { EpiInproj e{(float*)(p.ws + GW_ZUV), (float*)(p.ws + GW_ZR)};
              gg_gemm(lds, (const float*)(p.ws + GW_H1), D, nullptr, p.in[I_WIN], INW, 0, nullptr, NTOK, INW, D, e, bid, nb); } break;
    case 3: ph_gmlp_ln(p, bid, nb); break;
    case 4: ph_gmlp_mix(p, bid, nb); break;
    case 5: ph_rwkv_prep(p, lds, sub, bid, nb); break;
    case 6: ph_rwkv_scan(p, lds, sub, bid, nb); break;
    case 7: { EpiOutproj e{p.in[I_X], (const float*)(p.ws + GW_MOD), (float*)(p.ws + GW_X1)};
              gg_gemm(lds, p.out, D, nullptr, p.in[I_WOUT], D, 0, nullptr, NTOK, D, D, e, bid, nb); } break;
    case 8: ph_norm2_route(p, lds, bid, nb); break;
    case 9: ph_moe_init(p, bid, nb); break;
    case 10: ph_moe_place(p, bid, nb); break;
    case 11: { EpiGate e{(float*)(p.ws + GW_HB)};
               gg_gemm(lds, (const float*)(p.ws + GW_H2), D, (const int*)(p.ws + GW_ROWTOK), p.in[I_WG], EH, (size_t)D * EH, (const int*)(p.ws + GW_TILEE), PROWS, EH, D, e, bid, nb); } break;
    case 12: { EpiUp e{(float*)(p.ws + GW_HB)};
               gg_gemm(lds, (const float*)(p.ws + GW_H2), D, (const int*)(p.ws + GW_ROWTOK), p.in[I_WU], EH, (size_t)D * EH, (const int*)(p.ws + GW_TILEE), PROWS, EH, D, e, bid, nb); } break;
    case 13: { EpiDown e{(const int*)(p.ws + GW_ROWAID), (const float*)(p.ws + GW_ROWW), p.out, (float*)(p.ws + GW_H2)};
               gg_gemm(lds, (const float*)(p.ws + GW_HB), EH, nullptr, p.in[I_WD], D, (size_t)EH * D, (const int*)(p.ws + GW_TILEE), PROWS, D, EH, e, bid, nb); } break;
    case 14: ph_final(p, bid, nb); break;
    }
}

__global__ void __launch_bounds__(NTHR) k_mega(Params p) {
    __shared__ __attribute__((aligned(16))) float lds[8192];
    cg::grid_group grid = cg::this_grid();
    const int bid = blockIdx.x, nb = gridDim.x;
#define PH(ph, sub) do { run_phase(p, lds, ph, sub, bid, nb); grid.sync(); } while (0)
    PH(0, 0); PH(1, 0); PH(2, 0); PH(3, 0); PH(4, 0);
    for (int half = 0; half < 2; ++half) { PH(5, half); PH(6, half); }
    PH(7, 0); PH(8, 0); PH(9, 0); PH(10, 0); PH(11, 0); PH(12, 0); PH(13, 0);
    run_phase(p, lds, 14, 0, bid, nb);
#undef PH
}

extern "C" void kernel_launch(void* const* d_in, const int* in_sizes, int n_in, void* d_out, int out_size, void* d_ws, size_t ws_size, hipStream_t stream) {
    if (n_in != 31 || ws_size < WS_NEED || out_size != NTOK * D) { fprintf(stderr, "kernel_launch: unexpected sizes n_in %d ws %zu out %d\n", n_in, ws_size, out_size); return; }
    static int grid_blocks = 0;
    if (!grid_blocks) {
        int dev = 0, cus = 0, per_cu = 0;
        (void)hipGetDevice(&dev);
        (void)hipDeviceGetAttribute(&cus, hipDeviceAttributeMultiprocessorCount, dev);
        (void)hipOccupancyMaxActiveBlocksPerMultiprocessor(&per_cu, k_mega, NTHR, 0);
        if (per_cu < 1) per_cu = 1;
        grid_blocks = cus;
    }
    Params p{};
    for (int i = 0; i < 31; ++i) p.in[i] = (const float*)d_in[i];
    p.out = (float*)d_out; p.ws = (unsigned char*)d_ws;
    (void)hipMemsetAsync((char*)d_ws + GW_CTL, 0, 4096, stream);
    void* args[] = {&p};
    hipError_t e = hipLaunchCooperativeKernel((void*)k_mega, dim3(grid_blocks), dim3(NTHR), args, 0, stream);
    if (e != hipSuccess) fprintf(stderr, "cooperative launch failed: %s (grid %d)\n", hipGetErrorString(e), grid_blocks);
}
```

```cpp
#include <hip/hip_runtime.h>
#include <hip/hip_cooperative_groups.h>
#include <cstdio>
#include <cstdint>
namespace cg = cooperative_groups;
__device__ __forceinline__ int otid() { int t = threadIdx.x; asm volatile("" : "+v"(t)); return t; }

namespace pg8 {
#define PG8_LAS __attribute__((address_space(3)))
typedef unsigned short bf16_t;
typedef short bf16x8 __attribute__((ext_vector_type(8)));
typedef float f32x4 __attribute__((ext_vector_type(4)));
typedef unsigned u32x4 __attribute__((ext_vector_type(4)));
constexpr int BM = 256, BK = 64, HALF = 128, HTB = HALF * BK * 2  , STAGE_BYTES = 8 * HTB, NXCD = 8, WGM = 8;

__host__ __device__ __forceinline__ int lds_byte(int r, int c) { const int st = (r >> 4) * 2 + (c >> 5), rr = r & 15, cc = c & 31, ob = rr * 64 + cc * 2; return st * 1024 + (ob ^ (((ob >> 9) & 1) << 5)); }
__host__ __device__ __forceinline__ void stage_rc(int b, int& R, int& C) { const int st = b / 1024, sb = b % 1024, swz = sb ^ (((sb >> 9) & 1) << 5); R = (st >> 1) * 16 + swz / 64; C = (st & 1) * 32 + (swz % 64) / 2; }
__host__ __device__ __forceinline__ int perm32(int rho) { const int n = rho >> 4, i = rho & 15; return 8 * (i >> 2) + 4 * n + (i & 3); }

struct Unit { int pm, pn, pb; };
struct Gemm { const bf16_t* A; const bf16_t* Bt; int M, N, K; };

struct StaticOrder {
    int nM, nN, nwg, G, c;
    __host__ __device__ void init(int M, int N, int G_, int c_) { nM = M / BM; nN = N / BM; nwg = nM * nN; G = G_; c = c_; }
    __host__ __device__ bool next(int i, Unit& u) const {
        const long L = (long)i * G + c; if (L >= nwg) return false;
        int wgid = (int)L; { const int q = nwg / NXCD, r = nwg % NXCD, xcd = wgid % NXCD, off = wgid / NXCD; wgid = (xcd < r ? xcd * (q + 1) : r * (q + 1) + (xcd - r) * q) + off; }
        const int nig = WGM * nN, gid = wgid / nig, fm = gid * WGM, gsz = (nM - fm) < WGM ? (nM - fm) : WGM;
        u.pm = fm + ((wgid % nig) % gsz); u.pn = (wgid % nig) / gsz; u.pb = u.pn; return true;
    }
    __device__ __forceinline__ void a_ready(const Unit&) const {}
    __device__ __forceinline__ void done(const Unit&) const {}
};

__device__ __forceinline__ unsigned cvt_pk_bf16(float lo, float hi) { unsigned r; asm volatile("v_cvt_pk_bf16_f32 %0, %1, %2" : "=v"(r) : "v"(lo), "v"(hi)); return r; }
typedef float f32x2 __attribute__((ext_vector_type(2)));
template <class Epi, class Sched, bool ALIGN_EPI = false, bool SP2 = false>
__device__ __forceinline__ void gemm_phase(PG8_LAS unsigned char* lds, const Gemm g, const Sched& S, const Epi& E) {
    const int tid = otid(), wid = __builtin_amdgcn_readfirstlane(tid >> 6), lane = tid & 63, wr = wid >> 2, wc = wid & 3, fr = lane & 15, fq = lane >> 4;
    const int K = g.K, nt = K / BK;
    unsigned voffA[2], voffB[2];
#pragma unroll
    for (int i = 0; i < 2; ++i) { int R, C; stage_rc(tid * 16 + i * 8192, R, C); const int Rb = Epi::PERM ? ((R & ~31) + perm32(R & 31)) : R;
        voffA[i] = (unsigned)(R * K + C) * 2u; voffB[i] = (unsigned)(Rb * K + C) * 2u; }
    const size_t kstep = (size_t)(BK * 2);
    const size_t hstep = (size_t)HALF * K * 2;
    const size_t tstep = 2 * hstep;
    const unsigned ldsw = (unsigned)wid * 1024u;
    const int aoff = lds_byte(wr * 64 + fr, fq * 8), boff = lds_byte(wc * 32 + fr, fq * 8);
#define PG8_SA(b, h) (((b) * 2 + (h)) * HTB)
#define PG8_SB(b, h) ((4 + (b) * 2 + (h)) * HTB)
#define PG8_STAGE(bufoff, gbase, voff) do { _Pragma("unroll") for (int _i = 0; _i < 2; ++_i) \
        __builtin_amdgcn_global_load_lds((const unsigned*)((const char*)(gbase) + (voff)[_i]), (PG8_LAS unsigned*)(lds + (bufoff) + ldsw + _i * 8192), 16, 0, 0); } while (0)
#define PG8_LDA(dst, b, h) do { _Pragma("unroll") for (int m = 0; m < 4; ++m) _Pragma("unroll") for (int k = 0; k < 2; ++k) dst[m][k] = *(const PG8_LAS bf16x8*)(lds + PG8_SA(b, h) + aoff + m * 2048 + k * 1024); } while (0)
#define PG8_LDB(dst, b, h) do { _Pragma("unroll") for (int n = 0; n < 2; ++n) _Pragma("unroll") for (int k = 0; k < 2; ++k) dst[n][k] = *(const PG8_LAS bf16x8*)(lds + PG8_SB(b, h) + boff + n * 2048 + k * 1024); } while (0)
#define PG8_MMA(ai, bj, At, Bt) do { __builtin_amdgcn_s_setprio(1); _Pragma("unroll") for (int m = 0; m < 4; ++m) _Pragma("unroll") for (int n = 0; n < 2; ++n) _Pragma("unroll") for (int k = 0; k < 2; ++k) \
        acc[ai][bj][m][n] = __builtin_amdgcn_mfma_f32_16x16x32_bf16(Bt[n][k], At[m][k], acc[ai][bj][m][n], 0, 0, 0); __builtin_amdgcn_s_setprio(0); } while (0)
#define PG8_WAIT_V(n) asm volatile("s_waitcnt vmcnt(" #n ")" ::: "memory")
#define PG8_WAIT_L(n) asm volatile("s_waitcnt lgkmcnt(" #n ")" ::: "memory")
#define PG8_BAR __builtin_amdgcn_s_barrier()
#define PG8_SCHED __builtin_amdgcn_sched_barrier(0)
    Unit cur, nxt; int ui = 0;
    if (!S.next(0, cur)) return;
    f32x4 acc[2][2][4][2];
#pragma unroll
    for (int a = 0; a < 2; ++a)
#pragma unroll
        for (int b = 0; b < 2; ++b)
#pragma unroll
            for (int m = 0; m < 4; ++m)
#pragma unroll
                for (int n = 0; n < 2; ++n) acc[a][b][m][n] = (f32x4){0.f, 0.f, 0.f, 0.f};
    bf16x8 At[4][2], B0[2][2], B1[2][2];
    const char* cA = (const char*)g.A + (size_t)cur.pm * tstep; const char* cB = (const char*)g.Bt + (size_t)cur.pb * tstep;
    S.a_ready(cur);
    if constexpr (SP2) {
        PG8_STAGE(PG8_SB(0, 0), cB, voffB); PG8_STAGE(PG8_SB(0, 1), cB + hstep, voffB); PG8_STAGE(PG8_SA(0, 0), cA, voffA); PG8_STAGE(PG8_SA(0, 1), cA + hstep, voffA);
        if (wr == 1) PG8_BAR;
        PG8_WAIT_V(2); PG8_BAR;
        PG8_STAGE(PG8_SB(1, 0), cB + kstep, voffB); PG8_STAGE(PG8_SA(1, 0), cA + kstep, voffA); PG8_STAGE(PG8_SB(1, 1), cB + hstep + kstep, voffB);
        PG8_WAIT_V(6); PG8_BAR;
    } else {
        PG8_STAGE(PG8_SB(0, 0), cB, voffB); PG8_STAGE(PG8_SA(0, 0), cA, voffA); PG8_STAGE(PG8_SB(0, 1), cB + hstep, voffB); PG8_STAGE(PG8_SA(0, 1), cA + hstep, voffA);
        if (wr == 1) PG8_BAR;
        PG8_WAIT_V(4); PG8_BAR;
        PG8_STAGE(PG8_SB(1, 0), cB + kstep, voffB); PG8_STAGE(PG8_SA(1, 0), cA + kstep, voffA); PG8_STAGE(PG8_SB(1, 1), cB + hstep + kstep, voffB);
        PG8_WAIT_V(6); PG8_BAR;
    }
    for (;;) {
        const bool has_next = S.next(ui + 1, nxt);
        const char* nA = has_next ? (const char*)g.A + (size_t)nxt.pm * tstep : cA; const char* nB = has_next ? (const char*)g.Bt + (size_t)nxt.pb * tstep : cB;
        for (int t = 0; t < nt; t += 2) {
            const bool last = (t == nt - 2);
            const char* a1 = cA + (size_t)(t + 1) * kstep;
            const char* a2 = last ? nA : cA + (size_t)(t + 2) * kstep; const char* b2 = last ? nB : cB + (size_t)(t + 2) * kstep;
            const char* a3 = a2 + kstep; const char* b3 = b2 + kstep;
            if (last && has_next) S.a_ready(nxt);
            if constexpr (SP2) {
            PG8_LDB(B0, 0, 0); PG8_LDB(B1, 0, 1); PG8_SCHED; PG8_LDA(At, 0, 0); PG8_STAGE(PG8_SA(1, 1), a1 + hstep, voffA);
            PG8_WAIT_V(8); PG8_WAIT_L(0); PG8_BAR; PG8_MMA(0, 0, At, B0); PG8_MMA(0, 1, At, B1); PG8_BAR; PG8_SCHED;
            PG8_LDA(At, 0, 1); PG8_STAGE(PG8_SB(0, 0), b2, voffB); PG8_STAGE(PG8_SB(0, 1), b2 + hstep, voffB); PG8_STAGE(PG8_SA(0, 0), a2, voffA);
            PG8_WAIT_V(8); PG8_WAIT_L(0); PG8_BAR; PG8_MMA(1, 0, At, B0); PG8_MMA(1, 1, At, B1); PG8_BAR; PG8_SCHED;
            PG8_LDB(B0, 1, 0); PG8_LDB(B1, 1, 1); PG8_SCHED; PG8_LDA(At, 1, 0); PG8_STAGE(PG8_SA(0, 1), a2 + hstep, voffA);
            PG8_WAIT_V(8); PG8_WAIT_L(0); PG8_BAR; PG8_MMA(0, 0, At, B0); PG8_MMA(0, 1, At, B1); PG8_BAR; PG8_SCHED;
            PG8_LDA(At, 1, 1); PG8_STAGE(PG8_SB(1, 0), b3, voffB); PG8_STAGE(PG8_SB(1, 1), b3 + hstep, voffB); PG8_STAGE(PG8_SA(1, 0), a3, voffA);
            PG8_WAIT_V(8); PG8_WAIT_L(0); PG8_BAR; PG8_MMA(1, 0, At, B0); PG8_MMA(1, 1, At, B1); PG8_BAR; PG8_SCHED;
            } else {
            PG8_LDB(B0, 0, 0); PG8_SCHED; PG8_LDA(At, 0, 0); PG8_STAGE(PG8_SA(1, 1), a1 + hstep, voffA);
            PG8_WAIT_L(8); PG8_BAR; PG8_WAIT_L(0); PG8_MMA(0, 0, At, B0); PG8_BAR; PG8_SCHED;
            PG8_LDB(B1, 0, 1); PG8_STAGE(PG8_SB(0, 0), b2, voffB);
            PG8_BAR; PG8_WAIT_L(0); PG8_MMA(0, 1, At, B1); PG8_BAR;
            PG8_LDA(At, 0, 1); PG8_STAGE(PG8_SA(0, 0), a2, voffA);
            PG8_BAR; PG8_WAIT_L(0); PG8_MMA(1, 0, At, B0); PG8_BAR; PG8_SCHED;
            PG8_STAGE(PG8_SB(0, 1), b2 + hstep, voffB);
            PG8_WAIT_V(6); PG8_BAR; PG8_MMA(1, 1, At, B1); PG8_BAR;
            PG8_LDB(B0, 1, 0); PG8_SCHED; PG8_LDA(At, 1, 0); PG8_STAGE(PG8_SA(0, 1), a2 + hstep, voffA);
            PG8_WAIT_L(8); PG8_BAR; PG8_WAIT_L(0); PG8_MMA(0, 0, At, B0); PG8_BAR; PG8_SCHED;
            PG8_LDB(B1, 1, 1); PG8_STAGE(PG8_SB(1, 0), b3, voffB);
            PG8_BAR; PG8_WAIT_L(0); PG8_MMA(0, 1, At, B1); PG8_BAR;
            PG8_LDA(At, 1, 1); PG8_STAGE(PG8_SA(1, 0), a3, voffA);
            PG8_BAR; PG8_WAIT_L(0); PG8_MMA(1, 0, At, B0); PG8_BAR; PG8_SCHED;
            PG8_STAGE(PG8_SB(1, 1), b3 + hstep, voffB);
            PG8_WAIT_V(6); PG8_BAR; PG8_MMA(1, 1, At, B1); PG8_BAR;
            }
        }
        if constexpr (ALIGN_EPI) { if (wr == 0) PG8_BAR; }
        if constexpr (!Epi::AFTER_DRAIN) { E(acc, cur, wr, wc, fr, fq); S.done(cur); }
        if (!has_next) break;
#pragma unroll
        for (int a = 0; a < 2; ++a)
#pragma unroll
            for (int b = 0; b < 2; ++b)
#pragma unroll
                for (int m = 0; m < 4; ++m)
#pragma unroll
                    for (int n = 0; n < 2; ++n) acc[a][b][m][n] = (f32x4){0.f, 0.f, 0.f, 0.f};
        cur = nxt; cA = nA; cB = nB; ++ui;
        if constexpr (ALIGN_EPI) { if (wr == 1) PG8_BAR; }
    }
    PG8_WAIT_V(0);
    if constexpr (!ALIGN_EPI) { if (wr == 0) PG8_BAR; }
    PG8_BAR;
    if constexpr (Epi::AFTER_DRAIN) { E.fused(acc, cur, wr, wc, fr, fq, lds, wid, lane); S.done(cur); }
#undef PG8_SA
#undef PG8_SB
#undef PG8_STAGE
#undef PG8_LDA
#undef PG8_LDB
#undef PG8_MMA
#undef PG8_WAIT_V
#undef PG8_WAIT_L
#undef PG8_BAR
#undef PG8_SCHED
}
}
constexpr int D = 1024, BATCH = 8, SEQ = 4096, NTOK = BATCH * SEQ;
constexpr int GW = 512, RW = 512, HD = 64, CHUNK = 128;
constexpr int RPROJ = 1696, INW = 2720, ZLD = 2816;
constexpr int NG = 4, EPG = 8, NE = 32, EH = 512;
constexpr int NTHR = 512;
constexpr int LDS_BYTES = 147456;

typedef float f32x16 __attribute__((ext_vector_type(16)));
typedef float f32x4 __attribute__((ext_vector_type(4)));
typedef unsigned u32x4 __attribute__((ext_vector_type(4)));
typedef unsigned u32x2 __attribute__((ext_vector_type(2)));
typedef unsigned short bf16;
#define LAS __attribute__((address_space(3)))

constexpr size_t MiB = 1u << 20;
constexpr size_t W_WINT = 0;
constexpr size_t W_WOUTT = 6 * MiB;
constexpr size_t W_LORAT = 8 * MiB;
constexpr size_t W_WC = 9 * MiB;
constexpr size_t W_MOD = 10 * MiB;
constexpr size_t W_TAB = 11 * MiB;
constexpr size_t W_WGUT = 16 * MiB;
constexpr size_t W_WDT = 80 * MiB;
constexpr size_t W_H1 = 112 * MiB;
constexpr size_t W_Z = 176 * MiB;
constexpr size_t W_YCAT = 352 * MiB;
constexpr size_t W_LO = 416 * MiB;
constexpr size_t WS_NEED = 512 * MiB;
constexpr size_t T_TOKE = W_TAB;
constexpr size_t T_TOKW = W_TAB + 512 * 1024;
constexpr size_t T_ROWTOK = W_TAB + 1024 * 1024;
constexpr size_t T_ROWAID = W_TAB + 1536 * 1024;
constexpr size_t T_ROWW = W_TAB + 2048 * 1024;
constexpr size_t T_TILEE = W_TAB + 2560 * 1024;
constexpr size_t T_CTL = W_TAB + 3072 * 1024;

struct Params {
    const float* in[31];
    float* out;
    unsigned char* ws;
};
typedef const __attribute__((address_space(4))) Params& PRef;
typedef const __attribute__((address_space(4))) Params* PPtr;
__device__ __forceinline__ PPtr opq(PPtr k) { asm volatile("" : "+s"(k)); return k; }
enum { I_X = 0, I_C, I_ADAW, I_ADAB, I_N1G, I_WIN, I_GLNW, I_GLNB, I_GWS, I_GBS, I_MU, I_W0, I_W2, I_A0, I_A2, I_G2, I_KK, I_KA, I_RK, I_GNW, I_GNB, I_WOUT, I_N2G, I_RGW, I_RGB, I_REW, I_REB, I_WG, I_WU, I_WD, I_FNG };

__device__ __forceinline__ float wave_sum(float v) {
#pragma unroll
    for (int o = 1; o < 64; o <<= 1) v += __shfl_xor(v, o);
    return v;
}
#define DPP_ADD(v, ctrl) v += __builtin_bit_cast(float, __builtin_amdgcn_update_dpp(0, __builtin_bit_cast(int, v), ctrl, 0xf, 0xf, false))
__device__ __forceinline__ float wave_sum_dpp(float v) {
    DPP_ADD(v, 0xB1); DPP_ADD(v, 0x4E); DPP_ADD(v, 0x141); DPP_ADD(v, 0x140);
    const int iv = __builtin_bit_cast(int, v);
    const float a = __builtin_bit_cast(float, __builtin_amdgcn_readlane(iv, 0)), b = __builtin_bit_cast(float, __builtin_amdgcn_readlane(iv, 16));
    const float c = __builtin_bit_cast(float, __builtin_amdgcn_readlane(iv, 32)), d = __builtin_bit_cast(float, __builtin_amdgcn_readlane(iv, 48));
    return (a + b) + (c + d);
}
__device__ __forceinline__ float xsum4(float s) {
    s += __builtin_bit_cast(float, __builtin_amdgcn_ds_swizzle(__builtin_bit_cast(int, s), 0x401F));
    float a = s, b = s;
    asm volatile("s_nop 1\n\tv_permlane32_swap_b32 %0, %1\n\ts_nop 1" : "+v"(a), "+v"(b));
    return a + b;
}
__device__ __forceinline__ float gelu_tanh(float x) {
    const float u = 0.7978845608028654f * (x + 0.044715f * x * x * x);
    return 0.5f * x * (1.0f + tanhf(u));
}
__device__ __forceinline__ float gelu_fast(float x) {
    const float u2 = -2.302208198f * (x + 0.044715f * x * x * x);
    return x * __builtin_amdgcn_rcpf(1.0f + __builtin_amdgcn_exp2f(u2));
}
__device__ __forceinline__ float sigmoidf_(float x) { return 1.0f / (1.0f + expf(-x)); }
__device__ __forceinline__ float softplusf_(float x) { return fmaxf(x, 0.f) + log1pf(expf(-fabsf(x))); }
__device__ __forceinline__ float bf2f(unsigned short b) { return __uint_as_float(((unsigned)b) << 16); }
__device__ __forceinline__ float bflo(unsigned w) { return __uint_as_float(w << 16); }
__device__ __forceinline__ float bfhi(unsigned w) { return __uint_as_float(w & 0xffff0000u); }
__device__ __forceinline__ unsigned f2bf(float f) { unsigned u = __float_as_uint(f); return (u + 0x7fffu + ((u >> 16) & 1u)) >> 16; }
__device__ __forceinline__ unsigned pk2(float lo, float hi) { return f2bf(lo) | (f2bf(hi) << 16); }
constexpr int GT = 128;
constexpr int PROWS_G = NTOK * 2 + NE * GT;
constexpr int PTILES_G = PROWS_G / GT;
template <class Epi>
__device__ __forceinline__ void gg_gemm(float* lds, const float* __restrict__ A, int lda, const int* rowidx, const float* __restrict__ B, int ldb, size_t bstride,
                        const int* tile_expert, int M, int N, int K, const Epi& epi, int bid, int nb) {
    float* As = lds;
    float* Bs = lds + 16 * 132;
    const int tid = otid(), lane = tid & 63, wid = tid >> 6, wm = wid >> 1, wn = wid & 1;
    const int tilesN = (N + 127) / 128, tilesM = M / 128;
    for (int tile = bid; tile < tilesM * tilesN; tile += nb) {
        const int tm = tile / tilesN, tn = tile % tilesN;
        const float* Bp = B;
        if (tile_expert) { const int e = tile_expert[tm]; if (e < 0) continue; Bp = B + (size_t)e * bstride; }
        f32x16 acc0, acc1;
#pragma unroll
        for (int i = 0; i < 16; ++i) { acc0[i] = 0.f; acc1[i] = 0.f; }
        const int arow = tid >> 2, akq = (tid & 3) * 4;
        int asrc = tm * 128 + arow;
        if (rowidx) asrc = rowidx[asrc];
        const int bk = tid >> 5, bn4 = (tid & 31) * 4, bcol = tn * 128 + bn4;
        for (int k0 = 0; k0 < K; k0 += 16) {
            f32x4 av = {0.f, 0.f, 0.f, 0.f};
            if (asrc >= 0) av = *(const f32x4*)(A + (size_t)asrc * lda + k0 + akq);
            f32x4 bv = {0.f, 0.f, 0.f, 0.f};
            if (bcol < N) bv = *(const f32x4*)(Bp + (size_t)(k0 + bk) * ldb + bcol);
            __syncthreads();
            As[(akq + 0) * 132 + arow] = av[0]; As[(akq + 1) * 132 + arow] = av[1]; As[(akq + 2) * 132 + arow] = av[2]; As[(akq + 3) * 132 + arow] = av[3];
            *(f32x4*)(Bs + bk * 128 + bn4) = bv;
            __syncthreads();
#pragma unroll
            for (int kk = 0; kk < 16; kk += 2) {
                const int kr = kk + (lane >> 5);
                const float a = As[kr * 132 + wm * 32 + (lane & 31)];
                const float b0 = Bs[kr * 128 + wn * 64 + (lane & 31)];
                const float b1 = Bs[kr * 128 + wn * 64 + 32 + (lane & 31)];
                acc0 = __builtin_amdgcn_mfma_f32_32x32x2f32(a, b0, acc0, 0, 0, 0);
                acc1 = __builtin_amdgcn_mfma_f32_32x32x2f32(a, b1, acc1, 0, 0, 0);
            }
        }
#pragma unroll
        for (int r = 0; r < 16; ++r) {
            const int row = tm * 128 + wm * 32 + (r & 3) + 8 * (r >> 2) + 4 * (lane >> 5);
            const int c0 = tn * 128 + wn * 64 + (lane & 31);
            if (c0 < N) epi(row, c0, acc0[r]);
            if (c0 + 32 < N) epi(row, c0 + 32, acc1[r]);
        }
        __syncthreads();
    }
}
__device__ __forceinline__ void gold_normmod(const float* __restrict__ x, const float* __restrict__ g, const float* mod, int shift_idx, int scale_idx, float* __restrict__ out, int bid, int nb) {
    const int tid_ = otid(), lane = tid_ & 63, wv = tid_ >> 6;
    for (int row = bid * 8 + wv; row < NTOK; row += nb * 8) {
        const int b = row / SEQ;
        const f32x4* xr = (const f32x4*)(x + (size_t)row * D) + lane;
        f32x4 v[4]; float s = 0.f;
#pragma unroll
        for (int j = 0; j < 4; ++j) { v[j] = xr[64 * j]; s += v[j][0] * v[j][0] + v[j][1] * v[j][1] + v[j][2] * v[j][2] + v[j][3] * v[j][3]; }
        const float r = rsqrtf(wave_sum(s) * (1.0f / D) + 1e-6f);
        const float* sh = mod + b * 6 * D + shift_idx * D; const float* sc = mod + b * 6 * D + scale_idx * D;
        f32x4* o = (f32x4*)(out + (size_t)row * D) + lane;
#pragma unroll
        for (int j = 0; j < 4; ++j) {
            const int c0 = (lane + 64 * j) * 4; f32x4 y;
#pragma unroll
            for (int q = 0; q < 4; ++q) y[q] = v[j][q] * r * g[c0 + q] * (1.0f + sc[c0 + q]) + sh[c0 + q];
            o[64 * j] = y;
        }
    }
}
__device__ __forceinline__ void gold_gmlp_ln(PRef p, const bf16* Z, float* vln, int bid, int nb) {
    const float* lw = p.in[I_GLNW]; const float* lb = p.in[I_GLNB];
    const int tid_ = otid(), lane = tid_ & 63, wv = tid_ >> 6;
    for (int row = bid * 8 + wv; row < NTOK; row += nb * 8) {
        const bf16* vr = Z + (size_t)row * ZLD + 512;
        float v[8]; float s = 0.f;
#pragma unroll
        for (int j = 0; j < 8; ++j) { v[j] = bf2f(vr[lane + 64 * j]); s += v[j]; }
        const float m = wave_sum(s) * (1.0f / 512.f); float q = 0.f;
#pragma unroll
        for (int j = 0; j < 8; ++j) { const float d = v[j] - m; q += d * d; }
        const float rs = rsqrtf(wave_sum(q) * (1.0f / 512.f) + 1e-5f);
#pragma unroll
        for (int j = 0; j < 8; ++j) { const int c = lane + 64 * j; vln[(size_t)row * 512 + c] = (v[j] - m) * rs * lw[c] + lb[c]; }
    }
}
__device__ __forceinline__ void gold_gmlp_mix(PRef p, const bf16* Z, const float* vln, float* ycat, int bid, int nb) {
    const float* wsp = p.in[I_GWS]; const float* bsp = p.in[I_GBS];
    for (int t = bid; t < NTOK; t += nb) {
        const int c = otid(), h = c >> 6, tl = t & 127, t0 = t - tl;
        const float* wrow = wsp + ((size_t)h * CHUNK + tl) * CHUNK;
        float s = 0.f;
        for (int ss = 0; ss <= tl; ++ss) s = fmaf(wrow[ss], vln[(size_t)(t0 + ss) * 512 + c], s);
        s += bsp[h * CHUNK + tl];
        ycat[(size_t)t * 1024 + c] = bf2f(Z[(size_t)t * ZLD + c]) * s;
    }
}
constexpr int NPT = 8192;
__device__ __forceinline__ void gold_rwkv_prep(PRef p, float* lds, const bf16* Z, float* SC, float* RKo, int part, int bid, int nb) {
    constexpr size_t AS = (size_t)NPT * 512;
    float *Ro = SC, *Wo = SC + AS, *Ko = SC + 2 * AS, *Vo = SC + 3 * AS, *Ao = SC + 4 * AS, *Bo = SC + 5 * AS, *Go = SC + 6 * AS;
    const float* mu = p.in[I_MU];
    float* zs = lds;
    const int c = otid(), lane = c & 63, h = c >> 6;
    for (int tl = bid; tl < NPT; tl += nb) {
        const int t = part * NPT + tl;
        __syncthreads();
        for (int j = c; j < RPROJ; j += NTHR) {
            const float cur = bf2f(Z[(size_t)t * ZLD + 1024 + j]);
            const float prev = (t % SEQ == 0) ? 0.f : bf2f(Z[(size_t)(t - 1) * ZLD + 1024 + j]);
            float z = cur + (prev - cur) * mu[j];
            if (j >= 1536 && j < 1568) z = tanhf(z);
            if (j >= 1600) z = sigmoidf_(z);
            zs[j] = z;
        }
        __syncthreads();
        const float r = zs[c], k = zs[512 + c], v = zs[1024 + c];
        float dw = 0.f, da = 0.f, g = 0.f;
#pragma unroll 4
        for (int j = 0; j < 32; ++j) dw = fmaf(zs[1536 + j], p.in[I_W2][j * 512 + c], dw);
#pragma unroll 4
        for (int j = 0; j < 32; ++j) da = fmaf(zs[1568 + j], p.in[I_A2][j * 512 + c], da);
#pragma unroll 4
        for (int j = 0; j < 96; ++j) g = fmaf(zs[1600 + j], p.in[I_G2][j * 512 + c], g);
        const float wlog = -softplusf_(-(p.in[I_W0][c] + dw)) - 0.5f;
        const float decay = expf(-expf(wlog));
        const float asig = sigmoidf_(p.in[I_A0][c] + da);
        const float kkv = k * p.in[I_KK][c];
        const float nrm = sqrtf(wave_sum(kkv * kkv));
        const float kk = kkv / fmaxf(nrm, 1e-12f);
        const float k2 = k * (1.0f + (asig - 1.0f) * p.in[I_KA][c]);
        const float rk = wave_sum(r * k2 * p.in[I_RK][c]);
        const size_t o = (size_t)tl * 512 + c;
        Ro[o] = r; Wo[o] = decay; Ko[o] = k2; Vo[o] = v; Ao[o] = -kk; Bo[o] = kk * asig; Go[o] = g;
        if (lane == 0) RKo[tl * 8 + h] = rk;
    }
}
__device__ __forceinline__ void gold_rwkv_prep_lo(PRef p, float* lds, const bf16* Z, const bf16* LO, float* SC, float* RKo, int part, int bid, int nb) {
    constexpr size_t AS = (size_t)NPT * 512;
    float *Ro = SC, *Wo = SC + AS, *Ko = SC + 2 * AS, *Vo = SC + 3 * AS, *Ao = SC + 4 * AS, *Bo = SC + 5 * AS, *Go = SC + 6 * AS;
    const float* mu = p.in[I_MU];
    const int c = otid(), lane = c & 63, h = c >> 6;
    for (int tl = bid; tl < NPT; tl += nb) {
        const int t = part * NPT + tl;
        float z3[3];
#pragma unroll
        for (int q = 0; q < 3; ++q) { const int j = q * 512 + c;
            const float cur = bf2f(Z[(size_t)t * ZLD + 1024 + j]);
            const float prev = (t % SEQ == 0) ? 0.f : bf2f(Z[(size_t)(t - 1) * ZLD + 1024 + j]);
            z3[q] = cur + (prev - cur) * mu[j]; }
        const float r = z3[0], k = z3[1], v = z3[2];
        const float decay = expf(bf2f(LO[(size_t)t * 1536 + c]));
        const float asig = bf2f(LO[(size_t)t * 1536 + 512 + c]);
        const float g = bf2f(LO[(size_t)t * 1536 + 1024 + c]);
        const float kkv = k * p.in[I_KK][c];
        const float nrm = sqrtf(wave_sum(kkv * kkv));
        const float kk = kkv / fmaxf(nrm, 1e-12f);
        const float k2 = k * (1.0f + (asig - 1.0f) * p.in[I_KA][c]);
        const float rk = wave_sum(r * k2 * p.in[I_RK][c]);
        const size_t o = (size_t)tl * 512 + c;
        Ro[o] = r; Wo[o] = decay; Ko[o] = k2; Vo[o] = v; Ao[o] = -kk; Bo[o] = kk * asig; Go[o] = g;
        if (lane == 0) RKo[tl * 8 + h] = rk;
    }
}
template <class YT>
__device__ __forceinline__ void gold_rwkv_scan(PRef p, float* lds, const float* SC, const float* RKi, YT* ycat, int part, int bid, int nb) {
    constexpr size_t AS = (size_t)NPT * 512;
    const float *Ri = SC, *Wi = SC + AS, *Ki = SC + 2 * AS, *Vi = SC + 3 * AS, *Ai = SC + 4 * AS, *Bi = SC + 5 * AS, *Gi = SC + 6 * AS;
    constexpr int TS = 16;
    float* vec = lds;
    float* vb = lds + 5 * TS * 64;
    float* yb = vb + TS * 64;
    const int tid = otid(), lane = tid & 63, wv = tid >> 6;
    for (int item = bid; item < (NPT / SEQ) * 8; item += nb) {
        const int bl = item >> 3, h = item & 7;
        float S[64];
#pragma unroll
        for (int k = 0; k < 64; ++k) S[k] = 0.f;
        for (int c0 = 0; c0 < SEQ; c0 += TS) {
            __syncthreads();
            for (int i = tid; i < 6 * TS * 64; i += NTHR) {
                const int arr = i / (TS * 64), rem = i % (TS * 64), s = rem >> 6, d = rem & 63;
                const size_t src = ((size_t)(bl * SEQ + c0 + s)) * 512 + h * 64 + d;
                const float* ap = arr == 0 ? Ri : arr == 1 ? Wi : arr == 2 ? Ki : arr == 3 ? Ai : arr == 4 ? Bi : Vi;
                const float val = ap[src];
                if (arr < 5) vec[(arr * TS + s) * 64 + d] = val; else vb[s * 64 + d] = val;
            }
            __syncthreads();
            if (wv == 0) {
                for (int s = 0; s < TS; ++s) {
                    const float* rr = vec + (0 * TS + s) * 64; const float* ww = vec + (1 * TS + s) * 64; const float* kk = vec + (2 * TS + s) * 64;
                    const float* aa = vec + (3 * TS + s) * 64; const float* bb = vec + (4 * TS + s) * 64;
                    const float vv = vb[s * 64 + lane];
                    float sa = 0.f;
#pragma unroll
                    for (int k = 0; k < 64; ++k) sa = fmaf(S[k], aa[k], sa);
                    float y = 0.f;
#pragma unroll
                    for (int k = 0; k < 64; ++k) { S[k] = fmaf(S[k], ww[k], fmaf(sa, bb[k], vv * kk[k])); y = fmaf(S[k], rr[k], y); }
                    yb[s * 64 + lane] = y;
                }
            }
            __syncthreads();
            for (int s = wv; s < TS; s += 8) {
                const int tl = bl * SEQ + c0 + s; const int t = part * NPT + tl; const int c = h * 64 + lane;
                const float y = yb[s * 64 + lane];
                const float m = wave_sum(y) * (1.0f / 64.f); const float dlt = y - m;
                const float var = wave_sum(dlt * dlt) * (1.0f / 64.f);
                float o = dlt * rsqrtf(var + 64e-5f) * p.in[I_GNW][c] + p.in[I_GNB][c];
                o += RKi[tl * 8 + h] * Vi[(size_t)tl * 512 + c];
                o *= Gi[(size_t)tl * 512 + c];
                if (sizeof(YT) == 2) ((bf16*)ycat)[(size_t)t * 1024 + 512 + c] = (bf16)f2bf(o); else ((float*)ycat)[(size_t)t * 1024 + 512 + c] = o;
            }
        }
    }
}
struct GEpiOutproj {
    const float* x; const float* mod; float* x1;
    __device__ __forceinline__ void operator()(int row, int col, float v) const {
        const int b = row / SEQ;
        x1[(size_t)row * D + col] = x[(size_t)row * D + col] + mod[b * 6 * D + 2 * D + col] * v;
    }
};
__device__ __forceinline__ void gold_norm2_route(PRef p, float* lds, const float* x1, float* h2, int bid, int nb) {
    const float* mod = (const float*)(p.ws + W_MOD);
    int* toke = (int*)(p.ws + T_TOKE); float* tokw = (float*)(p.ws + T_TOKW); int* cnt = (int*)(p.ws + T_CTL);
    const float* g = p.in[I_N2G]; const float* rgw = p.in[I_RGW]; const float* rew = p.in[I_REW];
    const int tid_ = otid(), lane = tid_ & 63, wv = tid_ >> 6;
    for (int row = bid * 8 + wv; row < NTOK; row += nb * 8) {
        const int b = row / SEQ;
        const float* xr = x1 + (size_t)row * D;
        float s = 0.f;
#pragma unroll 4
        for (int j = 0; j < 16; ++j) { const float xv = xr[lane + 64 * j]; s += xv * xv; }
        const float r = rsqrtf(wave_sum(s) * (1.0f / D) + 1e-6f);
        const float* sh = mod + b * 6 * D + 3 * D; const float* sc = mod + b * 6 * D + 4 * D;
        float lg[36];
#pragma unroll
        for (int j = 0; j < 36; ++j) lg[j] = 0.f;
#pragma unroll 1
        for (int j = 0; j < 16; ++j) {
            const int c = lane + 64 * j;
            const float hv = xr[c] * r * g[c] * (1.0f + sc[c]) + sh[c];
            h2[(size_t)row * D + c] = hv;
#pragma unroll
            for (int q = 0; q < 4; ++q) lg[q] = fmaf(hv, rgw[c * 4 + q], lg[q]);
#pragma unroll
            for (int q = 0; q < 32; ++q) lg[4 + q] = fmaf(hv, rew[c * 32 + q], lg[4 + q]);
        }
#pragma unroll
        for (int j = 0; j < 36; ++j) lg[j] = wave_sum(lg[j]);
        float* wl = lds + wv * 64;
        if (lane == 0) {
#pragma unroll
            for (int j = 0; j < 36; ++j) wl[j] = lg[j];
            float gm = -1e30f; int gi = 0;
            for (int q = 0; q < 4; ++q) { const float t = wl[q] + p.in[I_RGB][q]; if (t > gm) { gm = t; gi = q; } }
            float gs = 0.f; for (int q = 0; q < 4; ++q) gs += expf(wl[q] + p.in[I_RGB][q] - gm);
            const float gp = 1.0f / gs;
            float* el = wl + 40;
            for (int q = 0; q < 8; ++q) el[q] = wl[4 + gi * 8 + q] + p.in[I_REB][gi * 8 + q];
            int i0 = 0; for (int q = 1; q < 8; ++q) if (el[q] > el[i0]) i0 = q;
            int i1 = (i0 == 0) ? 1 : 0; for (int q = 0; q < 8; ++q) if (q != i0 && el[q] > el[i1]) i1 = q;
            const float em = el[i0];
            const float p0 = 1.0f, p1 = expf(el[i1] - em);
            const float w0 = gp * p0 / (p0 + p1), w1 = gp * p1 / (p0 + p1);
            const int e0 = gi * 8 + i0, e1 = gi * 8 + i1;
            toke[row * 2] = e0; toke[row * 2 + 1] = e1; tokw[row * 2] = w0; tokw[row * 2 + 1] = w1;
            atomicAdd(&cnt[e0], 1); atomicAdd(&cnt[e1], 1);
        }
    }
}
__device__ __forceinline__ void gold_moe_init(PRef p, int bid, int nb) {
    int* rowtok = (int*)(p.ws + T_ROWTOK); int* rowaid = (int*)(p.ws + T_ROWAID); float* roww = (float*)(p.ws + T_ROWW); int* tilee = (int*)(p.ws + T_TILEE);
    const int* cnt = (const int*)(p.ws + T_CTL);
    for (int i = bid * NTHR + otid(); i < PROWS_G; i += nb * NTHR) { rowtok[i] = -1; rowaid[i] = -1; roww[i] = 0.f; }
    if (bid == 0 && otid() == 0) {
        int t = 0;
        for (int e = 0; e < NE; ++e) { const int nt = (cnt[e] + GT - 1) / GT; for (int j = 0; j < nt; ++j) tilee[t++] = e; }
        for (; t < PTILES_G; ++t) tilee[t] = -1;
    }
}
__device__ __forceinline__ void gold_moe_place(PRef p, int bid, int nb) {
    int* rowtok = (int*)(p.ws + T_ROWTOK); int* rowaid = (int*)(p.ws + T_ROWAID); float* roww = (float*)(p.ws + T_ROWW);
    const int* cnt = (const int*)(p.ws + T_CTL); int* cursor = (int*)(p.ws + T_CTL + 128);
    const int* toke = (const int*)(p.ws + T_TOKE); const float* tokw = (const float*)(p.ws + T_TOKW);
    for (int a = bid * NTHR + otid(); a < NTOK * 2; a += nb * NTHR) {
        const int e = toke[a];
        int start = 0; for (int q = 0; q < e; ++q) start += (cnt[q] + GT - 1) / GT * GT;
        const int pos = start + atomicAdd(&cursor[e], 1);
        rowtok[pos] = a >> 1; rowaid[pos] = a; roww[pos] = tokw[a];
    }
}
struct GEpiGate { float* hb; __device__ __forceinline__ void operator()(int row, int col, float v) const { hb[(size_t)row * EH + col] = v; } };
struct GEpiUp { float* hb; __device__ __forceinline__ void operator()(int row, int col, float v) const { const float g = hb[(size_t)row * EH + col]; hb[(size_t)row * EH + col] = g / (1.0f + expf(-g)) * v; } };
struct GEpiDown {
    const int* rowaid; const float* roww; float* y0; float* y1;
    __device__ __forceinline__ void operator()(int row, int col, float v) const {
        const int a = rowaid[row]; if (a < 0) return;
        float* y = (a & 1) ? y1 : y0;
        y[(size_t)(a >> 1) * D + col] = roww[row] * v;
    }
};
__device__ __forceinline__ void gold_final(PRef p, const float* x1, const float* y0, const float* y1, int bid, int nb) {
    const float* mod = (const float*)(p.ws + W_MOD);
    float* out = p.out; const float* g = p.in[I_FNG];
    const int tid_ = otid(), lane = tid_ & 63, wv = tid_ >> 6;
    for (int row = bid * 8 + wv; row < NTOK; row += nb * 8) {
        const int b = row / SEQ; const float* gt = mod + b * 6 * D + 5 * D;
        float v[16]; float s = 0.f;
#pragma unroll
        for (int j = 0; j < 16; ++j) { const int c = lane + 64 * j; const size_t o = (size_t)row * D + c; v[j] = x1[o] + gt[c] * (y0[o] + y1[o]); s += v[j] * v[j]; }
        const float r = rsqrtf(wave_sum(s) * (1.0f / D) + 1e-6f);
#pragma unroll
        for (int j = 0; j < 16; ++j) { const int c = lane + 64 * j; out[(size_t)row * D + c] = v[j] * r * g[c]; }
    }
}
__device__ __forceinline__ void p0_transpose_item(const float* __restrict__ W, int K, int N, bf16* WT, long row_off, LAS float* scr, int item, int lane) {
    const int nblk = N / 32, kb = item / nblk, nb = item % nblk, k0 = 64 * kb, n0 = 32 * nb;
#pragma unroll 8
    for (int i = 0; i < 32; ++i) { const int kk = 2 * i + (lane >> 5); scr[kk * 33 + (lane & 31)] = W[(size_t)(k0 + kk) * N + n0 + (lane & 31)]; }
    asm volatile("s_waitcnt lgkmcnt(0)" ::: "memory");
    const int c = lane & 7;
#pragma unroll
    for (int j = 0; j < 4; ++j) { const int n = (lane >> 3) + 8 * j; const LAS float* s = scr + (8 * c) * 33 + n;
        u32x4 o; o.x = pk2(s[0 * 33], s[1 * 33]); o.y = pk2(s[2 * 33], s[3 * 33]); o.z = pk2(s[4 * 33], s[5 * 33]); o.w = pk2(s[6 * 33], s[7 * 33]);
        *(u32x4*)(WT + (size_t)(row_off + n0 + n) * K + k0 + 8 * c) = o; }
    asm volatile("s_waitcnt lgkmcnt(0)" ::: "memory");
}
__device__ __forceinline__ void p0_mod_item(PRef p, LAS float* red, int item) {
    const int tid = otid(), col = tid & 63, ks = __builtin_amdgcn_readfirstlane(tid >> 6), n = item * 64 + col;
    const float* __restrict__ c = p.in[I_C]; const float* __restrict__ w = p.in[I_ADAW];
    float acc[8];
#pragma unroll
    for (int b = 0; b < 8; ++b) acc[b] = 0.f;
#pragma unroll 4
    for (int k = ks * 128; k < ks * 128 + 128; ++k) {
        const float wv = w[(size_t)k * (6 * D) + n];
#pragma unroll
        for (int b = 0; b < 8; ++b) acc[b] = fmaf(c[b * D + k], wv, acc[b]);
    }
#pragma unroll
    for (int b = 0; b < 8; ++b) red[(ks * 8 + b) * 64 + col] = acc[b];
    __syncthreads();
    { const int b = tid >> 6; float s = 0.f;
#pragma unroll
      for (int q = 0; q < 8; ++q) s += red[(q * 8 + b) * 64 + col];
      ((float*)(p.ws + W_MOD))[b * 6 * D + n] = s + p.in[I_ADAB][n]; }
    __syncthreads();
}
template <bool WITH_MOE>
__device__ __forceinline__ void p0_prep(PRef p, LAS unsigned char* lds, int bid, int nb) {
    const int tid = otid(), lane = tid & 63, wave = __builtin_amdgcn_readfirstlane(tid >> 6);
    for (int it = bid; it < 96; it += nb) p0_mod_item(p, (LAS float*)lds, it);
    { bf16* lt = (bf16*)(p.ws + W_LORAT);
      for (int i = bid * NTHR + tid; i < 1536 * 256; i += nb * NTHR) { const int n = i >> 8, k = i & 255; float v = 0.f;
          if (n < 512) { if (k < 32) v = p.in[I_W2][k * 512 + n]; }
          else if (n < 1024) { if (k >= 32 && k < 64) v = p.in[I_A2][(k - 32) * 512 + (n - 512)]; }
          else { if (k >= 64 && k < 160) v = p.in[I_G2][(k - 64) * 512 + (n - 1024)]; }
          lt[i] = (bf16)f2bf(v); }
      bf16* wc = (bf16*)(p.ws + W_WC);
      for (int i = bid * NTHR + tid; i < 8 * 128 * 128; i += nb * NTHR) { const int s = i & 127, t = (i >> 7) & 127; wc[i] = (s <= t) ? (bf16)f2bf(p.in[I_GWS][i]) : (bf16)0; }
      bf16* wpad = (bf16*)(p.ws + W_WINT) + (size_t)INW * D;
      for (int i = bid * NTHR + tid; i < (ZLD - INW) * D; i += nb * NTHR) wpad[i] = 0; }
    LAS float* scr = (LAS float*)(lds + wave * 16384);
    const int gw = bid * 8 + wave, NGW = nb * 8;
    constexpr int I_IN = (D / 64) * (INW / 32), I_OUT = (D / 64) * (D / 32), I_GU = (D / 64) * (EH / 32), I_DN = (EH / 64) * (D / 32);
    constexpr int NIT = I_IN + I_OUT + (WITH_MOE ? NE * (2 * I_GU + I_DN) : 0);
    for (int it = gw; it < NIT; it += NGW) {
        int r = it;
        if (r < I_IN) { p0_transpose_item(p.in[I_WIN], D, INW, (bf16*)(p.ws + W_WINT), 0, scr, r, lane); continue; } r -= I_IN;
        if (r < I_OUT) { p0_transpose_item(p.in[I_WOUT], D, D, (bf16*)(p.ws + W_WOUTT), 0, scr, r, lane); continue; } r -= I_OUT;
        if (WITH_MOE) {
            const int e = r / (2 * I_GU + I_DN); r -= e * (2 * I_GU + I_DN);
            if (r < 2 * I_GU) {
                const int up = r >= I_GU; if (up) r -= I_GU;
                const int nbk = r % (EH / 32), hb = nbk * 32;
                const long row_off = (long)e * 1024 + (hb / 128) * 256 + up * 128 + (hb % 128) - hb;
                p0_transpose_item((up ? p.in[I_WU] : p.in[I_WG]) + (size_t)e * D * EH, D, EH, (bf16*)(p.ws + W_WGUT), row_off, scr, r, lane);
            } else { r -= 2 * I_GU;
                p0_transpose_item(p.in[I_WD] + (size_t)e * EH * D, EH, D, (bf16*)(p.ws + W_WDT), (long)e * 1024, scr, r, lane); }
        }
    }
}
__device__ __forceinline__ void p1_h1(PRef p, int bid, int nb) {
    const float* __restrict__ x = p.in[I_X]; const float* __restrict__ g = p.in[I_N1G]; const float* mod = (const float*)(p.ws + W_MOD);
    bf16* H1 = (bf16*)(p.ws + W_H1);
    const int tid_ = otid(), lane = tid_ & 63, wv = tid_ >> 6;
    for (int row = bid * 8 + wv; row < NTOK; row += nb * 8) {
        const int b = row / SEQ;
        const f32x4* xr = (const f32x4*)(x + (size_t)row * D) + lane;
        f32x4 v[4]; float s = 0.f;
#pragma unroll
        for (int j = 0; j < 4; ++j) { v[j] = xr[64 * j]; s += v[j][0] * v[j][0] + v[j][1] * v[j][1] + v[j][2] * v[j][2] + v[j][3] * v[j][3]; }
        const float r = rsqrtf(wave_sum(s) * (1.0f / D) + 1e-6f);
        const float* sh = mod + b * 6 * D; const float* sc = mod + b * 6 * D + D;
        u32x2* o = (u32x2*)(H1 + (size_t)row * D) + lane;
#pragma unroll
        for (int j = 0; j < 4; ++j) {
            const int c0 = (lane + 64 * j) * 4;
            const f32x4 gg = *(const f32x4*)(g + c0), ss = *(const f32x4*)(sc + c0), hh = *(const f32x4*)(sh + c0);
            f32x4 y;
#pragma unroll
            for (int q = 0; q < 4; ++q) y[q] = v[j][q] * r * gg[q] * (1.0f + ss[q]) + hh[q];
            u32x2 w; w.x = pk2(y[0], y[1]); w.y = pk2(y[2], y[3]);
            o[64 * j] = w;
        }
    }
}
struct EpiZ {
    static constexpr bool PERM = true, AFTER_DRAIN = false;
    bf16* Z;
    __device__ __forceinline__ void operator()(const f32x4 (&acc)[2][2][4][2], const pg8::Unit& u, int wr, int wc, int fr, int fq) const {
        const int row0 = u.pm * 256 + wr * 64 + fr, col0 = u.pn * 256 + wc * 32 + 8 * fq;
        const bool act = u.pn < 4;
#pragma unroll
        for (int ai = 0; ai < 2; ++ai)
#pragma unroll
            for (int m = 0; m < 4; ++m) { bf16* rowp = Z + (size_t)(row0 + ai * 128 + m * 16) * ZLD + col0;
#pragma unroll
                for (int bj = 0; bj < 2; ++bj) { f32x4 v0 = acc[ai][bj][m][0], v1 = acc[ai][bj][m][1];
                    if (act) {
#pragma unroll
                        for (int q = 0; q < 4; ++q) { v0[q] = gelu_fast(v0[q]); v1[q] = gelu_fast(v1[q]); } }
                    u32x4 w; w.x = pg8::cvt_pk_bf16(v0[0], v0[1]); w.y = pg8::cvt_pk_bf16(v0[2], v0[3]); w.z = pg8::cvt_pk_bf16(v1[0], v1[1]); w.w = pg8::cvt_pk_bf16(v1[2], v1[3]);
                    *(u32x4*)(rowp + bj * 128) = w; } }
    }
};
constexpr int VNT_PITCH = 272;
__device__ __forceinline__ void p3_gmlp_unit(PRef p, LAS unsigned char* lds, int chunk) {
    typedef short bf16x8 __attribute__((ext_vector_type(8)));
    const int tid = otid(), lane = tid & 63, wave = __builtin_amdgcn_readfirstlane(tid >> 6);
    const bf16* Z = (const bf16*)(p.ws + W_Z); bf16* ycat = (bf16*)(p.ws + W_YCAT);
    const int t0 = chunk * CHUNK;
    { float lw[8], lb[8];
#pragma unroll
      for (int j = 0; j < 8; ++j) { lw[j] = p.in[I_GLNW][lane + 64 * j]; lb[j] = p.in[I_GLNB][lane + 64 * j]; }
      for (int sp = 0; sp < 8; ++sp) {
          const int s = wave * 16 + sp * 2;
          const bf16* v0p = Z + (size_t)(t0 + s) * ZLD + 512 + lane; const bf16* v1p = v0p + ZLD;
          float a[8], b[8]; float sa = 0.f, sb = 0.f;
#pragma unroll
          for (int j = 0; j < 8; ++j) { a[j] = bf2f(v0p[64 * j]); b[j] = bf2f(v1p[64 * j]); sa += a[j]; sb += b[j]; }
          const float ma = wave_sum(sa) * (1.f / 512.f), mb = wave_sum(sb) * (1.f / 512.f); float qa = 0.f, qb = 0.f;
#pragma unroll
          for (int j = 0; j < 8; ++j) { a[j] -= ma; b[j] -= mb; qa += a[j] * a[j]; qb += b[j] * b[j]; }
          const float ra = rsqrtf(wave_sum(qa) * (1.f / 512.f) + 1e-5f), rb = rsqrtf(wave_sum(qb) * (1.f / 512.f) + 1e-5f);
#pragma unroll
          for (int j = 0; j < 8; ++j) { const unsigned w = pk2(a[j] * ra * lw[j] + lb[j], b[j] * rb * lw[j] + lb[j]);
              *(LAS unsigned*)(lds + (lane + 64 * j) * VNT_PITCH + s * 2) = w; }
      } }
    __syncthreads();
    const bf16* Wc = (const bf16*)(p.ws + W_WC) + (size_t)wave * CHUNK * CHUNK;
    const int fr = lane & 15, fq = lane >> 4;
    const LAS unsigned char* abase = lds + (wave * 64 + fr) * VNT_PITCH + fq * 16;
    for (int tt = 0; tt < 8; ++tt) {
        f32x4 acc[4];
#pragma unroll
        for (int dt = 0; dt < 4; ++dt) acc[dt] = (f32x4){0.f, 0.f, 0.f, 0.f};
        const int nks = ((tt * 16 + 15) >> 5) + 1;
        for (int ks = 0; ks < nks; ++ks) {
            const bf16x8 bfr = *(const bf16x8*)(Wc + (size_t)(tt * 16 + fr) * CHUNK + ks * 32 + fq * 8);
#pragma unroll
            for (int dt = 0; dt < 4; ++dt) {
                const bf16x8 afr = *(const LAS bf16x8*)(abase + dt * 16 * VNT_PITCH + ks * 64);
                acc[dt] = __builtin_amdgcn_mfma_f32_16x16x32_bf16(afr, bfr, acc[dt], 0, 0, 0);
            }
        }
        const int tl = tt * 16 + fr, t = t0 + tl;
        const float bsv = p.in[I_GBS][wave * CHUNK + tl];
#pragma unroll
        for (int dt = 0; dt < 4; ++dt) {
            const int c = wave * 64 + dt * 16 + fq * 4;
            const u32x2 uw = *(const u32x2*)(Z + (size_t)t * ZLD + c);
            u32x2 o; o.x = pk2(bflo(uw.x) * (acc[dt][0] + bsv), bfhi(uw.x) * (acc[dt][1] + bsv)); o.y = pk2(bflo(uw.y) * (acc[dt][2] + bsv), bfhi(uw.y) * (acc[dt][3] + bsv));
            *(u32x2*)(ycat + (size_t)t * 1024 + c) = o;
        }
    }
    __syncthreads();
}
struct EpiX1 {
    static constexpr bool PERM = false, AFTER_DRAIN = false;
    const float* x; const float* mod; float* x1;
    __device__ __forceinline__ void operator()(const f32x4 (&acc)[2][2][4][2], const pg8::Unit& u, int wr, int wc, int fr, int fq) const {
        const int row0 = u.pm * 256 + wr * 64 + fr, col0 = u.pn * 256 + wc * 32 + 4 * fq;
        const int b = (u.pm * 256) / SEQ;
        const float* gt = mod + b * 6 * D + 2 * D;
        f32x4 gv[2][2];
#pragma unroll
        for (int bj = 0; bj < 2; ++bj)
#pragma unroll
            for (int n = 0; n < 2; ++n) gv[bj][n] = *(const f32x4*)(gt + col0 + bj * 128 + n * 16);
#pragma unroll
        for (int ai = 0; ai < 2; ++ai)
#pragma unroll
            for (int m = 0; m < 4; ++m) { const size_t off = (size_t)(row0 + ai * 128 + m * 16) * D + col0;
#pragma unroll
                for (int bj = 0; bj < 2; ++bj)
#pragma unroll
                    for (int n = 0; n < 2; ++n) { const f32x4 xv = *(const f32x4*)(x + off + bj * 128 + n * 16);
                        *(f32x4*)(x1 + off + bj * 128 + n * 16) = xv + gv[bj][n] * acc[ai][bj][m][n]; } }
    }
};
constexpr size_t W_A2 = 112 * MiB;
constexpr size_t W_Q = 112 * MiB;
constexpr size_t W_Y2 = 144 * MiB;
constexpr size_t T_RK = W_TAB + 4 * MiB;
constexpr size_t O_M = 0, O_N = 32 * MiB, O_S = 64 * MiB, O_VL = 96 * MiB;
constexpr int SCL = 128, NCH = SEQ / SCL;

__device__ __forceinline__ float sigmoid_fast(float x) { return __builtin_amdgcn_rcpf(1.0f + __builtin_amdgcn_exp2f(-1.4426950409f * x)); }
__device__ __forceinline__ void p3_lorain(PRef p, int bid, int nb) {
    const bf16* Z = (const bf16*)(p.ws + W_Z); bf16* A2 = (bf16*)(p.ws + W_A2);
    const int tid = otid(), j = tid & 255, sub = tid >> 8;
    const float muj = (j < 160) ? p.in[I_MU][1536 + j] : 0.f;
    for (int t = bid * 2 + sub; t < NTOK; t += nb * 2) {
        float v = 0.f;
        if (j < 160) {
            const float cur = bf2f(Z[(size_t)t * ZLD + 2560 + j]);
            const float prev = (t % SEQ == 0) ? 0.f : bf2f(Z[(size_t)(t - 1) * ZLD + 2560 + j]);
            v = cur + (prev - cur) * muj;
            if (j < 32) v = tanhf(v); else if (j >= 64) v = sigmoidf_(v);
        }
        A2[(size_t)t * 256 + j] = (bf16)f2bf(v);
    }
}
struct EpiLO {
    static constexpr bool PERM = true, AFTER_DRAIN = false;
    bf16* LO; const float* w0; const float* a0;
    __device__ __forceinline__ void operator()(const f32x4 (&acc)[2][2][4][2], const pg8::Unit& u, int wr, int wc, int fr, int fq) const {
        const int row0 = u.pm * 256 + wr * 64 + fr, col0 = u.pn * 256 + wc * 32 + 8 * fq, kind = u.pn >> 1;
#pragma unroll
        for (int bj = 0; bj < 2; ++bj) {
            f32x4 bv[2];
#pragma unroll
            for (int n = 0; n < 2; ++n) { const int ch = col0 + bj * 128 + 4 * n - kind * 512;
                bv[n] = kind == 0 ? *(const f32x4*)(w0 + ch) : kind == 1 ? *(const f32x4*)(a0 + ch) : (f32x4){0.f, 0.f, 0.f, 0.f}; }
#pragma unroll
            for (int ai = 0; ai < 2; ++ai)
#pragma unroll
                for (int m = 0; m < 4; ++m) { bf16* rowp = LO + (size_t)(row0 + ai * 128 + m * 16) * 1536 + col0 + bj * 128;
                    f32x4 v0 = acc[ai][bj][m][0] + bv[0], v1 = acc[ai][bj][m][1] + bv[1];
                    if (kind < 2) { const float sc = kind == 0 ? -0.6065306597f : 1.0f;
#pragma unroll
                        for (int q = 0; q < 4; ++q) { v0[q] = sc * sigmoid_fast(v0[q]); v1[q] = sc * sigmoid_fast(v1[q]); } }
                    u32x4 w; w.x = pg8::cvt_pk_bf16(v0[0], v0[1]); w.y = pg8::cvt_pk_bf16(v0[2], v0[3]); w.z = pg8::cvt_pk_bf16(v1[0], v1[1]); w.w = pg8::cvt_pk_bf16(v1[2], v1[3]);
                    *(u32x4*)rowp = w;
                    asm volatile("" ::: "memory"); }
        }
    }
};
constexpr int SC_TS = 8;
__device__ __forceinline__ void p5a_chunk(PRef p, LAS unsigned char* lds, int q) {
    typedef float f32x2 __attribute__((ext_vector_type(2)));
    const int tid_ = otid(), lane = tid_ & 63, wave = __builtin_amdgcn_readfirstlane(tid_ >> 6);
    const int seq = q / NCH, c = q % NCH, b = seq >> 3, h = seq & 7;
    const int tb = b * SEQ + c * SCL, hc = h * 64 + lane;
    const bf16* Z = (const bf16*)(p.ws + W_Z); const bf16* LO = (const bf16*)(p.ws + W_LO);
    bf16* Qo = (bf16*)(p.ws + W_Q); bf16* Y2o = (bf16*)(p.ws + W_Y2); bf16* VLo = (bf16*)((unsigned char*)p.out + O_VL); float* RKo = (float*)(p.ws + T_RK);
    LAS float* vec = (LAS float*)(lds + wave * (SC_TS * 6 * 256));
    const float mur = p.in[I_MU][hc], muk = p.in[I_MU][512 + hc], muv = p.in[I_MU][1024 + hc];
    const float kkc = p.in[I_KK][hc], kac = p.in[I_KA][hc], rkc = p.in[I_RK][hc];
    float rp = 0.f, kp = 0.f, vp = 0.f;
    if (c != 0) { const bf16* zp = Z + (size_t)(tb - 1) * ZLD + 1024 + hc; rp = bf2f(zp[0]); kp = bf2f(zp[512]); vp = bf2f(zp[1024]); }
    f32x2 Mr[32], Nr[32];
#pragma unroll
    for (int k = 0; k < 32; ++k) { Mr[k] = (f32x2){(2 * k == lane) ? 1.f : 0.f, (2 * k + 1 == lane) ? 1.f : 0.f}; Nr[k] = (f32x2){0.f, 0.f}; }
    for (int sb = 0; sb < SCL / SC_TS; ++sb) {
        const int t0 = tb + sb * SC_TS;
#pragma unroll 1
        for (int sg = 0; sg < SC_TS; sg += 4) { float zr[4], zk[4], zv[4], lw[4], as[4];
          const bf16* zp0 = Z + (unsigned)((t0 + sg) * ZLD + 1024 + hc); const bf16* lp0 = LO + (unsigned)((t0 + sg) * 1536 + hc);
#pragma unroll
          for (int s = 0; s < 4; ++s) { const bf16* zp = zp0 + s * ZLD; const bf16* lp = lp0 + s * 1536;
              zr[s] = bf2f(zp[0]); zk[s] = bf2f(zp[512]); zv[s] = bf2f(zp[1024]); lw[s] = bf2f(lp[0]); as[s] = bf2f(lp[512]); }
#pragma unroll
          for (int s = 0; s < 4; ++s) {
              const float r = zr[s] + (rp - zr[s]) * mur, k = zk[s] + (kp - zk[s]) * muk, v = zv[s] + (vp - zv[s]) * muv;
              rp = zr[s]; kp = zk[s]; vp = zv[s];
              const float kkv = k * kkc;
              const float nrm = sqrtf(wave_sum_dpp(kkv * kkv));
              const float kk = kkv / fmaxf(nrm, 1e-12f);
              const float k2 = k * (1.0f + (as[s] - 1.0f) * kac);
              const float rk = wave_sum_dpp(r * k2 * rkc);
              LAS float* o = vec + (sg + s) * 384 + lane;
              o[0] = __builtin_amdgcn_exp2f(1.4426950409f * lw[s]); o[64] = -kk; o[128] = kk * as[s]; o[192] = k2; o[256] = r; o[320] = v;
              VLo[(unsigned)((t0 + sg + s) * 512 + hc)] = (bf16)f2bf(v);
              if (lane == 0) RKo[(unsigned)((t0 + sg + s) * 8 + h)] = rk;
          } }
        asm volatile("s_waitcnt lgkmcnt(0)" ::: "memory");
        for (int s = 0; s < SC_TS; ++s) {
            const LAS float* vs = vec + s * 384;
            const float vi = vs[320 + lane];
            f32x2 saM = {0.f, 0.f}, saN = {0.f, 0.f};
#pragma unroll
            for (int k4 = 0; k4 < 16; ++k4) { const f32x4 a4 = *(const LAS f32x4*)(vs + 64 + 4 * k4);
                const f32x2 a0 = {a4[0], a4[1]}, a1 = {a4[2], a4[3]};
                saM += Mr[2 * k4] * a0; saN += Nr[2 * k4] * a0; saM += Mr[2 * k4 + 1] * a1; saN += Nr[2 * k4 + 1] * a1;
                if ((k4 & 3) == 3) asm volatile("" ::: "memory"); }
            const float sM = saM[0] + saM[1], sN = saN[0] + saN[1];
            const f32x2 sM2 = {sM, sM}, sN2 = {sN, sN}, vi2 = {vi, vi};
            f32x2 yM = {0.f, 0.f}, yN = {0.f, 0.f};
#pragma unroll
            for (int k4 = 0; k4 < 16; ++k4) {
                const f32x4 w4 = *(const LAS f32x4*)(vs + 4 * k4), b4 = *(const LAS f32x4*)(vs + 128 + 4 * k4), k4v = *(const LAS f32x4*)(vs + 192 + 4 * k4), r4 = *(const LAS f32x4*)(vs + 256 + 4 * k4);
#pragma unroll
                for (int hh = 0; hh < 2; ++hh) {
                    const f32x2 w2 = {w4[2 * hh], w4[2 * hh + 1]}, b2 = {b4[2 * hh], b4[2 * hh + 1]}, k2 = {k4v[2 * hh], k4v[2 * hh + 1]}, r2 = {r4[2 * hh], r4[2 * hh + 1]};
                    const int kx = 2 * k4 + hh;
                    Mr[kx] = Mr[kx] * w2 + sM2 * b2;
                    Nr[kx] = Nr[kx] * w2 + (sN2 * b2 + vi2 * k2);
                    yM += Mr[kx] * r2; yN += Nr[kx] * r2;
                }
                asm volatile("" ::: "memory");
            }
            const unsigned oo = (unsigned)((t0 + s) * 512 + hc);
            Qo[oo] = (bf16)f2bf(yM[0] + yM[1]); Y2o[oo] = (bf16)f2bf(yN[0] + yN[1]);
        }
        asm volatile("s_waitcnt lgkmcnt(0)" ::: "memory");
    }
    f32x4* Mo = (f32x4*)((unsigned char*)p.out + O_M + (size_t)q * 16384 + lane * 256);
    f32x4* No = (f32x4*)((unsigned char*)p.out + O_N + (size_t)q * 16384 + lane * 256);
#pragma unroll
    for (int k4 = 0; k4 < 16; ++k4) { Mo[k4] = (f32x4){Mr[2 * k4][0], Mr[2 * k4][1], Mr[2 * k4 + 1][0], Mr[2 * k4 + 1][1]}; No[k4] = (f32x4){Nr[2 * k4][0], Nr[2 * k4][1], Nr[2 * k4 + 1][0], Nr[2 * k4 + 1][1]}; }
}
__device__ __forceinline__ void p5b_chain(PRef p, LAS unsigned char* lds, int item) {
    typedef float f32x2 __attribute__((ext_vector_type(2)));
    const int tid = otid(), r = tid >> 5, j0 = (tid & 31) * 2, seq = item >> 2, rg = item & 3;
    LAS float* Sl = (LAS float*)lds;
    LAS float* Ml = (LAS float*)(lds + 4096);
    const unsigned char* Mb = (const unsigned char*)p.out + O_M + (size_t)seq * NCH * 16384;
    const unsigned char* Nb = (const unsigned char*)p.out + O_N + (size_t)seq * NCH * 16384 + (size_t)(rg * 16 + r) * 256 + j0 * 4;
    unsigned char* Sb = (unsigned char*)p.out + O_S + (size_t)seq * NCH * 16384 + (size_t)(rg * 16 + r) * 256 + j0 * 4;
    f32x2 sreg = {0.f, 0.f};
    f32x4 m0[2], m1[2], m2[2], m3[2]; f32x2 n0, n1, n2, n3;
#define P5B_LOAD(mm, nn, cc) do { const f32x4* mp = (const f32x4*)(Mb + (size_t)(cc) * 16384) + tid; mm[0] = mp[0]; mm[1] = mp[512]; nn = *(const f32x2*)(Nb + (size_t)(cc) * 16384); } while (0)
#define P5B_STEP(mm, nn, cc) do { \
        __syncthreads(); \
        *(LAS f32x4*)(Ml + tid * 4) = mm[0]; *(LAS f32x4*)(Ml + 2048 + tid * 4) = mm[1]; *(LAS f32x2*)(Sl + r * 64 + j0) = sreg; \
        *(f32x2*)(Sb + (size_t)(cc) * 16384) = sreg; \
        f32x2 acc = nn; \
        __syncthreads(); \
        if ((cc) + 4 < NCH) P5B_LOAD(mm, nn, (cc) + 4); \
        _Pragma("unroll 16") for (int i = 0; i < 64; ++i) { const float sv = Sl[r * 64 + i]; const f32x2 mv = *(const LAS f32x2*)(Ml + i * 64 + j0); acc += (f32x2){sv, sv} * mv; } \
        sreg = acc; } while (0)
    P5B_LOAD(m0, n0, 0); P5B_LOAD(m1, n1, 1); P5B_LOAD(m2, n2, 2); P5B_LOAD(m3, n3, 3);
    for (int c = 0; c < NCH; c += 4) { P5B_STEP(m0, n0, c); P5B_STEP(m1, n1, c + 1); P5B_STEP(m2, n2, c + 2); P5B_STEP(m3, n3, c + 3); }
    __syncthreads();
#undef P5B_LOAD
#undef P5B_STEP
}
#ifndef P5C_MASK
#define P5C_MASK(c, h, tt) true
#endif
__device__ __forceinline__ void p5c_chunk(PRef p, int q) {
    typedef short bf16x8 __attribute__((ext_vector_type(8)));
    const int lane = otid() & 63, fr = lane & 15, fq = lane >> 4;
    const int seq = q / NCH, c = q % NCH, b = seq >> 3, h = seq & 7, tb = b * SEQ + c * SCL;
    const bf16* Qi = (const bf16*)(p.ws + W_Q); const bf16* Y2i = (const bf16*)(p.ws + W_Y2); const bf16* VLi = (const bf16*)((const unsigned char*)p.out + O_VL);
    const float* RKi = (const float*)(p.ws + T_RK); const bf16* LO = (const bf16*)(p.ws + W_LO); bf16* ycat = (bf16*)(p.ws + W_YCAT);
    const float* Sc = (const float*)((const unsigned char*)p.out + O_S + (size_t)q * 16384);
    bf16x8 sa[4][2];
#pragma unroll
    for (int vt = 0; vt < 4; ++vt)
#pragma unroll
        for (int ks = 0; ks < 2; ++ks) { const f32x4* sp = (const f32x4*)(Sc + (vt * 16 + fr) * 64 + ks * 32 + fq * 8); const f32x4 x0 = sp[0], x1 = sp[1];
            u32x4 w; w.x = pg8::cvt_pk_bf16(x0[0], x0[1]); w.y = pg8::cvt_pk_bf16(x0[2], x0[3]); w.z = pg8::cvt_pk_bf16(x1[0], x1[1]); w.w = pg8::cvt_pk_bf16(x1[2], x1[3]);
            sa[vt][ks] = __builtin_bit_cast(bf16x8, w); }
    f32x4 gw[4], gb[4];
#pragma unroll
    for (int vt = 0; vt < 4; ++vt) { gw[vt] = *(const f32x4*)(p.in[I_GNW] + h * 64 + vt * 16 + fq * 4); gb[vt] = *(const f32x4*)(p.in[I_GNB] + h * 64 + vt * 16 + fq * 4); }
#pragma unroll 1
    for (int tt = 0; tt < SCL / 16; ++tt) {
        const int t = tb + tt * 16 + fr;
        const unsigned tq = (unsigned)(t * 512 + h * 64);
        const bf16x8 qb0 = *(const bf16x8*)(Qi + (tq + fq * 8)), qb1 = *(const bf16x8*)(Qi + (tq + 32 + fq * 8));
        f32x4 y[4]; float s = 0.f;
#pragma unroll
        for (int vt = 0; vt < 4; ++vt) {
            const u32x2 yw = *(const u32x2*)(Y2i + (tq + vt * 16 + fq * 4));
            f32x4 a = {bflo(yw.x), bfhi(yw.x), bflo(yw.y), bfhi(yw.y)};
            a = __builtin_amdgcn_mfma_f32_16x16x32_bf16(sa[vt][0], qb0, a, 0, 0, 0);
            a = __builtin_amdgcn_mfma_f32_16x16x32_bf16(sa[vt][1], qb1, a, 0, 0, 0);
            y[vt] = a; s += (a[0] + a[1]) + (a[2] + a[3]);
        }
        s = xsum4(s);
        const float m = s * (1.f / 64.f); float qq = 0.f;
#pragma unroll
        for (int vt = 0; vt < 4; ++vt) { y[vt] = y[vt] - m; qq += (y[vt][0] * y[vt][0] + y[vt][1] * y[vt][1]) + (y[vt][2] * y[vt][2] + y[vt][3] * y[vt][3]); }
        qq = xsum4(qq);
        const float rs = rsqrtf(qq * (1.f / 64.f) + 64e-5f);
        const float rk = RKi[(unsigned)(t * 8 + h)];
#pragma unroll
        for (int vt = 0; vt < 4; ++vt) {
            const int cc = h * 64 + vt * 16 + fq * 4;
            const u32x2 vw = *(const u32x2*)(VLi + (unsigned)(t * 512 + cc)); const u32x2 gwv = *(const u32x2*)(LO + (unsigned)(t * 1536 + 1024 + cc));
            const f32x4 vv = {bflo(vw.x), bfhi(vw.x), bflo(vw.y), bfhi(vw.y)}, gg = {bflo(gwv.x), bfhi(gwv.x), bflo(gwv.y), bfhi(gwv.y)};
            const f32x4 o = (y[vt] * rs * gw[vt] + gb[vt] + vv * rk) * gg;
            u32x2 ow; ow.x = pk2(o[0], o[1]); ow.y = pk2(o[2], o[3]);
            if (P5C_MASK(c, h, tt)) *(u32x2*)(ycat + (unsigned)(t * 1024 + 512 + cc)) = ow;
        }
    }
}
constexpr size_t G_H2 = 176 * MiB, G_HB = 16 * MiB, G_Y0 = 304 * MiB, G_Y1 = 176 * MiB;
__global__ void __launch_bounds__(NTHR, 2) k_mega(Params p_unused) {
    PPtr kp = (PPtr)__builtin_amdgcn_kernarg_segment_ptr();
#define p (*opq(kp))
    extern __shared__ __attribute__((aligned(16))) unsigned char lds_raw[];
    cg::grid_group grid = cg::this_grid();
    const int bid = blockIdx.x, nb = gridDim.x;
    LAS unsigned char* lds = (LAS unsigned char*)lds_raw;
    float* ldsf = (float*)lds_raw;
    p0_prep<false>(p, lds, bid, nb); grid.sync();
    p1_h1(p, bid, nb); grid.sync();
    { pg8::Gemm g{(const pg8::bf16_t*)(p.ws + W_H1), (const pg8::bf16_t*)(p.ws + W_WINT), NTOK, ZLD, D}; pg8::StaticOrder S; S.init(NTOK, ZLD, nb, bid);
      EpiZ E{(bf16*)(p.ws + W_Z)};
      pg8::gemm_phase<EpiZ, pg8::StaticOrder, true, true>(lds, g, S, E); }
    grid.sync();
    for (int ch = bid; ch < NTOK / CHUNK; ch += nb) p3_gmlp_unit(p, lds, ch);
    p3_lorain(p, bid, nb);
    grid.sync();
    { int kop = 256; asm volatile("" : "+s"(kop));
      pg8::Gemm g{(const pg8::bf16_t*)(p.ws + W_A2), (const pg8::bf16_t*)(p.ws + W_LORAT), NTOK, 1536, kop}; pg8::StaticOrder S; S.init(NTOK, 1536, nb, bid);
      EpiLO E{(bf16*)(p.ws + W_LO), p.in[I_W0], p.in[I_A0]};
      pg8::gemm_phase<EpiLO, pg8::StaticOrder, true, true>(lds, g, S, E); }
    grid.sync();
    for (int q = bid * 8 + __builtin_amdgcn_readfirstlane(otid() >> 6); q < BATCH * 8 * NCH; q += nb * 8) p5a_chunk(p, lds, q);
    grid.sync();
    for (int it = bid; it < BATCH * 8 * 4; it += nb) p5b_chain(p, lds, it);
    grid.sync();
    for (int q = bid * 8 + __builtin_amdgcn_readfirstlane(otid() >> 6); q < BATCH * 8 * NCH; q += nb * 8) p5c_chunk(p, q);
    grid.sync();
    { pg8::Gemm g{(const pg8::bf16_t*)(p.ws + W_YCAT), (const pg8::bf16_t*)(p.ws + W_WOUTT), NTOK, D, D}; pg8::StaticOrder S; S.init(NTOK, D, nb, bid);
      EpiX1 E{p.in[I_X], (const float*)(p.ws + W_MOD), p.out};
      pg8::gemm_phase<EpiX1, pg8::StaticOrder, true, true>(lds, g, S, E); }
    grid.sync();
    gold_norm2_route(p, ldsf, p.out, (float*)(p.ws + G_H2), bid, nb); grid.sync();
    gold_moe_init(p, bid, nb); grid.sync();
    gold_moe_place(p, bid, nb); grid.sync();
    { GEpiGate e{(float*)(p.ws + G_HB)};
      gg_gemm(ldsf, (const float*)(p.ws + G_H2), D, (const int*)(p.ws + T_ROWTOK), p.in[I_WG], EH, (size_t)D * EH, (const int*)(p.ws + T_TILEE), PROWS_G, EH, D, e, bid, nb); } grid.sync();
    { GEpiUp e{(float*)(p.ws + G_HB)};
      gg_gemm(ldsf, (const float*)(p.ws + G_H2), D, (const int*)(p.ws + T_ROWTOK), p.in[I_WU], EH, (size_t)D * EH, (const int*)(p.ws + T_TILEE), PROWS_G, EH, D, e, bid, nb); } grid.sync();
    { GEpiDown e{(const int*)(p.ws + T_ROWAID), (const float*)(p.ws + T_ROWW), (float*)(p.ws + G_Y0), (float*)(p.ws + G_Y1)};
      gg_gemm(ldsf, (const float*)(p.ws + G_HB), EH, nullptr, p.in[I_WD], D, (size_t)EH * D, (const int*)(p.ws + T_TILEE), PROWS_G, D, EH, e, bid, nb); } grid.sync();
    gold_final(p, p.out, (const float*)(p.ws + G_Y0), (const float*)(p.ws + G_Y1), bid, nb);
#undef p
}
extern "C" void kernel_launch(void* const* d_in, const int* in_sizes, int n_in, void* d_out, int out_size, void* d_ws, size_t ws_size, hipStream_t stream) {
    if (n_in != 31 || ws_size < WS_NEED || out_size != NTOK * D) { fprintf(stderr, "kernel_launch: unexpected sizes n_in %d ws %zu out %d\n", n_in, ws_size, out_size); return; }
    static int grid_blocks = 0;
    if (!grid_blocks) {
        int dev = 0, cus = 0, per_cu = 0;
        (void)hipGetDevice(&dev);
        (void)hipDeviceGetAttribute(&cus, hipDeviceAttributeMultiprocessorCount, dev);
        (void)hipFuncSetAttribute((const void*)k_mega, hipFuncAttributeMaxDynamicSharedMemorySize, LDS_BYTES);
        (void)hipOccupancyMaxActiveBlocksPerMultiprocessor(&per_cu, (const void*)k_mega, NTHR, LDS_BYTES);
        if (per_cu < 1) fprintf(stderr, "kernel_launch: occupancy query says %d blocks/CU\n", per_cu);
        grid_blocks = cus;
    }
    Params p{};
    for (int i = 0; i < 31; ++i) p.in[i] = (const float*)d_in[i];
    p.out = (float*)d_out; p.ws = (unsigned char*)d_ws;
    (void)hipMemsetAsync((char*)d_ws + T_CTL, 0, 4096, stream);
    void* args[] = {&p};
    hipError_t e = hipLaunchCooperativeKernel((void*)k_mega, dim3(grid_blocks), dim3(NTHR), args, LDS_BYTES, stream);
    if (e != hipSuccess) fprintf(stderr, "cooperative launch failed: %s (grid %d)\n", hipGetErrorString(e), grid_blocks);
}
```

```cpp
#include <hip/hip_runtime.h>
#include <hip/hip_cooperative_groups.h>
#include <cstdio>
#include <cstdint>
namespace cg = cooperative_groups;
__device__ __forceinline__ int otid() { int t = threadIdx.x; asm volatile("" : "+v"(t)); return t; }

namespace pg8 {
#define PG8_LAS __attribute__((address_space(3)))
typedef unsigned short bf16_t;
typedef short bf16x8 __attribute__((ext_vector_type(8)));
typedef float f32x4 __attribute__((ext_vector_type(4)));
typedef unsigned u32x4 __attribute__((ext_vector_type(4)));
constexpr int BM = 256, BK = 64, HALF = 128, HTB = HALF * BK * 2  , STAGE_BYTES = 8 * HTB, NXCD = 8, WGM = 8;

__host__ __device__ __forceinline__ int lds_byte(int r, int c) { const int st = (r >> 4) * 2 + (c >> 5), rr = r & 15, cc = c & 31, ob = rr * 64 + cc * 2; return st * 1024 + (ob ^ (((ob >> 9) & 1) << 5)); }
__host__ __device__ __forceinline__ void stage_rc(int b, int& R, int& C) { const int st = b / 1024, sb = b % 1024, swz = sb ^ (((sb >> 9) & 1) << 5); R = (st >> 1) * 16 + swz / 64; C = (st & 1) * 32 + (swz % 64) / 2; }
__host__ __device__ __forceinline__ int perm32(int rho) { const int n = rho >> 4, i = rho & 15; return 8 * (i >> 2) + 4 * n + (i & 3); }

struct Unit { int pm, pn, pb; };
struct Gemm { const bf16_t* A; const bf16_t* Bt; int M, N, K; };

struct StaticOrder {
    int nM, nN, nwg, G, c;
    __host__ __device__ void init(int M, int N, int G_, int c_) { nM = M / BM; nN = N / BM; nwg = nM * nN; G = G_; c = c_; }
    __host__ __device__ bool next(int i, Unit& u) const {
        const long L = (long)i * G + c; if (L >= nwg) return false;
        int wgid = (int)L; { const int q = nwg / NXCD, r = nwg % NXCD, xcd = wgid % NXCD, off = wgid / NXCD; wgid = (xcd < r ? xcd * (q + 1) : r * (q + 1) + (xcd - r) * q) + off; }
        const int nig = WGM * nN, gid = wgid / nig, fm = gid * WGM, gsz = (nM - fm) < WGM ? (nM - fm) : WGM;
        u.pm = fm + ((wgid % nig) % gsz); u.pn = (wgid % nig) / gsz; u.pb = u.pn; return true;
    }
    __device__ __forceinline__ void a_ready(const Unit&) const {}
    __device__ __forceinline__ void done(const Unit&) const {}
};

__device__ __forceinline__ unsigned cvt_pk_bf16(float lo, float hi) { unsigned r; asm volatile("v_cvt_pk_bf16_f32 %0, %1, %2" : "=v"(r) : "v"(lo), "v"(hi)); return r; }
typedef float f32x2 __attribute__((ext_vector_type(2)));
template <class Epi, class Sched, bool ALIGN_EPI = false, bool SP2 = false>
__device__ __forceinline__ void gemm_phase(PG8_LAS unsigned char* lds, const Gemm g, const Sched& S, const Epi& E) {
    const int tid = otid(), wid = __builtin_amdgcn_readfirstlane(tid >> 6), lane = tid & 63, wr = wid >> 2, wc = wid & 3, fr = lane & 15, fq = lane >> 4;
    const int K = g.K, nt = K / BK;
    unsigned voffA[2], voffB[2];
#pragma unroll
    for (int i = 0; i < 2; ++i) { int R, C; stage_rc(tid * 16 + i * 8192, R, C); const int Rb = Epi::PERM ? ((R & ~31) + perm32(R & 31)) : R;
        voffA[i] = (unsigned)(R * K + C) * 2u; voffB[i] = (unsigned)(Rb * K + C) * 2u; }
    const size_t kstep = (size_t)(BK * 2);
    const size_t hstep = (size_t)HALF * K * 2;
    const size_t tstep = 2 * hstep;
    const unsigned ldsw = (unsigned)wid * 1024u;
    const int aoff = lds_byte(wr * 64 + fr, fq * 8), boff = lds_byte(wc * 32 + fr, fq * 8);
#define PG8_SA(b, h) (((b) * 2 + (h)) * HTB)
#define PG8_SB(b, h) ((4 + (b) * 2 + (h)) * HTB)
#define PG8_STAGE(bufoff, gbase, voff) do { _Pragma("unroll") for (int _i = 0; _i < 2; ++_i) \
        __builtin_amdgcn_global_load_lds((const unsigned*)((const char*)(gbase) + (voff)[_i]), (PG8_LAS unsigned*)(lds + (bufoff) + ldsw + _i * 8192), 16, 0, 0); } while (0)
#define PG8_LDA(dst, b, h) do { _Pragma("unroll") for (int m = 0; m < 4; ++m) _Pragma("unroll") for (int k = 0; k < 2; ++k) dst[m][k] = *(const PG8_LAS bf16x8*)(lds + PG8_SA(b, h) + aoff + m * 2048 + k * 1024); } while (0)
#define PG8_LDB(dst, b, h) do { _Pragma("unroll") for (int n = 0; n < 2; ++n) _Pragma("unroll") for (int k = 0; k < 2; ++k) dst[n][k] = *(const PG8_LAS bf16x8*)(lds + PG8_SB(b, h) + boff + n * 2048 + k * 1024); } while (0)
#define PG8_MMA(ai, bj, At, Bt) do { __builtin_amdgcn_s_setprio(1); _Pragma("unroll") for (int m = 0; m < 4; ++m) _Pragma("unroll") for (int n = 0; n < 2; ++n) _Pragma("unroll") for (int k = 0; k < 2; ++k) \
        acc[ai][bj][m][n] = __builtin_amdgcn_mfma_f32_16x16x32_bf16(Bt[n][k], At[m][k], acc[ai][bj][m][n], 0, 0, 0); __builtin_amdgcn_s_setprio(0); } while (0)
#define PG8_WAIT_V(n) asm volatile("s_waitcnt vmcnt(" #n ")" ::: "memory")
#define PG8_WAIT_L(n) asm volatile("s_waitcnt lgkmcnt(" #n ")" ::: "memory")
#define PG8_BAR __builtin_amdgcn_s_barrier()
#define PG8_SCHED __builtin_amdgcn_sched_barrier(0)
    Unit cur, nxt; int ui = 0;
    if (!S.next(0, cur)) return;
    f32x4 acc[2][2][4][2];
#pragma unroll
    for (int a = 0; a < 2; ++a)
#pragma unroll
        for (int b = 0; b < 2; ++b)
#pragma unroll
            for (int m = 0; m < 4; ++m)
#pragma unroll
                for (int n = 0; n < 2; ++n) acc[a][b][m][n] = (f32x4){0.f, 0.f, 0.f, 0.f};
    bf16x8 At[4][2], B0[2][2], B1[2][2];
    const char* cA = (const char*)g.A + (size_t)cur.pm * tstep; const char* cB = (const char*)g.Bt + (size_t)cur.pb * tstep;
    S.a_ready(cur);
    if constexpr (SP2) {
        PG8_STAGE(PG8_SB(0, 0), cB, voffB); PG8_STAGE(PG8_SB(0, 1), cB + hstep, voffB); PG8_STAGE(PG8_SA(0, 0), cA, voffA); PG8_STAGE(PG8_SA(0, 1), cA + hstep, voffA);
        if (wr == 1) PG8_BAR;
        PG8_WAIT_V(2); PG8_BAR;
        PG8_STAGE(PG8_SB(1, 0), cB + kstep, voffB); PG8_STAGE(PG8_SA(1, 0), cA + kstep, voffA); PG8_STAGE(PG8_SB(1, 1), cB + hstep + kstep, voffB);
        PG8_WAIT_V(6); PG8_BAR;
    } else {
        PG8_STAGE(PG8_SB(0, 0), cB, voffB); PG8_STAGE(PG8_SA(0, 0), cA, voffA); PG8_STAGE(PG8_SB(0, 1), cB + hstep, voffB); PG8_STAGE(PG8_SA(0, 1), cA + hstep, voffA);
        if (wr == 1) PG8_BAR;
        PG8_WAIT_V(4); PG8_BAR;
        PG8_STAGE(PG8_SB(1, 0), cB + kstep, voffB); PG8_STAGE(PG8_SA(1, 0), cA + kstep, voffA); PG8_STAGE(PG8_SB(1, 1), cB + hstep + kstep, voffB);
        PG8_WAIT_V(6); PG8_BAR;
    }
    for (;;) {
        const bool has_next = S.next(ui + 1, nxt);
        const char* nA = has_next ? (const char*)g.A + (size_t)nxt.pm * tstep : cA; const char* nB = has_next ? (const char*)g.Bt + (size_t)nxt.pb * tstep : cB;
        for (int t = 0; t < nt; t += 2) {
            const bool last = (t == nt - 2);
            const char* a1 = cA + (size_t)(t + 1) * kstep;
            const char* a2 = last ? nA : cA + (size_t)(t + 2) * kstep; const char* b2 = last ? nB : cB + (size_t)(t + 2) * kstep;
            const char* a3 = a2 + kstep; const char* b3 = b2 + kstep;
            if (last && has_next) S.a_ready(nxt);
            if constexpr (SP2) {
            PG8_LDB(B0, 0, 0); PG8_LDB(B1, 0, 1); PG8_SCHED; PG8_LDA(At, 0, 0); PG8_STAGE(PG8_SA(1, 1), a1 + hstep, voffA);
            PG8_WAIT_V(8); PG8_WAIT_L(0); PG8_BAR; PG8_MMA(0, 0, At, B0); PG8_MMA(0, 1, At, B1); PG8_BAR; PG8_SCHED;
            PG8_LDA(At, 0, 1); PG8_STAGE(PG8_SB(0, 0), b2, voffB); PG8_STAGE(PG8_SB(0, 1), b2 + hstep, voffB); PG8_STAGE(PG8_SA(0, 0), a2, voffA);
            PG8_WAIT_V(8); PG8_WAIT_L(0); PG8_BAR; PG8_MMA(1, 0, At, B0); PG8_MMA(1, 1, At, B1); PG8_BAR; PG8_SCHED;
            PG8_LDB(B0, 1, 0); PG8_LDB(B1, 1, 1); PG8_SCHED; PG8_LDA(At, 1, 0); PG8_STAGE(PG8_SA(0, 1), a2 + hstep, voffA);
            PG8_WAIT_V(8); PG8_WAIT_L(0); PG8_BAR; PG8_MMA(0, 0, At, B0); PG8_MMA(0, 1, At, B1); PG8_BAR; PG8_SCHED;
            PG8_LDA(At, 1, 1); PG8_STAGE(PG8_SB(1, 0), b3, voffB); PG8_STAGE(PG8_SB(1, 1), b3 + hstep, voffB); PG8_STAGE(PG8_SA(1, 0), a3, voffA);
            PG8_WAIT_V(8); PG8_WAIT_L(0); PG8_BAR; PG8_MMA(1, 0, At, B0); PG8_MMA(1, 1, At, B1); PG8_BAR; PG8_SCHED;
            } else {
            PG8_LDB(B0, 0, 0); PG8_SCHED; PG8_LDA(At, 0, 0); PG8_STAGE(PG8_SA(1, 1), a1 + hstep, voffA);
            PG8_WAIT_L(8); PG8_BAR; PG8_WAIT_L(0); PG8_MMA(0, 0, At, B0); PG8_BAR; PG8_SCHED;
            PG8_LDB(B1, 0, 1); PG8_STAGE(PG8_SB(0, 0), b2, voffB);
            PG8_BAR; PG8_WAIT_L(0); PG8_MMA(0, 1, At, B1); PG8_BAR;
            PG8_LDA(At, 0, 1); PG8_STAGE(PG8_SA(0, 0), a2, voffA);
            PG8_BAR; PG8_WAIT_L(0); PG8_MMA(1, 0, At, B0); PG8_BAR; PG8_SCHED;
            PG8_STAGE(PG8_SB(0, 1), b2 + hstep, voffB);
            PG8_WAIT_V(6); PG8_BAR; PG8_MMA(1, 1, At, B1); PG8_BAR;
            PG8_LDB(B0, 1, 0); PG8_SCHED; PG8_LDA(At, 1, 0); PG8_STAGE(PG8_SA(0, 1), a2 + hstep, voffA);
            PG8_WAIT_L(8); PG8_BAR; PG8_WAIT_L(0); PG8_MMA(0, 0, At, B0); PG8_BAR; PG8_SCHED;
            PG8_LDB(B1, 1, 1); PG8_STAGE(PG8_SB(1, 0), b3, voffB);
            PG8_BAR; PG8_WAIT_L(0); PG8_MMA(0, 1, At, B1); PG8_BAR;
            PG8_LDA(At, 1, 1); PG8_STAGE(PG8_SA(1, 0), a3, voffA);
            PG8_BAR; PG8_WAIT_L(0); PG8_MMA(1, 0, At, B0); PG8_BAR; PG8_SCHED;
            PG8_STAGE(PG8_SB(1, 1), b3 + hstep, voffB);
            PG8_WAIT_V(6); PG8_BAR; PG8_MMA(1, 1, At, B1); PG8_BAR;
            }
        }
        if constexpr (ALIGN_EPI) { if (wr == 0) PG8_BAR; }
        if constexpr (!Epi::AFTER_DRAIN) { E(acc, cur, wr, wc, fr, fq); S.done(cur); }
        if (!has_next) break;
#pragma unroll
        for (int a = 0; a < 2; ++a)
#pragma unroll
            for (int b = 0; b < 2; ++b)
#pragma unroll
                for (int m = 0; m < 4; ++m)
#pragma unroll
                    for (int n = 0; n < 2; ++n) acc[a][b][m][n] = (f32x4){0.f, 0.f, 0.f, 0.f};
        cur = nxt; cA = nA; cB = nB; ++ui;
        if constexpr (ALIGN_EPI) { if (wr == 1) PG8_BAR; }
    }
    PG8_WAIT_V(0);
    if constexpr (!ALIGN_EPI) { if (wr == 0) PG8_BAR; }
    PG8_BAR;
    if constexpr (Epi::AFTER_DRAIN) { E.fused(acc, cur, wr, wc, fr, fq, lds, wid, lane); S.done(cur); }
#undef PG8_SA
#undef PG8_SB
#undef PG8_STAGE
#undef PG8_LDA
#undef PG8_LDB
#undef PG8_MMA
#undef PG8_WAIT_V
#undef PG8_WAIT_L
#undef PG8_BAR
#undef PG8_SCHED
}
}
constexpr int D = 1024, BATCH = 8, SEQ = 4096, NTOK = BATCH * SEQ;
constexpr int GW = 512, RW = 512, HD = 64, CHUNK = 128;
constexpr int RPROJ = 1696, INW = 2720, ZLD = 2816;
constexpr int NG = 4, EPG = 8, NE = 32, EH = 512;
constexpr int NTHR = 512;
constexpr int LDS_BYTES = 163840;

typedef float f32x16 __attribute__((ext_vector_type(16)));
typedef float f32x4 __attribute__((ext_vector_type(4)));
typedef unsigned u32x4 __attribute__((ext_vector_type(4)));
typedef unsigned u32x2 __attribute__((ext_vector_type(2)));
typedef unsigned short bf16;
#define LAS __attribute__((address_space(3)))

constexpr size_t MiB = 1u << 20;
constexpr size_t W_WINT = 0;
constexpr size_t W_WOUTT = 6 * MiB;
constexpr size_t W_LORAT = 8 * MiB;
constexpr size_t W_WC = 9 * MiB;
constexpr size_t W_MOD = 10 * MiB;
constexpr size_t W_TAB = 11 * MiB;
constexpr size_t W_WGUT = 16 * MiB;
constexpr size_t W_WDT = 80 * MiB;
constexpr size_t W_H1 = 112 * MiB;
constexpr size_t W_Z = 176 * MiB;
constexpr size_t W_YCAT = 352 * MiB;
constexpr size_t W_LO = 416 * MiB;
constexpr size_t WS_NEED = 512 * MiB;
constexpr size_t T_TOKE = W_TAB;
constexpr size_t T_TOKW = W_TAB + 512 * 1024;
constexpr size_t T_ROWTOK = W_TAB + 1024 * 1024;
constexpr size_t T_ROWAID = W_TAB + 1536 * 1024;
constexpr size_t T_ROWW = W_TAB + 2048 * 1024;
constexpr size_t T_TILEE = W_TAB + 2560 * 1024;
constexpr size_t T_CTL = W_TAB + 3072 * 1024;

struct Params {
    const float* in[31];
    float* out;
    unsigned char* ws;
};
typedef const __attribute__((address_space(4))) Params& PRef;
typedef const __attribute__((address_space(4))) Params* PPtr;
__device__ __forceinline__ PPtr opq(PPtr k) { asm volatile("" : "+s"(k)); return k; }
enum { I_X = 0, I_C, I_ADAW, I_ADAB, I_N1G, I_WIN, I_GLNW, I_GLNB, I_GWS, I_GBS, I_MU, I_W0, I_W2, I_A0, I_A2, I_G2, I_KK, I_KA, I_RK, I_GNW, I_GNB, I_WOUT, I_N2G, I_RGW, I_RGB, I_REW, I_REB, I_WG, I_WU, I_WD, I_FNG };

__device__ __forceinline__ float wave_sum(float v) {
#pragma unroll
    for (int o = 1; o < 64; o <<= 1) v += __shfl_xor(v, o);
    return v;
}
#define DPP_ADD(v, ctrl) v += __builtin_bit_cast(float, __builtin_amdgcn_update_dpp(0, __builtin_bit_cast(int, v), ctrl, 0xf, 0xf, false))
__device__ __forceinline__ float wave_sum_dpp(float v) {
    DPP_ADD(v, 0xB1); DPP_ADD(v, 0x4E); DPP_ADD(v, 0x141); DPP_ADD(v, 0x140);
    const int iv = __builtin_bit_cast(int, v);
    const float a = __builtin_bit_cast(float, __builtin_amdgcn_readlane(iv, 0)), b = __builtin_bit_cast(float, __builtin_amdgcn_readlane(iv, 16));
    const float c = __builtin_bit_cast(float, __builtin_amdgcn_readlane(iv, 32)), d = __builtin_bit_cast(float, __builtin_amdgcn_readlane(iv, 48));
    return (a + b) + (c + d);
}
__device__ __forceinline__ float xsum4(float s) {
    s += __builtin_bit_cast(float, __builtin_amdgcn_ds_swizzle(__builtin_bit_cast(int, s), 0x401F));
    float a = s, b = s;
    asm volatile("s_nop 1\n\tv_permlane32_swap_b32 %0, %1\n\ts_nop 1" : "+v"(a), "+v"(b));
    return a + b;
}
__device__ __forceinline__ float wave_sum_v(float v) {
    DPP_ADD(v, 0xB1); DPP_ADD(v, 0x4E); DPP_ADD(v, 0x141); DPP_ADD(v, 0x140);
    return xsum4(v);
}
__device__ __forceinline__ float gelu_tanh(float x) {
    const float u = 0.7978845608028654f * (x + 0.044715f * x * x * x);
    return 0.5f * x * (1.0f + tanhf(u));
}
__device__ __forceinline__ float gelu_fast(float x) {
    const float u2 = -2.302208198f * (x + 0.044715f * x * x * x);
    return x * __builtin_amdgcn_rcpf(1.0f + __builtin_amdgcn_exp2f(u2));
}
__device__ __forceinline__ float sigmoidf_(float x) { return 1.0f / (1.0f + expf(-x)); }
__device__ __forceinline__ float softplusf_(float x) { return fmaxf(x, 0.f) + log1pf(expf(-fabsf(x))); }
__device__ __forceinline__ float bf2f(unsigned short b) { return __uint_as_float(((unsigned)b) << 16); }
__device__ __forceinline__ float bflo(unsigned w) { return __uint_as_float(w << 16); }
__device__ __forceinline__ float bfhi(unsigned w) { return __uint_as_float(w & 0xffff0000u); }
__device__ __forceinline__ unsigned f2bf(float f) { unsigned u = __float_as_uint(f); return (u + 0x7fffu + ((u >> 16) & 1u)) >> 16; }
__device__ __forceinline__ unsigned pk2(float lo, float hi) { return f2bf(lo) | (f2bf(hi) << 16); }
constexpr int GT = 128;
constexpr int PROWS_G = NTOK * 2 + NE * GT;
constexpr int PTILES_G = PROWS_G / GT;
template <class Epi>
__device__ __forceinline__ void gg_gemm(float* lds, const float* __restrict__ A, int lda, const int* rowidx, const float* __restrict__ B, int ldb, size_t bstride,
                        const int* tile_expert, int M, int N, int K, const Epi& epi, int bid, int nb) {
    float* As = lds;
    float* Bs = lds + 16 * 132;
    const int tid = otid(), lane = tid & 63, wid = tid >> 6, wm = wid >> 1, wn = wid & 1;
    const int tilesN = (N + 127) / 128, tilesM = M / 128;
    for (int tile = bid; tile < tilesM * tilesN; tile += nb) {
        const int tm = tile / tilesN, tn = tile % tilesN;
        const float* Bp = B;
        if (tile_expert) { const int e = tile_expert[tm]; if (e < 0) continue; Bp = B + (size_t)e * bstride; }
        f32x16 acc0, acc1;
#pragma unroll
        for (int i = 0; i < 16; ++i) { acc0[i] = 0.f; acc1[i] = 0.f; }
        const int arow = tid >> 2, akq = (tid & 3) * 4;
        int asrc = tm * 128 + arow;
        if (rowidx) asrc = rowidx[asrc];
        const int bk = tid >> 5, bn4 = (tid & 31) * 4, bcol = tn * 128 + bn4;
        for (int k0 = 0; k0 < K; k0 += 16) {
            f32x4 av = {0.f, 0.f, 0.f, 0.f};
            if (asrc >= 0) av = *(const f32x4*)(A + (size_t)asrc * lda + k0 + akq);
            f32x4 bv = {0.f, 0.f, 0.f, 0.f};
            if (bcol < N) bv = *(const f32x4*)(Bp + (size_t)(k0 + bk) * ldb + bcol);
            __syncthreads();
            As[(akq + 0) * 132 + arow] = av[0]; As[(akq + 1) * 132 + arow] = av[1]; As[(akq + 2) * 132 + arow] = av[2]; As[(akq + 3) * 132 + arow] = av[3];
            *(f32x4*)(Bs + bk * 128 + bn4) = bv;
            __syncthreads();
#pragma unroll
            for (int kk = 0; kk < 16; kk += 2) {
                const int kr = kk + (lane >> 5);
                const float a = As[kr * 132 + wm * 32 + (lane & 31)];
                const float b0 = Bs[kr * 128 + wn * 64 + (lane & 31)];
                const float b1 = Bs[kr * 128 + wn * 64 + 32 + (lane & 31)];
                acc0 = __builtin_amdgcn_mfma_f32_32x32x2f32(a, b0, acc0, 0, 0, 0);
                acc1 = __builtin_amdgcn_mfma_f32_32x32x2f32(a, b1, acc1, 0, 0, 0);
            }
        }
#pragma unroll
        for (int r = 0; r < 16; ++r) {
            const int row = tm * 128 + wm * 32 + (r & 3) + 8 * (r >> 2) + 4 * (lane >> 5);
            const int c0 = tn * 128 + wn * 64 + (lane & 31);
            if (c0 < N) epi(row, c0, acc0[r]);
            if (c0 + 32 < N) epi(row, c0 + 32, acc1[r]);
        }
        __syncthreads();
    }
}
__device__ __forceinline__ void gold_normmod(const float* __restrict__ x, const float* __restrict__ g, const float* mod, int shift_idx, int scale_idx, float* __restrict__ out, int bid, int nb) {
    const int tid_ = otid(), lane = tid_ & 63, wv = tid_ >> 6;
    for (int row = bid * 8 + wv; row < NTOK; row += nb * 8) {
        const int b = row / SEQ;
        const f32x4* xr = (const f32x4*)(x + (size_t)row * D) + lane;
        f32x4 v[4]; float s = 0.f;
#pragma unroll
        for (int j = 0; j < 4; ++j) { v[j] = xr[64 * j]; s += v[j][0] * v[j][0] + v[j][1] * v[j][1] + v[j][2] * v[j][2] + v[j][3] * v[j][3]; }
        const float r = rsqrtf(wave_sum(s) * (1.0f / D) + 1e-6f);
        const float* sh = mod + b * 6 * D + shift_idx * D; const float* sc = mod + b * 6 * D + scale_idx * D;
        f32x4* o = (f32x4*)(out + (size_t)row * D) + lane;
#pragma unroll
        for (int j = 0; j < 4; ++j) {
            const int c0 = (lane + 64 * j) * 4; f32x4 y;
#pragma unroll
            for (int q = 0; q < 4; ++q) y[q] = v[j][q] * r * g[c0 + q] * (1.0f + sc[c0 + q]) + sh[c0 + q];
            o[64 * j] = y;
        }
    }
}
__device__ __forceinline__ void gold_gmlp_ln(PRef p, const bf16* Z, float* vln, int bid, int nb) {
    const float* lw = p.in[I_GLNW]; const float* lb = p.in[I_GLNB];
    const int tid_ = otid(), lane = tid_ & 63, wv = tid_ >> 6;
    for (int row = bid * 8 + wv; row < NTOK; row += nb * 8) {
        const bf16* vr = Z + (size_t)row * ZLD + 512;
        float v[8]; float s = 0.f;
#pragma unroll
        for (int j = 0; j < 8; ++j) { v[j] = bf2f(vr[lane + 64 * j]); s += v[j]; }
        const float m = wave_sum(s) * (1.0f / 512.f); float q = 0.f;
#pragma unroll
        for (int j = 0; j < 8; ++j) { const float d = v[j] - m; q += d * d; }
        const float rs = rsqrtf(wave_sum(q) * (1.0f / 512.f) + 1e-5f);
#pragma unroll
        for (int j = 0; j < 8; ++j) { const int c = lane + 64 * j; vln[(size_t)row * 512 + c] = (v[j] - m) * rs * lw[c] + lb[c]; }
    }
}
__device__ __forceinline__ void gold_gmlp_mix(PRef p, const bf16* Z, const float* vln, float* ycat, int bid, int nb) {
    const float* wsp = p.in[I_GWS]; const float* bsp = p.in[I_GBS];
    for (int t = bid; t < NTOK; t += nb) {
        const int c = otid(), h = c >> 6, tl = t & 127, t0 = t - tl;
        const float* wrow = wsp + ((size_t)h * CHUNK + tl) * CHUNK;
        float s = 0.f;
        for (int ss = 0; ss <= tl; ++ss) s = fmaf(wrow[ss], vln[(size_t)(t0 + ss) * 512 + c], s);
        s += bsp[h * CHUNK + tl];
        ycat[(size_t)t * 1024 + c] = bf2f(Z[(size_t)t * ZLD + c]) * s;
    }
}
constexpr int NPT = 8192;
__device__ __forceinline__ void gold_rwkv_prep(PRef p, float* lds, const bf16* Z, float* SC, float* RKo, int part, int bid, int nb) {
    constexpr size_t AS = (size_t)NPT * 512;
    float *Ro = SC, *Wo = SC + AS, *Ko = SC + 2 * AS, *Vo = SC + 3 * AS, *Ao = SC + 4 * AS, *Bo = SC + 5 * AS, *Go = SC + 6 * AS;
    const float* mu = p.in[I_MU];
    float* zs = lds;
    const int c = otid(), lane = c & 63, h = c >> 6;
    for (int tl = bid; tl < NPT; tl += nb) {
        const int t = part * NPT + tl;
        __syncthreads();
        for (int j = c; j < RPROJ; j += NTHR) {
            const float cur = bf2f(Z[(size_t)t * ZLD + 1024 + j]);
            const float prev = (t % SEQ == 0) ? 0.f : bf2f(Z[(size_t)(t - 1) * ZLD + 1024 + j]);
            float z = cur + (prev - cur) * mu[j];
            if (j >= 1536 && j < 1568) z = tanhf(z);
            if (j >= 1600) z = sigmoidf_(z);
            zs[j] = z;
        }
        __syncthreads();
        const float r = zs[c], k = zs[512 + c], v = zs[1024 + c];
        float dw = 0.f, da = 0.f, g = 0.f;
#pragma unroll 4
        for (int j = 0; j < 32; ++j) dw = fmaf(zs[1536 + j], p.in[I_W2][j * 512 + c], dw);
#pragma unroll 4
        for (int j = 0; j < 32; ++j) da = fmaf(zs[1568 + j], p.in[I_A2][j * 512 + c], da);
#pragma unroll 4
        for (int j = 0; j < 96; ++j) g = fmaf(zs[1600 + j], p.in[I_G2][j * 512 + c], g);
        const float wlog = -softplusf_(-(p.in[I_W0][c] + dw)) - 0.5f;
        const float decay = expf(-expf(wlog));
        const float asig = sigmoidf_(p.in[I_A0][c] + da);
        const float kkv = k * p.in[I_KK][c];
        const float nrm = sqrtf(wave_sum(kkv * kkv));
        const float kk = kkv / fmaxf(nrm, 1e-12f);
        const float k2 = k * (1.0f + (asig - 1.0f) * p.in[I_KA][c]);
        const float rk = wave_sum(r * k2 * p.in[I_RK][c]);
        const size_t o = (size_t)tl * 512 + c;
        Ro[o] = r; Wo[o] = decay; Ko[o] = k2; Vo[o] = v; Ao[o] = -kk; Bo[o] = kk * asig; Go[o] = g;
        if (lane == 0) RKo[tl * 8 + h] = rk;
    }
}
__device__ __forceinline__ void gold_rwkv_prep_lo(PRef p, float* lds, const bf16* Z, const bf16* LO, float* SC, float* RKo, int part, int bid, int nb) {
    constexpr size_t AS = (size_t)NPT * 512;
    float *Ro = SC, *Wo = SC + AS, *Ko = SC + 2 * AS, *Vo = SC + 3 * AS, *Ao = SC + 4 * AS, *Bo = SC + 5 * AS, *Go = SC + 6 * AS;
    const float* mu = p.in[I_MU];
    const int c = otid(), lane = c & 63, h = c >> 6;
    for (int tl = bid; tl < NPT; tl += nb) {
        const int t = part * NPT + tl;
        float z3[3];
#pragma unroll
        for (int q = 0; q < 3; ++q) { const int j = q * 512 + c;
            const float cur = bf2f(Z[(size_t)t * ZLD + 1024 + j]);
            const float prev = (t % SEQ == 0) ? 0.f : bf2f(Z[(size_t)(t - 1) * ZLD + 1024 + j]);
            z3[q] = cur + (prev - cur) * mu[j]; }
        const float r = z3[0], k = z3[1], v = z3[2];
        const float decay = expf(bf2f(LO[(size_t)t * 1536 + c]));
        const float asig = bf2f(LO[(size_t)t * 1536 + 512 + c]);
        const float g = bf2f(LO[(size_t)t * 1536 + 1024 + c]);
        const float kkv = k * p.in[I_KK][c];
        const float nrm = sqrtf(wave_sum(kkv * kkv));
        const float kk = kkv / fmaxf(nrm, 1e-12f);
        const float k2 = k * (1.0f + (asig - 1.0f) * p.in[I_KA][c]);
        const float rk = wave_sum(r * k2 * p.in[I_RK][c]);
        const size_t o = (size_t)tl * 512 + c;
        Ro[o] = r; Wo[o] = decay; Ko[o] = k2; Vo[o] = v; Ao[o] = -kk; Bo[o] = kk * asig; Go[o] = g;
        if (lane == 0) RKo[tl * 8 + h] = rk;
    }
}
template <class YT>
__device__ __forceinline__ void gold_rwkv_scan(PRef p, float* lds, const float* SC, const float* RKi, YT* ycat, int part, int bid, int nb) {
    constexpr size_t AS = (size_t)NPT * 512;
    const float *Ri = SC, *Wi = SC + AS, *Ki = SC + 2 * AS, *Vi = SC + 3 * AS, *Ai = SC + 4 * AS, *Bi = SC + 5 * AS, *Gi = SC + 6 * AS;
    constexpr int TS = 16;
    float* vec = lds;
    float* vb = lds + 5 * TS * 64;
    float* yb = vb + TS * 64;
    const int tid = otid(), lane = tid & 63, wv = tid >> 6;
    for (int item = bid; item < (NPT / SEQ) * 8; item += nb) {
        const int bl = item >> 3, h = item & 7;
        float S[64];
#pragma unroll
        for (int k = 0; k < 64; ++k) S[k] = 0.f;
        for (int c0 = 0; c0 < SEQ; c0 += TS) {
            __syncthreads();
            for (int i = tid; i < 6 * TS * 64; i += NTHR) {
                const int arr = i / (TS * 64), rem = i % (TS * 64), s = rem >> 6, d = rem & 63;
                const size_t src = ((size_t)(bl * SEQ + c0 + s)) * 512 + h * 64 + d;
                const float* ap = arr == 0 ? Ri : arr == 1 ? Wi : arr == 2 ? Ki : arr == 3 ? Ai : arr == 4 ? Bi : Vi;
                const float val = ap[src];
                if (arr < 5) vec[(arr * TS + s) * 64 + d] = val; else vb[s * 64 + d] = val;
            }
            __syncthreads();
            if (wv == 0) {
                for (int s = 0; s < TS; ++s) {
                    const float* rr = vec + (0 * TS + s) * 64; const float* ww = vec + (1 * TS + s) * 64; const float* kk = vec + (2 * TS + s) * 64;
                    const float* aa = vec + (3 * TS + s) * 64; const float* bb = vec + (4 * TS + s) * 64;
                    const float vv = vb[s * 64 + lane];
                    float sa = 0.f;
#pragma unroll
                    for (int k = 0; k < 64; ++k) sa = fmaf(S[k], aa[k], sa);
                    float y = 0.f;
#pragma unroll
                    for (int k = 0; k < 64; ++k) { S[k] = fmaf(S[k], ww[k], fmaf(sa, bb[k], vv * kk[k])); y = fmaf(S[k], rr[k], y); }
                    yb[s * 64 + lane] = y;
                }
            }
            __syncthreads();
            for (int s = wv; s < TS; s += 8) {
                const int tl = bl * SEQ + c0 + s; const int t = part * NPT + tl; const int c = h * 64 + lane;
                const float y = yb[s * 64 + lane];
                const float m = wave_sum(y) * (1.0f / 64.f); const float dlt = y - m;
                const float var = wave_sum(dlt * dlt) * (1.0f / 64.f);
                float o = dlt * rsqrtf(var + 64e-5f) * p.in[I_GNW][c] + p.in[I_GNB][c];
                o += RKi[tl * 8 + h] * Vi[(size_t)tl * 512 + c];
                o *= Gi[(size_t)tl * 512 + c];
                if (sizeof(YT) == 2) ((bf16*)ycat)[(size_t)t * 1024 + 512 + c] = (bf16)f2bf(o); else ((float*)ycat)[(size_t)t * 1024 + 512 + c] = o;
            }
        }
    }
}
struct GEpiOutproj {
    const float* x; const float* mod; float* x1;
    __device__ __forceinline__ void operator()(int row, int col, float v) const {
        const int b = row / SEQ;
        x1[(size_t)row * D + col] = x[(size_t)row * D + col] + mod[b * 6 * D + 2 * D + col] * v;
    }
};
__device__ __forceinline__ void gold_norm2_route(PRef p, float* lds, const float* x1, float* h2, int bid, int nb) {
    const float* mod = (const float*)(p.ws + W_MOD);
    int* toke = (int*)(p.ws + T_TOKE); float* tokw = (float*)(p.ws + T_TOKW); int* cnt = (int*)(p.ws + T_CTL);
    const float* g = p.in[I_N2G]; const float* rgw = p.in[I_RGW]; const float* rew = p.in[I_REW];
    const int tid_ = otid(), lane = tid_ & 63, wv = tid_ >> 6;
    for (int row = bid * 8 + wv; row < NTOK; row += nb * 8) {
        const int b = row / SEQ;
        const float* xr = x1 + (size_t)row * D;
        float s = 0.f;
#pragma unroll 4
        for (int j = 0; j < 16; ++j) { const float xv = xr[lane + 64 * j]; s += xv * xv; }
        const float r = rsqrtf(wave_sum(s) * (1.0f / D) + 1e-6f);
        const float* sh = mod + b * 6 * D + 3 * D; const float* sc = mod + b * 6 * D + 4 * D;
        float lg[36];
#pragma unroll
        for (int j = 0; j < 36; ++j) lg[j] = 0.f;
#pragma unroll 1
        for (int j = 0; j < 16; ++j) {
            const int c = lane + 64 * j;
            const float hv = xr[c] * r * g[c] * (1.0f + sc[c]) + sh[c];
            h2[(size_t)row * D + c] = hv;
#pragma unroll
            for (int q = 0; q < 4; ++q) lg[q] = fmaf(hv, rgw[c * 4 + q], lg[q]);
#pragma unroll
            for (int q = 0; q < 32; ++q) lg[4 + q] = fmaf(hv, rew[c * 32 + q], lg[4 + q]);
        }
#pragma unroll
        for (int j = 0; j < 36; ++j) lg[j] = wave_sum(lg[j]);
        float* wl = lds + wv * 64;
        if (lane == 0) {
#pragma unroll
            for (int j = 0; j < 36; ++j) wl[j] = lg[j];
            float gm = -1e30f; int gi = 0;
            for (int q = 0; q < 4; ++q) { const float t = wl[q] + p.in[I_RGB][q]; if (t > gm) { gm = t; gi = q; } }
            float gs = 0.f; for (int q = 0; q < 4; ++q) gs += expf(wl[q] + p.in[I_RGB][q] - gm);
            const float gp = 1.0f / gs;
            float* el = wl + 40;
            for (int q = 0; q < 8; ++q) el[q] = wl[4 + gi * 8 + q] + p.in[I_REB][gi * 8 + q];
            int i0 = 0; for (int q = 1; q < 8; ++q) if (el[q] > el[i0]) i0 = q;
            int i1 = (i0 == 0) ? 1 : 0; for (int q = 0; q < 8; ++q) if (q != i0 && el[q] > el[i1]) i1 = q;
            const float em = el[i0];
            const float p0 = 1.0f, p1 = expf(el[i1] - em);
            const float w0 = gp * p0 / (p0 + p1), w1 = gp * p1 / (p0 + p1);
            const int e0 = gi * 8 + i0, e1 = gi * 8 + i1;
            toke[row * 2] = e0; toke[row * 2 + 1] = e1; tokw[row * 2] = w0; tokw[row * 2 + 1] = w1;
            atomicAdd(&cnt[e0], 1); atomicAdd(&cnt[e1], 1);
        }
    }
}
__device__ __forceinline__ void gold_moe_init(PRef p, int bid, int nb) {
    int* rowtok = (int*)(p.ws + T_ROWTOK); int* rowaid = (int*)(p.ws + T_ROWAID); float* roww = (float*)(p.ws + T_ROWW); int* tilee = (int*)(p.ws + T_TILEE);
    const int* cnt = (const int*)(p.ws + T_CTL);
    for (int i = bid * NTHR + otid(); i < PROWS_G; i += nb * NTHR) { rowtok[i] = -1; rowaid[i] = -1; roww[i] = 0.f; }
    if (bid == 0 && otid() == 0) {
        int t = 0;
        for (int e = 0; e < NE; ++e) { const int nt = (cnt[e] + GT - 1) / GT; for (int j = 0; j < nt; ++j) tilee[t++] = e; }
        for (; t < PTILES_G; ++t) tilee[t] = -1;
    }
}
__device__ __forceinline__ void gold_moe_place(PRef p, int bid, int nb) {
    int* rowtok = (int*)(p.ws + T_ROWTOK); int* rowaid = (int*)(p.ws + T_ROWAID); float* roww = (float*)(p.ws + T_ROWW);
    const int* cnt = (const int*)(p.ws + T_CTL); int* cursor = (int*)(p.ws + T_CTL + 128);
    const int* toke = (const int*)(p.ws + T_TOKE); const float* tokw = (const float*)(p.ws + T_TOKW);
    for (int a = bid * NTHR + otid(); a < NTOK * 2; a += nb * NTHR) {
        const int e = toke[a];
        int start = 0; for (int q = 0; q < e; ++q) start += (cnt[q] + GT - 1) / GT * GT;
        const int pos = start + atomicAdd(&cursor[e], 1);
        rowtok[pos] = a >> 1; rowaid[pos] = a; roww[pos] = tokw[a];
    }
}
struct GEpiGate { float* hb; __device__ __forceinline__ void operator()(int row, int col, float v) const { hb[(size_t)row * EH + col] = v; } };
struct GEpiUp { float* hb; __device__ __forceinline__ void operator()(int row, int col, float v) const { const float g = hb[(size_t)row * EH + col]; hb[(size_t)row * EH + col] = g / (1.0f + expf(-g)) * v; } };
struct GEpiDown {
    const int* rowaid; const float* roww; float* y0; float* y1;
    __device__ __forceinline__ void operator()(int row, int col, float v) const {
        const int a = rowaid[row]; if (a < 0) return;
        float* y = (a & 1) ? y1 : y0;
        y[(size_t)(a >> 1) * D + col] = roww[row] * v;
    }
};
__device__ __forceinline__ void gold_final(PRef p, const float* x1, const float* y0, const float* y1, int bid, int nb) {
    const float* mod = (const float*)(p.ws + W_MOD);
    float* out = p.out; const float* g = p.in[I_FNG];
    const int tid_ = otid(), lane = tid_ & 63, wv = tid_ >> 6;
    for (int row = bid * 8 + wv; row < NTOK; row += nb * 8) {
        const int b = row / SEQ; const float* gt = mod + b * 6 * D + 5 * D;
        float v[16]; float s = 0.f;
#pragma unroll
        for (int j = 0; j < 16; ++j) { const int c = lane + 64 * j; const size_t o = (size_t)row * D + c; v[j] = x1[o] + gt[c] * (y0[o] + y1[o]); s += v[j] * v[j]; }
        const float r = rsqrtf(wave_sum(s) * (1.0f / D) + 1e-6f);
#pragma unroll
        for (int j = 0; j < 16; ++j) { const int c = lane + 64 * j; out[(size_t)row * D + c] = v[j] * r * g[c]; }
    }
}
__device__ __forceinline__ void p0_transpose_item(const float* __restrict__ W, int K, int N, bf16* WT, long row_off, LAS float* scr, int item, int lane) {
    const int nblk = N / 32, kb = item / nblk, nb = item % nblk, k0 = 64 * kb, n0 = 32 * nb;
#pragma unroll 8
    for (int i = 0; i < 32; ++i) { const int kk = 2 * i + (lane >> 5); scr[kk * 33 + (lane & 31)] = W[(size_t)(k0 + kk) * N + n0 + (lane & 31)]; }
    asm volatile("s_waitcnt lgkmcnt(0)" ::: "memory");
    const int c = lane & 7;
#pragma unroll
    for (int j = 0; j < 4; ++j) { const int n = (lane >> 3) + 8 * j; const LAS float* s = scr + (8 * c) * 33 + n;
        u32x4 o; o.x = pk2(s[0 * 33], s[1 * 33]); o.y = pk2(s[2 * 33], s[3 * 33]); o.z = pk2(s[4 * 33], s[5 * 33]); o.w = pk2(s[6 * 33], s[7 * 33]);
        *(u32x4*)(WT + (size_t)(row_off + n0 + n) * K + k0 + 8 * c) = o; }
    asm volatile("s_waitcnt lgkmcnt(0)" ::: "memory");
}
__device__ __forceinline__ void p0_mod_item(PRef p, LAS float* red, int item) {
    const int tid = otid(), col = tid & 63, ks = __builtin_amdgcn_readfirstlane(tid >> 6), n = item * 64 + col;
    const float* __restrict__ c = p.in[I_C]; const float* __restrict__ w = p.in[I_ADAW];
    float acc[8];
#pragma unroll
    for (int b = 0; b < 8; ++b) acc[b] = 0.f;
#pragma unroll 4
    for (int k = ks * 128; k < ks * 128 + 128; ++k) {
        const float wv = w[(size_t)k * (6 * D) + n];
#pragma unroll
        for (int b = 0; b < 8; ++b) acc[b] = fmaf(c[b * D + k], wv, acc[b]);
    }
#pragma unroll
    for (int b = 0; b < 8; ++b) red[(ks * 8 + b) * 64 + col] = acc[b];
    __syncthreads();
    { const int b = tid >> 6; float s = 0.f;
#pragma unroll
      for (int q = 0; q < 8; ++q) s += red[(q * 8 + b) * 64 + col];
      ((float*)(p.ws + W_MOD))[b * 6 * D + n] = s + p.in[I_ADAB][n]; }
    __syncthreads();
}
template <bool WITH_MOE>
__device__ __forceinline__ void p0_prep(PRef p, LAS unsigned char* lds, int bid, int nb) {
    const int tid = otid(), lane = tid & 63, wave = __builtin_amdgcn_readfirstlane(tid >> 6);
    for (int it = bid; it < 96; it += nb) p0_mod_item(p, (LAS float*)lds, it);
    { bf16* lt = (bf16*)(p.ws + W_LORAT);
      for (int i = bid * NTHR + tid; i < 1536 * 256; i += nb * NTHR) { const int n = i >> 8, k = i & 255; float v = 0.f;
          if (n < 512) { if (k < 32) v = p.in[I_W2][k * 512 + n]; }
          else if (n < 1024) { if (k >= 32 && k < 64) v = p.in[I_A2][(k - 32) * 512 + (n - 512)]; }
          else { if (k >= 64 && k < 160) v = p.in[I_G2][(k - 64) * 512 + (n - 1024)]; }
          lt[i] = (bf16)f2bf(v); }
      bf16* wc = (bf16*)(p.ws + W_WC);
      for (int i = bid * NTHR + tid; i < 8 * 128 * 128; i += nb * NTHR) { const int s = i & 127, t = (i >> 7) & 127; wc[i] = (s <= t) ? (bf16)f2bf(p.in[I_GWS][i]) : (bf16)0; }
      bf16* wpad = (bf16*)(p.ws + W_WINT) + (size_t)INW * D;
      for (int i = bid * NTHR + tid; i < (ZLD - INW) * D; i += nb * NTHR) wpad[i] = 0; }
    LAS float* scr = (LAS float*)(lds + wave * 16384);
    const int gw = bid * 8 + wave, NGW = nb * 8;
    constexpr int I_IN = (D / 64) * (INW / 32), I_OUT = (D / 64) * (D / 32), I_GU = (D / 64) * (EH / 32), I_DN = (EH / 64) * (D / 32);
    constexpr int NIT = I_IN + I_OUT + (WITH_MOE ? NE * (2 * I_GU + I_DN) : 0);
    for (int it = gw; it < NIT; it += NGW) {
        int r = it;
        if (r < I_IN) { p0_transpose_item(p.in[I_WIN], D, INW, (bf16*)(p.ws + W_WINT), 0, scr, r, lane); continue; } r -= I_IN;
        if (r < I_OUT) { p0_transpose_item(p.in[I_WOUT], D, D, (bf16*)(p.ws + W_WOUTT), 0, scr, r, lane); continue; } r -= I_OUT;
        if (WITH_MOE) {
            const int e = r / (2 * I_GU + I_DN); r -= e * (2 * I_GU + I_DN);
            if (r < 2 * I_GU) {
                const int up = r >= I_GU; if (up) r -= I_GU;
                const int nbk = r % (EH / 32), hb = nbk * 32;
                const long row_off = (long)e * 1024 + (hb / 128) * 256 + up * 128 + (hb % 128) - hb;
                p0_transpose_item((up ? p.in[I_WU] : p.in[I_WG]) + (size_t)e * D * EH, D, EH, (bf16*)(p.ws + W_WGUT), row_off, scr, r, lane);
            } else { r -= 2 * I_GU;
                p0_transpose_item(p.in[I_WD] + (size_t)e * EH * D, EH, D, (bf16*)(p.ws + W_WDT), (long)e * 1024, scr, r, lane); }
        }
    }
}
__device__ __forceinline__ void p1_h1(PRef p, int bid, int nb) {
    const float* __restrict__ x = p.in[I_X]; const float* __restrict__ g = p.in[I_N1G]; const float* mod = (const float*)(p.ws + W_MOD);
    bf16* H1 = (bf16*)(p.ws + W_H1);
    const int tid_ = otid(), lane = tid_ & 63, wv = tid_ >> 6;
    for (int row = bid * 8 + wv; row < NTOK; row += nb * 8) {
        const int b = row / SEQ;
        const f32x4* xr = (const f32x4*)(x + (size_t)row * D) + lane;
        f32x4 v[4]; float s = 0.f;
#pragma unroll
        for (int j = 0; j < 4; ++j) { v[j] = xr[64 * j]; s += v[j][0] * v[j][0] + v[j][1] * v[j][1] + v[j][2] * v[j][2] + v[j][3] * v[j][3]; }
        const float r = rsqrtf(wave_sum(s) * (1.0f / D) + 1e-6f);
        const float* sh = mod + b * 6 * D; const float* sc = mod + b * 6 * D + D;
        u32x2* o = (u32x2*)(H1 + (size_t)row * D) + lane;
#pragma unroll
        for (int j = 0; j < 4; ++j) {
            const int c0 = (lane + 64 * j) * 4;
            const f32x4 gg = *(const f32x4*)(g + c0), ss = *(const f32x4*)(sc + c0), hh = *(const f32x4*)(sh + c0);
            f32x4 y;
#pragma unroll
            for (int q = 0; q < 4; ++q) y[q] = v[j][q] * r * gg[q] * (1.0f + ss[q]) + hh[q];
            u32x2 w; w.x = pk2(y[0], y[1]); w.y = pk2(y[2], y[3]);
            o[64 * j] = w;
        }
    }
}
struct EpiZ {
    static constexpr bool PERM = true, AFTER_DRAIN = false;
    bf16* Z;
    __device__ __forceinline__ void operator()(const f32x4 (&acc)[2][2][4][2], const pg8::Unit& u, int wr, int wc, int fr, int fq) const {
        const int row0 = u.pm * 256 + wr * 64 + fr, col0 = u.pn * 256 + wc * 32 + 8 * fq;
        const bool act = u.pn < 4;
#pragma unroll
        for (int ai = 0; ai < 2; ++ai)
#pragma unroll
            for (int m = 0; m < 4; ++m) { bf16* rowp = Z + (size_t)(row0 + ai * 128 + m * 16) * ZLD + col0;
#pragma unroll
                for (int bj = 0; bj < 2; ++bj) { f32x4 v0 = acc[ai][bj][m][0], v1 = acc[ai][bj][m][1];
                    if (act) {
#pragma unroll
                        for (int q = 0; q < 4; ++q) { v0[q] = gelu_fast(v0[q]); v1[q] = gelu_fast(v1[q]); } }
                    u32x4 w; w.x = pg8::cvt_pk_bf16(v0[0], v0[1]); w.y = pg8::cvt_pk_bf16(v0[2], v0[3]); w.z = pg8::cvt_pk_bf16(v1[0], v1[1]); w.w = pg8::cvt_pk_bf16(v1[2], v1[3]);
                    *(u32x4*)(rowp + bj * 128) = w; } }
    }
};
constexpr int VNT_PITCH = 272;
__device__ __forceinline__ void p3_gmlp_unit(PRef p, LAS unsigned char* lds, int chunk) {
    typedef short bf16x8 __attribute__((ext_vector_type(8)));
    const int tid = otid(), lane = tid & 63, wave = __builtin_amdgcn_readfirstlane(tid >> 6);
    const bf16* Z = (const bf16*)(p.ws + W_Z); bf16* ycat = (bf16*)(p.ws + W_YCAT);
    const int t0 = chunk * CHUNK;
    { float lw[8], lb[8];
#pragma unroll
      for (int j = 0; j < 8; ++j) { lw[j] = p.in[I_GLNW][lane + 64 * j]; lb[j] = p.in[I_GLNB][lane + 64 * j]; }
      for (int sp = 0; sp < 8; ++sp) {
          const int s = wave * 16 + sp * 2;
          const bf16* v0p = Z + (size_t)(t0 + s) * ZLD + 512 + lane; const bf16* v1p = v0p + ZLD;
          float a[8], b[8]; float sa = 0.f, sb = 0.f;
#pragma unroll
          for (int j = 0; j < 8; ++j) { a[j] = bf2f(v0p[64 * j]); b[j] = bf2f(v1p[64 * j]); sa += a[j]; sb += b[j]; }
          const float ma = wave_sum(sa) * (1.f / 512.f), mb = wave_sum(sb) * (1.f / 512.f); float qa = 0.f, qb = 0.f;
#pragma unroll
          for (int j = 0; j < 8; ++j) { a[j] -= ma; b[j] -= mb; qa += a[j] * a[j]; qb += b[j] * b[j]; }
          const float ra = rsqrtf(wave_sum(qa) * (1.f / 512.f) + 1e-5f), rb = rsqrtf(wave_sum(qb) * (1.f / 512.f) + 1e-5f);
#pragma unroll
          for (int j = 0; j < 8; ++j) { const unsigned w = pk2(a[j] * ra * lw[j] + lb[j], b[j] * rb * lw[j] + lb[j]);
              *(LAS unsigned*)(lds + (lane + 64 * j) * VNT_PITCH + s * 2) = w; }
      } }
    __syncthreads();
    const bf16* Wc = (const bf16*)(p.ws + W_WC) + (size_t)wave * CHUNK * CHUNK;
    const int fr = lane & 15, fq = lane >> 4;
    const LAS unsigned char* abase = lds + (wave * 64 + fr) * VNT_PITCH + fq * 16;
    for (int tt = 0; tt < 8; ++tt) {
        f32x4 acc[4];
#pragma unroll
        for (int dt = 0; dt < 4; ++dt) acc[dt] = (f32x4){0.f, 0.f, 0.f, 0.f};
        const int nks = ((tt * 16 + 15) >> 5) + 1;
        for (int ks = 0; ks < nks; ++ks) {
            const bf16x8 bfr = *(const bf16x8*)(Wc + (size_t)(tt * 16 + fr) * CHUNK + ks * 32 + fq * 8);
#pragma unroll
            for (int dt = 0; dt < 4; ++dt) {
                const bf16x8 afr = *(const LAS bf16x8*)(abase + dt * 16 * VNT_PITCH + ks * 64);
                acc[dt] = __builtin_amdgcn_mfma_f32_16x16x32_bf16(afr, bfr, acc[dt], 0, 0, 0);
            }
        }
        const int tl = tt * 16 + fr, t = t0 + tl;
        const float bsv = p.in[I_GBS][wave * CHUNK + tl];
#pragma unroll
        for (int dt = 0; dt < 4; ++dt) {
            const int c = wave * 64 + dt * 16 + fq * 4;
            const u32x2 uw = *(const u32x2*)(Z + (size_t)t * ZLD + c);
            u32x2 o; o.x = pk2(bflo(uw.x) * (acc[dt][0] + bsv), bfhi(uw.x) * (acc[dt][1] + bsv)); o.y = pk2(bflo(uw.y) * (acc[dt][2] + bsv), bfhi(uw.y) * (acc[dt][3] + bsv));
            *(u32x2*)(ycat + (size_t)t * 1024 + c) = o;
        }
    }
    __syncthreads();
}
struct EpiX1 {
    static constexpr bool PERM = false, AFTER_DRAIN = false;
    const float* x; const float* mod; float* x1;
    __device__ __forceinline__ void operator()(const f32x4 (&acc)[2][2][4][2], const pg8::Unit& u, int wr, int wc, int fr, int fq) const {
        const int row0 = u.pm * 256 + wr * 64 + fr, col0 = u.pn * 256 + wc * 32 + 4 * fq;
        const int b = (u.pm * 256) / SEQ;
        const float* gt = mod + b * 6 * D + 2 * D;
        f32x4 gv[2][2];
#pragma unroll
        for (int bj = 0; bj < 2; ++bj)
#pragma unroll
            for (int n = 0; n < 2; ++n) gv[bj][n] = *(const f32x4*)(gt + col0 + bj * 128 + n * 16);
#pragma unroll
        for (int ai = 0; ai < 2; ++ai)
#pragma unroll
            for (int m = 0; m < 4; ++m) { const size_t off = (size_t)(row0 + ai * 128 + m * 16) * D + col0;
#pragma unroll
                for (int bj = 0; bj < 2; ++bj)
#pragma unroll
                    for (int n = 0; n < 2; ++n) { const f32x4 xv = *(const f32x4*)(x + off + bj * 128 + n * 16);
                        *(f32x4*)(x1 + off + bj * 128 + n * 16) = xv + gv[bj][n] * acc[ai][bj][m][n]; } }
    }
};
constexpr size_t W_A2 = 112 * MiB;
constexpr size_t W_Q = 112 * MiB;
constexpr size_t W_Y2 = 144 * MiB;
constexpr size_t T_RK = W_TAB + 4 * MiB;
constexpr size_t O_M = 0, O_N = 32 * MiB, O_S = 64 * MiB, O_VL = 96 * MiB;
constexpr int SCL = 128, NCH = SEQ / SCL;

__device__ __forceinline__ float sigmoid_fast(float x) { return __builtin_amdgcn_rcpf(1.0f + __builtin_amdgcn_exp2f(-1.4426950409f * x)); }
__device__ __forceinline__ void p3_lorain(PRef p, int bid, int nb) {
    const bf16* Z = (const bf16*)(p.ws + W_Z); bf16* A2 = (bf16*)(p.ws + W_A2);
    const int tid = otid(), j = tid & 255, sub = tid >> 8;
    const float muj = (j < 160) ? p.in[I_MU][1536 + j] : 0.f;
    for (int t = bid * 2 + sub; t < NTOK; t += nb * 2) {
        float v = 0.f;
        if (j < 160) {
            const float cur = bf2f(Z[(size_t)t * ZLD + 2560 + j]);
            const float prev = (t % SEQ == 0) ? 0.f : bf2f(Z[(size_t)(t - 1) * ZLD + 2560 + j]);
            v = cur + (prev - cur) * muj;
            if (j < 32) v = tanhf(v); else if (j >= 64) v = sigmoidf_(v);
        }
        A2[(size_t)t * 256 + j] = (bf16)f2bf(v);
    }
}
struct EpiLO {
    static constexpr bool PERM = true, AFTER_DRAIN = false;
    bf16* LO; const float* w0; const float* a0;
    __device__ __forceinline__ void operator()(const f32x4 (&acc)[2][2][4][2], const pg8::Unit& u, int wr, int wc, int fr, int fq) const {
        const int row0 = u.pm * 256 + wr * 64 + fr, col0 = u.pn * 256 + wc * 32 + 8 * fq, kind = u.pn >> 1;
#pragma unroll
        for (int bj = 0; bj < 2; ++bj) {
            f32x4 bv[2];
#pragma unroll
            for (int n = 0; n < 2; ++n) { const int ch = col0 + bj * 128 + 4 * n - kind * 512;
                bv[n] = kind == 0 ? *(const f32x4*)(w0 + ch) : kind == 1 ? *(const f32x4*)(a0 + ch) : (f32x4){0.f, 0.f, 0.f, 0.f}; }
#pragma unroll
            for (int ai = 0; ai < 2; ++ai)
#pragma unroll
                for (int m = 0; m < 4; ++m) { bf16* rowp = LO + (size_t)(row0 + ai * 128 + m * 16) * 1536 + col0 + bj * 128;
                    f32x4 v0 = acc[ai][bj][m][0] + bv[0], v1 = acc[ai][bj][m][1] + bv[1];
                    if (kind < 2) { const float sc = kind == 0 ? -0.6065306597f : 1.0f;
#pragma unroll
                        for (int q = 0; q < 4; ++q) { v0[q] = sc * sigmoid_fast(v0[q]); v1[q] = sc * sigmoid_fast(v1[q]); } }
                    u32x4 w; w.x = pg8::cvt_pk_bf16(v0[0], v0[1]); w.y = pg8::cvt_pk_bf16(v0[2], v0[3]); w.z = pg8::cvt_pk_bf16(v1[0], v1[1]); w.w = pg8::cvt_pk_bf16(v1[2], v1[3]);
                    *(u32x4*)rowp = w;
                    asm volatile("" ::: "memory"); }
        }
    }
};
constexpr int SC_TS = 8;
__device__ __forceinline__ void p5a_chunk(PRef p, LAS unsigned char* lds, int q) {
    typedef float f32x2 __attribute__((ext_vector_type(2)));
    const int tid_ = otid(), lane = tid_ & 63, wave = __builtin_amdgcn_readfirstlane(tid_ >> 6);
    const int seq = q / NCH, c = q % NCH, b = seq >> 3, h = seq & 7;
    const int tb = b * SEQ + c * SCL, hc = h * 64 + lane;
    const bf16* Z = (const bf16*)(p.ws + W_Z); const bf16* LO = (const bf16*)(p.ws + W_LO);
    bf16* Qo = (bf16*)(p.ws + W_Q); bf16* Y2o = (bf16*)(p.ws + W_Y2); bf16* VLo = (bf16*)((unsigned char*)p.out + O_VL); float* RKo = (float*)(p.ws + T_RK);
    LAS float* vec = (LAS float*)(lds + wave * (SC_TS * 6 * 256));
    const float mur = p.in[I_MU][hc], muk = p.in[I_MU][512 + hc], muv = p.in[I_MU][1024 + hc];
    const float kkc = p.in[I_KK][hc], kac = p.in[I_KA][hc], rkc = p.in[I_RK][hc];
    float rp = 0.f, kp = 0.f, vp = 0.f;
    if (c != 0) { const bf16* zp = Z + (size_t)(tb - 1) * ZLD + 1024 + hc; rp = bf2f(zp[0]); kp = bf2f(zp[512]); vp = bf2f(zp[1024]); }
    f32x2 Mr[32], Nr[32];
#pragma unroll
    for (int k = 0; k < 32; ++k) { Mr[k] = (f32x2){(2 * k == lane) ? 1.f : 0.f, (2 * k + 1 == lane) ? 1.f : 0.f}; Nr[k] = (f32x2){0.f, 0.f}; }
    for (int sb = 0; sb < SCL / SC_TS; ++sb) {
        const int t0 = tb + sb * SC_TS;
#pragma unroll 1
        for (int sg = 0; sg < SC_TS; sg += 4) { float zr[4], zk[4], zv[4], lw[4], as[4];
          const bf16* zp0 = Z + (unsigned)((t0 + sg) * ZLD + 1024 + hc); const bf16* lp0 = LO + (unsigned)((t0 + sg) * 1536 + hc);
#pragma unroll
          for (int s = 0; s < 4; ++s) { const bf16* zp = zp0 + s * ZLD; const bf16* lp = lp0 + s * 1536;
              zr[s] = bf2f(zp[0]); zk[s] = bf2f(zp[512]); zv[s] = bf2f(zp[1024]); lw[s] = bf2f(lp[0]); as[s] = bf2f(lp[512]); }
#pragma unroll
          for (int s = 0; s < 4; ++s) {
              const float r = zr[s] + (rp - zr[s]) * mur, k = zk[s] + (kp - zk[s]) * muk, v = zv[s] + (vp - zv[s]) * muv;
              rp = zr[s]; kp = zk[s]; vp = zv[s];
              const float kkv = k * kkc;
              const float nrm = sqrtf(wave_sum_dpp(kkv * kkv));
              const float kk = kkv / fmaxf(nrm, 1e-12f);
              const float k2 = k * (1.0f + (as[s] - 1.0f) * kac);
              const float rk = wave_sum_dpp(r * k2 * rkc);
              LAS float* o = vec + (sg + s) * 384 + lane;
              o[0] = __builtin_amdgcn_exp2f(1.4426950409f * lw[s]); o[64] = -kk; o[128] = kk * as[s]; o[192] = k2; o[256] = r; o[320] = v;
              VLo[(unsigned)((t0 + sg + s) * 512 + hc)] = (bf16)f2bf(v);
              if (lane == 0) RKo[(unsigned)((t0 + sg + s) * 8 + h)] = rk;
          } }
        asm volatile("s_waitcnt lgkmcnt(0)" ::: "memory");
        for (int s = 0; s < SC_TS; ++s) {
            const LAS float* vs = vec + s * 384;
            const float vi = vs[320 + lane];
            f32x2 saM = {0.f, 0.f}, saN = {0.f, 0.f};
#pragma unroll
            for (int k4 = 0; k4 < 16; ++k4) { const f32x4 a4 = *(const LAS f32x4*)(vs + 64 + 4 * k4);
                const f32x2 a0 = {a4[0], a4[1]}, a1 = {a4[2], a4[3]};
                saM += Mr[2 * k4] * a0; saN += Nr[2 * k4] * a0; saM += Mr[2 * k4 + 1] * a1; saN += Nr[2 * k4 + 1] * a1;
                if ((k4 & 3) == 3) asm volatile("" ::: "memory"); }
            const float sM = saM[0] + saM[1], sN = saN[0] + saN[1];
            const f32x2 sM2 = {sM, sM}, sN2 = {sN, sN}, vi2 = {vi, vi};
            f32x2 yM = {0.f, 0.f}, yN = {0.f, 0.f};
#pragma unroll
            for (int k4 = 0; k4 < 16; ++k4) {
                const f32x4 w4 = *(const LAS f32x4*)(vs + 4 * k4), b4 = *(const LAS f32x4*)(vs + 128 + 4 * k4), k4v = *(const LAS f32x4*)(vs + 192 + 4 * k4), r4 = *(const LAS f32x4*)(vs + 256 + 4 * k4);
#pragma unroll
                for (int hh = 0; hh < 2; ++hh) {
                    const f32x2 w2 = {w4[2 * hh], w4[2 * hh + 1]}, b2 = {b4[2 * hh], b4[2 * hh + 1]}, k2 = {k4v[2 * hh], k4v[2 * hh + 1]}, r2 = {r4[2 * hh], r4[2 * hh + 1]};
                    const int kx = 2 * k4 + hh;
                    Mr[kx] = Mr[kx] * w2 + sM2 * b2;
                    Nr[kx] = Nr[kx] * w2 + (sN2 * b2 + vi2 * k2);
                    yM += Mr[kx] * r2; yN += Nr[kx] * r2;
                }
                asm volatile("" ::: "memory");
            }
            const unsigned oo = (unsigned)((t0 + s) * 512 + hc);
            Qo[oo] = (bf16)f2bf(yM[0] + yM[1]); Y2o[oo] = (bf16)f2bf(yN[0] + yN[1]);
        }
        asm volatile("s_waitcnt lgkmcnt(0)" ::: "memory");
    }
    f32x4* Mo = (f32x4*)((unsigned char*)p.out + O_M + (size_t)q * 16384 + lane * 256);
    f32x4* No = (f32x4*)((unsigned char*)p.out + O_N + (size_t)q * 16384 + lane * 256);
#pragma unroll
    for (int k4 = 0; k4 < 16; ++k4) { Mo[k4] = (f32x4){Mr[2 * k4][0], Mr[2 * k4][1], Mr[2 * k4 + 1][0], Mr[2 * k4 + 1][1]}; No[k4] = (f32x4){Nr[2 * k4][0], Nr[2 * k4][1], Nr[2 * k4 + 1][0], Nr[2 * k4 + 1][1]}; }
}
__device__ __forceinline__ void p5b_chain(PRef p, LAS unsigned char* lds, int item) {
    typedef float f32x2 __attribute__((ext_vector_type(2)));
    const int tid = otid(), r = tid >> 5, j0 = (tid & 31) * 2, seq = item >> 2, rg = item & 3;
    LAS float* Sl = (LAS float*)lds;
    LAS float* Ml = (LAS float*)(lds + 4096);
    const unsigned char* Mb = (const unsigned char*)p.out + O_M + (size_t)seq * NCH * 16384;
    const unsigned char* Nb = (const unsigned char*)p.out + O_N + (size_t)seq * NCH * 16384 + (size_t)(rg * 16 + r) * 256 + j0 * 4;
    unsigned char* Sb = (unsigned char*)p.out + O_S + (size_t)seq * NCH * 16384 + (size_t)(rg * 16 + r) * 256 + j0 * 4;
    f32x2 sreg = {0.f, 0.f};
    f32x4 m0[2], m1[2], m2[2], m3[2]; f32x2 n0, n1, n2, n3;
#define P5B_LOAD(mm, nn, cc) do { const f32x4* mp = (const f32x4*)(Mb + (size_t)(cc) * 16384) + tid; mm[0] = mp[0]; mm[1] = mp[512]; nn = *(const f32x2*)(Nb + (size_t)(cc) * 16384); } while (0)
#define P5B_STEP(mm, nn, cc) do { \
        __syncthreads(); \
        *(LAS f32x4*)(Ml + tid * 4) = mm[0]; *(LAS f32x4*)(Ml + 2048 + tid * 4) = mm[1]; *(LAS f32x2*)(Sl + r * 64 + j0) = sreg; \
        *(f32x2*)(Sb + (size_t)(cc) * 16384) = sreg; \
        f32x2 acc = nn; \
        __syncthreads(); \
        if ((cc) + 4 < NCH) P5B_LOAD(mm, nn, (cc) + 4); \
        _Pragma("unroll 16") for (int i = 0; i < 64; ++i) { const float sv = Sl[r * 64 + i]; const f32x2 mv = *(const LAS f32x2*)(Ml + i * 64 + j0); acc += (f32x2){sv, sv} * mv; } \
        sreg = acc; } while (0)
    P5B_LOAD(m0, n0, 0); P5B_LOAD(m1, n1, 1); P5B_LOAD(m2, n2, 2); P5B_LOAD(m3, n3, 3);
    for (int c = 0; c < NCH; c += 4) { P5B_STEP(m0, n0, c); P5B_STEP(m1, n1, c + 1); P5B_STEP(m2, n2, c + 2); P5B_STEP(m3, n3, c + 3); }
    __syncthreads();
#undef P5B_LOAD
#undef P5B_STEP
}
#ifndef P5C_MASK
#define P5C_MASK(c, h, tt) true
#endif
__device__ __forceinline__ void p5c_chunk(PRef p, int q) {
    typedef short bf16x8 __attribute__((ext_vector_type(8)));
    const int lane = otid() & 63, fr = lane & 15, fq = lane >> 4;
    const int seq = q / NCH, c = q % NCH, b = seq >> 3, h = seq & 7, tb = b * SEQ + c * SCL;
    const bf16* Qi = (const bf16*)(p.ws + W_Q); const bf16* Y2i = (const bf16*)(p.ws + W_Y2); const bf16* VLi = (const bf16*)((const unsigned char*)p.out + O_VL);
    const float* RKi = (const float*)(p.ws + T_RK); const bf16* LO = (const bf16*)(p.ws + W_LO); bf16* ycat = (bf16*)(p.ws + W_YCAT);
    const float* Sc = (const float*)((const unsigned char*)p.out + O_S + (size_t)q * 16384);
    bf16x8 sa[4][2];
#pragma unroll
    for (int vt = 0; vt < 4; ++vt)
#pragma unroll
        for (int ks = 0; ks < 2; ++ks) { const f32x4* sp = (const f32x4*)(Sc + (vt * 16 + fr) * 64 + ks * 32 + fq * 8); const f32x4 x0 = sp[0], x1 = sp[1];
            u32x4 w; w.x = pg8::cvt_pk_bf16(x0[0], x0[1]); w.y = pg8::cvt_pk_bf16(x0[2], x0[3]); w.z = pg8::cvt_pk_bf16(x1[0], x1[1]); w.w = pg8::cvt_pk_bf16(x1[2], x1[3]);
            sa[vt][ks] = __builtin_bit_cast(bf16x8, w); }
    f32x4 gw[4], gb[4];
#pragma unroll
    for (int vt = 0; vt < 4; ++vt) { gw[vt] = *(const f32x4*)(p.in[I_GNW] + h * 64 + vt * 16 + fq * 4); gb[vt] = *(const f32x4*)(p.in[I_GNB] + h * 64 + vt * 16 + fq * 4); }
#pragma unroll 1
    for (int tt = 0; tt < SCL / 16; ++tt) {
        const int t = tb + tt * 16 + fr;
        const unsigned tq = (unsigned)(t * 512 + h * 64);
        const bf16x8 qb0 = *(const bf16x8*)(Qi + (tq + fq * 8)), qb1 = *(const bf16x8*)(Qi + (tq + 32 + fq * 8));
        f32x4 y[4]; float s = 0.f;
#pragma unroll
        for (int vt = 0; vt < 4; ++vt) {
            const u32x2 yw = *(const u32x2*)(Y2i + (tq + vt * 16 + fq * 4));
            f32x4 a = {bflo(yw.x), bfhi(yw.x), bflo(yw.y), bfhi(yw.y)};
            a = __builtin_amdgcn_mfma_f32_16x16x32_bf16(sa[vt][0], qb0, a, 0, 0, 0);
            a = __builtin_amdgcn_mfma_f32_16x16x32_bf16(sa[vt][1], qb1, a, 0, 0, 0);
            y[vt] = a; s += (a[0] + a[1]) + (a[2] + a[3]);
        }
        s = xsum4(s);
        const float m = s * (1.f / 64.f); float qq = 0.f;
#pragma unroll
        for (int vt = 0; vt < 4; ++vt) { y[vt] = y[vt] - m; qq += (y[vt][0] * y[vt][0] + y[vt][1] * y[vt][1]) + (y[vt][2] * y[vt][2] + y[vt][3] * y[vt][3]); }
        qq = xsum4(qq);
        const float rs = rsqrtf(qq * (1.f / 64.f) + 64e-5f);
        const float rk = RKi[(unsigned)(t * 8 + h)];
#pragma unroll
        for (int vt = 0; vt < 4; ++vt) {
            const int cc = h * 64 + vt * 16 + fq * 4;
            const u32x2 vw = *(const u32x2*)(VLi + (unsigned)(t * 512 + cc)); const u32x2 gwv = *(const u32x2*)(LO + (unsigned)(t * 1536 + 1024 + cc));
            const f32x4 vv = {bflo(vw.x), bfhi(vw.x), bflo(vw.y), bfhi(vw.y)}, gg = {bflo(gwv.x), bfhi(gwv.x), bflo(gwv.y), bfhi(gwv.y)};
            const f32x4 o = (y[vt] * rs * gw[vt] + gb[vt] + vv * rk) * gg;
            u32x2 ow; ow.x = pk2(o[0], o[1]); ow.y = pk2(o[2], o[3]);
            if (P5C_MASK(c, h, tt)) *(u32x2*)(ycat + (unsigned)(t * 1024 + 512 + cc)) = ow;
        }
    }
}
constexpr size_t W_H2 = 112 * MiB;
constexpr size_t W_XS = 176 * MiB;
constexpr size_t W_HB = 320 * MiB;
constexpr size_t W_YB = 176 * MiB;
constexpr int PROWS = NTOK * 2 + NE * 256, PTILES = PROWS / 256;
constexpr size_t T_HIST = W_TAB + 3 * 1024 * 1024 + 8192;
constexpr size_t T_NT = W_TAB + 3 * 1024 * 1024 + 4096;
constexpr size_t T_BQ = W_TAB + 3 * 1024 * 1024 + 65536;
constexpr int TPW = NTOK / 256;

__device__ __forceinline__ void p1_bq(PRef p, LAS float* red, int b) {
    const int tid = otid();
    const float* sh = (const float*)(p.ws + W_MOD) + b * 6 * D + 3 * D;
    if (tid < 288) { const int q = tid % 36, part = tid / 36; float s = 0.f;
        for (int c = part * 128; c < part * 128 + 128; ++c) s = fmaf(sh[c], q < 4 ? p.in[I_RGW][c * 4 + q] : p.in[I_REW][c * 32 + q - 4], s);
        red[part * 36 + q] = s; }
    __syncthreads();
    if (tid < 36) { float s = 0.f;
#pragma unroll
        for (int k = 0; k < 8; ++k) s += red[k * 36 + tid];
        ((float*)(p.ws + T_BQ))[b * 36 + tid] = s + (tid < 4 ? p.in[I_RGB][tid] : p.in[I_REB][tid - 4]); }
    __syncthreads();
}
__device__ __forceinline__ void p7_route(PRef p, LAS unsigned char* lds, int bid) {
    const int tid = otid(), lane = tid & 63, wave = __builtin_amdgcn_readfirstlane(tid >> 6);
    const float* x1 = p.out; bf16* H2 = (bf16*)(p.ws + W_H2);
    LAS int* hist = (LAS int*)(lds + 147456);
    const int b = (bid * TPW) / SEQ;
    const float* mod = (const float*)(p.ws + W_MOD) + b * 6 * D;
    const float* n2g = p.in[I_N2G];
    for (int ch = tid; ch < 1024 * 8; ch += NTHR) { const int c = ch >> 3, i = ch & 7;
        *(LAS f32x4*)(lds + c * 128 + 16 * (i ^ ((c >> 1) & 7))) = *(const f32x4*)(p.in[I_REW] + c * 32 + i * 4); }
    for (int c = tid; c < 1024; c += NTHR) *(LAS f32x4*)(lds + 131072 + c * 16) = *(const f32x4*)(p.in[I_RGW] + c * 4);
    if (tid < 32) hist[tid] = 0;
    if (tid < 36) *(LAS float*)(lds + 147456 + 128 + 4 * tid) = ((const float*)(p.ws + T_BQ))[b * 36 + tid];
    __syncthreads();
    const int sw = (lane >> 1) & 7;
#pragma unroll 1
    for (int tp = 0; tp < TPW / 8; tp += 2) {
        const int t0 = bid * TPW + wave * (TPW / 8) + tp;
        const float* xr0 = x1 + (size_t)t0 * D; bf16* hr0 = H2 + (size_t)t0 * D;
        float acc[2][36];
#pragma unroll
        for (int u = 0; u < 2; ++u)
#pragma unroll
            for (int q = 0; q < 36; ++q) acc[u][q] = 0.f;
        float ss0 = 0.f, ss1 = 0.f;
#pragma unroll 1
        for (int j = 0; j < 16; ++j) {
            const int c = lane + 64 * j;
            const float x0 = xr0[c], x1v = xr0[D + c], gsv = n2g[c] * (1.0f + mod[4 * D + c]);
            ss0 = fmaf(x0, x0, ss0); ss1 = fmaf(x1v, x1v, ss1);
            const float a0 = x0 * gsv, a1 = x1v * gsv;
            const LAS unsigned char* rowp = lds + c * 128;
            { const f32x4 w = *(const LAS f32x4*)(lds + 131072 + c * 16);
#pragma unroll
              for (int q = 0; q < 4; ++q) { acc[0][q] = fmaf(a0, w[q], acc[0][q]); acc[1][q] = fmaf(a1, w[q], acc[1][q]); } }
#pragma unroll
            for (int i = 0; i < 8; ++i) { const f32x4 w = *(const LAS f32x4*)(rowp + 16 * (i ^ sw));
#pragma unroll
                for (int q = 0; q < 4; ++q) { acc[0][4 + 4 * i + q] = fmaf(a0, w[q], acc[0][4 + 4 * i + q]); acc[1][4 + 4 * i + q] = fmaf(a1, w[q], acc[1][4 + 4 * i + q]); } }
        }
        const float r0 = rsqrtf(wave_sum_v(ss0) * (1.0f / D) + 1e-6f), r1 = rsqrtf(wave_sum_v(ss1) * (1.0f / D) + 1e-6f);
#pragma unroll 1
        for (int j = 0; j < 16; ++j) { const int c = lane + 64 * j; const float gsv = n2g[c] * (1.0f + mod[4 * D + c]), sh = mod[3 * D + c];
            hr0[c] = (bf16)f2bf(xr0[c] * r0 * gsv + sh); hr0[D + c] = (bf16)f2bf(xr0[D + c] * r1 * gsv + sh); }
#pragma unroll
        for (int u = 0; u < 2; ++u) {
            const float r = u ? r1 : r0;
            float lg[36];
#pragma unroll
            for (int q = 0; q < 36; ++q) { lg[q] = wave_sum_v(acc[u][q]) * r; if ((q & 3) == 3) __builtin_amdgcn_sched_barrier(0); }
            unsigned bqo = 147456u + 128u; asm volatile("" : "+v"(bqo));
#pragma unroll
            for (int q = 0; q < 36; ++q) lg[q] += *(const LAS float*)(lds + bqo + 4 * q);
            int gi = 0; float gm = lg[0];
#pragma unroll
            for (int q = 1; q < 4; ++q) if (lg[q] > gm) { gm = lg[q]; gi = q; }
            float gsum = 0.f;
#pragma unroll
            for (int q = 0; q < 4; ++q) gsum += expf(lg[q] - gm);
            const float gp = 1.0f / gsum;
            float el[8];
#pragma unroll
            for (int q = 0; q < 8; ++q) el[q] = gi == 0 ? lg[4 + q] : gi == 1 ? lg[12 + q] : gi == 2 ? lg[20 + q] : lg[28 + q];
            int i0 = 0; float m0 = el[0];
#pragma unroll
            for (int q = 1; q < 8; ++q) if (el[q] > m0) { m0 = el[q]; i0 = q; }
            int i1 = -1; float m1 = -3.0e38f;
#pragma unroll
            for (int q = 0; q < 8; ++q) if (q != i0 && el[q] > m1) { m1 = el[q]; i1 = q; }
            const float p1 = expf(m1 - m0);
            const float w0 = gp / (1.0f + p1), w1 = gp * p1 / (1.0f + p1);
            if (lane == 0) { const int t = t0 + u, e0 = gi * 8 + i0, e1 = gi * 8 + i1;
                int* toke = (int*)(p.ws + T_TOKE); float* tokw = (float*)(p.ws + T_TOKW);
                toke[t * 2] = e0; toke[t * 2 + 1] = e1; tokw[t * 2] = w0; tokw[t * 2 + 1] = w1;
                __hip_atomic_fetch_add(&hist[e0], 1, __ATOMIC_RELAXED, __HIP_MEMORY_SCOPE_WORKGROUP); __hip_atomic_fetch_add(&hist[e1], 1, __ATOMIC_RELAXED, __HIP_MEMORY_SCOPE_WORKGROUP); }
        }
    }
    __syncthreads();
    if (tid < 32) ((int*)(p.ws + T_HIST))[bid * 32 + tid] = hist[tid];
    __syncthreads();
}
__device__ __forceinline__ void p8_place(PRef p, LAS unsigned char* lds, int bid) {
    const int tid = otid(), lane = tid & 63, wave = __builtin_amdgcn_readfirstlane(tid >> 6);
    LAS int* ptot = (LAS int*)lds;
    LAS int* pbef = ptot + 512;
    LAS int* base = pbef + 512;
    LAS int* lcur = base + 32;
    LAS int* posl = lcur + 32;
    LAS int* padb = posl + 256;
    const int* hist = (const int*)(p.ws + T_HIST);
    { const int e = tid & 31, part = tid >> 5; int tot = 0, bef = 0;
#pragma unroll 4
      for (int w = part * 16; w < part * 16 + 16; ++w) { const int c = hist[w * 32 + e]; tot += c; bef += (w < bid) ? c : 0; }
      ptot[part * 32 + e] = tot; pbef[part * 32 + e] = bef; }
    __syncthreads();
    if (tid < 32) { int tot = 0, bef = 0;
#pragma unroll
        for (int k = 0; k < 16; ++k) { tot += ptot[k * 32 + tid]; bef += pbef[k * 32 + tid]; }
        ptot[tid] = tot; pbef[tid] = bef; lcur[tid] = 0; }
    __syncthreads();
    if (tid == 0) { int row = 0;
        for (int e = 0; e < NE; ++e) { const int cnt = ptot[e], nt = (cnt + 255) >> 8; base[e] = row + pbef[e]; padb[e] = row + cnt; padb[32 + e] = row + nt * 256;
            if (bid == 0) { int* te = (int*)(p.ws + T_TILEE); for (int k = 0; k < nt; ++k) te[(row >> 8) + k] = e; }
            row += nt * 256; }
        if (bid == 0) *(int*)(p.ws + T_NT) = row >> 8; }
    __syncthreads();
    int* rowaid = (int*)(p.ws + T_ROWAID); float* roww = (float*)(p.ws + T_ROWW);
    if (tid < 256) { const int a = bid * 256 + tid; const int e = ((const int*)(p.ws + T_TOKE))[a];
        const int pos = base[e] + __hip_atomic_fetch_add(&lcur[e], 1, __ATOMIC_RELAXED, __HIP_MEMORY_SCOPE_WORKGROUP);
        posl[tid] = pos; rowaid[pos] = a; roww[pos] = ((const float*)(p.ws + T_TOKW))[a]; }
    if (bid < NE) for (int r = padb[bid] + tid; r < padb[32 + bid]; r += NTHR) { rowaid[r] = -1; roww[r] = 0.f; }
    __syncthreads();
    const bf16* H2 = (const bf16*)(p.ws + W_H2); bf16* XS = (bf16*)(p.ws + W_XS);
#pragma unroll 2
    for (int k = wave; k < 256; k += 8) { const int tok = (bid * 256 + k) >> 1; const int pos = posl[k];
        const u32x4* src = (const u32x4*)(H2 + (size_t)tok * D) + lane; u32x4* dst = (u32x4*)(XS + (size_t)pos * D) + lane;
        const u32x4 v0 = src[0], v1 = src[64]; dst[0] = v0; dst[64] = v1; }
    __syncthreads();
}
struct MoeOrder {
    const int* tile_e; int nM, G, c;
    __device__ __forceinline__ bool next(int i, pg8::Unit& u) const {
        const int nwg = nM * 4; const long L = (long)i * G + c; if (L >= nwg) return false;
        int wgid = (int)L; { const int q = nwg / 8, r = nwg % 8, xcd = wgid % 8, off = wgid / 8; wgid = (xcd < r ? xcd * (q + 1) : r * (q + 1) + (xcd - r) * q) + off; }
        const int nig = 8 * 4, gid = wgid / nig, fm = gid * 8, gsz = (nM - fm) < 8 ? (nM - fm) : 8;
        u.pm = fm + ((wgid % nig) % gsz); u.pn = (wgid % nig) / gsz; u.pb = tile_e[u.pm] * 4 + u.pn; return true;
    }
    __device__ __forceinline__ void a_ready(const pg8::Unit&) const {}
    __device__ __forceinline__ void done(const pg8::Unit&) const {}
};
__device__ __forceinline__ float silu_fast(float x) { return x * __builtin_amdgcn_rcpf(1.0f + __builtin_amdgcn_exp2f(-1.4426950409f * x)); }
struct EpiH {
    static constexpr bool PERM = true, AFTER_DRAIN = false;
    bf16* H;
    __device__ __forceinline__ void operator()(const f32x4 (&acc)[2][2][4][2], const pg8::Unit& u, int wr, int wc, int fr, int fq) const {
        const int row0 = u.pm * 256 + wr * 64 + fr, col0 = u.pn * 128 + wc * 32 + 8 * fq;
#pragma unroll
        for (int ai = 0; ai < 2; ++ai)
#pragma unroll
            for (int m = 0; m < 4; ++m) { const f32x4 g0 = acc[ai][0][m][0], g1 = acc[ai][0][m][1], u0 = acc[ai][1][m][0], u1 = acc[ai][1][m][1];
                f32x4 h0, h1;
#pragma unroll
                for (int q = 0; q < 4; ++q) { h0[q] = silu_fast(g0[q]) * u0[q]; h1[q] = silu_fast(g1[q]) * u1[q]; }
                u32x4 w; w.x = pg8::cvt_pk_bf16(h0[0], h0[1]); w.y = pg8::cvt_pk_bf16(h0[2], h0[3]); w.z = pg8::cvt_pk_bf16(h1[0], h1[1]); w.w = pg8::cvt_pk_bf16(h1[2], h1[3]);
                *(u32x4*)(H + (size_t)(row0 + ai * 128 + m * 16) * EH + col0) = w; }
    }
};
struct EpiY {
    static constexpr bool PERM = true, AFTER_DRAIN = false;
    bf16* YB; const int* rowaid; const float* roww;
    __device__ __forceinline__ void operator()(const f32x4 (&acc)[2][2][4][2], const pg8::Unit& u, int wr, int wc, int fr, int fq) const {
        const int row0 = u.pm * 256 + wr * 64 + fr, col0 = u.pn * 256 + wc * 32 + 8 * fq;
#pragma unroll
        for (int ai = 0; ai < 2; ++ai)
#pragma unroll
            for (int m = 0; m < 4; ++m) { const int row = row0 + ai * 128 + m * 16; const int a = rowaid[row]; const float w = roww[row];
                if (a >= 0) {
#pragma unroll
                    for (int bj = 0; bj < 2; ++bj) { const f32x4 v0 = acc[ai][bj][m][0] * w, v1 = acc[ai][bj][m][1] * w;
                        u32x4 o; o.x = pg8::cvt_pk_bf16(v0[0], v0[1]); o.y = pg8::cvt_pk_bf16(v0[2], v0[3]); o.z = pg8::cvt_pk_bf16(v1[0], v1[1]); o.w = pg8::cvt_pk_bf16(v1[2], v1[3]);
                        *(u32x4*)(YB + (size_t)a * D + col0 + bj * 128) = o; } } }
    }
};
__device__ __forceinline__ void p11_final(PRef p, int bid, int nb) {
    const int tid_ = otid(), lane = tid_ & 63, wv = tid_ >> 6;
    const float* mod = (const float*)(p.ws + W_MOD); const bf16* YB = (const bf16*)(p.ws + W_YB); float* out = p.out; const float* g = p.in[I_FNG];
#pragma unroll 1
    for (int row = bid * 8 + wv; row < NTOK; row += nb * 8) {
        const float* gt = mod + (row / SEQ) * 6 * D + 5 * D;
        f32x4 v[4]; float s = 0.f;
#pragma unroll
        for (int j = 0; j < 4; ++j) { const int c0 = (lane + 64 * j) * 4;
            const f32x4 xv = *(const f32x4*)(out + (size_t)row * D + c0), gv = *(const f32x4*)(gt + c0);
            const u32x2 a = *(const u32x2*)(YB + (size_t)(2 * row) * D + c0), b = *(const u32x2*)(YB + (size_t)(2 * row + 1) * D + c0);
            const f32x4 y = {bflo(a.x) + bflo(b.x), bfhi(a.x) + bfhi(b.x), bflo(a.y) + bflo(b.y), bfhi(a.y) + bfhi(b.y)};
            v[j] = xv + gv * y; s += (v[j][0] * v[j][0] + v[j][1] * v[j][1]) + (v[j][2] * v[j][2] + v[j][3] * v[j][3]); }
        const float r = rsqrtf(wave_sum_dpp(s) * (1.0f / D) + 1e-6f);
#pragma unroll
        for (int j = 0; j < 4; ++j) { const int c0 = (lane + 64 * j) * 4; *(f32x4*)(out + (size_t)row * D + c0) = v[j] * r * *(const f32x4*)(g + c0); }
    }
}
__global__ void __launch_bounds__(NTHR, 2) k_mega(Params p_unused) {
    extern __shared__ __attribute__((aligned(16))) unsigned char lds_raw[];
    PPtr kp = (PPtr)__builtin_amdgcn_kernarg_segment_ptr();
#define p (*opq(kp))
    cg::grid_group grid = cg::this_grid();
    const int bid = blockIdx.x, nb = gridDim.x;
    LAS unsigned char* lds = (LAS unsigned char*)lds_raw;
    p0_prep<true>(p, lds, bid, nb); grid.sync();
    p1_h1(p, bid, nb); if (bid < BATCH) p1_bq(p, (LAS float*)lds, bid); grid.sync();
    { pg8::Gemm g{(const pg8::bf16_t*)(p.ws + W_H1), (const pg8::bf16_t*)(p.ws + W_WINT), NTOK, ZLD, D}; pg8::StaticOrder S; S.init(NTOK, ZLD, nb, bid);
      EpiZ E{(bf16*)(p.ws + W_Z)};
      pg8::gemm_phase<EpiZ, pg8::StaticOrder, true, true>(lds, g, S, E); }
    grid.sync();
#pragma unroll 1
    for (int ch = bid; ch < NTOK / CHUNK; ch += nb) p3_gmlp_unit(p, lds, ch);
    p3_lorain(p, bid, nb);
    grid.sync();
    { int kop = 256; asm volatile("" : "+s"(kop));
      pg8::Gemm g{(const pg8::bf16_t*)(p.ws + W_A2), (const pg8::bf16_t*)(p.ws + W_LORAT), NTOK, 1536, kop}; pg8::StaticOrder S; S.init(NTOK, 1536, nb, bid);
      EpiLO E{(bf16*)(p.ws + W_LO), p.in[I_W0], p.in[I_A0]};
      pg8::gemm_phase<EpiLO, pg8::StaticOrder, true, true>(lds, g, S, E); }
    grid.sync();
#pragma unroll 1
    for (int q = bid * 8 + __builtin_amdgcn_readfirstlane(otid() >> 6); q < BATCH * 8 * NCH; q += nb * 8) p5a_chunk(p, lds, q);
    grid.sync();
#pragma unroll 1
    for (int it = bid; it < BATCH * 8 * 4; it += nb) p5b_chain(p, lds, it);
    grid.sync();
#pragma unroll 1
    for (int q = bid * 8 + __builtin_amdgcn_readfirstlane(otid() >> 6); q < BATCH * 8 * NCH; q += nb * 8) p5c_chunk(p, q);
    grid.sync();
    { pg8::Gemm g{(const pg8::bf16_t*)(p.ws + W_YCAT), (const pg8::bf16_t*)(p.ws + W_WOUTT), NTOK, D, D}; pg8::StaticOrder S; S.init(NTOK, D, nb, bid);
      EpiX1 E{p.in[I_X], (const float*)(p.ws + W_MOD), p.out};
      pg8::gemm_phase<EpiX1, pg8::StaticOrder, true, true>(lds, g, S, E); }
    grid.sync();
    p7_route(p, lds, bid); grid.sync();
    p8_place(p, lds, bid); grid.sync();
    { const int nM = *(const int*)(p.ws + T_NT);
      pg8::Gemm g{(const pg8::bf16_t*)(p.ws + W_XS), (const pg8::bf16_t*)(p.ws + W_WGUT), PROWS, 1024, D}; MoeOrder S{(const int*)(p.ws + T_TILEE), nM, nb, bid};
      EpiH E{(bf16*)(p.ws + W_HB)};
      pg8::gemm_phase<EpiH, MoeOrder, true, true>(lds, g, S, E); }
    grid.sync();
    { const int nM = *(const int*)(p.ws + T_NT);
      pg8::Gemm g{(const pg8::bf16_t*)(p.ws + W_HB), (const pg8::bf16_t*)(p.ws + W_WDT), PROWS, 1024, EH}; MoeOrder S{(const int*)(p.ws + T_TILEE), nM, nb, bid};
      EpiY E{(bf16*)(p.ws + W_YB), (const int*)(p.ws + T_ROWAID), (const float*)(p.ws + T_ROWW)};
      pg8::gemm_phase<EpiY, MoeOrder, true, true>(lds, g, S, E); }
    grid.sync();
    p11_final(p, bid, nb);
#undef p
}
extern "C" void kernel_launch(void* const* d_in, const int* in_sizes, int n_in, void* d_out, int out_size, void* d_ws, size_t ws_size, hipStream_t stream) {
    if (n_in != 31 || ws_size < WS_NEED || out_size != NTOK * D) { fprintf(stderr, "kernel_launch: unexpected sizes n_in %d ws %zu out %d\n", n_in, ws_size, out_size); return; }
    static int grid_blocks = 0;
    if (!grid_blocks) {
        int dev = 0, cus = 0, per_cu = 0;
        (void)hipGetDevice(&dev);
        (void)hipDeviceGetAttribute(&cus, hipDeviceAttributeMultiprocessorCount, dev);
        (void)hipFuncSetAttribute((const void*)k_mega, hipFuncAttributeMaxDynamicSharedMemorySize, LDS_BYTES);
        (void)hipOccupancyMaxActiveBlocksPerMultiprocessor(&per_cu, (const void*)k_mega, NTHR, LDS_BYTES);
        if (per_cu < 1) fprintf(stderr, "kernel_launch: occupancy query says %d blocks/CU\n", per_cu);
        grid_blocks = cus;
    }
    Params p{};
    for (int i = 0; i < 31; ++i) p.in[i] = (const float*)d_in[i];
    p.out = (float*)d_out; p.ws = (unsigned char*)d_ws;
    (void)hipMemsetAsync((char*)d_ws + T_CTL, 0, 4096, stream);
    void* args[] = {&p};
    hipError_t e = hipLaunchCooperativeKernel((void*)k_mega, dim3(grid_blocks), dim3(NTHR), args, LDS_BYTES, stream);
    if (e != hipSuccess) fprintf(stderr, "cooperative launch failed: %s (grid %d)\n", hipGetErrorString(e), grid_blocks);
}
```

```cpp
#include <hip/hip_runtime.h>
#include <hip/hip_cooperative_groups.h>
#include <cstdio>
#include <cstdint>
namespace cg = cooperative_groups;
__device__ __forceinline__ int otid() { int t = threadIdx.x; asm volatile("" : "+v"(t)); return t; }

namespace pg8 {
#define PG8_LAS __attribute__((address_space(3)))
typedef unsigned short bf16_t;
typedef short bf16x8 __attribute__((ext_vector_type(8)));
typedef float f32x4 __attribute__((ext_vector_type(4)));
typedef unsigned u32x4 __attribute__((ext_vector_type(4)));
constexpr int BM = 256, BK = 64, HALF = 128, HTB = HALF * BK * 2  , STAGE_BYTES = 8 * HTB, NXCD = 8, WGM = 8;

__host__ __device__ __forceinline__ int lds_byte(int r, int c) { const int st = (r >> 4) * 2 + (c >> 5), rr = r & 15, cc = c & 31, ob = rr * 64 + cc * 2; return st * 1024 + (ob ^ (((ob >> 9) & 1) << 5)); }
__host__ __device__ __forceinline__ void stage_rc(int b, int& R, int& C) { const int st = b / 1024, sb = b % 1024, swz = sb ^ (((sb >> 9) & 1) << 5); R = (st >> 1) * 16 + swz / 64; C = (st & 1) * 32 + (swz % 64) / 2; }
__host__ __device__ __forceinline__ int perm32(int rho) { const int n = rho >> 4, i = rho & 15; return 8 * (i >> 2) + 4 * n + (i & 3); }

struct Unit { int pm, pn, pb; };
struct Gemm { const bf16_t* A; const bf16_t* Bt; int M, N, K; };

struct StaticOrder {
    int nM, nN, nwg, G, c;
    __host__ __device__ void init(int M, int N, int G_, int c_) { nM = M / BM; nN = N / BM; nwg = nM * nN; G = G_; c = c_; }
    __host__ __device__ bool next(int i, Unit& u) const {
        const long L = (long)i * G + c; if (L >= nwg) return false;
        int wgid = (int)L; { const int q = nwg / NXCD, r = nwg % NXCD, xcd = wgid % NXCD, off = wgid / NXCD; wgid = (xcd < r ? xcd * (q + 1) : r * (q + 1) + (xcd - r) * q) + off; }
        const int nig = WGM * nN, gid = wgid / nig, fm = gid * WGM, gsz = (nM - fm) < WGM ? (nM - fm) : WGM;
        u.pm = fm + ((wgid % nig) % gsz); u.pn = (wgid % nig) / gsz; u.pb = u.pn; return true;
    }
    __device__ __forceinline__ void a_ready(const Unit&) const {}
    __device__ __forceinline__ void done(const Unit&) const {}
};

__device__ __forceinline__ unsigned cvt_pk_bf16(float lo, float hi) { unsigned r; asm volatile("v_cvt_pk_bf16_f32 %0, %1, %2" : "=v"(r) : "v"(lo), "v"(hi)); return r; }
typedef float f32x2 __attribute__((ext_vector_type(2)));
template <class Epi, class Sched, bool ALIGN_EPI = false, bool SP2 = false>
__device__ __forceinline__ void gemm_phase(PG8_LAS unsigned char* lds, const Gemm g, const Sched& S, const Epi& E) {
    const int tid = otid(), wid = __builtin_amdgcn_readfirstlane(tid >> 6), lane = tid & 63, wr = wid >> 2, wc = wid & 3, fr = lane & 15, fq = lane >> 4;
    const int K = g.K, nt = K / BK;
    unsigned voffA[2], voffB[2];
#pragma unroll
    for (int i = 0; i < 2; ++i) { int R, C; stage_rc(tid * 16 + i * 8192, R, C); const int Rb = Epi::PERM ? ((R & ~31) + perm32(R & 31)) : R;
        voffA[i] = (unsigned)(R * K + C) * 2u; voffB[i] = (unsigned)(Rb * K + C) * 2u; }
    const size_t kstep = (size_t)(BK * 2);
    const size_t hstep = (size_t)HALF * K * 2;
    const size_t tstep = 2 * hstep;
    const unsigned ldsw = (unsigned)wid * 1024u;
    const int aoff = lds_byte(wr * 64 + fr, fq * 8), boff = lds_byte(wc * 32 + fr, fq * 8);
#define PG8_SA(b, h) (((b) * 2 + (h)) * HTB)
#define PG8_SB(b, h) ((4 + (b) * 2 + (h)) * HTB)
#define PG8_STAGE(bufoff, gbase, voff) do { _Pragma("unroll") for (int _i = 0; _i < 2; ++_i) \
        __builtin_amdgcn_global_load_lds((const unsigned*)((const char*)(gbase) + (voff)[_i]), (PG8_LAS unsigned*)(lds + (bufoff) + ldsw + _i * 8192), 16, 0, 0); } while (0)
#define PG8_LDA(dst, b, h) do { _Pragma("unroll") for (int m = 0; m < 4; ++m) _Pragma("unroll") for (int k = 0; k < 2; ++k) dst[m][k] = *(const PG8_LAS bf16x8*)(lds + PG8_SA(b, h) + aoff + m * 2048 + k * 1024); } while (0)
#define PG8_LDB(dst, b, h) do { _Pragma("unroll") for (int n = 0; n < 2; ++n) _Pragma("unroll") for (int k = 0; k < 2; ++k) dst[n][k] = *(const PG8_LAS bf16x8*)(lds + PG8_SB(b, h) + boff + n * 2048 + k * 1024); } while (0)
#define PG8_MMA(ai, bj, At, Bt) do { __builtin_amdgcn_s_setprio(1); _Pragma("unroll") for (int m = 0; m < 4; ++m) _Pragma("unroll") for (int n = 0; n < 2; ++n) _Pragma("unroll") for (int k = 0; k < 2; ++k) \
        acc[ai][bj][m][n] = __builtin_amdgcn_mfma_f32_16x16x32_bf16(Bt[n][k], At[m][k], acc[ai][bj][m][n], 0, 0, 0); __builtin_amdgcn_s_setprio(0); } while (0)
#define PG8_WAIT_V(n) asm volatile("s_waitcnt vmcnt(" #n ")" ::: "memory")
#define PG8_WAIT_L(n) asm volatile("s_waitcnt lgkmcnt(" #n ")" ::: "memory")
#define PG8_BAR __builtin_amdgcn_s_barrier()
#define PG8_SCHED __builtin_amdgcn_sched_barrier(0)
    Unit cur, nxt; int ui = 0;
    if (!S.next(0, cur)) return;
    f32x4 acc[2][2][4][2];
#pragma unroll
    for (int a = 0; a < 2; ++a)
#pragma unroll
        for (int b = 0; b < 2; ++b)
#pragma unroll
            for (int m = 0; m < 4; ++m)
#pragma unroll
                for (int n = 0; n < 2; ++n) acc[a][b][m][n] = (f32x4){0.f, 0.f, 0.f, 0.f};
    bf16x8 At[4][2], B0[2][2], B1[2][2];
    const char* cA = (const char*)g.A + (size_t)cur.pm * tstep; const char* cB = (const char*)g.Bt + (size_t)cur.pb * tstep;
    S.a_ready(cur);
    if constexpr (SP2) {
        PG8_STAGE(PG8_SB(0, 0), cB, voffB); PG8_STAGE(PG8_SB(0, 1), cB + hstep, voffB); PG8_STAGE(PG8_SA(0, 0), cA, voffA); PG8_STAGE(PG8_SA(0, 1), cA + hstep, voffA);
        if (wr == 1) PG8_BAR;
        PG8_WAIT_V(2); PG8_BAR;
        PG8_STAGE(PG8_SB(1, 0), cB + kstep, voffB); PG8_STAGE(PG8_SA(1, 0), cA + kstep, voffA); PG8_STAGE(PG8_SB(1, 1), cB + hstep + kstep, voffB);
        PG8_WAIT_V(6); PG8_BAR;
    } else {
        PG8_STAGE(PG8_SB(0, 0), cB, voffB); PG8_STAGE(PG8_SA(0, 0), cA, voffA); PG8_STAGE(PG8_SB(0, 1), cB + hstep, voffB); PG8_STAGE(PG8_SA(0, 1), cA + hstep, voffA);
        if (wr == 1) PG8_BAR;
        PG8_WAIT_V(4); PG8_BAR;
        PG8_STAGE(PG8_SB(1, 0), cB + kstep, voffB); PG8_STAGE(PG8_SA(1, 0), cA + kstep, voffA); PG8_STAGE(PG8_SB(1, 1), cB + hstep + kstep, voffB);
        PG8_WAIT_V(6); PG8_BAR;
    }
    for (;;) {
        const bool has_next = S.next(ui + 1, nxt);
        const char* nA = has_next ? (const char*)g.A + (size_t)nxt.pm * tstep : cA; const char* nB = has_next ? (const char*)g.Bt + (size_t)nxt.pb * tstep : cB;
        for (int t = 0; t < nt; t += 2) {
            const bool last = (t == nt - 2);
            const char* a1 = cA + (size_t)(t + 1) * kstep;
            const char* a2 = last ? nA : cA + (size_t)(t + 2) * kstep; const char* b2 = last ? nB : cB + (size_t)(t + 2) * kstep;
            const char* a3 = a2 + kstep; const char* b3 = b2 + kstep;
            if (last && has_next) S.a_ready(nxt);
            if constexpr (SP2) {
            PG8_LDB(B0, 0, 0); PG8_LDB(B1, 0, 1); PG8_SCHED; PG8_LDA(At, 0, 0); PG8_STAGE(PG8_SA(1, 1), a1 + hstep, voffA);
            PG8_WAIT_V(8); PG8_WAIT_L(0); PG8_BAR; PG8_MMA(0, 0, At, B0); PG8_MMA(0, 1, At, B1); PG8_BAR; PG8_SCHED;
            PG8_LDA(At, 0, 1); PG8_STAGE(PG8_SB(0, 0), b2, voffB); PG8_STAGE(PG8_SB(0, 1), b2 + hstep, voffB); PG8_STAGE(PG8_SA(0, 0), a2, voffA);
            PG8_WAIT_V(8); PG8_WAIT_L(0); PG8_BAR; PG8_MMA(1, 0, At, B0); PG8_MMA(1, 1, At, B1); PG8_BAR; PG8_SCHED;
            PG8_LDB(B0, 1, 0); PG8_LDB(B1, 1, 1); PG8_SCHED; PG8_LDA(At, 1, 0); PG8_STAGE(PG8_SA(0, 1), a2 + hstep, voffA);
            PG8_WAIT_V(8); PG8_WAIT_L(0); PG8_BAR; PG8_MMA(0, 0, At, B0); PG8_MMA(0, 1, At, B1); PG8_BAR; PG8_SCHED;
            PG8_LDA(At, 1, 1); PG8_STAGE(PG8_SB(1, 0), b3, voffB); PG8_STAGE(PG8_SB(1, 1), b3 + hstep, voffB); PG8_STAGE(PG8_SA(1, 0), a3, voffA);
            PG8_WAIT_V(8); PG8_WAIT_L(0); PG8_BAR; PG8_MMA(1, 0, At, B0); PG8_MMA(1, 1, At, B1); PG8_BAR; PG8_SCHED;
            } else {
            PG8_LDB(B0, 0, 0); PG8_SCHED; PG8_LDA(At, 0, 0); PG8_STAGE(PG8_SA(1, 1), a1 + hstep, voffA);
            PG8_WAIT_L(8); PG8_BAR; PG8_WAIT_L(0); PG8_MMA(0, 0, At, B0); PG8_BAR; PG8_SCHED;
            PG8_LDB(B1, 0, 1); PG8_STAGE(PG8_SB(0, 0), b2, voffB);
            PG8_BAR; PG8_WAIT_L(0); PG8_MMA(0, 1, At, B1); PG8_BAR;
            PG8_LDA(At, 0, 1); PG8_STAGE(PG8_SA(0, 0), a2, voffA);
            PG8_BAR; PG8_WAIT_L(0); PG8_MMA(1, 0, At, B0); PG8_BAR; PG8_SCHED;
            PG8_STAGE(PG8_SB(0, 1), b2 + hstep, voffB);
            PG8_WAIT_V(6); PG8_BAR; PG8_MMA(1, 1, At, B1); PG8_BAR;
            PG8_LDB(B0, 1, 0); PG8_SCHED; PG8_LDA(At, 1, 0); PG8_STAGE(PG8_SA(0, 1), a2 + hstep, voffA);
            PG8_WAIT_L(8); PG8_BAR; PG8_WAIT_L(0); PG8_MMA(0, 0, At, B0); PG8_BAR; PG8_SCHED;
            PG8_LDB(B1, 1, 1); PG8_STAGE(PG8_SB(1, 0), b3, voffB);
            PG8_BAR; PG8_WAIT_L(0); PG8_MMA(0, 1, At, B1); PG8_BAR;
            PG8_LDA(At, 1, 1); PG8_STAGE(PG8_SA(1, 0), a3, voffA);
            PG8_BAR; PG8_WAIT_L(0); PG8_MMA(1, 0, At, B0); PG8_BAR; PG8_SCHED;
            PG8_STAGE(PG8_SB(1, 1), b3 + hstep, voffB);
            PG8_WAIT_V(6); PG8_BAR; PG8_MMA(1, 1, At, B1); PG8_BAR;
            }
        }
        if constexpr (ALIGN_EPI) { if (wr == 0) PG8_BAR; }
        if constexpr (!Epi::AFTER_DRAIN) { E(acc, cur, wr, wc, fr, fq); S.done(cur); }
        if (!has_next) break;
#pragma unroll
        for (int a = 0; a < 2; ++a)
#pragma unroll
            for (int b = 0; b < 2; ++b)
#pragma unroll
                for (int m = 0; m < 4; ++m)
#pragma unroll
                    for (int n = 0; n < 2; ++n) acc[a][b][m][n] = (f32x4){0.f, 0.f, 0.f, 0.f};
        cur = nxt; cA = nA; cB = nB; ++ui;
        if constexpr (ALIGN_EPI) { if (wr == 1) PG8_BAR; }
    }
    PG8_WAIT_V(0);
    if constexpr (!ALIGN_EPI) { if (wr == 0) PG8_BAR; }
    PG8_BAR;
    if constexpr (Epi::AFTER_DRAIN) { E.fused(acc, cur, wr, wc, fr, fq, lds, wid, lane); S.done(cur); }
#undef PG8_SA
#undef PG8_SB
#undef PG8_STAGE
#undef PG8_LDA
#undef PG8_LDB
#undef PG8_MMA
#undef PG8_WAIT_V
#undef PG8_WAIT_L
#undef PG8_BAR
#undef PG8_SCHED
}
}
constexpr int D = 1024, BATCH = 8, SEQ = 4096, NTOK = BATCH * SEQ;
constexpr int GW = 512, RW = 512, HD = 64, CHUNK = 128;
constexpr int RPROJ = 1696, INW = 2720, ZLD = 2816;
constexpr int NG = 4, EPG = 8, NE = 32, EH = 512;
constexpr int NTHR = 512;
constexpr int LDS_BYTES = 163840;

typedef float f32x16 __attribute__((ext_vector_type(16)));
typedef float f32x4 __attribute__((ext_vector_type(4)));
typedef unsigned u32x4 __attribute__((ext_vector_type(4)));
typedef unsigned u32x2 __attribute__((ext_vector_type(2)));
typedef unsigned short bf16;
#define LAS __attribute__((address_space(3)))

constexpr size_t MiB = 1u << 20;
constexpr size_t W_WINT = 0;
constexpr size_t W_WOUTT = 6 * MiB;
constexpr size_t W_LORAT = 8 * MiB;
constexpr size_t W_WC = 9 * MiB;
constexpr size_t W_MOD = 10 * MiB;
constexpr size_t W_TAB = 11 * MiB;
constexpr size_t W_WGUT = 16 * MiB;
constexpr size_t W_WDT = 80 * MiB;
constexpr size_t W_H1 = 112 * MiB;
constexpr size_t W_Z = 176 * MiB;
constexpr size_t W_YCAT = 352 * MiB;
constexpr size_t W_LO = 416 * MiB;
constexpr size_t WS_NEED = 512 * MiB;
constexpr size_t T_TOKE = W_TAB;
constexpr size_t T_TOKW = W_TAB + 512 * 1024;
constexpr size_t T_ROWTOK = W_TAB + 1024 * 1024;
constexpr size_t T_ROWAID = W_TAB + 1536 * 1024;
constexpr size_t T_ROWW = W_TAB + 2048 * 1024;
constexpr size_t T_TILEE = W_TAB + 2560 * 1024;
constexpr size_t T_CTL = W_TAB + 3072 * 1024;
constexpr size_t T_BAR = W_TAB + 3584 * 1024;

struct Params {
    const float* in[31];
    float* out;
    unsigned char* ws;
};
typedef const __attribute__((address_space(4))) Params& PRef;
typedef const __attribute__((address_space(4))) Params* PPtr;
__device__ __forceinline__ PPtr opq(PPtr k) { asm volatile("" : "+s"(k)); return k; }
enum { I_X = 0, I_C, I_ADAW, I_ADAB, I_N1G, I_WIN, I_GLNW, I_GLNB, I_GWS, I_GBS, I_MU, I_W0, I_W2, I_A0, I_A2, I_G2, I_KK, I_KA, I_RK, I_GNW, I_GNB, I_WOUT, I_N2G, I_RGW, I_RGB, I_REW, I_REB, I_WG, I_WU, I_WD, I_FNG };

__device__ __forceinline__ float wave_sum(float v) {
#pragma unroll
    for (int o = 1; o < 64; o <<= 1) v += __shfl_xor(v, o);
    return v;
}
#define DPP_ADD(v, ctrl) v += __builtin_bit_cast(float, __builtin_amdgcn_update_dpp(0, __builtin_bit_cast(int, v), ctrl, 0xf, 0xf, false))
__device__ __forceinline__ float wave_sum_dpp(float v) {
    DPP_ADD(v, 0xB1); DPP_ADD(v, 0x4E); DPP_ADD(v, 0x141); DPP_ADD(v, 0x140);
    const int iv = __builtin_bit_cast(int, v);
    const float a = __builtin_bit_cast(float, __builtin_amdgcn_readlane(iv, 0)), b = __builtin_bit_cast(float, __builtin_amdgcn_readlane(iv, 16));
    const float c = __builtin_bit_cast(float, __builtin_amdgcn_readlane(iv, 32)), d = __builtin_bit_cast(float, __builtin_amdgcn_readlane(iv, 48));
    return (a + b) + (c + d);
}
__device__ __forceinline__ float xsum4(float s) {
    s += __builtin_bit_cast(float, __builtin_amdgcn_ds_swizzle(__builtin_bit_cast(int, s), 0x401F));
    float a = s, b = s;
    asm volatile("s_nop 1\n\tv_permlane32_swap_b32 %0, %1\n\ts_nop 1" : "+v"(a), "+v"(b));
    return a + b;
}
__device__ __forceinline__ float wave_sum_v(float v) {
    DPP_ADD(v, 0xB1); DPP_ADD(v, 0x4E); DPP_ADD(v, 0x141); DPP_ADD(v, 0x140);
    return xsum4(v);
}
__device__ __forceinline__ float gelu_tanh(float x) {
    const float u = 0.7978845608028654f * (x + 0.044715f * x * x * x);
    return 0.5f * x * (1.0f + tanhf(u));
}
__device__ __forceinline__ float gelu_fast(float x) {
    const float u2 = -2.302208198f * (x + 0.044715f * x * x * x);
    return x * __builtin_amdgcn_rcpf(1.0f + __builtin_amdgcn_exp2f(u2));
}
__device__ __forceinline__ float sigmoidf_(float x) { return 1.0f / (1.0f + expf(-x)); }
__device__ __forceinline__ float softplusf_(float x) { return fmaxf(x, 0.f) + log1pf(expf(-fabsf(x))); }
__device__ __forceinline__ float bf2f(unsigned short b) { return __uint_as_float(((unsigned)b) << 16); }
__device__ __forceinline__ float bflo(unsigned w) { return __uint_as_float(w << 16); }
__device__ __forceinline__ float bfhi(unsigned w) { return __uint_as_float(w & 0xffff0000u); }
__device__ __forceinline__ unsigned f2bf(float f) { unsigned u = __float_as_uint(f); return (u + 0x7fffu + ((u >> 16) & 1u)) >> 16; }
__device__ __forceinline__ unsigned pk2(float lo, float hi) { return f2bf(lo) | (f2bf(hi) << 16); }
#define XB_TMO      128
#define XB_XCNT(j)  (256  + 64 * (j))
#define XB_XSUB(j)  (1280 + 64 * (j))
#define XB_XGEN(j)  (2304 + 64 * (j))
#define XB_TOP      3328
#define XB_TOPGEN   3392
#define XCD_BAR_WORDS 3456
#define XB_SPIN_CAP (1u << 18)

__device__ __forceinline__ unsigned xb_ld(unsigned* p)              { return __hip_atomic_load(p, __ATOMIC_RELAXED, __HIP_MEMORY_SCOPE_AGENT); }
__device__ __forceinline__ unsigned xb_add(unsigned* p, unsigned v) { return __hip_atomic_fetch_add(p, v, __ATOMIC_RELAXED, __HIP_MEMORY_SCOPE_AGENT); }
__device__ __forceinline__ unsigned xb_xcc_id() { return (unsigned)__builtin_amdgcn_s_getreg((3 << 11) | 20) & 0xFu; }
#define XB_SPIN(cond, bar) do { unsigned _sp = 0; while (cond) { __builtin_amdgcn_s_sleep(1); \
    if ((++_sp & 255u) == 0u) { if (xb_ld(&(bar)[XB_TMO])) break; if (_sp > XB_SPIN_CAP) { atomicAdd(&(bar)[XB_TMO], 1u); break; } } } } while (0)

struct XcdBarrier {
    unsigned* bar; unsigned x;
    volatile LAS unsigned* st;
};

__device__ __forceinline__ XcdBarrier xcd_barrier_post(unsigned* bar, volatile LAS unsigned* st) {
    XcdBarrier b; b.bar = bar; b.x = xb_xcc_id(); b.st = st;
    if (threadIdx.x == 0) (void)xb_add(&bar[XB_XCNT(b.x)], 1u);
    return b;
}
__device__ __forceinline__ void xcd_barrier_complete(unsigned* bar, unsigned x, unsigned& nloc, unsigned& nx) {
    const unsigned G = gridDim.x * gridDim.y * gridDim.z;
    unsigned sum, cnt, mine, sp = 0u;
    for (;;) {
        sum = 0u; cnt = 0u; mine = 0u;
#pragma unroll
        for (unsigned j = 0; j < 16; ++j) { const unsigned c = xb_ld(&bar[XB_XCNT(j)]); sum += c; cnt += (c > 0u) ? 1u : 0u; mine = (j == x) ? c : mine; }
        if (sum == G) break;
        __builtin_amdgcn_s_sleep(1);
        if ((++sp & 255u) == 0u) { if (xb_ld(&bar[XB_TMO])) break; if (sp > XB_SPIN_CAP) { atomicAdd(&bar[XB_TMO], 1u); break; } }
    }
    nloc = mine > 0u ? mine : 1u; nx = cnt > 0u ? cnt : 1u;
}

__device__ __forceinline__ void xcd_barrier(const XcdBarrier& b) {
    asm volatile("s_waitcnt vmcnt(0)" ::: "memory");
    __syncthreads();
    if (threadIdx.x == 0) {
        unsigned* bar = b.bar;
        __builtin_amdgcn_s_waitcnt(0);
        unsigned nloc = b.st[0], nx = b.st[1];
        if (nloc == 0u) { xcd_barrier_complete(bar, b.x, nloc, nx); b.st[0] = nloc; b.st[1] = nx; }
        const unsigned old = xb_add(&bar[XB_XSUB(b.x)], 1u);
        const unsigned gen = old / nloc;
        if (old + 1u == (gen + 1u) * nloc) {
            __builtin_amdgcn_fence(__ATOMIC_RELEASE, "agent");
            asm volatile("s_waitcnt vmcnt(0)" ::: "memory");
            const unsigned og = xb_add(&bar[XB_TOP], 1u);
            const unsigned tg = og / nx;
            if (og + 1u == (tg + 1u) * nx) xb_add(&bar[XB_TOPGEN], 1u);
            else XB_SPIN(xb_ld(&bar[XB_TOPGEN]) == tg, bar);
            __builtin_amdgcn_fence(__ATOMIC_ACQUIRE, "agent");
            xb_add(&bar[XB_XGEN(b.x)], 1u);
            asm volatile("s_waitcnt vmcnt(0)" ::: "memory");
        } else {
            XB_SPIN(xb_ld(&bar[XB_XGEN(b.x)]) == gen, bar);
            __builtin_amdgcn_fence(__ATOMIC_ACQUIRE, "agent");
            asm volatile("s_waitcnt vmcnt(0)" ::: "memory");
        }
    }
    __syncthreads();
}
constexpr int GT = 128;
constexpr int PROWS_G = NTOK * 2 + NE * GT;
constexpr int PTILES_G = PROWS_G / GT;
template <class Epi>
__device__ __forceinline__ void gg_gemm(float* lds, const float* __restrict__ A, int lda, const int* rowidx, const float* __restrict__ B, int ldb, size_t bstride,
                        const int* tile_expert, int M, int N, int K, const Epi& epi, int bid, int nb) {
    float* As = lds;
    float* Bs = lds + 16 * 132;
    const int tid = otid(), lane = tid & 63, wid = tid >> 6, wm = wid >> 1, wn = wid & 1;
    const int tilesN = (N + 127) / 128, tilesM = M / 128;
    for (int tile = bid; tile < tilesM * tilesN; tile += nb) {
        const int tm = tile / tilesN, tn = tile % tilesN;
        const float* Bp = B;
        if (tile_expert) { const int e = tile_expert[tm]; if (e < 0) continue; Bp = B + (size_t)e * bstride; }
        f32x16 acc0, acc1;
#pragma unroll
        for (int i = 0; i < 16; ++i) { acc0[i] = 0.f; acc1[i] = 0.f; }
        const int arow = tid >> 2, akq = (tid & 3) * 4;
        int asrc = tm * 128 + arow;
        if (rowidx) asrc = rowidx[asrc];
        const int bk = tid >> 5, bn4 = (tid & 31) * 4, bcol = tn * 128 + bn4;
        for (int k0 = 0; k0 < K; k0 += 16) {
            f32x4 av = {0.f, 0.f, 0.f, 0.f};
            if (asrc >= 0) av = *(const f32x4*)(A + (size_t)asrc * lda + k0 + akq);
            f32x4 bv = {0.f, 0.f, 0.f, 0.f};
            if (bcol < N) bv = *(const f32x4*)(Bp + (size_t)(k0 + bk) * ldb + bcol);
            __syncthreads();
            As[(akq + 0) * 132 + arow] = av[0]; As[(akq + 1) * 132 + arow] = av[1]; As[(akq + 2) * 132 + arow] = av[2]; As[(akq + 3) * 132 + arow] = av[3];
            *(f32x4*)(Bs + bk * 128 + bn4) = bv;
            __syncthreads();
#pragma unroll
            for (int kk = 0; kk < 16; kk += 2) {
                const int kr = kk + (lane >> 5);
                const float a = As[kr * 132 + wm * 32 + (lane & 31)];
                const float b0 = Bs[kr * 128 + wn * 64 + (lane & 31)];
                const float b1 = Bs[kr * 128 + wn * 64 + 32 + (lane & 31)];
                acc0 = __builtin_amdgcn_mfma_f32_32x32x2f32(a, b0, acc0, 0, 0, 0);
                acc1 = __builtin_amdgcn_mfma_f32_32x32x2f32(a, b1, acc1, 0, 0, 0);
            }
        }
#pragma unroll
        for (int r = 0; r < 16; ++r) {
            const int row = tm * 128 + wm * 32 + (r & 3) + 8 * (r >> 2) + 4 * (lane >> 5);
            const int c0 = tn * 128 + wn * 64 + (lane & 31);
            if (c0 < N) epi(row, c0, acc0[r]);
            if (c0 + 32 < N) epi(row, c0 + 32, acc1[r]);
        }
        __syncthreads();
    }
}
__device__ __forceinline__ void gold_normmod(const float* __restrict__ x, const float* __restrict__ g, const float* mod, int shift_idx, int scale_idx, float* __restrict__ out, int bid, int nb) {
    const int tid_ = otid(), lane = tid_ & 63, wv = tid_ >> 6;
    for (int row = bid * 8 + wv; row < NTOK; row += nb * 8) {
        const int b = row / SEQ;
        const f32x4* xr = (const f32x4*)(x + (size_t)row * D) + lane;
        f32x4 v[4]; float s = 0.f;
#pragma unroll
        for (int j = 0; j < 4; ++j) { v[j] = xr[64 * j]; s += v[j][0] * v[j][0] + v[j][1] * v[j][1] + v[j][2] * v[j][2] + v[j][3] * v[j][3]; }
        const float r = rsqrtf(wave_sum(s) * (1.0f / D) + 1e-6f);
        const float* sh = mod + b * 6 * D + shift_idx * D; const float* sc = mod + b * 6 * D + scale_idx * D;
        f32x4* o = (f32x4*)(out + (size_t)row * D) + lane;
#pragma unroll
        for (int j = 0; j < 4; ++j) {
            const int c0 = (lane + 64 * j) * 4; f32x4 y;
#pragma unroll
            for (int q = 0; q < 4; ++q) y[q] = v[j][q] * r * g[c0 + q] * (1.0f + sc[c0 + q]) + sh[c0 + q];
            o[64 * j] = y;
        }
    }
}
__device__ __forceinline__ void gold_gmlp_ln(PRef p, const bf16* Z, float* vln, int bid, int nb) {
    const float* lw = p.in[I_GLNW]; const float* lb = p.in[I_GLNB];
    const int tid_ = otid(), lane = tid_ & 63, wv = tid_ >> 6;
    for (int row = bid * 8 + wv; row < NTOK; row += nb * 8) {
        const bf16* vr = Z + (size_t)row * ZLD + 512;
        float v[8]; float s = 0.f;
#pragma unroll
        for (int j = 0; j < 8; ++j) { v[j] = bf2f(vr[lane + 64 * j]); s += v[j]; }
        const float m = wave_sum(s) * (1.0f / 512.f); float q = 0.f;
#pragma unroll
        for (int j = 0; j < 8; ++j) { const float d = v[j] - m; q += d * d; }
        const float rs = rsqrtf(wave_sum(q) * (1.0f / 512.f) + 1e-5f);
#pragma unroll
        for (int j = 0; j < 8; ++j) { const int c = lane + 64 * j; vln[(size_t)row * 512 + c] = (v[j] - m) * rs * lw[c] + lb[c]; }
    }
}
__device__ __forceinline__ void gold_gmlp_mix(PRef p, const bf16* Z, const float* vln, float* ycat, int bid, int nb) {
    const float* wsp = p.in[I_GWS]; const float* bsp = p.in[I_GBS];
    for (int t = bid; t < NTOK; t += nb) {
        const int c = otid(), h = c >> 6, tl = t & 127, t0 = t - tl;
        const float* wrow = wsp + ((size_t)h * CHUNK + tl) * CHUNK;
        float s = 0.f;
        for (int ss = 0; ss <= tl; ++ss) s = fmaf(wrow[ss], vln[(size_t)(t0 + ss) * 512 + c], s);
        s += bsp[h * CHUNK + tl];
        ycat[(size_t)t * 1024 + c] = bf2f(Z[(size_t)t * ZLD + c]) * s;
    }
}
constexpr int NPT = 8192;
__device__ __forceinline__ void gold_rwkv_prep(PRef p, float* lds, const bf16* Z, float* SC, float* RKo, int part, int bid, int nb) {
    constexpr size_t AS = (size_t)NPT * 512;
    float *Ro = SC, *Wo = SC + AS, *Ko = SC + 2 * AS, *Vo = SC + 3 * AS, *Ao = SC + 4 * AS, *Bo = SC + 5 * AS, *Go = SC + 6 * AS;
    const float* mu = p.in[I_MU];
    float* zs = lds;
    const int c = otid(), lane = c & 63, h = c >> 6;
    for (int tl = bid; tl < NPT; tl += nb) {
        const int t = part * NPT + tl;
        __syncthreads();
        for (int j = c; j < RPROJ; j += NTHR) {
            const float cur = bf2f(Z[(size_t)t * ZLD + 1024 + j]);
            const float prev = (t % SEQ == 0) ? 0.f : bf2f(Z[(size_t)(t - 1) * ZLD + 1024 + j]);
            float z = cur + (prev - cur) * mu[j];
            if (j >= 1536 && j < 1568) z = tanhf(z);
            if (j >= 1600) z = sigmoidf_(z);
            zs[j] = z;
        }
        __syncthreads();
        const float r = zs[c], k = zs[512 + c], v = zs[1024 + c];
        float dw = 0.f, da = 0.f, g = 0.f;
#pragma unroll 4
        for (int j = 0; j < 32; ++j) dw = fmaf(zs[1536 + j], p.in[I_W2][j * 512 + c], dw);
#pragma unroll 4
        for (int j = 0; j < 32; ++j) da = fmaf(zs[1568 + j], p.in[I_A2][j * 512 + c], da);
#pragma unroll 4
        for (int j = 0; j < 96; ++j) g = fmaf(zs[1600 + j], p.in[I_G2][j * 512 + c], g);
        const float wlog = -softplusf_(-(p.in[I_W0][c] + dw)) - 0.5f;
        const float decay = expf(-expf(wlog));
        const float asig = sigmoidf_(p.in[I_A0][c] + da);
        const float kkv = k * p.in[I_KK][c];
        const float nrm = sqrtf(wave_sum(kkv * kkv));
        const float kk = kkv / fmaxf(nrm, 1e-12f);
        const float k2 = k * (1.0f + (asig - 1.0f) * p.in[I_KA][c]);
        const float rk = wave_sum(r * k2 * p.in[I_RK][c]);
        const size_t o = (size_t)tl * 512 + c;
        Ro[o] = r; Wo[o] = decay; Ko[o] = k2; Vo[o] = v; Ao[o] = -kk; Bo[o] = kk * asig; Go[o] = g;
        if (lane == 0) RKo[tl * 8 + h] = rk;
    }
}
__device__ __forceinline__ void gold_rwkv_prep_lo(PRef p, float* lds, const bf16* Z, const bf16* LO, float* SC, float* RKo, int part, int bid, int nb) {
    constexpr size_t AS = (size_t)NPT * 512;
    float *Ro = SC, *Wo = SC + AS, *Ko = SC + 2 * AS, *Vo = SC + 3 * AS, *Ao = SC + 4 * AS, *Bo = SC + 5 * AS, *Go = SC + 6 * AS;
    const float* mu = p.in[I_MU];
    const int c = otid(), lane = c & 63, h = c >> 6;
    for (int tl = bid; tl < NPT; tl += nb) {
        const int t = part * NPT + tl;
        float z3[3];
#pragma unroll
        for (int q = 0; q < 3; ++q) { const int j = q * 512 + c;
            const float cur = bf2f(Z[(size_t)t * ZLD + 1024 + j]);
            const float prev = (t % SEQ == 0) ? 0.f : bf2f(Z[(size_t)(t - 1) * ZLD + 1024 + j]);
            z3[q] = cur + (prev - cur) * mu[j]; }
        const float r = z3[0], k = z3[1], v = z3[2];
        const float decay = expf(bf2f(LO[(size_t)t * 1536 + c]));
        const float asig = bf2f(LO[(size_t)t * 1536 + 512 + c]);
        const float g = bf2f(LO[(size_t)t * 1536 + 1024 + c]);
        const float kkv = k * p.in[I_KK][c];
        const float nrm = sqrtf(wave_sum(kkv * kkv));
        const float kk = kkv / fmaxf(nrm, 1e-12f);
        const float k2 = k * (1.0f + (asig - 1.0f) * p.in[I_KA][c]);
        const float rk = wave_sum(r * k2 * p.in[I_RK][c]);
        const size_t o = (size_t)tl * 512 + c;
        Ro[o] = r; Wo[o] = decay; Ko[o] = k2; Vo[o] = v; Ao[o] = -kk; Bo[o] = kk * asig; Go[o] = g;
        if (lane == 0) RKo[tl * 8 + h] = rk;
    }
}
template <class YT>
__device__ __forceinline__ void gold_rwkv_scan(PRef p, float* lds, const float* SC, const float* RKi, YT* ycat, int part, int bid, int nb) {
    constexpr size_t AS = (size_t)NPT * 512;
    const float *Ri = SC, *Wi = SC + AS, *Ki = SC + 2 * AS, *Vi = SC + 3 * AS, *Ai = SC + 4 * AS, *Bi = SC + 5 * AS, *Gi = SC + 6 * AS;
    constexpr int TS = 16;
    float* vec = lds;
    float* vb = lds + 5 * TS * 64;
    float* yb = vb + TS * 64;
    const int tid = otid(), lane = tid & 63, wv = tid >> 6;
    for (int item = bid; item < (NPT / SEQ) * 8; item += nb) {
        const int bl = item >> 3, h = item & 7;
        float S[64];
#pragma unroll
        for (int k = 0; k < 64; ++k) S[k] = 0.f;
        for (int c0 = 0; c0 < SEQ; c0 += TS) {
            __syncthreads();
            for (int i = tid; i < 6 * TS * 64; i += NTHR) {
                const int arr = i / (TS * 64), rem = i % (TS * 64), s = rem >> 6, d = rem & 63;
                const size_t src = ((size_t)(bl * SEQ + c0 + s)) * 512 + h * 64 + d;
                const float* ap = arr == 0 ? Ri : arr == 1 ? Wi : arr == 2 ? Ki : arr == 3 ? Ai : arr == 4 ? Bi : Vi;
                const float val = ap[src];
                if (arr < 5) vec[(arr * TS + s) * 64 + d] = val; else vb[s * 64 + d] = val;
            }
            __syncthreads();
            if (wv == 0) {
                for (int s = 0; s < TS; ++s) {
                    const float* rr = vec + (0 * TS + s) * 64; const float* ww = vec + (1 * TS + s) * 64; const float* kk = vec + (2 * TS + s) * 64;
                    const float* aa = vec + (3 * TS + s) * 64; const float* bb = vec + (4 * TS + s) * 64;
                    const float vv = vb[s * 64 + lane];
                    float sa = 0.f;
#pragma unroll
                    for (int k = 0; k < 64; ++k) sa = fmaf(S[k], aa[k], sa);
                    float y = 0.f;
#pragma unroll
                    for (int k = 0; k < 64; ++k) { S[k] = fmaf(S[k], ww[k], fmaf(sa, bb[k], vv * kk[k])); y = fmaf(S[k], rr[k], y); }
                    yb[s * 64 + lane] = y;
                }
            }
            __syncthreads();
            for (int s = wv; s < TS; s += 8) {
                const int tl = bl * SEQ + c0 + s; const int t = part * NPT + tl; const int c = h * 64 + lane;
                const float y = yb[s * 64 + lane];
                const float m = wave_sum(y) * (1.0f / 64.f); const float dlt = y - m;
                const float var = wave_sum(dlt * dlt) * (1.0f / 64.f);
                float o = dlt * rsqrtf(var + 64e-5f) * p.in[I_GNW][c] + p.in[I_GNB][c];
                o += RKi[tl * 8 + h] * Vi[(size_t)tl * 512 + c];
                o *= Gi[(size_t)tl * 512 + c];
                if (sizeof(YT) == 2) ((bf16*)ycat)[(size_t)t * 1024 + 512 + c] = (bf16)f2bf(o); else ((float*)ycat)[(size_t)t * 1024 + 512 + c] = o;
            }
        }
    }
}
struct GEpiOutproj {
    const float* x; const float* mod; float* x1;
    __device__ __forceinline__ void operator()(int row, int col, float v) const {
        const int b = row / SEQ;
        x1[(size_t)row * D + col] = x[(size_t)row * D + col] + mod[b * 6 * D + 2 * D + col] * v;
    }
};
__device__ __forceinline__ void gold_norm2_route(PRef p, float* lds, const float* x1, float* h2, int bid, int nb) {
    const float* mod = (const float*)(p.ws + W_MOD);
    int* toke = (int*)(p.ws + T_TOKE); float* tokw = (float*)(p.ws + T_TOKW); int* cnt = (int*)(p.ws + T_CTL);
    const float* g = p.in[I_N2G]; const float* rgw = p.in[I_RGW]; const float* rew = p.in[I_REW];
    const int tid_ = otid(), lane = tid_ & 63, wv = tid_ >> 6;
    for (int row = bid * 8 + wv; row < NTOK; row += nb * 8) {
        const int b = row / SEQ;
        const float* xr = x1 + (size_t)row * D;
        float s = 0.f;
#pragma unroll 4
        for (int j = 0; j < 16; ++j) { const float xv = xr[lane + 64 * j]; s += xv * xv; }
        const float r = rsqrtf(wave_sum(s) * (1.0f / D) + 1e-6f);
        const float* sh = mod + b * 6 * D + 3 * D; const float* sc = mod + b * 6 * D + 4 * D;
        float lg[36];
#pragma unroll
        for (int j = 0; j < 36; ++j) lg[j] = 0.f;
#pragma unroll 1
        for (int j = 0; j < 16; ++j) {
            const int c = lane + 64 * j;
            const float hv = xr[c] * r * g[c] * (1.0f + sc[c]) + sh[c];
            h2[(size_t)row * D + c] = hv;
#pragma unroll
            for (int q = 0; q < 4; ++q) lg[q] = fmaf(hv, rgw[c * 4 + q], lg[q]);
#pragma unroll
            for (int q = 0; q < 32; ++q) lg[4 + q] = fmaf(hv, rew[c * 32 + q], lg[4 + q]);
        }
#pragma unroll
        for (int j = 0; j < 36; ++j) lg[j] = wave_sum(lg[j]);
        float* wl = lds + wv * 64;
        if (lane == 0) {
#pragma unroll
            for (int j = 0; j < 36; ++j) wl[j] = lg[j];
            float gm = -1e30f; int gi = 0;
            for (int q = 0; q < 4; ++q) { const float t = wl[q] + p.in[I_RGB][q]; if (t > gm) { gm = t; gi = q; } }
            float gs = 0.f; for (int q = 0; q < 4; ++q) gs += expf(wl[q] + p.in[I_RGB][q] - gm);
            const float gp = 1.0f / gs;
            float* el = wl + 40;
            for (int q = 0; q < 8; ++q) el[q] = wl[4 + gi * 8 + q] + p.in[I_REB][gi * 8 + q];
            int i0 = 0; for (int q = 1; q < 8; ++q) if (el[q] > el[i0]) i0 = q;
            int i1 = (i0 == 0) ? 1 : 0; for (int q = 0; q < 8; ++q) if (q != i0 && el[q] > el[i1]) i1 = q;
            const float em = el[i0];
            const float p0 = 1.0f, p1 = expf(el[i1] - em);
            const float w0 = gp * p0 / (p0 + p1), w1 = gp * p1 / (p0 + p1);
            const int e0 = gi * 8 + i0, e1 = gi * 8 + i1;
            toke[row * 2] = e0; toke[row * 2 + 1] = e1; tokw[row * 2] = w0; tokw[row * 2 + 1] = w1;
            atomicAdd(&cnt[e0], 1); atomicAdd(&cnt[e1], 1);
        }
    }
}
__device__ __forceinline__ void gold_moe_init(PRef p, int bid, int nb) {
    int* rowtok = (int*)(p.ws + T_ROWTOK); int* rowaid = (int*)(p.ws + T_ROWAID); float* roww = (float*)(p.ws + T_ROWW); int* tilee = (int*)(p.ws + T_TILEE);
    const int* cnt = (const int*)(p.ws + T_CTL);
    for (int i = bid * NTHR + otid(); i < PROWS_G; i += nb * NTHR) { rowtok[i] = -1; rowaid[i] = -1; roww[i] = 0.f; }
    if (bid == 0 && otid() == 0) {
        int t = 0;
        for (int e = 0; e < NE; ++e) { const int nt = (cnt[e] + GT - 1) / GT; for (int j = 0; j < nt; ++j) tilee[t++] = e; }
        for (; t < PTILES_G; ++t) tilee[t] = -1;
    }
}
__device__ __forceinline__ void gold_moe_place(PRef p, int bid, int nb) {
    int* rowtok = (int*)(p.ws + T_ROWTOK); int* rowaid = (int*)(p.ws + T_ROWAID); float* roww = (float*)(p.ws + T_ROWW);
    const int* cnt = (const int*)(p.ws + T_CTL); int* cursor = (int*)(p.ws + T_CTL + 128);
    const int* toke = (const int*)(p.ws + T_TOKE); const float* tokw = (const float*)(p.ws + T_TOKW);
    for (int a = bid * NTHR + otid(); a < NTOK * 2; a += nb * NTHR) {
        const int e = toke[a];
        int start = 0; for (int q = 0; q < e; ++q) start += (cnt[q] + GT - 1) / GT * GT;
        const int pos = start + atomicAdd(&cursor[e], 1);
        rowtok[pos] = a >> 1; rowaid[pos] = a; roww[pos] = tokw[a];
    }
}
struct GEpiGate { float* hb; __device__ __forceinline__ void operator()(int row, int col, float v) const { hb[(size_t)row * EH + col] = v; } };
struct GEpiUp { float* hb; __device__ __forceinline__ void operator()(int row, int col, float v) const { const float g = hb[(size_t)row * EH + col]; hb[(size_t)row * EH + col] = g / (1.0f + expf(-g)) * v; } };
struct GEpiDown {
    const int* rowaid; const float* roww; float* y0; float* y1;
    __device__ __forceinline__ void operator()(int row, int col, float v) const {
        const int a = rowaid[row]; if (a < 0) return;
        float* y = (a & 1) ? y1 : y0;
        y[(size_t)(a >> 1) * D + col] = roww[row] * v;
    }
};
__device__ __forceinline__ void gold_final(PRef p, const float* x1, const float* y0, const float* y1, int bid, int nb) {
    const float* mod = (const float*)(p.ws + W_MOD);
    float* out = p.out; const float* g = p.in[I_FNG];
    const int tid_ = otid(), lane = tid_ & 63, wv = tid_ >> 6;
    for (int row = bid * 8 + wv; row < NTOK; row += nb * 8) {
        const int b = row / SEQ; const float* gt = mod + b * 6 * D + 5 * D;
        float v[16]; float s = 0.f;
#pragma unroll
        for (int j = 0; j < 16; ++j) { const int c = lane + 64 * j; const size_t o = (size_t)row * D + c; v[j] = x1[o] + gt[c] * (y0[o] + y1[o]); s += v[j] * v[j]; }
        const float r = rsqrtf(wave_sum(s) * (1.0f / D) + 1e-6f);
#pragma unroll
        for (int j = 0; j < 16; ++j) { const int c = lane + 64 * j; out[(size_t)row * D + c] = v[j] * r * g[c]; }
    }
}
__device__ __forceinline__ void p0_transpose_item(const float* __restrict__ W, int K, int N, bf16* WT, long row_off, LAS float* scr, int item, int lane) {
    const int nblk = N / 32, kb = item / nblk, nb = item % nblk, k0 = 64 * kb, n0 = 32 * nb;
#pragma unroll 8
    for (int i = 0; i < 32; ++i) { const int kk = 2 * i + (lane >> 5); scr[kk * 33 + (lane & 31)] = W[(size_t)(k0 + kk) * N + n0 + (lane & 31)]; }
    asm volatile("s_waitcnt lgkmcnt(0)" ::: "memory");
    const int c = lane & 7;
#pragma unroll
    for (int j = 0; j < 4; ++j) { const int n = (lane >> 3) + 8 * j; const LAS float* s = scr + (8 * c) * 33 + n;
        u32x4 o; o.x = pk2(s[0 * 33], s[1 * 33]); o.y = pk2(s[2 * 33], s[3 * 33]); o.z = pk2(s[4 * 33], s[5 * 33]); o.w = pk2(s[6 * 33], s[7 * 33]);
        *(u32x4*)(WT + (size_t)(row_off + n0 + n) * K + k0 + 8 * c) = o; }
    asm volatile("s_waitcnt lgkmcnt(0)" ::: "memory");
}
__device__ __forceinline__ void p0_mod_item(PRef p, LAS float* red, int item) {
    const int tid = otid(), col = tid & 63, ks = __builtin_amdgcn_readfirstlane(tid >> 6), n = item * 64 + col;
    const float* __restrict__ c = p.in[I_C]; const float* __restrict__ w = p.in[I_ADAW];
    float acc[8];
#pragma unroll
    for (int b = 0; b < 8; ++b) acc[b] = 0.f;
#pragma unroll 4
    for (int k = ks * 128; k < ks * 128 + 128; ++k) {
        const float wv = w[(size_t)k * (6 * D) + n];
#pragma unroll
        for (int b = 0; b < 8; ++b) acc[b] = fmaf(c[b * D + k], wv, acc[b]);
    }
#pragma unroll
    for (int b = 0; b < 8; ++b) red[(ks * 8 + b) * 64 + col] = acc[b];
    __syncthreads();
    { const int b = tid >> 6; float s = 0.f;
#pragma unroll
      for (int q = 0; q < 8; ++q) s += red[(q * 8 + b) * 64 + col];
      ((float*)(p.ws + W_MOD))[b * 6 * D + n] = s + p.in[I_ADAB][n]; }
    __syncthreads();
}
template <bool WITH_MOE>
__device__ __forceinline__ void p0_prep(PRef p, LAS unsigned char* lds, int bid, int nb) {
    const int tid = otid(), lane = tid & 63, wave = __builtin_amdgcn_readfirstlane(tid >> 6);
    for (int it = bid; it < 96; it += nb) p0_mod_item(p, (LAS float*)lds, it);
    { bf16* lt = (bf16*)(p.ws + W_LORAT);
      for (int i = bid * NTHR + tid; i < 1536 * 256; i += nb * NTHR) { const int n = i >> 8, k = i & 255; float v = 0.f;
          if (n < 512) { if (k < 32) v = p.in[I_W2][k * 512 + n]; }
          else if (n < 1024) { if (k >= 32 && k < 64) v = p.in[I_A2][(k - 32) * 512 + (n - 512)]; }
          else { if (k >= 64 && k < 160) v = p.in[I_G2][(k - 64) * 512 + (n - 1024)]; }
          lt[i] = (bf16)f2bf(v); }
      bf16* wc = (bf16*)(p.ws + W_WC);
      for (int i = bid * NTHR + tid; i < 8 * 128 * 128; i += nb * NTHR) { const int s = i & 127, t = (i >> 7) & 127; wc[i] = (s <= t) ? (bf16)f2bf(p.in[I_GWS][i]) : (bf16)0; }
      bf16* wpad = (bf16*)(p.ws + W_WINT) + (size_t)INW * D;
      for (int i = bid * NTHR + tid; i < (ZLD - INW) * D; i += nb * NTHR) wpad[i] = 0; }
    LAS float* scr = (LAS float*)(lds + wave * 16384);
    const int gw = bid * 8 + wave, NGW = nb * 8;
    constexpr int I_IN = (D / 64) * (INW / 32), I_OUT = (D / 64) * (D / 32), I_GU = (D / 64) * (EH / 32), I_DN = (EH / 64) * (D / 32);
    constexpr int NIT = I_IN + I_OUT + (WITH_MOE ? NE * (2 * I_GU + I_DN) : 0);
    for (int it = gw; it < NIT; it += NGW) {
        int r = it;
        if (r < I_IN) { p0_transpose_item(p.in[I_WIN], D, INW, (bf16*)(p.ws + W_WINT), 0, scr, r, lane); continue; } r -= I_IN;
        if (r < I_OUT) { p0_transpose_item(p.in[I_WOUT], D, D, (bf16*)(p.ws + W_WOUTT), 0, scr, r, lane); continue; } r -= I_OUT;
        if (WITH_MOE) {
            const int e = r / (2 * I_GU + I_DN); r -= e * (2 * I_GU + I_DN);
            if (r < 2 * I_GU) {
                const int up = r >= I_GU; if (up) r -= I_GU;
                const int nbk = r % (EH / 32), hb = nbk * 32;
                const long row_off = (long)e * 1024 + (hb / 128) * 256 + up * 128 + (hb % 128) - hb;
                p0_transpose_item((up ? p.in[I_WU] : p.in[I_WG]) + (size_t)e * D * EH, D, EH, (bf16*)(p.ws + W_WGUT), row_off, scr, r, lane);
            } else { r -= 2 * I_GU;
                p0_transpose_item(p.in[I_WD] + (size_t)e * EH * D, EH, D, (bf16*)(p.ws + W_WDT), (long)e * 1024, scr, r, lane); }
        }
    }
}
__device__ __forceinline__ void p1_h1(PRef p, int bid, int nb) {
    const float* __restrict__ x = p.in[I_X]; const float* __restrict__ g = p.in[I_N1G]; const float* mod = (const float*)(p.ws + W_MOD);
    bf16* H1 = (bf16*)(p.ws + W_H1);
    const int tid_ = otid(), lane = tid_ & 63, wv = tid_ >> 6;
    for (int row = bid * 8 + wv; row < NTOK; row += nb * 8) {
        const int b = row / SEQ;
        const f32x4* xr = (const f32x4*)(x + (size_t)row * D) + lane;
        f32x4 v[4]; float s = 0.f;
#pragma unroll
        for (int j = 0; j < 4; ++j) { v[j] = xr[64 * j]; s += v[j][0] * v[j][0] + v[j][1] * v[j][1] + v[j][2] * v[j][2] + v[j][3] * v[j][3]; }
        const float r = rsqrtf(wave_sum(s) * (1.0f / D) + 1e-6f);
        const float* sh = mod + b * 6 * D; const float* sc = mod + b * 6 * D + D;
        u32x2* o = (u32x2*)(H1 + (size_t)row * D) + lane;
#pragma unroll
        for (int j = 0; j < 4; ++j) {
            const int c0 = (lane + 64 * j) * 4;
            const f32x4 gg = *(const f32x4*)(g + c0), ss = *(const f32x4*)(sc + c0), hh = *(const f32x4*)(sh + c0);
            f32x4 y;
#pragma unroll
            for (int q = 0; q < 4; ++q) y[q] = v[j][q] * r * gg[q] * (1.0f + ss[q]) + hh[q];
            u32x2 w; w.x = pk2(y[0], y[1]); w.y = pk2(y[2], y[3]);
            o[64 * j] = w;
        }
    }
}
struct EpiZ {
    static constexpr bool PERM = true, AFTER_DRAIN = false;
    bf16* Z;
    __device__ __forceinline__ void operator()(const f32x4 (&acc)[2][2][4][2], const pg8::Unit& u, int wr, int wc, int fr, int fq) const {
        const int row0 = u.pm * 256 + wr * 64 + fr, col0 = u.pn * 256 + wc * 32 + 8 * fq;
        const bool act = u.pn < 4;
#pragma unroll
        for (int ai = 0; ai < 2; ++ai)
#pragma unroll
            for (int m = 0; m < 4; ++m) { bf16* rowp = Z + (size_t)(row0 + ai * 128 + m * 16) * ZLD + col0;
#pragma unroll
                for (int bj = 0; bj < 2; ++bj) { f32x4 v0 = acc[ai][bj][m][0], v1 = acc[ai][bj][m][1];
                    if (act) {
#pragma unroll
                        for (int q = 0; q < 4; ++q) { v0[q] = gelu_fast(v0[q]); v1[q] = gelu_fast(v1[q]); } }
                    u32x4 w; w.x = pg8::cvt_pk_bf16(v0[0], v0[1]); w.y = pg8::cvt_pk_bf16(v0[2], v0[3]); w.z = pg8::cvt_pk_bf16(v1[0], v1[1]); w.w = pg8::cvt_pk_bf16(v1[2], v1[3]);
                    *(u32x4*)(rowp + bj * 128) = w; } }
    }
};
constexpr int VNT_PITCH = 272;
__device__ __forceinline__ void p3_gmlp_unit(PRef p, LAS unsigned char* lds, int chunk) {
    typedef short bf16x8 __attribute__((ext_vector_type(8)));
    const int tid = otid(), lane = tid & 63, wave = __builtin_amdgcn_readfirstlane(tid >> 6);
    const bf16* Z = (const bf16*)(p.ws + W_Z); bf16* ycat = (bf16*)(p.ws + W_YCAT);
    const int t0 = chunk * CHUNK;
    { float lw[8], lb[8];
#pragma unroll
      for (int j = 0; j < 8; ++j) { lw[j] = p.in[I_GLNW][lane + 64 * j]; lb[j] = p.in[I_GLNB][lane + 64 * j]; }
      for (int sp = 0; sp < 8; ++sp) {
          const int s = wave * 16 + sp * 2;
          const bf16* v0p = Z + (size_t)(t0 + s) * ZLD + 512 + lane; const bf16* v1p = v0p + ZLD;
          float a[8], b[8]; float sa = 0.f, sb = 0.f;
#pragma unroll
          for (int j = 0; j < 8; ++j) { a[j] = bf2f(v0p[64 * j]); b[j] = bf2f(v1p[64 * j]); sa += a[j]; sb += b[j]; }
          const float ma = wave_sum(sa) * (1.f / 512.f), mb = wave_sum(sb) * (1.f / 512.f); float qa = 0.f, qb = 0.f;
#pragma unroll
          for (int j = 0; j < 8; ++j) { a[j] -= ma; b[j] -= mb; qa += a[j] * a[j]; qb += b[j] * b[j]; }
          const float ra = rsqrtf(wave_sum(qa) * (1.f / 512.f) + 1e-5f), rb = rsqrtf(wave_sum(qb) * (1.f / 512.f) + 1e-5f);
#pragma unroll
          for (int j = 0; j < 8; ++j) { const unsigned w = pk2(a[j] * ra * lw[j] + lb[j], b[j] * rb * lw[j] + lb[j]);
              *(LAS unsigned*)(lds + (lane + 64 * j) * VNT_PITCH + s * 2) = w; }
      } }
    __syncthreads();
    const bf16* Wc = (const bf16*)(p.ws + W_WC) + (size_t)wave * CHUNK * CHUNK;
    const int fr = lane & 15, fq = lane >> 4;
    const LAS unsigned char* abase = lds + (wave * 64 + fr) * VNT_PITCH + fq * 16;
    for (int tt = 0; tt < 8; ++tt) {
        f32x4 acc[4];
#pragma unroll
        for (int dt = 0; dt < 4; ++dt) acc[dt] = (f32x4){0.f, 0.f, 0.f, 0.f};
        const int nks = ((tt * 16 + 15) >> 5) + 1;
        for (int ks = 0; ks < nks; ++ks) {
            const bf16x8 bfr = *(const bf16x8*)(Wc + (size_t)(tt * 16 + fr) * CHUNK + ks * 32 + fq * 8);
#pragma unroll
            for (int dt = 0; dt < 4; ++dt) {
                const bf16x8 afr = *(const LAS bf16x8*)(abase + dt * 16 * VNT_PITCH + ks * 64);
                acc[dt] = __builtin_amdgcn_mfma_f32_16x16x32_bf16(afr, bfr, acc[dt], 0, 0, 0);
            }
        }
        const int tl = tt * 16 + fr, t = t0 + tl;
        const float bsv = p.in[I_GBS][wave * CHUNK + tl];
#pragma unroll
        for (int dt = 0; dt < 4; ++dt) {
            const int c = wave * 64 + dt * 16 + fq * 4;
            const u32x2 uw = *(const u32x2*)(Z + (size_t)t * ZLD + c);
            u32x2 o; o.x = pk2(bflo(uw.x) * (acc[dt][0] + bsv), bfhi(uw.x) * (acc[dt][1] + bsv)); o.y = pk2(bflo(uw.y) * (acc[dt][2] + bsv), bfhi(uw.y) * (acc[dt][3] + bsv));
            *(u32x2*)(ycat + (size_t)t * 1024 + c) = o;
        }
    }
    __syncthreads();
}
struct EpiX1 {
    static constexpr bool PERM = false, AFTER_DRAIN = false;
    const float* x; const float* mod; float* x1;
    __device__ __forceinline__ void operator()(const f32x4 (&acc)[2][2][4][2], const pg8::Unit& u, int wr, int wc, int fr, int fq) const {
        const int row0 = u.pm * 256 + wr * 64 + fr, col0 = u.pn * 256 + wc * 32 + 4 * fq;
        const int b = (u.pm * 256) / SEQ;
        const float* gt = mod + b * 6 * D + 2 * D;
        f32x4 gv[2][2];
#pragma unroll
        for (int bj = 0; bj < 2; ++bj)
#pragma unroll
            for (int n = 0; n < 2; ++n) gv[bj][n] = *(const f32x4*)(gt + col0 + bj * 128 + n * 16);
#pragma unroll
        for (int ai = 0; ai < 2; ++ai)
#pragma unroll
            for (int m = 0; m < 4; ++m) { const size_t off = (size_t)(row0 + ai * 128 + m * 16) * D + col0;
#pragma unroll
                for (int bj = 0; bj < 2; ++bj)
#pragma unroll
                    for (int n = 0; n < 2; ++n) { const f32x4 xv = *(const f32x4*)(x + off + bj * 128 + n * 16);
                        *(f32x4*)(x1 + off + bj * 128 + n * 16) = xv + gv[bj][n] * acc[ai][bj][m][n]; } }
    }
};
constexpr size_t W_A2 = 112 * MiB;
constexpr size_t W_Q = 112 * MiB;
constexpr size_t W_Y2 = 144 * MiB;
constexpr size_t T_RK = W_TAB + 4 * MiB;
constexpr size_t O_M = 0, O_N = 32 * MiB, O_S = 64 * MiB, O_VL = 96 * MiB;
constexpr int SCL = 128, NCH = SEQ / SCL;

__device__ __forceinline__ float sigmoid_fast(float x) { return __builtin_amdgcn_rcpf(1.0f + __builtin_amdgcn_exp2f(-1.4426950409f * x)); }
__device__ __forceinline__ void p3_lorain(PRef p, int bid, int nb) {
    const bf16* Z = (const bf16*)(p.ws + W_Z); bf16* A2 = (bf16*)(p.ws + W_A2);
    const int tid = otid(), j = tid & 255, sub = tid >> 8;
    const float muj = (j < 160) ? p.in[I_MU][1536 + j] : 0.f;
    for (int t = bid * 2 + sub; t < NTOK; t += nb * 2) {
        float v = 0.f;
        if (j < 160) {
            const float cur = bf2f(Z[(size_t)t * ZLD + 2560 + j]);
            const float prev = (t % SEQ == 0) ? 0.f : bf2f(Z[(size_t)(t - 1) * ZLD + 2560 + j]);
            v = cur + (prev - cur) * muj;
            if (j < 32) v = tanhf(v); else if (j >= 64) v = sigmoidf_(v);
        }
        A2[(size_t)t * 256 + j] = (bf16)f2bf(v);
    }
}
struct EpiLO {
    static constexpr bool PERM = true, AFTER_DRAIN = false;
    bf16* LO; const float* w0; const float* a0;
    __device__ __forceinline__ void operator()(const f32x4 (&acc)[2][2][4][2], const pg8::Unit& u, int wr, int wc, int fr, int fq) const {
        const int row0 = u.pm * 256 + wr * 64 + fr, col0 = u.pn * 256 + wc * 32 + 8 * fq, kind = u.pn >> 1;
#pragma unroll
        for (int bj = 0; bj < 2; ++bj) {
            f32x4 bv[2];
#pragma unroll
            for (int n = 0; n < 2; ++n) { const int ch = col0 + bj * 128 + 4 * n - kind * 512;
                bv[n] = kind == 0 ? *(const f32x4*)(w0 + ch) : kind == 1 ? *(const f32x4*)(a0 + ch) : (f32x4){0.f, 0.f, 0.f, 0.f}; }
#pragma unroll
            for (int ai = 0; ai < 2; ++ai)
#pragma unroll
                for (int m = 0; m < 4; ++m) { bf16* rowp = LO + (size_t)(row0 + ai * 128 + m * 16) * 1536 + col0 + bj * 128;
                    f32x4 v0 = acc[ai][bj][m][0] + bv[0], v1 = acc[ai][bj][m][1] + bv[1];
                    if (kind < 2) { const float sc = kind == 0 ? -0.6065306597f : 1.0f;
#pragma unroll
                        for (int q = 0; q < 4; ++q) { v0[q] = sc * sigmoid_fast(v0[q]); v1[q] = sc * sigmoid_fast(v1[q]); } }
                    u32x4 w; w.x = pg8::cvt_pk_bf16(v0[0], v0[1]); w.y = pg8::cvt_pk_bf16(v0[2], v0[3]); w.z = pg8::cvt_pk_bf16(v1[0], v1[1]); w.w = pg8::cvt_pk_bf16(v1[2], v1[3]);
                    *(u32x4*)rowp = w;
                    asm volatile("" ::: "memory"); }
        }
    }
};
constexpr int SC_TS = 8;
__device__ __forceinline__ void p5a_chunk(PRef p, LAS unsigned char* lds, int q) {
    typedef float f32x2 __attribute__((ext_vector_type(2)));
    const int tid_ = otid(), lane = tid_ & 63, wave = __builtin_amdgcn_readfirstlane(tid_ >> 6);
    const int seq = q / NCH, c = q % NCH, b = seq >> 3, h = seq & 7;
    const int tb = b * SEQ + c * SCL, hc = h * 64 + lane;
    const bf16* Z = (const bf16*)(p.ws + W_Z); const bf16* LO = (const bf16*)(p.ws + W_LO);
    bf16* Qo = (bf16*)(p.ws + W_Q); bf16* Y2o = (bf16*)(p.ws + W_Y2); bf16* VLo = (bf16*)((unsigned char*)p.out + O_VL); float* RKo = (float*)(p.ws + T_RK);
    LAS float* vec = (LAS float*)(lds + wave * (SC_TS * 6 * 256));
    const float mur = p.in[I_MU][hc], muk = p.in[I_MU][512 + hc], muv = p.in[I_MU][1024 + hc];
    const float kkc = p.in[I_KK][hc], kac = p.in[I_KA][hc], rkc = p.in[I_RK][hc];
    float rp = 0.f, kp = 0.f, vp = 0.f;
    if (c != 0) { const bf16* zp = Z + (size_t)(tb - 1) * ZLD + 1024 + hc; rp = bf2f(zp[0]); kp = bf2f(zp[512]); vp = bf2f(zp[1024]); }
    f32x2 Mr[32], Nr[32];
#pragma unroll
    for (int k = 0; k < 32; ++k) { Mr[k] = (f32x2){(2 * k == lane) ? 1.f : 0.f, (2 * k + 1 == lane) ? 1.f : 0.f}; Nr[k] = (f32x2){0.f, 0.f}; }
    for (int sb = 0; sb < SCL / SC_TS; ++sb) {
        const int t0 = tb + sb * SC_TS;
#pragma unroll 1
        for (int sg = 0; sg < SC_TS; sg += 4) { float zr[4], zk[4], zv[4], lw[4], as[4];
          const bf16* zp0 = Z + (unsigned)((t0 + sg) * ZLD + 1024 + hc); const bf16* lp0 = LO + (unsigned)((t0 + sg) * 1536 + hc);
#pragma unroll
          for (int s = 0; s < 4; ++s) { const bf16* zp = zp0 + s * ZLD; const bf16* lp = lp0 + s * 1536;
              zr[s] = bf2f(zp[0]); zk[s] = bf2f(zp[512]); zv[s] = bf2f(zp[1024]); lw[s] = bf2f(lp[0]); as[s] = bf2f(lp[512]); }
#pragma unroll
          for (int s = 0; s < 4; ++s) {
              const float r = zr[s] + (rp - zr[s]) * mur, k = zk[s] + (kp - zk[s]) * muk, v = zv[s] + (vp - zv[s]) * muv;
              rp = zr[s]; kp = zk[s]; vp = zv[s];
              const float kkv = k * kkc;
              const float nrm = sqrtf(wave_sum_dpp(kkv * kkv));
              const float kk = kkv / fmaxf(nrm, 1e-12f);
              const float k2 = k * (1.0f + (as[s] - 1.0f) * kac);
              const float rk = wave_sum_dpp(r * k2 * rkc);
              LAS float* o = vec + (sg + s) * 384 + lane;
              o[0] = __builtin_amdgcn_exp2f(1.4426950409f * lw[s]); o[64] = -kk; o[128] = kk * as[s]; o[192] = k2; o[256] = r; o[320] = v;
              VLo[(unsigned)((t0 + sg + s) * 512 + hc)] = (bf16)f2bf(v);
              if (lane == 0) RKo[(unsigned)((t0 + sg + s) * 8 + h)] = rk;
          } }
        asm volatile("s_waitcnt lgkmcnt(0)" ::: "memory");
        for (int s = 0; s < SC_TS; ++s) {
            const LAS float* vs = vec + s * 384;
            const float vi = vs[320 + lane];
            f32x2 saM = {0.f, 0.f}, saN = {0.f, 0.f};
#pragma unroll
            for (int k4 = 0; k4 < 16; ++k4) { const f32x4 a4 = *(const LAS f32x4*)(vs + 64 + 4 * k4);
                const f32x2 a0 = {a4[0], a4[1]}, a1 = {a4[2], a4[3]};
                saM += Mr[2 * k4] * a0; saN += Nr[2 * k4] * a0; saM += Mr[2 * k4 + 1] * a1; saN += Nr[2 * k4 + 1] * a1;
                if ((k4 & 3) == 3) asm volatile("" ::: "memory"); }
            const float sM = saM[0] + saM[1], sN = saN[0] + saN[1];
            const f32x2 sM2 = {sM, sM}, sN2 = {sN, sN}, vi2 = {vi, vi};
            f32x2 yM = {0.f, 0.f}, yN = {0.f, 0.f};
#pragma unroll
            for (int k4 = 0; k4 < 16; ++k4) {
                const f32x4 w4 = *(const LAS f32x4*)(vs + 4 * k4), b4 = *(const LAS f32x4*)(vs + 128 + 4 * k4), k4v = *(const LAS f32x4*)(vs + 192 + 4 * k4), r4 = *(const LAS f32x4*)(vs + 256 + 4 * k4);
#pragma unroll
                for (int hh = 0; hh < 2; ++hh) {
                    const f32x2 w2 = {w4[2 * hh], w4[2 * hh + 1]}, b2 = {b4[2 * hh], b4[2 * hh + 1]}, k2 = {k4v[2 * hh], k4v[2 * hh + 1]}, r2 = {r4[2 * hh], r4[2 * hh + 1]};
                    const int kx = 2 * k4 + hh;
                    Mr[kx] = Mr[kx] * w2 + sM2 * b2;
                    Nr[kx] = Nr[kx] * w2 + (sN2 * b2 + vi2 * k2);
                    yM += Mr[kx] * r2; yN += Nr[kx] * r2;
                }
                asm volatile("" ::: "memory");
            }
            const unsigned oo = (unsigned)((t0 + s) * 512 + hc);
            Qo[oo] = (bf16)f2bf(yM[0] + yM[1]); Y2o[oo] = (bf16)f2bf(yN[0] + yN[1]);
        }
        asm volatile("s_waitcnt lgkmcnt(0)" ::: "memory");
    }
    f32x4* Mo = (f32x4*)((unsigned char*)p.out + O_M + (size_t)q * 16384 + lane * 256);
    f32x4* No = (f32x4*)((unsigned char*)p.out + O_N + (size_t)q * 16384 + lane * 256);
#pragma unroll
    for (int k4 = 0; k4 < 16; ++k4) { Mo[k4] = (f32x4){Mr[2 * k4][0], Mr[2 * k4][1], Mr[2 * k4 + 1][0], Mr[2 * k4 + 1][1]}; No[k4] = (f32x4){Nr[2 * k4][0], Nr[2 * k4][1], Nr[2 * k4 + 1][0], Nr[2 * k4 + 1][1]}; }
}
__device__ __forceinline__ void p5b_chain(PRef p, LAS unsigned char* lds, int item) {
    typedef float f32x2 __attribute__((ext_vector_type(2)));
    const int tid = otid(), r = tid >> 5, j0 = (tid & 31) * 2, seq = item >> 2, rg = item & 3;
    LAS float* Sl = (LAS float*)lds;
    LAS float* Ml = (LAS float*)(lds + 4096);
    const unsigned char* Mb = (const unsigned char*)p.out + O_M + (size_t)seq * NCH * 16384;
    const unsigned char* Nb = (const unsigned char*)p.out + O_N + (size_t)seq * NCH * 16384 + (size_t)(rg * 16 + r) * 256 + j0 * 4;
    unsigned char* Sb = (unsigned char*)p.out + O_S + (size_t)seq * NCH * 16384 + (size_t)(rg * 16 + r) * 256 + j0 * 4;
    f32x2 sreg = {0.f, 0.f};
    f32x4 m0[2], m1[2], m2[2], m3[2]; f32x2 n0, n1, n2, n3;
#define P5B_LOAD(mm, nn, cc) do { const f32x4* mp = (const f32x4*)(Mb + (size_t)(cc) * 16384) + tid; mm[0] = mp[0]; mm[1] = mp[512]; nn = *(const f32x2*)(Nb + (size_t)(cc) * 16384); } while (0)
#define P5B_STEP(mm, nn, cc) do { \
        __syncthreads(); \
        *(LAS f32x4*)(Ml + tid * 4) = mm[0]; *(LAS f32x4*)(Ml + 2048 + tid * 4) = mm[1]; *(LAS f32x2*)(Sl + r * 64 + j0) = sreg; \
        *(f32x2*)(Sb + (size_t)(cc) * 16384) = sreg; \
        f32x2 acc = nn; \
        __syncthreads(); \
        if ((cc) + 4 < NCH) P5B_LOAD(mm, nn, (cc) + 4); \
        _Pragma("unroll 16") for (int i = 0; i < 64; ++i) { const float sv = Sl[r * 64 + i]; const f32x2 mv = *(const LAS f32x2*)(Ml + i * 64 + j0); acc += (f32x2){sv, sv} * mv; } \
        sreg = acc; } while (0)
    P5B_LOAD(m0, n0, 0); P5B_LOAD(m1, n1, 1); P5B_LOAD(m2, n2, 2); P5B_LOAD(m3, n3, 3);
    for (int c = 0; c < NCH; c += 4) { P5B_STEP(m0, n0, c); P5B_STEP(m1, n1, c + 1); P5B_STEP(m2, n2, c + 2); P5B_STEP(m3, n3, c + 3); }
    __syncthreads();
#undef P5B_LOAD
#undef P5B_STEP
}
#ifndef P5C_MASK
#define P5C_MASK(c, h, tt) true
#endif
__device__ __forceinline__ void p5c_chunk(PRef p, int q) {
    typedef short bf16x8 __attribute__((ext_vector_type(8)));
    const int lane = otid() & 63, fr = lane & 15, fq = lane >> 4;
    const int seq = q / NCH, c = q % NCH, b = seq >> 3, h = seq & 7, tb = b * SEQ + c * SCL;
    const bf16* Qi = (const bf16*)(p.ws + W_Q); const bf16* Y2i = (const bf16*)(p.ws + W_Y2); const bf16* VLi = (const bf16*)((const unsigned char*)p.out + O_VL);
    const float* RKi = (const float*)(p.ws + T_RK); const bf16* LO = (const bf16*)(p.ws + W_LO); bf16* ycat = (bf16*)(p.ws + W_YCAT);
    const float* Sc = (const float*)((const unsigned char*)p.out + O_S + (size_t)q * 16384);
    bf16x8 sa[4][2];
#pragma unroll
    for (int vt = 0; vt < 4; ++vt)
#pragma unroll
        for (int ks = 0; ks < 2; ++ks) { const f32x4* sp = (const f32x4*)(Sc + (vt * 16 + fr) * 64 + ks * 32 + fq * 8); const f32x4 x0 = sp[0], x1 = sp[1];
            u32x4 w; w.x = pg8::cvt_pk_bf16(x0[0], x0[1]); w.y = pg8::cvt_pk_bf16(x0[2], x0[3]); w.z = pg8::cvt_pk_bf16(x1[0], x1[1]); w.w = pg8::cvt_pk_bf16(x1[2], x1[3]);
            sa[vt][ks] = __builtin_bit_cast(bf16x8, w); }
    f32x4 gw[4], gb[4];
#pragma unroll
    for (int vt = 0; vt < 4; ++vt) { gw[vt] = *(const f32x4*)(p.in[I_GNW] + h * 64 + vt * 16 + fq * 4); gb[vt] = *(const f32x4*)(p.in[I_GNB] + h * 64 + vt * 16 + fq * 4); }
#pragma unroll 1
    for (int tt = 0; tt < SCL / 16; ++tt) {
        const int t = tb + tt * 16 + fr;
        const unsigned tq = (unsigned)(t * 512 + h * 64);
        const bf16x8 qb0 = *(const bf16x8*)(Qi + (tq + fq * 8)), qb1 = *(const bf16x8*)(Qi + (tq + 32 + fq * 8));
        f32x4 y[4]; float s = 0.f;
#pragma unroll
        for (int vt = 0; vt < 4; ++vt) {
            const u32x2 yw = *(const u32x2*)(Y2i + (tq + vt * 16 + fq * 4));
            f32x4 a = {bflo(yw.x), bfhi(yw.x), bflo(yw.y), bfhi(yw.y)};
            a = __builtin_amdgcn_mfma_f32_16x16x32_bf16(sa[vt][0], qb0, a, 0, 0, 0);
            a = __builtin_amdgcn_mfma_f32_16x16x32_bf16(sa[vt][1], qb1, a, 0, 0, 0);
            y[vt] = a; s += (a[0] + a[1]) + (a[2] + a[3]);
        }
        s = xsum4(s);
        const float m = s * (1.f / 64.f); float qq = 0.f;
#pragma unroll
        for (int vt = 0; vt < 4; ++vt) { y[vt] = y[vt] - m; qq += (y[vt][0] * y[vt][0] + y[vt][1] * y[vt][1]) + (y[vt][2] * y[vt][2] + y[vt][3] * y[vt][3]); }
        qq = xsum4(qq);
        const float rs = rsqrtf(qq * (1.f / 64.f) + 64e-5f);
        const float rk = RKi[(unsigned)(t * 8 + h)];
#pragma unroll
        for (int vt = 0; vt < 4; ++vt) {
            const int cc = h * 64 + vt * 16 + fq * 4;
            const u32x2 vw = *(const u32x2*)(VLi + (unsigned)(t * 512 + cc)); const u32x2 gwv = *(const u32x2*)(LO + (unsigned)(t * 1536 + 1024 + cc));
            const f32x4 vv = {bflo(vw.x), bfhi(vw.x), bflo(vw.y), bfhi(vw.y)}, gg = {bflo(gwv.x), bfhi(gwv.x), bflo(gwv.y), bfhi(gwv.y)};
            const f32x4 o = (y[vt] * rs * gw[vt] + gb[vt] + vv * rk) * gg;
            u32x2 ow; ow.x = pk2(o[0], o[1]); ow.y = pk2(o[2], o[3]);
            if (P5C_MASK(c, h, tt)) *(u32x2*)(ycat + (unsigned)(t * 1024 + 512 + cc)) = ow;
        }
    }
}
constexpr size_t W_H2 = 112 * MiB;
constexpr size_t W_XS = 176 * MiB;
constexpr size_t W_HB = 320 * MiB;
constexpr size_t W_YB = 176 * MiB;
constexpr int PROWS = NTOK * 2 + NE * 256, PTILES = PROWS / 256;
constexpr size_t T_HIST = W_TAB + 3 * 1024 * 1024 + 8192;
constexpr size_t T_NT = W_TAB + 3 * 1024 * 1024 + 4096;
constexpr size_t T_BQ = W_TAB + 3 * 1024 * 1024 + 65536;
constexpr int TPW = NTOK / 256;

__device__ __forceinline__ void p1_bq(PRef p, LAS float* red, int b) {
    const int tid = otid();
    const float* sh = (const float*)(p.ws + W_MOD) + b * 6 * D + 3 * D;
    if (tid < 288) { const int q = tid % 36, part = tid / 36; float s = 0.f;
        for (int c = part * 128; c < part * 128 + 128; ++c) s = fmaf(sh[c], q < 4 ? p.in[I_RGW][c * 4 + q] : p.in[I_REW][c * 32 + q - 4], s);
        red[part * 36 + q] = s; }
    __syncthreads();
    if (tid < 36) { float s = 0.f;
#pragma unroll
        for (int k = 0; k < 8; ++k) s += red[k * 36 + tid];
        ((float*)(p.ws + T_BQ))[b * 36 + tid] = s + (tid < 4 ? p.in[I_RGB][tid] : p.in[I_REB][tid - 4]); }
    __syncthreads();
}
__device__ __forceinline__ void p7_route(PRef p, LAS unsigned char* lds, int bid) {
    const int tid = otid(), lane = tid & 63, wave = __builtin_amdgcn_readfirstlane(tid >> 6);
    const float* x1 = p.out; bf16* H2 = (bf16*)(p.ws + W_H2);
    LAS int* hist = (LAS int*)(lds + 147456);
    const int b = (bid * TPW) / SEQ;
    const float* mod = (const float*)(p.ws + W_MOD) + b * 6 * D;
    const float* n2g = p.in[I_N2G];
    for (int ch = tid; ch < 1024 * 8; ch += NTHR) { const int c = ch >> 3, i = ch & 7;
        *(LAS f32x4*)(lds + c * 128 + 16 * (i ^ ((c >> 1) & 7))) = *(const f32x4*)(p.in[I_REW] + c * 32 + i * 4); }
    for (int c = tid; c < 1024; c += NTHR) *(LAS f32x4*)(lds + 131072 + c * 16) = *(const f32x4*)(p.in[I_RGW] + c * 4);
    if (tid < 32) hist[tid] = 0;
    if (tid < 36) *(LAS float*)(lds + 147456 + 128 + 4 * tid) = ((const float*)(p.ws + T_BQ))[b * 36 + tid];
    __syncthreads();
    const int sw = (lane >> 1) & 7;
#pragma unroll 1
    for (int tp = 0; tp < TPW / 8; tp += 2) {
        const int t0 = bid * TPW + wave * (TPW / 8) + tp;
        const float* xr0 = x1 + (size_t)t0 * D; bf16* hr0 = H2 + (size_t)t0 * D;
        float acc[2][36];
#pragma unroll
        for (int u = 0; u < 2; ++u)
#pragma unroll
            for (int q = 0; q < 36; ++q) acc[u][q] = 0.f;
        float ss0 = 0.f, ss1 = 0.f;
#pragma unroll 1
        for (int j = 0; j < 16; ++j) {
            const int c = lane + 64 * j;
            const float x0 = xr0[c], x1v = xr0[D + c], gsv = n2g[c] * (1.0f + mod[4 * D + c]);
            ss0 = fmaf(x0, x0, ss0); ss1 = fmaf(x1v, x1v, ss1);
            const float a0 = x0 * gsv, a1 = x1v * gsv;
            const LAS unsigned char* rowp = lds + c * 128;
            { const f32x4 w = *(const LAS f32x4*)(lds + 131072 + c * 16);
#pragma unroll
              for (int q = 0; q < 4; ++q) { acc[0][q] = fmaf(a0, w[q], acc[0][q]); acc[1][q] = fmaf(a1, w[q], acc[1][q]); } }
#pragma unroll
            for (int i = 0; i < 8; ++i) { const f32x4 w = *(const LAS f32x4*)(rowp + 16 * (i ^ sw));
#pragma unroll
                for (int q = 0; q < 4; ++q) { acc[0][4 + 4 * i + q] = fmaf(a0, w[q], acc[0][4 + 4 * i + q]); acc[1][4 + 4 * i + q] = fmaf(a1, w[q], acc[1][4 + 4 * i + q]); } }
        }
        const float r0 = rsqrtf(wave_sum_v(ss0) * (1.0f / D) + 1e-6f), r1 = rsqrtf(wave_sum_v(ss1) * (1.0f / D) + 1e-6f);
#pragma unroll 1
        for (int j = 0; j < 16; ++j) { const int c = lane + 64 * j; const float gsv = n2g[c] * (1.0f + mod[4 * D + c]), sh = mod[3 * D + c];
            hr0[c] = (bf16)f2bf(xr0[c] * r0 * gsv + sh); hr0[D + c] = (bf16)f2bf(xr0[D + c] * r1 * gsv + sh); }
#pragma unroll
        for (int u = 0; u < 2; ++u) {
            const float r = u ? r1 : r0;
            float lg[36];
#pragma unroll
            for (int q = 0; q < 36; ++q) { lg[q] = wave_sum_v(acc[u][q]) * r; if ((q & 3) == 3) __builtin_amdgcn_sched_barrier(0); }
            unsigned bqo = 147456u + 128u; asm volatile("" : "+v"(bqo));
#pragma unroll
            for (int q = 0; q < 36; ++q) lg[q] += *(const LAS float*)(lds + bqo + 4 * q);
            int gi = 0; float gm = lg[0];
#pragma unroll
            for (int q = 1; q < 4; ++q) if (lg[q] > gm) { gm = lg[q]; gi = q; }
            float gsum = 0.f;
#pragma unroll
            for (int q = 0; q < 4; ++q) gsum += expf(lg[q] - gm);
            const float gp = 1.0f / gsum;
            float el[8];
#pragma unroll
            for (int q = 0; q < 8; ++q) el[q] = gi == 0 ? lg[4 + q] : gi == 1 ? lg[12 + q] : gi == 2 ? lg[20 + q] : lg[28 + q];
            int i0 = 0; float m0 = el[0];
#pragma unroll
            for (int q = 1; q < 8; ++q) if (el[q] > m0) { m0 = el[q]; i0 = q; }
            int i1 = -1; float m1 = -3.0e38f;
#pragma unroll
            for (int q = 0; q < 8; ++q) if (q != i0 && el[q] > m1) { m1 = el[q]; i1 = q; }
            const float p1 = expf(m1 - m0);
            const float w0 = gp / (1.0f + p1), w1 = gp * p1 / (1.0f + p1);
            if (lane == 0) { const int t = t0 + u, e0 = gi * 8 + i0, e1 = gi * 8 + i1;
                int* toke = (int*)(p.ws + T_TOKE); float* tokw = (float*)(p.ws + T_TOKW);
                toke[t * 2] = e0; toke[t * 2 + 1] = e1; tokw[t * 2] = w0; tokw[t * 2 + 1] = w1;
                __hip_atomic_fetch_add(&hist[e0], 1, __ATOMIC_RELAXED, __HIP_MEMORY_SCOPE_WORKGROUP); __hip_atomic_fetch_add(&hist[e1], 1, __ATOMIC_RELAXED, __HIP_MEMORY_SCOPE_WORKGROUP); }
        }
    }
    __syncthreads();
    if (tid < 32) ((int*)(p.ws + T_HIST))[bid * 32 + tid] = hist[tid];
    __syncthreads();
}
__device__ __forceinline__ void p8_place(PRef p, LAS unsigned char* lds, int bid) {
    const int tid = otid(), lane = tid & 63, wave = __builtin_amdgcn_readfirstlane(tid >> 6);
    LAS int* ptot = (LAS int*)lds;
    LAS int* pbef = ptot + 512;
    LAS int* base = pbef + 512;
    LAS int* lcur = base + 32;
    LAS int* posl = lcur + 32;
    LAS int* padb = posl + 256;
    const int* hist = (const int*)(p.ws + T_HIST);
    { const int e = tid & 31, part = tid >> 5; int tot = 0, bef = 0;
#pragma unroll 4
      for (int w = part * 16; w < part * 16 + 16; ++w) { const int c = hist[w * 32 + e]; tot += c; bef += (w < bid) ? c : 0; }
      ptot[part * 32 + e] = tot; pbef[part * 32 + e] = bef; }
    __syncthreads();
    if (tid < 32) { int tot = 0, bef = 0;
#pragma unroll
        for (int k = 0; k < 16; ++k) { tot += ptot[k * 32 + tid]; bef += pbef[k * 32 + tid]; }
        ptot[tid] = tot; pbef[tid] = bef; lcur[tid] = 0; }
    __syncthreads();
    if (tid == 0) { int row = 0;
        for (int e = 0; e < NE; ++e) { const int cnt = ptot[e], nt = (cnt + 255) >> 8; base[e] = row + pbef[e]; padb[e] = row + cnt; padb[32 + e] = row + nt * 256;
            if (bid == 0) { int* te = (int*)(p.ws + T_TILEE); for (int k = 0; k < nt; ++k) te[(row >> 8) + k] = e; }
            row += nt * 256; }
        if (bid == 0) *(int*)(p.ws + T_NT) = row >> 8; }
    __syncthreads();
    int* rowaid = (int*)(p.ws + T_ROWAID); float* roww = (float*)(p.ws + T_ROWW);
    if (tid < 256) { const int a = bid * 256 + tid; const int e = ((const int*)(p.ws + T_TOKE))[a];
        const int pos = base[e] + __hip_atomic_fetch_add(&lcur[e], 1, __ATOMIC_RELAXED, __HIP_MEMORY_SCOPE_WORKGROUP);
        posl[tid] = pos; rowaid[pos] = a; roww[pos] = ((const float*)(p.ws + T_TOKW))[a]; }
    if (bid < NE) for (int r = padb[bid] + tid; r < padb[32 + bid]; r += NTHR) { rowaid[r] = -1; roww[r] = 0.f; }
    __syncthreads();
    const bf16* H2 = (const bf16*)(p.ws + W_H2); bf16* XS = (bf16*)(p.ws + W_XS);
#pragma unroll 2
    for (int k = wave; k < 256; k += 8) { const int tok = (bid * 256 + k) >> 1; const int pos = posl[k];
        const u32x4* src = (const u32x4*)(H2 + (size_t)tok * D) + lane; u32x4* dst = (u32x4*)(XS + (size_t)pos * D) + lane;
        const u32x4 v0 = src[0], v1 = src[64]; dst[0] = v0; dst[64] = v1; }
    __syncthreads();
}
struct MoeOrder {
    const int* tile_e; int nM, G, c;
    __device__ __forceinline__ bool next(int i, pg8::Unit& u) const {
        const int nwg = nM * 4; const long L = (long)i * G + c; if (L >= nwg) return false;
        int wgid = (int)L; { const int q = nwg / 8, r = nwg % 8, xcd = wgid % 8, off = wgid / 8; wgid = (xcd < r ? xcd * (q + 1) : r * (q + 1) + (xcd - r) * q) + off; }
        const int nig = 8 * 4, gid = wgid / nig, fm = gid * 8, gsz = (nM - fm) < 8 ? (nM - fm) : 8;
        u.pm = fm + ((wgid % nig) % gsz); u.pn = (wgid % nig) / gsz; u.pb = tile_e[u.pm] * 4 + u.pn; return true;
    }
    __device__ __forceinline__ void a_ready(const pg8::Unit&) const {}
    __device__ __forceinline__ void done(const pg8::Unit&) const {}
};
__device__ __forceinline__ float silu_fast(float x) { return x * __builtin_amdgcn_rcpf(1.0f + __builtin_amdgcn_exp2f(-1.4426950409f * x)); }
struct EpiH {
    static constexpr bool PERM = true, AFTER_DRAIN = false;
    bf16* H;
    __device__ __forceinline__ void operator()(const f32x4 (&acc)[2][2][4][2], const pg8::Unit& u, int wr, int wc, int fr, int fq) const {
        const int row0 = u.pm * 256 + wr * 64 + fr, col0 = u.pn * 128 + wc * 32 + 8 * fq;
#pragma unroll
        for (int ai = 0; ai < 2; ++ai)
#pragma unroll
            for (int m = 0; m < 4; ++m) { const f32x4 g0 = acc[ai][0][m][0], g1 = acc[ai][0][m][1], u0 = acc[ai][1][m][0], u1 = acc[ai][1][m][1];
                f32x4 h0, h1;
#pragma unroll
                for (int q = 0; q < 4; ++q) { h0[q] = silu_fast(g0[q]) * u0[q]; h1[q] = silu_fast(g1[q]) * u1[q]; }
                u32x4 w; w.x = pg8::cvt_pk_bf16(h0[0], h0[1]); w.y = pg8::cvt_pk_bf16(h0[2], h0[3]); w.z = pg8::cvt_pk_bf16(h1[0], h1[1]); w.w = pg8::cvt_pk_bf16(h1[2], h1[3]);
                *(u32x4*)(H + (size_t)(row0 + ai * 128 + m * 16) * EH + col0) = w; }
    }
};
struct EpiY {
    static constexpr bool PERM = true, AFTER_DRAIN = false;
    bf16* YB; const int* rowaid; const float* roww;
    __device__ __forceinline__ void operator()(const f32x4 (&acc)[2][2][4][2], const pg8::Unit& u, int wr, int wc, int fr, int fq) const {
        const int row0 = u.pm * 256 + wr * 64 + fr, col0 = u.pn * 256 + wc * 32 + 8 * fq;
#pragma unroll
        for (int ai = 0; ai < 2; ++ai)
#pragma unroll
            for (int m = 0; m < 4; ++m) { const int row = row0 + ai * 128 + m * 16; const int a = rowaid[row]; const float w = roww[row];
                if (a >= 0) {
#pragma unroll
                    for (int bj = 0; bj < 2; ++bj) { const f32x4 v0 = acc[ai][bj][m][0] * w, v1 = acc[ai][bj][m][1] * w;
                        u32x4 o; o.x = pg8::cvt_pk_bf16(v0[0], v0[1]); o.y = pg8::cvt_pk_bf16(v0[2], v0[3]); o.z = pg8::cvt_pk_bf16(v1[0], v1[1]); o.w = pg8::cvt_pk_bf16(v1[2], v1[3]);
                        *(u32x4*)(YB + (size_t)a * D + col0 + bj * 128) = o; } } }
    }
};
__device__ __forceinline__ void p11_final(PRef p, int bid, int nb) {
    const int tid_ = otid(), lane = tid_ & 63, wv = tid_ >> 6;
    const float* mod = (const float*)(p.ws + W_MOD); const bf16* YB = (const bf16*)(p.ws + W_YB); float* out = p.out; const float* g = p.in[I_FNG];
#pragma unroll 1
    for (int row = bid * 8 + wv; row < NTOK; row += nb * 8) {
        const float* gt = mod + (row / SEQ) * 6 * D + 5 * D;
        f32x4 v[4]; float s = 0.f;
#pragma unroll
        for (int j = 0; j < 4; ++j) { const int c0 = (lane + 64 * j) * 4;
            const f32x4 xv = *(const f32x4*)(out + (size_t)row * D + c0), gv = *(const f32x4*)(gt + c0);
            const u32x2 a = *(const u32x2*)(YB + (size_t)(2 * row) * D + c0), b = *(const u32x2*)(YB + (size_t)(2 * row + 1) * D + c0);
            const f32x4 y = {bflo(a.x) + bflo(b.x), bfhi(a.x) + bfhi(b.x), bflo(a.y) + bflo(b.y), bfhi(a.y) + bfhi(b.y)};
            v[j] = xv + gv * y; s += (v[j][0] * v[j][0] + v[j][1] * v[j][1]) + (v[j][2] * v[j][2] + v[j][3] * v[j][3]); }
        const float r = rsqrtf(wave_sum_dpp(s) * (1.0f / D) + 1e-6f);
#pragma unroll
        for (int j = 0; j < 4; ++j) { const int c0 = (lane + 64 * j) * 4; *(f32x4*)(out + (size_t)row * D + c0) = v[j] * r * *(const f32x4*)(g + c0); }
    }
}
__global__ void __launch_bounds__(NTHR, 2) k_mega(Params p_unused) {
    extern __shared__ __attribute__((aligned(16))) unsigned char lds_raw[];
    PPtr kp = (PPtr)__builtin_amdgcn_kernarg_segment_ptr();
#define p (*opq(kp))
    cg::grid_group grid = cg::this_grid();
    const int bid = blockIdx.x, nb = gridDim.x;
    LAS unsigned char* lds = (LAS unsigned char*)lds_raw;
    volatile LAS unsigned* bst = (volatile LAS unsigned*)(lds + LDS_BYTES - 64);
    if (otid() < 2) bst[otid()] = 0u;
    __syncthreads();
    XcdBarrier xb = xcd_barrier_post((unsigned*)(p.ws + T_BAR), bst);
#define GSYNC() xcd_barrier(xb)
    p0_prep<true>(p, lds, bid, nb); grid.sync();
    p1_h1(p, bid, nb); if (bid < BATCH) p1_bq(p, (LAS float*)lds, bid); GSYNC();
    { pg8::Gemm g{(const pg8::bf16_t*)(p.ws + W_H1), (const pg8::bf16_t*)(p.ws + W_WINT), NTOK, ZLD, D}; pg8::StaticOrder S; S.init(NTOK, ZLD, nb, bid);
      EpiZ E{(bf16*)(p.ws + W_Z)};
      pg8::gemm_phase<EpiZ, pg8::StaticOrder, true, true>(lds, g, S, E); }
    GSYNC();
#pragma unroll 1
    for (int ch = bid; ch < NTOK / CHUNK; ch += nb) p3_gmlp_unit(p, lds, ch);
    p3_lorain(p, bid, nb);
    GSYNC();
    { int kop = 256; asm volatile("" : "+s"(kop));
      pg8::Gemm g{(const pg8::bf16_t*)(p.ws + W_A2), (const pg8::bf16_t*)(p.ws + W_LORAT), NTOK, 1536, kop}; pg8::StaticOrder S; S.init(NTOK, 1536, nb, bid);
      EpiLO E{(bf16*)(p.ws + W_LO), p.in[I_W0], p.in[I_A0]};
      pg8::gemm_phase<EpiLO, pg8::StaticOrder, true, true>(lds, g, S, E); }
    GSYNC();
#pragma unroll 1
    for (int q = bid * 8 + __builtin_amdgcn_readfirstlane(otid() >> 6); q < BATCH * 8 * NCH; q += nb * 8) p5a_chunk(p, lds, q);
    GSYNC();
#pragma unroll 1
    for (int it = bid; it < BATCH * 8 * 4; it += nb) p5b_chain(p, lds, it);
    GSYNC();
#pragma unroll 1
    for (int q = bid * 8 + __builtin_amdgcn_readfirstlane(otid() >> 6); q < BATCH * 8 * NCH; q += nb * 8) p5c_chunk(p, q);
    GSYNC();
    { pg8::Gemm g{(const pg8::bf16_t*)(p.ws + W_YCAT), (const pg8::bf16_t*)(p.ws + W_WOUTT), NTOK, D, D}; pg8::StaticOrder S; S.init(NTOK, D, nb, bid);
      EpiX1 E{p.in[I_X], (const float*)(p.ws + W_MOD), p.out};
      pg8::gemm_phase<EpiX1, pg8::StaticOrder, true, true>(lds, g, S, E); }
    GSYNC();
    p7_route(p, lds, bid); GSYNC();
    p8_place(p, lds, bid); GSYNC();
    { const int nM = *(const int*)(p.ws + T_NT);
      pg8::Gemm g{(const pg8::bf16_t*)(p.ws + W_XS), (const pg8::bf16_t*)(p.ws + W_WGUT), PROWS, 1024, D}; MoeOrder S{(const int*)(p.ws + T_TILEE), nM, nb, bid};
      EpiH E{(bf16*)(p.ws + W_HB)};
      pg8::gemm_phase<EpiH, MoeOrder, true, true>(lds, g, S, E); }
    GSYNC();
    { const int nM = *(const int*)(p.ws + T_NT);
      pg8::Gemm g{(const pg8::bf16_t*)(p.ws + W_HB), (const pg8::bf16_t*)(p.ws + W_WDT), PROWS, 1024, EH}; MoeOrder S{(const int*)(p.ws + T_TILEE), nM, nb, bid};
      EpiY E{(bf16*)(p.ws + W_YB), (const int*)(p.ws + T_ROWAID), (const float*)(p.ws + T_ROWW)};
      pg8::gemm_phase<EpiY, MoeOrder, true, true>(lds, g, S, E); }
    GSYNC();
    p11_final(p, bid, nb);
#undef GSYNC
#undef p
}
extern "C" void kernel_launch(void* const* d_in, const int* in_sizes, int n_in, void* d_out, int out_size, void* d_ws, size_t ws_size, hipStream_t stream) {
    if (n_in != 31 || ws_size < WS_NEED || out_size != NTOK * D) { fprintf(stderr, "kernel_launch: unexpected sizes n_in %d ws %zu out %d\n", n_in, ws_size, out_size); return; }
    static int grid_blocks = 0;
    if (!grid_blocks) {
        int dev = 0, cus = 0, per_cu = 0;
        (void)hipGetDevice(&dev);
        (void)hipDeviceGetAttribute(&cus, hipDeviceAttributeMultiprocessorCount, dev);
        (void)hipFuncSetAttribute((const void*)k_mega, hipFuncAttributeMaxDynamicSharedMemorySize, LDS_BYTES);
        (void)hipOccupancyMaxActiveBlocksPerMultiprocessor(&per_cu, (const void*)k_mega, NTHR, LDS_BYTES);
        if (per_cu < 1) fprintf(stderr, "kernel_launch: occupancy query says %d blocks/CU\n", per_cu);
        grid_blocks = cus;
    }
    Params p{};
    for (int i = 0; i < 31; ++i) p.in[i] = (const float*)d_in[i];
    p.out = (float*)d_out; p.ws = (unsigned char*)d_ws;
    (void)hipMemsetAsync((char*)d_ws + T_BAR, 0, 16384, stream);
    void* args[] = {&p};
    hipError_t e = hipLaunchCooperativeKernel((void*)k_mega, dim3(grid_blocks), dim3(NTHR), args, LDS_BYTES, stream);
    if (e != hipSuccess) fprintf(stderr, "cooperative launch failed: %s (grid %d)\n", hipGetErrorString(e), grid_blocks);
}
```

```cpp
#include <hip/hip_runtime.h>
#include <hip/hip_cooperative_groups.h>
#include <cstdio>
#include <cstdint>
namespace cg = cooperative_groups;
__device__ __forceinline__ int otid() { int t = threadIdx.x; asm volatile("" : "+v"(t)); return t; }

namespace pg8 {
#define PG8_LAS __attribute__((address_space(3)))
typedef unsigned short bf16_t;
typedef short bf16x8 __attribute__((ext_vector_type(8)));
typedef float f32x4 __attribute__((ext_vector_type(4)));
typedef unsigned u32x4 __attribute__((ext_vector_type(4)));
constexpr int BM = 256, BK = 64, HALF = 128, HTB = HALF * BK * 2  , STAGE_BYTES = 8 * HTB, NXCD = 8, WGM = 8;

__host__ __device__ __forceinline__ int lds_byte(int r, int c) { const int st = (r >> 4) * 2 + (c >> 5), rr = r & 15, cc = c & 31, ob = rr * 64 + cc * 2; return st * 1024 + (ob ^ (((ob >> 9) & 1) << 5)); }
__host__ __device__ __forceinline__ void stage_rc(int b, int& R, int& C) { const int st = b / 1024, sb = b % 1024, swz = sb ^ (((sb >> 9) & 1) << 5); R = (st >> 1) * 16 + swz / 64; C = (st & 1) * 32 + (swz % 64) / 2; }
__host__ __device__ __forceinline__ int perm32(int rho) { const int n = rho >> 4, i = rho & 15; return 8 * (i >> 2) + 4 * n + (i & 3); }

struct Unit { int pm, pn, pb; };
struct Gemm { const bf16_t* A; const bf16_t* Bt; int M, N, K; };

struct StaticOrder {
    static constexpr bool GATHER = false;
    int nM, nN, nwg, G, c;
    __device__ __forceinline__ int rowsrc(int) const { return 0; }
    __host__ __device__ void init(int M, int N, int G_, int c_) { nM = M / BM; nN = N / BM; nwg = nM * nN; G = G_; c = c_; }
    __host__ __device__ bool next(int i, Unit& u) const {
        const long L = (long)i * G + c; if (L >= nwg) return false;
        int wgid = (int)L; { const int q = nwg / NXCD, r = nwg % NXCD, xcd = wgid % NXCD, off = wgid / NXCD; wgid = (xcd < r ? xcd * (q + 1) : r * (q + 1) + (xcd - r) * q) + off; }
        const int nig = WGM * nN, gid = wgid / nig, fm = gid * WGM, gsz = (nM - fm) < WGM ? (nM - fm) : WGM;
        u.pm = fm + ((wgid % nig) % gsz); u.pn = (wgid % nig) / gsz; u.pb = u.pn; return true;
    }
    __device__ __forceinline__ void a_ready(const Unit&) const {}
    __device__ __forceinline__ void done(const Unit&) const {}
};

__device__ __forceinline__ unsigned cvt_pk_bf16(float lo, float hi) { unsigned r; asm volatile("v_cvt_pk_bf16_f32 %0, %1, %2" : "=v"(r) : "v"(lo), "v"(hi)); return r; }
typedef float f32x2 __attribute__((ext_vector_type(2)));
template <class Epi, class Sched, bool ALIGN_EPI = false, bool SP2 = false>
__device__ __forceinline__ void gemm_phase(PG8_LAS unsigned char* lds, const Gemm g, const Sched& S, const Epi& E) {
    const int tid = otid(), wid = __builtin_amdgcn_readfirstlane(tid >> 6), lane = tid & 63, wr = wid >> 2, wc = wid & 3, fr = lane & 15, fq = lane >> 4;
    const int K = g.K, nt = K / BK;
    unsigned voffA[2], voffB[2];
#pragma unroll
    for (int i = 0; i < 2; ++i) { int R, C; stage_rc(tid * 16 + i * 8192, R, C); const int Rb = Epi::PERM ? ((R & ~31) + perm32(R & 31)) : R;
        voffA[i] = (unsigned)(R * K + C) * 2u; voffB[i] = (unsigned)(Rb * K + C) * 2u; }
    const size_t kstep = (size_t)(BK * 2);
    const size_t hstep = (size_t)HALF * K * 2;
    const size_t tstep = 2 * hstep;
    unsigned vA0[2], vA1[2], nA0[2], nA1[2];
    PG8_LAS int* rtab = (PG8_LAS int*)(lds + STAGE_BYTES);
    auto fillA = [&](int ui_, unsigned (&o0)[2], unsigned (&o1)[2]) {
#pragma unroll
        for (int i = 0; i < 2; ++i) {
            if constexpr (Sched::GATHER) { int R, C; stage_rc(tid * 16 + i * 8192, R, C);
                o0[i] = (unsigned)(rtab[ui_ * 256 + R] * K + C) * 2u; o1[i] = (unsigned)(rtab[ui_ * 256 + 128 + R] * K + C) * 2u; }
            else { o0[i] = voffA[i]; o1[i] = voffA[i] + (unsigned)hstep; } } };
    const unsigned ldsw = (unsigned)wid * 1024u;
    const int aoff = lds_byte(wr * 64 + fr, fq * 8), boff = lds_byte(wc * 32 + fr, fq * 8);
#define PG8_SA(b, h) (((b) * 2 + (h)) * HTB)
#define PG8_SB(b, h) ((4 + (b) * 2 + (h)) * HTB)
#define PG8_STAGE(bufoff, gbase, voff) do { _Pragma("unroll") for (int _i = 0; _i < 2; ++_i) \
        __builtin_amdgcn_global_load_lds((const unsigned*)((const char*)(gbase) + (voff)[_i]), (PG8_LAS unsigned*)(lds + (bufoff) + ldsw + _i * 8192), 16, 0, 0); } while (0)
#define PG8_LDA(dst, b, h) do { _Pragma("unroll") for (int m = 0; m < 4; ++m) _Pragma("unroll") for (int k = 0; k < 2; ++k) dst[m][k] = *(const PG8_LAS bf16x8*)(lds + PG8_SA(b, h) + aoff + m * 2048 + k * 1024); } while (0)
#define PG8_LDB(dst, b, h) do { _Pragma("unroll") for (int n = 0; n < 2; ++n) _Pragma("unroll") for (int k = 0; k < 2; ++k) dst[n][k] = *(const PG8_LAS bf16x8*)(lds + PG8_SB(b, h) + boff + n * 2048 + k * 1024); } while (0)
#define PG8_MMA(ai, bj, At, Bt) do { __builtin_amdgcn_s_setprio(1); _Pragma("unroll") for (int m = 0; m < 4; ++m) _Pragma("unroll") for (int n = 0; n < 2; ++n) _Pragma("unroll") for (int k = 0; k < 2; ++k) \
        acc[ai][bj][m][n] = __builtin_amdgcn_mfma_f32_16x16x32_bf16(Bt[n][k], At[m][k], acc[ai][bj][m][n], 0, 0, 0); __builtin_amdgcn_s_setprio(0); } while (0)
#define PG8_WAIT_V(n) asm volatile("s_waitcnt vmcnt(" #n ")" ::: "memory")
#define PG8_WAIT_L(n) asm volatile("s_waitcnt lgkmcnt(" #n ")" ::: "memory")
#define PG8_BAR __builtin_amdgcn_s_barrier()
#define PG8_SCHED __builtin_amdgcn_sched_barrier(0)
    Unit cur, nxt; int ui = 0;
    if (!S.next(0, cur)) return;
    f32x4 acc[2][2][4][2];
#pragma unroll
    for (int a = 0; a < 2; ++a)
#pragma unroll
        for (int b = 0; b < 2; ++b)
#pragma unroll
            for (int m = 0; m < 4; ++m)
#pragma unroll
                for (int n = 0; n < 2; ++n) acc[a][b][m][n] = (f32x4){0.f, 0.f, 0.f, 0.f};
    bf16x8 At[4][2], B0[2][2], B1[2][2];
    if constexpr (Sched::GATHER) {
        for (int ui_ = 0; ; ++ui_) { Unit u_; if (!S.next(ui_, u_)) break; if (tid < 256) rtab[ui_ * 256 + tid] = S.rowsrc(u_.pm * 256 + tid); }
        __syncthreads();
    }
    fillA(0, vA0, vA1);
    const char* cA = Sched::GATHER ? (const char*)g.A : (const char*)g.A + (size_t)cur.pm * tstep; const char* cB = (const char*)g.Bt + (size_t)cur.pb * tstep;
    S.a_ready(cur);
    if constexpr (SP2) {
        PG8_STAGE(PG8_SB(0, 0), cB, voffB); PG8_STAGE(PG8_SB(0, 1), cB + hstep, voffB); PG8_STAGE(PG8_SA(0, 0), cA, vA0); PG8_STAGE(PG8_SA(0, 1), cA, vA1);
        if (wr == 1) PG8_BAR;
        PG8_WAIT_V(2); PG8_BAR;
        PG8_STAGE(PG8_SB(1, 0), cB + kstep, voffB); PG8_STAGE(PG8_SA(1, 0), cA + kstep, vA0); PG8_STAGE(PG8_SB(1, 1), cB + hstep + kstep, voffB);
        PG8_WAIT_V(6); PG8_BAR;
    } else {
        PG8_STAGE(PG8_SB(0, 0), cB, voffB); PG8_STAGE(PG8_SA(0, 0), cA, vA0); PG8_STAGE(PG8_SB(0, 1), cB + hstep, voffB); PG8_STAGE(PG8_SA(0, 1), cA, vA1);
        if (wr == 1) PG8_BAR;
        PG8_WAIT_V(4); PG8_BAR;
        PG8_STAGE(PG8_SB(1, 0), cB + kstep, voffB); PG8_STAGE(PG8_SA(1, 0), cA + kstep, vA0); PG8_STAGE(PG8_SB(1, 1), cB + hstep + kstep, voffB);
        PG8_WAIT_V(6); PG8_BAR;
    }
    for (;;) {
        const bool has_next = S.next(ui + 1, nxt);
        const char* nA = has_next ? (Sched::GATHER ? (const char*)g.A : (const char*)g.A + (size_t)nxt.pm * tstep) : cA; const char* nB = has_next ? (const char*)g.Bt + (size_t)nxt.pb * tstep : cB;
        if (has_next) fillA(ui + 1, nA0, nA1); else {
#pragma unroll
            for (int i = 0; i < 2; ++i) { nA0[i] = vA0[i]; nA1[i] = vA1[i]; } }
        for (int t = 0; t < nt; t += 2) {
            const bool last = (t == nt - 2);
            const char* a1 = cA + (size_t)(t + 1) * kstep;
            const char* a2 = last ? nA : cA + (size_t)(t + 2) * kstep; const char* b2 = last ? nB : cB + (size_t)(t + 2) * kstep;
            const char* a3 = a2 + kstep; const char* b3 = b2 + kstep;
            unsigned sA0[2], sA1[2];
#pragma unroll
            for (int i = 0; i < 2; ++i) { sA0[i] = last ? nA0[i] : vA0[i]; sA1[i] = last ? nA1[i] : vA1[i]; }
            if (last && has_next) S.a_ready(nxt);
            if constexpr (SP2) {
            PG8_LDB(B0, 0, 0); PG8_LDB(B1, 0, 1); PG8_SCHED; PG8_LDA(At, 0, 0); PG8_STAGE(PG8_SA(1, 1), a1, vA1);
            PG8_WAIT_V(8); PG8_WAIT_L(0); PG8_BAR; PG8_MMA(0, 0, At, B0); PG8_MMA(0, 1, At, B1); PG8_BAR; PG8_SCHED;
            PG8_LDA(At, 0, 1); PG8_STAGE(PG8_SB(0, 0), b2, voffB); PG8_STAGE(PG8_SB(0, 1), b2 + hstep, voffB); PG8_STAGE(PG8_SA(0, 0), a2, sA0);
            PG8_WAIT_V(8); PG8_WAIT_L(0); PG8_BAR; PG8_MMA(1, 0, At, B0); PG8_MMA(1, 1, At, B1); PG8_BAR; PG8_SCHED;
            PG8_LDB(B0, 1, 0); PG8_LDB(B1, 1, 1); PG8_SCHED; PG8_LDA(At, 1, 0); PG8_STAGE(PG8_SA(0, 1), a2, sA1);
            PG8_WAIT_V(8); PG8_WAIT_L(0); PG8_BAR; PG8_MMA(0, 0, At, B0); PG8_MMA(0, 1, At, B1); PG8_BAR; PG8_SCHED;
            PG8_LDA(At, 1, 1); PG8_STAGE(PG8_SB(1, 0), b3, voffB); PG8_STAGE(PG8_SB(1, 1), b3 + hstep, voffB); PG8_STAGE(PG8_SA(1, 0), a3, sA0);
            PG8_WAIT_V(8); PG8_WAIT_L(0); PG8_BAR; PG8_MMA(1, 0, At, B0); PG8_MMA(1, 1, At, B1); PG8_BAR; PG8_SCHED;
            } else {
            PG8_LDB(B0, 0, 0); PG8_SCHED; PG8_LDA(At, 0, 0); PG8_STAGE(PG8_SA(1, 1), a1, vA1);
            PG8_WAIT_L(8); PG8_BAR; PG8_WAIT_L(0); PG8_MMA(0, 0, At, B0); PG8_BAR; PG8_SCHED;
            PG8_LDB(B1, 0, 1); PG8_STAGE(PG8_SB(0, 0), b2, voffB);
            PG8_BAR; PG8_WAIT_L(0); PG8_MMA(0, 1, At, B1); PG8_BAR;
            PG8_LDA(At, 0, 1); PG8_STAGE(PG8_SA(0, 0), a2, sA0);
            PG8_BAR; PG8_WAIT_L(0); PG8_MMA(1, 0, At, B0); PG8_BAR; PG8_SCHED;
            PG8_STAGE(PG8_SB(0, 1), b2 + hstep, voffB);
            PG8_WAIT_V(6); PG8_BAR; PG8_MMA(1, 1, At, B1); PG8_BAR;
            PG8_LDB(B0, 1, 0); PG8_SCHED; PG8_LDA(At, 1, 0); PG8_STAGE(PG8_SA(0, 1), a2, sA1);
            PG8_WAIT_L(8); PG8_BAR; PG8_WAIT_L(0); PG8_MMA(0, 0, At, B0); PG8_BAR; PG8_SCHED;
            PG8_LDB(B1, 1, 1); PG8_STAGE(PG8_SB(1, 0), b3, voffB);
            PG8_BAR; PG8_WAIT_L(0); PG8_MMA(0, 1, At, B1); PG8_BAR;
            PG8_LDA(At, 1, 1); PG8_STAGE(PG8_SA(1, 0), a3, sA0);
            PG8_BAR; PG8_WAIT_L(0); PG8_MMA(1, 0, At, B0); PG8_BAR; PG8_SCHED;
            PG8_STAGE(PG8_SB(1, 1), b3 + hstep, voffB);
            PG8_WAIT_V(6); PG8_BAR; PG8_MMA(1, 1, At, B1); PG8_BAR;
            }
        }
        if constexpr (ALIGN_EPI) { if (wr == 0) PG8_BAR; }
        if constexpr (!Epi::AFTER_DRAIN) { E(acc, cur, wr, wc, fr, fq); S.done(cur); }
        if (!has_next) break;
#pragma unroll
        for (int a = 0; a < 2; ++a)
#pragma unroll
            for (int b = 0; b < 2; ++b)
#pragma unroll
                for (int m = 0; m < 4; ++m)
#pragma unroll
                    for (int n = 0; n < 2; ++n) acc[a][b][m][n] = (f32x4){0.f, 0.f, 0.f, 0.f};
        cur = nxt; cA = nA; cB = nB; ++ui;
#pragma unroll
        for (int i = 0; i < 2; ++i) { vA0[i] = nA0[i]; vA1[i] = nA1[i]; }
        if constexpr (ALIGN_EPI) { if (wr == 1) PG8_BAR; }
    }
    PG8_WAIT_V(0);
    if constexpr (!ALIGN_EPI) { if (wr == 0) PG8_BAR; }
    PG8_BAR;
    if constexpr (Epi::AFTER_DRAIN) { E.fused(acc, cur, wr, wc, fr, fq, lds, wid, lane); S.done(cur); }
#undef PG8_SA
#undef PG8_SB
#undef PG8_STAGE
#undef PG8_LDA
#undef PG8_LDB
#undef PG8_MMA
#undef PG8_WAIT_V
#undef PG8_WAIT_L
#undef PG8_BAR
#undef PG8_SCHED
}
}
constexpr int D = 1024, BATCH = 8, SEQ = 4096, NTOK = BATCH * SEQ;
constexpr int GW = 512, RW = 512, HD = 64, CHUNK = 128;
constexpr int RPROJ = 1696, INW = 2720, ZLD = 2816;
constexpr int NG = 4, EPG = 8, NE = 32, EH = 512;
constexpr int NTHR = 512;
constexpr int LDS_BYTES = 163840;

typedef float f32x16 __attribute__((ext_vector_type(16)));
typedef float f32x4 __attribute__((ext_vector_type(4)));
typedef unsigned u32x4 __attribute__((ext_vector_type(4)));
typedef unsigned u32x2 __attribute__((ext_vector_type(2)));
typedef unsigned short bf16;
#define LAS __attribute__((address_space(3)))

constexpr size_t MiB = 1u << 20;
constexpr size_t W_WINT = 0;
constexpr size_t W_WOUTT = 6 * MiB;
constexpr size_t W_LORAT = 8 * MiB;
constexpr size_t W_WC = 9 * MiB;
constexpr size_t W_MOD = 10 * MiB;
constexpr size_t W_TAB = 11 * MiB;
constexpr size_t W_WGUT = 16 * MiB;
constexpr size_t W_WDT = 80 * MiB;
constexpr size_t W_H1 = 112 * MiB;
constexpr size_t W_Z = 176 * MiB;
constexpr size_t W_YCAT = 352 * MiB;
constexpr size_t W_LO = 416 * MiB;
constexpr size_t WS_NEED = 512 * MiB;
constexpr size_t T_TOKE = W_TAB;
constexpr size_t T_TOKW = W_TAB + 512 * 1024;
constexpr size_t T_ROWTOK = W_TAB + 1024 * 1024;
constexpr size_t T_ROWAID = W_TAB + 1536 * 1024;
constexpr size_t T_ROWW = W_TAB + 2048 * 1024;
constexpr size_t T_TILEE = W_TAB + 2560 * 1024;
constexpr size_t T_CTL = W_TAB + 3072 * 1024;
constexpr size_t T_BAR = W_TAB + 3584 * 1024;

struct Params {
    const float* in[31];
    float* out;
    unsigned char* ws;
};
typedef const __attribute__((address_space(4))) Params& PRef;
typedef const __attribute__((address_space(4))) Params* PPtr;
__device__ __forceinline__ PPtr opq(PPtr k) { asm volatile("" : "+s"(k)); return k; }
enum { I_X = 0, I_C, I_ADAW, I_ADAB, I_N1G, I_WIN, I_GLNW, I_GLNB, I_GWS, I_GBS, I_MU, I_W0, I_W2, I_A0, I_A2, I_G2, I_KK, I_KA, I_RK, I_GNW, I_GNB, I_WOUT, I_N2G, I_RGW, I_RGB, I_REW, I_REB, I_WG, I_WU, I_WD, I_FNG };

__device__ __forceinline__ float wave_sum(float v) {
#pragma unroll
    for (int o = 1; o < 64; o <<= 1) v += __shfl_xor(v, o);
    return v;
}
#define DPP_ADD(v, ctrl) v += __builtin_bit_cast(float, __builtin_amdgcn_update_dpp(0, __builtin_bit_cast(int, v), ctrl, 0xf, 0xf, false))
__device__ __forceinline__ float wave_sum_dpp(float v) {
    DPP_ADD(v, 0xB1); DPP_ADD(v, 0x4E); DPP_ADD(v, 0x141); DPP_ADD(v, 0x140);
    const int iv = __builtin_bit_cast(int, v);
    const float a = __builtin_bit_cast(float, __builtin_amdgcn_readlane(iv, 0)), b = __builtin_bit_cast(float, __builtin_amdgcn_readlane(iv, 16));
    const float c = __builtin_bit_cast(float, __builtin_amdgcn_readlane(iv, 32)), d = __builtin_bit_cast(float, __builtin_amdgcn_readlane(iv, 48));
    return (a + b) + (c + d);
}
__device__ __forceinline__ float xsum4(float s) {
    s += __builtin_bit_cast(float, __builtin_amdgcn_ds_swizzle(__builtin_bit_cast(int, s), 0x401F));
    float a = s, b = s;
    asm volatile("s_nop 1\n\tv_permlane32_swap_b32 %0, %1\n\ts_nop 1" : "+v"(a), "+v"(b));
    return a + b;
}
__device__ __forceinline__ float wave_sum_v(float v) {
    DPP_ADD(v, 0xB1); DPP_ADD(v, 0x4E); DPP_ADD(v, 0x141); DPP_ADD(v, 0x140);
    return xsum4(v);
}
__device__ __forceinline__ float gelu_tanh(float x) {
    const float u = 0.7978845608028654f * (x + 0.044715f * x * x * x);
    return 0.5f * x * (1.0f + tanhf(u));
}
__device__ __forceinline__ float gelu_fast(float x) {
    const float u2 = -2.302208198f * (x + 0.044715f * x * x * x);
    return x * __builtin_amdgcn_rcpf(1.0f + __builtin_amdgcn_exp2f(u2));
}
__device__ __forceinline__ float sigmoidf_(float x) { return 1.0f / (1.0f + expf(-x)); }
__device__ __forceinline__ float softplusf_(float x) { return fmaxf(x, 0.f) + log1pf(expf(-fabsf(x))); }
__device__ __forceinline__ float bf2f(unsigned short b) { return __uint_as_float(((unsigned)b) << 16); }
__device__ __forceinline__ float bflo(unsigned w) { return __uint_as_float(w << 16); }
__device__ __forceinline__ float bfhi(unsigned w) { return __uint_as_float(w & 0xffff0000u); }
__device__ __forceinline__ unsigned f2bf(float f) { unsigned u = __float_as_uint(f); return (u + 0x7fffu + ((u >> 16) & 1u)) >> 16; }
__device__ __forceinline__ unsigned pk2(float lo, float hi) { return f2bf(lo) | (f2bf(hi) << 16); }
#define XB_TMO      128
#define XB_XCNT(j)  (256  + 64 * (j))
#define XB_XSUB(j)  (1280 + 64 * (j))
#define XB_XGEN(j)  (2304 + 64 * (j))
#define XB_TOP      3328
#define XB_TOPGEN   3392
#define XCD_BAR_WORDS 3456
#define XB_SPIN_CAP (1u << 18)

__device__ __forceinline__ unsigned xb_ld(unsigned* p)              { return __hip_atomic_load(p, __ATOMIC_RELAXED, __HIP_MEMORY_SCOPE_AGENT); }
__device__ __forceinline__ unsigned xb_add(unsigned* p, unsigned v) { return __hip_atomic_fetch_add(p, v, __ATOMIC_RELAXED, __HIP_MEMORY_SCOPE_AGENT); }
__device__ __forceinline__ unsigned xb_xcc_id() { return (unsigned)__builtin_amdgcn_s_getreg((3 << 11) | 20) & 0xFu; }
#define XB_SPIN(cond, bar) do { unsigned _sp = 0; while (cond) { __builtin_amdgcn_s_sleep(1); \
    if ((++_sp & 255u) == 0u) { if (xb_ld(&(bar)[XB_TMO])) break; if (_sp > XB_SPIN_CAP) { atomicAdd(&(bar)[XB_TMO], 1u); break; } } } } while (0)

struct XcdBarrier {
    unsigned* bar; unsigned x;
    volatile LAS unsigned* st;
};

__device__ __forceinline__ XcdBarrier xcd_barrier_post(unsigned* bar, volatile LAS unsigned* st) {
    XcdBarrier b; b.bar = bar; b.x = xb_xcc_id(); b.st = st;
    if (threadIdx.x == 0) (void)xb_add(&bar[XB_XCNT(b.x)], 1u);
    return b;
}
__device__ __forceinline__ void xcd_barrier_complete(unsigned* bar, unsigned x, unsigned& nloc, unsigned& nx) {
    const unsigned G = gridDim.x * gridDim.y * gridDim.z;
    unsigned sum, cnt, mine, sp = 0u;
    for (;;) {
        sum = 0u; cnt = 0u; mine = 0u;
#pragma unroll
        for (unsigned j = 0; j < 16; ++j) { const unsigned c = xb_ld(&bar[XB_XCNT(j)]); sum += c; cnt += (c > 0u) ? 1u : 0u; mine = (j == x) ? c : mine; }
        if (sum == G) break;
        __builtin_amdgcn_s_sleep(1);
        if ((++sp & 255u) == 0u) { if (xb_ld(&bar[XB_TMO])) break; if (sp > XB_SPIN_CAP) { atomicAdd(&bar[XB_TMO], 1u); break; } }
    }
    nloc = mine > 0u ? mine : 1u; nx = cnt > 0u ? cnt : 1u;
}

__device__ __forceinline__ void xcd_barrier(const XcdBarrier& b) {
    asm volatile("s_waitcnt vmcnt(0)" ::: "memory");
    __syncthreads();
    if (threadIdx.x == 0) {
        unsigned* bar = b.bar;
        __builtin_amdgcn_s_waitcnt(0);
        unsigned nloc = b.st[0], nx = b.st[1];
        if (nloc == 0u) { xcd_barrier_complete(bar, b.x, nloc, nx); b.st[0] = nloc; b.st[1] = nx; }
        const unsigned old = xb_add(&bar[XB_XSUB(b.x)], 1u);
        const unsigned gen = old / nloc;
        if (old + 1u == (gen + 1u) * nloc) {
            __builtin_amdgcn_fence(__ATOMIC_RELEASE, "agent");
            asm volatile("s_waitcnt vmcnt(0)" ::: "memory");
            const unsigned og = xb_add(&bar[XB_TOP], 1u);
            const unsigned tg = og / nx;
            if (og + 1u == (tg + 1u) * nx) xb_add(&bar[XB_TOPGEN], 1u);
            else XB_SPIN(xb_ld(&bar[XB_TOPGEN]) == tg, bar);
            __builtin_amdgcn_fence(__ATOMIC_ACQUIRE, "agent");
            xb_add(&bar[XB_XGEN(b.x)], 1u);
            asm volatile("s_waitcnt vmcnt(0)" ::: "memory");
        } else {
            XB_SPIN(xb_ld(&bar[XB_XGEN(b.x)]) == gen, bar);
            __builtin_amdgcn_fence(__ATOMIC_ACQUIRE, "agent");
            asm volatile("s_waitcnt vmcnt(0)" ::: "memory");
        }
    }
    __syncthreads();
}
constexpr int GT = 128;
constexpr int PROWS_G = NTOK * 2 + NE * GT;
constexpr int PTILES_G = PROWS_G / GT;
template <class Epi>
__device__ __forceinline__ void gg_gemm(float* lds, const float* __restrict__ A, int lda, const int* rowidx, const float* __restrict__ B, int ldb, size_t bstride,
                        const int* tile_expert, int M, int N, int K, const Epi& epi, int bid, int nb) {
    float* As = lds;
    float* Bs = lds + 16 * 132;
    const int tid = otid(), lane = tid & 63, wid = tid >> 6, wm = wid >> 1, wn = wid & 1;
    const int tilesN = (N + 127) / 128, tilesM = M / 128;
    for (int tile = bid; tile < tilesM * tilesN; tile += nb) {
        const int tm = tile / tilesN, tn = tile % tilesN;
        const float* Bp = B;
        if (tile_expert) { const int e = tile_expert[tm]; if (e < 0) continue; Bp = B + (size_t)e * bstride; }
        f32x16 acc0, acc1;
#pragma unroll
        for (int i = 0; i < 16; ++i) { acc0[i] = 0.f; acc1[i] = 0.f; }
        const int arow = tid >> 2, akq = (tid & 3) * 4;
        int asrc = tm * 128 + arow;
        if (rowidx) asrc = rowidx[asrc];
        const int bk = tid >> 5, bn4 = (tid & 31) * 4, bcol = tn * 128 + bn4;
        for (int k0 = 0; k0 < K; k0 += 16) {
            f32x4 av = {0.f, 0.f, 0.f, 0.f};
            if (asrc >= 0) av = *(const f32x4*)(A + (size_t)asrc * lda + k0 + akq);
            f32x4 bv = {0.f, 0.f, 0.f, 0.f};
            if (bcol < N) bv = *(const f32x4*)(Bp + (size_t)(k0 + bk) * ldb + bcol);
            __syncthreads();
            As[(akq + 0) * 132 + arow] = av[0]; As[(akq + 1) * 132 + arow] = av[1]; As[(akq + 2) * 132 + arow] = av[2]; As[(akq + 3) * 132 + arow] = av[3];
            *(f32x4*)(Bs + bk * 128 + bn4) = bv;
            __syncthreads();
#pragma unroll
            for (int kk = 0; kk < 16; kk += 2) {
                const int kr = kk + (lane >> 5);
                const float a = As[kr * 132 + wm * 32 + (lane & 31)];
                const float b0 = Bs[kr * 128 + wn * 64 + (lane & 31)];
                const float b1 = Bs[kr * 128 + wn * 64 + 32 + (lane & 31)];
                acc0 = __builtin_amdgcn_mfma_f32_32x32x2f32(a, b0, acc0, 0, 0, 0);
                acc1 = __builtin_amdgcn_mfma_f32_32x32x2f32(a, b1, acc1, 0, 0, 0);
            }
        }
#pragma unroll
        for (int r = 0; r < 16; ++r) {
            const int row = tm * 128 + wm * 32 + (r & 3) + 8 * (r >> 2) + 4 * (lane >> 5);
            const int c0 = tn * 128 + wn * 64 + (lane & 31);
            if (c0 < N) epi(row, c0, acc0[r]);
            if (c0 + 32 < N) epi(row, c0 + 32, acc1[r]);
        }
        __syncthreads();
    }
}
__device__ __forceinline__ void gold_normmod(const float* __restrict__ x, const float* __restrict__ g, const float* mod, int shift_idx, int scale_idx, float* __restrict__ out, int bid, int nb) {
    const int tid_ = otid(), lane = tid_ & 63, wv = tid_ >> 6;
    for (int row = bid * 8 + wv; row < NTOK; row += nb * 8) {
        const int b = row / SEQ;
        const f32x4* xr = (const f32x4*)(x + (size_t)row * D) + lane;
        f32x4 v[4]; float s = 0.f;
#pragma unroll
        for (int j = 0; j < 4; ++j) { v[j] = xr[64 * j]; s += v[j][0] * v[j][0] + v[j][1] * v[j][1] + v[j][2] * v[j][2] + v[j][3] * v[j][3]; }
        const float r = rsqrtf(wave_sum(s) * (1.0f / D) + 1e-6f);
        const float* sh = mod + b * 6 * D + shift_idx * D; const float* sc = mod + b * 6 * D + scale_idx * D;
        f32x4* o = (f32x4*)(out + (size_t)row * D) + lane;
#pragma unroll
        for (int j = 0; j < 4; ++j) {
            const int c0 = (lane + 64 * j) * 4; f32x4 y;
#pragma unroll
            for (int q = 0; q < 4; ++q) y[q] = v[j][q] * r * g[c0 + q] * (1.0f + sc[c0 + q]) + sh[c0 + q];
            o[64 * j] = y;
        }
    }
}
__device__ __forceinline__ void gold_gmlp_ln(PRef p, const bf16* Z, float* vln, int bid, int nb) {
    const float* lw = p.in[I_GLNW]; const float* lb = p.in[I_GLNB];
    const int tid_ = otid(), lane = tid_ & 63, wv = tid_ >> 6;
    for (int row = bid * 8 + wv; row < NTOK; row += nb * 8) {
        const bf16* vr = Z + (size_t)row * ZLD + 512;
        float v[8]; float s = 0.f;
#pragma unroll
        for (int j = 0; j < 8; ++j) { v[j] = bf2f(vr[lane + 64 * j]); s += v[j]; }
        const float m = wave_sum(s) * (1.0f / 512.f); float q = 0.f;
#pragma unroll
        for (int j = 0; j < 8; ++j) { const float d = v[j] - m; q += d * d; }
        const float rs = rsqrtf(wave_sum(q) * (1.0f / 512.f) + 1e-5f);
#pragma unroll
        for (int j = 0; j < 8; ++j) { const int c = lane + 64 * j; vln[(size_t)row * 512 + c] = (v[j] - m) * rs * lw[c] + lb[c]; }
    }
}
__device__ __forceinline__ void gold_gmlp_mix(PRef p, const bf16* Z, const float* vln, float* ycat, int bid, int nb) {
    const float* wsp = p.in[I_GWS]; const float* bsp = p.in[I_GBS];
    for (int t = bid; t < NTOK; t += nb) {
        const int c = otid(), h = c >> 6, tl = t & 127, t0 = t - tl;
        const float* wrow = wsp + ((size_t)h * CHUNK + tl) * CHUNK;
        float s = 0.f;
        for (int ss = 0; ss <= tl; ++ss) s = fmaf(wrow[ss], vln[(size_t)(t0 + ss) * 512 + c], s);
        s += bsp[h * CHUNK + tl];
        ycat[(size_t)t * 1024 + c] = bf2f(Z[(size_t)t * ZLD + c]) * s;
    }
}
constexpr int NPT = 8192;
__device__ __forceinline__ void gold_rwkv_prep(PRef p, float* lds, const bf16* Z, float* SC, float* RKo, int part, int bid, int nb) {
    constexpr size_t AS = (size_t)NPT * 512;
    float *Ro = SC, *Wo = SC + AS, *Ko = SC + 2 * AS, *Vo = SC + 3 * AS, *Ao = SC + 4 * AS, *Bo = SC + 5 * AS, *Go = SC + 6 * AS;
    const float* mu = p.in[I_MU];
    float* zs = lds;
    const int c = otid(), lane = c & 63, h = c >> 6;
    for (int tl = bid; tl < NPT; tl += nb) {
        const int t = part * NPT + tl;
        __syncthreads();
        for (int j = c; j < RPROJ; j += NTHR) {
            const float cur = bf2f(Z[(size_t)t * ZLD + 1024 + j]);
            const float prev = (t % SEQ == 0) ? 0.f : bf2f(Z[(size_t)(t - 1) * ZLD + 1024 + j]);
            float z = cur + (prev - cur) * mu[j];
            if (j >= 1536 && j < 1568) z = tanhf(z);
            if (j >= 1600) z = sigmoidf_(z);
            zs[j] = z;
        }
        __syncthreads();
        const float r = zs[c], k = zs[512 + c], v = zs[1024 + c];
        float dw = 0.f, da = 0.f, g = 0.f;
#pragma unroll 4
        for (int j = 0; j < 32; ++j) dw = fmaf(zs[1536 + j], p.in[I_W2][j * 512 + c], dw);
#pragma unroll 4
        for (int j = 0; j < 32; ++j) da = fmaf(zs[1568 + j], p.in[I_A2][j * 512 + c], da);
#pragma unroll 4
        for (int j = 0; j < 96; ++j) g = fmaf(zs[1600 + j], p.in[I_G2][j * 512 + c], g);
        const float wlog = -softplusf_(-(p.in[I_W0][c] + dw)) - 0.5f;
        const float decay = expf(-expf(wlog));
        const float asig = sigmoidf_(p.in[I_A0][c] + da);
        const float kkv = k * p.in[I_KK][c];
        const float nrm = sqrtf(wave_sum(kkv * kkv));
        const float kk = kkv / fmaxf(nrm, 1e-12f);
        const float k2 = k * (1.0f + (asig - 1.0f) * p.in[I_KA][c]);
        const float rk = wave_sum(r * k2 * p.in[I_RK][c]);
        const size_t o = (size_t)tl * 512 + c;
        Ro[o] = r; Wo[o] = decay; Ko[o] = k2; Vo[o] = v; Ao[o] = -kk; Bo[o] = kk * asig; Go[o] = g;
        if (lane == 0) RKo[tl * 8 + h] = rk;
    }
}
__device__ __forceinline__ void gold_rwkv_prep_lo(PRef p, float* lds, const bf16* Z, const bf16* LO, float* SC, float* RKo, int part, int bid, int nb) {
    constexpr size_t AS = (size_t)NPT * 512;
    float *Ro = SC, *Wo = SC + AS, *Ko = SC + 2 * AS, *Vo = SC + 3 * AS, *Ao = SC + 4 * AS, *Bo = SC + 5 * AS, *Go = SC + 6 * AS;
    const float* mu = p.in[I_MU];
    const int c = otid(), lane = c & 63, h = c >> 6;
    for (int tl = bid; tl < NPT; tl += nb) {
        const int t = part * NPT + tl;
        float z3[3];
#pragma unroll
        for (int q = 0; q < 3; ++q) { const int j = q * 512 + c;
            const float cur = bf2f(Z[(size_t)t * ZLD + 1024 + j]);
            const float prev = (t % SEQ == 0) ? 0.f : bf2f(Z[(size_t)(t - 1) * ZLD + 1024 + j]);
            z3[q] = cur + (prev - cur) * mu[j]; }
        const float r = z3[0], k = z3[1], v = z3[2];
        const float decay = expf(bf2f(LO[(size_t)t * 1536 + c]));
        const float asig = bf2f(LO[(size_t)t * 1536 + 512 + c]);
        const float g = bf2f(LO[(size_t)t * 1536 + 1024 + c]);
        const float kkv = k * p.in[I_KK][c];
        const float nrm = sqrtf(wave_sum(kkv * kkv));
        const float kk = kkv / fmaxf(nrm, 1e-12f);
        const float k2 = k * (1.0f + (asig - 1.0f) * p.in[I_KA][c]);
        const float rk = wave_sum(r * k2 * p.in[I_RK][c]);
        const size_t o = (size_t)tl * 512 + c;
        Ro[o] = r; Wo[o] = decay; Ko[o] = k2; Vo[o] = v; Ao[o] = -kk; Bo[o] = kk * asig; Go[o] = g;
        if (lane == 0) RKo[tl * 8 + h] = rk;
    }
}
template <class YT>
__device__ __forceinline__ void gold_rwkv_scan(PRef p, float* lds, const float* SC, const float* RKi, YT* ycat, int part, int bid, int nb) {
    constexpr size_t AS = (size_t)NPT * 512;
    const float *Ri = SC, *Wi = SC + AS, *Ki = SC + 2 * AS, *Vi = SC + 3 * AS, *Ai = SC + 4 * AS, *Bi = SC + 5 * AS, *Gi = SC + 6 * AS;
    constexpr int TS = 16;
    float* vec = lds;
    float* vb = lds + 5 * TS * 64;
    float* yb = vb + TS * 64;
    const int tid = otid(), lane = tid & 63, wv = tid >> 6;
    for (int item = bid; item < (NPT / SEQ) * 8; item += nb) {
        const int bl = item >> 3, h = item & 7;
        float S[64];
#pragma unroll
        for (int k = 0; k < 64; ++k) S[k] = 0.f;
        for (int c0 = 0; c0 < SEQ; c0 += TS) {
            __syncthreads();
            for (int i = tid; i < 6 * TS * 64; i += NTHR) {
                const int arr = i / (TS * 64), rem = i % (TS * 64), s = rem >> 6, d = rem & 63;
                const size_t src = ((size_t)(bl * SEQ + c0 + s)) * 512 + h * 64 + d;
                const float* ap = arr == 0 ? Ri : arr == 1 ? Wi : arr == 2 ? Ki : arr == 3 ? Ai : arr == 4 ? Bi : Vi;
                const float val = ap[src];
                if (arr < 5) vec[(arr * TS + s) * 64 + d] = val; else vb[s * 64 + d] = val;
            }
            __syncthreads();
            if (wv == 0) {
                for (int s = 0; s < TS; ++s) {
                    const float* rr = vec + (0 * TS + s) * 64; const float* ww = vec + (1 * TS + s) * 64; const float* kk = vec + (2 * TS + s) * 64;
                    const float* aa = vec + (3 * TS + s) * 64; const float* bb = vec + (4 * TS + s) * 64;
                    const float vv = vb[s * 64 + lane];
                    float sa = 0.f;
#pragma unroll
                    for (int k = 0; k < 64; ++k) sa = fmaf(S[k], aa[k], sa);
                    float y = 0.f;
#pragma unroll
                    for (int k = 0; k < 64; ++k) { S[k] = fmaf(S[k], ww[k], fmaf(sa, bb[k], vv * kk[k])); y = fmaf(S[k], rr[k], y); }
                    yb[s * 64 + lane] = y;
                }
            }
            __syncthreads();
            for (int s = wv; s < TS; s += 8) {
                const int tl = bl * SEQ + c0 + s; const int t = part * NPT + tl; const int c = h * 64 + lane;
                const float y = yb[s * 64 + lane];
                const float m = wave_sum(y) * (1.0f / 64.f); const float dlt = y - m;
                const float var = wave_sum(dlt * dlt) * (1.0f / 64.f);
                float o = dlt * rsqrtf(var + 64e-5f) * p.in[I_GNW][c] + p.in[I_GNB][c];
                o += RKi[tl * 8 + h] * Vi[(size_t)tl * 512 + c];
                o *= Gi[(size_t)tl * 512 + c];
                if (sizeof(YT) == 2) ((bf16*)ycat)[(size_t)t * 1024 + 512 + c] = (bf16)f2bf(o); else ((float*)ycat)[(size_t)t * 1024 + 512 + c] = o;
            }
        }
    }
}
struct GEpiOutproj {
    const float* x; const float* mod; float* x1;
    __device__ __forceinline__ void operator()(int row, int col, float v) const {
        const int b = row / SEQ;
        x1[(size_t)row * D + col] = x[(size_t)row * D + col] + mod[b * 6 * D + 2 * D + col] * v;
    }
};
__device__ __forceinline__ void gold_norm2_route(PRef p, float* lds, const float* x1, float* h2, int bid, int nb) {
    const float* mod = (const float*)(p.ws + W_MOD);
    int* toke = (int*)(p.ws + T_TOKE); float* tokw = (float*)(p.ws + T_TOKW); int* cnt = (int*)(p.ws + T_CTL);
    const float* g = p.in[I_N2G]; const float* rgw = p.in[I_RGW]; const float* rew = p.in[I_REW];
    const int tid_ = otid(), lane = tid_ & 63, wv = tid_ >> 6;
    for (int row = bid * 8 + wv; row < NTOK; row += nb * 8) {
        const int b = row / SEQ;
        const float* xr = x1 + (size_t)row * D;
        float s = 0.f;
#pragma unroll 4
        for (int j = 0; j < 16; ++j) { const float xv = xr[lane + 64 * j]; s += xv * xv; }
        const float r = rsqrtf(wave_sum(s) * (1.0f / D) + 1e-6f);
        const float* sh = mod + b * 6 * D + 3 * D; const float* sc = mod + b * 6 * D + 4 * D;
        float lg[36];
#pragma unroll
        for (int j = 0; j < 36; ++j) lg[j] = 0.f;
#pragma unroll 1
        for (int j = 0; j < 16; ++j) {
            const int c = lane + 64 * j;
            const float hv = xr[c] * r * g[c] * (1.0f + sc[c]) + sh[c];
            h2[(size_t)row * D + c] = hv;
#pragma unroll
            for (int q = 0; q < 4; ++q) lg[q] = fmaf(hv, rgw[c * 4 + q], lg[q]);
#pragma unroll
            for (int q = 0; q < 32; ++q) lg[4 + q] = fmaf(hv, rew[c * 32 + q], lg[4 + q]);
        }
#pragma unroll
        for (int j = 0; j < 36; ++j) lg[j] = wave_sum(lg[j]);
        float* wl = lds + wv * 64;
        if (lane == 0) {
#pragma unroll
            for (int j = 0; j < 36; ++j) wl[j] = lg[j];
            float gm = -1e30f; int gi = 0;
            for (int q = 0; q < 4; ++q) { const float t = wl[q] + p.in[I_RGB][q]; if (t > gm) { gm = t; gi = q; } }
            float gs = 0.f; for (int q = 0; q < 4; ++q) gs += expf(wl[q] + p.in[I_RGB][q] - gm);
            const float gp = 1.0f / gs;
            float* el = wl + 40;
            for (int q = 0; q < 8; ++q) el[q] = wl[4 + gi * 8 + q] + p.in[I_REB][gi * 8 + q];
            int i0 = 0; for (int q = 1; q < 8; ++q) if (el[q] > el[i0]) i0 = q;
            int i1 = (i0 == 0) ? 1 : 0; for (int q = 0; q < 8; ++q) if (q != i0 && el[q] > el[i1]) i1 = q;
            const float em = el[i0];
            const float p0 = 1.0f, p1 = expf(el[i1] - em);
            const float w0 = gp * p0 / (p0 + p1), w1 = gp * p1 / (p0 + p1);
            const int e0 = gi * 8 + i0, e1 = gi * 8 + i1;
            toke[row * 2] = e0; toke[row * 2 + 1] = e1; tokw[row * 2] = w0; tokw[row * 2 + 1] = w1;
            atomicAdd(&cnt[e0], 1); atomicAdd(&cnt[e1], 1);
        }
    }
}
__device__ __forceinline__ void gold_moe_init(PRef p, int bid, int nb) {
    int* rowtok = (int*)(p.ws + T_ROWTOK); int* rowaid = (int*)(p.ws + T_ROWAID); float* roww = (float*)(p.ws + T_ROWW); int* tilee = (int*)(p.ws + T_TILEE);
    const int* cnt = (const int*)(p.ws + T_CTL);
    for (int i = bid * NTHR + otid(); i < PROWS_G; i += nb * NTHR) { rowtok[i] = -1; rowaid[i] = -1; roww[i] = 0.f; }
    if (bid == 0 && otid() == 0) {
        int t = 0;
        for (int e = 0; e < NE; ++e) { const int nt = (cnt[e] + GT - 1) / GT; for (int j = 0; j < nt; ++j) tilee[t++] = e; }
        for (; t < PTILES_G; ++t) tilee[t] = -1;
    }
}
__device__ __forceinline__ void gold_moe_place(PRef p, int bid, int nb) {
    int* rowtok = (int*)(p.ws + T_ROWTOK); int* rowaid = (int*)(p.ws + T_ROWAID); float* roww = (float*)(p.ws + T_ROWW);
    const int* cnt = (const int*)(p.ws + T_CTL); int* cursor = (int*)(p.ws + T_CTL + 128);
    const int* toke = (const int*)(p.ws + T_TOKE); const float* tokw = (const float*)(p.ws + T_TOKW);
    for (int a = bid * NTHR + otid(); a < NTOK * 2; a += nb * NTHR) {
        const int e = toke[a];
        int start = 0; for (int q = 0; q < e; ++q) start += (cnt[q] + GT - 1) / GT * GT;
        const int pos = start + atomicAdd(&cursor[e], 1);
        rowtok[pos] = a >> 1; rowaid[pos] = a; roww[pos] = tokw[a];
    }
}
struct GEpiGate { float* hb; __device__ __forceinline__ void operator()(int row, int col, float v) const { hb[(size_t)row * EH + col] = v; } };
struct GEpiUp { float* hb; __device__ __forceinline__ void operator()(int row, int col, float v) const { const float g = hb[(size_t)row * EH + col]; hb[(size_t)row * EH + col] = g / (1.0f + expf(-g)) * v; } };
struct GEpiDown {
    const int* rowaid; const float* roww; float* y0; float* y1;
    __device__ __forceinline__ void operator()(int row, int col, float v) const {
        const int a = rowaid[row]; if (a < 0) return;
        float* y = (a & 1) ? y1 : y0;
        y[(size_t)(a >> 1) * D + col] = roww[row] * v;
    }
};
__device__ __forceinline__ void gold_final(PRef p, const float* x1, const float* y0, const float* y1, int bid, int nb) {
    const float* mod = (const float*)(p.ws + W_MOD);
    float* out = p.out; const float* g = p.in[I_FNG];
    const int tid_ = otid(), lane = tid_ & 63, wv = tid_ >> 6;
    for (int row = bid * 8 + wv; row < NTOK; row += nb * 8) {
        const int b = row / SEQ; const float* gt = mod + b * 6 * D + 5 * D;
        float v[16]; float s = 0.f;
#pragma unroll
        for (int j = 0; j < 16; ++j) { const int c = lane + 64 * j; const size_t o = (size_t)row * D + c; v[j] = x1[o] + gt[c] * (y0[o] + y1[o]); s += v[j] * v[j]; }
        const float r = rsqrtf(wave_sum(s) * (1.0f / D) + 1e-6f);
#pragma unroll
        for (int j = 0; j < 16; ++j) { const int c = lane + 64 * j; out[(size_t)row * D + c] = v[j] * r * g[c]; }
    }
}
struct TrItem { const float* W; bf16* WT; int K, N; long row_off; int item; };
__device__ __forceinline__ void p0_tr_load(const TrItem& it, float (&tv)[32], int lane) {
    const int nblk = it.N / 32, kb = it.item / nblk, nb = it.item % nblk, k0 = 64 * kb, n0 = 32 * nb;
#pragma unroll
    for (int i = 0; i < 32; ++i) tv[i] = it.W[(size_t)(k0 + 2 * i + (lane >> 5)) * it.N + n0 + (lane & 31)];
}
__device__ __forceinline__ void p0_tr_store(const TrItem& it, const float (&tv)[32], LAS float* scr, int lane) {
    const int nblk = it.N / 32, kb = it.item / nblk, nb = it.item % nblk, k0 = 64 * kb, n0 = 32 * nb;
#pragma unroll
    for (int i = 0; i < 32; ++i) scr[(2 * i + (lane >> 5)) * 33 + (lane & 31)] = tv[i];
    asm volatile("s_waitcnt lgkmcnt(0)" ::: "memory");
    const int c = lane & 7;
#pragma unroll
    for (int j = 0; j < 4; ++j) { const int n = (lane >> 3) + 8 * j; const LAS float* s = scr + (8 * c) * 33 + n;
        u32x4 o; o.x = pk2(s[0 * 33], s[1 * 33]); o.y = pk2(s[2 * 33], s[3 * 33]); o.z = pk2(s[4 * 33], s[5 * 33]); o.w = pk2(s[6 * 33], s[7 * 33]);
        *(u32x4*)(it.WT + (size_t)(it.row_off + n0 + n) * it.K + k0 + 8 * c) = o; }
    asm volatile("s_waitcnt lgkmcnt(0)" ::: "memory");
}
__device__ __forceinline__ void p0_mod_item(PRef p, LAS float* red, int item) {
    const int tid = otid(), col = tid & 63, ks = __builtin_amdgcn_readfirstlane(tid >> 6), n = item * 64 + col;
    const float* __restrict__ c = p.in[I_C]; const float* __restrict__ w = p.in[I_ADAW];
    float acc[8];
#pragma unroll
    for (int b = 0; b < 8; ++b) acc[b] = 0.f;
#pragma unroll 4
    for (int k = ks * 128; k < ks * 128 + 128; ++k) {
        const float wv = w[(size_t)k * (6 * D) + n];
#pragma unroll
        for (int b = 0; b < 8; ++b) acc[b] = fmaf(c[b * D + k], wv, acc[b]);
    }
#pragma unroll
    for (int b = 0; b < 8; ++b) red[(ks * 8 + b) * 64 + col] = acc[b];
    __syncthreads();
    { const int b = tid >> 6; float s = 0.f;
#pragma unroll
      for (int q = 0; q < 8; ++q) s += red[(q * 8 + b) * 64 + col];
      ((float*)(p.ws + W_MOD))[b * 6 * D + n] = s + p.in[I_ADAB][n]; }
    __syncthreads();
}
template <bool WITH_MOE>
__device__ __forceinline__ void p0_prep(PRef p, LAS unsigned char* lds, int bid, int nb) {
    const int tid = otid(), lane = tid & 63, wave = __builtin_amdgcn_readfirstlane(tid >> 6);
    for (int it = bid; it < 96; it += nb) p0_mod_item(p, (LAS float*)lds, it);
    { bf16* lt = (bf16*)(p.ws + W_LORAT);
      for (int i = bid * NTHR + tid; i < 1536 * 256; i += nb * NTHR) { const int n = i >> 8, k = i & 255; float v = 0.f;
          if (n < 512) { if (k < 32) v = p.in[I_W2][k * 512 + n]; }
          else if (n < 1024) { if (k >= 32 && k < 64) v = p.in[I_A2][(k - 32) * 512 + (n - 512)]; }
          else { if (k >= 64 && k < 160) v = p.in[I_G2][(k - 64) * 512 + (n - 1024)]; }
          lt[i] = (bf16)f2bf(v); }
      bf16* wc = (bf16*)(p.ws + W_WC);
      for (int i = bid * NTHR + tid; i < 8 * 128 * 128; i += nb * NTHR) { const int s = i & 127, t = (i >> 7) & 127; wc[i] = (s <= t) ? (bf16)f2bf(p.in[I_GWS][i]) : (bf16)0; }
      bf16* wpad = (bf16*)(p.ws + W_WINT) + (size_t)INW * D;
      for (int i = bid * NTHR + tid; i < (ZLD - INW) * D; i += nb * NTHR) wpad[i] = 0; }
    LAS float* scr = (LAS float*)(lds + wave * 16384);
    const int gw = bid * 8 + wave, NGW = nb * 8;
    constexpr int I_IN = (D / 64) * (INW / 32), I_OUT = (D / 64) * (D / 32), I_GU = (D / 64) * (EH / 32), I_DN = (EH / 64) * (D / 32);
    constexpr int NIT = I_IN + I_OUT + (WITH_MOE ? NE * (2 * I_GU + I_DN) : 0);
    auto decode = [&](int it) -> TrItem {
        int r = it;
        if (r < I_IN) return TrItem{p.in[I_WIN], (bf16*)(p.ws + W_WINT), D, INW, 0, r}; r -= I_IN;
        if (r < I_OUT) return TrItem{p.in[I_WOUT], (bf16*)(p.ws + W_WOUTT), D, D, 0, r}; r -= I_OUT;
        const int e = r / (2 * I_GU + I_DN); r -= e * (2 * I_GU + I_DN);
        if (r < 2 * I_GU) {
            const int up = r >= I_GU; if (up) r -= I_GU;
            const int nbk = r % (EH / 32), hb = nbk * 32;
            const long row_off = (long)e * 1024 + (hb / 128) * 256 + up * 128 + (hb % 128) - hb;
            return TrItem{(up ? p.in[I_WU] : p.in[I_WG]) + (size_t)e * D * EH, (bf16*)(p.ws + W_WGUT), D, EH, row_off, r}; }
        r -= 2 * I_GU;
        return TrItem{p.in[I_WD] + (size_t)e * EH * D, (bf16*)(p.ws + W_WDT), EH, D, (long)e * 1024, r};
    };
    float tvA[32], tvB[32];
    int it = gw;
    if (it < NIT) { TrItem cur = decode(it); p0_tr_load(cur, tvA, lane);
#pragma unroll 1
        for (;;) {
            const int itn = it + NGW; TrItem nxt = cur;
            if (itn < NIT) { nxt = decode(itn); p0_tr_load(nxt, tvB, lane); }
            p0_tr_store(cur, tvA, scr, lane);
            if (itn >= NIT) break;
            const int itn2 = itn + NGW; cur = nxt;
            if (itn2 < NIT) { cur = decode(itn2); p0_tr_load(cur, tvA, lane); }
            p0_tr_store(nxt, tvB, scr, lane);
            if (itn2 >= NIT) break;
            it = itn2;
        } }
}
__device__ __forceinline__ void p1_h1(PRef p, int bid, int nb) {
    const float* __restrict__ x = p.in[I_X]; const float* __restrict__ g = p.in[I_N1G]; const float* mod = (const float*)(p.ws + W_MOD);
    bf16* H1 = (bf16*)(p.ws + W_H1);
    const int tid_ = otid(), lane = tid_ & 63, wv = tid_ >> 6;
    for (int row = bid * 8 + wv; row < NTOK; row += nb * 8) {
        const int b = row / SEQ;
        const f32x4* xr = (const f32x4*)(x + (size_t)row * D) + lane;
        f32x4 v[4]; float s = 0.f;
#pragma unroll
        for (int j = 0; j < 4; ++j) { v[j] = xr[64 * j]; s += v[j][0] * v[j][0] + v[j][1] * v[j][1] + v[j][2] * v[j][2] + v[j][3] * v[j][3]; }
        const float r = rsqrtf(wave_sum_dpp(s) * (1.0f / D) + 1e-6f);
        const float* sh = mod + b * 6 * D; const float* sc = mod + b * 6 * D + D;
        u32x2* o = (u32x2*)(H1 + (size_t)row * D) + lane;
#pragma unroll
        for (int j = 0; j < 4; ++j) {
            const int c0 = (lane + 64 * j) * 4;
            const f32x4 gg = *(const f32x4*)(g + c0), ss = *(const f32x4*)(sc + c0), hh = *(const f32x4*)(sh + c0);
            f32x4 y;
#pragma unroll
            for (int q = 0; q < 4; ++q) y[q] = v[j][q] * r * gg[q] * (1.0f + ss[q]) + hh[q];
            u32x2 w; w.x = pk2(y[0], y[1]); w.y = pk2(y[2], y[3]);
            o[64 * j] = w;
        }
    }
}
struct EpiZ {
    static constexpr bool PERM = true, AFTER_DRAIN = false;
    bf16* Z;
    __device__ __forceinline__ void operator()(const f32x4 (&acc)[2][2][4][2], const pg8::Unit& u, int wr, int wc, int fr, int fq) const {
        const int row0 = u.pm * 256 + wr * 64 + fr, col0 = u.pn * 256 + wc * 32 + 8 * fq;
        const bool act = u.pn < 4;
#pragma unroll
        for (int ai = 0; ai < 2; ++ai)
#pragma unroll
            for (int m = 0; m < 4; ++m) { bf16* rowp = Z + (size_t)(row0 + ai * 128 + m * 16) * ZLD + col0;
#pragma unroll
                for (int bj = 0; bj < 2; ++bj) { f32x4 v0 = acc[ai][bj][m][0], v1 = acc[ai][bj][m][1];
                    if (act) {
#pragma unroll
                        for (int q = 0; q < 4; ++q) { v0[q] = gelu_fast(v0[q]); v1[q] = gelu_fast(v1[q]); } }
                    u32x4 w; w.x = pg8::cvt_pk_bf16(v0[0], v0[1]); w.y = pg8::cvt_pk_bf16(v0[2], v0[3]); w.z = pg8::cvt_pk_bf16(v1[0], v1[1]); w.w = pg8::cvt_pk_bf16(v1[2], v1[3]);
                    *(u32x4*)(rowp + bj * 128) = w; } }
    }
};
constexpr int VNT_PITCH = 272;
__device__ __forceinline__ void p3_gmlp_unit(PRef p, LAS unsigned char* lds, int chunk) {
    typedef short bf16x8 __attribute__((ext_vector_type(8)));
    const int tid = otid(), lane = tid & 63, wave = __builtin_amdgcn_readfirstlane(tid >> 6);
    const bf16* Z = (const bf16*)(p.ws + W_Z); bf16* ycat = (bf16*)(p.ws + W_YCAT);
    const int t0 = chunk * CHUNK;
    { float lw[8], lb[8];
#pragma unroll
      for (int j = 0; j < 8; ++j) { lw[j] = p.in[I_GLNW][lane + 64 * j]; lb[j] = p.in[I_GLNB][lane + 64 * j]; }
      for (int sp = 0; sp < 8; ++sp) {
          const int s = wave * 16 + sp * 2;
          const bf16* v0p = Z + (size_t)(t0 + s) * ZLD + 512 + lane; const bf16* v1p = v0p + ZLD;
          float a[8], b[8]; float sa = 0.f, sb = 0.f;
#pragma unroll
          for (int j = 0; j < 8; ++j) { a[j] = bf2f(v0p[64 * j]); b[j] = bf2f(v1p[64 * j]); sa += a[j]; sb += b[j]; }
          const float ma = wave_sum_dpp(sa) * (1.f / 512.f), mb = wave_sum_dpp(sb) * (1.f / 512.f); float qa = 0.f, qb = 0.f;
#pragma unroll
          for (int j = 0; j < 8; ++j) { a[j] -= ma; b[j] -= mb; qa += a[j] * a[j]; qb += b[j] * b[j]; }
          const float ra = rsqrtf(wave_sum_dpp(qa) * (1.f / 512.f) + 1e-5f), rb = rsqrtf(wave_sum_dpp(qb) * (1.f / 512.f) + 1e-5f);
#pragma unroll
          for (int j = 0; j < 8; ++j) { const unsigned w = pk2(a[j] * ra * lw[j] + lb[j], b[j] * rb * lw[j] + lb[j]);
              *(LAS unsigned*)(lds + (lane + 64 * j) * VNT_PITCH + s * 2) = w; }
      } }
    __syncthreads();
    const bf16* Wc = (const bf16*)(p.ws + W_WC) + (size_t)wave * CHUNK * CHUNK;
    const int fr = lane & 15, fq = lane >> 4;
    const LAS unsigned char* abase = lds + (wave * 64 + fr) * VNT_PITCH + fq * 16;
    for (int tt = 0; tt < 8; ++tt) {
        f32x4 acc[4];
#pragma unroll
        for (int dt = 0; dt < 4; ++dt) acc[dt] = (f32x4){0.f, 0.f, 0.f, 0.f};
        const int nks = ((tt * 16 + 15) >> 5) + 1;
        for (int ks = 0; ks < nks; ++ks) {
            const bf16x8 bfr = *(const bf16x8*)(Wc + (size_t)(tt * 16 + fr) * CHUNK + ks * 32 + fq * 8);
#pragma unroll
            for (int dt = 0; dt < 4; ++dt) {
                const bf16x8 afr = *(const LAS bf16x8*)(abase + dt * 16 * VNT_PITCH + ks * 64);
                acc[dt] = __builtin_amdgcn_mfma_f32_16x16x32_bf16(afr, bfr, acc[dt], 0, 0, 0);
            }
        }
        const int tl = tt * 16 + fr, t = t0 + tl;
        const float bsv = p.in[I_GBS][wave * CHUNK + tl];
#pragma unroll
        for (int dt = 0; dt < 4; ++dt) {
            const int c = wave * 64 + dt * 16 + fq * 4;
            const u32x2 uw = *(const u32x2*)(Z + (size_t)t * ZLD + c);
            u32x2 o; o.x = pk2(bflo(uw.x) * (acc[dt][0] + bsv), bfhi(uw.x) * (acc[dt][1] + bsv)); o.y = pk2(bflo(uw.y) * (acc[dt][2] + bsv), bfhi(uw.y) * (acc[dt][3] + bsv));
            *(u32x2*)(ycat + (size_t)t * 1024 + c) = o;
        }
    }
    __syncthreads();
}
struct EpiX1 {
    static constexpr bool PERM = false, AFTER_DRAIN = false;
    const float* x; const float* mod; float* x1;
    __device__ __forceinline__ void operator()(const f32x4 (&acc)[2][2][4][2], const pg8::Unit& u, int wr, int wc, int fr, int fq) const {
        const int row0 = u.pm * 256 + wr * 64 + fr, col0 = u.pn * 256 + wc * 32 + 4 * fq;
        const int b = (u.pm * 256) / SEQ;
        const float* gt = mod + b * 6 * D + 2 * D;
        f32x4 gv[2][2];
#pragma unroll
        for (int bj = 0; bj < 2; ++bj)
#pragma unroll
            for (int n = 0; n < 2; ++n) gv[bj][n] = *(const f32x4*)(gt + col0 + bj * 128 + n * 16);
#pragma unroll
        for (int ai = 0; ai < 2; ++ai)
#pragma unroll
            for (int m = 0; m < 4; ++m) { const size_t off = (size_t)(row0 + ai * 128 + m * 16) * D + col0;
#pragma unroll
                for (int bj = 0; bj < 2; ++bj)
#pragma unroll
                    for (int n = 0; n < 2; ++n) { const f32x4 xv = *(const f32x4*)(x + off + bj * 128 + n * 16);
                        *(f32x4*)(x1 + off + bj * 128 + n * 16) = xv + gv[bj][n] * acc[ai][bj][m][n]; } }
    }
};
constexpr size_t W_A2 = 112 * MiB;
constexpr size_t W_Q = 112 * MiB;
constexpr size_t W_Y2 = 144 * MiB;
constexpr size_t T_RK = W_TAB + 4 * MiB;
constexpr size_t O_M = 0, O_N = 64 * MiB;
constexpr size_t W_S = 176 * MiB;
constexpr int SCL = 64, NCH = SEQ / SCL;

__device__ __forceinline__ float sigmoid_fast(float x) { return __builtin_amdgcn_rcpf(1.0f + __builtin_amdgcn_exp2f(-1.4426950409f * x)); }
__device__ __forceinline__ void p3_lorain(PRef p, int bid, int nb) {
    const bf16* Z = (const bf16*)(p.ws + W_Z); bf16* A2 = (bf16*)(p.ws + W_A2);
    const int tid = otid(), j = tid & 255, sub = tid >> 8;
    const float muj = (j < 160) ? p.in[I_MU][1536 + j] : 0.f;
#pragma unroll 1
    for (int blk = bid; blk < NTOK / 128; blk += nb) {
        const int ts = blk * 128 + sub * 64;
        if (j < 160) {
            const bf16* zp = Z + (size_t)ts * ZLD + 2560 + j; bf16* ap = A2 + (size_t)ts * 256 + j;
            float prev = (ts % SEQ == 0) ? 0.f : bf2f(zp[-ZLD]);
#pragma unroll 1
            for (int t0 = 0; t0 < 64; t0 += 8) { float cur[8];
#pragma unroll
                for (int q = 0; q < 8; ++q) cur[q] = bf2f(zp[(size_t)(t0 + q) * ZLD]);
#pragma unroll
                for (int q = 0; q < 8; ++q) { float v = cur[q] + (prev - cur[q]) * muj; prev = cur[q];
                    if (j < 32) v = tanhf(v); else if (j >= 64) v = sigmoidf_(v);
                    ap[(size_t)(t0 + q) * 256] = (bf16)f2bf(v); } }
        } else { bf16* ap = A2 + (size_t)ts * 256 + j;
#pragma unroll 8
            for (int t = 0; t < 64; ++t) ap[(size_t)t * 256] = 0; }
    }
}
struct EpiLO {
    static constexpr bool PERM = true, AFTER_DRAIN = false;
    bf16* LO; const float* w0; const float* a0;
    __device__ __forceinline__ void operator()(const f32x4 (&acc)[2][2][4][2], const pg8::Unit& u, int wr, int wc, int fr, int fq) const {
        const int row0 = u.pm * 256 + wr * 64 + fr, col0 = u.pn * 256 + wc * 32 + 8 * fq, kind = u.pn >> 1;
#pragma unroll
        for (int bj = 0; bj < 2; ++bj) {
            f32x4 bv[2];
#pragma unroll
            for (int n = 0; n < 2; ++n) { const int ch = col0 + bj * 128 + 4 * n - kind * 512;
                bv[n] = kind == 0 ? *(const f32x4*)(w0 + ch) : kind == 1 ? *(const f32x4*)(a0 + ch) : (f32x4){0.f, 0.f, 0.f, 0.f}; }
#pragma unroll
            for (int ai = 0; ai < 2; ++ai)
#pragma unroll
                for (int m = 0; m < 4; ++m) { bf16* rowp = LO + (size_t)(row0 + ai * 128 + m * 16) * 1536 + col0 + bj * 128;
                    f32x4 v0 = acc[ai][bj][m][0] + bv[0], v1 = acc[ai][bj][m][1] + bv[1];
                    if (kind < 2) { const float sc = kind == 0 ? -0.6065306597f : 1.0f;
#pragma unroll
                        for (int q = 0; q < 4; ++q) { v0[q] = sc * sigmoid_fast(v0[q]); v1[q] = sc * sigmoid_fast(v1[q]); } }
                    u32x4 w; w.x = pg8::cvt_pk_bf16(v0[0], v0[1]); w.y = pg8::cvt_pk_bf16(v0[2], v0[3]); w.z = pg8::cvt_pk_bf16(v1[0], v1[1]); w.w = pg8::cvt_pk_bf16(v1[2], v1[3]);
                    *(u32x4*)rowp = w;
                    asm volatile("" ::: "memory"); }
        }
    }
};
constexpr int SC_TS = 8;
__device__ __forceinline__ void p5a_chunk(PRef p, LAS unsigned char* lds, int q) {
    typedef float f32x2 __attribute__((ext_vector_type(2)));
    const int tid_ = otid(), lane = tid_ & 63, wave = __builtin_amdgcn_readfirstlane(tid_ >> 6);
    const int seq = q / NCH, c = q % NCH, b = seq >> 3, h = seq & 7;
    const int tb = b * SEQ + c * SCL, hc = h * 64 + lane;
    const bf16* Z = (const bf16*)(p.ws + W_Z); const bf16* LO = (const bf16*)(p.ws + W_LO);
    bf16* Qo = (bf16*)(p.ws + W_Q); bf16* Y2o = (bf16*)(p.ws + W_Y2); bf16* VLo = (bf16*)(p.ws + W_YCAT); float* RKo = (float*)(p.ws + T_RK);
    LAS float* vec = (LAS float*)(lds + wave * (SC_TS * 6 * 256));
    const float mur = p.in[I_MU][hc], muk = p.in[I_MU][512 + hc], muv = p.in[I_MU][1024 + hc];
    const float kkc = p.in[I_KK][hc], kac = p.in[I_KA][hc], rkc = p.in[I_RK][hc];
    float rp = 0.f, kp = 0.f, vp = 0.f;
    if (c != 0) { const bf16* zp = Z + (size_t)(tb - 1) * ZLD + 1024 + hc; rp = bf2f(zp[0]); kp = bf2f(zp[512]); vp = bf2f(zp[1024]); }
    f32x2 Mr[32], Nr[32];
#pragma unroll
    for (int k = 0; k < 32; ++k) { Mr[k] = (f32x2){(2 * k == lane) ? 1.f : 0.f, (2 * k + 1 == lane) ? 1.f : 0.f}; Nr[k] = (f32x2){0.f, 0.f}; }
    for (int sb = 0; sb < SCL / SC_TS; ++sb) {
        const int t0 = tb + sb * SC_TS;
#pragma unroll 1
        for (int sg = 0; sg < SC_TS; sg += 4) { float zr[4], zk[4], zv[4], lw[4], as[4];
          const bf16* zp0 = Z + (unsigned)((t0 + sg) * ZLD + 1024 + hc); const bf16* lp0 = LO + (unsigned)((t0 + sg) * 1536 + hc);
#pragma unroll
          for (int s = 0; s < 4; ++s) { const bf16* zp = zp0 + s * ZLD; const bf16* lp = lp0 + s * 1536;
              zr[s] = bf2f(zp[0]); zk[s] = bf2f(zp[512]); zv[s] = bf2f(zp[1024]); lw[s] = bf2f(lp[0]); as[s] = bf2f(lp[512]); }
#pragma unroll
          for (int s = 0; s < 4; ++s) {
              const float r = zr[s] + (rp - zr[s]) * mur, k = zk[s] + (kp - zk[s]) * muk, v = zv[s] + (vp - zv[s]) * muv;
              rp = zr[s]; kp = zk[s]; vp = zv[s];
              const float kkv = k * kkc;
              const float nrm = sqrtf(wave_sum_dpp(kkv * kkv));
              const float kk = kkv / fmaxf(nrm, 1e-12f);
              const float k2 = k * (1.0f + (as[s] - 1.0f) * kac);
              const float rk = wave_sum_dpp(r * k2 * rkc);
              LAS float* o = vec + (sg + s) * 384 + lane;
              o[0] = __builtin_amdgcn_exp2f(1.4426950409f * lw[s]); o[64] = -kk; o[128] = kk * as[s]; o[192] = k2; o[256] = r; o[320] = v;
              VLo[(unsigned)((t0 + sg + s) * 1024 + 512 + hc)] = (bf16)f2bf(v);
              if (lane == 0) RKo[(unsigned)((t0 + sg + s) * 8 + h)] = rk;
          } }
        asm volatile("s_waitcnt lgkmcnt(0)" ::: "memory");
        for (int s = 0; s < SC_TS; ++s) {
            const LAS float* vs = vec + s * 384;
            const float vi = vs[320 + lane];
            f32x2 saM = {0.f, 0.f}, saN = {0.f, 0.f};
#pragma unroll
            for (int k4 = 0; k4 < 16; ++k4) { const f32x4 a4 = *(const LAS f32x4*)(vs + 64 + 4 * k4);
                const f32x2 a0 = {a4[0], a4[1]}, a1 = {a4[2], a4[3]};
                saM += Mr[2 * k4] * a0; saN += Nr[2 * k4] * a0; saM += Mr[2 * k4 + 1] * a1; saN += Nr[2 * k4 + 1] * a1;
                if ((k4 & 3) == 3) asm volatile("" ::: "memory"); }
            const float sM = saM[0] + saM[1], sN = saN[0] + saN[1];
            const f32x2 sM2 = {sM, sM}, sN2 = {sN, sN}, vi2 = {vi, vi};
            f32x2 yM = {0.f, 0.f}, yN = {0.f, 0.f};
#pragma unroll
            for (int k4 = 0; k4 < 16; ++k4) {
                const f32x4 w4 = *(const LAS f32x4*)(vs + 4 * k4), b4 = *(const LAS f32x4*)(vs + 128 + 4 * k4), k4v = *(const LAS f32x4*)(vs + 192 + 4 * k4), r4 = *(const LAS f32x4*)(vs + 256 + 4 * k4);
#pragma unroll
                for (int hh = 0; hh < 2; ++hh) {
                    const f32x2 w2 = {w4[2 * hh], w4[2 * hh + 1]}, b2 = {b4[2 * hh], b4[2 * hh + 1]}, k2 = {k4v[2 * hh], k4v[2 * hh + 1]}, r2 = {r4[2 * hh], r4[2 * hh + 1]};
                    const int kx = 2 * k4 + hh;
                    Mr[kx] = Mr[kx] * w2 + sM2 * b2;
                    Nr[kx] = Nr[kx] * w2 + (sN2 * b2 + vi2 * k2);
                    yM += Mr[kx] * r2; yN += Nr[kx] * r2;
                }
                asm volatile("" ::: "memory");
            }
            const unsigned oo = (unsigned)((t0 + s) * 512 + hc);
            Qo[oo] = (bf16)f2bf(yM[0] + yM[1]); Y2o[oo] = (bf16)f2bf(yN[0] + yN[1]);
        }
        asm volatile("s_waitcnt lgkmcnt(0)" ::: "memory");
    }
    f32x4* Mo = (f32x4*)((unsigned char*)p.out + O_M + (size_t)q * 16384 + lane * 256);
    f32x4* No = (f32x4*)((unsigned char*)p.out + O_N + (size_t)q * 16384 + lane * 256);
#pragma unroll
    for (int k4 = 0; k4 < 16; ++k4) { Mo[k4] = (f32x4){Mr[2 * k4][0], Mr[2 * k4][1], Mr[2 * k4 + 1][0], Mr[2 * k4 + 1][1]}; No[k4] = (f32x4){Nr[2 * k4][0], Nr[2 * k4][1], Nr[2 * k4 + 1][0], Nr[2 * k4 + 1][1]}; }
}
__device__ __forceinline__ void p5b_chain(PRef p, LAS unsigned char* lds, int item) {
    typedef float f32x2 __attribute__((ext_vector_type(2)));
    const int tid = otid(), r = tid >> 5, j0 = (tid & 31) * 2, seq = (item & 7) + 8 * (item >> 5), rg = (item >> 3) & 3;
    LAS float* Sl = (LAS float*)lds;
    LAS float* Ml = (LAS float*)(lds + 4096);
    const unsigned char* Mb = (const unsigned char*)p.out + O_M + (size_t)seq * NCH * 16384;
    const unsigned char* Nb = (const unsigned char*)p.out + O_N + (size_t)seq * NCH * 16384 + (size_t)(rg * 16 + r) * 256 + j0 * 4;
    unsigned char* Sb = p.ws + W_S + (size_t)seq * NCH * 16384 + (size_t)(rg * 16 + r) * 256 + j0 * 4;
    f32x2 sreg = {0.f, 0.f};
    f32x4 m0[2], m1[2], m2[2], m3[2]; f32x2 n0, n1, n2, n3;
#define P5B_LOAD(mm, nn, cc) do { const f32x4* mp = (const f32x4*)(Mb + (size_t)(cc) * 16384) + tid; mm[0] = mp[0]; mm[1] = mp[512]; nn = *(const f32x2*)(Nb + (size_t)(cc) * 16384); } while (0)
#define P5B_BAR() do { asm volatile("s_waitcnt lgkmcnt(0)" ::: "memory"); __builtin_amdgcn_s_barrier(); asm volatile("" ::: "memory"); } while (0)
#define P5B_STEP(mm, nn, cc) do { \
        P5B_BAR(); \
        *(LAS f32x4*)(Ml + tid * 4) = mm[0]; *(LAS f32x4*)(Ml + 2048 + tid * 4) = mm[1]; *(LAS f32x2*)(Sl + r * 64 + j0) = sreg; \
        *(f32x2*)(Sb + (size_t)(cc) * 16384) = sreg; \
        f32x2 acc = nn; \
        P5B_BAR(); \
        if ((cc) + 4 < NCH) P5B_LOAD(mm, nn, (cc) + 4); \
        _Pragma("unroll 16") for (int i = 0; i < 64; ++i) { const float sv = Sl[r * 64 + i]; const f32x2 mv = *(const LAS f32x2*)(Ml + i * 64 + j0); acc += (f32x2){sv, sv} * mv; } \
        sreg = acc; } while (0)
    P5B_LOAD(m0, n0, 0); P5B_LOAD(m1, n1, 1); P5B_LOAD(m2, n2, 2); P5B_LOAD(m3, n3, 3);
    for (int c = 0; c < NCH; c += 4) { P5B_STEP(m0, n0, c); P5B_STEP(m1, n1, c + 1); P5B_STEP(m2, n2, c + 2); P5B_STEP(m3, n3, c + 3); }
    __syncthreads();
#undef P5B_LOAD
#undef P5B_STEP
#undef P5B_BAR
}
#ifndef P5C_MASK
#define P5C_MASK(c, h, tt) true
#endif
__device__ __forceinline__ void p5c_chunk(PRef p, int q) {
    typedef short bf16x8 __attribute__((ext_vector_type(8)));
    const int lane = otid() & 63, fr = lane & 15, fq = lane >> 4;
    const int seq = q / NCH, c = q % NCH, b = seq >> 3, h = seq & 7, tb = b * SEQ + c * SCL;
    const bf16* Qi = (const bf16*)(p.ws + W_Q); const bf16* Y2i = (const bf16*)(p.ws + W_Y2);
    const float* RKi = (const float*)(p.ws + T_RK); const bf16* LO = (const bf16*)(p.ws + W_LO); bf16* ycat = (bf16*)(p.ws + W_YCAT);
    const float* Sc = (const float*)(p.ws + W_S + (size_t)q * 16384);
    bf16x8 sa[4][2];
#pragma unroll
    for (int vt = 0; vt < 4; ++vt)
#pragma unroll
        for (int ks = 0; ks < 2; ++ks) { const f32x4* sp = (const f32x4*)(Sc + (vt * 16 + fr) * 64 + ks * 32 + fq * 8); const f32x4 x0 = sp[0], x1 = sp[1];
            u32x4 w; w.x = pg8::cvt_pk_bf16(x0[0], x0[1]); w.y = pg8::cvt_pk_bf16(x0[2], x0[3]); w.z = pg8::cvt_pk_bf16(x1[0], x1[1]); w.w = pg8::cvt_pk_bf16(x1[2], x1[3]);
            sa[vt][ks] = __builtin_bit_cast(bf16x8, w); }
    f32x4 gw[4], gb[4];
#pragma unroll
    for (int vt = 0; vt < 4; ++vt) { gw[vt] = *(const f32x4*)(p.in[I_GNW] + h * 64 + vt * 16 + fq * 4); gb[vt] = *(const f32x4*)(p.in[I_GNB] + h * 64 + vt * 16 + fq * 4); }
#pragma unroll 1
    for (int tt = 0; tt < SCL / 16; ++tt) {
        const int t = tb + tt * 16 + fr;
        const unsigned tq = (unsigned)(t * 512 + h * 64);
        const bf16x8 qb0 = *(const bf16x8*)(Qi + (tq + fq * 8)), qb1 = *(const bf16x8*)(Qi + (tq + 32 + fq * 8));
        f32x4 y[4]; float s = 0.f;
#pragma unroll
        for (int vt = 0; vt < 4; ++vt) {
            const u32x2 yw = *(const u32x2*)(Y2i + (tq + vt * 16 + fq * 4));
            f32x4 a = {bflo(yw.x), bfhi(yw.x), bflo(yw.y), bfhi(yw.y)};
            a = __builtin_amdgcn_mfma_f32_16x16x32_bf16(sa[vt][0], qb0, a, 0, 0, 0);
            a = __builtin_amdgcn_mfma_f32_16x16x32_bf16(sa[vt][1], qb1, a, 0, 0, 0);
            y[vt] = a; s += (a[0] + a[1]) + (a[2] + a[3]);
        }
        s = xsum4(s);
        const float m = s * (1.f / 64.f); float qq = 0.f;
#pragma unroll
        for (int vt = 0; vt < 4; ++vt) { y[vt] = y[vt] - m; qq += (y[vt][0] * y[vt][0] + y[vt][1] * y[vt][1]) + (y[vt][2] * y[vt][2] + y[vt][3] * y[vt][3]); }
        qq = xsum4(qq);
        const float rs = rsqrtf(qq * (1.f / 64.f) + 64e-5f);
        const float rk = RKi[(unsigned)(t * 8 + h)];
#pragma unroll
        for (int vt = 0; vt < 4; ++vt) {
            const int cc = h * 64 + vt * 16 + fq * 4;
            const u32x2 vw = *(const u32x2*)(ycat + (unsigned)(t * 1024 + 512 + cc)); const u32x2 gwv = *(const u32x2*)(LO + (unsigned)(t * 1536 + 1024 + cc));
            const f32x4 vv = {bflo(vw.x), bfhi(vw.x), bflo(vw.y), bfhi(vw.y)}, gg = {bflo(gwv.x), bfhi(gwv.x), bflo(gwv.y), bfhi(gwv.y)};
            const f32x4 o = (y[vt] * rs * gw[vt] + gb[vt] + vv * rk) * gg;
            u32x2 ow; ow.x = pk2(o[0], o[1]); ow.y = pk2(o[2], o[3]);
            if (P5C_MASK(c, h, tt)) *(u32x2*)(ycat + (unsigned)(t * 1024 + 512 + cc)) = ow;
        }
    }
}
constexpr size_t W_H2 = 112 * MiB;
constexpr size_t W_XS = 176 * MiB;
constexpr size_t W_HB = 320 * MiB;
constexpr size_t W_YB = 176 * MiB;
constexpr int PROWS = NTOK * 2 + NE * 256, PTILES = PROWS / 256;
constexpr size_t T_HIST = W_TAB + 3 * 1024 * 1024 + 8192;
constexpr size_t T_NT = W_TAB + 3 * 1024 * 1024 + 4096;
constexpr size_t T_BQ = W_TAB + 3 * 1024 * 1024 + 65536;
constexpr int TPW = NTOK / 256;

__device__ __forceinline__ void p1_bq(PRef p, LAS float* red, int b) {
    const int tid = otid();
    const float* sh = (const float*)(p.ws + W_MOD) + b * 6 * D + 3 * D;
    if (tid < 288) { const int q = tid % 36, part = tid / 36; float s = 0.f;
        for (int c = part * 128; c < part * 128 + 128; ++c) s = fmaf(sh[c], q < 4 ? p.in[I_RGW][c * 4 + q] : p.in[I_REW][c * 32 + q - 4], s);
        red[part * 36 + q] = s; }
    __syncthreads();
    if (tid < 36) { float s = 0.f;
#pragma unroll
        for (int k = 0; k < 8; ++k) s += red[k * 36 + tid];
        ((float*)(p.ws + T_BQ))[b * 36 + tid] = s + (tid < 4 ? p.in[I_RGB][tid] : p.in[I_REB][tid - 4]); }
    __syncthreads();
}
__device__ __forceinline__ void p7_route(PRef p, LAS unsigned char* lds, int bid) {
    const int tid = otid(), lane = tid & 63, wave = __builtin_amdgcn_readfirstlane(tid >> 6);
    const float* x1 = p.out; bf16* H2 = (bf16*)(p.ws + W_H2);
    LAS int* hist = (LAS int*)(lds + 147456);
    const int b = (bid * TPW) / SEQ;
    const float* mod = (const float*)(p.ws + W_MOD) + b * 6 * D;
    const float* n2g = p.in[I_N2G];
    for (int ch = tid; ch < 1024 * 8; ch += NTHR) { const int c = ch >> 3, i = ch & 7;
        *(LAS f32x4*)(lds + c * 128 + 16 * (i ^ ((c >> 1) & 7))) = *(const f32x4*)(p.in[I_REW] + c * 32 + i * 4); }
    for (int c = tid; c < 1024; c += NTHR) *(LAS f32x4*)(lds + 131072 + c * 16) = *(const f32x4*)(p.in[I_RGW] + c * 4);
    if (tid < 32) hist[tid] = 0;
    if (tid < 36) *(LAS float*)(lds + 147456 + 128 + 4 * tid) = tid < 4 ? p.in[I_RGB][tid] : p.in[I_REB][tid - 4];
    __syncthreads();
    const int sw = (lane >> 1) & 7;
#pragma unroll 1
    for (int tp = 0; tp < TPW / 8; tp += 2) {
        const int t0 = bid * TPW + wave * (TPW / 8) + tp;
        const float* xr0 = x1 + (size_t)t0 * D; bf16* hr0 = H2 + (size_t)t0 * D;
        float r0, r1;
        { float pa[16], pb[16];
#pragma unroll
          for (int j = 0; j < 16; ++j) { pa[j] = xr0[lane + 64 * j]; pb[j] = xr0[D + lane + 64 * j]; }
          float ss0 = 0.f, ss1 = 0.f;
#pragma unroll
          for (int j = 0; j < 16; ++j) { ss0 = fmaf(pa[j], pa[j], ss0); ss1 = fmaf(pb[j], pb[j], ss1); }
          r0 = rsqrtf(wave_sum_v(ss0) * (1.0f / D) + 1e-6f); r1 = rsqrtf(wave_sum_v(ss1) * (1.0f / D) + 1e-6f); }
        float acc[2][36];
#pragma unroll
        for (int u = 0; u < 2; ++u)
#pragma unroll
            for (int q = 0; q < 36; ++q) acc[u][q] = 0.f;
#pragma unroll 1
        for (int j0 = 0; j0 < 16; j0 += 4) {
            float xa[4], xb[4], gv[4], sv[4];
#pragma unroll
            for (int jj = 0; jj < 4; ++jj) { const int c = lane + 64 * (j0 + jj); xa[jj] = xr0[c]; xb[jj] = xr0[D + c]; gv[jj] = n2g[c] * (1.0f + mod[4 * D + c]); sv[jj] = mod[3 * D + c]; }
#pragma unroll
            for (int jj = 0; jj < 4; ++jj) {
                const int c = lane + 64 * (j0 + jj);
                const float a0 = xa[jj] * r0 * gv[jj] + sv[jj], a1 = xb[jj] * r1 * gv[jj] + sv[jj];
                hr0[c] = (bf16)f2bf(a0); hr0[D + c] = (bf16)f2bf(a1);
                const LAS unsigned char* rowp = lds + c * 128;
                { const f32x4 w = *(const LAS f32x4*)(lds + 131072 + c * 16);
#pragma unroll
                  for (int q = 0; q < 4; ++q) { acc[0][q] = fmaf(a0, w[q], acc[0][q]); acc[1][q] = fmaf(a1, w[q], acc[1][q]); } }
#pragma unroll
                for (int i = 0; i < 8; ++i) { const f32x4 w = *(const LAS f32x4*)(rowp + 16 * (i ^ sw));
#pragma unroll
                    for (int q = 0; q < 4; ++q) { acc[0][4 + 4 * i + q] = fmaf(a0, w[q], acc[0][4 + 4 * i + q]); acc[1][4 + 4 * i + q] = fmaf(a1, w[q], acc[1][4 + 4 * i + q]); } }
            }
        }
#pragma unroll
        for (int u = 0; u < 2; ++u) {
            float lg[36];
#pragma unroll
            for (int q = 0; q < 36; ++q) { lg[q] = wave_sum_v(acc[u][q]); if ((q & 3) == 3) __builtin_amdgcn_sched_barrier(0); }
            unsigned bqo = 147456u + 128u; asm volatile("" : "+v"(bqo));
#pragma unroll
            for (int q = 0; q < 36; ++q) lg[q] += *(const LAS float*)(lds + bqo + 4 * q);
            int gi = 0; float gm = lg[0];
#pragma unroll
            for (int q = 1; q < 4; ++q) if (lg[q] > gm) { gm = lg[q]; gi = q; }
            float gsum = 0.f;
#pragma unroll
            for (int q = 0; q < 4; ++q) gsum += expf(lg[q] - gm);
            const float gp = 1.0f / gsum;
            float el[8];
#pragma unroll
            for (int q = 0; q < 8; ++q) el[q] = gi == 0 ? lg[4 + q] : gi == 1 ? lg[12 + q] : gi == 2 ? lg[20 + q] : lg[28 + q];
            int i0 = 0; float m0 = el[0];
#pragma unroll
            for (int q = 1; q < 8; ++q) if (el[q] > m0) { m0 = el[q]; i0 = q; }
            int i1 = -1; float m1 = -3.0e38f;
#pragma unroll
            for (int q = 0; q < 8; ++q) if (q != i0 && el[q] > m1) { m1 = el[q]; i1 = q; }
            const float p1 = expf(m1 - m0);
            const float w0 = gp / (1.0f + p1), w1 = gp * p1 / (1.0f + p1);
            if (lane == 0) { const int t = t0 + u, e0 = gi * 8 + i0, e1 = gi * 8 + i1;
                int* toke = (int*)(p.ws + T_TOKE); float* tokw = (float*)(p.ws + T_TOKW);
                toke[t * 2] = e0; toke[t * 2 + 1] = e1; tokw[t * 2] = w0; tokw[t * 2 + 1] = w1;
                __hip_atomic_fetch_add(&hist[e0], 1, __ATOMIC_RELAXED, __HIP_MEMORY_SCOPE_WORKGROUP); __hip_atomic_fetch_add(&hist[e1], 1, __ATOMIC_RELAXED, __HIP_MEMORY_SCOPE_WORKGROUP); }
        }
    }
    __syncthreads();
    if (tid < 32) ((int*)(p.ws + T_HIST))[bid * 32 + tid] = hist[tid];
    __syncthreads();
}
__device__ __forceinline__ void p8_place(PRef p, LAS unsigned char* lds, int bid) {
    const int tid = otid(), lane = tid & 63, wave = __builtin_amdgcn_readfirstlane(tid >> 6);
    LAS int* ptot = (LAS int*)lds;
    LAS int* pbef = ptot + 512;
    LAS int* base = pbef + 512;
    LAS int* lcur = base + 32;
    LAS int* posl = lcur + 32;
    LAS int* padb = posl + 256;
    const int* hist = (const int*)(p.ws + T_HIST);
    { const int e = tid & 31, part = tid >> 5; int tot = 0, bef = 0;
#pragma unroll 4
      for (int w = part * 16; w < part * 16 + 16; ++w) { const int c = hist[w * 32 + e]; tot += c; bef += (w < bid) ? c : 0; }
      ptot[part * 32 + e] = tot; pbef[part * 32 + e] = bef; }
    __syncthreads();
    if (tid < 32) { int tot = 0, bef = 0;
#pragma unroll
        for (int k = 0; k < 16; ++k) { tot += ptot[k * 32 + tid]; bef += pbef[k * 32 + tid]; }
        ptot[tid] = tot; pbef[tid] = bef; lcur[tid] = 0; }
    __syncthreads();
    if (tid == 0) { int row = 0;
        for (int e = 0; e < NE; ++e) { const int cnt = ptot[e], nt = (cnt + 255) >> 8; base[e] = row + pbef[e]; padb[e] = row + cnt; padb[32 + e] = row + nt * 256;
            if (bid == 0) { int* te = (int*)(p.ws + T_TILEE); for (int k = 0; k < nt; ++k) te[(row >> 8) + k] = e; }
            row += nt * 256; }
        if (bid == 0) *(int*)(p.ws + T_NT) = row >> 8; }
    __syncthreads();
    int* rowaid = (int*)(p.ws + T_ROWAID); float* roww = (float*)(p.ws + T_ROWW);
    if (tid < 256) { const int a = bid * 256 + tid; const int e = ((const int*)(p.ws + T_TOKE))[a];
        const int pos = base[e] + __hip_atomic_fetch_add(&lcur[e], 1, __ATOMIC_RELAXED, __HIP_MEMORY_SCOPE_WORKGROUP);
        posl[tid] = pos; rowaid[pos] = a; roww[pos] = ((const float*)(p.ws + T_TOKW))[a]; }
    if (bid < NE) for (int r = padb[bid] + tid; r < padb[32 + bid]; r += NTHR) { rowaid[r] = -1; roww[r] = 0.f; }
    __syncthreads();
    __syncthreads();
}
template <bool GATHER_>
struct MoeOrder {
    static constexpr bool GATHER = GATHER_;
    const int* tile_e; const int* rowaid; int nM, G, c;
    __device__ __forceinline__ int rowsrc(int row) const { const int a = rowaid[row]; return (a < 0 ? 0 : a) >> 1; }
    __device__ __forceinline__ bool next(int i, pg8::Unit& u) const {
        const int nwg = nM * 4; const long L = (long)i * G + c; if (L >= nwg) return false;
        int wgid = (int)L; { const int q = nwg / 8, r = nwg % 8, xcd = wgid % 8, off = wgid / 8; wgid = (xcd < r ? xcd * (q + 1) : r * (q + 1) + (xcd - r) * q) + off; }
        const int nig = 8 * 4, gid = wgid / nig, fm = gid * 8, gsz = (nM - fm) < 8 ? (nM - fm) : 8;
        u.pm = fm + ((wgid % nig) % gsz); u.pn = (wgid % nig) / gsz; u.pb = tile_e[u.pm] * 4 + u.pn; return true;
    }
    __device__ __forceinline__ void a_ready(const pg8::Unit&) const {}
    __device__ __forceinline__ void done(const pg8::Unit&) const {}
};
__device__ __forceinline__ float silu_fast(float x) { return x * __builtin_amdgcn_rcpf(1.0f + __builtin_amdgcn_exp2f(-1.4426950409f * x)); }
struct EpiH {
    static constexpr bool PERM = true, AFTER_DRAIN = false;
    bf16* H;
    __device__ __forceinline__ void operator()(const f32x4 (&acc)[2][2][4][2], const pg8::Unit& u, int wr, int wc, int fr, int fq) const {
        const int row0 = u.pm * 256 + wr * 64 + fr, col0 = u.pn * 128 + wc * 32 + 8 * fq;
#pragma unroll
        for (int ai = 0; ai < 2; ++ai)
#pragma unroll
            for (int m = 0; m < 4; ++m) { const f32x4 g0 = acc[ai][0][m][0], g1 = acc[ai][0][m][1], u0 = acc[ai][1][m][0], u1 = acc[ai][1][m][1];
                f32x4 h0, h1;
#pragma unroll
                for (int q = 0; q < 4; ++q) { h0[q] = silu_fast(g0[q]) * u0[q]; h1[q] = silu_fast(g1[q]) * u1[q]; }
                u32x4 w; w.x = pg8::cvt_pk_bf16(h0[0], h0[1]); w.y = pg8::cvt_pk_bf16(h0[2], h0[3]); w.z = pg8::cvt_pk_bf16(h1[0], h1[1]); w.w = pg8::cvt_pk_bf16(h1[2], h1[3]);
                *(u32x4*)(H + (size_t)(row0 + ai * 128 + m * 16) * EH + col0) = w; }
    }
};
struct EpiY {
    static constexpr bool PERM = true, AFTER_DRAIN = false;
    bf16* YB; const int* rowaid; const float* roww;
    __device__ __forceinline__ void operator()(const f32x4 (&acc)[2][2][4][2], const pg8::Unit& u, int wr, int wc, int fr, int fq) const {
        const int row0 = u.pm * 256 + wr * 64 + fr, col0 = u.pn * 256 + wc * 32 + 8 * fq;
#pragma unroll
        for (int ai = 0; ai < 2; ++ai)
#pragma unroll
            for (int m = 0; m < 4; ++m) { const int row = row0 + ai * 128 + m * 16; const int a = rowaid[row]; const float w = roww[row];
                if (a >= 0) {
#pragma unroll
                    for (int bj = 0; bj < 2; ++bj) { const f32x4 v0 = acc[ai][bj][m][0] * w, v1 = acc[ai][bj][m][1] * w;
                        u32x4 o; o.x = pg8::cvt_pk_bf16(v0[0], v0[1]); o.y = pg8::cvt_pk_bf16(v0[2], v0[3]); o.z = pg8::cvt_pk_bf16(v1[0], v1[1]); o.w = pg8::cvt_pk_bf16(v1[2], v1[3]);
                        *(u32x4*)(YB + (size_t)a * D + col0 + bj * 128) = o; } } }
    }
};
__device__ __forceinline__ void p11_final(PRef p, int bid, int nb) {
    const int tid_ = otid(), lane = tid_ & 63, wv = tid_ >> 6;
    const float* mod = (const float*)(p.ws + W_MOD); const bf16* YB = (const bf16*)(p.ws + W_YB); float* out = p.out; const float* g = p.in[I_FNG];
#pragma unroll 1
    for (int row = bid * 8 + wv; row < NTOK; row += nb * 8) {
        const float* gt = mod + (row / SEQ) * 6 * D + 5 * D;
        f32x4 v[4]; float s = 0.f;
#pragma unroll
        for (int j = 0; j < 4; ++j) { const int c0 = (lane + 64 * j) * 4;
            const f32x4 xv = *(const f32x4*)(out + (size_t)row * D + c0), gv = *(const f32x4*)(gt + c0);
            const u32x2 a = *(const u32x2*)(YB + (size_t)(2 * row) * D + c0), b = *(const u32x2*)(YB + (size_t)(2 * row + 1) * D + c0);
            const f32x4 y = {bflo(a.x) + bflo(b.x), bfhi(a.x) + bfhi(b.x), bflo(a.y) + bflo(b.y), bfhi(a.y) + bfhi(b.y)};
            v[j] = xv + gv * y; s += (v[j][0] * v[j][0] + v[j][1] * v[j][1]) + (v[j][2] * v[j][2] + v[j][3] * v[j][3]); }
        const float r = rsqrtf(wave_sum_dpp(s) * (1.0f / D) + 1e-6f);
#pragma unroll
        for (int j = 0; j < 4; ++j) { const int c0 = (lane + 64 * j) * 4; *(f32x4*)(out + (size_t)row * D + c0) = v[j] * r * *(const f32x4*)(g + c0); }
    }
}
constexpr int PM_PB = 144, PM_MAT = 64 * PM_PB;
enum { PM_AT = 0, PM_RT, PM_BT, PM_KT, PM_VT, PM_BPT, PM_KPT, PM_AAK, PM_ARB, PM_ARK, PM_W1T, PM_U2T, PM_NMAT };
constexpr int PM_AAB = PM_NMAT * PM_MAT, PM_P = PM_AAB + 16384, PM_TOT = PM_P + 16384, PM_G = PM_TOT + 2048, PM_END = PM_G + 256;
static_assert(PM_END <= LDS_BYTES, "pass-A LDS map");
struct PmRaw { float zr[9], zk[9], zv[9], lw[8], as[8]; };
__device__ __forceinline__ void p5m_load(PRef p, PmRaw& R, int q, int wave, int lane) {
    const int seq = q / NCH, c = q % NCH, b = seq >> 3, h = seq & 7, tg = b * SEQ + c * SCL + wave * 8, hc = h * 64 + lane;
    const bf16* Z = (const bf16*)(p.ws + W_Z); const bf16* LO = (const bf16*)(p.ws + W_LO);
    const bool has_prev = !(wave == 0 && c == 0);
    const bf16* zp0 = Z + (size_t)(tg - 1) * ZLD + 1024 + hc;
    R.zr[0] = has_prev ? bf2f(zp0[0]) : 0.f; R.zk[0] = has_prev ? bf2f(zp0[512]) : 0.f; R.zv[0] = has_prev ? bf2f(zp0[1024]) : 0.f;
#pragma unroll
    for (int s = 0; s < 8; ++s) { const bf16* zp = Z + (size_t)(tg + s) * ZLD + 1024 + hc; const bf16* lp = LO + (size_t)(tg + s) * 1536 + hc;
        R.zr[s + 1] = bf2f(zp[0]); R.zk[s + 1] = bf2f(zp[512]); R.zv[s + 1] = bf2f(zp[1024]); R.lw[s] = bf2f(lp[0]); R.as[s] = bf2f(lp[512]); }
}
#define PM_BAR() do { asm volatile("s_waitcnt lgkmcnt(0)" ::: "memory"); __builtin_amdgcn_s_barrier(); asm volatile("" ::: "memory"); } while (0)
__device__ __forceinline__ void p5m_chunk(PRef p, LAS unsigned char* lds, int q, int qnext, PmRaw& R) {
    typedef short bf16x8 __attribute__((ext_vector_type(8)));
    const int tid = otid(), lane = tid & 63, wave = __builtin_amdgcn_readfirstlane(tid >> 6), fr = lane & 15, fq = lane >> 4;
    const int seq = q / NCH, c = q % NCH, b = seq >> 3, h = seq & 7, tb = b * SEQ + c * SCL, hc = h * 64 + lane;
#define PMAT(i) (lds + (i) * PM_MAT)
#define PFRAG(mat, row, ks) (*(const LAS bf16x8*)((mat) + (row) * PM_PB + ((ks) * 32 + fq * 8) * 2))
#ifndef PM_DUP
#define PM_DUP 0
#endif
#pragma unroll 1
    for (int d0 = 0; d0 < ((PM_DUP >> 3) & 1) + 1; ++d0) { if (d0) PM_BAR();
        const int t8 = wave * 8, tg = tb + t8;
        float (&zr)[9] = R.zr; float (&zk)[9] = R.zk; float (&zv)[9] = R.zv; float (&lw)[8] = R.lw; float (&as)[8] = R.as;
        float cl[8]; { float run = 0.f;
#pragma unroll
          for (int s = 0; s < 8; ++s) { run += lw[s]; cl[s] = run; } }
        *(LAS float*)(lds + PM_TOT + (wave * 64 + lane) * 4) = cl[7];
        PM_BAR();
        float off = 0.f, lcL = 0.f;
#pragma unroll
        for (int w = 0; w < 8; ++w) { const float tv = *(const LAS float*)(lds + PM_TOT + (w * 64 + lane) * 4); lcL += tv; off += (w < wave) ? tv : 0.f; }
        if (wave == 0) *(LAS float*)(lds + PM_G + lane * 4) = __builtin_amdgcn_exp2f(1.4426950409f * lcL);
        const float mur = p.in[I_MU][hc], muk = p.in[I_MU][512 + hc], muv = p.in[I_MU][1024 + hc];
        const float kkc = p.in[I_KK][hc], kac = p.in[I_KA][hc], rkc = p.in[I_RK][hc];
        bf16* VLo = (bf16*)(p.ws + W_YCAT); float* RKo = (float*)(p.ws + T_RK);
        unsigned pv[4], pbp[4], pkp[4];
#pragma unroll
        for (int s = 0; s < 8; ++s) {
            const float r = zr[s + 1] + (zr[s] - zr[s + 1]) * mur, k = zk[s + 1] + (zk[s] - zk[s + 1]) * muk, v = zv[s + 1] + (zv[s] - zv[s + 1]) * muv;
            const float kkv = k * kkc;
            const float kk = kkv * rsqrtf(fmaxf(wave_sum_dpp(kkv * kkv), 1e-24f));
            const float k2 = k * (1.0f + (as[s] - 1.0f) * kac);
            const float rk = wave_sum_dpp(r * k2 * rkc);
            const float bb = kk * as[s];
            const float lc = off + cl[s], lcp = lc - lw[s];
            const float e_lc = __builtin_amdgcn_exp2f(1.4426950409f * lc), e_lcp = __builtin_amdgcn_exp2f(1.4426950409f * lcp);
            const float e_nlc = __builtin_amdgcn_exp2f(-1.4426950409f * lc), e_l = __builtin_amdgcn_exp2f(1.4426950409f * (lcL - lc));
            const int t = t8 + s;
            *(LAS bf16*)(PMAT(PM_AT) + t * PM_PB + lane * 2) = (bf16)f2bf(-kk * e_lcp);
            *(LAS bf16*)(PMAT(PM_RT) + t * PM_PB + lane * 2) = (bf16)f2bf(r * e_lc);
            *(LAS bf16*)(PMAT(PM_BT) + t * PM_PB + lane * 2) = (bf16)f2bf(bb * e_nlc);
            *(LAS bf16*)(PMAT(PM_KT) + t * PM_PB + lane * 2) = (bf16)f2bf(k2 * e_nlc);
            const unsigned vb = f2bf(v), bpb = f2bf(bb * e_l), kpb = f2bf(k2 * e_l);
            if (s & 1) { pv[s >> 1] |= vb << 16; pbp[s >> 1] |= bpb << 16; pkp[s >> 1] |= kpb << 16; } else { pv[s >> 1] = vb; pbp[s >> 1] = bpb; pkp[s >> 1] = kpb; }
            VLo[(unsigned)((tg + s) * 1024 + 512 + hc)] = (bf16)vb;
            if (lane == 0) RKo[(unsigned)((tg + s) * 8 + h)] = rk;
        }
        *(LAS u32x4*)(PMAT(PM_VT) + lane * PM_PB + wave * 16) = (u32x4){pv[0], pv[1], pv[2], pv[3]};
        *(LAS u32x4*)(PMAT(PM_BPT) + lane * PM_PB + wave * 16) = (u32x4){pbp[0], pbp[1], pbp[2], pbp[3]};
        *(LAS u32x4*)(PMAT(PM_KPT) + lane * PM_PB + wave * 16) = (u32x4){pkp[0], pkp[1], pkp[2], pkp[3]};
    }
    if (qnext >= 0) p5m_load(p, R, qnext, wave, lane);
    PM_BAR();
#pragma unroll 1
    for (int d1 = 0; d1 < ((PM_DUP >> 0) & 1) + 1; ++d1) {
        const int pp = wave >> 1, half = wave & 1;
        const LAS unsigned char* Xm = PMAT(pp < 2 ? PM_AT : PM_RT);
        const LAS unsigned char* Ym = PMAT((pp & 1) ? PM_KT : PM_BT);
#pragma unroll
        for (int ti = 0; ti < 2; ++ti) {
            const int tt = half ? (1 + ti) : (3 * ti);
            const bf16x8 xb0 = PFRAG(Xm, tt * 16 + fr, 0), xb1 = PFRAG(Xm, tt * 16 + fr, 1);
            const int t = tt * 16 + fr;
#pragma unroll
            for (int jt = 0; jt < 4; ++jt) {
                f32x4 acc = {0.f, 0.f, 0.f, 0.f};
                if (jt <= tt) { acc = __builtin_amdgcn_mfma_f32_16x16x32_bf16(PFRAG(Ym, jt * 16 + fr, 0), xb0, acc, 0, 0, 0);
                                acc = __builtin_amdgcn_mfma_f32_16x16x32_bf16(PFRAG(Ym, jt * 16 + fr, 1), xb1, acc, 0, 0, 0); }
                const int j0 = jt * 16 + 4 * fq;
#pragma unroll
                for (int rg = 0; rg < 4; ++rg) { const bool keep = (pp < 2) ? (j0 + rg < t) : (j0 + rg <= t); acc[rg] = keep ? acc[rg] : 0.f; }
                if (pp == 0) {
#pragma unroll
                    for (int rg = 0; rg < 4; ++rg) *(LAS float*)(lds + PM_AAB + (t * 64 + rg * 16 + jt * 4 + fq) * 4) = acc[rg];
                } else {
                    u32x2 w; w.x = pk2(acc[0], acc[1]); w.y = pk2(acc[2], acc[3]);
                    *(LAS u32x2*)(PMAT(PM_AAK + pp - 1) + t * PM_PB + j0 * 2) = w;
                }
            }
        }
    }
    PM_BAR();
#pragma unroll 1
    for (int d2 = 0; d2 < ((PM_DUP >> 1) & 1) + 1; ++d2) {
        const bool isw1 = wave < 4;
        const int colb = (wave & 3) * 16, cl = lane >> 2, part = lane & 3, col = colb + cl;
        if (!isw1) {
            const bf16x8 vb0 = PFRAG(PMAT(PM_VT), colb + fr, 0), vb1 = PFRAG(PMAT(PM_VT), colb + fr, 1);
#pragma unroll
            for (int tt = 0; tt < 4; ++tt) { f32x4 acc = {0.f, 0.f, 0.f, 0.f};
                acc = __builtin_amdgcn_mfma_f32_16x16x32_bf16(PFRAG(PMAT(PM_AAK), tt * 16 + fr, 0), vb0, acc, 0, 0, 0);
                acc = __builtin_amdgcn_mfma_f32_16x16x32_bf16(PFRAG(PMAT(PM_AAK), tt * 16 + fr, 1), vb1, acc, 0, 0, 0);
#pragma unroll
                for (int rg = 0; rg < 4; ++rg) *(LAS float*)(lds + PM_P + ((tt * 16 + 4 * fq + rg) * 64 + colb + fr) * 4) = acc[rg]; }
            asm volatile("s_waitcnt lgkmcnt(0)" ::: "memory");
        }
        float X[16];
#pragma unroll
        for (int jj = 0; jj < 16; ++jj) X[jj] = 0.f;
        const LAS unsigned char* arow = lds + PM_AAB + part * 64;
#define PM_LOADBLK(g, rh, a4, cf) do { \
            _Pragma("unroll") for (int r = 0; r < 4; ++r) { const int t = 4 * (g) + r; \
                rh[r] = isw1 ? bf2f(*(const LAS bf16*)(PMAT(PM_AT) + t * PM_PB + col * 2)) : *(const LAS float*)(lds + PM_P + (t * 64 + col) * 4); \
                _Pragma("unroll") for (int m = 0; m < 4; ++m) if (m * 4 < (g)) a4[r][m] = *(const LAS f32x4*)(arow + t * 256 + m * 16); } \
            { const LAS unsigned char* cb = lds + PM_AAB + (g) * 4; \
              cf[0] = *(const LAS float*)(cb + (4 * (g) + 1) * 256); cf[1] = *(const LAS float*)(cb + (4 * (g) + 2) * 256); cf[2] = *(const LAS float*)(cb + (4 * (g) + 2) * 256 + 64); \
              cf[3] = *(const LAS float*)(cb + (4 * (g) + 3) * 256); cf[4] = *(const LAS float*)(cb + (4 * (g) + 3) * 256 + 64); cf[5] = *(const LAS float*)(cb + (4 * (g) + 3) * 256 + 128); } } while (0)
#define PM_SOLVEBLK(g, rh, a4, cf) do { float sm[4]; \
            _Pragma("unroll") for (int r = 0; r < 4; ++r) { float s0 = 0.f, s1 = 0.f; \
                _Pragma("unroll") for (int m = 0; m < 4; ++m) if (m * 4 < (g)) { \
                    _Pragma("unroll") for (int i = 0; i < 4; ++i) if (m * 4 + i < (g)) { if (i & 1) s1 = fmaf(a4[r][m][i], X[m * 4 + i], s1); else s0 = fmaf(a4[r][m][i], X[m * 4 + i], s0); } } \
                sm[r] = s0 + s1; } \
            _Pragma("unroll") for (int r = 0; r < 4; ++r) { DPP_ADD(sm[r], 0xB1); DPP_ADD(sm[r], 0x4E); } \
            const float x0 = rh[0] + sm[0]; \
            const float x1 = fmaf(cf[0], x0, rh[1] + sm[1]); \
            const float x2 = fmaf(cf[2], x1, fmaf(cf[1], x0, rh[2] + sm[2])); \
            const float x3 = fmaf(cf[5], x2, fmaf(cf[4], x1, fmaf(cf[3], x0, rh[3] + sm[3]))); \
            X[g] = part == 0 ? x0 : part == 1 ? x1 : part == 2 ? x2 : x3; } while (0)
        { float rhA[4], cfA[6], rhB[4], cfB[6]; f32x4 aA[4][4], aB[4][4];
          PM_LOADBLK(0, rhA, aA, cfA);
#pragma unroll
          for (int g2 = 0; g2 < 16; g2 += 2) {
              PM_LOADBLK(g2 + 1, rhB, aB, cfB); __builtin_amdgcn_sched_barrier(0);
              PM_SOLVEBLK(g2, rhA, aA, cfA);
              if (g2 + 2 < 16) { PM_LOADBLK(g2 + 2, rhA, aA, cfA); } __builtin_amdgcn_sched_barrier(0);
              PM_SOLVEBLK(g2 + 1, rhB, aB, cfB);
          } }
#undef PM_LOADBLK
#undef PM_SOLVEBLK
        LAS unsigned char* om = PMAT(isw1 ? PM_W1T : PM_U2T) + col * PM_PB + part * 2;
#pragma unroll
        for (int jj = 0; jj < 16; ++jj) *(LAS bf16*)(om + jj * 8) = (bf16)f2bf(X[jj]);
    }
    PM_BAR();
#pragma unroll 1
    for (int d3 = 0; d3 < ((PM_DUP >> 2) & 1) + 1; ++d3) {
        float* Mo = (float*)((unsigned char*)p.out + O_M + (size_t)q * 16384); float* No = (float*)((unsigned char*)p.out + O_N + (size_t)q * 16384);
        bf16* Qo = (bf16*)(p.ws + W_Q); bf16* Y2o = (bf16*)(p.ws + W_Y2);
#pragma unroll
        for (int ti = 0; ti < 2; ++ti) {
            const int idx = wave * 2 + ti, rt = idx >> 2, ct = idx & 3;
            {
                f32x4 acc = {0.f, 0.f, 0.f, 0.f};
#pragma unroll
                for (int ks = 0; ks < 2; ++ks) acc = __builtin_amdgcn_mfma_f32_16x16x32_bf16(PFRAG(PMAT(PM_BPT), ct * 16 + fr, ks), PFRAG(PMAT(PM_W1T), rt * 16 + fr, ks), acc, 0, 0, 0);
                const int i = rt * 16 + fr, c0 = ct * 16 + 4 * fq;
#pragma unroll
                for (int rg = 0; rg < 4; ++rg) if (c0 + rg == i) acc[rg] += *(const LAS float*)(lds + PM_G + i * 4);
                *(f32x4*)(Mo + i * 64 + c0) = acc; }
            {
                f32x4 acc = {0.f, 0.f, 0.f, 0.f};
#pragma unroll
                for (int ks = 0; ks < 2; ++ks) { acc = __builtin_amdgcn_mfma_f32_16x16x32_bf16(PFRAG(PMAT(PM_BPT), ct * 16 + fr, ks), PFRAG(PMAT(PM_U2T), rt * 16 + fr, ks), acc, 0, 0, 0);
                                                  acc = __builtin_amdgcn_mfma_f32_16x16x32_bf16(PFRAG(PMAT(PM_KPT), ct * 16 + fr, ks), PFRAG(PMAT(PM_VT), rt * 16 + fr, ks), acc, 0, 0, 0); }
                *(f32x4*)(No + (rt * 16 + fr) * 64 + ct * 16 + 4 * fq) = acc; }
            {
                f32x4 acc = {0.f, 0.f, 0.f, 0.f};
#pragma unroll
                for (int ks = 0; ks < 2; ++ks) acc = __builtin_amdgcn_mfma_f32_16x16x32_bf16(PFRAG(PMAT(PM_W1T), ct * 16 + fr, ks), PFRAG(PMAT(PM_ARB), rt * 16 + fr, ks), acc, 0, 0, 0);
                const int t = rt * 16 + fr, i0 = ct * 16 + 4 * fq;
                const u32x2 rw = *(const LAS u32x2*)(PMAT(PM_RT) + t * PM_PB + i0 * 2);
                u32x2 o; o.x = pk2(acc[0] + bflo(rw.x), acc[1] + bfhi(rw.x)); o.y = pk2(acc[2] + bflo(rw.y), acc[3] + bfhi(rw.y));
                *(u32x2*)(Qo + (unsigned)((tb + t) * 512 + h * 64 + i0)) = o; }
            {
                f32x4 acc = {0.f, 0.f, 0.f, 0.f};
#pragma unroll
                for (int ks = 0; ks < 2; ++ks) { acc = __builtin_amdgcn_mfma_f32_16x16x32_bf16(PFRAG(PMAT(PM_U2T), ct * 16 + fr, ks), PFRAG(PMAT(PM_ARB), rt * 16 + fr, ks), acc, 0, 0, 0);
                                                  acc = __builtin_amdgcn_mfma_f32_16x16x32_bf16(PFRAG(PMAT(PM_VT), ct * 16 + fr, ks), PFRAG(PMAT(PM_ARK), rt * 16 + fr, ks), acc, 0, 0, 0); }
                const int t = rt * 16 + fr, v0 = ct * 16 + 4 * fq;
                u32x2 o; o.x = pk2(acc[0], acc[1]); o.y = pk2(acc[2], acc[3]);
                *(u32x2*)(Y2o + (unsigned)((tb + t) * 512 + h * 64 + v0)) = o; }
        }
    }
    PM_BAR();
#undef PMAT
#undef PFRAG
}

__device__ __forceinline__ void p5m_run(PRef p, LAS unsigned char* lds, int bid, int nb) {
    const int tid = otid(), lane = tid & 63, wave = __builtin_amdgcn_readfirstlane(tid >> 6);
    PmRaw R;
    if (bid < BATCH * 8 * NCH) p5m_load(p, R, bid, wave, lane);
#pragma unroll 1
    for (int q = bid; q < BATCH * 8 * NCH; q += nb) p5m_chunk(p, lds, q, (q + nb < BATCH * 8 * NCH) ? q + nb : -1, R);
}
__global__ void __launch_bounds__(NTHR, 2) k_mega(Params p_unused) {
    extern __shared__ __attribute__((aligned(16))) unsigned char lds_raw[];
    PPtr kp = (PPtr)__builtin_amdgcn_kernarg_segment_ptr();
#define p (*opq(kp))
    cg::grid_group grid = cg::this_grid();
    const int bid = blockIdx.x, nb = gridDim.x;
    LAS unsigned char* lds = (LAS unsigned char*)lds_raw;
    volatile LAS unsigned* bst = (volatile LAS unsigned*)(lds + LDS_BYTES - 64);
    if (otid() < 2) bst[otid()] = 0u;
    __syncthreads();
    XcdBarrier xb = xcd_barrier_post((unsigned*)(p.ws + T_BAR), bst);
#define GSYNC() xcd_barrier(xb)
    p0_prep<true>(p, lds, bid, nb); grid.sync();
    p1_h1(p, bid, nb); if (bid < BATCH) p1_bq(p, (LAS float*)lds, bid); GSYNC();
    { pg8::Gemm g{(const pg8::bf16_t*)(p.ws + W_H1), (const pg8::bf16_t*)(p.ws + W_WINT), NTOK, ZLD, D}; pg8::StaticOrder S; S.init(NTOK, ZLD, nb, bid);
      EpiZ E{(bf16*)(p.ws + W_Z)};
      pg8::gemm_phase<EpiZ, pg8::StaticOrder, true, true>(lds, g, S, E); }
    GSYNC();
#pragma unroll 1
    for (int ch = bid; ch < NTOK / CHUNK; ch += nb) p3_gmlp_unit(p, lds, ch);
    p3_lorain(p, bid, nb);
    GSYNC();
    { int kop = 256; asm volatile("" : "+s"(kop));
      pg8::Gemm g{(const pg8::bf16_t*)(p.ws + W_A2), (const pg8::bf16_t*)(p.ws + W_LORAT), NTOK, 1536, kop}; pg8::StaticOrder S; S.init(NTOK, 1536, nb, bid);
      EpiLO E{(bf16*)(p.ws + W_LO), p.in[I_W0], p.in[I_A0]};
      pg8::gemm_phase<EpiLO, pg8::StaticOrder, true, true>(lds, g, S, E); }
    GSYNC();
    p5m_run(p, lds, bid, nb);
    GSYNC();
#pragma unroll 1
    for (int it = bid; it < BATCH * 8 * 4; it += nb) p5b_chain(p, lds, it);
    GSYNC();
#pragma unroll 1
    for (int q = bid * 8 + __builtin_amdgcn_readfirstlane(otid() >> 6); q < BATCH * 8 * NCH; q += nb * 8) p5c_chunk(p, q);
    GSYNC();
    { pg8::Gemm g{(const pg8::bf16_t*)(p.ws + W_YCAT), (const pg8::bf16_t*)(p.ws + W_WOUTT), NTOK, D, D}; pg8::StaticOrder S; S.init(NTOK, D, nb, bid);
      EpiX1 E{p.in[I_X], (const float*)(p.ws + W_MOD), p.out};
      pg8::gemm_phase<EpiX1, pg8::StaticOrder, true, true>(lds, g, S, E); }
    GSYNC();
    p7_route(p, lds, bid); GSYNC();
    p8_place(p, lds, bid); GSYNC();
    { const int nM = *(const int*)(p.ws + T_NT);
      pg8::Gemm g{(const pg8::bf16_t*)(p.ws + W_H2), (const pg8::bf16_t*)(p.ws + W_WGUT), PROWS, 1024, D}; MoeOrder<true> S{(const int*)(p.ws + T_TILEE), (const int*)(p.ws + T_ROWAID), nM, nb, bid};
      EpiH E{(bf16*)(p.ws + W_HB)};
      pg8::gemm_phase<EpiH, MoeOrder<true>, true, true>(lds, g, S, E); }
    GSYNC();
    { const int nM = *(const int*)(p.ws + T_NT);
      pg8::Gemm g{(const pg8::bf16_t*)(p.ws + W_HB), (const pg8::bf16_t*)(p.ws + W_WDT), PROWS, 1024, EH}; MoeOrder<false> S{(const int*)(p.ws + T_TILEE), (const int*)(p.ws + T_ROWAID), nM, nb, bid};
      EpiY E{(bf16*)(p.ws + W_YB), (const int*)(p.ws + T_ROWAID), (const float*)(p.ws + T_ROWW)};
      pg8::gemm_phase<EpiY, MoeOrder<false>, true, true>(lds, g, S, E); }
    GSYNC();
    p11_final(p, bid, nb);
#undef GSYNC
#undef p
}
extern "C" void kernel_launch(void* const* d_in, const int* in_sizes, int n_in, void* d_out, int out_size, void* d_ws, size_t ws_size, hipStream_t stream) {
    if (n_in != 31 || ws_size < WS_NEED || out_size != NTOK * D) { fprintf(stderr, "kernel_launch: unexpected sizes n_in %d ws %zu out %d\n", n_in, ws_size, out_size); return; }
    static int grid_blocks = 0;
    if (!grid_blocks) {
        int dev = 0, cus = 0, per_cu = 0;
        (void)hipGetDevice(&dev);
        (void)hipDeviceGetAttribute(&cus, hipDeviceAttributeMultiprocessorCount, dev);
        (void)hipFuncSetAttribute((const void*)k_mega, hipFuncAttributeMaxDynamicSharedMemorySize, LDS_BYTES);
        (void)hipOccupancyMaxActiveBlocksPerMultiprocessor(&per_cu, (const void*)k_mega, NTHR, LDS_BYTES);
        if (per_cu < 1) fprintf(stderr, "kernel_launch: occupancy query says %d blocks/CU\n", per_cu);
        grid_blocks = cus;
    }
    Params p{};
    for (int i = 0; i < 31; ++i) p.in[i] = (const float*)d_in[i];
    p.out = (float*)d_out; p.ws = (unsigned char*)d_ws;
    (void)hipMemsetAsync((char*)d_ws + T_BAR, 0, 16384, stream);
    void* args[] = {&p};
    hipError_t e = hipLaunchCooperativeKernel((void*)k_mega, dim3(grid_blocks), dim3(NTHR), args, LDS_BYTES, stream);
    if (e != hipSuccess) fprintf(stderr, "cooperative launch failed: %s (grid %d)\n", hipGetErrorString(e), grid_blocks);
}
```

```cpp
#include <hip/hip_runtime.h>
#include <hip/hip_cooperative_groups.h>
#include <cstdio>
#include <cstdint>
namespace cg = cooperative_groups;
__device__ __forceinline__ int otid() { int t = threadIdx.x; asm volatile("" : "+v"(t)); return t; }

namespace pg8 {
#define PG8_LAS __attribute__((address_space(3)))
typedef unsigned short bf16_t;
typedef short bf16x8 __attribute__((ext_vector_type(8)));
typedef float f32x4 __attribute__((ext_vector_type(4)));
typedef unsigned u32x4 __attribute__((ext_vector_type(4)));
constexpr int BM = 256, BK = 64, HALF = 128, HTB = HALF * BK * 2  , STAGE_BYTES = 8 * HTB, NXCD = 8, WGM = 8;

__host__ __device__ __forceinline__ int lds_byte(int r, int c) { const int st = (r >> 4) * 2 + (c >> 5), rr = r & 15, cc = c & 31, ob = rr * 64 + cc * 2; return st * 1024 + (ob ^ (((ob >> 9) & 1) << 5)); }
__host__ __device__ __forceinline__ void stage_rc(int b, int& R, int& C) { const int st = b / 1024, sb = b % 1024, swz = sb ^ (((sb >> 9) & 1) << 5); R = (st >> 1) * 16 + swz / 64; C = (st & 1) * 32 + (swz % 64) / 2; }
__host__ __device__ __forceinline__ int perm32(int rho) { const int n = rho >> 4, i = rho & 15; return 8 * (i >> 2) + 4 * n + (i & 3); }

struct Unit { int pm, pn, pb; };
struct Gemm { const bf16_t* A; const bf16_t* Bt; int M, N, K; };

struct StaticOrder {
    static constexpr bool GATHER = false;
    int nM, nN, nwg, G, c;
    __device__ __forceinline__ int rowsrc(int) const { return 0; }
    __host__ __device__ void init(int M, int N, int G_, int c_) { nM = M / BM; nN = N / BM; nwg = nM * nN; G = G_; c = c_; }
    __host__ __device__ bool next(int i, Unit& u) const {
        const long L = (long)i * G + c; if (L >= nwg) return false;
        int wgid = (int)L; { const int q = nwg / NXCD, r = nwg % NXCD, xcd = wgid % NXCD, off = wgid / NXCD; wgid = (xcd < r ? xcd * (q + 1) : r * (q + 1) + (xcd - r) * q) + off; }
        const int nig = WGM * nN, gid = wgid / nig, fm = gid * WGM, gsz = (nM - fm) < WGM ? (nM - fm) : WGM;
        u.pm = fm + ((wgid % nig) % gsz); u.pn = (wgid % nig) / gsz; u.pb = u.pn; return true;
    }
    __device__ __forceinline__ void a_ready(const Unit&) const {}
    __device__ __forceinline__ void done(const Unit&) const {}
};

__device__ __forceinline__ unsigned cvt_pk_bf16(float lo, float hi) { unsigned r; asm volatile("v_cvt_pk_bf16_f32 %0, %1, %2" : "=v"(r) : "v"(lo), "v"(hi)); return r; }
typedef float f32x2 __attribute__((ext_vector_type(2)));
template <class Epi, class Sched, bool ALIGN_EPI = false, bool SP2 = false>
__device__ __forceinline__ void gemm_phase(PG8_LAS unsigned char* lds, const Gemm g, const Sched& S, const Epi& E) {
    const int tid = otid(), wid = __builtin_amdgcn_readfirstlane(tid >> 6), lane = tid & 63, wr = wid >> 2, wc = wid & 3, fr = lane & 15, fq = lane >> 4;
    const int K = g.K, nt = K / BK;
    unsigned voffA[2], voffB[2];
#pragma unroll
    for (int i = 0; i < 2; ++i) { int R, C; stage_rc(tid * 16 + i * 8192, R, C); const int Rb = Epi::PERM ? ((R & ~31) + perm32(R & 31)) : R;
        voffA[i] = (unsigned)(R * K + C) * 2u; voffB[i] = (unsigned)(Rb * K + C) * 2u; }
    const size_t kstep = (size_t)(BK * 2);
    const size_t hstep = (size_t)HALF * K * 2;
    const size_t tstep = 2 * hstep;
    unsigned vA0[2], vA1[2], nA0[2], nA1[2];
    PG8_LAS int* rtab = (PG8_LAS int*)(lds + STAGE_BYTES);
    auto fillA = [&](int ui_, unsigned (&o0)[2], unsigned (&o1)[2]) {
#pragma unroll
        for (int i = 0; i < 2; ++i) {
            if constexpr (Sched::GATHER) { int R, C; stage_rc(tid * 16 + i * 8192, R, C);
                o0[i] = (unsigned)(rtab[ui_ * 256 + R] * K + C) * 2u; o1[i] = (unsigned)(rtab[ui_ * 256 + 128 + R] * K + C) * 2u; }
            else { o0[i] = voffA[i]; o1[i] = voffA[i] + (unsigned)hstep; } } };
    const unsigned ldsw = (unsigned)wid * 1024u;
    const int aoff = lds_byte(wr * 64 + fr, fq * 8), boff = lds_byte(wc * 32 + fr, fq * 8);
#define PG8_SA(b, h) (((b) * 2 + (h)) * HTB)
#define PG8_SB(b, h) ((4 + (b) * 2 + (h)) * HTB)
#define PG8_STAGE(bufoff, gbase, voff) do { _Pragma("unroll") for (int _i = 0; _i < 2; ++_i) \
        __builtin_amdgcn_global_load_lds((const unsigned*)((const char*)(gbase) + (voff)[_i]), (PG8_LAS unsigned*)(lds + (bufoff) + ldsw + _i * 8192), 16, 0, 0); } while (0)
#define PG8_LDA(dst, b, h) do { _Pragma("unroll") for (int m = 0; m < 4; ++m) _Pragma("unroll") for (int k = 0; k < 2; ++k) dst[m][k] = *(const PG8_LAS bf16x8*)(lds + PG8_SA(b, h) + aoff + m * 2048 + k * 1024); } while (0)
#define PG8_LDB(dst, b, h) do { _Pragma("unroll") for (int n = 0; n < 2; ++n) _Pragma("unroll") for (int k = 0; k < 2; ++k) dst[n][k] = *(const PG8_LAS bf16x8*)(lds + PG8_SB(b, h) + boff + n * 2048 + k * 1024); } while (0)
#define PG8_MMA(ai, bj, At, Bt) do { __builtin_amdgcn_s_setprio(1); _Pragma("unroll") for (int m = 0; m < 4; ++m) _Pragma("unroll") for (int n = 0; n < 2; ++n) _Pragma("unroll") for (int k = 0; k < 2; ++k) \
        acc[ai][bj][m][n] = __builtin_amdgcn_mfma_f32_16x16x32_bf16(Bt[n][k], At[m][k], acc[ai][bj][m][n], 0, 0, 0); __builtin_amdgcn_s_setprio(0); } while (0)
#define PG8_WAIT_V(n) asm volatile("s_waitcnt vmcnt(" #n ")" ::: "memory")
#define PG8_WAIT_L(n) asm volatile("s_waitcnt lgkmcnt(" #n ")" ::: "memory")
#define PG8_BAR __builtin_amdgcn_s_barrier()
#define PG8_SCHED __builtin_amdgcn_sched_barrier(0)
    Unit cur, nxt; int ui = 0;
    if (!S.next(0, cur)) return;
    f32x4 acc[2][2][4][2];
#pragma unroll
    for (int a = 0; a < 2; ++a)
#pragma unroll
        for (int b = 0; b < 2; ++b)
#pragma unroll
            for (int m = 0; m < 4; ++m)
#pragma unroll
                for (int n = 0; n < 2; ++n) acc[a][b][m][n] = (f32x4){0.f, 0.f, 0.f, 0.f};
    bf16x8 At[4][2], B0[2][2], B1[2][2];
    if constexpr (Sched::GATHER) {
        for (int ui_ = 0; ; ++ui_) { Unit u_; if (!S.next(ui_, u_)) break; if (tid < 256) rtab[ui_ * 256 + tid] = S.rowsrc(u_.pm * 256 + tid); }
        __syncthreads();
    }
    fillA(0, vA0, vA1);
    const char* cA = Sched::GATHER ? (const char*)g.A : (const char*)g.A + (size_t)cur.pm * tstep; const char* cB = (const char*)g.Bt + (size_t)cur.pb * tstep;
    S.a_ready(cur);
    if constexpr (SP2) {
        PG8_STAGE(PG8_SB(0, 0), cB, voffB); PG8_STAGE(PG8_SB(0, 1), cB + hstep, voffB); PG8_STAGE(PG8_SA(0, 0), cA, vA0); PG8_STAGE(PG8_SA(0, 1), cA, vA1);
        if (wr == 1) PG8_BAR;
        PG8_WAIT_V(2); PG8_BAR;
        PG8_STAGE(PG8_SB(1, 0), cB + kstep, voffB); PG8_STAGE(PG8_SA(1, 0), cA + kstep, vA0); PG8_STAGE(PG8_SB(1, 1), cB + hstep + kstep, voffB);
        PG8_WAIT_V(6); PG8_BAR;
    } else {
        PG8_STAGE(PG8_SB(0, 0), cB, voffB); PG8_STAGE(PG8_SA(0, 0), cA, vA0); PG8_STAGE(PG8_SB(0, 1), cB + hstep, voffB); PG8_STAGE(PG8_SA(0, 1), cA, vA1);
        if (wr == 1) PG8_BAR;
        PG8_WAIT_V(4); PG8_BAR;
        PG8_STAGE(PG8_SB(1, 0), cB + kstep, voffB); PG8_STAGE(PG8_SA(1, 0), cA + kstep, vA0); PG8_STAGE(PG8_SB(1, 1), cB + hstep + kstep, voffB);
        PG8_WAIT_V(6); PG8_BAR;
    }
    for (;;) {
        const bool has_next = S.next(ui + 1, nxt);
        const char* nA = has_next ? (Sched::GATHER ? (const char*)g.A : (const char*)g.A + (size_t)nxt.pm * tstep) : cA; const char* nB = has_next ? (const char*)g.Bt + (size_t)nxt.pb * tstep : cB;
        if (has_next) fillA(ui + 1, nA0, nA1); else {
#pragma unroll
            for (int i = 0; i < 2; ++i) { nA0[i] = vA0[i]; nA1[i] = vA1[i]; } }
        for (int t = 0; t < nt; t += 2) {
            const bool last = (t == nt - 2);
            const char* a1 = cA + (size_t)(t + 1) * kstep;
            const char* a2 = last ? nA : cA + (size_t)(t + 2) * kstep; const char* b2 = last ? nB : cB + (size_t)(t + 2) * kstep;
            const char* a3 = a2 + kstep; const char* b3 = b2 + kstep;
            unsigned sA0[2], sA1[2];
#pragma unroll
            for (int i = 0; i < 2; ++i) { sA0[i] = last ? nA0[i] : vA0[i]; sA1[i] = last ? nA1[i] : vA1[i]; }
            if (last && has_next) S.a_ready(nxt);
            if constexpr (SP2) {
            PG8_LDB(B0, 0, 0); PG8_LDB(B1, 0, 1); PG8_SCHED; PG8_LDA(At, 0, 0); PG8_STAGE(PG8_SA(1, 1), a1, vA1);
            PG8_WAIT_V(8); PG8_WAIT_L(0); PG8_BAR; PG8_MMA(0, 0, At, B0); PG8_MMA(0, 1, At, B1); PG8_BAR; PG8_SCHED;
            PG8_LDA(At, 0, 1); PG8_STAGE(PG8_SB(0, 0), b2, voffB); PG8_STAGE(PG8_SB(0, 1), b2 + hstep, voffB); PG8_STAGE(PG8_SA(0, 0), a2, sA0);
            PG8_WAIT_V(8); PG8_WAIT_L(0); PG8_BAR; PG8_MMA(1, 0, At, B0); PG8_MMA(1, 1, At, B1); PG8_BAR; PG8_SCHED;
            PG8_LDB(B0, 1, 0); PG8_LDB(B1, 1, 1); PG8_SCHED; PG8_LDA(At, 1, 0); PG8_STAGE(PG8_SA(0, 1), a2, sA1);
            PG8_WAIT_V(8); PG8_WAIT_L(0); PG8_BAR; PG8_MMA(0, 0, At, B0); PG8_MMA(0, 1, At, B1); PG8_BAR; PG8_SCHED;
            PG8_LDA(At, 1, 1); PG8_STAGE(PG8_SB(1, 0), b3, voffB); PG8_STAGE(PG8_SB(1, 1), b3 + hstep, voffB); PG8_STAGE(PG8_SA(1, 0), a3, sA0);
            PG8_WAIT_V(8); PG8_WAIT_L(0); PG8_BAR; PG8_MMA(1, 0, At, B0); PG8_MMA(1, 1, At, B1); PG8_BAR; PG8_SCHED;
            } else {
            PG8_LDB(B0, 0, 0); PG8_SCHED; PG8_LDA(At, 0, 0); PG8_STAGE(PG8_SA(1, 1), a1, vA1);
            PG8_WAIT_L(8); PG8_BAR; PG8_WAIT_L(0); PG8_MMA(0, 0, At, B0); PG8_BAR; PG8_SCHED;
            PG8_LDB(B1, 0, 1); PG8_STAGE(PG8_SB(0, 0), b2, voffB);
            PG8_BAR; PG8_WAIT_L(0); PG8_MMA(0, 1, At, B1); PG8_BAR;
            PG8_LDA(At, 0, 1); PG8_STAGE(PG8_SA(0, 0), a2, sA0);
            PG8_BAR; PG8_WAIT_L(0); PG8_MMA(1, 0, At, B0); PG8_BAR; PG8_SCHED;
            PG8_STAGE(PG8_SB(0, 1), b2 + hstep, voffB);
            PG8_WAIT_V(6); PG8_BAR; PG8_MMA(1, 1, At, B1); PG8_BAR;
            PG8_LDB(B0, 1, 0); PG8_SCHED; PG8_LDA(At, 1, 0); PG8_STAGE(PG8_SA(0, 1), a2, sA1);
            PG8_WAIT_L(8); PG8_BAR; PG8_WAIT_L(0); PG8_MMA(0, 0, At, B0); PG8_BAR; PG8_SCHED;
            PG8_LDB(B1, 1, 1); PG8_STAGE(PG8_SB(1, 0), b3, voffB);
            PG8_BAR; PG8_WAIT_L(0); PG8_MMA(0, 1, At, B1); PG8_BAR;
            PG8_LDA(At, 1, 1); PG8_STAGE(PG8_SA(1, 0), a3, sA0);
            PG8_BAR; PG8_WAIT_L(0); PG8_MMA(1, 0, At, B0); PG8_BAR; PG8_SCHED;
            PG8_STAGE(PG8_SB(1, 1), b3 + hstep, voffB);
            PG8_WAIT_V(6); PG8_BAR; PG8_MMA(1, 1, At, B1); PG8_BAR;
            }
        }
        if constexpr (ALIGN_EPI) { if (wr == 0) PG8_BAR; }
        if constexpr (!Epi::AFTER_DRAIN) { E(acc, cur, wr, wc, fr, fq); S.done(cur); }
        if (!has_next) break;
#pragma unroll
        for (int a = 0; a < 2; ++a)
#pragma unroll
            for (int b = 0; b < 2; ++b)
#pragma unroll
                for (int m = 0; m < 4; ++m)
#pragma unroll
                    for (int n = 0; n < 2; ++n) acc[a][b][m][n] = (f32x4){0.f, 0.f, 0.f, 0.f};
        cur = nxt; cA = nA; cB = nB; ++ui;
#pragma unroll
        for (int i = 0; i < 2; ++i) { vA0[i] = nA0[i]; vA1[i] = nA1[i]; }
        if constexpr (ALIGN_EPI) { if (wr == 1) PG8_BAR; }
    }
    PG8_WAIT_V(0);
    if constexpr (!ALIGN_EPI) { if (wr == 0) PG8_BAR; }
    PG8_BAR;
    if constexpr (Epi::AFTER_DRAIN) { E.fused(acc, cur, wr, wc, fr, fq, lds, wid, lane); S.done(cur); }
#undef PG8_SA
#undef PG8_SB
#undef PG8_STAGE
#undef PG8_LDA
#undef PG8_LDB
#undef PG8_MMA
#undef PG8_WAIT_V
#undef PG8_WAIT_L
#undef PG8_BAR
#undef PG8_SCHED
}
}
constexpr int D = 1024, BATCH = 8, SEQ = 4096, NTOK = BATCH * SEQ;
constexpr int GW = 512, RW = 512, HD = 64, CHUNK = 128;
constexpr int RPROJ = 1696, INW = 2720, ZLD = 2816;
constexpr int NG = 4, EPG = 8, NE = 32, EH = 512;
constexpr int NTHR = 512;
constexpr int LDS_BYTES = 163840;

typedef float f32x16 __attribute__((ext_vector_type(16)));
typedef float f32x4 __attribute__((ext_vector_type(4)));
typedef unsigned u32x4 __attribute__((ext_vector_type(4)));
typedef unsigned u32x2 __attribute__((ext_vector_type(2)));
typedef unsigned short bf16;
#define LAS __attribute__((address_space(3)))

constexpr size_t MiB = 1u << 20;
constexpr size_t W_WINT = 0;
constexpr size_t W_WOUTT = 6 * MiB;
constexpr size_t W_LORAT = 8 * MiB;
constexpr size_t W_WC = 9 * MiB;
constexpr size_t W_MOD = 10 * MiB;
constexpr size_t W_TAB = 11 * MiB;
constexpr size_t W_WGUT = 16 * MiB;
constexpr size_t W_WDT = 80 * MiB;
constexpr size_t W_H1 = 112 * MiB;
constexpr size_t W_Z = 176 * MiB;
constexpr size_t W_YCAT = 352 * MiB;
constexpr size_t W_LO = 416 * MiB;
constexpr size_t WS_NEED = 512 * MiB;
constexpr size_t T_TOKE = W_TAB;
constexpr size_t T_TOKW = W_TAB + 512 * 1024;
constexpr size_t T_ROWTOK = W_TAB + 1024 * 1024;
constexpr size_t T_ROWAID = W_TAB + 1536 * 1024;
constexpr size_t T_ROWW = W_TAB + 2048 * 1024;
constexpr size_t T_TILEE = W_TAB + 2560 * 1024;
constexpr size_t T_CTL = W_TAB + 3072 * 1024;
constexpr size_t T_BAR = W_TAB + 3584 * 1024;

struct Params {
    const float* in[31];
    float* out;
    unsigned char* ws;
};
typedef const __attribute__((address_space(4))) Params& PRef;
typedef const __attribute__((address_space(4))) Params* PPtr;
__device__ __forceinline__ PPtr opq(PPtr k) { asm volatile("" : "+s"(k)); return k; }
enum { I_X = 0, I_C, I_ADAW, I_ADAB, I_N1G, I_WIN, I_GLNW, I_GLNB, I_GWS, I_GBS, I_MU, I_W0, I_W2, I_A0, I_A2, I_G2, I_KK, I_KA, I_RK, I_GNW, I_GNB, I_WOUT, I_N2G, I_RGW, I_RGB, I_REW, I_REB, I_WG, I_WU, I_WD, I_FNG };

__device__ __forceinline__ float wave_sum(float v) {
#pragma unroll
    for (int o = 1; o < 64; o <<= 1) v += __shfl_xor(v, o);
    return v;
}
#define DPP_ADD(v, ctrl) v += __builtin_bit_cast(float, __builtin_amdgcn_update_dpp(0, __builtin_bit_cast(int, v), ctrl, 0xf, 0xf, false))
__device__ __forceinline__ float wave_sum_dpp(float v) {
    DPP_ADD(v, 0xB1); DPP_ADD(v, 0x4E); DPP_ADD(v, 0x141); DPP_ADD(v, 0x140);
    const int iv = __builtin_bit_cast(int, v);
    const float a = __builtin_bit_cast(float, __builtin_amdgcn_readlane(iv, 0)), b = __builtin_bit_cast(float, __builtin_amdgcn_readlane(iv, 16));
    const float c = __builtin_bit_cast(float, __builtin_amdgcn_readlane(iv, 32)), d = __builtin_bit_cast(float, __builtin_amdgcn_readlane(iv, 48));
    return (a + b) + (c + d);
}
__device__ __forceinline__ float xsum4(float s) {
    s += __builtin_bit_cast(float, __builtin_amdgcn_ds_swizzle(__builtin_bit_cast(int, s), 0x401F));
    float a = s, b = s;
    asm volatile("s_nop 1\n\tv_permlane32_swap_b32 %0, %1\n\ts_nop 1" : "+v"(a), "+v"(b));
    return a + b;
}
__device__ __forceinline__ float wave_sum_v(float v) {
    DPP_ADD(v, 0xB1); DPP_ADD(v, 0x4E); DPP_ADD(v, 0x141); DPP_ADD(v, 0x140);
    return xsum4(v);
}
__device__ __forceinline__ float gelu_tanh(float x) {
    const float u = 0.7978845608028654f * (x + 0.044715f * x * x * x);
    return 0.5f * x * (1.0f + tanhf(u));
}
__device__ __forceinline__ float gelu_fast(float x) {
    const float u2 = -2.302208198f * (x + 0.044715f * x * x * x);
    return x * __builtin_amdgcn_rcpf(1.0f + __builtin_amdgcn_exp2f(u2));
}
__device__ __forceinline__ float sigmoidf_(float x) { return 1.0f / (1.0f + expf(-x)); }
__device__ __forceinline__ float softplusf_(float x) { return fmaxf(x, 0.f) + log1pf(expf(-fabsf(x))); }
__device__ __forceinline__ float bf2f(unsigned short b) { return __uint_as_float(((unsigned)b) << 16); }
__device__ __forceinline__ float bflo(unsigned w) { return __uint_as_float(w << 16); }
__device__ __forceinline__ float bfhi(unsigned w) { return __uint_as_float(w & 0xffff0000u); }
__device__ __forceinline__ unsigned f2bf(float f) { unsigned u = __float_as_uint(f); return (u + 0x7fffu + ((u >> 16) & 1u)) >> 16; }
__device__ __forceinline__ unsigned pk2(float lo, float hi) { return f2bf(lo) | (f2bf(hi) << 16); }
#define XB_TMO      128
#define XB_XCNT(j)  (256  + 64 * (j))
#define XB_XSUB(j)  (1280 + 64 * (j))
#define XB_XGEN(j)  (2304 + 64 * (j))
#define XB_TOP      3328
#define XB_TOPGEN   3392
#define XCD_BAR_WORDS 3456
#define XB_SPIN_CAP (1u << 18)

__device__ __forceinline__ unsigned xb_ld(unsigned* p)              { return __hip_atomic_load(p, __ATOMIC_RELAXED, __HIP_MEMORY_SCOPE_AGENT); }
__device__ __forceinline__ unsigned xb_add(unsigned* p, unsigned v) { return __hip_atomic_fetch_add(p, v, __ATOMIC_RELAXED, __HIP_MEMORY_SCOPE_AGENT); }
__device__ __forceinline__ unsigned xb_xcc_id() { return (unsigned)__builtin_amdgcn_s_getreg((3 << 11) | 20) & 0xFu; }
#define XB_SPIN(cond, bar) do { unsigned _sp = 0; while (cond) { __builtin_amdgcn_s_sleep(1); \
    if ((++_sp & 255u) == 0u) { if (xb_ld(&(bar)[XB_TMO])) break; if (_sp > XB_SPIN_CAP) { atomicAdd(&(bar)[XB_TMO], 1u); break; } } } } while (0)

struct XcdBarrier {
    unsigned* bar; unsigned x;
    volatile LAS unsigned* st;
};

__device__ __forceinline__ XcdBarrier xcd_barrier_post(unsigned* bar, volatile LAS unsigned* st) {
    XcdBarrier b; b.bar = bar; b.x = xb_xcc_id(); b.st = st;
    if (threadIdx.x == 0) (void)xb_add(&bar[XB_XCNT(b.x)], 1u);
    return b;
}
__device__ __forceinline__ void xcd_barrier_complete(unsigned* bar, unsigned x, unsigned& nloc, unsigned& nx) {
    const unsigned G = gridDim.x * gridDim.y * gridDim.z;
    unsigned sum, cnt, mine, sp = 0u;
    for (;;) {
        sum = 0u; cnt = 0u; mine = 0u;
#pragma unroll
        for (unsigned j = 0; j < 16; ++j) { const unsigned c = xb_ld(&bar[XB_XCNT(j)]); sum += c; cnt += (c > 0u) ? 1u : 0u; mine = (j == x) ? c : mine; }
        if (sum == G) break;
        __builtin_amdgcn_s_sleep(1);
        if ((++sp & 255u) == 0u) { if (xb_ld(&bar[XB_TMO])) break; if (sp > XB_SPIN_CAP) { atomicAdd(&bar[XB_TMO], 1u); break; } }
    }
    nloc = mine > 0u ? mine : 1u; nx = cnt > 0u ? cnt : 1u;
}

__device__ __forceinline__ void xcd_barrier(const XcdBarrier& b) {
    asm volatile("s_waitcnt vmcnt(0)" ::: "memory");
    __syncthreads();
    if (threadIdx.x == 0) {
        unsigned* bar = b.bar;
        __builtin_amdgcn_s_waitcnt(0);
        unsigned nloc = b.st[0], nx = b.st[1];
        if (nloc == 0u) { xcd_barrier_complete(bar, b.x, nloc, nx); b.st[0] = nloc; b.st[1] = nx; }
        const unsigned old = xb_add(&bar[XB_XSUB(b.x)], 1u);
        const unsigned gen = old / nloc;
        if (old + 1u == (gen + 1u) * nloc) {
            __builtin_amdgcn_fence(__ATOMIC_RELEASE, "agent");
            asm volatile("s_waitcnt vmcnt(0)" ::: "memory");
            const unsigned og = xb_add(&bar[XB_TOP], 1u);
            const unsigned tg = og / nx;
            if (og + 1u == (tg + 1u) * nx) xb_add(&bar[XB_TOPGEN], 1u);
            else XB_SPIN(xb_ld(&bar[XB_TOPGEN]) == tg, bar);
            __builtin_amdgcn_fence(__ATOMIC_ACQUIRE, "agent");
            xb_add(&bar[XB_XGEN(b.x)], 1u);
            asm volatile("s_waitcnt vmcnt(0)" ::: "memory");
        } else {
            XB_SPIN(xb_ld(&bar[XB_XGEN(b.x)]) == gen, bar);
            __builtin_amdgcn_fence(__ATOMIC_ACQUIRE, "agent");
            asm volatile("s_waitcnt vmcnt(0)" ::: "memory");
        }
    }
    __syncthreads();
}
constexpr int GT = 128;
constexpr int PROWS_G = NTOK * 2 + NE * GT;
constexpr int PTILES_G = PROWS_G / GT;
template <class Epi>
__device__ __forceinline__ void gg_gemm(float* lds, const float* __restrict__ A, int lda, const int* rowidx, const float* __restrict__ B, int ldb, size_t bstride,
                        const int* tile_expert, int M, int N, int K, const Epi& epi, int bid, int nb) {
    float* As = lds;
    float* Bs = lds + 16 * 132;
    const int tid = otid(), lane = tid & 63, wid = tid >> 6, wm = wid >> 1, wn = wid & 1;
    const int tilesN = (N + 127) / 128, tilesM = M / 128;
    for (int tile = bid; tile < tilesM * tilesN; tile += nb) {
        const int tm = tile / tilesN, tn = tile % tilesN;
        const float* Bp = B;
        if (tile_expert) { const int e = tile_expert[tm]; if (e < 0) continue; Bp = B + (size_t)e * bstride; }
        f32x16 acc0, acc1;
#pragma unroll
        for (int i = 0; i < 16; ++i) { acc0[i] = 0.f; acc1[i] = 0.f; }
        const int arow = tid >> 2, akq = (tid & 3) * 4;
        int asrc = tm * 128 + arow;
        if (rowidx) asrc = rowidx[asrc];
        const int bk = tid >> 5, bn4 = (tid & 31) * 4, bcol = tn * 128 + bn4;
        for (int k0 = 0; k0 < K; k0 += 16) {
            f32x4 av = {0.f, 0.f, 0.f, 0.f};
            if (asrc >= 0) av = *(const f32x4*)(A + (size_t)asrc * lda + k0 + akq);
            f32x4 bv = {0.f, 0.f, 0.f, 0.f};
            if (bcol < N) bv = *(const f32x4*)(Bp + (size_t)(k0 + bk) * ldb + bcol);
            __syncthreads();
            As[(akq + 0) * 132 + arow] = av[0]; As[(akq + 1) * 132 + arow] = av[1]; As[(akq + 2) * 132 + arow] = av[2]; As[(akq + 3) * 132 + arow] = av[3];
            *(f32x4*)(Bs + bk * 128 + bn4) = bv;
            __syncthreads();
#pragma unroll
            for (int kk = 0; kk < 16; kk += 2) {
                const int kr = kk + (lane >> 5);
                const float a = As[kr * 132 + wm * 32 + (lane & 31)];
                const float b0 = Bs[kr * 128 + wn * 64 + (lane & 31)];
                const float b1 = Bs[kr * 128 + wn * 64 + 32 + (lane & 31)];
                acc0 = __builtin_amdgcn_mfma_f32_32x32x2f32(a, b0, acc0, 0, 0, 0);
                acc1 = __builtin_amdgcn_mfma_f32_32x32x2f32(a, b1, acc1, 0, 0, 0);
            }
        }
#pragma unroll
        for (int r = 0; r < 16; ++r) {
            const int row = tm * 128 + wm * 32 + (r & 3) + 8 * (r >> 2) + 4 * (lane >> 5);
            const int c0 = tn * 128 + wn * 64 + (lane & 31);
            if (c0 < N) epi(row, c0, acc0[r]);
            if (c0 + 32 < N) epi(row, c0 + 32, acc1[r]);
        }
        __syncthreads();
    }
}
__device__ __forceinline__ void gold_normmod(const float* __restrict__ x, const float* __restrict__ g, const float* mod, int shift_idx, int scale_idx, float* __restrict__ out, int bid, int nb) {
    const int tid_ = otid(), lane = tid_ & 63, wv = tid_ >> 6;
    for (int row = bid * 8 + wv; row < NTOK; row += nb * 8) {
        const int b = row / SEQ;
        const f32x4* xr = (const f32x4*)(x + (size_t)row * D) + lane;
        f32x4 v[4]; float s = 0.f;
#pragma unroll
        for (int j = 0; j < 4; ++j) { v[j] = xr[64 * j]; s += v[j][0] * v[j][0] + v[j][1] * v[j][1] + v[j][2] * v[j][2] + v[j][3] * v[j][3]; }
        const float r = rsqrtf(wave_sum(s) * (1.0f / D) + 1e-6f);
        const float* sh = mod + b * 6 * D + shift_idx * D; const float* sc = mod + b * 6 * D + scale_idx * D;
        f32x4* o = (f32x4*)(out + (size_t)row * D) + lane;
#pragma unroll
        for (int j = 0; j < 4; ++j) {
            const int c0 = (lane + 64 * j) * 4; f32x4 y;
#pragma unroll
            for (int q = 0; q < 4; ++q) y[q] = v[j][q] * r * g[c0 + q] * (1.0f + sc[c0 + q]) + sh[c0 + q];
            o[64 * j] = y;
        }
    }
}
__device__ __forceinline__ void gold_gmlp_ln(PRef p, const bf16* Z, float* vln, int bid, int nb) {
    const float* lw = p.in[I_GLNW]; const float* lb = p.in[I_GLNB];
    const int tid_ = otid(), lane = tid_ & 63, wv = tid_ >> 6;
    for (int row = bid * 8 + wv; row < NTOK; row += nb * 8) {
        const bf16* vr = Z + (size_t)row * ZLD + 512;
        float v[8]; float s = 0.f;
#pragma unroll
        for (int j = 0; j < 8; ++j) { v[j] = bf2f(vr[lane + 64 * j]); s += v[j]; }
        const float m = wave_sum(s) * (1.0f / 512.f); float q = 0.f;
#pragma unroll
        for (int j = 0; j < 8; ++j) { const float d = v[j] - m; q += d * d; }
        const float rs = rsqrtf(wave_sum(q) * (1.0f / 512.f) + 1e-5f);
#pragma unroll
        for (int j = 0; j < 8; ++j) { const int c = lane + 64 * j; vln[(size_t)row * 512 + c] = (v[j] - m) * rs * lw[c] + lb[c]; }
    }
}
__device__ __forceinline__ void gold_gmlp_mix(PRef p, const bf16* Z, const float* vln, float* ycat, int bid, int nb) {
    const float* wsp = p.in[I_GWS]; const float* bsp = p.in[I_GBS];
    for (int t = bid; t < NTOK; t += nb) {
        const int c = otid(), h = c >> 6, tl = t & 127, t0 = t - tl;
        const float* wrow = wsp + ((size_t)h * CHUNK + tl) * CHUNK;
        float s = 0.f;
        for (int ss = 0; ss <= tl; ++ss) s = fmaf(wrow[ss], vln[(size_t)(t0 + ss) * 512 + c], s);
        s += bsp[h * CHUNK + tl];
        ycat[(size_t)t * 1024 + c] = bf2f(Z[(size_t)t * ZLD + c]) * s;
    }
}
constexpr int NPT = 8192;
__device__ __forceinline__ void gold_rwkv_prep(PRef p, float* lds, const bf16* Z, float* SC, float* RKo, int part, int bid, int nb) {
    constexpr size_t AS = (size_t)NPT * 512;
    float *Ro = SC, *Wo = SC + AS, *Ko = SC + 2 * AS, *Vo = SC + 3 * AS, *Ao = SC + 4 * AS, *Bo = SC + 5 * AS, *Go = SC + 6 * AS;
    const float* mu = p.in[I_MU];
    float* zs = lds;
    const int c = otid(), lane = c & 63, h = c >> 6;
    for (int tl = bid; tl < NPT; tl += nb) {
        const int t = part * NPT + tl;
        __syncthreads();
        for (int j = c; j < RPROJ; j += NTHR) {
            const float cur = bf2f(Z[(size_t)t * ZLD + 1024 + j]);
            const float prev = (t % SEQ == 0) ? 0.f : bf2f(Z[(size_t)(t - 1) * ZLD + 1024 + j]);
            float z = cur + (prev - cur) * mu[j];
            if (j >= 1536 && j < 1568) z = tanhf(z);
            if (j >= 1600) z = sigmoidf_(z);
            zs[j] = z;
        }
        __syncthreads();
        const float r = zs[c], k = zs[512 + c], v = zs[1024 + c];
        float dw = 0.f, da = 0.f, g = 0.f;
#pragma unroll 4
        for (int j = 0; j < 32; ++j) dw = fmaf(zs[1536 + j], p.in[I_W2][j * 512 + c], dw);
#pragma unroll 4
        for (int j = 0; j < 32; ++j) da = fmaf(zs[1568 + j], p.in[I_A2][j * 512 + c], da);
#pragma unroll 4
        for (int j = 0; j < 96; ++j) g = fmaf(zs[1600 + j], p.in[I_G2][j * 512 + c], g);
        const float wlog = -softplusf_(-(p.in[I_W0][c] + dw)) - 0.5f;
        const float decay = expf(-expf(wlog));
        const float asig = sigmoidf_(p.in[I_A0][c] + da);
        const float kkv = k * p.in[I_KK][c];
        const float nrm = sqrtf(wave_sum(kkv * kkv));
        const float kk = kkv / fmaxf(nrm, 1e-12f);
        const float k2 = k * (1.0f + (asig - 1.0f) * p.in[I_KA][c]);
        const float rk = wave_sum(r * k2 * p.in[I_RK][c]);
        const size_t o = (size_t)tl * 512 + c;
        Ro[o] = r; Wo[o] = decay; Ko[o] = k2; Vo[o] = v; Ao[o] = -kk; Bo[o] = kk * asig; Go[o] = g;
        if (lane == 0) RKo[tl * 8 + h] = rk;
    }
}
__device__ __forceinline__ void gold_rwkv_prep_lo(PRef p, float* lds, const bf16* Z, const bf16* LO, float* SC, float* RKo, int part, int bid, int nb) {
    constexpr size_t AS = (size_t)NPT * 512;
    float *Ro = SC, *Wo = SC + AS, *Ko = SC + 2 * AS, *Vo = SC + 3 * AS, *Ao = SC + 4 * AS, *Bo = SC + 5 * AS, *Go = SC + 6 * AS;
    const float* mu = p.in[I_MU];
    const int c = otid(), lane = c & 63, h = c >> 6;
    for (int tl = bid; tl < NPT; tl += nb) {
        const int t = part * NPT + tl;
        float z3[3];
#pragma unroll
        for (int q = 0; q < 3; ++q) { const int j = q * 512 + c;
            const float cur = bf2f(Z[(size_t)t * ZLD + 1024 + j]);
            const float prev = (t % SEQ == 0) ? 0.f : bf2f(Z[(size_t)(t - 1) * ZLD + 1024 + j]);
            z3[q] = cur + (prev - cur) * mu[j]; }
        const float r = z3[0], k = z3[1], v = z3[2];
        const float decay = expf(bf2f(LO[(size_t)t * 1536 + c]));
        const float asig = bf2f(LO[(size_t)t * 1536 + 512 + c]);
        const float g = bf2f(LO[(size_t)t * 1536 + 1024 + c]);
        const float kkv = k * p.in[I_KK][c];
        const float nrm = sqrtf(wave_sum(kkv * kkv));
        const float kk = kkv / fmaxf(nrm, 1e-12f);
        const float k2 = k * (1.0f + (asig - 1.0f) * p.in[I_KA][c]);
        const float rk = wave_sum(r * k2 * p.in[I_RK][c]);
        const size_t o = (size_t)tl * 512 + c;
        Ro[o] = r; Wo[o] = decay; Ko[o] = k2; Vo[o] = v; Ao[o] = -kk; Bo[o] = kk * asig; Go[o] = g;
        if (lane == 0) RKo[tl * 8 + h] = rk;
    }
}
template <class YT>
__device__ __forceinline__ void gold_rwkv_scan(PRef p, float* lds, const float* SC, const float* RKi, YT* ycat, int part, int bid, int nb) {
    constexpr size_t AS = (size_t)NPT * 512;
    const float *Ri = SC, *Wi = SC + AS, *Ki = SC + 2 * AS, *Vi = SC + 3 * AS, *Ai = SC + 4 * AS, *Bi = SC + 5 * AS, *Gi = SC + 6 * AS;
    constexpr int TS = 16;
    float* vec = lds;
    float* vb = lds + 5 * TS * 64;
    float* yb = vb + TS * 64;
    const int tid = otid(), lane = tid & 63, wv = tid >> 6;
    for (int item = bid; item < (NPT / SEQ) * 8; item += nb) {
        const int bl = item >> 3, h = item & 7;
        float S[64];
#pragma unroll
        for (int k = 0; k < 64; ++k) S[k] = 0.f;
        for (int c0 = 0; c0 < SEQ; c0 += TS) {
            __syncthreads();
            for (int i = tid; i < 6 * TS * 64; i += NTHR) {
                const int arr = i / (TS * 64), rem = i % (TS * 64), s = rem >> 6, d = rem & 63;
                const size_t src = ((size_t)(bl * SEQ + c0 + s)) * 512 + h * 64 + d;
                const float* ap = arr == 0 ? Ri : arr == 1 ? Wi : arr == 2 ? Ki : arr == 3 ? Ai : arr == 4 ? Bi : Vi;
                const float val = ap[src];
                if (arr < 5) vec[(arr * TS + s) * 64 + d] = val; else vb[s * 64 + d] = val;
            }
            __syncthreads();
            if (wv == 0) {
                for (int s = 0; s < TS; ++s) {
                    const float* rr = vec + (0 * TS + s) * 64; const float* ww = vec + (1 * TS + s) * 64; const float* kk = vec + (2 * TS + s) * 64;
                    const float* aa = vec + (3 * TS + s) * 64; const float* bb = vec + (4 * TS + s) * 64;
                    const float vv = vb[s * 64 + lane];
                    float sa = 0.f;
#pragma unroll
                    for (int k = 0; k < 64; ++k) sa = fmaf(S[k], aa[k], sa);
                    float y = 0.f;
#pragma unroll
                    for (int k = 0; k < 64; ++k) { S[k] = fmaf(S[k], ww[k], fmaf(sa, bb[k], vv * kk[k])); y = fmaf(S[k], rr[k], y); }
                    yb[s * 64 + lane] = y;
                }
            }
            __syncthreads();
            for (int s = wv; s < TS; s += 8) {
                const int tl = bl * SEQ + c0 + s; const int t = part * NPT + tl; const int c = h * 64 + lane;
                const float y = yb[s * 64 + lane];
                const float m = wave_sum(y) * (1.0f / 64.f); const float dlt = y - m;
                const float var = wave_sum(dlt * dlt) * (1.0f / 64.f);
                float o = dlt * rsqrtf(var + 64e-5f) * p.in[I_GNW][c] + p.in[I_GNB][c];
                o += RKi[tl * 8 + h] * Vi[(size_t)tl * 512 + c];
                o *= Gi[(size_t)tl * 512 + c];
                if (sizeof(YT) == 2) ((bf16*)ycat)[(size_t)t * 1024 + 512 + c] = (bf16)f2bf(o); else ((float*)ycat)[(size_t)t * 1024 + 512 + c] = o;
            }
        }
    }
}
struct GEpiOutproj {
    const float* x; const float* mod; float* x1;
    __device__ __forceinline__ void operator()(int row, int col, float v) const {
        const int b = row / SEQ;
        x1[(size_t)row * D + col] = x[(size_t)row * D + col] + mod[b * 6 * D + 2 * D + col] * v;
    }
};
__device__ __forceinline__ void gold_norm2_route(PRef p, float* lds, const float* x1, float* h2, int bid, int nb) {
    const float* mod = (const float*)(p.ws + W_MOD);
    int* toke = (int*)(p.ws + T_TOKE); float* tokw = (float*)(p.ws + T_TOKW); int* cnt = (int*)(p.ws + T_CTL);
    const float* g = p.in[I_N2G]; const float* rgw = p.in[I_RGW]; const float* rew = p.in[I_REW];
    const int tid_ = otid(), lane = tid_ & 63, wv = tid_ >> 6;
    for (int row = bid * 8 + wv; row < NTOK; row += nb * 8) {
        const int b = row / SEQ;
        const float* xr = x1 + (size_t)row * D;
        float s = 0.f;
#pragma unroll 4
        for (int j = 0; j < 16; ++j) { const float xv = xr[lane + 64 * j]; s += xv * xv; }
        const float r = rsqrtf(wave_sum(s) * (1.0f / D) + 1e-6f);
        const float* sh = mod + b * 6 * D + 3 * D; const float* sc = mod + b * 6 * D + 4 * D;
        float lg[36];
#pragma unroll
        for (int j = 0; j < 36; ++j) lg[j] = 0.f;
#pragma unroll 1
        for (int j = 0; j < 16; ++j) {
            const int c = lane + 64 * j;
            const float hv = xr[c] * r * g[c] * (1.0f + sc[c]) + sh[c];
            h2[(size_t)row * D + c] = hv;
#pragma unroll
            for (int q = 0; q < 4; ++q) lg[q] = fmaf(hv, rgw[c * 4 + q], lg[q]);
#pragma unroll
            for (int q = 0; q < 32; ++q) lg[4 + q] = fmaf(hv, rew[c * 32 + q], lg[4 + q]);
        }
#pragma unroll
        for (int j = 0; j < 36; ++j) lg[j] = wave_sum(lg[j]);
        float* wl = lds + wv * 64;
        if (lane == 0) {
#pragma unroll
            for (int j = 0; j < 36; ++j) wl[j] = lg[j];
            float gm = -1e30f; int gi = 0;
            for (int q = 0; q < 4; ++q) { const float t = wl[q] + p.in[I_RGB][q]; if (t > gm) { gm = t; gi = q; } }
            float gs = 0.f; for (int q = 0; q < 4; ++q) gs += expf(wl[q] + p.in[I_RGB][q] - gm);
            const float gp = 1.0f / gs;
            float* el = wl + 40;
            for (int q = 0; q < 8; ++q) el[q] = wl[4 + gi * 8 + q] + p.in[I_REB][gi * 8 + q];
            int i0 = 0; for (int q = 1; q < 8; ++q) if (el[q] > el[i0]) i0 = q;
            int i1 = (i0 == 0) ? 1 : 0; for (int q = 0; q < 8; ++q) if (q != i0 && el[q] > el[i1]) i1 = q;
            const float em = el[i0];
            const float p0 = 1.0f, p1 = expf(el[i1] - em);
            const float w0 = gp * p0 / (p0 + p1), w1 = gp * p1 / (p0 + p1);
            const int e0 = gi * 8 + i0, e1 = gi * 8 + i1;
            toke[row * 2] = e0; toke[row * 2 + 1] = e1; tokw[row * 2] = w0; tokw[row * 2 + 1] = w1;
            atomicAdd(&cnt[e0], 1); atomicAdd(&cnt[e1], 1);
        }
    }
}
__device__ __forceinline__ void gold_moe_init(PRef p, int bid, int nb) {
    int* rowtok = (int*)(p.ws + T_ROWTOK); int* rowaid = (int*)(p.ws + T_ROWAID); float* roww = (float*)(p.ws + T_ROWW); int* tilee = (int*)(p.ws + T_TILEE);
    const int* cnt = (const int*)(p.ws + T_CTL);
    for (int i = bid * NTHR + otid(); i < PROWS_G; i += nb * NTHR) { rowtok[i] = -1; rowaid[i] = -1; roww[i] = 0.f; }
    if (bid == 0 && otid() == 0) {
        int t = 0;
        for (int e = 0; e < NE; ++e) { const int nt = (cnt[e] + GT - 1) / GT; for (int j = 0; j < nt; ++j) tilee[t++] = e; }
        for (; t < PTILES_G; ++t) tilee[t] = -1;
    }
}
__device__ __forceinline__ void gold_moe_place(PRef p, int bid, int nb) {
    int* rowtok = (int*)(p.ws + T_ROWTOK); int* rowaid = (int*)(p.ws + T_ROWAID); float* roww = (float*)(p.ws + T_ROWW);
    const int* cnt = (const int*)(p.ws + T_CTL); int* cursor = (int*)(p.ws + T_CTL + 128);
    const int* toke = (const int*)(p.ws + T_TOKE); const float* tokw = (const float*)(p.ws + T_TOKW);
    for (int a = bid * NTHR + otid(); a < NTOK * 2; a += nb * NTHR) {
        const int e = toke[a];
        int start = 0; for (int q = 0; q < e; ++q) start += (cnt[q] + GT - 1) / GT * GT;
        const int pos = start + atomicAdd(&cursor[e], 1);
        rowtok[pos] = a >> 1; rowaid[pos] = a; roww[pos] = tokw[a];
    }
}
struct GEpiGate { float* hb; __device__ __forceinline__ void operator()(int row, int col, float v) const { hb[(size_t)row * EH + col] = v; } };
struct GEpiUp { float* hb; __device__ __forceinline__ void operator()(int row, int col, float v) const { const float g = hb[(size_t)row * EH + col]; hb[(size_t)row * EH + col] = g / (1.0f + expf(-g)) * v; } };
struct GEpiDown {
    const int* rowaid; const float* roww; float* y0; float* y1;
    __device__ __forceinline__ void operator()(int row, int col, float v) const {
        const int a = rowaid[row]; if (a < 0) return;
        float* y = (a & 1) ? y1 : y0;
        y[(size_t)(a >> 1) * D + col] = roww[row] * v;
    }
};
__device__ __forceinline__ void gold_final(PRef p, const float* x1, const float* y0, const float* y1, int bid, int nb) {
    const float* mod = (const float*)(p.ws + W_MOD);
    float* out = p.out; const float* g = p.in[I_FNG];
    const int tid_ = otid(), lane = tid_ & 63, wv = tid_ >> 6;
    for (int row = bid * 8 + wv; row < NTOK; row += nb * 8) {
        const int b = row / SEQ; const float* gt = mod + b * 6 * D + 5 * D;
        float v[16]; float s = 0.f;
#pragma unroll
        for (int j = 0; j < 16; ++j) { const int c = lane + 64 * j; const size_t o = (size_t)row * D + c; v[j] = x1[o] + gt[c] * (y0[o] + y1[o]); s += v[j] * v[j]; }
        const float r = rsqrtf(wave_sum(s) * (1.0f / D) + 1e-6f);
#pragma unroll
        for (int j = 0; j < 16; ++j) { const int c = lane + 64 * j; out[(size_t)row * D + c] = v[j] * r * g[c]; }
    }
}
struct TrItem { const float* W; bf16* WT; int K, N; long row_off; int item; };
__device__ __forceinline__ void p0_tr_load(const TrItem& it, float (&tv)[32], int lane) {
    const int nblk = it.N / 32, kb = it.item / nblk, nb = it.item % nblk, k0 = 64 * kb, n0 = 32 * nb;
#pragma unroll
    for (int i = 0; i < 32; ++i) tv[i] = it.W[(size_t)(k0 + 2 * i + (lane >> 5)) * it.N + n0 + (lane & 31)];
}
__device__ __forceinline__ void p0_tr_store(const TrItem& it, const float (&tv)[32], LAS float* scr, int lane) {
    const int nblk = it.N / 32, kb = it.item / nblk, nb = it.item % nblk, k0 = 64 * kb, n0 = 32 * nb;
#pragma unroll
    for (int i = 0; i < 32; ++i) scr[(2 * i + (lane >> 5)) * 33 + (lane & 31)] = tv[i];
    asm volatile("s_waitcnt lgkmcnt(0)" ::: "memory");
    const int c = lane & 7;
#pragma unroll
    for (int j = 0; j < 4; ++j) { const int n = (lane >> 3) + 8 * j; const LAS float* s = scr + (8 * c) * 33 + n;
        u32x4 o; o.x = pk2(s[0 * 33], s[1 * 33]); o.y = pk2(s[2 * 33], s[3 * 33]); o.z = pk2(s[4 * 33], s[5 * 33]); o.w = pk2(s[6 * 33], s[7 * 33]);
        *(u32x4*)(it.WT + (size_t)(it.row_off + n0 + n) * it.K + k0 + 8 * c) = o; }
    asm volatile("s_waitcnt lgkmcnt(0)" ::: "memory");
}
__device__ __forceinline__ void p0_mod_item(PRef p, LAS float* red, int item) {
    const int tid = otid(), col = tid & 63, ks = __builtin_amdgcn_readfirstlane(tid >> 6), n = item * 64 + col;
    const float* __restrict__ c = p.in[I_C]; const float* __restrict__ w = p.in[I_ADAW];
    float acc[8];
#pragma unroll
    for (int b = 0; b < 8; ++b) acc[b] = 0.f;
#pragma unroll 16
    for (int k = ks * 128; k < ks * 128 + 128; ++k) {
        const float wv = w[(size_t)k * (6 * D) + n];
#pragma unroll
        for (int b = 0; b < 8; ++b) acc[b] = fmaf(c[b * D + k], wv, acc[b]);
    }
#pragma unroll
    for (int b = 0; b < 8; ++b) red[(ks * 8 + b) * 64 + col] = acc[b];
    __syncthreads();
    { const int b = tid >> 6; float s = 0.f;
#pragma unroll
      for (int q = 0; q < 8; ++q) s += red[(q * 8 + b) * 64 + col];
      ((float*)(p.ws + W_MOD))[b * 6 * D + n] = s + p.in[I_ADAB][n]; }
    __syncthreads();
}
template <bool WITH_MOE>
__device__ __forceinline__ void p0_prep(PRef p, LAS unsigned char* lds, int bid, int nb) {
    const int tid = otid(), lane = tid & 63, wave = __builtin_amdgcn_readfirstlane(tid >> 6);
    for (int it = bid; it < 96; it += nb) p0_mod_item(p, (LAS float*)lds, it);
    { bf16* lt = (bf16*)(p.ws + W_LORAT);
      for (int i = bid * NTHR + tid; i < 1536 * 256; i += nb * NTHR) { const int n = i >> 8, k = i & 255; float v = 0.f;
          if (n < 512) { if (k < 32) v = p.in[I_W2][k * 512 + n]; }
          else if (n < 1024) { if (k >= 32 && k < 64) v = p.in[I_A2][(k - 32) * 512 + (n - 512)]; }
          else { if (k >= 64 && k < 160) v = p.in[I_G2][(k - 64) * 512 + (n - 1024)]; }
          lt[i] = (bf16)f2bf(v); }
      bf16* wc = (bf16*)(p.ws + W_WC);
      for (int i = bid * NTHR + tid; i < 8 * 128 * 128; i += nb * NTHR) { const int s = i & 127, t = (i >> 7) & 127; wc[i] = (s <= t) ? (bf16)f2bf(p.in[I_GWS][i]) : (bf16)0; }
      bf16* wpad = (bf16*)(p.ws + W_WINT) + (size_t)INW * D;
      for (int i = bid * NTHR + tid; i < (ZLD - INW) * D; i += nb * NTHR) wpad[i] = 0; }
    LAS float* scr = (LAS float*)(lds + wave * 16384);
    const int gw = bid * 8 + wave, NGW = nb * 8;
    constexpr int I_IN = (D / 64) * (INW / 32), I_OUT = (D / 64) * (D / 32), I_GU = (D / 64) * (EH / 32), I_DN = (EH / 64) * (D / 32);
    constexpr int NIT = I_IN + I_OUT + (WITH_MOE ? NE * (2 * I_GU + I_DN) : 0);
    auto decode = [&](int it) -> TrItem {
        int r = it;
        if (r < I_IN) return TrItem{p.in[I_WIN], (bf16*)(p.ws + W_WINT), D, INW, 0, r}; r -= I_IN;
        if (r < I_OUT) return TrItem{p.in[I_WOUT], (bf16*)(p.ws + W_WOUTT), D, D, 0, r}; r -= I_OUT;
        const int e = r / (2 * I_GU + I_DN); r -= e * (2 * I_GU + I_DN);
        if (r < 2 * I_GU) {
            const int up = r >= I_GU; if (up) r -= I_GU;
            const int nbk = r % (EH / 32), hb = nbk * 32;
            const long row_off = (long)e * 1024 + (hb / 128) * 256 + up * 128 + (hb % 128) - hb;
            return TrItem{(up ? p.in[I_WU] : p.in[I_WG]) + (size_t)e * D * EH, (bf16*)(p.ws + W_WGUT), D, EH, row_off, r}; }
        r -= 2 * I_GU;
        return TrItem{p.in[I_WD] + (size_t)e * EH * D, (bf16*)(p.ws + W_WDT), EH, D, (long)e * 1024, r};
    };
    float tvA[32], tvB[32];
    int it = gw;
    if (it < NIT) { TrItem cur = decode(it); p0_tr_load(cur, tvA, lane);
#pragma unroll 1
        for (;;) {
            const int itn = it + NGW; TrItem nxt = cur;
            if (itn < NIT) { nxt = decode(itn); p0_tr_load(nxt, tvB, lane); }
            p0_tr_store(cur, tvA, scr, lane);
            if (itn >= NIT) break;
            const int itn2 = itn + NGW; cur = nxt;
            if (itn2 < NIT) { cur = decode(itn2); p0_tr_load(cur, tvA, lane); }
            p0_tr_store(nxt, tvB, scr, lane);
            if (itn2 >= NIT) break;
            it = itn2;
        } }
}
__device__ __forceinline__ void p1_h1(PRef p, int bid, int nb) {
    const float* __restrict__ x = p.in[I_X]; const float* __restrict__ g = p.in[I_N1G]; const float* mod = (const float*)(p.ws + W_MOD);
    bf16* H1 = (bf16*)(p.ws + W_H1);
    const int tid_ = otid(), lane = tid_ & 63, wv = tid_ >> 6;
#pragma unroll 1
    for (int row = (bid * 8 + wv) * 2; row < NTOK; row += nb * 16) {
        const int b = row / SEQ;
        const f32x4* xr = (const f32x4*)(x + (size_t)row * D) + lane;
        f32x4 v[2][4]; float s0 = 0.f, s1 = 0.f;
#pragma unroll
        for (int j = 0; j < 4; ++j) { v[0][j] = xr[64 * j]; v[1][j] = xr[256 + 64 * j]; }
#pragma unroll
        for (int j = 0; j < 4; ++j) { s0 += (v[0][j][0] * v[0][j][0] + v[0][j][1] * v[0][j][1]) + (v[0][j][2] * v[0][j][2] + v[0][j][3] * v[0][j][3]);
                                      s1 += (v[1][j][0] * v[1][j][0] + v[1][j][1] * v[1][j][1]) + (v[1][j][2] * v[1][j][2] + v[1][j][3] * v[1][j][3]); }
        const float r0 = rsqrtf(wave_sum_dpp(s0) * (1.0f / D) + 1e-6f), r1 = rsqrtf(wave_sum_dpp(s1) * (1.0f / D) + 1e-6f);
        const float* sh = mod + b * 6 * D; const float* sc = mod + b * 6 * D + D;
        u32x2* o = (u32x2*)(H1 + (size_t)row * D) + lane;
#pragma unroll
        for (int j = 0; j < 4; ++j) {
            const int c0 = (lane + 64 * j) * 4;
            const f32x4 gg = *(const f32x4*)(g + c0), ss = *(const f32x4*)(sc + c0), hh = *(const f32x4*)(sh + c0);
            f32x4 y0, y1;
#pragma unroll
            for (int q = 0; q < 4; ++q) { const float m = gg[q] * (1.0f + ss[q]); y0[q] = v[0][j][q] * r0 * m + hh[q]; y1[q] = v[1][j][q] * r1 * m + hh[q]; }
            u32x2 w0, w1; w0.x = pk2(y0[0], y0[1]); w0.y = pk2(y0[2], y0[3]); w1.x = pk2(y1[0], y1[1]); w1.y = pk2(y1[2], y1[3]);
            o[64 * j] = w0; o[256 + 64 * j] = w1;
        }
    }
}
struct EpiZ {
    static constexpr bool PERM = true, AFTER_DRAIN = false;
    bf16* Z;
    __device__ __forceinline__ void operator()(const f32x4 (&acc)[2][2][4][2], const pg8::Unit& u, int wr, int wc, int fr, int fq) const {
        const int row0 = u.pm * 256 + wr * 64 + fr, col0 = u.pn * 256 + wc * 32 + 8 * fq;
        const bool act = u.pn < 4;
#pragma unroll
        for (int ai = 0; ai < 2; ++ai)
#pragma unroll
            for (int m = 0; m < 4; ++m) { bf16* rowp = Z + (size_t)(row0 + ai * 128 + m * 16) * ZLD + col0;
#pragma unroll
                for (int bj = 0; bj < 2; ++bj) { f32x4 v0 = acc[ai][bj][m][0], v1 = acc[ai][bj][m][1];
                    if (act) {
#pragma unroll
                        for (int q = 0; q < 4; ++q) { v0[q] = gelu_fast(v0[q]); v1[q] = gelu_fast(v1[q]); } }
                    u32x4 w; w.x = pg8::cvt_pk_bf16(v0[0], v0[1]); w.y = pg8::cvt_pk_bf16(v0[2], v0[3]); w.z = pg8::cvt_pk_bf16(v1[0], v1[1]); w.w = pg8::cvt_pk_bf16(v1[2], v1[3]);
                    *(u32x4*)(rowp + bj * 128) = w; } }
    }
};
constexpr int VNT_PITCH = 272;
__device__ __forceinline__ void p3_gmlp_unit(PRef p, LAS unsigned char* lds, int chunk) {
    typedef short bf16x8 __attribute__((ext_vector_type(8)));
    const int tid = otid(), lane = tid & 63, wave = __builtin_amdgcn_readfirstlane(tid >> 6);
    const bf16* Z = (const bf16*)(p.ws + W_Z); bf16* ycat = (bf16*)(p.ws + W_YCAT);
    const int t0 = chunk * CHUNK;
    { float lw[8], lb[8];
#pragma unroll
      for (int j = 0; j < 8; ++j) { lw[j] = p.in[I_GLNW][lane + 64 * j]; lb[j] = p.in[I_GLNB][lane + 64 * j]; }
      for (int sp = 0; sp < 8; ++sp) {
          const int s = wave * 16 + sp * 2;
          const bf16* v0p = Z + (size_t)(t0 + s) * ZLD + 512 + lane; const bf16* v1p = v0p + ZLD;
          float a[8], b[8]; float sa = 0.f, sb = 0.f;
#pragma unroll
          for (int j = 0; j < 8; ++j) { a[j] = bf2f(v0p[64 * j]); b[j] = bf2f(v1p[64 * j]); sa += a[j]; sb += b[j]; }
          const float ma = wave_sum_dpp(sa) * (1.f / 512.f), mb = wave_sum_dpp(sb) * (1.f / 512.f); float qa = 0.f, qb = 0.f;
#pragma unroll
          for (int j = 0; j < 8; ++j) { a[j] -= ma; b[j] -= mb; qa += a[j] * a[j]; qb += b[j] * b[j]; }
          const float ra = rsqrtf(wave_sum_dpp(qa) * (1.f / 512.f) + 1e-5f), rb = rsqrtf(wave_sum_dpp(qb) * (1.f / 512.f) + 1e-5f);
#pragma unroll
          for (int j = 0; j < 8; ++j) { const unsigned w = pk2(a[j] * ra * lw[j] + lb[j], b[j] * rb * lw[j] + lb[j]);
              *(LAS unsigned*)(lds + (lane + 64 * j) * VNT_PITCH + s * 2) = w; }
      } }
    __syncthreads();
    const bf16* Wc = (const bf16*)(p.ws + W_WC) + (size_t)wave * CHUNK * CHUNK;
    const int fr = lane & 15, fq = lane >> 4;
    const LAS unsigned char* abase = lds + (wave * 64 + fr) * VNT_PITCH + fq * 16;
    for (int tt = 0; tt < 8; ++tt) {
        f32x4 acc[4];
#pragma unroll
        for (int dt = 0; dt < 4; ++dt) acc[dt] = (f32x4){0.f, 0.f, 0.f, 0.f};
        const int nks = ((tt * 16 + 15) >> 5) + 1;
        for (int ks = 0; ks < nks; ++ks) {
            const bf16x8 bfr = *(const bf16x8*)(Wc + (size_t)(tt * 16 + fr) * CHUNK + ks * 32 + fq * 8);
#pragma unroll
            for (int dt = 0; dt < 4; ++dt) {
                const bf16x8 afr = *(const LAS bf16x8*)(abase + dt * 16 * VNT_PITCH + ks * 64);
                acc[dt] = __builtin_amdgcn_mfma_f32_16x16x32_bf16(afr, bfr, acc[dt], 0, 0, 0);
            }
        }
        const int tl = tt * 16 + fr, t = t0 + tl;
        const float bsv = p.in[I_GBS][wave * CHUNK + tl];
#pragma unroll
        for (int dt = 0; dt < 4; ++dt) {
            const int c = wave * 64 + dt * 16 + fq * 4;
            const u32x2 uw = *(const u32x2*)(Z + (size_t)t * ZLD + c);
            u32x2 o; o.x = pk2(bflo(uw.x) * (acc[dt][0] + bsv), bfhi(uw.x) * (acc[dt][1] + bsv)); o.y = pk2(bflo(uw.y) * (acc[dt][2] + bsv), bfhi(uw.y) * (acc[dt][3] + bsv));
            *(u32x2*)(ycat + (size_t)t * 1024 + c) = o;
        }
    }
    __syncthreads();
}
constexpr size_t W_X1B = 240 * MiB;
struct EpiX1 {
    static constexpr bool PERM = true, AFTER_DRAIN = false;
    const float* x; const float* mod; bf16* x1;
    __device__ __forceinline__ void operator()(const f32x4 (&acc)[2][2][4][2], const pg8::Unit& u, int wr, int wc, int fr, int fq) const {
        const int row0 = u.pm * 256 + wr * 64 + fr, col0 = u.pn * 256 + wc * 32 + 8 * fq;
        const int b = (u.pm * 256) / SEQ;
        const float* gt = mod + b * 6 * D + 2 * D;
#pragma unroll
        for (int bj = 0; bj < 2; ++bj) { const f32x4 g0 = *(const f32x4*)(gt + col0 + bj * 128), g1 = *(const f32x4*)(gt + col0 + bj * 128 + 4);
#pragma unroll
            for (int ai = 0; ai < 2; ++ai)
#pragma unroll
                for (int m = 0; m < 4; ++m) { const size_t off = (size_t)(row0 + ai * 128 + m * 16) * D + col0 + bj * 128;
                    const f32x4 x0 = *(const f32x4*)(x + off), xb = *(const f32x4*)(x + off + 4);
                    const f32x4 v0 = x0 + g0 * acc[ai][bj][m][0], v1 = xb + g1 * acc[ai][bj][m][1];
                    u32x4 w; w.x = pg8::cvt_pk_bf16(v0[0], v0[1]); w.y = pg8::cvt_pk_bf16(v0[2], v0[3]); w.z = pg8::cvt_pk_bf16(v1[0], v1[1]); w.w = pg8::cvt_pk_bf16(v1[2], v1[3]);
                    *(u32x4*)(x1 + off) = w; } }
    }
};
constexpr size_t W_A2 = 112 * MiB;
constexpr size_t W_Q = 112 * MiB;
constexpr size_t W_Y2 = 144 * MiB;
constexpr size_t T_RK = W_TAB + 4 * MiB;
constexpr size_t O_M = 0, O_N = 64 * MiB;
constexpr size_t W_S = 176 * MiB;
constexpr int SCL = 64, NCH = SEQ / SCL;

__device__ __forceinline__ float sigmoid_fast(float x) { return __builtin_amdgcn_rcpf(1.0f + __builtin_amdgcn_exp2f(-1.4426950409f * x)); }
__device__ __forceinline__ void p3_lorain(PRef p, int bid, int nb) {
    const bf16* Z = (const bf16*)(p.ws + W_Z); bf16* A2 = (bf16*)(p.ws + W_A2);
    const int tid = otid(), j = tid & 255, sub = tid >> 8;
    const float muj = (j < 160) ? p.in[I_MU][1536 + j] : 0.f;
#pragma unroll 1
    for (int blk = bid; blk < NTOK / 128; blk += nb) {
        const int ts = blk * 128 + sub * 64;
        if (j < 160) {
            const bf16* zp = Z + (size_t)ts * ZLD + 2560 + j; bf16* ap = A2 + (size_t)ts * 256 + j;
            float prev = (ts % SEQ == 0) ? 0.f : bf2f(zp[-ZLD]);
#pragma unroll 1
            for (int t0 = 0; t0 < 64; t0 += 8) { float cur[8];
#pragma unroll
                for (int q = 0; q < 8; ++q) cur[q] = bf2f(zp[(size_t)(t0 + q) * ZLD]);
#pragma unroll
                for (int q = 0; q < 8; ++q) { float v = cur[q] + (prev - cur[q]) * muj; prev = cur[q];
                    if (j < 32) v = tanhf(v); else if (j >= 64) v = sigmoidf_(v);
                    ap[(size_t)(t0 + q) * 256] = (bf16)f2bf(v); } }
        } else { bf16* ap = A2 + (size_t)ts * 256 + j;
#pragma unroll 8
            for (int t = 0; t < 64; ++t) ap[(size_t)t * 256] = 0; }
    }
}
struct EpiLO {
    static constexpr bool PERM = true, AFTER_DRAIN = false;
    bf16* LO; const float* w0; const float* a0;
    __device__ __forceinline__ void operator()(const f32x4 (&acc)[2][2][4][2], const pg8::Unit& u, int wr, int wc, int fr, int fq) const {
        const int row0 = u.pm * 256 + wr * 64 + fr, col0 = u.pn * 256 + wc * 32 + 8 * fq, kind = u.pn >> 1;
#pragma unroll
        for (int bj = 0; bj < 2; ++bj) {
            f32x4 bv[2];
#pragma unroll
            for (int n = 0; n < 2; ++n) { const int ch = col0 + bj * 128 + 4 * n - kind * 512;
                bv[n] = kind == 0 ? *(const f32x4*)(w0 + ch) : kind == 1 ? *(const f32x4*)(a0 + ch) : (f32x4){0.f, 0.f, 0.f, 0.f}; }
#pragma unroll
            for (int ai = 0; ai < 2; ++ai)
#pragma unroll
                for (int m = 0; m < 4; ++m) { bf16* rowp = LO + (size_t)(row0 + ai * 128 + m * 16) * 1536 + col0 + bj * 128;
                    f32x4 v0 = acc[ai][bj][m][0] + bv[0], v1 = acc[ai][bj][m][1] + bv[1];
                    if (kind < 2) { const float sc = kind == 0 ? -0.6065306597f : 1.0f;
#pragma unroll
                        for (int q = 0; q < 4; ++q) { v0[q] = sc * sigmoid_fast(v0[q]); v1[q] = sc * sigmoid_fast(v1[q]); } }
                    u32x4 w; w.x = pg8::cvt_pk_bf16(v0[0], v0[1]); w.y = pg8::cvt_pk_bf16(v0[2], v0[3]); w.z = pg8::cvt_pk_bf16(v1[0], v1[1]); w.w = pg8::cvt_pk_bf16(v1[2], v1[3]);
                    *(u32x4*)rowp = w;
                    asm volatile("" ::: "memory"); }
        }
    }
};
constexpr int SC_TS = 8;
__device__ __forceinline__ void p5a_chunk(PRef p, LAS unsigned char* lds, int q) {
    typedef float f32x2 __attribute__((ext_vector_type(2)));
    const int tid_ = otid(), lane = tid_ & 63, wave = __builtin_amdgcn_readfirstlane(tid_ >> 6);
    const int seq = q / NCH, c = q % NCH, b = seq >> 3, h = seq & 7;
    const int tb = b * SEQ + c * SCL, hc = h * 64 + lane;
    const bf16* Z = (const bf16*)(p.ws + W_Z); const bf16* LO = (const bf16*)(p.ws + W_LO);
    bf16* Qo = (bf16*)(p.ws + W_Q); bf16* Y2o = (bf16*)(p.ws + W_Y2); bf16* VLo = (bf16*)(p.ws + W_YCAT); float* RKo = (float*)(p.ws + T_RK);
    LAS float* vec = (LAS float*)(lds + wave * (SC_TS * 6 * 256));
    const float mur = p.in[I_MU][hc], muk = p.in[I_MU][512 + hc], muv = p.in[I_MU][1024 + hc];
    const float kkc = p.in[I_KK][hc], kac = p.in[I_KA][hc], rkc = p.in[I_RK][hc];
    float rp = 0.f, kp = 0.f, vp = 0.f;
    if (c != 0) { const bf16* zp = Z + (size_t)(tb - 1) * ZLD + 1024 + hc; rp = bf2f(zp[0]); kp = bf2f(zp[512]); vp = bf2f(zp[1024]); }
    f32x2 Mr[32], Nr[32];
#pragma unroll
    for (int k = 0; k < 32; ++k) { Mr[k] = (f32x2){(2 * k == lane) ? 1.f : 0.f, (2 * k + 1 == lane) ? 1.f : 0.f}; Nr[k] = (f32x2){0.f, 0.f}; }
    for (int sb = 0; sb < SCL / SC_TS; ++sb) {
        const int t0 = tb + sb * SC_TS;
#pragma unroll 1
        for (int sg = 0; sg < SC_TS; sg += 4) { float zr[4], zk[4], zv[4], lw[4], as[4];
          const bf16* zp0 = Z + (unsigned)((t0 + sg) * ZLD + 1024 + hc); const bf16* lp0 = LO + (unsigned)((t0 + sg) * 1536 + hc);
#pragma unroll
          for (int s = 0; s < 4; ++s) { const bf16* zp = zp0 + s * ZLD; const bf16* lp = lp0 + s * 1536;
              zr[s] = bf2f(zp[0]); zk[s] = bf2f(zp[512]); zv[s] = bf2f(zp[1024]); lw[s] = bf2f(lp[0]); as[s] = bf2f(lp[512]); }
#pragma unroll
          for (int s = 0; s < 4; ++s) {
              const float r = zr[s] + (rp - zr[s]) * mur, k = zk[s] + (kp - zk[s]) * muk, v = zv[s] + (vp - zv[s]) * muv;
              rp = zr[s]; kp = zk[s]; vp = zv[s];
              const float kkv = k * kkc;
              const float nrm = sqrtf(wave_sum_dpp(kkv * kkv));
              const float kk = kkv / fmaxf(nrm, 1e-12f);
              const float k2 = k * (1.0f + (as[s] - 1.0f) * kac);
              const float rk = wave_sum_dpp(r * k2 * rkc);
              LAS float* o = vec + (sg + s) * 384 + lane;
              o[0] = __builtin_amdgcn_exp2f(1.4426950409f * lw[s]); o[64] = -kk; o[128] = kk * as[s]; o[192] = k2; o[256] = r; o[320] = v;
              VLo[(unsigned)((t0 + sg + s) * 1024 + 512 + hc)] = (bf16)f2bf(v);
              if (lane == 0) RKo[(unsigned)((t0 + sg + s) * 8 + h)] = rk;
          } }
        asm volatile("s_waitcnt lgkmcnt(0)" ::: "memory");
        for (int s = 0; s < SC_TS; ++s) {
            const LAS float* vs = vec + s * 384;
            const float vi = vs[320 + lane];
            f32x2 saM = {0.f, 0.f}, saN = {0.f, 0.f};
#pragma unroll
            for (int k4 = 0; k4 < 16; ++k4) { const f32x4 a4 = *(const LAS f32x4*)(vs + 64 + 4 * k4);
                const f32x2 a0 = {a4[0], a4[1]}, a1 = {a4[2], a4[3]};
                saM += Mr[2 * k4] * a0; saN += Nr[2 * k4] * a0; saM += Mr[2 * k4 + 1] * a1; saN += Nr[2 * k4 + 1] * a1;
                if ((k4 & 3) == 3) asm volatile("" ::: "memory"); }
            const float sM = saM[0] + saM[1], sN = saN[0] + saN[1];
            const f32x2 sM2 = {sM, sM}, sN2 = {sN, sN}, vi2 = {vi, vi};
            f32x2 yM = {0.f, 0.f}, yN = {0.f, 0.f};
#pragma unroll
            for (int k4 = 0; k4 < 16; ++k4) {
                const f32x4 w4 = *(const LAS f32x4*)(vs + 4 * k4), b4 = *(const LAS f32x4*)(vs + 128 + 4 * k4), k4v = *(const LAS f32x4*)(vs + 192 + 4 * k4), r4 = *(const LAS f32x4*)(vs + 256 + 4 * k4);
#pragma unroll
                for (int hh = 0; hh < 2; ++hh) {
                    const f32x2 w2 = {w4[2 * hh], w4[2 * hh + 1]}, b2 = {b4[2 * hh], b4[2 * hh + 1]}, k2 = {k4v[2 * hh], k4v[2 * hh + 1]}, r2 = {r4[2 * hh], r4[2 * hh + 1]};
                    const int kx = 2 * k4 + hh;
                    Mr[kx] = Mr[kx] * w2 + sM2 * b2;
                    Nr[kx] = Nr[kx] * w2 + (sN2 * b2 + vi2 * k2);
                    yM += Mr[kx] * r2; yN += Nr[kx] * r2;
                }
                asm volatile("" ::: "memory");
            }
            const unsigned oo = (unsigned)((t0 + s) * 512 + hc);
            Qo[oo] = (bf16)f2bf(yM[0] + yM[1]); Y2o[oo] = (bf16)f2bf(yN[0] + yN[1]);
        }
        asm volatile("s_waitcnt lgkmcnt(0)" ::: "memory");
    }
    f32x4* Mo = (f32x4*)((unsigned char*)p.out + O_M + (size_t)q * 16384 + lane * 256);
    f32x4* No = (f32x4*)((unsigned char*)p.out + O_N + (size_t)q * 16384 + lane * 256);
#pragma unroll
    for (int k4 = 0; k4 < 16; ++k4) { Mo[k4] = (f32x4){Mr[2 * k4][0], Mr[2 * k4][1], Mr[2 * k4 + 1][0], Mr[2 * k4 + 1][1]}; No[k4] = (f32x4){Nr[2 * k4][0], Nr[2 * k4][1], Nr[2 * k4 + 1][0], Nr[2 * k4 + 1][1]}; }
}
__device__ __forceinline__ void p5b_chain(PRef p, LAS unsigned char* lds, int item) {
    typedef float f32x2 __attribute__((ext_vector_type(2)));
    const int tid = otid(), r = tid >> 5, j0 = (tid & 31) * 2, seq = (item & 7) + 8 * (item >> 5), rg = (item >> 3) & 3;
    const unsigned char* Mb = (const unsigned char*)p.out + O_M + (size_t)seq * NCH * 16384;
    const unsigned char* Nb = (const unsigned char*)p.out + O_N + (size_t)seq * NCH * 16384 + (size_t)(rg * 16 + r) * 256 + j0 * 4;
    unsigned char* Sb = p.ws + W_S + (size_t)seq * NCH * 16384 + (size_t)(rg * 16 + r) * 256 + j0 * 4;
    f32x2 sreg = {0.f, 0.f};
    f32x4 m0[2], m1[2], m2[2], m3[2]; f32x2 n0, n1, n2, n3;
#define P5B_LOAD(mm, nn, cc) do { const f32x4* mp = (const f32x4*)(Mb + (size_t)(cc) * 16384) + tid; mm[0] = mp[0]; mm[1] = mp[512]; nn = *(const f32x2*)(Nb + (size_t)(cc) * 16384); } while (0)
#define P5B_BAR() do { asm volatile("s_waitcnt lgkmcnt(0)" ::: "memory"); __builtin_amdgcn_s_barrier(); asm volatile("" ::: "memory"); } while (0)
#define P5B_STEP(mm, nn, cc) do { \
        LAS float* Sl = (LAS float*)(lds + ((cc) & 1) * 20480); LAS float* Ml = Sl + 1024; \
        *(LAS f32x4*)(Ml + tid * 4) = mm[0]; *(LAS f32x4*)(Ml + 2048 + tid * 4) = mm[1]; *(LAS f32x2*)(Sl + r * 64 + j0) = sreg; \
        *(f32x2*)(Sb + (size_t)(cc) * 16384) = sreg; \
        f32x2 acc = nn; \
        P5B_BAR(); \
        if ((cc) + 4 < NCH) P5B_LOAD(mm, nn, (cc) + 4); \
        _Pragma("unroll 16") for (int i = 0; i < 64; ++i) { const float sv = Sl[r * 64 + i]; const f32x2 mv = *(const LAS f32x2*)(Ml + i * 64 + j0); acc += (f32x2){sv, sv} * mv; } \
        sreg = acc; } while (0)
    __syncthreads();
    P5B_LOAD(m0, n0, 0); P5B_LOAD(m1, n1, 1); P5B_LOAD(m2, n2, 2); P5B_LOAD(m3, n3, 3);
    for (int c = 0; c < NCH; c += 4) { P5B_STEP(m0, n0, c); P5B_STEP(m1, n1, c + 1); P5B_STEP(m2, n2, c + 2); P5B_STEP(m3, n3, c + 3); }
    __syncthreads();
#undef P5B_LOAD
#undef P5B_STEP
#undef P5B_BAR
}
#ifndef P5C_MASK
#define P5C_MASK(c, h, tt) true
#endif
__device__ __forceinline__ void p5c_chunk(PRef p, int q) {
    typedef short bf16x8 __attribute__((ext_vector_type(8)));
    const int lane = otid() & 63, fr = lane & 15, fq = lane >> 4;
    const int seq = q / NCH, c = q % NCH, b = seq >> 3, h = seq & 7, tb = b * SEQ + c * SCL;
    const bf16* Qi = (const bf16*)(p.ws + W_Q); const bf16* Y2i = (const bf16*)(p.ws + W_Y2);
    const float* RKi = (const float*)(p.ws + T_RK); const bf16* LO = (const bf16*)(p.ws + W_LO); bf16* ycat = (bf16*)(p.ws + W_YCAT);
    const float* Sc = (const float*)(p.ws + W_S + (size_t)q * 16384);
    bf16x8 sa[4][2];
#pragma unroll
    for (int vt = 0; vt < 4; ++vt)
#pragma unroll
        for (int ks = 0; ks < 2; ++ks) { const f32x4* sp = (const f32x4*)(Sc + (vt * 16 + fr) * 64 + ks * 32 + fq * 8); const f32x4 x0 = sp[0], x1 = sp[1];
            u32x4 w; w.x = pg8::cvt_pk_bf16(x0[0], x0[1]); w.y = pg8::cvt_pk_bf16(x0[2], x0[3]); w.z = pg8::cvt_pk_bf16(x1[0], x1[1]); w.w = pg8::cvt_pk_bf16(x1[2], x1[3]);
            sa[vt][ks] = __builtin_bit_cast(bf16x8, w); }
    f32x4 gw[4], gb[4];
#pragma unroll
    for (int vt = 0; vt < 4; ++vt) { gw[vt] = *(const f32x4*)(p.in[I_GNW] + h * 64 + vt * 16 + fq * 4); gb[vt] = *(const f32x4*)(p.in[I_GNB] + h * 64 + vt * 16 + fq * 4); }
#pragma unroll 1
    for (int tt = 0; tt < SCL / 16; ++tt) {
        const int t = tb + tt * 16 + fr;
        const unsigned tq = (unsigned)(t * 512 + h * 64);
        const bf16x8 qb0 = *(const bf16x8*)(Qi + (tq + fq * 8)), qb1 = *(const bf16x8*)(Qi + (tq + 32 + fq * 8));
        f32x4 y[4]; float s = 0.f;
#pragma unroll
        for (int vt = 0; vt < 4; ++vt) {
            const u32x2 yw = *(const u32x2*)(Y2i + (tq + vt * 16 + fq * 4));
            f32x4 a = {bflo(yw.x), bfhi(yw.x), bflo(yw.y), bfhi(yw.y)};
            a = __builtin_amdgcn_mfma_f32_16x16x32_bf16(sa[vt][0], qb0, a, 0, 0, 0);
            a = __builtin_amdgcn_mfma_f32_16x16x32_bf16(sa[vt][1], qb1, a, 0, 0, 0);
            y[vt] = a; s += (a[0] + a[1]) + (a[2] + a[3]);
        }
        s = xsum4(s);
        const float m = s * (1.f / 64.f); float qq = 0.f;
#pragma unroll
        for (int vt = 0; vt < 4; ++vt) { y[vt] = y[vt] - m; qq += (y[vt][0] * y[vt][0] + y[vt][1] * y[vt][1]) + (y[vt][2] * y[vt][2] + y[vt][3] * y[vt][3]); }
        qq = xsum4(qq);
        const float rs = rsqrtf(qq * (1.f / 64.f) + 64e-5f);
        const float rk = RKi[(unsigned)(t * 8 + h)];
#pragma unroll
        for (int vt = 0; vt < 4; ++vt) {
            const int cc = h * 64 + vt * 16 + fq * 4;
            const u32x2 vw = *(const u32x2*)(ycat + (unsigned)(t * 1024 + 512 + cc)); const u32x2 gwv = *(const u32x2*)(LO + (unsigned)(t * 1536 + 1024 + cc));
            const f32x4 vv = {bflo(vw.x), bfhi(vw.x), bflo(vw.y), bfhi(vw.y)}, gg = {bflo(gwv.x), bfhi(gwv.x), bflo(gwv.y), bfhi(gwv.y)};
            const f32x4 o = (y[vt] * rs * gw[vt] + gb[vt] + vv * rk) * gg;
            u32x2 ow; ow.x = pk2(o[0], o[1]); ow.y = pk2(o[2], o[3]);
            if (P5C_MASK(c, h, tt)) *(u32x2*)(ycat + (unsigned)(t * 1024 + 512 + cc)) = ow;
        }
    }
}
constexpr size_t W_H2 = 112 * MiB;
constexpr size_t W_XS = 176 * MiB;
constexpr size_t W_HB = 320 * MiB;
constexpr int PROWS = NTOK * 2 + NE * 256, PTILES = PROWS / 256;
constexpr size_t T_HIST = W_TAB + 3 * 1024 * 1024 + 8192;
constexpr size_t T_NT = W_TAB + 3 * 1024 * 1024 + 4096;
constexpr size_t T_BQ = W_TAB + 3 * 1024 * 1024 + 65536;
constexpr int TPW = NTOK / 256;

__device__ __forceinline__ void p1_bq(PRef p, LAS float* red, int b) {
    const int tid = otid();
    const float* sh = (const float*)(p.ws + W_MOD) + b * 6 * D + 3 * D;
    if (tid < 288) { const int q = tid % 36, part = tid / 36; float s = 0.f;
        for (int c = part * 128; c < part * 128 + 128; ++c) s = fmaf(sh[c], q < 4 ? p.in[I_RGW][c * 4 + q] : p.in[I_REW][c * 32 + q - 4], s);
        red[part * 36 + q] = s; }
    __syncthreads();
    if (tid < 36) { float s = 0.f;
#pragma unroll
        for (int k = 0; k < 8; ++k) s += red[k * 36 + tid];
        ((float*)(p.ws + T_BQ))[b * 36 + tid] = s + (tid < 4 ? p.in[I_RGB][tid] : p.in[I_REB][tid - 4]); }
    __syncthreads();
}
__device__ __forceinline__ void p7_route(PRef p, LAS unsigned char* lds, int bid) {
    const int tid = otid(), lane = tid & 63, wave = __builtin_amdgcn_readfirstlane(tid >> 6);
    const float* x1 = p.out; bf16* H2 = (bf16*)(p.ws + W_H2);
    LAS int* hist = (LAS int*)(lds + 147456);
    const int b = (bid * TPW) / SEQ;
    const float* mod = (const float*)(p.ws + W_MOD) + b * 6 * D;
    const float* n2g = p.in[I_N2G];
    for (int ch = tid; ch < 1024 * 8; ch += NTHR) { const int c = ch >> 3, i = ch & 7;
        *(LAS f32x4*)(lds + c * 128 + 16 * (i ^ ((c >> 1) & 7))) = *(const f32x4*)(p.in[I_REW] + c * 32 + i * 4); }
    for (int c = tid; c < 1024; c += NTHR) *(LAS f32x4*)(lds + 131072 + c * 16) = *(const f32x4*)(p.in[I_RGW] + c * 4);
    if (tid < 32) hist[tid] = 0;
    if (tid < 36) *(LAS float*)(lds + 147456 + 128 + 4 * tid) = tid < 4 ? p.in[I_RGB][tid] : p.in[I_REB][tid - 4];
    __syncthreads();
    const int sw = (lane >> 1) & 7;
#pragma unroll 1
    for (int tp = 0; tp < TPW / 8; tp += 2) {
        const int t0 = bid * TPW + wave * (TPW / 8) + tp;
        const float* xr0 = x1 + (size_t)t0 * D; bf16* hr0 = H2 + (size_t)t0 * D;
        float r0, r1;
        { float pa[16], pb[16];
#pragma unroll
          for (int j = 0; j < 16; ++j) { pa[j] = xr0[lane + 64 * j]; pb[j] = xr0[D + lane + 64 * j]; }
          float ss0 = 0.f, ss1 = 0.f;
#pragma unroll
          for (int j = 0; j < 16; ++j) { ss0 = fmaf(pa[j], pa[j], ss0); ss1 = fmaf(pb[j], pb[j], ss1); }
          r0 = rsqrtf(wave_sum_v(ss0) * (1.0f / D) + 1e-6f); r1 = rsqrtf(wave_sum_v(ss1) * (1.0f / D) + 1e-6f); }
        float acc[2][36];
#pragma unroll
        for (int u = 0; u < 2; ++u)
#pragma unroll
            for (int q = 0; q < 36; ++q) acc[u][q] = 0.f;
#pragma unroll 1
        for (int j0 = 0; j0 < 16; j0 += 4) {
            float xa[4], xb[4], gv[4], sv[4];
#pragma unroll
            for (int jj = 0; jj < 4; ++jj) { const int c = lane + 64 * (j0 + jj); xa[jj] = xr0[c]; xb[jj] = xr0[D + c]; gv[jj] = n2g[c] * (1.0f + mod[4 * D + c]); sv[jj] = mod[3 * D + c]; }
#pragma unroll
            for (int jj = 0; jj < 4; ++jj) {
                const int c = lane + 64 * (j0 + jj);
                const float a0 = xa[jj] * r0 * gv[jj] + sv[jj], a1 = xb[jj] * r1 * gv[jj] + sv[jj];
                hr0[c] = (bf16)f2bf(a0); hr0[D + c] = (bf16)f2bf(a1);
                const LAS unsigned char* rowp = lds + c * 128;
                { const f32x4 w = *(const LAS f32x4*)(lds + 131072 + c * 16);
#pragma unroll
                  for (int q = 0; q < 4; ++q) { acc[0][q] = fmaf(a0, w[q], acc[0][q]); acc[1][q] = fmaf(a1, w[q], acc[1][q]); } }
#pragma unroll
                for (int i = 0; i < 8; ++i) { const f32x4 w = *(const LAS f32x4*)(rowp + 16 * (i ^ sw));
#pragma unroll
                    for (int q = 0; q < 4; ++q) { acc[0][4 + 4 * i + q] = fmaf(a0, w[q], acc[0][4 + 4 * i + q]); acc[1][4 + 4 * i + q] = fmaf(a1, w[q], acc[1][4 + 4 * i + q]); } }
            }
        }
#pragma unroll
        for (int u = 0; u < 2; ++u) {
            float lg[36];
#pragma unroll
            for (int q = 0; q < 36; ++q) { lg[q] = wave_sum_v(acc[u][q]); if ((q & 3) == 3) __builtin_amdgcn_sched_barrier(0); }
            unsigned bqo = 147456u + 128u; asm volatile("" : "+v"(bqo));
#pragma unroll
            for (int q = 0; q < 36; ++q) lg[q] += *(const LAS float*)(lds + bqo + 4 * q);
            int gi = 0; float gm = lg[0];
#pragma unroll
            for (int q = 1; q < 4; ++q) if (lg[q] > gm) { gm = lg[q]; gi = q; }
            float gsum = 0.f;
#pragma unroll
            for (int q = 0; q < 4; ++q) gsum += expf(lg[q] - gm);
            const float gp = 1.0f / gsum;
            float el[8];
#pragma unroll
            for (int q = 0; q < 8; ++q) el[q] = gi == 0 ? lg[4 + q] : gi == 1 ? lg[12 + q] : gi == 2 ? lg[20 + q] : lg[28 + q];
            int i0 = 0; float m0 = el[0];
#pragma unroll
            for (int q = 1; q < 8; ++q) if (el[q] > m0) { m0 = el[q]; i0 = q; }
            int i1 = -1; float m1 = -3.0e38f;
#pragma unroll
            for (int q = 0; q < 8; ++q) if (q != i0 && el[q] > m1) { m1 = el[q]; i1 = q; }
            const float p1 = expf(m1 - m0);
            const float w0 = gp / (1.0f + p1), w1 = gp * p1 / (1.0f + p1);
            if (lane == 0) { const int t = t0 + u, e0 = gi * 8 + i0, e1 = gi * 8 + i1;
                int* toke = (int*)(p.ws + T_TOKE); float* tokw = (float*)(p.ws + T_TOKW);
                toke[t * 2] = e0; toke[t * 2 + 1] = e1; tokw[t * 2] = w0; tokw[t * 2 + 1] = w1;
                __hip_atomic_fetch_add(&hist[e0], 1, __ATOMIC_RELAXED, __HIP_MEMORY_SCOPE_WORKGROUP); __hip_atomic_fetch_add(&hist[e1], 1, __ATOMIC_RELAXED, __HIP_MEMORY_SCOPE_WORKGROUP); }
        }
    }
    __syncthreads();
    if (tid < 32) ((int*)(p.ws + T_HIST))[bid * 32 + tid] = hist[tid];
    __syncthreads();
}
__device__ __forceinline__ void p8_place(PRef p, LAS unsigned char* lds, int bid) {
    const int tid = otid(), lane = tid & 63, wave = __builtin_amdgcn_readfirstlane(tid >> 6);
    LAS int* ptot = (LAS int*)lds;
    LAS int* pbef = ptot + 512;
    LAS int* base = pbef + 512;
    LAS int* lcur = base + 32;
    LAS int* posl = lcur + 32;
    LAS int* padb = posl + 256;
    const int* hist = (const int*)(p.ws + T_HIST);
    { const int e = tid & 31, part = tid >> 5; int tot = 0, bef = 0;
#pragma unroll 4
      for (int w = part * 16; w < part * 16 + 16; ++w) { const int c = hist[w * 32 + e]; tot += c; bef += (w < bid) ? c : 0; }
      ptot[part * 32 + e] = tot; pbef[part * 32 + e] = bef; }
    __syncthreads();
    if (tid < 32) { int tot = 0, bef = 0;
#pragma unroll
        for (int k = 0; k < 16; ++k) { tot += ptot[k * 32 + tid]; bef += pbef[k * 32 + tid]; }
        ptot[tid] = tot; pbef[tid] = bef; lcur[tid] = 0; }
    __syncthreads();
    if (tid == 0) { int row = 0;
        for (int e = 0; e < NE; ++e) { const int cnt = ptot[e], nt = (cnt + 255) >> 8; base[e] = row + pbef[e]; padb[e] = row + cnt; padb[32 + e] = row + nt * 256;
            if (bid == 0) { int* te = (int*)(p.ws + T_TILEE); for (int k = 0; k < nt; ++k) te[(row >> 8) + k] = e; }
            row += nt * 256; }
        if (bid == 0) *(int*)(p.ws + T_NT) = row >> 8; }
    __syncthreads();
    int* rowaid = (int*)(p.ws + T_ROWAID); float* roww = (float*)(p.ws + T_ROWW);
    if (tid < 256) { const int a = bid * 256 + tid; const int e = ((const int*)(p.ws + T_TOKE))[a];
        const int pos = base[e] + __hip_atomic_fetch_add(&lcur[e], 1, __ATOMIC_RELAXED, __HIP_MEMORY_SCOPE_WORKGROUP);
        posl[tid] = pos; rowaid[pos] = a; roww[pos] = ((const float*)(p.ws + T_TOKW))[a]; }
    if (bid < NE) for (int r = padb[bid] + tid; r < padb[32 + bid]; r += NTHR) { rowaid[r] = -1; roww[r] = 0.f; }
    __syncthreads();
    __syncthreads();
}
template <bool GATHER_>
struct MoeOrder {
    static constexpr bool GATHER = GATHER_;
    const int* tile_e; const int* rowaid; int nM, G, c;
    __device__ __forceinline__ int rowsrc(int row) const { const int a = rowaid[row]; return (a < 0 ? 0 : a) >> 1; }
    __device__ __forceinline__ bool next(int i, pg8::Unit& u) const {
        const int nwg = nM * 4; const long L = (long)i * G + c; if (L >= nwg) return false;
        int wgid = (int)L; { const int q = nwg / 8, r = nwg % 8, xcd = wgid % 8, off = wgid / 8; wgid = (xcd < r ? xcd * (q + 1) : r * (q + 1) + (xcd - r) * q) + off; }
        const int nig = 8 * 4, gid = wgid / nig, fm = gid * 8, gsz = (nM - fm) < 8 ? (nM - fm) : 8;
        u.pm = fm + ((wgid % nig) % gsz); u.pn = (wgid % nig) / gsz; u.pb = tile_e[u.pm] * 4 + u.pn; return true;
    }
    __device__ __forceinline__ void a_ready(const pg8::Unit&) const {}
    __device__ __forceinline__ void done(const pg8::Unit&) const {}
};
__device__ __forceinline__ float silu_fast(float x) { return x * __builtin_amdgcn_rcpf(1.0f + __builtin_amdgcn_exp2f(-1.4426950409f * x)); }
struct EpiH {
    static constexpr bool PERM = true, AFTER_DRAIN = false;
    bf16* H;
    __device__ __forceinline__ void operator()(const f32x4 (&acc)[2][2][4][2], const pg8::Unit& u, int wr, int wc, int fr, int fq) const {
        const int row0 = u.pm * 256 + wr * 64 + fr, col0 = u.pn * 128 + wc * 32 + 8 * fq;
#pragma unroll
        for (int ai = 0; ai < 2; ++ai)
#pragma unroll
            for (int m = 0; m < 4; ++m) { const f32x4 g0 = acc[ai][0][m][0], g1 = acc[ai][0][m][1], u0 = acc[ai][1][m][0], u1 = acc[ai][1][m][1];
                f32x4 h0, h1;
#pragma unroll
                for (int q = 0; q < 4; ++q) { h0[q] = silu_fast(g0[q]) * u0[q]; h1[q] = silu_fast(g1[q]) * u1[q]; }
                u32x4 w; w.x = pg8::cvt_pk_bf16(h0[0], h0[1]); w.y = pg8::cvt_pk_bf16(h0[2], h0[3]); w.z = pg8::cvt_pk_bf16(h1[0], h1[1]); w.w = pg8::cvt_pk_bf16(h1[2], h1[3]);
                *(u32x4*)(H + (size_t)(row0 + ai * 128 + m * 16) * EH + col0) = w; }
    }
};
struct EpiY {
    static constexpr bool PERM = true, AFTER_DRAIN = false;
    bf16* YB; const int* rowaid; const float* roww;
    __device__ __forceinline__ void operator()(const f32x4 (&acc)[2][2][4][2], const pg8::Unit& u, int wr, int wc, int fr, int fq) const {
        const int row0 = u.pm * 256 + wr * 64 + fr, col0 = u.pn * 256 + wc * 32 + 8 * fq;
#pragma unroll
        for (int ai = 0; ai < 2; ++ai)
#pragma unroll
            for (int m = 0; m < 4; ++m) { const int row = row0 + ai * 128 + m * 16; const int a = rowaid[row]; const float w = roww[row];
                if (a >= 0) {
#pragma unroll
                    for (int bj = 0; bj < 2; ++bj) { const f32x4 v0 = acc[ai][bj][m][0] * w, v1 = acc[ai][bj][m][1] * w;
                        u32x4 o; o.x = pg8::cvt_pk_bf16(v0[0], v0[1]); o.y = pg8::cvt_pk_bf16(v0[2], v0[3]); o.z = pg8::cvt_pk_bf16(v1[0], v1[1]); o.w = pg8::cvt_pk_bf16(v1[2], v1[3]);
                        *(u32x4*)(YB + (size_t)a * D + col0 + bj * 128) = o; } } }
    }
};
__device__ __forceinline__ void p11_final(PRef p, int bid, int nb) {
    const int tid_ = otid(), lane = tid_ & 63, wv = tid_ >> 6;
    const float* mod = (const float*)(p.ws + W_MOD); const bf16* YB = (const bf16*)p.out; const bf16* X1 = (const bf16*)(p.ws + W_X1B); float* out = p.out; const float* g = p.in[I_FNG];
#pragma unroll 1
    for (int row = bid * 8 + wv; row < NTOK; row += nb * 8) {
        const float* gt = mod + (row / SEQ) * 6 * D + 5 * D;
        f32x4 v[4]; float s = 0.f;
#pragma unroll
        for (int j = 0; j < 4; ++j) { const int c0 = (lane + 64 * j) * 4;
            const u32x2 xw = *(const u32x2*)(X1 + (size_t)row * D + c0); const f32x4 xv = {bflo(xw.x), bfhi(xw.x), bflo(xw.y), bfhi(xw.y)}, gv = *(const f32x4*)(gt + c0);
            const u32x2 a = *(const u32x2*)(YB + (size_t)(2 * row) * D + c0), b = *(const u32x2*)(YB + (size_t)(2 * row + 1) * D + c0);
            const f32x4 y = {bflo(a.x) + bflo(b.x), bfhi(a.x) + bfhi(b.x), bflo(a.y) + bflo(b.y), bfhi(a.y) + bfhi(b.y)};
            v[j] = xv + gv * y; s += (v[j][0] * v[j][0] + v[j][1] * v[j][1]) + (v[j][2] * v[j][2] + v[j][3] * v[j][3]); }
        const float r = rsqrtf(wave_sum_dpp(s) * (1.0f / D) + 1e-6f);
#pragma unroll
        for (int j = 0; j < 4; ++j) { const int c0 = (lane + 64 * j) * 4; *(f32x4*)(out + (size_t)row * D + c0) = v[j] * r * *(const f32x4*)(g + c0); }
    }
}
constexpr int PM_PB = 144, PM_MAT = 64 * PM_PB;
enum { PM_AT = 0, PM_RT, PM_BT, PM_KT, PM_VT, PM_BPT, PM_KPT, PM_AAK, PM_ARB, PM_ARK, PM_W1T, PM_U2T, PM_NMAT };
constexpr int PM_AAB = PM_NMAT * PM_MAT, PM_P = PM_AAB + 16384, PM_TOT = PM_P + 16384, PM_G = PM_TOT + 2048, PM_END = PM_G + 256;
static_assert(PM_END <= LDS_BYTES, "pass-A LDS map");
struct PmRaw { float zr[9], zk[9], zv[9], lw[8], as[8]; };
__device__ __forceinline__ void p5m_load(PRef p, PmRaw& R, int q, int wave, int lane) {
    const int seq = q / NCH, c = q % NCH, b = seq >> 3, h = seq & 7, tg = b * SEQ + c * SCL + wave * 8, hc = h * 64 + lane;
    const bf16* Z = (const bf16*)(p.ws + W_Z); const bf16* LO = (const bf16*)(p.ws + W_LO);
    const bool has_prev = !(wave == 0 && c == 0);
    const bf16* zp0 = Z + (size_t)(tg - 1) * ZLD + 1024 + hc;
    R.zr[0] = has_prev ? bf2f(zp0[0]) : 0.f; R.zk[0] = has_prev ? bf2f(zp0[512]) : 0.f; R.zv[0] = has_prev ? bf2f(zp0[1024]) : 0.f;
#pragma unroll
    for (int s = 0; s < 8; ++s) { const bf16* zp = Z + (size_t)(tg + s) * ZLD + 1024 + hc; const bf16* lp = LO + (size_t)(tg + s) * 1536 + hc;
        R.zr[s + 1] = bf2f(zp[0]); R.zk[s + 1] = bf2f(zp[512]); R.zv[s + 1] = bf2f(zp[1024]); R.lw[s] = bf2f(lp[0]); R.as[s] = bf2f(lp[512]); }
}
#define PM_BAR() do { asm volatile("s_waitcnt lgkmcnt(0)" ::: "memory"); __builtin_amdgcn_s_barrier(); asm volatile("" ::: "memory"); } while (0)
__device__ __forceinline__ void p5m_chunk(PRef p, LAS unsigned char* lds, int q, int qnext, PmRaw& R) {
    typedef short bf16x8 __attribute__((ext_vector_type(8)));
    const int tid = otid(), lane = tid & 63, wave = __builtin_amdgcn_readfirstlane(tid >> 6), fr = lane & 15, fq = lane >> 4;
    const int seq = q / NCH, c = q % NCH, b = seq >> 3, h = seq & 7, tb = b * SEQ + c * SCL, hc = h * 64 + lane;
#define PMAT(i) (lds + (i) * PM_MAT)
#define PFRAG(mat, row, ks) (*(const LAS bf16x8*)((mat) + (row) * PM_PB + ((ks) * 32 + fq * 8) * 2))
#ifndef PM_DUP
#define PM_DUP 0
#endif
#pragma unroll 1
    for (int d0 = 0; d0 < ((PM_DUP >> 3) & 1) + 1; ++d0) { if (d0) PM_BAR();
        const int t8 = wave * 8, tg = tb + t8;
        float (&zr)[9] = R.zr; float (&zk)[9] = R.zk; float (&zv)[9] = R.zv; float (&lw)[8] = R.lw; float (&as)[8] = R.as;
        float cl[8]; { float run = 0.f;
#pragma unroll
          for (int s = 0; s < 8; ++s) { run += lw[s]; cl[s] = run; } }
        *(LAS float*)(lds + PM_TOT + (wave * 64 + lane) * 4) = cl[7];
        PM_BAR();
        float off = 0.f, lcL = 0.f;
#pragma unroll
        for (int w = 0; w < 8; ++w) { const float tv = *(const LAS float*)(lds + PM_TOT + (w * 64 + lane) * 4); lcL += tv; off += (w < wave) ? tv : 0.f; }
        if (wave == 0) *(LAS float*)(lds + PM_G + lane * 4) = __builtin_amdgcn_exp2f(1.4426950409f * lcL);
        const float mur = p.in[I_MU][hc], muk = p.in[I_MU][512 + hc], muv = p.in[I_MU][1024 + hc];
        const float kkc = p.in[I_KK][hc], kac = p.in[I_KA][hc], rkc = p.in[I_RK][hc];
        bf16* VLo = (bf16*)(p.ws + W_YCAT); float* RKo = (float*)(p.ws + T_RK);
        unsigned pv[4], pbp[4], pkp[4];
#pragma unroll
        for (int s = 0; s < 8; ++s) {
            const float r = zr[s + 1] + (zr[s] - zr[s + 1]) * mur, k = zk[s + 1] + (zk[s] - zk[s + 1]) * muk, v = zv[s + 1] + (zv[s] - zv[s + 1]) * muv;
            const float kkv = k * kkc;
            const float kk = kkv * rsqrtf(fmaxf(wave_sum_dpp(kkv * kkv), 1e-24f));
            const float k2 = k * (1.0f + (as[s] - 1.0f) * kac);
            const float rk = wave_sum_dpp(r * k2 * rkc);
            const float bb = kk * as[s];
            const float lc = off + cl[s], lcp = lc - lw[s];
            const float e_lc = __builtin_amdgcn_exp2f(1.4426950409f * lc), e_lcp = __builtin_amdgcn_exp2f(1.4426950409f * lcp);
            const float e_nlc = __builtin_amdgcn_exp2f(-1.4426950409f * lc), e_l = __builtin_amdgcn_exp2f(1.4426950409f * (lcL - lc));
            const int t = t8 + s;
            *(LAS bf16*)(PMAT(PM_AT) + t * PM_PB + lane * 2) = (bf16)f2bf(-kk * e_lcp);
            *(LAS bf16*)(PMAT(PM_RT) + t * PM_PB + lane * 2) = (bf16)f2bf(r * e_lc);
            *(LAS bf16*)(PMAT(PM_BT) + t * PM_PB + lane * 2) = (bf16)f2bf(bb * e_nlc);
            *(LAS bf16*)(PMAT(PM_KT) + t * PM_PB + lane * 2) = (bf16)f2bf(k2 * e_nlc);
            const unsigned vb = f2bf(v), bpb = f2bf(bb * e_l), kpb = f2bf(k2 * e_l);
            if (s & 1) { pv[s >> 1] |= vb << 16; pbp[s >> 1] |= bpb << 16; pkp[s >> 1] |= kpb << 16; } else { pv[s >> 1] = vb; pbp[s >> 1] = bpb; pkp[s >> 1] = kpb; }
            VLo[(unsigned)((tg + s) * 1024 + 512 + hc)] = (bf16)vb;
            if (lane == 0) RKo[(unsigned)((tg + s) * 8 + h)] = rk;
        }
        *(LAS u32x4*)(PMAT(PM_VT) + lane * PM_PB + wave * 16) = (u32x4){pv[0], pv[1], pv[2], pv[3]};
        *(LAS u32x4*)(PMAT(PM_BPT) + lane * PM_PB + wave * 16) = (u32x4){pbp[0], pbp[1], pbp[2], pbp[3]};
        *(LAS u32x4*)(PMAT(PM_KPT) + lane * PM_PB + wave * 16) = (u32x4){pkp[0], pkp[1], pkp[2], pkp[3]};
    }
    if (qnext >= 0) p5m_load(p, R, qnext, wave, lane);
    PM_BAR();
#pragma unroll 1
    for (int d1 = 0; d1 < ((PM_DUP >> 0) & 1) + 1; ++d1) {
        const int pp = wave >> 1, half = wave & 1;
        const LAS unsigned char* Xm = PMAT(pp < 2 ? PM_AT : PM_RT);
        const LAS unsigned char* Ym = PMAT((pp & 1) ? PM_KT : PM_BT);
#pragma unroll
        for (int ti = 0; ti < 2; ++ti) {
            const int tt = half ? (1 + ti) : (3 * ti);
            const bf16x8 xb0 = PFRAG(Xm, tt * 16 + fr, 0), xb1 = PFRAG(Xm, tt * 16 + fr, 1);
            const int t = tt * 16 + fr;
#pragma unroll
            for (int jt = 0; jt < 4; ++jt) {
                f32x4 acc = {0.f, 0.f, 0.f, 0.f};
                if (jt <= tt) { acc = __builtin_amdgcn_mfma_f32_16x16x32_bf16(PFRAG(Ym, jt * 16 + fr, 0), xb0, acc, 0, 0, 0);
                                acc = __builtin_amdgcn_mfma_f32_16x16x32_bf16(PFRAG(Ym, jt * 16 + fr, 1), xb1, acc, 0, 0, 0); }
                const int j0 = jt * 16 + 4 * fq;
#pragma unroll
                for (int rg = 0; rg < 4; ++rg) { const bool keep = (pp < 2) ? (j0 + rg < t) : (j0 + rg <= t); acc[rg] = keep ? acc[rg] : 0.f; }
                if (pp == 0) {
#pragma unroll
                    for (int rg = 0; rg < 4; ++rg) *(LAS float*)(lds + PM_AAB + (t * 64 + rg * 16 + jt * 4 + fq) * 4) = acc[rg];
                } else {
                    u32x2 w; w.x = pk2(acc[0], acc[1]); w.y = pk2(acc[2], acc[3]);
                    *(LAS u32x2*)(PMAT(PM_AAK + pp - 1) + t * PM_PB + j0 * 2) = w;
                }
            }
        }
    }
    PM_BAR();
#pragma unroll 1
    for (int d2 = 0; d2 < ((PM_DUP >> 1) & 1) + 1; ++d2) {
        const bool isw1 = wave < 4;
        const int colb = (wave & 3) * 16, cl = lane >> 2, part = lane & 3, col = colb + cl;
        if (!isw1) {
            const bf16x8 vb0 = PFRAG(PMAT(PM_VT), colb + fr, 0), vb1 = PFRAG(PMAT(PM_VT), colb + fr, 1);
#pragma unroll
            for (int tt = 0; tt < 4; ++tt) { f32x4 acc = {0.f, 0.f, 0.f, 0.f};
                acc = __builtin_amdgcn_mfma_f32_16x16x32_bf16(PFRAG(PMAT(PM_AAK), tt * 16 + fr, 0), vb0, acc, 0, 0, 0);
                acc = __builtin_amdgcn_mfma_f32_16x16x32_bf16(PFRAG(PMAT(PM_AAK), tt * 16 + fr, 1), vb1, acc, 0, 0, 0);
#pragma unroll
                for (int rg = 0; rg < 4; ++rg) *(LAS float*)(lds + PM_P + ((tt * 16 + 4 * fq + rg) * 64 + colb + fr) * 4) = acc[rg]; }
            asm volatile("s_waitcnt lgkmcnt(0)" ::: "memory");
        }
        float X[16];
#pragma unroll
        for (int jj = 0; jj < 16; ++jj) X[jj] = 0.f;
        const LAS unsigned char* arow = lds + PM_AAB + part * 64;
#define PM_LOADBLK(g, rh, a4, cf) do { \
            _Pragma("unroll") for (int r = 0; r < 4; ++r) { const int t = 4 * (g) + r; \
                rh[r] = isw1 ? bf2f(*(const LAS bf16*)(PMAT(PM_AT) + t * PM_PB + col * 2)) : *(const LAS float*)(lds + PM_P + (t * 64 + col) * 4); \
                _Pragma("unroll") for (int m = 0; m < 4; ++m) if (m * 4 < (g)) a4[r][m] = *(const LAS f32x4*)(arow + t * 256 + m * 16); } \
            { const LAS unsigned char* cb = lds + PM_AAB + (g) * 4; \
              cf[0] = *(const LAS float*)(cb + (4 * (g) + 1) * 256); cf[1] = *(const LAS float*)(cb + (4 * (g) + 2) * 256); cf[2] = *(const LAS float*)(cb + (4 * (g) + 2) * 256 + 64); \
              cf[3] = *(const LAS float*)(cb + (4 * (g) + 3) * 256); cf[4] = *(const LAS float*)(cb + (4 * (g) + 3) * 256 + 64); cf[5] = *(const LAS float*)(cb + (4 * (g) + 3) * 256 + 128); } } while (0)
#define PM_SOLVEBLK(g, rh, a4, cf) do { float sm[4]; \
            _Pragma("unroll") for (int r = 0; r < 4; ++r) { float s0 = 0.f, s1 = 0.f; \
                _Pragma("unroll") for (int m = 0; m < 4; ++m) if (m * 4 < (g)) { \
                    _Pragma("unroll") for (int i = 0; i < 4; ++i) if (m * 4 + i < (g)) { if (i & 1) s1 = fmaf(a4[r][m][i], X[m * 4 + i], s1); else s0 = fmaf(a4[r][m][i], X[m * 4 + i], s0); } } \
                sm[r] = s0 + s1; } \
            _Pragma("unroll") for (int r = 0; r < 4; ++r) { DPP_ADD(sm[r], 0xB1); DPP_ADD(sm[r], 0x4E); } \
            const float x0 = rh[0] + sm[0]; \
            const float x1 = fmaf(cf[0], x0, rh[1] + sm[1]); \
            const float x2 = fmaf(cf[2], x1, fmaf(cf[1], x0, rh[2] + sm[2])); \
            const float x3 = fmaf(cf[5], x2, fmaf(cf[4], x1, fmaf(cf[3], x0, rh[3] + sm[3]))); \
            X[g] = part == 0 ? x0 : part == 1 ? x1 : part == 2 ? x2 : x3; } while (0)
        { float rhA[4], cfA[6], rhB[4], cfB[6]; f32x4 aA[4][4], aB[4][4];
          PM_LOADBLK(0, rhA, aA, cfA);
#pragma unroll
          for (int g2 = 0; g2 < 16; g2 += 2) {
              PM_LOADBLK(g2 + 1, rhB, aB, cfB); __builtin_amdgcn_sched_barrier(0);
              PM_SOLVEBLK(g2, rhA, aA, cfA);
              if (g2 + 2 < 16) { PM_LOADBLK(g2 + 2, rhA, aA, cfA); } __builtin_amdgcn_sched_barrier(0);
              PM_SOLVEBLK(g2 + 1, rhB, aB, cfB);
          } }
#undef PM_LOADBLK
#undef PM_SOLVEBLK
        LAS unsigned char* om = PMAT(isw1 ? PM_W1T : PM_U2T) + col * PM_PB + part * 2;
#pragma unroll
        for (int jj = 0; jj < 16; ++jj) *(LAS bf16*)(om + jj * 8) = (bf16)f2bf(X[jj]);
    }
    PM_BAR();
#pragma unroll 1
    for (int d3 = 0; d3 < ((PM_DUP >> 2) & 1) + 1; ++d3) {
        float* Mo = (float*)((unsigned char*)p.out + O_M + (size_t)q * 16384); float* No = (float*)((unsigned char*)p.out + O_N + (size_t)q * 16384);
        bf16* Qo = (bf16*)(p.ws + W_Q); bf16* Y2o = (bf16*)(p.ws + W_Y2);
#pragma unroll
        for (int ti = 0; ti < 2; ++ti) {
            const int idx = wave * 2 + ti, rt = idx >> 2, ct = idx & 3;
            {
                f32x4 acc = {0.f, 0.f, 0.f, 0.f};
#pragma unroll
                for (int ks = 0; ks < 2; ++ks) acc = __builtin_amdgcn_mfma_f32_16x16x32_bf16(PFRAG(PMAT(PM_BPT), ct * 16 + fr, ks), PFRAG(PMAT(PM_W1T), rt * 16 + fr, ks), acc, 0, 0, 0);
                const int i = rt * 16 + fr, c0 = ct * 16 + 4 * fq;
#pragma unroll
                for (int rg = 0; rg < 4; ++rg) if (c0 + rg == i) acc[rg] += *(const LAS float*)(lds + PM_G + i * 4);
                *(f32x4*)(Mo + i * 64 + c0) = acc; }
            {
                f32x4 acc = {0.f, 0.f, 0.f, 0.f};
#pragma unroll
                for (int ks = 0; ks < 2; ++ks) { acc = __builtin_amdgcn_mfma_f32_16x16x32_bf16(PFRAG(PMAT(PM_BPT), ct * 16 + fr, ks), PFRAG(PMAT(PM_U2T), rt * 16 + fr, ks), acc, 0, 0, 0);
                                                  acc = __builtin_amdgcn_mfma_f32_16x16x32_bf16(PFRAG(PMAT(PM_KPT), ct * 16 + fr, ks), PFRAG(PMAT(PM_VT), rt * 16 + fr, ks), acc, 0, 0, 0); }
                *(f32x4*)(No + (rt * 16 + fr) * 64 + ct * 16 + 4 * fq) = acc; }
            {
                f32x4 acc = {0.f, 0.f, 0.f, 0.f};
#pragma unroll
                for (int ks = 0; ks < 2; ++ks) acc = __builtin_amdgcn_mfma_f32_16x16x32_bf16(PFRAG(PMAT(PM_W1T), ct * 16 + fr, ks), PFRAG(PMAT(PM_ARB), rt * 16 + fr, ks), acc, 0, 0, 0);
                const int t = rt * 16 + fr, i0 = ct * 16 + 4 * fq;
                const u32x2 rw = *(const LAS u32x2*)(PMAT(PM_RT) + t * PM_PB + i0 * 2);
                u32x2 o; o.x = pk2(acc[0] + bflo(rw.x), acc[1] + bfhi(rw.x)); o.y = pk2(acc[2] + bflo(rw.y), acc[3] + bfhi(rw.y));
                *(u32x2*)(Qo + (unsigned)((tb + t) * 512 + h * 64 + i0)) = o; }
            {
                f32x4 acc = {0.f, 0.f, 0.f, 0.f};
#pragma unroll
                for (int ks = 0; ks < 2; ++ks) { acc = __builtin_amdgcn_mfma_f32_16x16x32_bf16(PFRAG(PMAT(PM_U2T), ct * 16 + fr, ks), PFRAG(PMAT(PM_ARB), rt * 16 + fr, ks), acc, 0, 0, 0);
                                                  acc = __builtin_amdgcn_mfma_f32_16x16x32_bf16(PFRAG(PMAT(PM_VT), ct * 16 + fr, ks), PFRAG(PMAT(PM_ARK), rt * 16 + fr, ks), acc, 0, 0, 0); }
                const int t = rt * 16 + fr, v0 = ct * 16 + 4 * fq;
                u32x2 o; o.x = pk2(acc[0], acc[1]); o.y = pk2(acc[2], acc[3]);
                *(u32x2*)(Y2o + (unsigned)((tb + t) * 512 + h * 64 + v0)) = o; }
        }
    }
    PM_BAR();
#undef PMAT
#undef PFRAG
}

__device__ __forceinline__ void p5m_run(PRef p, LAS unsigned char* lds, int bid, int nb) {
    const int tid = otid(), lane = tid & 63, wave = __builtin_amdgcn_readfirstlane(tid >> 6);
    PmRaw R;
    if (bid < BATCH * 8 * NCH) p5m_load(p, R, bid, wave, lane);
#pragma unroll 1
    for (int q = bid; q < BATCH * 8 * NCH; q += nb) p5m_chunk(p, lds, q, (q + nb < BATCH * 8 * NCH) ? q + nb : -1, R);
}
constexpr int R7_WP = 1040, R7_WSZ = 48 * R7_WP, R7_AP = 144, R7_ASZ = 16 * R7_AP;
constexpr int R7_WAVE0 = 2 * R7_WSZ, R7_WAVESZ = 2 * R7_ASZ + 3072, R7_HIST = R7_WAVE0 + 8 * R7_WAVESZ;
static_assert(R7_HIST + 256 <= LDS_BYTES, "router LDS map");
__device__ __forceinline__ void p7m_route(PRef p, LAS unsigned char* lds, int bid) {
    typedef short bf16x8 __attribute__((ext_vector_type(8)));
    const int tid = otid(), lane = tid & 63, wave = __builtin_amdgcn_readfirstlane(tid >> 6), fr = lane & 15, fq = lane >> 4;
    const int tok = lane >> 2, sub = lane & 3;
    const bf16* x1 = (const bf16*)(p.ws + W_X1B); bf16* H2 = (bf16*)(p.ws + W_H2);
    LAS int* hist = (LAS int*)(lds + R7_HIST);
    const int b = (bid * TPW) / SEQ, t0 = bid * TPW + wave * 16;
    const float* mod = (const float*)(p.ws + W_MOD) + b * 6 * D;
    const float* n2g = p.in[I_N2G];
    LAS unsigned char* Ahi = lds + R7_WAVE0 + wave * R7_WAVESZ; LAS unsigned char* Alo = Ahi + R7_ASZ; LAS float* Lw = (LAS float*)(Alo + R7_ASZ);
    if (tid < 32) hist[tid] = 0;
    const bf16* xrow = x1 + (size_t)(t0 + tok) * D + sub * 16;
    float ss = 0.f;
#pragma unroll 1
    for (int s4 = 0; s4 < 16; s4 += 8) { u32x4 v[16];
#pragma unroll
        for (int s = 0; s < 8; ++s) { v[s * 2] = *(const u32x4*)(xrow + (s4 + s) * 64); v[s * 2 + 1] = *(const u32x4*)(xrow + (s4 + s) * 64 + 8); }
#pragma unroll
        for (int i = 0; i < 16; ++i)
#pragma unroll
            for (int q = 0; q < 4; ++q) { const float a = bflo(v[i][q]), bq = bfhi(v[i][q]); ss = fmaf(a, a, fmaf(bq, bq, ss)); } }
    DPP_ADD(ss, 0xB1); DPP_ADD(ss, 0x4E);
    const float r = rsqrtf(ss * (1.0f / D) + 1e-6f);
    f32x4 acc[3];
#pragma unroll
    for (int qt = 0; qt < 3; ++qt) acc[qt] = (f32x4){0.f, 0.f, 0.f, 0.f};
#pragma unroll 1
    for (int kh = 0; kh < 2; ++kh) {
        __syncthreads();
#pragma unroll 1
        for (int idx = tid; idx < 512 * 12; idx += NTHR) { const int cq = idx % 12, kl = idx / 12, k = kh * 512 + kl;
            f32x4 w = {0.f, 0.f, 0.f, 0.f};
            if (cq == 0) w = *(const f32x4*)(p.in[I_RGW] + k * 4); else if (cq < 9) w = *(const f32x4*)(p.in[I_REW] + k * 32 + (cq - 1) * 4);
#pragma unroll
            for (int i = 0; i < 4; ++i) { const unsigned hi = f2bf(w[i]); const unsigned lo = f2bf(w[i] - bflo(hi));
                *(LAS bf16*)(lds + (cq * 4 + i) * R7_WP + kl * 2) = (bf16)hi; *(LAS bf16*)(lds + R7_WSZ + (cq * 4 + i) * R7_WP + kl * 2) = (bf16)lo; } }
        __syncthreads();
#pragma unroll 1
        for (int sl = 0; sl < 8; ++sl) {
            const int k0 = kh * 512 + sl * 64 + sub * 16;
            f32x4 xv[4], gv[4], cv[4], sv[4];
            { const u32x4 xa = *(const u32x4*)(x1 + (size_t)(t0 + tok) * D + k0), xb = *(const u32x4*)(x1 + (size_t)(t0 + tok) * D + k0 + 8);
              xv[0] = (f32x4){bflo(xa.x), bfhi(xa.x), bflo(xa.y), bfhi(xa.y)}; xv[1] = (f32x4){bflo(xa.z), bfhi(xa.z), bflo(xa.w), bfhi(xa.w)};
              xv[2] = (f32x4){bflo(xb.x), bfhi(xb.x), bflo(xb.y), bfhi(xb.y)}; xv[3] = (f32x4){bflo(xb.z), bfhi(xb.z), bflo(xb.w), bfhi(xb.w)}; }
#pragma unroll
            for (int i = 0; i < 4; ++i) { gv[i] = *(const f32x4*)(n2g + k0 + i * 4); cv[i] = *(const f32x4*)(mod + 4 * D + k0 + i * 4); sv[i] = *(const f32x4*)(mod + 3 * D + k0 + i * 4); }
            unsigned hi[8], lo[8];
#pragma unroll
            for (int i = 0; i < 4; ++i)
#pragma unroll
                for (int j = 0; j < 4; j += 2) { const float h0 = xv[i][j] * r * gv[i][j] * (1.0f + cv[i][j]) + sv[i][j], h1 = xv[i][j + 1] * r * gv[i][j + 1] * (1.0f + cv[i][j + 1]) + sv[i][j + 1];
                    const unsigned a0 = f2bf(h0), a1 = f2bf(h1); hi[i * 2 + (j >> 1)] = a0 | (a1 << 16); lo[i * 2 + (j >> 1)] = f2bf(h0 - bflo(a0)) | (f2bf(h1 - bflo(a1)) << 16); }
            *(u32x4*)(H2 + (size_t)(t0 + tok) * D + k0) = (u32x4){hi[0], hi[1], hi[2], hi[3]}; *(u32x4*)(H2 + (size_t)(t0 + tok) * D + k0 + 8) = (u32x4){hi[4], hi[5], hi[6], hi[7]};
            *(LAS u32x4*)(Ahi + tok * R7_AP + sub * 32) = (u32x4){hi[0], hi[1], hi[2], hi[3]}; *(LAS u32x4*)(Ahi + tok * R7_AP + sub * 32 + 16) = (u32x4){hi[4], hi[5], hi[6], hi[7]};
            *(LAS u32x4*)(Alo + tok * R7_AP + sub * 32) = (u32x4){lo[0], lo[1], lo[2], lo[3]}; *(LAS u32x4*)(Alo + tok * R7_AP + sub * 32 + 16) = (u32x4){lo[4], lo[5], lo[6], lo[7]};
            asm volatile("s_waitcnt lgkmcnt(0)" ::: "memory");
#pragma unroll
            for (int ks = 0; ks < 2; ++ks) {
                const bf16x8 ah = *(const LAS bf16x8*)(Ahi + fr * R7_AP + (ks * 32 + fq * 8) * 2), al = *(const LAS bf16x8*)(Alo + fr * R7_AP + (ks * 32 + fq * 8) * 2);
#pragma unroll
                for (int qt = 0; qt < 3; ++qt) { const int wo = (qt * 16 + fr) * R7_WP + (sl * 64 + ks * 32 + fq * 8) * 2;
                    const bf16x8 bh = *(const LAS bf16x8*)(lds + wo), bl = *(const LAS bf16x8*)(lds + R7_WSZ + wo);
                    acc[qt] = __builtin_amdgcn_mfma_f32_16x16x32_bf16(ah, bh, acc[qt], 0, 0, 0);
                    acc[qt] = __builtin_amdgcn_mfma_f32_16x16x32_bf16(al, bh, acc[qt], 0, 0, 0);
                    acc[qt] = __builtin_amdgcn_mfma_f32_16x16x32_bf16(ah, bl, acc[qt], 0, 0, 0); } }
            asm volatile("s_waitcnt lgkmcnt(0)" ::: "memory");
        }
    }
#pragma unroll
    for (int qt = 0; qt < 3; ++qt)
#pragma unroll
        for (int rg = 0; rg < 4; ++rg) Lw[(4 * fq + rg) * 48 + qt * 16 + fr] = acc[qt][rg];
    asm volatile("s_waitcnt lgkmcnt(0)" ::: "memory");
    if (lane < 16) {
        const LAS float* lg = Lw + lane * 48;
        int gi = 0; float gm = lg[0] + p.in[I_RGB][0];
#pragma unroll
        for (int q = 1; q < 4; ++q) { const float v = lg[q] + p.in[I_RGB][q]; if (v > gm) { gm = v; gi = q; } }
        float gsum = 0.f;
#pragma unroll
        for (int q = 0; q < 4; ++q) gsum += expf(lg[q] + p.in[I_RGB][q] - gm);
        const float gp = 1.0f / gsum;
        const LAS float* el = lg + 4 + gi * 8; const float* eb = p.in[I_REB] + gi * 8;
        int i0 = 0; float m0 = el[0] + eb[0];
#pragma unroll
        for (int q = 1; q < 8; ++q) { const float v = el[q] + eb[q]; if (v > m0) { m0 = v; i0 = q; } }
        int i1 = -1; float m1 = -3.0e38f;
#pragma unroll
        for (int q = 0; q < 8; ++q) { const float v = el[q] + eb[q]; if (q != i0 && v > m1) { m1 = v; i1 = q; } }
        const float p1 = expf(m1 - m0);
        const float w0 = gp / (1.0f + p1), w1 = gp * p1 / (1.0f + p1);
        const int t = t0 + lane, e0 = gi * 8 + i0, e1 = gi * 8 + i1;
        int* toke = (int*)(p.ws + T_TOKE); float* tokw = (float*)(p.ws + T_TOKW);
        toke[t * 2] = e0; toke[t * 2 + 1] = e1; tokw[t * 2] = w0; tokw[t * 2 + 1] = w1;
        __hip_atomic_fetch_add(&hist[e0], 1, __ATOMIC_RELAXED, __HIP_MEMORY_SCOPE_WORKGROUP); __hip_atomic_fetch_add(&hist[e1], 1, __ATOMIC_RELAXED, __HIP_MEMORY_SCOPE_WORKGROUP);
    }
    __syncthreads();
    if (tid < 32) ((int*)(p.ws + T_HIST))[bid * 32 + tid] = hist[tid];
    __syncthreads();
}
__global__ void __launch_bounds__(NTHR, 2) k_mega(Params p_unused) {
    extern __shared__ __attribute__((aligned(16))) unsigned char lds_raw[];
    PPtr kp = (PPtr)__builtin_amdgcn_kernarg_segment_ptr();
#define p (*opq(kp))
    cg::grid_group grid = cg::this_grid();
    const int bid = blockIdx.x, nb = gridDim.x;
    LAS unsigned char* lds = (LAS unsigned char*)lds_raw;
    volatile LAS unsigned* bst = (volatile LAS unsigned*)(lds + LDS_BYTES - 64);
    if (otid() < 2) bst[otid()] = 0u;
    __syncthreads();
    XcdBarrier xb = xcd_barrier_post((unsigned*)(p.ws + T_BAR), bst);
#define GSYNC() xcd_barrier(xb)
    p0_prep<true>(p, lds, bid, nb); grid.sync();
    p1_h1(p, bid, nb); if (bid < BATCH) p1_bq(p, (LAS float*)lds, bid); GSYNC();
    { pg8::Gemm g{(const pg8::bf16_t*)(p.ws + W_H1), (const pg8::bf16_t*)(p.ws + W_WINT), NTOK, ZLD, D}; pg8::StaticOrder S; S.init(NTOK, ZLD, nb, bid);
      EpiZ E{(bf16*)(p.ws + W_Z)};
      pg8::gemm_phase<EpiZ, pg8::StaticOrder, true, true>(lds, g, S, E); }
    GSYNC();
#pragma unroll 1
    for (int ch = bid; ch < NTOK / CHUNK; ch += nb) p3_gmlp_unit(p, lds, ch);
    p3_lorain(p, bid, nb);
    GSYNC();
    { int kop = 256; asm volatile("" : "+s"(kop));
      pg8::Gemm g{(const pg8::bf16_t*)(p.ws + W_A2), (const pg8::bf16_t*)(p.ws + W_LORAT), NTOK, 1536, kop}; pg8::StaticOrder S; S.init(NTOK, 1536, nb, bid);
      EpiLO E{(bf16*)(p.ws + W_LO), p.in[I_W0], p.in[I_A0]};
      pg8::gemm_phase<EpiLO, pg8::StaticOrder, true, true>(lds, g, S, E); }
    GSYNC();
    p5m_run(p, lds, bid, nb);
    GSYNC();
#pragma unroll 1
    for (int it = bid; it < BATCH * 8 * 4; it += nb) p5b_chain(p, lds, it);
    GSYNC();
#pragma unroll 1
    for (int q = bid * 8 + __builtin_amdgcn_readfirstlane(otid() >> 6); q < BATCH * 8 * NCH; q += nb * 8) p5c_chunk(p, q);
    GSYNC();
    { pg8::Gemm g{(const pg8::bf16_t*)(p.ws + W_YCAT), (const pg8::bf16_t*)(p.ws + W_WOUTT), NTOK, D, D}; pg8::StaticOrder S; S.init(NTOK, D, nb, bid);
      EpiX1 E{p.in[I_X], (const float*)(p.ws + W_MOD), (bf16*)(p.ws + W_X1B)};
      pg8::gemm_phase<EpiX1, pg8::StaticOrder, true, true>(lds, g, S, E); }
    GSYNC();
    p7m_route(p, lds, bid); GSYNC();
    p8_place(p, lds, bid); GSYNC();
    { const int nM = *(const int*)(p.ws + T_NT);
      pg8::Gemm g{(const pg8::bf16_t*)(p.ws + W_H2), (const pg8::bf16_t*)(p.ws + W_WGUT), PROWS, 1024, D}; MoeOrder<true> S{(const int*)(p.ws + T_TILEE), (const int*)(p.ws + T_ROWAID), nM, nb, bid};
      EpiH E{(bf16*)(p.ws + W_HB)};
      pg8::gemm_phase<EpiH, MoeOrder<true>, true, true>(lds, g, S, E); }
    GSYNC();
    { const int nM = *(const int*)(p.ws + T_NT);
      pg8::Gemm g{(const pg8::bf16_t*)(p.ws + W_HB), (const pg8::bf16_t*)(p.ws + W_WDT), PROWS, 1024, EH}; MoeOrder<false> S{(const int*)(p.ws + T_TILEE), (const int*)(p.ws + T_ROWAID), nM, nb, bid};
      EpiY E{(bf16*)p.out, (const int*)(p.ws + T_ROWAID), (const float*)(p.ws + T_ROWW)};
      pg8::gemm_phase<EpiY, MoeOrder<false>, true, true>(lds, g, S, E); }
    GSYNC();
    p11_final(p, bid, nb);
#undef GSYNC
#undef p
}
extern "C" void kernel_launch(void* const* d_in, const int* in_sizes, int n_in, void* d_out, int out_size, void* d_ws, size_t ws_size, hipStream_t stream) {
    if (n_in != 31 || ws_size < WS_NEED || out_size != NTOK * D) { fprintf(stderr, "kernel_launch: unexpected sizes n_in %d ws %zu out %d\n", n_in, ws_size, out_size); return; }
    static int grid_blocks = 0;
    if (!grid_blocks) {
        int dev = 0, cus = 0, per_cu = 0;
        (void)hipGetDevice(&dev);
        (void)hipDeviceGetAttribute(&cus, hipDeviceAttributeMultiprocessorCount, dev);
        (void)hipFuncSetAttribute((const void*)k_mega, hipFuncAttributeMaxDynamicSharedMemorySize, LDS_BYTES);
        (void)hipOccupancyMaxActiveBlocksPerMultiprocessor(&per_cu, (const void*)k_mega, NTHR, LDS_BYTES);
        if (per_cu < 1) fprintf(stderr, "kernel_launch: occupancy query says %d blocks/CU\n", per_cu);
        grid_blocks = cus;
    }
    Params p{};
    for (int i = 0; i < 31; ++i) p.in[i] = (const float*)d_in[i];
    p.out = (float*)d_out; p.ws = (unsigned char*)d_ws;
    (void)hipMemsetAsync((char*)d_ws + T_BAR, 0, 16384, stream);
    void* args[] = {&p};
    hipError_t e = hipLaunchCooperativeKernel((void*)k_mega, dim3(grid_blocks), dim3(NTHR), args, LDS_BYTES, stream);
    if (e != hipSuccess) fprintf(stderr, "cooperative launch failed: %s (grid %d)\n", hipGetErrorString(e), grid_blocks);
}
```

```cpp
#include <hip/hip_runtime.h>
#include <hip/hip_cooperative_groups.h>
#include <cstdio>
#include <cstdint>
namespace cg = cooperative_groups;
__device__ __forceinline__ int otid() { int t = threadIdx.x; asm volatile("" : "+v"(t)); return t; }

namespace pg8 {
#define PG8_LAS __attribute__((address_space(3)))
typedef unsigned short bf16_t;
typedef short bf16x8 __attribute__((ext_vector_type(8)));
typedef float f32x4 __attribute__((ext_vector_type(4)));
typedef unsigned u32x4 __attribute__((ext_vector_type(4)));
constexpr int BM = 256, BK = 64, HALF = 128, HTB = HALF * BK * 2  , STAGE_BYTES = 8 * HTB, NXCD = 8, WGM = 8;

__host__ __device__ __forceinline__ int lds_byte(int r, int c) { const int st = (r >> 4) * 2 + (c >> 5), rr = r & 15, cc = c & 31, ob = rr * 64 + cc * 2; return st * 1024 + (ob ^ (((ob >> 9) & 1) << 5)); }
__host__ __device__ __forceinline__ void stage_rc(int b, int& R, int& C) { const int st = b / 1024, sb = b % 1024, swz = sb ^ (((sb >> 9) & 1) << 5); R = (st >> 1) * 16 + swz / 64; C = (st & 1) * 32 + (swz % 64) / 2; }
__host__ __device__ __forceinline__ int perm32(int rho) { const int n = rho >> 4, i = rho & 15; return 8 * (i >> 2) + 4 * n + (i & 3); }

struct Unit { int pm, pn, pb; };
struct Gemm { const bf16_t* A; const bf16_t* Bt; int M, N, K; };

struct StaticOrder {
    static constexpr bool GATHER = false;
    int nM, nN, nwg, G, c;
    __device__ __forceinline__ int rowsrc(int) const { return 0; }
    __host__ __device__ void init(int M, int N, int G_, int c_) { nM = M / BM; nN = N / BM; nwg = nM * nN; G = G_; c = c_; }
    __host__ __device__ bool next(int i, Unit& u) const {
        const long L = (long)i * G + c; if (L >= nwg) return false;
        int wgid = (int)L; { const int q = nwg / NXCD, r = nwg % NXCD, xcd = wgid % NXCD, off = wgid / NXCD; wgid = (xcd < r ? xcd * (q + 1) : r * (q + 1) + (xcd - r) * q) + off; }
        const int nig = WGM * nN, gid = wgid / nig, fm = gid * WGM, gsz = (nM - fm) < WGM ? (nM - fm) : WGM;
        u.pm = fm + ((wgid % nig) % gsz); u.pn = (wgid % nig) / gsz; u.pb = u.pn; return true;
    }
    __device__ __forceinline__ void a_ready(const Unit&) const {}
    __device__ __forceinline__ void done(const Unit&) const {}
};

__device__ __forceinline__ unsigned cvt_pk_bf16(float lo, float hi) { unsigned r; asm volatile("v_cvt_pk_bf16_f32 %0, %1, %2" : "=v"(r) : "v"(lo), "v"(hi)); return r; }
typedef float f32x2 __attribute__((ext_vector_type(2)));
template <class Epi, class Sched, bool ALIGN_EPI = false, bool SP2 = false>
__device__ __forceinline__ void gemm_phase(PG8_LAS unsigned char* lds, const Gemm g, const Sched& S, const Epi& E) {
    const int tid = otid(), wid = __builtin_amdgcn_readfirstlane(tid >> 6), lane = tid & 63, wr = wid >> 2, wc = wid & 3, fr = lane & 15, fq = lane >> 4;
    const int K = g.K, nt = K / BK;
    unsigned voffA[2], voffB[2];
#pragma unroll
    for (int i = 0; i < 2; ++i) { int R, C; stage_rc(tid * 16 + i * 8192, R, C); const int Rb = Epi::PERM ? ((R & ~31) + perm32(R & 31)) : R;
        voffA[i] = (unsigned)(R * K + C) * 2u; voffB[i] = (unsigned)(Rb * K + C) * 2u; }
    const size_t kstep = (size_t)(BK * 2);
    const size_t hstep = (size_t)HALF * K * 2;
    const size_t tstep = 2 * hstep;
    unsigned vA0[2], vA1[2], nA0[2], nA1[2];
    PG8_LAS int* rtab = (PG8_LAS int*)(lds + STAGE_BYTES);
    auto fillA = [&](int ui_, unsigned (&o0)[2], unsigned (&o1)[2]) {
#pragma unroll
        for (int i = 0; i < 2; ++i) {
            if constexpr (Sched::GATHER) { int R, C; stage_rc(tid * 16 + i * 8192, R, C);
                o0[i] = (unsigned)(rtab[ui_ * 256 + R] * K + C) * 2u; o1[i] = (unsigned)(rtab[ui_ * 256 + 128 + R] * K + C) * 2u; }
            else { o0[i] = voffA[i]; o1[i] = voffA[i] + (unsigned)hstep; } } };
    const unsigned ldsw = (unsigned)wid * 1024u;
    const int aoff = lds_byte(wr * 64 + fr, fq * 8), boff = lds_byte(wc * 32 + fr, fq * 8);
#define PG8_SA(b, h) (((b) * 2 + (h)) * HTB)
#define PG8_SB(b, h) ((4 + (b) * 2 + (h)) * HTB)
#define PG8_STAGE(bufoff, gbase, voff) do { _Pragma("unroll") for (int _i = 0; _i < 2; ++_i) \
        __builtin_amdgcn_global_load_lds((const unsigned*)((const char*)(gbase) + (voff)[_i]), (PG8_LAS unsigned*)(lds + (bufoff) + ldsw + _i * 8192), 16, 0, 0); } while (0)
#define PG8_LDA(dst, b, h) do { _Pragma("unroll") for (int m = 0; m < 4; ++m) _Pragma("unroll") for (int k = 0; k < 2; ++k) dst[m][k] = *(const PG8_LAS bf16x8*)(lds + PG8_SA(b, h) + aoff + m * 2048 + k * 1024); } while (0)
#define PG8_LDB(dst, b, h) do { _Pragma("unroll") for (int n = 0; n < 2; ++n) _Pragma("unroll") for (int k = 0; k < 2; ++k) dst[n][k] = *(const PG8_LAS bf16x8*)(lds + PG8_SB(b, h) + boff + n * 2048 + k * 1024); } while (0)
#define PG8_MMA(ai, bj, At, Bt) do { __builtin_amdgcn_s_setprio(1); _Pragma("unroll") for (int m = 0; m < 4; ++m) _Pragma("unroll") for (int n = 0; n < 2; ++n) _Pragma("unroll") for (int k = 0; k < 2; ++k) \
        acc[ai][bj][m][n] = __builtin_amdgcn_mfma_f32_16x16x32_bf16(Bt[n][k], At[m][k], acc[ai][bj][m][n], 0, 0, 0); __builtin_amdgcn_s_setprio(0); } while (0)
#define PG8_WAIT_V(n) asm volatile("s_waitcnt vmcnt(" #n ")" ::: "memory")
#define PG8_WAIT_L(n) asm volatile("s_waitcnt lgkmcnt(" #n ")" ::: "memory")
#define PG8_BAR __builtin_amdgcn_s_barrier()
#define PG8_SCHED __builtin_amdgcn_sched_barrier(0)
    Unit cur, nxt; int ui = 0;
    if (!S.next(0, cur)) return;
    f32x4 acc[2][2][4][2];
#pragma unroll
    for (int a = 0; a < 2; ++a)
#pragma unroll
        for (int b = 0; b < 2; ++b)
#pragma unroll
            for (int m = 0; m < 4; ++m)
#pragma unroll
                for (int n = 0; n < 2; ++n) acc[a][b][m][n] = (f32x4){0.f, 0.f, 0.f, 0.f};
    bf16x8 At[4][2], B0[2][2], B1[2][2];
    if constexpr (Sched::GATHER) {
        for (int ui_ = 0; ; ++ui_) { Unit u_; if (!S.next(ui_, u_)) break; if (tid < 256) rtab[ui_ * 256 + tid] = S.rowsrc(u_.pm * 256 + tid); }
        __syncthreads();
    }
    fillA(0, vA0, vA1);
    const char* cA = Sched::GATHER ? (const char*)g.A : (const char*)g.A + (size_t)cur.pm * tstep; const char* cB = (const char*)g.Bt + (size_t)cur.pb * tstep;
    S.a_ready(cur);
    if constexpr (SP2) {
        PG8_STAGE(PG8_SB(0, 0), cB, voffB); PG8_STAGE(PG8_SB(0, 1), cB + hstep, voffB); PG8_STAGE(PG8_SA(0, 0), cA, vA0); PG8_STAGE(PG8_SA(0, 1), cA, vA1);
        if (wr == 1) PG8_BAR;
        PG8_WAIT_V(2); PG8_BAR;
        PG8_STAGE(PG8_SB(1, 0), cB + kstep, voffB); PG8_STAGE(PG8_SA(1, 0), cA + kstep, vA0); PG8_STAGE(PG8_SB(1, 1), cB + hstep + kstep, voffB);
        PG8_WAIT_V(6); PG8_BAR;
    } else {
        PG8_STAGE(PG8_SB(0, 0), cB, voffB); PG8_STAGE(PG8_SA(0, 0), cA, vA0); PG8_STAGE(PG8_SB(0, 1), cB + hstep, voffB); PG8_STAGE(PG8_SA(0, 1), cA, vA1);
        if (wr == 1) PG8_BAR;
        PG8_WAIT_V(4); PG8_BAR;
        PG8_STAGE(PG8_SB(1, 0), cB + kstep, voffB); PG8_STAGE(PG8_SA(1, 0), cA + kstep, vA0); PG8_STAGE(PG8_SB(1, 1), cB + hstep + kstep, voffB);
        PG8_WAIT_V(6); PG8_BAR;
    }
    for (;;) {
        const bool has_next = S.next(ui + 1, nxt);
        const char* nA = has_next ? (Sched::GATHER ? (const char*)g.A : (const char*)g.A + (size_t)nxt.pm * tstep) : cA; const char* nB = has_next ? (const char*)g.Bt + (size_t)nxt.pb * tstep : cB;
        if (has_next) fillA(ui + 1, nA0, nA1); else {
#pragma unroll
            for (int i = 0; i < 2; ++i) { nA0[i] = vA0[i]; nA1[i] = vA1[i]; } }
        for (int t = 0; t < nt; t += 2) {
            const bool last = (t == nt - 2);
            const char* a1 = cA + (size_t)(t + 1) * kstep;
            const char* a2 = last ? nA : cA + (size_t)(t + 2) * kstep; const char* b2 = last ? nB : cB + (size_t)(t + 2) * kstep;
            const char* a3 = a2 + kstep; const char* b3 = b2 + kstep;
            unsigned sA0[2], sA1[2];
#pragma unroll
            for (int i = 0; i < 2; ++i) { sA0[i] = last ? nA0[i] : vA0[i]; sA1[i] = last ? nA1[i] : vA1[i]; }
            if (last && has_next) S.a_ready(nxt);
            if constexpr (SP2) {
            PG8_LDB(B0, 0, 0); PG8_LDB(B1, 0, 1); PG8_SCHED; PG8_LDA(At, 0, 0); PG8_STAGE(PG8_SA(1, 1), a1, vA1);
            PG8_WAIT_V(8); PG8_WAIT_L(0); PG8_BAR; PG8_MMA(0, 0, At, B0); PG8_MMA(0, 1, At, B1); PG8_BAR; PG8_SCHED;
            PG8_LDA(At, 0, 1); PG8_STAGE(PG8_SB(0, 0), b2, voffB); PG8_STAGE(PG8_SB(0, 1), b2 + hstep, voffB); PG8_STAGE(PG8_SA(0, 0), a2, sA0);
            PG8_WAIT_V(8); PG8_WAIT_L(0); PG8_BAR; PG8_MMA(1, 0, At, B0); PG8_MMA(1, 1, At, B1); PG8_BAR; PG8_SCHED;
            PG8_LDB(B0, 1, 0); PG8_LDB(B1, 1, 1); PG8_SCHED; PG8_LDA(At, 1, 0); PG8_STAGE(PG8_SA(0, 1), a2, sA1);
            PG8_WAIT_V(8); PG8_WAIT_L(0); PG8_BAR; PG8_MMA(0, 0, At, B0); PG8_MMA(0, 1, At, B1); PG8_BAR; PG8_SCHED;
            PG8_LDA(At, 1, 1); PG8_STAGE(PG8_SB(1, 0), b3, voffB); PG8_STAGE(PG8_SB(1, 1), b3 + hstep, voffB); PG8_STAGE(PG8_SA(1, 0), a3, sA0);
            PG8_WAIT_V(8); PG8_WAIT_L(0); PG8_BAR; PG8_MMA(1, 0, At, B0); PG8_MMA(1, 1, At, B1); PG8_BAR; PG8_SCHED;
            } else {
            PG8_LDB(B0, 0, 0); PG8_SCHED; PG8_LDA(At, 0, 0); PG8_STAGE(PG8_SA(1, 1), a1, vA1);
            PG8_WAIT_L(8); PG8_BAR; PG8_WAIT_L(0); PG8_MMA(0, 0, At, B0); PG8_BAR; PG8_SCHED;
            PG8_LDB(B1, 0, 1); PG8_STAGE(PG8_SB(0, 0), b2, voffB);
            PG8_BAR; PG8_WAIT_L(0); PG8_MMA(0, 1, At, B1); PG8_BAR;
            PG8_LDA(At, 0, 1); PG8_STAGE(PG8_SA(0, 0), a2, sA0);
            PG8_BAR; PG8_WAIT_L(0); PG8_MMA(1, 0, At, B0); PG8_BAR; PG8_SCHED;
            PG8_STAGE(PG8_SB(0, 1), b2 + hstep, voffB);
            PG8_WAIT_V(6); PG8_BAR; PG8_MMA(1, 1, At, B1); PG8_BAR;
            PG8_LDB(B0, 1, 0); PG8_SCHED; PG8_LDA(At, 1, 0); PG8_STAGE(PG8_SA(0, 1), a2, sA1);
            PG8_WAIT_L(8); PG8_BAR; PG8_WAIT_L(0); PG8_MMA(0, 0, At, B0); PG8_BAR; PG8_SCHED;
            PG8_LDB(B1, 1, 1); PG8_STAGE(PG8_SB(1, 0), b3, voffB);
            PG8_BAR; PG8_WAIT_L(0); PG8_MMA(0, 1, At, B1); PG8_BAR;
            PG8_LDA(At, 1, 1); PG8_STAGE(PG8_SA(1, 0), a3, sA0);
            PG8_BAR; PG8_WAIT_L(0); PG8_MMA(1, 0, At, B0); PG8_BAR; PG8_SCHED;
            PG8_STAGE(PG8_SB(1, 1), b3 + hstep, voffB);
            PG8_WAIT_V(6); PG8_BAR; PG8_MMA(1, 1, At, B1); PG8_BAR;
            }
        }
        if constexpr (ALIGN_EPI) { if (wr == 0) PG8_BAR; }
        if constexpr (!Epi::AFTER_DRAIN) { E(acc, cur, wr, wc, fr, fq); S.done(cur); }
        if (!has_next) break;
#pragma unroll
        for (int a = 0; a < 2; ++a)
#pragma unroll
            for (int b = 0; b < 2; ++b)
#pragma unroll
                for (int m = 0; m < 4; ++m)
#pragma unroll
                    for (int n = 0; n < 2; ++n) acc[a][b][m][n] = (f32x4){0.f, 0.f, 0.f, 0.f};
        cur = nxt; cA = nA; cB = nB; ++ui;
#pragma unroll
        for (int i = 0; i < 2; ++i) { vA0[i] = nA0[i]; vA1[i] = nA1[i]; }
        if constexpr (ALIGN_EPI) { if (wr == 1) PG8_BAR; }
    }
    PG8_WAIT_V(0);
    if constexpr (!ALIGN_EPI) { if (wr == 0) PG8_BAR; }
    PG8_BAR;
    if constexpr (Epi::AFTER_DRAIN) { E.fused(acc, cur, wr, wc, fr, fq, lds, wid, lane); S.done(cur); }
#undef PG8_SA
#undef PG8_SB
#undef PG8_STAGE
#undef PG8_LDA
#undef PG8_LDB
#undef PG8_MMA
#undef PG8_WAIT_V
#undef PG8_WAIT_L
#undef PG8_BAR
#undef PG8_SCHED
}
}
constexpr int D = 1024, BATCH = 8, SEQ = 4096, NTOK = BATCH * SEQ;
constexpr int GW = 512, RW = 512, HD = 64, CHUNK = 128;
constexpr int RPROJ = 1696, INW = 2720, ZLD = 2816;
constexpr int NG = 4, EPG = 8, NE = 32, EH = 512;
constexpr int NTHR = 512;
constexpr int LDS_BYTES = 163840;

typedef float f32x16 __attribute__((ext_vector_type(16)));
typedef float f32x4 __attribute__((ext_vector_type(4)));
typedef unsigned u32x4 __attribute__((ext_vector_type(4)));
typedef unsigned u32x2 __attribute__((ext_vector_type(2)));
typedef unsigned short bf16;
#define LAS __attribute__((address_space(3)))

constexpr size_t MiB = 1u << 20;
constexpr size_t W_WINT = 0;
constexpr size_t W_WOUTT = 6 * MiB;
constexpr size_t W_LORAT = 8 * MiB;
constexpr size_t W_WC = 9 * MiB;
constexpr size_t W_MOD = 10 * MiB;
constexpr size_t W_TAB = 11 * MiB;
constexpr size_t W_WGUT = 16 * MiB;
constexpr size_t W_WDT = 80 * MiB;
constexpr size_t W_H1 = 112 * MiB;
constexpr size_t W_Z = 176 * MiB;
constexpr size_t W_YCAT = 352 * MiB;
constexpr size_t W_LO = 416 * MiB;
constexpr size_t WS_NEED = 512 * MiB;
constexpr size_t T_TOKE = W_TAB;
constexpr size_t T_TOKW = W_TAB + 512 * 1024;
constexpr size_t T_ROWTOK = W_TAB + 1024 * 1024;
constexpr size_t T_ROWAID = W_TAB + 1536 * 1024;
constexpr size_t T_ROWW = W_TAB + 2048 * 1024;
constexpr size_t T_TILEE = W_TAB + 2560 * 1024;
constexpr size_t T_CTL = W_TAB + 3072 * 1024;
constexpr size_t T_BAR = W_TAB + 3584 * 1024;

struct Params {
    const float* in[31];
    float* out;
    unsigned char* ws;
};
typedef const __attribute__((address_space(4))) Params& PRef;
typedef const __attribute__((address_space(4))) Params* PPtr;
__device__ __forceinline__ PPtr opq(PPtr k) { asm volatile("" : "+s"(k)); return k; }
enum { I_X = 0, I_C, I_ADAW, I_ADAB, I_N1G, I_WIN, I_GLNW, I_GLNB, I_GWS, I_GBS, I_MU, I_W0, I_W2, I_A0, I_A2, I_G2, I_KK, I_KA, I_RK, I_GNW, I_GNB, I_WOUT, I_N2G, I_RGW, I_RGB, I_REW, I_REB, I_WG, I_WU, I_WD, I_FNG };

__device__ __forceinline__ float wave_sum(float v) {
#pragma unroll
    for (int o = 1; o < 64; o <<= 1) v += __shfl_xor(v, o);
    return v;
}
#define DPP_ADD(v, ctrl) v += __builtin_bit_cast(float, __builtin_amdgcn_update_dpp(0, __builtin_bit_cast(int, v), ctrl, 0xf, 0xf, false))
__device__ __forceinline__ float wave_sum_dpp(float v) {
    DPP_ADD(v, 0xB1); DPP_ADD(v, 0x4E); DPP_ADD(v, 0x141); DPP_ADD(v, 0x140);
    const int iv = __builtin_bit_cast(int, v);
    const float a = __builtin_bit_cast(float, __builtin_amdgcn_readlane(iv, 0)), b = __builtin_bit_cast(float, __builtin_amdgcn_readlane(iv, 16));
    const float c = __builtin_bit_cast(float, __builtin_amdgcn_readlane(iv, 32)), d = __builtin_bit_cast(float, __builtin_amdgcn_readlane(iv, 48));
    return (a + b) + (c + d);
}
__device__ __forceinline__ float xsum4(float s) {
    s += __builtin_bit_cast(float, __builtin_amdgcn_ds_swizzle(__builtin_bit_cast(int, s), 0x401F));
    float a = s, b = s;
    asm volatile("s_nop 1\n\tv_permlane32_swap_b32 %0, %1\n\ts_nop 1" : "+v"(a), "+v"(b));
    return a + b;
}
__device__ __forceinline__ float wave_sum_v(float v) {
    DPP_ADD(v, 0xB1); DPP_ADD(v, 0x4E); DPP_ADD(v, 0x141); DPP_ADD(v, 0x140);
    return xsum4(v);
}
__device__ __forceinline__ float gelu_tanh(float x) {
    const float u = 0.7978845608028654f * (x + 0.044715f * x * x * x);
    return 0.5f * x * (1.0f + tanhf(u));
}
__device__ __forceinline__ float gelu_fast(float x) {
    const float u2 = -2.302208198f * (x + 0.044715f * x * x * x);
    return x * __builtin_amdgcn_rcpf(1.0f + __builtin_amdgcn_exp2f(u2));
}
__device__ __forceinline__ float sigmoidf_(float x) { return 1.0f / (1.0f + expf(-x)); }
__device__ __forceinline__ float softplusf_(float x) { return fmaxf(x, 0.f) + log1pf(expf(-fabsf(x))); }
__device__ __forceinline__ float bf2f(unsigned short b) { return __uint_as_float(((unsigned)b) << 16); }
__device__ __forceinline__ float bflo(unsigned w) { return __uint_as_float(w << 16); }
__device__ __forceinline__ float bfhi(unsigned w) { return __uint_as_float(w & 0xffff0000u); }
__device__ __forceinline__ unsigned f2bf(float f) { unsigned u = __float_as_uint(f); return (u + 0x7fffu + ((u >> 16) & 1u)) >> 16; }
__device__ __forceinline__ unsigned pk2(float lo, float hi) { return f2bf(lo) | (f2bf(hi) << 16); }
#define XB_TMO      128
#define XB_XCNT(j)  (256  + 64 * (j))
#define XB_XSUB(j)  (1280 + 64 * (j))
#define XB_XGEN(j)  (2304 + 64 * (j))
#define XB_TOP      3328
#define XB_TOPGEN   3392
#define XCD_BAR_WORDS 3456
#define XB_SPIN_CAP (1u << 18)

__device__ __forceinline__ unsigned xb_ld(unsigned* p)              { return __hip_atomic_load(p, __ATOMIC_RELAXED, __HIP_MEMORY_SCOPE_AGENT); }
__device__ __forceinline__ unsigned xb_add(unsigned* p, unsigned v) { return __hip_atomic_fetch_add(p, v, __ATOMIC_RELAXED, __HIP_MEMORY_SCOPE_AGENT); }
__device__ __forceinline__ unsigned xb_xcc_id() { return (unsigned)__builtin_amdgcn_s_getreg((3 << 11) | 20) & 0xFu; }
#define XB_SPIN(cond, bar) do { unsigned _sp = 0; while (cond) { __builtin_amdgcn_s_sleep(1); \
    if ((++_sp & 255u) == 0u) { if (xb_ld(&(bar)[XB_TMO])) break; if (_sp > XB_SPIN_CAP) { atomicAdd(&(bar)[XB_TMO], 1u); break; } } } } while (0)

struct XcdBarrier {
    unsigned* bar; unsigned x;
    volatile LAS unsigned* st;
};

__device__ __forceinline__ XcdBarrier xcd_barrier_post(unsigned* bar, volatile LAS unsigned* st) {
    XcdBarrier b; b.bar = bar; b.x = xb_xcc_id(); b.st = st;
    if (threadIdx.x == 0) (void)xb_add(&bar[XB_XCNT(b.x)], 1u);
    return b;
}
__device__ __forceinline__ void xcd_barrier_complete(unsigned* bar, unsigned x, unsigned& nloc, unsigned& nx) {
    const unsigned G = gridDim.x * gridDim.y * gridDim.z;
    unsigned sum, cnt, mine, sp = 0u;
    for (;;) {
        sum = 0u; cnt = 0u; mine = 0u;
#pragma unroll
        for (unsigned j = 0; j < 16; ++j) { const unsigned c = xb_ld(&bar[XB_XCNT(j)]); sum += c; cnt += (c > 0u) ? 1u : 0u; mine = (j == x) ? c : mine; }
        if (sum == G) break;
        __builtin_amdgcn_s_sleep(1);
        if ((++sp & 255u) == 0u) { if (xb_ld(&bar[XB_TMO])) break; if (sp > XB_SPIN_CAP) { atomicAdd(&bar[XB_TMO], 1u); break; } }
    }
    nloc = mine > 0u ? mine : 1u; nx = cnt > 0u ? cnt : 1u;
}

__device__ __forceinline__ void xcd_barrier(const XcdBarrier& b) {
    asm volatile("s_waitcnt vmcnt(0)" ::: "memory");
    __syncthreads();
    if (threadIdx.x == 0) {
        unsigned* bar = b.bar;
        __builtin_amdgcn_s_waitcnt(0);
        unsigned nloc = b.st[0], nx = b.st[1];
        if (nloc == 0u) { xcd_barrier_complete(bar, b.x, nloc, nx); b.st[0] = nloc; b.st[1] = nx; }
        const unsigned old = xb_add(&bar[XB_XSUB(b.x)], 1u);
        const unsigned gen = old / nloc;
        if (old + 1u == (gen + 1u) * nloc) {
            __builtin_amdgcn_fence(__ATOMIC_RELEASE, "agent");
            asm volatile("s_waitcnt vmcnt(0)" ::: "memory");
            const unsigned og = xb_add(&bar[XB_TOP], 1u);
            const unsigned tg = og / nx;
            if (og + 1u == (tg + 1u) * nx) xb_add(&bar[XB_TOPGEN], 1u);
            else XB_SPIN(xb_ld(&bar[XB_TOPGEN]) == tg, bar);
            __builtin_amdgcn_fence(__ATOMIC_ACQUIRE, "agent");
            xb_add(&bar[XB_XGEN(b.x)], 1u);
            asm volatile("s_waitcnt vmcnt(0)" ::: "memory");
        } else {
            XB_SPIN(xb_ld(&bar[XB_XGEN(b.x)]) == gen, bar);
            __builtin_amdgcn_fence(__ATOMIC_ACQUIRE, "agent");
            asm volatile("s_waitcnt vmcnt(0)" ::: "memory");
        }
    }
    __syncthreads();
}
constexpr int GT = 128;
constexpr int PROWS_G = NTOK * 2 + NE * GT;
constexpr int PTILES_G = PROWS_G / GT;
template <class Epi>
__device__ __forceinline__ void gg_gemm(float* lds, const float* __restrict__ A, int lda, const int* rowidx, const float* __restrict__ B, int ldb, size_t bstride,
                        const int* tile_expert, int M, int N, int K, const Epi& epi, int bid, int nb) {
    float* As = lds;
    float* Bs = lds + 16 * 132;
    const int tid = otid(), lane = tid & 63, wid = tid >> 6, wm = wid >> 1, wn = wid & 1;
    const int tilesN = (N + 127) / 128, tilesM = M / 128;
    for (int tile = bid; tile < tilesM * tilesN; tile += nb) {
        const int tm = tile / tilesN, tn = tile % tilesN;
        const float* Bp = B;
        if (tile_expert) { const int e = tile_expert[tm]; if (e < 0) continue; Bp = B + (size_t)e * bstride; }
        f32x16 acc0, acc1;
#pragma unroll
        for (int i = 0; i < 16; ++i) { acc0[i] = 0.f; acc1[i] = 0.f; }
        const int arow = tid >> 2, akq = (tid & 3) * 4;
        int asrc = tm * 128 + arow;
        if (rowidx) asrc = rowidx[asrc];
        const int bk = tid >> 5, bn4 = (tid & 31) * 4, bcol = tn * 128 + bn4;
        for (int k0 = 0; k0 < K; k0 += 16) {
            f32x4 av = {0.f, 0.f, 0.f, 0.f};
            if (asrc >= 0) av = *(const f32x4*)(A + (size_t)asrc * lda + k0 + akq);
            f32x4 bv = {0.f, 0.f, 0.f, 0.f};
            if (bcol < N) bv = *(const f32x4*)(Bp + (size_t)(k0 + bk) * ldb + bcol);
            __syncthreads();
            As[(akq + 0) * 132 + arow] = av[0]; As[(akq + 1) * 132 + arow] = av[1]; As[(akq + 2) * 132 + arow] = av[2]; As[(akq + 3) * 132 + arow] = av[3];
            *(f32x4*)(Bs + bk * 128 + bn4) = bv;
            __syncthreads();
#pragma unroll
            for (int kk = 0; kk < 16; kk += 2) {
                const int kr = kk + (lane >> 5);
                const float a = As[kr * 132 + wm * 32 + (lane & 31)];
                const float b0 = Bs[kr * 128 + wn * 64 + (lane & 31)];
                const float b1 = Bs[kr * 128 + wn * 64 + 32 + (lane & 31)];
                acc0 = __builtin_amdgcn_mfma_f32_32x32x2f32(a, b0, acc0, 0, 0, 0);
                acc1 = __builtin_amdgcn_mfma_f32_32x32x2f32(a, b1, acc1, 0, 0, 0);
            }
        }
#pragma unroll
        for (int r = 0; r < 16; ++r) {
            const int row = tm * 128 + wm * 32 + (r & 3) + 8 * (r >> 2) + 4 * (lane >> 5);
            const int c0 = tn * 128 + wn * 64 + (lane & 31);
            if (c0 < N) epi(row, c0, acc0[r]);
            if (c0 + 32 < N) epi(row, c0 + 32, acc1[r]);
        }
        __syncthreads();
    }
}
__device__ __forceinline__ void gold_normmod(const float* __restrict__ x, const float* __restrict__ g, const float* mod, int shift_idx, int scale_idx, float* __restrict__ out, int bid, int nb) {
    const int tid_ = otid(), lane = tid_ & 63, wv = tid_ >> 6;
    for (int row = bid * 8 + wv; row < NTOK; row += nb * 8) {
        const int b = row / SEQ;
        const f32x4* xr = (const f32x4*)(x + (size_t)row * D) + lane;
        f32x4 v[4]; float s = 0.f;
#pragma unroll
        for (int j = 0; j < 4; ++j) { v[j] = xr[64 * j]; s += v[j][0] * v[j][0] + v[j][1] * v[j][1] + v[j][2] * v[j][2] + v[j][3] * v[j][3]; }
        const float r = rsqrtf(wave_sum(s) * (1.0f / D) + 1e-6f);
        const float* sh = mod + b * 6 * D + shift_idx * D; const float* sc = mod + b * 6 * D + scale_idx * D;
        f32x4* o = (f32x4*)(out + (size_t)row * D) + lane;
#pragma unroll
        for (int j = 0; j < 4; ++j) {
            const int c0 = (lane + 64 * j) * 4; f32x4 y;
#pragma unroll
            for (int q = 0; q < 4; ++q) y[q] = v[j][q] * r * g[c0 + q] * (1.0f + sc[c0 + q]) + sh[c0 + q];
            o[64 * j] = y;
        }
    }
}
__device__ __forceinline__ void gold_gmlp_ln(PRef p, const bf16* Z, float* vln, int bid, int nb) {
    const float* lw = p.in[I_GLNW]; const float* lb = p.in[I_GLNB];
    const int tid_ = otid(), lane = tid_ & 63, wv = tid_ >> 6;
    for (int row = bid * 8 + wv; row < NTOK; row += nb * 8) {
        const bf16* vr = Z + (size_t)row * ZLD + 512;
        float v[8]; float s = 0.f;
#pragma unroll
        for (int j = 0; j < 8; ++j) { v[j] = bf2f(vr[lane + 64 * j]); s += v[j]; }
        const float m = wave_sum(s) * (1.0f / 512.f); float q = 0.f;
#pragma unroll
        for (int j = 0; j < 8; ++j) { const float d = v[j] - m; q += d * d; }
        const float rs = rsqrtf(wave_sum(q) * (1.0f / 512.f) + 1e-5f);
#pragma unroll
        for (int j = 0; j < 8; ++j) { const int c = lane + 64 * j; vln[(size_t)row * 512 + c] = (v[j] - m) * rs * lw[c] + lb[c]; }
    }
}
__device__ __forceinline__ void gold_gmlp_mix(PRef p, const bf16* Z, const float* vln, float* ycat, int bid, int nb) {
    const float* wsp = p.in[I_GWS]; const float* bsp = p.in[I_GBS];
    for (int t = bid; t < NTOK; t += nb) {
        const int c = otid(), h = c >> 6, tl = t & 127, t0 = t - tl;
        const float* wrow = wsp + ((size_t)h * CHUNK + tl) * CHUNK;
        float s = 0.f;
        for (int ss = 0; ss <= tl; ++ss) s = fmaf(wrow[ss], vln[(size_t)(t0 + ss) * 512 + c], s);
        s += bsp[h * CHUNK + tl];
        ycat[(size_t)t * 1024 + c] = bf2f(Z[(size_t)t * ZLD + c]) * s;
    }
}
constexpr int NPT = 8192;
__device__ __forceinline__ void gold_rwkv_prep(PRef p, float* lds, const bf16* Z, float* SC, float* RKo, int part, int bid, int nb) {
    constexpr size_t AS = (size_t)NPT * 512;
    float *Ro = SC, *Wo = SC + AS, *Ko = SC + 2 * AS, *Vo = SC + 3 * AS, *Ao = SC + 4 * AS, *Bo = SC + 5 * AS, *Go = SC + 6 * AS;
    const float* mu = p.in[I_MU];
    float* zs = lds;
    const int c = otid(), lane = c & 63, h = c >> 6;
    for (int tl = bid; tl < NPT; tl += nb) {
        const int t = part * NPT + tl;
        __syncthreads();
        for (int j = c; j < RPROJ; j += NTHR) {
            const float cur = bf2f(Z[(size_t)t * ZLD + 1024 + j]);
            const float prev = (t % SEQ == 0) ? 0.f : bf2f(Z[(size_t)(t - 1) * ZLD + 1024 + j]);
            float z = cur + (prev - cur) * mu[j];
            if (j >= 1536 && j < 1568) z = tanhf(z);
            if (j >= 1600) z = sigmoidf_(z);
            zs[j] = z;
        }
        __syncthreads();
        const float r = zs[c], k = zs[512 + c], v = zs[1024 + c];
        float dw = 0.f, da = 0.f, g = 0.f;
#pragma unroll 4
        for (int j = 0; j < 32; ++j) dw = fmaf(zs[1536 + j], p.in[I_W2][j * 512 + c], dw);
#pragma unroll 4
        for (int j = 0; j < 32; ++j) da = fmaf(zs[1568 + j], p.in[I_A2][j * 512 + c], da);
#pragma unroll 4
        for (int j = 0; j < 96; ++j) g = fmaf(zs[1600 + j], p.in[I_G2][j * 512 + c], g);
        const float wlog = -softplusf_(-(p.in[I_W0][c] + dw)) - 0.5f;
        const float decay = expf(-expf(wlog));
        const float asig = sigmoidf_(p.in[I_A0][c] + da);
        const float kkv = k * p.in[I_KK][c];
        const float nrm = sqrtf(wave_sum(kkv * kkv));
        const float kk = kkv / fmaxf(nrm, 1e-12f);
        const float k2 = k * (1.0f + (asig - 1.0f) * p.in[I_KA][c]);
        const float rk = wave_sum(r * k2 * p.in[I_RK][c]);
        const size_t o = (size_t)tl * 512 + c;
        Ro[o] = r; Wo[o] = decay; Ko[o] = k2; Vo[o] = v; Ao[o] = -kk; Bo[o] = kk * asig; Go[o] = g;
        if (lane == 0) RKo[tl * 8 + h] = rk;
    }
}
__device__ __forceinline__ void gold_rwkv_prep_lo(PRef p, float* lds, const bf16* Z, const bf16* LO, float* SC, float* RKo, int part, int bid, int nb) {
    constexpr size_t AS = (size_t)NPT * 512;
    float *Ro = SC, *Wo = SC + AS, *Ko = SC + 2 * AS, *Vo = SC + 3 * AS, *Ao = SC + 4 * AS, *Bo = SC + 5 * AS, *Go = SC + 6 * AS;
    const float* mu = p.in[I_MU];
    const int c = otid(), lane = c & 63, h = c >> 6;
    for (int tl = bid; tl < NPT; tl += nb) {
        const int t = part * NPT + tl;
        float z3[3];
#pragma unroll
        for (int q = 0; q < 3; ++q) { const int j = q * 512 + c;
            const float cur = bf2f(Z[(size_t)t * ZLD + 1024 + j]);
            const float prev = (t % SEQ == 0) ? 0.f : bf2f(Z[(size_t)(t - 1) * ZLD + 1024 + j]);
            z3[q] = cur + (prev - cur) * mu[j]; }
        const float r = z3[0], k = z3[1], v = z3[2];
        const float decay = expf(bf2f(LO[(size_t)t * 1536 + c]));
        const float asig = bf2f(LO[(size_t)t * 1536 + 512 + c]);
        const float g = bf2f(LO[(size_t)t * 1536 + 1024 + c]);
        const float kkv = k * p.in[I_KK][c];
        const float nrm = sqrtf(wave_sum(kkv * kkv));
        const float kk = kkv / fmaxf(nrm, 1e-12f);
        const float k2 = k * (1.0f + (asig - 1.0f) * p.in[I_KA][c]);
        const float rk = wave_sum(r * k2 * p.in[I_RK][c]);
        const size_t o = (size_t)tl * 512 + c;
        Ro[o] = r; Wo[o] = decay; Ko[o] = k2; Vo[o] = v; Ao[o] = -kk; Bo[o] = kk * asig; Go[o] = g;
        if (lane == 0) RKo[tl * 8 + h] = rk;
    }
}
template <class YT>
__device__ __forceinline__ void gold_rwkv_scan(PRef p, float* lds, const float* SC, const float* RKi, YT* ycat, int part, int bid, int nb) {
    constexpr size_t AS = (size_t)NPT * 512;
    const float *Ri = SC, *Wi = SC + AS, *Ki = SC + 2 * AS, *Vi = SC + 3 * AS, *Ai = SC + 4 * AS, *Bi = SC + 5 * AS, *Gi = SC + 6 * AS;
    constexpr int TS = 16;
    float* vec = lds;
    float* vb = lds + 5 * TS * 64;
    float* yb = vb + TS * 64;
    const int tid = otid(), lane = tid & 63, wv = tid >> 6;
    for (int item = bid; item < (NPT / SEQ) * 8; item += nb) {
        const int bl = item >> 3, h = item & 7;
        float S[64];
#pragma unroll
        for (int k = 0; k < 64; ++k) S[k] = 0.f;
        for (int c0 = 0; c0 < SEQ; c0 += TS) {
            __syncthreads();
            for (int i = tid; i < 6 * TS * 64; i += NTHR) {
                const int arr = i / (TS * 64), rem = i % (TS * 64), s = rem >> 6, d = rem & 63;
                const size_t src = ((size_t)(bl * SEQ + c0 + s)) * 512 + h * 64 + d;
                const float* ap = arr == 0 ? Ri : arr == 1 ? Wi : arr == 2 ? Ki : arr == 3 ? Ai : arr == 4 ? Bi : Vi;
                const float val = ap[src];
                if (arr < 5) vec[(arr * TS + s) * 64 + d] = val; else vb[s * 64 + d] = val;
            }
            __syncthreads();
            if (wv == 0) {
                for (int s = 0; s < TS; ++s) {
                    const float* rr = vec + (0 * TS + s) * 64; const float* ww = vec + (1 * TS + s) * 64; const float* kk = vec + (2 * TS + s) * 64;
                    const float* aa = vec + (3 * TS + s) * 64; const float* bb = vec + (4 * TS + s) * 64;
                    const float vv = vb[s * 64 + lane];
                    float sa = 0.f;
#pragma unroll
                    for (int k = 0; k < 64; ++k) sa = fmaf(S[k], aa[k], sa);
                    float y = 0.f;
#pragma unroll
                    for (int k = 0; k < 64; ++k) { S[k] = fmaf(S[k], ww[k], fmaf(sa, bb[k], vv * kk[k])); y = fmaf(S[k], rr[k], y); }
                    yb[s * 64 + lane] = y;
                }
            }
            __syncthreads();
            for (int s = wv; s < TS; s += 8) {
                const int tl = bl * SEQ + c0 + s; const int t = part * NPT + tl; const int c = h * 64 + lane;
                const float y = yb[s * 64 + lane];
                const float m = wave_sum(y) * (1.0f / 64.f); const float dlt = y - m;
                const float var = wave_sum(dlt * dlt) * (1.0f / 64.f);
                float o = dlt * rsqrtf(var + 64e-5f) * p.in[I_GNW][c] + p.in[I_GNB][c];
                o += RKi[tl * 8 + h] * Vi[(size_t)tl * 512 + c];
                o *= Gi[(size_t)tl * 512 + c];
                if (sizeof(YT) == 2) ((bf16*)ycat)[(size_t)t * 1024 + 512 + c] = (bf16)f2bf(o); else ((float*)ycat)[(size_t)t * 1024 + 512 + c] = o;
            }
        }
    }
}
struct GEpiOutproj {
    const float* x; const float* mod; float* x1;
    __device__ __forceinline__ void operator()(int row, int col, float v) const {
        const int b = row / SEQ;
        x1[(size_t)row * D + col] = x[(size_t)row * D + col] + mod[b * 6 * D + 2 * D + col] * v;
    }
};
__device__ __forceinline__ void gold_norm2_route(PRef p, float* lds, const float* x1, float* h2, int bid, int nb) {
    const float* mod = (const float*)(p.ws + W_MOD);
    int* toke = (int*)(p.ws + T_TOKE); float* tokw = (float*)(p.ws + T_TOKW); int* cnt = (int*)(p.ws + T_CTL);
    const float* g = p.in[I_N2G]; const float* rgw = p.in[I_RGW]; const float* rew = p.in[I_REW];
    const int tid_ = otid(), lane = tid_ & 63, wv = tid_ >> 6;
    for (int row = bid * 8 + wv; row < NTOK; row += nb * 8) {
        const int b = row / SEQ;
        const float* xr = x1 + (size_t)row * D;
        float s = 0.f;
#pragma unroll 4
        for (int j = 0; j < 16; ++j) { const float xv = xr[lane + 64 * j]; s += xv * xv; }
        const float r = rsqrtf(wave_sum(s) * (1.0f / D) + 1e-6f);
        const float* sh = mod + b * 6 * D + 3 * D; const float* sc = mod + b * 6 * D + 4 * D;
        float lg[36];
#pragma unroll
        for (int j = 0; j < 36; ++j) lg[j] = 0.f;
#pragma unroll 1
        for (int j = 0; j < 16; ++j) {
            const int c = lane + 64 * j;
            const float hv = xr[c] * r * g[c] * (1.0f + sc[c]) + sh[c];
            h2[(size_t)row * D + c] = hv;
#pragma unroll
            for (int q = 0; q < 4; ++q) lg[q] = fmaf(hv, rgw[c * 4 + q], lg[q]);
#pragma unroll
            for (int q = 0; q < 32; ++q) lg[4 + q] = fmaf(hv, rew[c * 32 + q], lg[4 + q]);
        }
#pragma unroll
        for (int j = 0; j < 36; ++j) lg[j] = wave_sum(lg[j]);
        float* wl = lds + wv * 64;
        if (lane == 0) {
#pragma unroll
            for (int j = 0; j < 36; ++j) wl[j] = lg[j];
            float gm = -1e30f; int gi = 0;
            for (int q = 0; q < 4; ++q) { const float t = wl[q] + p.in[I_RGB][q]; if (t > gm) { gm = t; gi = q; } }
            float gs = 0.f; for (int q = 0; q < 4; ++q) gs += expf(wl[q] + p.in[I_RGB][q] - gm);
            const float gp = 1.0f / gs;
            float* el = wl + 40;
            for (int q = 0; q < 8; ++q) el[q] = wl[4 + gi * 8 + q] + p.in[I_REB][gi * 8 + q];
            int i0 = 0; for (int q = 1; q < 8; ++q) if (el[q] > el[i0]) i0 = q;
            int i1 = (i0 == 0) ? 1 : 0; for (int q = 0; q < 8; ++q) if (q != i0 && el[q] > el[i1]) i1 = q;
            const float em = el[i0];
            const float p0 = 1.0f, p1 = expf(el[i1] - em);
            const float w0 = gp * p0 / (p0 + p1), w1 = gp * p1 / (p0 + p1);
            const int e0 = gi * 8 + i0, e1 = gi * 8 + i1;
            toke[row * 2] = e0; toke[row * 2 + 1] = e1; tokw[row * 2] = w0; tokw[row * 2 + 1] = w1;
            atomicAdd(&cnt[e0], 1); atomicAdd(&cnt[e1], 1);
        }
    }
}
__device__ __forceinline__ void gold_moe_init(PRef p, int bid, int nb) {
    int* rowtok = (int*)(p.ws + T_ROWTOK); int* rowaid = (int*)(p.ws + T_ROWAID); float* roww = (float*)(p.ws + T_ROWW); int* tilee = (int*)(p.ws + T_TILEE);
    const int* cnt = (const int*)(p.ws + T_CTL);
    for (int i = bid * NTHR + otid(); i < PROWS_G; i += nb * NTHR) { rowtok[i] = -1; rowaid[i] = -1; roww[i] = 0.f; }
    if (bid == 0 && otid() == 0) {
        int t = 0;
        for (int e = 0; e < NE; ++e) { const int nt = (cnt[e] + GT - 1) / GT; for (int j = 0; j < nt; ++j) tilee[t++] = e; }
        for (; t < PTILES_G; ++t) tilee[t] = -1;
    }
}
__device__ __forceinline__ void gold_moe_place(PRef p, int bid, int nb) {
    int* rowtok = (int*)(p.ws + T_ROWTOK); int* rowaid = (int*)(p.ws + T_ROWAID); float* roww = (float*)(p.ws + T_ROWW);
    const int* cnt = (const int*)(p.ws + T_CTL); int* cursor = (int*)(p.ws + T_CTL + 128);
    const int* toke = (const int*)(p.ws + T_TOKE); const float* tokw = (const float*)(p.ws + T_TOKW);
    for (int a = bid * NTHR + otid(); a < NTOK * 2; a += nb * NTHR) {
        const int e = toke[a];
        int start = 0; for (int q = 0; q < e; ++q) start += (cnt[q] + GT - 1) / GT * GT;
        const int pos = start + atomicAdd(&cursor[e], 1);
        rowtok[pos] = a >> 1; rowaid[pos] = a; roww[pos] = tokw[a];
    }
}
struct GEpiGate { float* hb; __device__ __forceinline__ void operator()(int row, int col, float v) const { hb[(size_t)row * EH + col] = v; } };
struct GEpiUp { float* hb; __device__ __forceinline__ void operator()(int row, int col, float v) const { const float g = hb[(size_t)row * EH + col]; hb[(size_t)row * EH + col] = g / (1.0f + expf(-g)) * v; } };
struct GEpiDown {
    const int* rowaid; const float* roww; float* y0; float* y1;
    __device__ __forceinline__ void operator()(int row, int col, float v) const {
        const int a = rowaid[row]; if (a < 0) return;
        float* y = (a & 1) ? y1 : y0;
        y[(size_t)(a >> 1) * D + col] = roww[row] * v;
    }
};
__device__ __forceinline__ void gold_final(PRef p, const float* x1, const float* y0, const float* y1, int bid, int nb) {
    const float* mod = (const float*)(p.ws + W_MOD);
    float* out = p.out; const float* g = p.in[I_FNG];
    const int tid_ = otid(), lane = tid_ & 63, wv = tid_ >> 6;
    for (int row = bid * 8 + wv; row < NTOK; row += nb * 8) {
        const int b = row / SEQ; const float* gt = mod + b * 6 * D + 5 * D;
        float v[16]; float s = 0.f;
#pragma unroll
        for (int j = 0; j < 16; ++j) { const int c = lane + 64 * j; const size_t o = (size_t)row * D + c; v[j] = x1[o] + gt[c] * (y0[o] + y1[o]); s += v[j] * v[j]; }
        const float r = rsqrtf(wave_sum(s) * (1.0f / D) + 1e-6f);
#pragma unroll
        for (int j = 0; j < 16; ++j) { const int c = lane + 64 * j; out[(size_t)row * D + c] = v[j] * r * g[c]; }
    }
}
struct TrItem { const float* W; bf16* WT; int K, N; long row_off; int item; };
__device__ __forceinline__ void p0_tr_load(const TrItem& it, float (&tv)[32], int lane) {
    const int nblk = it.N / 32, kb = it.item / nblk, nb = it.item % nblk, k0 = 64 * kb, n0 = 32 * nb;
#pragma unroll
    for (int i = 0; i < 32; ++i) tv[i] = it.W[(size_t)(k0 + 2 * i + (lane >> 5)) * it.N + n0 + (lane & 31)];
}
__device__ __forceinline__ void p0_tr_store(const TrItem& it, const float (&tv)[32], LAS float* scr, int lane) {
    const int nblk = it.N / 32, kb = it.item / nblk, nb = it.item % nblk, k0 = 64 * kb, n0 = 32 * nb;
#pragma unroll
    for (int i = 0; i < 32; ++i) scr[(2 * i + (lane >> 5)) * 33 + (lane & 31)] = tv[i];
    asm volatile("s_waitcnt lgkmcnt(0)" ::: "memory");
    const int c = lane & 7;
#pragma unroll
    for (int j = 0; j < 4; ++j) { const int n = (lane >> 3) + 8 * j; const LAS float* s = scr + (8 * c) * 33 + n;
        u32x4 o; o.x = pk2(s[0 * 33], s[1 * 33]); o.y = pk2(s[2 * 33], s[3 * 33]); o.z = pk2(s[4 * 33], s[5 * 33]); o.w = pk2(s[6 * 33], s[7 * 33]);
        *(u32x4*)(it.WT + (size_t)(it.row_off + n0 + n) * it.K + k0 + 8 * c) = o; }
    asm volatile("s_waitcnt lgkmcnt(0)" ::: "memory");
}
__device__ __forceinline__ void p0_mod_item(PRef p, LAS float* red, int item) {
    const int tid = otid(), col = tid & 63, ks = __builtin_amdgcn_readfirstlane(tid >> 6), n = item * 64 + col;
    const float* __restrict__ c = p.in[I_C]; const float* __restrict__ w = p.in[I_ADAW];
    float acc[8];
#pragma unroll
    for (int b = 0; b < 8; ++b) acc[b] = 0.f;
#pragma unroll 16
    for (int k = ks * 128; k < ks * 128 + 128; ++k) {
        const float wv = w[(size_t)k * (6 * D) + n];
#pragma unroll
        for (int b = 0; b < 8; ++b) acc[b] = fmaf(c[b * D + k], wv, acc[b]);
    }
#pragma unroll
    for (int b = 0; b < 8; ++b) red[(ks * 8 + b) * 64 + col] = acc[b];
    __syncthreads();
    { const int b = tid >> 6; float s = 0.f;
#pragma unroll
      for (int q = 0; q < 8; ++q) s += red[(q * 8 + b) * 64 + col];
      ((float*)(p.ws + W_MOD))[b * 6 * D + n] = s + p.in[I_ADAB][n]; }
    __syncthreads();
}
template <bool WITH_MOE>
__device__ __forceinline__ void p0_prep(PRef p, LAS unsigned char* lds, int bid, int nb) {
    const int tid = otid(), lane = tid & 63, wave = __builtin_amdgcn_readfirstlane(tid >> 6);
    for (int it = bid; it < 96; it += nb) p0_mod_item(p, (LAS float*)lds, it);
    { bf16* lt = (bf16*)(p.ws + W_LORAT);
      for (int i = bid * NTHR + tid; i < 1536 * 256; i += nb * NTHR) { const int n = i >> 8, k = i & 255; float v = 0.f;
          if (n < 512) { if (k < 32) v = p.in[I_W2][k * 512 + n]; }
          else if (n < 1024) { if (k >= 32 && k < 64) v = p.in[I_A2][(k - 32) * 512 + (n - 512)]; }
          else { if (k >= 64 && k < 160) v = p.in[I_G2][(k - 64) * 512 + (n - 1024)]; }
          lt[i] = (bf16)f2bf(v); }
      bf16* wc = (bf16*)(p.ws + W_WC);
      for (int i = bid * NTHR + tid; i < 8 * 128 * 128; i += nb * NTHR) { const int s = i & 127, t = (i >> 7) & 127; wc[i] = (s <= t) ? (bf16)f2bf(p.in[I_GWS][i]) : (bf16)0; }
      bf16* wpad = (bf16*)(p.ws + W_WINT) + (size_t)INW * D;
      for (int i = bid * NTHR + tid; i < (ZLD - INW) * D; i += nb * NTHR) wpad[i] = 0; }
    LAS float* scr = (LAS float*)(lds + wave * 16384);
    const int gw = bid * 8 + wave, NGW = nb * 8;
    constexpr int I_IN = (D / 64) * (INW / 32), I_OUT = (D / 64) * (D / 32), I_GU = (D / 64) * (EH / 32), I_DN = (EH / 64) * (D / 32);
    constexpr int NIT = I_IN + I_OUT + (WITH_MOE ? NE * (2 * I_GU + I_DN) : 0);
    auto decode = [&](int it) -> TrItem {
        int r = it;
        if (r < I_IN) return TrItem{p.in[I_WIN], (bf16*)(p.ws + W_WINT), D, INW, 0, r}; r -= I_IN;
        if (r < I_OUT) return TrItem{p.in[I_WOUT], (bf16*)(p.ws + W_WOUTT), D, D, 0, r}; r -= I_OUT;
        const int e = r / (2 * I_GU + I_DN); r -= e * (2 * I_GU + I_DN);
        if (r < 2 * I_GU) {
            const int up = r >= I_GU; if (up) r -= I_GU;
            const int nbk = r % (EH / 32), hb = nbk * 32;
            const long row_off = (long)e * 1024 + (hb / 128) * 256 + up * 128 + (hb % 128) - hb;
            return TrItem{(up ? p.in[I_WU] : p.in[I_WG]) + (size_t)e * D * EH, (bf16*)(p.ws + W_WGUT), D, EH, row_off, r}; }
        r -= 2 * I_GU;
        return TrItem{p.in[I_WD] + (size_t)e * EH * D, (bf16*)(p.ws + W_WDT), EH, D, (long)e * 1024, r};
    };
    float tvA[32], tvB[32];
    int it = gw;
    if (it < NIT) { TrItem cur = decode(it); p0_tr_load(cur, tvA, lane);
#pragma unroll 1
        for (;;) {
            const int itn = it + NGW; TrItem nxt = cur;
            if (itn < NIT) { nxt = decode(itn); p0_tr_load(nxt, tvB, lane); }
            p0_tr_store(cur, tvA, scr, lane);
            if (itn >= NIT) break;
            const int itn2 = itn + NGW; cur = nxt;
            if (itn2 < NIT) { cur = decode(itn2); p0_tr_load(cur, tvA, lane); }
            p0_tr_store(nxt, tvB, scr, lane);
            if (itn2 >= NIT) break;
            it = itn2;
        } }
}
__device__ __forceinline__ void p1_h1(PRef p, int bid, int nb) {
    const float* __restrict__ x = p.in[I_X]; const float* __restrict__ g = p.in[I_N1G]; const float* mod = (const float*)(p.ws + W_MOD);
    bf16* H1 = (bf16*)(p.ws + W_H1);
    const int tid_ = otid(), lane = tid_ & 63, wv = tid_ >> 6;
#pragma unroll 1
    for (int row = (bid * 8 + wv) * 2; row < NTOK; row += nb * 16) {
        const int b = row / SEQ;
        const f32x4* xr = (const f32x4*)(x + (size_t)row * D) + lane;
        f32x4 v[2][4]; float s0 = 0.f, s1 = 0.f;
#pragma unroll
        for (int j = 0; j < 4; ++j) { v[0][j] = xr[64 * j]; v[1][j] = xr[256 + 64 * j]; }
#pragma unroll
        for (int j = 0; j < 4; ++j) { s0 += (v[0][j][0] * v[0][j][0] + v[0][j][1] * v[0][j][1]) + (v[0][j][2] * v[0][j][2] + v[0][j][3] * v[0][j][3]);
                                      s1 += (v[1][j][0] * v[1][j][0] + v[1][j][1] * v[1][j][1]) + (v[1][j][2] * v[1][j][2] + v[1][j][3] * v[1][j][3]); }
        const float r0 = rsqrtf(wave_sum_dpp(s0) * (1.0f / D) + 1e-6f), r1 = rsqrtf(wave_sum_dpp(s1) * (1.0f / D) + 1e-6f);
        const float* sh = mod + b * 6 * D; const float* sc = mod + b * 6 * D + D;
        u32x2* o = (u32x2*)(H1 + (size_t)row * D) + lane;
#pragma unroll
        for (int j = 0; j < 4; ++j) {
            const int c0 = (lane + 64 * j) * 4;
            const f32x4 gg = *(const f32x4*)(g + c0), ss = *(const f32x4*)(sc + c0), hh = *(const f32x4*)(sh + c0);
            f32x4 y0, y1;
#pragma unroll
            for (int q = 0; q < 4; ++q) { const float m = gg[q] * (1.0f + ss[q]); y0[q] = v[0][j][q] * r0 * m + hh[q]; y1[q] = v[1][j][q] * r1 * m + hh[q]; }
            u32x2 w0, w1; w0.x = pk2(y0[0], y0[1]); w0.y = pk2(y0[2], y0[3]); w1.x = pk2(y1[0], y1[1]); w1.y = pk2(y1[2], y1[3]);
            o[64 * j] = w0; o[256 + 64 * j] = w1;
        }
    }
}
struct EpiZ {
    static constexpr bool PERM = true, AFTER_DRAIN = false;
    bf16* Z;
    __device__ __forceinline__ void operator()(const f32x4 (&acc)[2][2][4][2], const pg8::Unit& u, int wr, int wc, int fr, int fq) const {
        const int row0 = u.pm * 256 + wr * 64 + fr, col0 = u.pn * 256 + wc * 32 + 8 * fq;
        const bool act = u.pn < 4;
#pragma unroll
        for (int ai = 0; ai < 2; ++ai)
#pragma unroll
            for (int m = 0; m < 4; ++m) { bf16* rowp = Z + (size_t)(row0 + ai * 128 + m * 16) * ZLD + col0;
#pragma unroll
                for (int bj = 0; bj < 2; ++bj) { f32x4 v0 = acc[ai][bj][m][0], v1 = acc[ai][bj][m][1];
                    if (act) {
#pragma unroll
                        for (int q = 0; q < 4; ++q) { v0[q] = gelu_fast(v0[q]); v1[q] = gelu_fast(v1[q]); } }
                    u32x4 w; w.x = pg8::cvt_pk_bf16(v0[0], v0[1]); w.y = pg8::cvt_pk_bf16(v0[2], v0[3]); w.z = pg8::cvt_pk_bf16(v1[0], v1[1]); w.w = pg8::cvt_pk_bf16(v1[2], v1[3]);
                    *(u32x4*)(rowp + bj * 128) = w; } }
    }
};
constexpr int VNT_PITCH = 272;
__device__ __forceinline__ void p3_gmlp_unit(PRef p, LAS unsigned char* lds, int chunk) {
    typedef short bf16x8 __attribute__((ext_vector_type(8)));
    const int tid = otid(), lane = tid & 63, wave = __builtin_amdgcn_readfirstlane(tid >> 6);
    const bf16* Z = (const bf16*)(p.ws + W_Z); bf16* ycat = (bf16*)(p.ws + W_YCAT);
    const int t0 = chunk * CHUNK;
    { float lw[8], lb[8];
#pragma unroll
      for (int j = 0; j < 8; ++j) { lw[j] = p.in[I_GLNW][lane + 64 * j]; lb[j] = p.in[I_GLNB][lane + 64 * j]; }
      for (int sp = 0; sp < 8; ++sp) {
          const int s = wave * 16 + sp * 2;
          const bf16* v0p = Z + (size_t)(t0 + s) * ZLD + 512 + lane; const bf16* v1p = v0p + ZLD;
          float a[8], b[8]; float sa = 0.f, sb = 0.f;
#pragma unroll
          for (int j = 0; j < 8; ++j) { a[j] = bf2f(v0p[64 * j]); b[j] = bf2f(v1p[64 * j]); sa += a[j]; sb += b[j]; }
          const float ma = wave_sum_dpp(sa) * (1.f / 512.f), mb = wave_sum_dpp(sb) * (1.f / 512.f); float qa = 0.f, qb = 0.f;
#pragma unroll
          for (int j = 0; j < 8; ++j) { a[j] -= ma; b[j] -= mb; qa += a[j] * a[j]; qb += b[j] * b[j]; }
          const float ra = rsqrtf(wave_sum_dpp(qa) * (1.f / 512.f) + 1e-5f), rb = rsqrtf(wave_sum_dpp(qb) * (1.f / 512.f) + 1e-5f);
#pragma unroll
          for (int j = 0; j < 8; ++j) { const unsigned w = pk2(a[j] * ra * lw[j] + lb[j], b[j] * rb * lw[j] + lb[j]);
              *(LAS unsigned*)(lds + (lane + 64 * j) * VNT_PITCH + s * 2) = w; }
      } }
    __syncthreads();
    const bf16* Wc = (const bf16*)(p.ws + W_WC) + (size_t)wave * CHUNK * CHUNK;
    const int fr = lane & 15, fq = lane >> 4;
    const LAS unsigned char* abase = lds + (wave * 64 + fr) * VNT_PITCH + fq * 16;
    for (int tt = 0; tt < 8; ++tt) {
        f32x4 acc[4];
#pragma unroll
        for (int dt = 0; dt < 4; ++dt) acc[dt] = (f32x4){0.f, 0.f, 0.f, 0.f};
        const int nks = ((tt * 16 + 15) >> 5) + 1;
        for (int ks = 0; ks < nks; ++ks) {
            const bf16x8 bfr = *(const bf16x8*)(Wc + (size_t)(tt * 16 + fr) * CHUNK + ks * 32 + fq * 8);
#pragma unroll
            for (int dt = 0; dt < 4; ++dt) {
                const bf16x8 afr = *(const LAS bf16x8*)(abase + dt * 16 * VNT_PITCH + ks * 64);
                acc[dt] = __builtin_amdgcn_mfma_f32_16x16x32_bf16(afr, bfr, acc[dt], 0, 0, 0);
            }
        }
        const int tl = tt * 16 + fr, t = t0 + tl;
        const float bsv = p.in[I_GBS][wave * CHUNK + tl];
#pragma unroll
        for (int dt = 0; dt < 4; ++dt) {
            const int c = wave * 64 + dt * 16 + fq * 4;
            const u32x2 uw = *(const u32x2*)(Z + (size_t)t * ZLD + c);
            u32x2 o; o.x = pk2(bflo(uw.x) * (acc[dt][0] + bsv), bfhi(uw.x) * (acc[dt][1] + bsv)); o.y = pk2(bflo(uw.y) * (acc[dt][2] + bsv), bfhi(uw.y) * (acc[dt][3] + bsv));
            *(u32x2*)(ycat + (size_t)t * 1024 + c) = o;
        }
    }
    __syncthreads();
}
constexpr size_t W_X1B = 240 * MiB;
struct EpiX1 {
    static constexpr bool PERM = true, AFTER_DRAIN = false;
    const float* x; const float* mod; bf16* x1;
    __device__ __forceinline__ void operator()(const f32x4 (&acc)[2][2][4][2], const pg8::Unit& u, int wr, int wc, int fr, int fq) const {
        const int row0 = u.pm * 256 + wr * 64 + fr, col0 = u.pn * 256 + wc * 32 + 8 * fq;
        const int b = (u.pm * 256) / SEQ;
        const float* gt = mod + b * 6 * D + 2 * D;
#pragma unroll
        for (int bj = 0; bj < 2; ++bj) { const f32x4 g0 = *(const f32x4*)(gt + col0 + bj * 128), g1 = *(const f32x4*)(gt + col0 + bj * 128 + 4);
#pragma unroll
            for (int ai = 0; ai < 2; ++ai)
#pragma unroll
                for (int m = 0; m < 4; ++m) { const size_t off = (size_t)(row0 + ai * 128 + m * 16) * D + col0 + bj * 128;
                    const f32x4 x0 = *(const f32x4*)(x + off), xb = *(const f32x4*)(x + off + 4);
                    const f32x4 v0 = x0 + g0 * acc[ai][bj][m][0], v1 = xb + g1 * acc[ai][bj][m][1];
                    u32x4 w; w.x = pg8::cvt_pk_bf16(v0[0], v0[1]); w.y = pg8::cvt_pk_bf16(v0[2], v0[3]); w.z = pg8::cvt_pk_bf16(v1[0], v1[1]); w.w = pg8::cvt_pk_bf16(v1[2], v1[3]);
                    *(u32x4*)(x1 + off) = w; } }
    }
};
constexpr size_t W_A2 = 112 * MiB;
constexpr size_t W_Q = 112 * MiB;
constexpr size_t W_Y2 = 144 * MiB;
constexpr size_t T_RK = W_TAB + 4 * MiB;
constexpr size_t O_M = 0, O_N = 64 * MiB;
constexpr size_t W_S = 176 * MiB;
constexpr int SCL = 64, NCH = SEQ / SCL;

__device__ __forceinline__ float sigmoid_fast(float x) { return __builtin_amdgcn_rcpf(1.0f + __builtin_amdgcn_exp2f(-1.4426950409f * x)); }
__device__ __forceinline__ void p3_lorain(PRef p, int bid, int nb) {
    const bf16* Z = (const bf16*)(p.ws + W_Z); bf16* A2 = (bf16*)(p.ws + W_A2);
    const int tid = otid(), j = tid & 255, sub = tid >> 8;
    const float muj = (j < 160) ? p.in[I_MU][1536 + j] : 0.f;
#pragma unroll 1
    for (int blk = bid; blk < NTOK / 128; blk += nb) {
        const int ts = blk * 128 + sub * 64;
        if (j < 160) {
            const bf16* zp = Z + (size_t)ts * ZLD + 2560 + j; bf16* ap = A2 + (size_t)ts * 256 + j;
            float prev = (ts % SEQ == 0) ? 0.f : bf2f(zp[-ZLD]);
#pragma unroll 1
            for (int t0 = 0; t0 < 64; t0 += 8) { float cur[8];
#pragma unroll
                for (int q = 0; q < 8; ++q) cur[q] = bf2f(zp[(size_t)(t0 + q) * ZLD]);
#pragma unroll
                for (int q = 0; q < 8; ++q) { float v = cur[q] + (prev - cur[q]) * muj; prev = cur[q];
                    if (j < 32) v = tanhf(v); else if (j >= 64) v = sigmoidf_(v);
                    ap[(size_t)(t0 + q) * 256] = (bf16)f2bf(v); } }
        } else { bf16* ap = A2 + (size_t)ts * 256 + j;
#pragma unroll 8
            for (int t = 0; t < 64; ++t) ap[(size_t)t * 256] = 0; }
    }
}
struct EpiLO {
    static constexpr bool PERM = true, AFTER_DRAIN = false;
    bf16* LO; const float* w0; const float* a0;
    __device__ __forceinline__ void operator()(const f32x4 (&acc)[2][2][4][2], const pg8::Unit& u, int wr, int wc, int fr, int fq) const {
        const int row0 = u.pm * 256 + wr * 64 + fr, col0 = u.pn * 256 + wc * 32 + 8 * fq, kind = u.pn >> 1;
#pragma unroll
        for (int bj = 0; bj < 2; ++bj) {
            f32x4 bv[2];
#pragma unroll
            for (int n = 0; n < 2; ++n) { const int ch = col0 + bj * 128 + 4 * n - kind * 512;
                bv[n] = kind == 0 ? *(const f32x4*)(w0 + ch) : kind == 1 ? *(const f32x4*)(a0 + ch) : (f32x4){0.f, 0.f, 0.f, 0.f}; }
#pragma unroll
            for (int ai = 0; ai < 2; ++ai)
#pragma unroll
                for (int m = 0; m < 4; ++m) { bf16* rowp = LO + (size_t)(row0 + ai * 128 + m * 16) * 1536 + col0 + bj * 128;
                    f32x4 v0 = acc[ai][bj][m][0] + bv[0], v1 = acc[ai][bj][m][1] + bv[1];
                    if (kind < 2) { const float sc = kind == 0 ? -0.6065306597f : 1.0f;
#pragma unroll
                        for (int q = 0; q < 4; ++q) { v0[q] = sc * sigmoid_fast(v0[q]); v1[q] = sc * sigmoid_fast(v1[q]); } }
                    u32x4 w; w.x = pg8::cvt_pk_bf16(v0[0], v0[1]); w.y = pg8::cvt_pk_bf16(v0[2], v0[3]); w.z = pg8::cvt_pk_bf16(v1[0], v1[1]); w.w = pg8::cvt_pk_bf16(v1[2], v1[3]);
                    *(u32x4*)rowp = w;
                    asm volatile("" ::: "memory"); }
        }
    }
};
constexpr int SC_TS = 8;
__device__ __forceinline__ void p5a_chunk(PRef p, LAS unsigned char* lds, int q) {
    typedef float f32x2 __attribute__((ext_vector_type(2)));
    const int tid_ = otid(), lane = tid_ & 63, wave = __builtin_amdgcn_readfirstlane(tid_ >> 6);
    const int seq = q / NCH, c = q % NCH, b = seq >> 3, h = seq & 7;
    const int tb = b * SEQ + c * SCL, hc = h * 64 + lane;
    const bf16* Z = (const bf16*)(p.ws + W_Z); const bf16* LO = (const bf16*)(p.ws + W_LO);
    bf16* Qo = (bf16*)(p.ws + W_Q); bf16* Y2o = (bf16*)(p.ws + W_Y2); bf16* VLo = (bf16*)(p.ws + W_YCAT); float* RKo = (float*)(p.ws + T_RK);
    LAS float* vec = (LAS float*)(lds + wave * (SC_TS * 6 * 256));
    const float mur = p.in[I_MU][hc], muk = p.in[I_MU][512 + hc], muv = p.in[I_MU][1024 + hc];
    const float kkc = p.in[I_KK][hc], kac = p.in[I_KA][hc], rkc = p.in[I_RK][hc];
    float rp = 0.f, kp = 0.f, vp = 0.f;
    if (c != 0) { const bf16* zp = Z + (size_t)(tb - 1) * ZLD + 1024 + hc; rp = bf2f(zp[0]); kp = bf2f(zp[512]); vp = bf2f(zp[1024]); }
    f32x2 Mr[32], Nr[32];
#pragma unroll
    for (int k = 0; k < 32; ++k) { Mr[k] = (f32x2){(2 * k == lane) ? 1.f : 0.f, (2 * k + 1 == lane) ? 1.f : 0.f}; Nr[k] = (f32x2){0.f, 0.f}; }
    for (int sb = 0; sb < SCL / SC_TS; ++sb) {
        const int t0 = tb + sb * SC_TS;
#pragma unroll 1
        for (int sg = 0; sg < SC_TS; sg += 4) { float zr[4], zk[4], zv[4], lw[4], as[4];
          const bf16* zp0 = Z + (unsigned)((t0 + sg) * ZLD + 1024 + hc); const bf16* lp0 = LO + (unsigned)((t0 + sg) * 1536 + hc);
#pragma unroll
          for (int s = 0; s < 4; ++s) { const bf16* zp = zp0 + s * ZLD; const bf16* lp = lp0 + s * 1536;
              zr[s] = bf2f(zp[0]); zk[s] = bf2f(zp[512]); zv[s] = bf2f(zp[1024]); lw[s] = bf2f(lp[0]); as[s] = bf2f(lp[512]); }
#pragma unroll
          for (int s = 0; s < 4; ++s) {
              const float r = zr[s] + (rp - zr[s]) * mur, k = zk[s] + (kp - zk[s]) * muk, v = zv[s] + (vp - zv[s]) * muv;
              rp = zr[s]; kp = zk[s]; vp = zv[s];
              const float kkv = k * kkc;
              const float nrm = sqrtf(wave_sum_dpp(kkv * kkv));
              const float kk = kkv / fmaxf(nrm, 1e-12f);
              const float k2 = k * (1.0f + (as[s] - 1.0f) * kac);
              const float rk = wave_sum_dpp(r * k2 * rkc);
              LAS float* o = vec + (sg + s) * 384 + lane;
              o[0] = __builtin_amdgcn_exp2f(1.4426950409f * lw[s]); o[64] = -kk; o[128] = kk * as[s]; o[192] = k2; o[256] = r; o[320] = v;
              VLo[(unsigned)((t0 + sg + s) * 1024 + 512 + hc)] = (bf16)f2bf(v);
              if (lane == 0) RKo[(unsigned)((t0 + sg + s) * 8 + h)] = rk;
          } }
        asm volatile("s_waitcnt lgkmcnt(0)" ::: "memory");
        for (int s = 0; s < SC_TS; ++s) {
            const LAS float* vs = vec + s * 384;
            const float vi = vs[320 + lane];
            f32x2 saM = {0.f, 0.f}, saN = {0.f, 0.f};
#pragma unroll
            for (int k4 = 0; k4 < 16; ++k4) { const f32x4 a4 = *(const LAS f32x4*)(vs + 64 + 4 * k4);
                const f32x2 a0 = {a4[0], a4[1]}, a1 = {a4[2], a4[3]};
                saM += Mr[2 * k4] * a0; saN += Nr[2 * k4] * a0; saM += Mr[2 * k4 + 1] * a1; saN += Nr[2 * k4 + 1] * a1;
                if ((k4 & 3) == 3) asm volatile("" ::: "memory"); }
            const float sM = saM[0] + saM[1], sN = saN[0] + saN[1];
            const f32x2 sM2 = {sM, sM}, sN2 = {sN, sN}, vi2 = {vi, vi};
            f32x2 yM = {0.f, 0.f}, yN = {0.f, 0.f};
#pragma unroll
            for (int k4 = 0; k4 < 16; ++k4) {
                const f32x4 w4 = *(const LAS f32x4*)(vs + 4 * k4), b4 = *(const LAS f32x4*)(vs + 128 + 4 * k4), k4v = *(const LAS f32x4*)(vs + 192 + 4 * k4), r4 = *(const LAS f32x4*)(vs + 256 + 4 * k4);
#pragma unroll
                for (int hh = 0; hh < 2; ++hh) {
                    const f32x2 w2 = {w4[2 * hh], w4[2 * hh + 1]}, b2 = {b4[2 * hh], b4[2 * hh + 1]}, k2 = {k4v[2 * hh], k4v[2 * hh + 1]}, r2 = {r4[2 * hh], r4[2 * hh + 1]};
                    const int kx = 2 * k4 + hh;
                    Mr[kx] = Mr[kx] * w2 + sM2 * b2;
                    Nr[kx] = Nr[kx] * w2 + (sN2 * b2 + vi2 * k2);
                    yM += Mr[kx] * r2; yN += Nr[kx] * r2;
                }
                asm volatile("" ::: "memory");
            }
            const unsigned oo = (unsigned)((t0 + s) * 512 + hc);
            Qo[oo] = (bf16)f2bf(yM[0] + yM[1]); Y2o[oo] = (bf16)f2bf(yN[0] + yN[1]);
        }
        asm volatile("s_waitcnt lgkmcnt(0)" ::: "memory");
    }
    f32x4* Mo = (f32x4*)((unsigned char*)p.out + O_M + (size_t)q * 16384 + lane * 256);
    f32x4* No = (f32x4*)((unsigned char*)p.out + O_N + (size_t)q * 16384 + lane * 256);
#pragma unroll
    for (int k4 = 0; k4 < 16; ++k4) { Mo[k4] = (f32x4){Mr[2 * k4][0], Mr[2 * k4][1], Mr[2 * k4 + 1][0], Mr[2 * k4 + 1][1]}; No[k4] = (f32x4){Nr[2 * k4][0], Nr[2 * k4][1], Nr[2 * k4 + 1][0], Nr[2 * k4 + 1][1]}; }
}
__device__ __forceinline__ void p5b_chain(PRef p, LAS unsigned char* lds, int item) {
    typedef float f32x2 __attribute__((ext_vector_type(2)));
    const int tid = otid(), r = tid >> 5, j0 = (tid & 31) * 2, seq = (item & 7) + 8 * (item >> 5), rg = (item >> 3) & 3;
    const unsigned char* Mb = (const unsigned char*)p.out + O_M + (size_t)seq * NCH * 16384;
    const unsigned char* Nb = (const unsigned char*)p.out + O_N + (size_t)seq * NCH * 16384 + (size_t)(rg * 16 + r) * 256 + j0 * 4;
    unsigned char* Sb = p.ws + W_S + (size_t)seq * NCH * 16384 + (size_t)(rg * 16 + r) * 256 + j0 * 4;
    f32x2 sreg = {0.f, 0.f};
    f32x4 m0[2], m1[2], m2[2], m3[2]; f32x2 n0, n1, n2, n3;
#define P5B_LOAD(mm, nn, cc) do { const f32x4* mp = (const f32x4*)(Mb + (size_t)(cc) * 16384) + tid; mm[0] = mp[0]; mm[1] = mp[512]; nn = *(const f32x2*)(Nb + (size_t)(cc) * 16384); } while (0)
#define P5B_BAR() do { asm volatile("s_waitcnt lgkmcnt(0)" ::: "memory"); __builtin_amdgcn_s_barrier(); asm volatile("" ::: "memory"); } while (0)
#define P5B_STEP(mm, nn, cc) do { \
        LAS float* Sl = (LAS float*)(lds + ((cc) & 1) * 20480); LAS float* Ml = Sl + 1024; \
        *(LAS f32x4*)(Ml + tid * 4) = mm[0]; *(LAS f32x4*)(Ml + 2048 + tid * 4) = mm[1]; *(LAS f32x2*)(Sl + r * 64 + j0) = sreg; \
        *(f32x2*)(Sb + (size_t)(cc) * 16384) = sreg; \
        f32x2 acc = nn; \
        P5B_BAR(); \
        if ((cc) + 4 < NCH) P5B_LOAD(mm, nn, (cc) + 4); \
        _Pragma("unroll 16") for (int i = 0; i < 64; ++i) { const float sv = Sl[r * 64 + i]; const f32x2 mv = *(const LAS f32x2*)(Ml + i * 64 + j0); acc += (f32x2){sv, sv} * mv; } \
        sreg = acc; } while (0)
    __syncthreads();
    P5B_LOAD(m0, n0, 0); P5B_LOAD(m1, n1, 1); P5B_LOAD(m2, n2, 2); P5B_LOAD(m3, n3, 3);
    for (int c = 0; c < NCH; c += 4) { P5B_STEP(m0, n0, c); P5B_STEP(m1, n1, c + 1); P5B_STEP(m2, n2, c + 2); P5B_STEP(m3, n3, c + 3); }
    __syncthreads();
#undef P5B_LOAD
#undef P5B_STEP
#undef P5B_BAR
}
#ifndef P5C_MASK
#define P5C_MASK(c, h, tt) true
#endif
__device__ __forceinline__ void p5c_chunk(PRef p, int q) {
    typedef short bf16x8 __attribute__((ext_vector_type(8)));
    const int lane = otid() & 63, fr = lane & 15, fq = lane >> 4;
    const int seq = q / NCH, c = q % NCH, b = seq >> 3, h = seq & 7, tb = b * SEQ + c * SCL;
    const bf16* Qi = (const bf16*)(p.ws + W_Q); const bf16* Y2i = (const bf16*)(p.ws + W_Y2);
    const float* RKi = (const float*)(p.ws + T_RK); const bf16* LO = (const bf16*)(p.ws + W_LO); bf16* ycat = (bf16*)(p.ws + W_YCAT);
    const float* Sc = (const float*)(p.ws + W_S + (size_t)q * 16384);
    bf16x8 sa[4][2];
#pragma unroll
    for (int vt = 0; vt < 4; ++vt)
#pragma unroll
        for (int ks = 0; ks < 2; ++ks) { const f32x4* sp = (const f32x4*)(Sc + (vt * 16 + fr) * 64 + ks * 32 + fq * 8); const f32x4 x0 = sp[0], x1 = sp[1];
            u32x4 w; w.x = pg8::cvt_pk_bf16(x0[0], x0[1]); w.y = pg8::cvt_pk_bf16(x0[2], x0[3]); w.z = pg8::cvt_pk_bf16(x1[0], x1[1]); w.w = pg8::cvt_pk_bf16(x1[2], x1[3]);
            sa[vt][ks] = __builtin_bit_cast(bf16x8, w); }
    f32x4 gw[4], gb[4];
#pragma unroll
    for (int vt = 0; vt < 4; ++vt) { gw[vt] = *(const f32x4*)(p.in[I_GNW] + h * 64 + vt * 16 + fq * 4); gb[vt] = *(const f32x4*)(p.in[I_GNB] + h * 64 + vt * 16 + fq * 4); }
#pragma unroll 1
    for (int tt = 0; tt < SCL / 16; ++tt) {
        const int t = tb + tt * 16 + fr;
        const unsigned tq = (unsigned)(t * 512 + h * 64);
        const bf16x8 qb0 = *(const bf16x8*)(Qi + (tq + fq * 8)), qb1 = *(const bf16x8*)(Qi + (tq + 32 + fq * 8));
        f32x4 y[4]; float s = 0.f;
#pragma unroll
        for (int vt = 0; vt < 4; ++vt) {
            const u32x2 yw = *(const u32x2*)(Y2i + (tq + vt * 16 + fq * 4));
            f32x4 a = {bflo(yw.x), bfhi(yw.x), bflo(yw.y), bfhi(yw.y)};
            a = __builtin_amdgcn_mfma_f32_16x16x32_bf16(sa[vt][0], qb0, a, 0, 0, 0);
            a = __builtin_amdgcn_mfma_f32_16x16x32_bf16(sa[vt][1], qb1, a, 0, 0, 0);
            y[vt] = a; s += (a[0] + a[1]) + (a[2] + a[3]);
        }
        s = xsum4(s);
        const float m = s * (1.f / 64.f); float qq = 0.f;
#pragma unroll
        for (int vt = 0; vt < 4; ++vt) { y[vt] = y[vt] - m; qq += (y[vt][0] * y[vt][0] + y[vt][1] * y[vt][1]) + (y[vt][2] * y[vt][2] + y[vt][3] * y[vt][3]); }
        qq = xsum4(qq);
        const float rs = rsqrtf(qq * (1.f / 64.f) + 64e-5f);
        const float rk = RKi[(unsigned)(t * 8 + h)];
#pragma unroll
        for (int vt = 0; vt < 4; ++vt) {
            const int cc = h * 64 + vt * 16 + fq * 4;
            const u32x2 vw = *(const u32x2*)(ycat + (unsigned)(t * 1024 + 512 + cc)); const u32x2 gwv = *(const u32x2*)(LO + (unsigned)(t * 1536 + 1024 + cc));
            const f32x4 vv = {bflo(vw.x), bfhi(vw.x), bflo(vw.y), bfhi(vw.y)}, gg = {bflo(gwv.x), bfhi(gwv.x), bflo(gwv.y), bfhi(gwv.y)};
            const f32x4 o = (y[vt] * rs * gw[vt] + gb[vt] + vv * rk) * gg;
            u32x2 ow; ow.x = pk2(o[0], o[1]); ow.y = pk2(o[2], o[3]);
            if (P5C_MASK(c, h, tt)) *(u32x2*)(ycat + (unsigned)(t * 1024 + 512 + cc)) = ow;
        }
    }
}
constexpr size_t W_H2 = 112 * MiB;
constexpr size_t W_XS = 176 * MiB;
constexpr size_t W_HB = 320 * MiB;
constexpr int PROWS = NTOK * 2 + NE * 256, PTILES = PROWS / 256;
constexpr size_t T_HIST = W_TAB + 3 * 1024 * 1024 + 8192;
constexpr size_t T_NT = W_TAB + 3 * 1024 * 1024 + 4096;
constexpr size_t T_BQ = W_TAB + 3 * 1024 * 1024 + 65536;
constexpr int TPW = NTOK / 256;

__device__ __forceinline__ void p1_bq(PRef p, LAS float* red, int b) {
    const int tid = otid();
    const float* sh = (const float*)(p.ws + W_MOD) + b * 6 * D + 3 * D;
    if (tid < 288) { const int q = tid % 36, part = tid / 36; float s = 0.f;
        for (int c = part * 128; c < part * 128 + 128; ++c) s = fmaf(sh[c], q < 4 ? p.in[I_RGW][c * 4 + q] : p.in[I_REW][c * 32 + q - 4], s);
        red[part * 36 + q] = s; }
    __syncthreads();
    if (tid < 36) { float s = 0.f;
#pragma unroll
        for (int k = 0; k < 8; ++k) s += red[k * 36 + tid];
        ((float*)(p.ws + T_BQ))[b * 36 + tid] = s + (tid < 4 ? p.in[I_RGB][tid] : p.in[I_REB][tid - 4]); }
    __syncthreads();
}
__device__ __forceinline__ void p7_route(PRef p, LAS unsigned char* lds, int bid) {
    const int tid = otid(), lane = tid & 63, wave = __builtin_amdgcn_readfirstlane(tid >> 6);
    const float* x1 = p.out; bf16* H2 = (bf16*)(p.ws + W_H2);
    LAS int* hist = (LAS int*)(lds + 147456);
    const int b = (bid * TPW) / SEQ;
    const float* mod = (const float*)(p.ws + W_MOD) + b * 6 * D;
    const float* n2g = p.in[I_N2G];
    for (int ch = tid; ch < 1024 * 8; ch += NTHR) { const int c = ch >> 3, i = ch & 7;
        *(LAS f32x4*)(lds + c * 128 + 16 * (i ^ ((c >> 1) & 7))) = *(const f32x4*)(p.in[I_REW] + c * 32 + i * 4); }
    for (int c = tid; c < 1024; c += NTHR) *(LAS f32x4*)(lds + 131072 + c * 16) = *(const f32x4*)(p.in[I_RGW] + c * 4);
    if (tid < 32) hist[tid] = 0;
    if (tid < 36) *(LAS float*)(lds + 147456 + 128 + 4 * tid) = tid < 4 ? p.in[I_RGB][tid] : p.in[I_REB][tid - 4];
    __syncthreads();
    const int sw = (lane >> 1) & 7;
#pragma unroll 1
    for (int tp = 0; tp < TPW / 8; tp += 2) {
        const int t0 = bid * TPW + wave * (TPW / 8) + tp;
        const float* xr0 = x1 + (size_t)t0 * D; bf16* hr0 = H2 + (size_t)t0 * D;
        float r0, r1;
        { float pa[16], pb[16];
#pragma unroll
          for (int j = 0; j < 16; ++j) { pa[j] = xr0[lane + 64 * j]; pb[j] = xr0[D + lane + 64 * j]; }
          float ss0 = 0.f, ss1 = 0.f;
#pragma unroll
          for (int j = 0; j < 16; ++j) { ss0 = fmaf(pa[j], pa[j], ss0); ss1 = fmaf(pb[j], pb[j], ss1); }
          r0 = rsqrtf(wave_sum_v(ss0) * (1.0f / D) + 1e-6f); r1 = rsqrtf(wave_sum_v(ss1) * (1.0f / D) + 1e-6f); }
        float acc[2][36];
#pragma unroll
        for (int u = 0; u < 2; ++u)
#pragma unroll
            for (int q = 0; q < 36; ++q) acc[u][q] = 0.f;
#pragma unroll 1
        for (int j0 = 0; j0 < 16; j0 += 4) {
            float xa[4], xb[4], gv[4], sv[4];
#pragma unroll
            for (int jj = 0; jj < 4; ++jj) { const int c = lane + 64 * (j0 + jj); xa[jj] = xr0[c]; xb[jj] = xr0[D + c]; gv[jj] = n2g[c] * (1.0f + mod[4 * D + c]); sv[jj] = mod[3 * D + c]; }
#pragma unroll
            for (int jj = 0; jj < 4; ++jj) {
                const int c = lane + 64 * (j0 + jj);
                const float a0 = xa[jj] * r0 * gv[jj] + sv[jj], a1 = xb[jj] * r1 * gv[jj] + sv[jj];
                hr0[c] = (bf16)f2bf(a0); hr0[D + c] = (bf16)f2bf(a1);
                const LAS unsigned char* rowp = lds + c * 128;
                { const f32x4 w = *(const LAS f32x4*)(lds + 131072 + c * 16);
#pragma unroll
                  for (int q = 0; q < 4; ++q) { acc[0][q] = fmaf(a0, w[q], acc[0][q]); acc[1][q] = fmaf(a1, w[q], acc[1][q]); } }
#pragma unroll
                for (int i = 0; i < 8; ++i) { const f32x4 w = *(const LAS f32x4*)(rowp + 16 * (i ^ sw));
#pragma unroll
                    for (int q = 0; q < 4; ++q) { acc[0][4 + 4 * i + q] = fmaf(a0, w[q], acc[0][4 + 4 * i + q]); acc[1][4 + 4 * i + q] = fmaf(a1, w[q], acc[1][4 + 4 * i + q]); } }
            }
        }
#pragma unroll
        for (int u = 0; u < 2; ++u) {
            float lg[36];
#pragma unroll
            for (int q = 0; q < 36; ++q) { lg[q] = wave_sum_v(acc[u][q]); if ((q & 3) == 3) __builtin_amdgcn_sched_barrier(0); }
            unsigned bqo = 147456u + 128u; asm volatile("" : "+v"(bqo));
#pragma unroll
            for (int q = 0; q < 36; ++q) lg[q] += *(const LAS float*)(lds + bqo + 4 * q);
            int gi = 0; float gm = lg[0];
#pragma unroll
            for (int q = 1; q < 4; ++q) if (lg[q] > gm) { gm = lg[q]; gi = q; }
            float gsum = 0.f;
#pragma unroll
            for (int q = 0; q < 4; ++q) gsum += expf(lg[q] - gm);
            const float gp = 1.0f / gsum;
            float el[8];
#pragma unroll
            for (int q = 0; q < 8; ++q) el[q] = gi == 0 ? lg[4 + q] : gi == 1 ? lg[12 + q] : gi == 2 ? lg[20 + q] : lg[28 + q];
            int i0 = 0; float m0 = el[0];
#pragma unroll
            for (int q = 1; q < 8; ++q) if (el[q] > m0) { m0 = el[q]; i0 = q; }
            int i1 = -1; float m1 = -3.0e38f;
#pragma unroll
            for (int q = 0; q < 8; ++q) if (q != i0 && el[q] > m1) { m1 = el[q]; i1 = q; }
            const float p1 = expf(m1 - m0);
            const float w0 = gp / (1.0f + p1), w1 = gp * p1 / (1.0f + p1);
            if (lane == 0) { const int t = t0 + u, e0 = gi * 8 + i0, e1 = gi * 8 + i1;
                int* toke = (int*)(p.ws + T_TOKE); float* tokw = (float*)(p.ws + T_TOKW);
                toke[t * 2] = e0; toke[t * 2 + 1] = e1; tokw[t * 2] = w0; tokw[t * 2 + 1] = w1;
                __hip_atomic_fetch_add(&hist[e0], 1, __ATOMIC_RELAXED, __HIP_MEMORY_SCOPE_WORKGROUP); __hip_atomic_fetch_add(&hist[e1], 1, __ATOMIC_RELAXED, __HIP_MEMORY_SCOPE_WORKGROUP); }
        }
    }
    __syncthreads();
    if (tid < 32) ((int*)(p.ws + T_HIST))[bid * 32 + tid] = hist[tid];
    __syncthreads();
}
__device__ __forceinline__ void p8_place(PRef p, LAS unsigned char* lds, int bid) {
    const int tid = otid(), lane = tid & 63, wave = __builtin_amdgcn_readfirstlane(tid >> 6);
    LAS int* ptot = (LAS int*)lds;
    LAS int* pbef = ptot + 512;
    LAS int* base = pbef + 512;
    LAS int* lcur = base + 32;
    LAS int* posl = lcur + 32;
    LAS int* padb = posl + 256;
    const int* hist = (const int*)(p.ws + T_HIST);
    { const int e = tid & 31, part = tid >> 5; int tot = 0, bef = 0;
#pragma unroll 4
      for (int w = part * 16; w < part * 16 + 16; ++w) { const int c = hist[w * 32 + e]; tot += c; bef += (w < bid) ? c : 0; }
      ptot[part * 32 + e] = tot; pbef[part * 32 + e] = bef; }
    __syncthreads();
    if (tid < 32) { int tot = 0, bef = 0;
#pragma unroll
        for (int k = 0; k < 16; ++k) { tot += ptot[k * 32 + tid]; bef += pbef[k * 32 + tid]; }
        ptot[tid] = tot; pbef[tid] = bef; lcur[tid] = 0; }
    __syncthreads();
    if (tid == 0) { int row = 0;
        for (int e = 0; e < NE; ++e) { const int cnt = ptot[e], nt = (cnt + 255) >> 8; base[e] = row + pbef[e]; padb[e] = row + cnt; padb[32 + e] = row + nt * 256;
            if (bid == 0) { int* te = (int*)(p.ws + T_TILEE); for (int k = 0; k < nt; ++k) te[(row >> 8) + k] = e; }
            row += nt * 256; }
        if (bid == 0) *(int*)(p.ws + T_NT) = row >> 8; }
    __syncthreads();
    int* rowaid = (int*)(p.ws + T_ROWAID); float* roww = (float*)(p.ws + T_ROWW);
    if (tid < 256) { const int a = bid * 256 + tid; const int e = ((const int*)(p.ws + T_TOKE))[a];
        const int pos = base[e] + __hip_atomic_fetch_add(&lcur[e], 1, __ATOMIC_RELAXED, __HIP_MEMORY_SCOPE_WORKGROUP);
        posl[tid] = pos; rowaid[pos] = a; roww[pos] = ((const float*)(p.ws + T_TOKW))[a]; }
    if (bid < NE) for (int r = padb[bid] + tid; r < padb[32 + bid]; r += NTHR) { rowaid[r] = -1; roww[r] = 0.f; }
    __syncthreads();
    __syncthreads();
}
template <bool GATHER_>
struct MoeOrder {
    static constexpr bool GATHER = GATHER_;
    const int* tile_e; const int* rowaid; int nM, G, c;
    __device__ __forceinline__ int rowsrc(int row) const { const int a = rowaid[row]; return (a < 0 ? 0 : a) >> 1; }
    __device__ __forceinline__ bool next(int i, pg8::Unit& u) const {
        const int nwg = nM * 4; const long L = (long)i * G + c; if (L >= nwg) return false;
        int wgid = (int)L; { const int q = nwg / 8, r = nwg % 8, xcd = wgid % 8, off = wgid / 8; wgid = (xcd < r ? xcd * (q + 1) : r * (q + 1) + (xcd - r) * q) + off; }
        const int nig = 8 * 4, gid = wgid / nig, fm = gid * 8, gsz = (nM - fm) < 8 ? (nM - fm) : 8;
        u.pm = fm + ((wgid % nig) % gsz); u.pn = (wgid % nig) / gsz; u.pb = tile_e[u.pm] * 4 + u.pn; return true;
    }
    __device__ __forceinline__ void a_ready(const pg8::Unit&) const {}
    __device__ __forceinline__ void done(const pg8::Unit&) const {}
};
__device__ __forceinline__ float silu_fast(float x) { return x * __builtin_amdgcn_rcpf(1.0f + __builtin_amdgcn_exp2f(-1.4426950409f * x)); }
struct EpiH {
    static constexpr bool PERM = true, AFTER_DRAIN = false;
    bf16* H;
    __device__ __forceinline__ void operator()(const f32x4 (&acc)[2][2][4][2], const pg8::Unit& u, int wr, int wc, int fr, int fq) const {
        const int row0 = u.pm * 256 + wr * 64 + fr, col0 = u.pn * 128 + wc * 32 + 8 * fq;
#pragma unroll
        for (int ai = 0; ai < 2; ++ai)
#pragma unroll
            for (int m = 0; m < 4; ++m) { const f32x4 g0 = acc[ai][0][m][0], g1 = acc[ai][0][m][1], u0 = acc[ai][1][m][0], u1 = acc[ai][1][m][1];
                f32x4 h0, h1;
#pragma unroll
                for (int q = 0; q < 4; ++q) { h0[q] = silu_fast(g0[q]) * u0[q]; h1[q] = silu_fast(g1[q]) * u1[q]; }
                u32x4 w; w.x = pg8::cvt_pk_bf16(h0[0], h0[1]); w.y = pg8::cvt_pk_bf16(h0[2], h0[3]); w.z = pg8::cvt_pk_bf16(h1[0], h1[1]); w.w = pg8::cvt_pk_bf16(h1[2], h1[3]);
                *(u32x4*)(H + (size_t)(row0 + ai * 128 + m * 16) * EH + col0) = w; }
    }
};
struct EpiY {
    static constexpr bool PERM = true, AFTER_DRAIN = false;
    bf16* YB; const int* rowaid; const float* roww;
    __device__ __forceinline__ void operator()(const f32x4 (&acc)[2][2][4][2], const pg8::Unit& u, int wr, int wc, int fr, int fq) const {
        const int row0 = u.pm * 256 + wr * 64 + fr, col0 = u.pn * 256 + wc * 32 + 8 * fq;
#pragma unroll
        for (int ai = 0; ai < 2; ++ai)
#pragma unroll
            for (int m = 0; m < 4; ++m) { const int row = row0 + ai * 128 + m * 16; const int a = rowaid[row]; const float w = roww[row];
                if (a >= 0) {
#pragma unroll
                    for (int bj = 0; bj < 2; ++bj) { const f32x4 v0 = acc[ai][bj][m][0] * w, v1 = acc[ai][bj][m][1] * w;
                        u32x4 o; o.x = pg8::cvt_pk_bf16(v0[0], v0[1]); o.y = pg8::cvt_pk_bf16(v0[2], v0[3]); o.z = pg8::cvt_pk_bf16(v1[0], v1[1]); o.w = pg8::cvt_pk_bf16(v1[2], v1[3]);
                        *(u32x4*)(YB + (size_t)a * D + col0 + bj * 128) = o; } } }
    }
};
__device__ __forceinline__ void p11_final(PRef p, int bid, int nb) {
    const int tid_ = otid(), lane = tid_ & 63, wv = tid_ >> 6;
    const float* mod = (const float*)(p.ws + W_MOD); const bf16* YB = (const bf16*)p.out; const bf16* X1 = (const bf16*)(p.ws + W_X1B); float* out = p.out; const float* g = p.in[I_FNG];
#pragma unroll 1
    for (int row = bid * 8 + wv; row < NTOK; row += nb * 8) {
        const float* gt = mod + (row / SEQ) * 6 * D + 5 * D;
        f32x4 v[4]; float s = 0.f;
#pragma unroll
        for (int j = 0; j < 4; ++j) { const int c0 = (lane + 64 * j) * 4;
            const u32x2 xw = *(const u32x2*)(X1 + (size_t)row * D + c0); const f32x4 xv = {bflo(xw.x), bfhi(xw.x), bflo(xw.y), bfhi(xw.y)}, gv = *(const f32x4*)(gt + c0);
            const u32x2 a = *(const u32x2*)(YB + (size_t)(2 * row) * D + c0), b = *(const u32x2*)(YB + (size_t)(2 * row + 1) * D + c0);
            const f32x4 y = {bflo(a.x) + bflo(b.x), bfhi(a.x) + bfhi(b.x), bflo(a.y) + bflo(b.y), bfhi(a.y) + bfhi(b.y)};
            v[j] = xv + gv * y; s += (v[j][0] * v[j][0] + v[j][1] * v[j][1]) + (v[j][2] * v[j][2] + v[j][3] * v[j][3]); }
        const float r = rsqrtf(wave_sum_dpp(s) * (1.0f / D) + 1e-6f);
#pragma unroll
        for (int j = 0; j < 4; ++j) { const int c0 = (lane + 64 * j) * 4; *(f32x4*)(out + (size_t)row * D + c0) = v[j] * r * *(const f32x4*)(g + c0); }
    }
}
constexpr int PM_PB = 144, PM_MAT = 64 * PM_PB;
enum { PM_AT = 0, PM_RT, PM_BT, PM_KT, PM_VT, PM_BPT, PM_KPT, PM_AAK, PM_ARB, PM_ARK, PM_W1T, PM_U2T, PM_NMAT };
constexpr int PM_AAB = PM_NMAT * PM_MAT, PM_P = PM_AAB + 16384, PM_TOT = PM_P + 16384, PM_G = PM_TOT + 2048, PM_END = PM_G + 256;
static_assert(PM_END <= LDS_BYTES, "pass-A LDS map");
struct PmRaw { float zr[9], zk[9], zv[9], lw[8], as[8]; };
__device__ __forceinline__ void p5m_load(PRef p, PmRaw& R, int q, int wave, int lane) {
    const int seq = q / NCH, c = q % NCH, b = seq >> 3, h = seq & 7, tg = b * SEQ + c * SCL + wave * 8, hc = h * 64 + lane;
    const bf16* Z = (const bf16*)(p.ws + W_Z); const bf16* LO = (const bf16*)(p.ws + W_LO);
    const bool has_prev = !(wave == 0 && c == 0);
    const bf16* zp0 = Z + (size_t)(tg - 1) * ZLD + 1024 + hc;
    R.zr[0] = has_prev ? bf2f(zp0[0]) : 0.f; R.zk[0] = has_prev ? bf2f(zp0[512]) : 0.f; R.zv[0] = has_prev ? bf2f(zp0[1024]) : 0.f;
#pragma unroll
    for (int s = 0; s < 8; ++s) { const bf16* zp = Z + (size_t)(tg + s) * ZLD + 1024 + hc; const bf16* lp = LO + (size_t)(tg + s) * 1536 + hc;
        R.zr[s + 1] = bf2f(zp[0]); R.zk[s + 1] = bf2f(zp[512]); R.zv[s + 1] = bf2f(zp[1024]); R.lw[s] = bf2f(lp[0]); R.as[s] = bf2f(lp[512]); }
}
#define PM_BAR() do { asm volatile("s_waitcnt lgkmcnt(0)" ::: "memory"); __builtin_amdgcn_s_barrier(); asm volatile("" ::: "memory"); } while (0)
__device__ __forceinline__ void p5m_chunk(PRef p, LAS unsigned char* lds, int q, int qnext, PmRaw& R) {
    typedef short bf16x8 __attribute__((ext_vector_type(8)));
    const int tid = otid(), lane = tid & 63, wave = __builtin_amdgcn_readfirstlane(tid >> 6), fr = lane & 15, fq = lane >> 4;
    const int seq = q / NCH, c = q % NCH, b = seq >> 3, h = seq & 7, tb = b * SEQ + c * SCL, hc = h * 64 + lane;
#define PMAT(i) (lds + (i) * PM_MAT)
#define PFRAG(mat, row, ks) (*(const LAS bf16x8*)((mat) + (row) * PM_PB + ((ks) * 32 + fq * 8) * 2))
#ifndef PM_DUP
#define PM_DUP 0
#endif
#pragma unroll 1
    for (int d0 = 0; d0 < ((PM_DUP >> 3) & 1) + 1; ++d0) { if (d0) PM_BAR();
        const int t8 = wave * 8, tg = tb + t8;
        float (&zr)[9] = R.zr; float (&zk)[9] = R.zk; float (&zv)[9] = R.zv; float (&lw)[8] = R.lw; float (&as)[8] = R.as;
        float cl[8]; { float run = 0.f;
#pragma unroll
          for (int s = 0; s < 8; ++s) { run += lw[s]; cl[s] = run; } }
        *(LAS float*)(lds + PM_TOT + (wave * 64 + lane) * 4) = cl[7];
        PM_BAR();
        float off = 0.f, lcL = 0.f;
#pragma unroll
        for (int w = 0; w < 8; ++w) { const float tv = *(const LAS float*)(lds + PM_TOT + (w * 64 + lane) * 4); lcL += tv; off += (w < wave) ? tv : 0.f; }
        if (wave == 0) *(LAS float*)(lds + PM_G + lane * 4) = __builtin_amdgcn_exp2f(1.4426950409f * lcL);
        const float mur = p.in[I_MU][hc], muk = p.in[I_MU][512 + hc], muv = p.in[I_MU][1024 + hc];
        const float kkc = p.in[I_KK][hc], kac = p.in[I_KA][hc], rkc = p.in[I_RK][hc];
        bf16* VLo = (bf16*)(p.ws + W_YCAT); float* RKo = (float*)(p.ws + T_RK);
        unsigned pv[4], pbp[4], pkp[4];
#pragma unroll
        for (int s = 0; s < 8; ++s) {
            const float r = zr[s + 1] + (zr[s] - zr[s + 1]) * mur, k = zk[s + 1] + (zk[s] - zk[s + 1]) * muk, v = zv[s + 1] + (zv[s] - zv[s + 1]) * muv;
            const float kkv = k * kkc;
            const float kk = kkv * rsqrtf(fmaxf(wave_sum_dpp(kkv * kkv), 1e-24f));
            const float k2 = k * (1.0f + (as[s] - 1.0f) * kac);
            const float rk = wave_sum_dpp(r * k2 * rkc);
            const float bb = kk * as[s];
            const float lc = off + cl[s], lcp = lc - lw[s];
            const float e_lc = __builtin_amdgcn_exp2f(1.4426950409f * lc), e_lcp = __builtin_amdgcn_exp2f(1.4426950409f * lcp);
            const float e_nlc = __builtin_amdgcn_exp2f(-1.4426950409f * lc), e_l = __builtin_amdgcn_exp2f(1.4426950409f * (lcL - lc));
            const int t = t8 + s;
            *(LAS bf16*)(PMAT(PM_AT) + t * PM_PB + lane * 2) = (bf16)f2bf(-kk * e_lcp);
            *(LAS bf16*)(PMAT(PM_RT) + t * PM_PB + lane * 2) = (bf16)f2bf(r * e_lc);
            *(LAS bf16*)(PMAT(PM_BT) + t * PM_PB + lane * 2) = (bf16)f2bf(bb * e_nlc);
            *(LAS bf16*)(PMAT(PM_KT) + t * PM_PB + lane * 2) = (bf16)f2bf(k2 * e_nlc);
            const unsigned vb = f2bf(v), bpb = f2bf(bb * e_l), kpb = f2bf(k2 * e_l);
            if (s & 1) { pv[s >> 1] |= vb << 16; pbp[s >> 1] |= bpb << 16; pkp[s >> 1] |= kpb << 16; } else { pv[s >> 1] = vb; pbp[s >> 1] = bpb; pkp[s >> 1] = kpb; }
            VLo[(unsigned)((tg + s) * 1024 + 512 + hc)] = (bf16)vb;
            if (lane == 0) RKo[(unsigned)((tg + s) * 8 + h)] = rk;
        }
        *(LAS u32x4*)(PMAT(PM_VT) + lane * PM_PB + wave * 16) = (u32x4){pv[0], pv[1], pv[2], pv[3]};
        *(LAS u32x4*)(PMAT(PM_BPT) + lane * PM_PB + wave * 16) = (u32x4){pbp[0], pbp[1], pbp[2], pbp[3]};
        *(LAS u32x4*)(PMAT(PM_KPT) + lane * PM_PB + wave * 16) = (u32x4){pkp[0], pkp[1], pkp[2], pkp[3]};
    }
    if (qnext >= 0) p5m_load(p, R, qnext, wave, lane);
    PM_BAR();
#pragma unroll 1
    for (int d1 = 0; d1 < ((PM_DUP >> 0) & 1) + 1; ++d1) {
        const int pp = wave >> 1, half = wave & 1;
        const LAS unsigned char* Xm = PMAT(pp < 2 ? PM_AT : PM_RT);
        const LAS unsigned char* Ym = PMAT((pp & 1) ? PM_KT : PM_BT);
#pragma unroll
        for (int ti = 0; ti < 2; ++ti) {
            const int tt = half ? (1 + ti) : (3 * ti);
            const bf16x8 xb0 = PFRAG(Xm, tt * 16 + fr, 0), xb1 = PFRAG(Xm, tt * 16 + fr, 1);
            const int t = tt * 16 + fr;
#pragma unroll
            for (int jt = 0; jt < 4; ++jt) {
                f32x4 acc = {0.f, 0.f, 0.f, 0.f};
                if (jt <= tt) { acc = __builtin_amdgcn_mfma_f32_16x16x32_bf16(PFRAG(Ym, jt * 16 + fr, 0), xb0, acc, 0, 0, 0);
                                acc = __builtin_amdgcn_mfma_f32_16x16x32_bf16(PFRAG(Ym, jt * 16 + fr, 1), xb1, acc, 0, 0, 0); }
                const int j0 = jt * 16 + 4 * fq;
#pragma unroll
                for (int rg = 0; rg < 4; ++rg) { const bool keep = (pp < 2) ? (j0 + rg < t) : (j0 + rg <= t); acc[rg] = keep ? acc[rg] : 0.f; }
                if (pp == 0) {
#pragma unroll
                    for (int rg = 0; rg < 4; ++rg) *(LAS float*)(lds + PM_AAB + (t * 64 + rg * 16 + jt * 4 + fq) * 4) = acc[rg];
                } else {
                    u32x2 w; w.x = pk2(acc[0], acc[1]); w.y = pk2(acc[2], acc[3]);
                    *(LAS u32x2*)(PMAT(PM_AAK + pp - 1) + t * PM_PB + j0 * 2) = w;
                }
            }
        }
    }
    PM_BAR();
#pragma unroll 1
    for (int d2 = 0; d2 < ((PM_DUP >> 1) & 1) + 1; ++d2) {
        const bool isw1 = wave < 4;
        const int colb = (wave & 3) * 16, cl = lane >> 2, part = lane & 3, col = colb + cl;
        if (!isw1) {
            const bf16x8 vb0 = PFRAG(PMAT(PM_VT), colb + fr, 0), vb1 = PFRAG(PMAT(PM_VT), colb + fr, 1);
#pragma unroll
            for (int tt = 0; tt < 4; ++tt) { f32x4 acc = {0.f, 0.f, 0.f, 0.f};
                acc = __builtin_amdgcn_mfma_f32_16x16x32_bf16(PFRAG(PMAT(PM_AAK), tt * 16 + fr, 0), vb0, acc, 0, 0, 0);
                acc = __builtin_amdgcn_mfma_f32_16x16x32_bf16(PFRAG(PMAT(PM_AAK), tt * 16 + fr, 1), vb1, acc, 0, 0, 0);
#pragma unroll
                for (int rg = 0; rg < 4; ++rg) *(LAS float*)(lds + PM_P + ((tt * 16 + 4 * fq + rg) * 64 + colb + fr) * 4) = acc[rg]; }
            asm volatile("s_waitcnt lgkmcnt(0)" ::: "memory");
        }
        float X[16];
#pragma unroll
        for (int jj = 0; jj < 16; ++jj) X[jj] = 0.f;
        const LAS unsigned char* arow = lds + PM_AAB + part * 64;
#define PM_LOADBLK(g, rh, a4, cf) do { \
            _Pragma("unroll") for (int r = 0; r < 4; ++r) { const int t = 4 * (g) + r; \
                rh[r] = isw1 ? bf2f(*(const LAS bf16*)(PMAT(PM_AT) + t * PM_PB + col * 2)) : *(const LAS float*)(lds + PM_P + (t * 64 + col) * 4); \
                _Pragma("unroll") for (int m = 0; m < 4; ++m) if (m * 4 < (g)) a4[r][m] = *(const LAS f32x4*)(arow + t * 256 + m * 16); } \
            { const LAS unsigned char* cb = lds + PM_AAB + (g) * 4; \
              cf[0] = *(const LAS float*)(cb + (4 * (g) + 1) * 256); cf[1] = *(const LAS float*)(cb + (4 * (g) + 2) * 256); cf[2] = *(const LAS float*)(cb + (4 * (g) + 2) * 256 + 64); \
              cf[3] = *(const LAS float*)(cb + (4 * (g) + 3) * 256); cf[4] = *(const LAS float*)(cb + (4 * (g) + 3) * 256 + 64); cf[5] = *(const LAS float*)(cb + (4 * (g) + 3) * 256 + 128); } } while (0)
#define PM_SOLVEBLK(g, rh, a4, cf) do { float sm[4]; \
            _Pragma("unroll") for (int r = 0; r < 4; ++r) { float s0 = 0.f, s1 = 0.f; \
                _Pragma("unroll") for (int m = 0; m < 4; ++m) if (m * 4 < (g)) { \
                    _Pragma("unroll") for (int i = 0; i < 4; ++i) if (m * 4 + i < (g)) { if (i & 1) s1 = fmaf(a4[r][m][i], X[m * 4 + i], s1); else s0 = fmaf(a4[r][m][i], X[m * 4 + i], s0); } } \
                sm[r] = s0 + s1; } \
            _Pragma("unroll") for (int r = 0; r < 4; ++r) { DPP_ADD(sm[r], 0xB1); DPP_ADD(sm[r], 0x4E); } \
            const float x0 = rh[0] + sm[0]; \
            const float x1 = fmaf(cf[0], x0, rh[1] + sm[1]); \
            const float x2 = fmaf(cf[2], x1, fmaf(cf[1], x0, rh[2] + sm[2])); \
            const float x3 = fmaf(cf[5], x2, fmaf(cf[4], x1, fmaf(cf[3], x0, rh[3] + sm[3]))); \
            X[g] = part == 0 ? x0 : part == 1 ? x1 : part == 2 ? x2 : x3; } while (0)
        { float rhA[4], cfA[6], rhB[4], cfB[6]; f32x4 aA[4][4], aB[4][4];
          PM_LOADBLK(0, rhA, aA, cfA);
#pragma unroll
          for (int g2 = 0; g2 < 16; g2 += 2) {
              PM_LOADBLK(g2 + 1, rhB, aB, cfB); __builtin_amdgcn_sched_barrier(0);
              PM_SOLVEBLK(g2, rhA, aA, cfA);
              if (g2 + 2 < 16) { PM_LOADBLK(g2 + 2, rhA, aA, cfA); } __builtin_amdgcn_sched_barrier(0);
              PM_SOLVEBLK(g2 + 1, rhB, aB, cfB);
          } }
#undef PM_LOADBLK
#undef PM_SOLVEBLK
        LAS unsigned char* om = PMAT(isw1 ? PM_W1T : PM_U2T) + col * PM_PB + part * 2;
#pragma unroll
        for (int jj = 0; jj < 16; ++jj) *(LAS bf16*)(om + jj * 8) = (bf16)f2bf(X[jj]);
    }
    PM_BAR();
#pragma unroll 1
    for (int d3 = 0; d3 < ((PM_DUP >> 2) & 1) + 1; ++d3) {
        float* Mo = (float*)((unsigned char*)p.out + O_M + (size_t)q * 16384); float* No = (float*)((unsigned char*)p.out + O_N + (size_t)q * 16384);
        bf16* Qo = (bf16*)(p.ws + W_Q); bf16* Y2o = (bf16*)(p.ws + W_Y2);
#pragma unroll
        for (int ti = 0; ti < 2; ++ti) {
            const int idx = wave * 2 + ti, rt = idx >> 2, ct = idx & 3;
            {
                f32x4 acc = {0.f, 0.f, 0.f, 0.f};
#pragma unroll
                for (int ks = 0; ks < 2; ++ks) acc = __builtin_amdgcn_mfma_f32_16x16x32_bf16(PFRAG(PMAT(PM_BPT), ct * 16 + fr, ks), PFRAG(PMAT(PM_W1T), rt * 16 + fr, ks), acc, 0, 0, 0);
                const int i = rt * 16 + fr, c0 = ct * 16 + 4 * fq;
#pragma unroll
                for (int rg = 0; rg < 4; ++rg) if (c0 + rg == i) acc[rg] += *(const LAS float*)(lds + PM_G + i * 4);
                *(f32x4*)(Mo + i * 64 + c0) = acc; }
            {
                f32x4 acc = {0.f, 0.f, 0.f, 0.f};
#pragma unroll
                for (int ks = 0; ks < 2; ++ks) { acc = __builtin_amdgcn_mfma_f32_16x16x32_bf16(PFRAG(PMAT(PM_BPT), ct * 16 + fr, ks), PFRAG(PMAT(PM_U2T), rt * 16 + fr, ks), acc, 0, 0, 0);
                                                  acc = __builtin_amdgcn_mfma_f32_16x16x32_bf16(PFRAG(PMAT(PM_KPT), ct * 16 + fr, ks), PFRAG(PMAT(PM_VT), rt * 16 + fr, ks), acc, 0, 0, 0); }
                *(f32x4*)(No + (rt * 16 + fr) * 64 + ct * 16 + 4 * fq) = acc; }
            {
                f32x4 acc = {0.f, 0.f, 0.f, 0.f};
#pragma unroll
                for (int ks = 0; ks < 2; ++ks) acc = __builtin_amdgcn_mfma_f32_16x16x32_bf16(PFRAG(PMAT(PM_W1T), ct * 16 + fr, ks), PFRAG(PMAT(PM_ARB), rt * 16 + fr, ks), acc, 0, 0, 0);
                const int t = rt * 16 + fr, i0 = ct * 16 + 4 * fq;
                const u32x2 rw = *(const LAS u32x2*)(PMAT(PM_RT) + t * PM_PB + i0 * 2);
                u32x2 o; o.x = pk2(acc[0] + bflo(rw.x), acc[1] + bfhi(rw.x)); o.y = pk2(acc[2] + bflo(rw.y), acc[3] + bfhi(rw.y));
                *(u32x2*)(Qo + (unsigned)((tb + t) * 512 + h * 64 + i0)) = o; }
            {
                f32x4 acc = {0.f, 0.f, 0.f, 0.f};
#pragma unroll
                for (int ks = 0; ks < 2; ++ks) { acc = __builtin_amdgcn_mfma_f32_16x16x32_bf16(PFRAG(PMAT(PM_U2T), ct * 16 + fr, ks), PFRAG(PMAT(PM_ARB), rt * 16 + fr, ks), acc, 0, 0, 0);
                                                  acc = __builtin_amdgcn_mfma_f32_16x16x32_bf16(PFRAG(PMAT(PM_VT), ct * 16 + fr, ks), PFRAG(PMAT(PM_ARK), rt * 16 + fr, ks), acc, 0, 0, 0); }
                const int t = rt * 16 + fr, v0 = ct * 16 + 4 * fq;
                u32x2 o; o.x = pk2(acc[0], acc[1]); o.y = pk2(acc[2], acc[3]);
                *(u32x2*)(Y2o + (unsigned)((tb + t) * 512 + h * 64 + v0)) = o; }
        }
    }
    PM_BAR();
#undef PMAT
#undef PFRAG
}

__device__ __forceinline__ void p5m_run(PRef p, LAS unsigned char* lds, int bid, int nb) {
    const int tid = otid(), lane = tid & 63, wave = __builtin_amdgcn_readfirstlane(tid >> 6);
    PmRaw R;
    if (bid < BATCH * 8 * NCH) p5m_load(p, R, bid, wave, lane);
#pragma unroll 1
    for (int q = bid; q < BATCH * 8 * NCH; q += nb) p5m_chunk(p, lds, q, (q + nb < BATCH * 8 * NCH) ? q + nb : -1, R);
}
constexpr int R7_WP = 1040, R7_WSZ = 48 * R7_WP, R7_AP = 144, R7_ASZ = 16 * R7_AP;
constexpr int R7_WAVE0 = 2 * R7_WSZ, R7_WAVESZ = 2 * R7_ASZ + 3072, R7_HIST = R7_WAVE0 + 8 * R7_WAVESZ;
static_assert(R7_HIST + 256 <= LDS_BYTES, "router LDS map");
__device__ __forceinline__ void p7m_route(PRef p, LAS unsigned char* lds, int bid) {
    typedef short bf16x8 __attribute__((ext_vector_type(8)));
    const int tid = otid(), lane = tid & 63, wave = __builtin_amdgcn_readfirstlane(tid >> 6), fr = lane & 15, fq = lane >> 4;
    const int tok = lane >> 2, sub = lane & 3;
    const bf16* x1 = (const bf16*)(p.ws + W_X1B); bf16* H2 = (bf16*)(p.ws + W_H2);
    LAS int* hist = (LAS int*)(lds + R7_HIST);
    const int b = (bid * TPW) / SEQ, t0 = bid * TPW + wave * 16;
    const float* mod = (const float*)(p.ws + W_MOD) + b * 6 * D;
    const float* n2g = p.in[I_N2G];
    LAS unsigned char* Ahi = lds + R7_WAVE0 + wave * R7_WAVESZ; LAS unsigned char* Alo = Ahi + R7_ASZ; LAS float* Lw = (LAS float*)(Alo + R7_ASZ);
    if (tid < 32) hist[tid] = 0;
    const bf16* xrow = x1 + (size_t)(t0 + tok) * D + sub * 16;
    float ss = 0.f;
#pragma unroll 1
    for (int s4 = 0; s4 < 16; s4 += 8) { u32x4 v[16];
#pragma unroll
        for (int s = 0; s < 8; ++s) { v[s * 2] = *(const u32x4*)(xrow + (s4 + s) * 64); v[s * 2 + 1] = *(const u32x4*)(xrow + (s4 + s) * 64 + 8); }
#pragma unroll
        for (int i = 0; i < 16; ++i)
#pragma unroll
            for (int q = 0; q < 4; ++q) { const float a = bflo(v[i][q]), bq = bfhi(v[i][q]); ss = fmaf(a, a, fmaf(bq, bq, ss)); } }
    DPP_ADD(ss, 0xB1); DPP_ADD(ss, 0x4E);
    const float r = rsqrtf(ss * (1.0f / D) + 1e-6f);
    f32x4 acc[3];
#pragma unroll
    for (int qt = 0; qt < 3; ++qt) acc[qt] = (f32x4){0.f, 0.f, 0.f, 0.f};
#pragma unroll 1
    for (int kh = 0; kh < 2; ++kh) {
        __syncthreads();
#pragma unroll 1
        for (int idx = tid; idx < 512 * 12; idx += NTHR) { const int cq = idx % 12, kl = idx / 12, k = kh * 512 + kl;
            f32x4 w = {0.f, 0.f, 0.f, 0.f};
            if (cq == 0) w = *(const f32x4*)(p.in[I_RGW] + k * 4); else if (cq < 9) w = *(const f32x4*)(p.in[I_REW] + k * 32 + (cq - 1) * 4);
#pragma unroll
            for (int i = 0; i < 4; ++i) { const unsigned hi = f2bf(w[i]); const unsigned lo = f2bf(w[i] - bflo(hi));
                *(LAS bf16*)(lds + (cq * 4 + i) * R7_WP + kl * 2) = (bf16)hi; *(LAS bf16*)(lds + R7_WSZ + (cq * 4 + i) * R7_WP + kl * 2) = (bf16)lo; } }
        __syncthreads();
#pragma unroll 1
        for (int sl = 0; sl < 8; ++sl) {
            const int k0 = kh * 512 + sl * 64 + sub * 16;
            f32x4 xv[4], gv[4], cv[4], sv[4];
            { const u32x4 xa = *(const u32x4*)(x1 + (size_t)(t0 + tok) * D + k0), xb = *(const u32x4*)(x1 + (size_t)(t0 + tok) * D + k0 + 8);
              xv[0] = (f32x4){bflo(xa.x), bfhi(xa.x), bflo(xa.y), bfhi(xa.y)}; xv[1] = (f32x4){bflo(xa.z), bfhi(xa.z), bflo(xa.w), bfhi(xa.w)};
              xv[2] = (f32x4){bflo(xb.x), bfhi(xb.x), bflo(xb.y), bfhi(xb.y)}; xv[3] = (f32x4){bflo(xb.z), bfhi(xb.z), bflo(xb.w), bfhi(xb.w)}; }
#pragma unroll
            for (int i = 0; i < 4; ++i) { gv[i] = *(const f32x4*)(n2g + k0 + i * 4); cv[i] = *(const f32x4*)(mod + 4 * D + k0 + i * 4); sv[i] = *(const f32x4*)(mod + 3 * D + k0 + i * 4); }
            unsigned hi[8], lo[8];
#pragma unroll
            for (int i = 0; i < 4; ++i)
#pragma unroll
                for (int j = 0; j < 4; j += 2) { const float h0 = xv[i][j] * r * gv[i][j] * (1.0f + cv[i][j]) + sv[i][j], h1 = xv[i][j + 1] * r * gv[i][j + 1] * (1.0f + cv[i][j + 1]) + sv[i][j + 1];
                    const unsigned a0 = f2bf(h0), a1 = f2bf(h1); hi[i * 2 + (j >> 1)] = a0 | (a1 << 16); lo[i * 2 + (j >> 1)] = f2bf(h0 - bflo(a0)) | (f2bf(h1 - bflo(a1)) << 16); }
            *(u32x4*)(H2 + (size_t)(t0 + tok) * D + k0) = (u32x4){hi[0], hi[1], hi[2], hi[3]}; *(u32x4*)(H2 + (size_t)(t0 + tok) * D + k0 + 8) = (u32x4){hi[4], hi[5], hi[6], hi[7]};
            *(LAS u32x4*)(Ahi + tok * R7_AP + sub * 32) = (u32x4){hi[0], hi[1], hi[2], hi[3]}; *(LAS u32x4*)(Ahi + tok * R7_AP + sub * 32 + 16) = (u32x4){hi[4], hi[5], hi[6], hi[7]};
            *(LAS u32x4*)(Alo + tok * R7_AP + sub * 32) = (u32x4){lo[0], lo[1], lo[2], lo[3]}; *(LAS u32x4*)(Alo + tok * R7_AP + sub * 32 + 16) = (u32x4){lo[4], lo[5], lo[6], lo[7]};
            asm volatile("s_waitcnt lgkmcnt(0)" ::: "memory");
#pragma unroll
            for (int ks = 0; ks < 2; ++ks) {
                const bf16x8 ah = *(const LAS bf16x8*)(Ahi + fr * R7_AP + (ks * 32 + fq * 8) * 2), al = *(const LAS bf16x8*)(Alo + fr * R7_AP + (ks * 32 + fq * 8) * 2);
#pragma unroll
                for (int qt = 0; qt < 3; ++qt) { const int wo = (qt * 16 + fr) * R7_WP + (sl * 64 + ks * 32 + fq * 8) * 2;
                    const bf16x8 bh = *(const LAS bf16x8*)(lds + wo), bl = *(const LAS bf16x8*)(lds + R7_WSZ + wo);
                    acc[qt] = __builtin_amdgcn_mfma_f32_16x16x32_bf16(ah, bh, acc[qt], 0, 0, 0);
                    acc[qt] = __builtin_amdgcn_mfma_f32_16x16x32_bf16(al, bh, acc[qt], 0, 0, 0);
                    acc[qt] = __builtin_amdgcn_mfma_f32_16x16x32_bf16(ah, bl, acc[qt], 0, 0, 0); } }
            asm volatile("s_waitcnt lgkmcnt(0)" ::: "memory");
        }
    }
#pragma unroll
    for (int qt = 0; qt < 3; ++qt)
#pragma unroll
        for (int rg = 0; rg < 4; ++rg) Lw[(4 * fq + rg) * 48 + qt * 16 + fr] = acc[qt][rg];
    asm volatile("s_waitcnt lgkmcnt(0)" ::: "memory");
    if (lane < 16) {
        const LAS float* lg = Lw + lane * 48;
        int gi = 0; float gm = lg[0] + p.in[I_RGB][0];
#pragma unroll
        for (int q = 1; q < 4; ++q) { const float v = lg[q] + p.in[I_RGB][q]; if (v > gm) { gm = v; gi = q; } }
        float gsum = 0.f;
#pragma unroll
        for (int q = 0; q < 4; ++q) gsum += expf(lg[q] + p.in[I_RGB][q] - gm);
        const float gp = 1.0f / gsum;
        const LAS float* el = lg + 4 + gi * 8; const float* eb = p.in[I_REB] + gi * 8;
        int i0 = 0; float m0 = el[0] + eb[0];
#pragma unroll
        for (int q = 1; q < 8; ++q) { const float v = el[q] + eb[q]; if (v > m0) { m0 = v; i0 = q; } }
        int i1 = -1; float m1 = -3.0e38f;
#pragma unroll
        for (int q = 0; q < 8; ++q) { const float v = el[q] + eb[q]; if (q != i0 && v > m1) { m1 = v; i1 = q; } }
        const float p1 = expf(m1 - m0);
        const float w0 = gp / (1.0f + p1), w1 = gp * p1 / (1.0f + p1);
        const int t = t0 + lane, e0 = gi * 8 + i0, e1 = gi * 8 + i1;
        int* toke = (int*)(p.ws + T_TOKE); float* tokw = (float*)(p.ws + T_TOKW);
        toke[t * 2] = e0; toke[t * 2 + 1] = e1; tokw[t * 2] = w0; tokw[t * 2 + 1] = w1;
        __hip_atomic_fetch_add(&hist[e0], 1, __ATOMIC_RELAXED, __HIP_MEMORY_SCOPE_WORKGROUP); __hip_atomic_fetch_add(&hist[e1], 1, __ATOMIC_RELAXED, __HIP_MEMORY_SCOPE_WORKGROUP);
    }
    __syncthreads();
    if (tid < 32) ((int*)(p.ws + T_HIST))[bid * 32 + tid] = hist[tid];
    __syncthreads();
}
constexpr int PB_PITCH = 68;
constexpr int PB_ML = 0, PB_SL = 64 * PB_PITCH * 4, PB_NL = PB_SL + 16 * PB_PITCH * 4, PB_IMG = PB_NL + 16 * PB_PITCH * 4;
__device__ __forceinline__ void p5b_chain_mfma(PRef p, LAS unsigned char* lds, int item) {
    const int tid = otid(), lane = tid & 63, wave = __builtin_amdgcn_readfirstlane(tid >> 6), fr = lane & 15, fq = lane >> 4;
    const int seq = (item & 7) + 8 * (item >> 5), rg = (item >> 3) & 3;
    const bool mm = wave < 4; const int ct = wave & 3, t2 = tid & 255, nrow = t2 >> 4, ncol = (t2 & 15) * 4;
    const unsigned char* Mb = (const unsigned char*)p.out + O_M + (size_t)seq * NCH * 16384;
    const unsigned char* Nb = (const unsigned char*)p.out + O_N + (size_t)seq * NCH * 16384 + (size_t)((rg * 16 + nrow) * 64 + ncol) * 4;
    unsigned char* Sb = p.ws + W_S + (size_t)seq * NCH * 16384 + (size_t)((rg * 16 + nrow) * 64 + ncol) * 4;
    const int mrow = tid >> 4, mcol = (tid & 15) * 4;
    f32x4 acc = {0.f, 0.f, 0.f, 0.f};
    f32x4 m0[2], m1[2], m2[2], m3[2], n0, n1, n2, n3;
#define PBM_LOAD(mmr, nn, cc) do { const f32x4* mp = (const f32x4*)(Mb + (size_t)(cc) * 16384) + tid; mmr[0] = mp[0]; mmr[1] = mp[512]; if (!mm) nn = *(const f32x4*)(Nb + (size_t)(cc) * 16384); } while (0)
#define PBM_STEP(mmr, nn, cc) do { \
        LAS unsigned char* img = lds + ((cc) & 1) * PB_IMG; \
        *(LAS f32x4*)(img + PB_ML + (mrow * PB_PITCH + mcol) * 4) = mmr[0]; *(LAS f32x4*)(img + PB_ML + ((mrow + 32) * PB_PITCH + mcol) * 4) = mmr[1]; \
        if (mm) { _Pragma("unroll") for (int rg_ = 0; rg_ < 4; ++rg_) *(LAS float*)(img + PB_SL + ((4 * fq + rg_) * PB_PITCH + ct * 16 + fr) * 4) = acc[rg_]; } \
        else *(LAS f32x4*)(img + PB_NL + (nrow * PB_PITCH + ncol) * 4) = nn; \
        asm volatile("s_waitcnt lgkmcnt(0)" ::: "memory"); __builtin_amdgcn_s_barrier(); asm volatile("" ::: "memory"); \
        if ((cc) + 4 < NCH) PBM_LOAD(mmr, nn, (cc) + 4); \
        if (mm) { \
            _Pragma("unroll") for (int rg_ = 0; rg_ < 4; ++rg_) acc[rg_] = *(const LAS float*)(img + PB_NL + ((4 * fq + rg_) * PB_PITCH + ct * 16 + fr) * 4); \
            _Pragma("unroll") for (int ks = 0; ks < 16; ++ks) { \
                const float a_ = *(const LAS float*)(img + PB_SL + (fr * PB_PITCH + ks * 4 + fq) * 4), b_ = *(const LAS float*)(img + PB_ML + ((ks * 4 + fq) * PB_PITCH + ct * 16 + fr) * 4); \
                acc = __builtin_amdgcn_mfma_f32_16x16x4f32(a_, b_, acc, 0, 0, 0); } \
        } else { const f32x4 sv = *(const LAS f32x4*)(img + PB_SL + (nrow * PB_PITCH + ncol) * 4); *(f32x4*)(Sb + (size_t)(cc) * 16384) = sv; } \
    } while (0)
    __syncthreads();
    PBM_LOAD(m0, n0, 0); PBM_LOAD(m1, n1, 1); PBM_LOAD(m2, n2, 2); PBM_LOAD(m3, n3, 3);
#pragma unroll 1
    for (int c = 0; c < NCH; c += 4) { PBM_STEP(m0, n0, c); PBM_STEP(m1, n1, c + 1); PBM_STEP(m2, n2, c + 2); PBM_STEP(m3, n3, c + 3); }
    __syncthreads();
#undef PBM_LOAD
#undef PBM_STEP
}
__global__ void __launch_bounds__(NTHR, 2) k_mega(Params p_unused) {
    extern __shared__ __attribute__((aligned(16))) unsigned char lds_raw[];
    PPtr kp = (PPtr)__builtin_amdgcn_kernarg_segment_ptr();
#define p (*opq(kp))
    cg::grid_group grid = cg::this_grid();
    const int bid = blockIdx.x, nb = gridDim.x;
    LAS unsigned char* lds = (LAS unsigned char*)lds_raw;
    volatile LAS unsigned* bst = (volatile LAS unsigned*)(lds + LDS_BYTES - 64);
    if (otid() < 2) bst[otid()] = 0u;
    __syncthreads();
    XcdBarrier xb = xcd_barrier_post((unsigned*)(p.ws + T_BAR), bst);
#define GSYNC() xcd_barrier(xb)
    p0_prep<true>(p, lds, bid, nb); grid.sync();
    p1_h1(p, bid, nb); if (bid < BATCH) p1_bq(p, (LAS float*)lds, bid); GSYNC();
    { pg8::Gemm g{(const pg8::bf16_t*)(p.ws + W_H1), (const pg8::bf16_t*)(p.ws + W_WINT), NTOK, ZLD, D}; pg8::StaticOrder S; S.init(NTOK, ZLD, nb, bid);
      EpiZ E{(bf16*)(p.ws + W_Z)};
      pg8::gemm_phase<EpiZ, pg8::StaticOrder, true, true>(lds, g, S, E); }
    GSYNC();
#pragma unroll 1
    for (int ch = bid; ch < NTOK / CHUNK; ch += nb) p3_gmlp_unit(p, lds, ch);
    p3_lorain(p, bid, nb);
    GSYNC();
    { int kop = 256; asm volatile("" : "+s"(kop));
      pg8::Gemm g{(const pg8::bf16_t*)(p.ws + W_A2), (const pg8::bf16_t*)(p.ws + W_LORAT), NTOK, 1536, kop}; pg8::StaticOrder S; S.init(NTOK, 1536, nb, bid);
      EpiLO E{(bf16*)(p.ws + W_LO), p.in[I_W0], p.in[I_A0]};
      pg8::gemm_phase<EpiLO, pg8::StaticOrder, true, true>(lds, g, S, E); }
    GSYNC();
    p5m_run(p, lds, bid, nb);
    GSYNC();
#pragma unroll 1
    for (int it = bid; it < BATCH * 8 * 4; it += nb) p5b_chain_mfma(p, lds, it);
    GSYNC();
#pragma unroll 1
    for (int q = bid * 8 + __builtin_amdgcn_readfirstlane(otid() >> 6); q < BATCH * 8 * NCH; q += nb * 8) p5c_chunk(p, q);
    GSYNC();
    { pg8::Gemm g{(const pg8::bf16_t*)(p.ws + W_YCAT), (const pg8::bf16_t*)(p.ws + W_WOUTT), NTOK, D, D}; pg8::StaticOrder S; S.init(NTOK, D, nb, bid);
      EpiX1 E{p.in[I_X], (const float*)(p.ws + W_MOD), (bf16*)(p.ws + W_X1B)};
      pg8::gemm_phase<EpiX1, pg8::StaticOrder, true, true>(lds, g, S, E); }
    GSYNC();
    p7m_route(p, lds, bid); GSYNC();
    p8_place(p, lds, bid); GSYNC();
    { const int nM = *(const int*)(p.ws + T_NT);
      pg8::Gemm g{(const pg8::bf16_t*)(p.ws + W_H2), (const pg8::bf16_t*)(p.ws + W_WGUT), PROWS, 1024, D}; MoeOrder<true> S{(const int*)(p.ws + T_TILEE), (const int*)(p.ws + T_ROWAID), nM, nb, bid};
      EpiH E{(bf16*)(p.ws + W_HB)};
      pg8::gemm_phase<EpiH, MoeOrder<true>, true, true>(lds, g, S, E); }
    GSYNC();
    { const int nM = *(const int*)(p.ws + T_NT);
      pg8::Gemm g{(const pg8::bf16_t*)(p.ws + W_HB), (const pg8::bf16_t*)(p.ws + W_WDT), PROWS, 1024, EH}; MoeOrder<false> S{(const int*)(p.ws + T_TILEE), (const int*)(p.ws + T_ROWAID), nM, nb, bid};
      EpiY E{(bf16*)p.out, (const int*)(p.ws + T_ROWAID), (const float*)(p.ws + T_ROWW)};
      pg8::gemm_phase<EpiY, MoeOrder<false>, true, true>(lds, g, S, E); }
    GSYNC();
    p11_final(p, bid, nb);
#undef GSYNC
#undef p
}
extern "C" void kernel_launch(void* const* d_in, const int* in_sizes, int n_in, void* d_out, int out_size, void* d_ws, size_t ws_size, hipStream_t stream) {
    if (n_in != 31 || ws_size < WS_NEED || out_size != NTOK * D) { fprintf(stderr, "kernel_launch: unexpected sizes n_in %d ws %zu out %d\n", n_in, ws_size, out_size); return; }
    static int grid_blocks = 0;
    if (!grid_blocks) {
        int dev = 0, cus = 0, per_cu = 0;
        (void)hipGetDevice(&dev);
        (void)hipDeviceGetAttribute(&cus, hipDeviceAttributeMultiprocessorCount, dev);
        (void)hipFuncSetAttribute((const void*)k_mega, hipFuncAttributeMaxDynamicSharedMemorySize, LDS_BYTES);
        (void)hipOccupancyMaxActiveBlocksPerMultiprocessor(&per_cu, (const void*)k_mega, NTHR, LDS_BYTES);
        if (per_cu < 1) fprintf(stderr, "kernel_launch: occupancy query says %d blocks/CU\n", per_cu);
        grid_blocks = cus;
    }
    Params p{};
    for (int i = 0; i < 31; ++i) p.in[i] = (const float*)d_in[i];
    p.out = (float*)d_out; p.ws = (unsigned char*)d_ws;
    (void)hipMemsetAsync((char*)d_ws + T_BAR, 0, 16384, stream);
    void* args[] = {&p};
    hipError_t e = hipLaunchCooperativeKernel((void*)k_mega, dim3(grid_blocks), dim3(NTHR), args, LDS_BYTES, stream);
    if (e != hipSuccess) fprintf(stderr, "cooperative launch failed: %s (grid %d)\n", hipGetErrorString(e), grid_blocks);
}
```

```cpp
#include <hip/hip_runtime.h>
#include <hip/hip_cooperative_groups.h>
#include <cstdio>
#include <cstdint>
namespace cg = cooperative_groups;
__device__ __forceinline__ int otid() { int t = threadIdx.x; asm volatile("" : "+v"(t)); return t; }

namespace pg8 {
#define PG8_LAS __attribute__((address_space(3)))
typedef unsigned short bf16_t;
typedef short bf16x8 __attribute__((ext_vector_type(8)));
typedef float f32x4 __attribute__((ext_vector_type(4)));
typedef unsigned u32x4 __attribute__((ext_vector_type(4)));
constexpr int BM = 256, BK = 64, HALF = 128, HTB = HALF * BK * 2  , STAGE_BYTES = 8 * HTB, NXCD = 8, WGM = 8;

__host__ __device__ __forceinline__ int lds_byte(int r, int c) { const int st = (r >> 4) * 2 + (c >> 5), rr = r & 15, cc = c & 31, ob = rr * 64 + cc * 2; return st * 1024 + (ob ^ (((ob >> 9) & 1) << 5)); }
__host__ __device__ __forceinline__ void stage_rc(int b, int& R, int& C) { const int st = b / 1024, sb = b % 1024, swz = sb ^ (((sb >> 9) & 1) << 5); R = (st >> 1) * 16 + swz / 64; C = (st & 1) * 32 + (swz % 64) / 2; }
__host__ __device__ __forceinline__ int perm32(int rho) { const int n = rho >> 4, i = rho & 15; return 8 * (i >> 2) + 4 * n + (i & 3); }

struct Unit { int pm, pn, pb; };
struct Gemm { const bf16_t* A; const bf16_t* Bt; int M, N, K; };

struct StaticOrder {
    static constexpr bool GATHER = false;
    int nM, nN, nwg, G, c;
    __device__ __forceinline__ int rowsrc(int) const { return 0; }
    __host__ __device__ void init(int M, int N, int G_, int c_) { nM = M / BM; nN = N / BM; nwg = nM * nN; G = G_; c = c_; }
    __host__ __device__ bool next(int i, Unit& u) const {
        const long L = (long)i * G + c; if (L >= nwg) return false;
        int wgid = (int)L; { const int q = nwg / NXCD, r = nwg % NXCD, xcd = wgid % NXCD, off = wgid / NXCD; wgid = (xcd < r ? xcd * (q + 1) : r * (q + 1) + (xcd - r) * q) + off; }
        const int nig = WGM * nN, gid = wgid / nig, fm = gid * WGM, gsz = (nM - fm) < WGM ? (nM - fm) : WGM;
        u.pm = fm + ((wgid % nig) % gsz); u.pn = (wgid % nig) / gsz; u.pb = u.pn; return true;
    }
    __device__ __forceinline__ void a_ready(const Unit&) const {}
    __device__ __forceinline__ void done(const Unit&) const {}
};

__device__ __forceinline__ unsigned cvt_pk_bf16(float lo, float hi) { unsigned r; asm volatile("v_cvt_pk_bf16_f32 %0, %1, %2" : "=v"(r) : "v"(lo), "v"(hi)); return r; }
typedef float f32x2 __attribute__((ext_vector_type(2)));
template <class Epi, class Sched, bool ALIGN_EPI = false, bool SP2 = false>
__device__ __forceinline__ void gemm_phase(PG8_LAS unsigned char* lds, const Gemm g, const Sched& S, const Epi& E) {
    const int tid = otid(), wid = __builtin_amdgcn_readfirstlane(tid >> 6), lane = tid & 63, wr = wid >> 2, wc = wid & 3, fr = lane & 15, fq = lane >> 4;
    const int K = g.K, nt = K / BK;
    unsigned voffA[2], voffB[2];
#pragma unroll
    for (int i = 0; i < 2; ++i) { int R, C; stage_rc(tid * 16 + i * 8192, R, C); const int Rb = Epi::PERM ? ((R & ~31) + perm32(R & 31)) : R;
        voffA[i] = (unsigned)(R * K + C) * 2u; voffB[i] = (unsigned)(Rb * K + C) * 2u; }
    const size_t kstep = (size_t)(BK * 2);
    const size_t hstep = (size_t)HALF * K * 2;
    const size_t tstep = 2 * hstep;
    unsigned vA0[2], vA1[2], nA0[2], nA1[2];
    PG8_LAS int* rtab = (PG8_LAS int*)(lds + STAGE_BYTES);
    auto fillA = [&](int ui_, unsigned (&o0)[2], unsigned (&o1)[2]) {
#pragma unroll
        for (int i = 0; i < 2; ++i) {
            if constexpr (Sched::GATHER) { int R, C; stage_rc(tid * 16 + i * 8192, R, C);
                o0[i] = (unsigned)(rtab[ui_ * 256 + R] * K + C) * 2u; o1[i] = (unsigned)(rtab[ui_ * 256 + 128 + R] * K + C) * 2u; }
            else { o0[i] = voffA[i]; o1[i] = voffA[i] + (unsigned)hstep; } } };
    const unsigned ldsw = (unsigned)wid * 1024u;
    const int aoff = lds_byte(wr * 64 + fr, fq * 8), boff = lds_byte(wc * 32 + fr, fq * 8);
#define PG8_SA(b, h) (((b) * 2 + (h)) * HTB)
#define PG8_SB(b, h) ((4 + (b) * 2 + (h)) * HTB)
#define PG8_STAGE(bufoff, gbase, voff) do { _Pragma("unroll") for (int _i = 0; _i < 2; ++_i) \
        __builtin_amdgcn_global_load_lds((const unsigned*)((const char*)(gbase) + (voff)[_i]), (PG8_LAS unsigned*)(lds + (bufoff) + ldsw + _i * 8192), 16, 0, 0); } while (0)
#define PG8_LDA(dst, b, h) do { _Pragma("unroll") for (int m = 0; m < 4; ++m) _Pragma("unroll") for (int k = 0; k < 2; ++k) dst[m][k] = *(const PG8_LAS bf16x8*)(lds + PG8_SA(b, h) + aoff + m * 2048 + k * 1024); } while (0)
#define PG8_LDB(dst, b, h) do { _Pragma("unroll") for (int n = 0; n < 2; ++n) _Pragma("unroll") for (int k = 0; k < 2; ++k) dst[n][k] = *(const PG8_LAS bf16x8*)(lds + PG8_SB(b, h) + boff + n * 2048 + k * 1024); } while (0)
#define PG8_MMA(ai, bj, At, Bt) do { __builtin_amdgcn_s_setprio(1); _Pragma("unroll") for (int m = 0; m < 4; ++m) _Pragma("unroll") for (int n = 0; n < 2; ++n) _Pragma("unroll") for (int k = 0; k < 2; ++k) \
        acc[ai][bj][m][n] = __builtin_amdgcn_mfma_f32_16x16x32_bf16(Bt[n][k], At[m][k], acc[ai][bj][m][n], 0, 0, 0); __builtin_amdgcn_s_setprio(0); } while (0)
#define PG8_WAIT_V(n) asm volatile("s_waitcnt vmcnt(" #n ")" ::: "memory")
#define PG8_WAIT_L(n) asm volatile("s_waitcnt lgkmcnt(" #n ")" ::: "memory")
#define PG8_BAR __builtin_amdgcn_s_barrier()
#define PG8_SCHED __builtin_amdgcn_sched_barrier(0)
    Unit cur, nxt; int ui = 0;
    if (!S.next(0, cur)) return;
    f32x4 acc[2][2][4][2];
#pragma unroll
    for (int a = 0; a < 2; ++a)
#pragma unroll
        for (int b = 0; b < 2; ++b)
#pragma unroll
            for (int m = 0; m < 4; ++m)
#pragma unroll
                for (int n = 0; n < 2; ++n) acc[a][b][m][n] = (f32x4){0.f, 0.f, 0.f, 0.f};
    bf16x8 At[4][2], B0[2][2], B1[2][2];
    if constexpr (Sched::GATHER) {
        for (int ui_ = 0; ; ++ui_) { Unit u_; if (!S.next(ui_, u_)) break; if (tid < 256) rtab[ui_ * 256 + tid] = S.rowsrc(u_.pm * 256 + tid); }
        __syncthreads();
    }
    fillA(0, vA0, vA1);
    const char* cA = Sched::GATHER ? (const char*)g.A : (const char*)g.A + (size_t)cur.pm * tstep; const char* cB = (const char*)g.Bt + (size_t)cur.pb * tstep;
    S.a_ready(cur);
    if constexpr (SP2) {
        PG8_STAGE(PG8_SB(0, 0), cB, voffB); PG8_STAGE(PG8_SB(0, 1), cB + hstep, voffB); PG8_STAGE(PG8_SA(0, 0), cA, vA0); PG8_STAGE(PG8_SA(0, 1), cA, vA1);
        if (wr == 1) PG8_BAR;
        PG8_WAIT_V(2); PG8_BAR;
        PG8_STAGE(PG8_SB(1, 0), cB + kstep, voffB); PG8_STAGE(PG8_SA(1, 0), cA + kstep, vA0); PG8_STAGE(PG8_SB(1, 1), cB + hstep + kstep, voffB);
        PG8_WAIT_V(6); PG8_BAR;
    } else {
        PG8_STAGE(PG8_SB(0, 0), cB, voffB); PG8_STAGE(PG8_SA(0, 0), cA, vA0); PG8_STAGE(PG8_SB(0, 1), cB + hstep, voffB); PG8_STAGE(PG8_SA(0, 1), cA, vA1);
        if (wr == 1) PG8_BAR;
        PG8_WAIT_V(4); PG8_BAR;
        PG8_STAGE(PG8_SB(1, 0), cB + kstep, voffB); PG8_STAGE(PG8_SA(1, 0), cA + kstep, vA0); PG8_STAGE(PG8_SB(1, 1), cB + hstep + kstep, voffB);
        PG8_WAIT_V(6); PG8_BAR;
    }
    for (;;) {
        const bool has_next = S.next(ui + 1, nxt);
        const char* nA = has_next ? (Sched::GATHER ? (const char*)g.A : (const char*)g.A + (size_t)nxt.pm * tstep) : cA; const char* nB = has_next ? (const char*)g.Bt + (size_t)nxt.pb * tstep : cB;
        if (has_next) fillA(ui + 1, nA0, nA1); else {
#pragma unroll
            for (int i = 0; i < 2; ++i) { nA0[i] = vA0[i]; nA1[i] = vA1[i]; } }
        for (int t = 0; t < nt; t += 2) {
            const bool last = (t == nt - 2);
            const char* a1 = cA + (size_t)(t + 1) * kstep;
            const char* a2 = last ? nA : cA + (size_t)(t + 2) * kstep; const char* b2 = last ? nB : cB + (size_t)(t + 2) * kstep;
            const char* a3 = a2 + kstep; const char* b3 = b2 + kstep;
            unsigned sA0[2], sA1[2];
#pragma unroll
            for (int i = 0; i < 2; ++i) { sA0[i] = last ? nA0[i] : vA0[i]; sA1[i] = last ? nA1[i] : vA1[i]; }
            if (last && has_next) S.a_ready(nxt);
            if constexpr (SP2) {
            PG8_LDB(B0, 0, 0); PG8_LDB(B1, 0, 1); PG8_SCHED; PG8_LDA(At, 0, 0); PG8_STAGE(PG8_SA(1, 1), a1, vA1);
            PG8_WAIT_V(8); PG8_WAIT_L(0); PG8_BAR; PG8_MMA(0, 0, At, B0); PG8_MMA(0, 1, At, B1); PG8_BAR; PG8_SCHED;
            PG8_LDA(At, 0, 1); PG8_STAGE(PG8_SB(0, 0), b2, voffB); PG8_STAGE(PG8_SB(0, 1), b2 + hstep, voffB); PG8_STAGE(PG8_SA(0, 0), a2, sA0);
            PG8_WAIT_V(8); PG8_WAIT_L(0); PG8_BAR; PG8_MMA(1, 0, At, B0); PG8_MMA(1, 1, At, B1); PG8_BAR; PG8_SCHED;
            PG8_LDB(B0, 1, 0); PG8_LDB(B1, 1, 1); PG8_SCHED; PG8_LDA(At, 1, 0); PG8_STAGE(PG8_SA(0, 1), a2, sA1);
            PG8_WAIT_V(8); PG8_WAIT_L(0); PG8_BAR; PG8_MMA(0, 0, At, B0); PG8_MMA(0, 1, At, B1); PG8_BAR; PG8_SCHED;
            PG8_LDA(At, 1, 1); PG8_STAGE(PG8_SB(1, 0), b3, voffB); PG8_STAGE(PG8_SB(1, 1), b3 + hstep, voffB); PG8_STAGE(PG8_SA(1, 0), a3, sA0);
            PG8_WAIT_V(8); PG8_WAIT_L(0); PG8_BAR; PG8_MMA(1, 0, At, B0); PG8_MMA(1, 1, At, B1); PG8_BAR; PG8_SCHED;
            } else {
            PG8_LDB(B0, 0, 0); PG8_SCHED; PG8_LDA(At, 0, 0); PG8_STAGE(PG8_SA(1, 1), a1, vA1);
            PG8_WAIT_L(8); PG8_BAR; PG8_WAIT_L(0); PG8_MMA(0, 0, At, B0); PG8_BAR; PG8_SCHED;
            PG8_LDB(B1, 0, 1); PG8_STAGE(PG8_SB(0, 0), b2, voffB);
            PG8_BAR; PG8_WAIT_L(0); PG8_MMA(0, 1, At, B1); PG8_BAR;
            PG8_LDA(At, 0, 1); PG8_STAGE(PG8_SA(0, 0), a2, sA0);
            PG8_BAR; PG8_WAIT_L(0); PG8_MMA(1, 0, At, B0); PG8_BAR; PG8_SCHED;
            PG8_STAGE(PG8_SB(0, 1), b2 + hstep, voffB);
            PG8_WAIT_V(6); PG8_BAR; PG8_MMA(1, 1, At, B1); PG8_BAR;
            PG8_LDB(B0, 1, 0); PG8_SCHED; PG8_LDA(At, 1, 0); PG8_STAGE(PG8_SA(0, 1), a2, sA1);
            PG8_WAIT_L(8); PG8_BAR; PG8_WAIT_L(0); PG8_MMA(0, 0, At, B0); PG8_BAR; PG8_SCHED;
            PG8_LDB(B1, 1, 1); PG8_STAGE(PG8_SB(1, 0), b3, voffB);
            PG8_BAR; PG8_WAIT_L(0); PG8_MMA(0, 1, At, B1); PG8_BAR;
            PG8_LDA(At, 1, 1); PG8_STAGE(PG8_SA(1, 0), a3, sA0);
            PG8_BAR; PG8_WAIT_L(0); PG8_MMA(1, 0, At, B0); PG8_BAR; PG8_SCHED;
            PG8_STAGE(PG8_SB(1, 1), b3 + hstep, voffB);
            PG8_WAIT_V(6); PG8_BAR; PG8_MMA(1, 1, At, B1); PG8_BAR;
            }
        }
        if constexpr (ALIGN_EPI) { if (wr == 0) PG8_BAR; }
        if constexpr (!Epi::AFTER_DRAIN) { E(acc, cur, wr, wc, fr, fq); S.done(cur); }
        if (!has_next) break;
#pragma unroll
        for (int a = 0; a < 2; ++a)
#pragma unroll
            for (int b = 0; b < 2; ++b)
#pragma unroll
                for (int m = 0; m < 4; ++m)
#pragma unroll
                    for (int n = 0; n < 2; ++n) acc[a][b][m][n] = (f32x4){0.f, 0.f, 0.f, 0.f};
        cur = nxt; cA = nA; cB = nB; ++ui;
#pragma unroll
        for (int i = 0; i < 2; ++i) { vA0[i] = nA0[i]; vA1[i] = nA1[i]; }
        if constexpr (ALIGN_EPI) { if (wr == 1) PG8_BAR; }
    }
    PG8_WAIT_V(0);
    if constexpr (!ALIGN_EPI) { if (wr == 0) PG8_BAR; }
    PG8_BAR;
    if constexpr (Epi::AFTER_DRAIN) { E.fused(acc, cur, wr, wc, fr, fq, lds, wid, lane); S.done(cur); }
#undef PG8_SA
#undef PG8_SB
#undef PG8_STAGE
#undef PG8_LDA
#undef PG8_LDB
#undef PG8_MMA
#undef PG8_WAIT_V
#undef PG8_WAIT_L
#undef PG8_BAR
#undef PG8_SCHED
}
}
constexpr int D = 1024, BATCH = 8, SEQ = 4096, NTOK = BATCH * SEQ;
constexpr int GW = 512, RW = 512, HD = 64, CHUNK = 128;
constexpr int RPROJ = 1696, INW = 2720, ZLD = 2816;
constexpr int NG = 4, EPG = 8, NE = 32, EH = 512;
constexpr int NTHR = 512;
constexpr int LDS_BYTES = 163840;

typedef float f32x16 __attribute__((ext_vector_type(16)));
typedef float f32x4 __attribute__((ext_vector_type(4)));
typedef unsigned u32x4 __attribute__((ext_vector_type(4)));
typedef unsigned u32x2 __attribute__((ext_vector_type(2)));
typedef unsigned short bf16;
#define LAS __attribute__((address_space(3)))

constexpr size_t MiB = 1u << 20;
constexpr size_t W_WINT = 0;
constexpr size_t W_WOUTT = 6 * MiB;
constexpr size_t W_LORAT = 8 * MiB;
constexpr size_t W_WC = 9 * MiB;
constexpr size_t W_MOD = 10 * MiB;
constexpr size_t W_TAB = 11 * MiB;
constexpr size_t W_WGUT = 16 * MiB;
constexpr size_t W_WDT = 80 * MiB;
constexpr size_t W_H1 = 112 * MiB;
constexpr size_t W_Z = 176 * MiB;
constexpr size_t W_YCAT = 352 * MiB;
constexpr size_t W_LO = 416 * MiB;
constexpr size_t WS_NEED = 512 * MiB;
constexpr size_t T_TOKE = W_TAB;
constexpr size_t T_TOKW = W_TAB + 512 * 1024;
constexpr size_t T_ROWTOK = W_TAB + 1024 * 1024;
constexpr size_t T_ROWAID = W_TAB + 1536 * 1024;
constexpr size_t T_ROWW = W_TAB + 2048 * 1024;
constexpr size_t T_TILEE = W_TAB + 2560 * 1024;
constexpr size_t T_CTL = W_TAB + 3072 * 1024;
constexpr size_t T_BAR = W_TAB + 3584 * 1024;

struct Params {
    const float* in[31];
    float* out;
    unsigned char* ws;
};
typedef const __attribute__((address_space(4))) Params& PRef;
typedef const __attribute__((address_space(4))) Params* PPtr;
__device__ __forceinline__ PPtr opq(PPtr k) { asm volatile("" : "+s"(k)); return k; }
enum { I_X = 0, I_C, I_ADAW, I_ADAB, I_N1G, I_WIN, I_GLNW, I_GLNB, I_GWS, I_GBS, I_MU, I_W0, I_W2, I_A0, I_A2, I_G2, I_KK, I_KA, I_RK, I_GNW, I_GNB, I_WOUT, I_N2G, I_RGW, I_RGB, I_REW, I_REB, I_WG, I_WU, I_WD, I_FNG };

__device__ __forceinline__ float wave_sum(float v) {
#pragma unroll
    for (int o = 1; o < 64; o <<= 1) v += __shfl_xor(v, o);
    return v;
}
#define DPP_ADD(v, ctrl) v += __builtin_bit_cast(float, __builtin_amdgcn_update_dpp(0, __builtin_bit_cast(int, v), ctrl, 0xf, 0xf, false))
__device__ __forceinline__ float wave_sum_dpp(float v) {
    DPP_ADD(v, 0xB1); DPP_ADD(v, 0x4E); DPP_ADD(v, 0x141); DPP_ADD(v, 0x140);
    const int iv = __builtin_bit_cast(int, v);
    const float a = __builtin_bit_cast(float, __builtin_amdgcn_readlane(iv, 0)), b = __builtin_bit_cast(float, __builtin_amdgcn_readlane(iv, 16));
    const float c = __builtin_bit_cast(float, __builtin_amdgcn_readlane(iv, 32)), d = __builtin_bit_cast(float, __builtin_amdgcn_readlane(iv, 48));
    return (a + b) + (c + d);
}
__device__ __forceinline__ float xsum4(float s) {
    s += __builtin_bit_cast(float, __builtin_amdgcn_ds_swizzle(__builtin_bit_cast(int, s), 0x401F));
    float a = s, b = s;
    asm volatile("s_nop 1\n\tv_permlane32_swap_b32 %0, %1\n\ts_nop 1" : "+v"(a), "+v"(b));
    return a + b;
}
__device__ __forceinline__ float wave_sum_v(float v) {
    DPP_ADD(v, 0xB1); DPP_ADD(v, 0x4E); DPP_ADD(v, 0x141); DPP_ADD(v, 0x140);
    return xsum4(v);
}
__device__ __forceinline__ float gelu_tanh(float x) {
    const float u = 0.7978845608028654f * (x + 0.044715f * x * x * x);
    return 0.5f * x * (1.0f + tanhf(u));
}
__device__ __forceinline__ float gelu_fast(float x) {
    const float u2 = -2.302208198f * (x + 0.044715f * x * x * x);
    return x * __builtin_amdgcn_rcpf(1.0f + __builtin_amdgcn_exp2f(u2));
}
__device__ __forceinline__ float sigmoidf_(float x) { return 1.0f / (1.0f + expf(-x)); }
__device__ __forceinline__ float softplusf_(float x) { return fmaxf(x, 0.f) + log1pf(expf(-fabsf(x))); }
__device__ __forceinline__ float bf2f(unsigned short b) { return __uint_as_float(((unsigned)b) << 16); }
__device__ __forceinline__ float bflo(unsigned w) { return __uint_as_float(w << 16); }
__device__ __forceinline__ float bfhi(unsigned w) { return __uint_as_float(w & 0xffff0000u); }
__device__ __forceinline__ unsigned f2bf(float f) { unsigned u = __float_as_uint(f); return (u + 0x7fffu + ((u >> 16) & 1u)) >> 16; }
__device__ __forceinline__ unsigned pk2(float lo, float hi) { return f2bf(lo) | (f2bf(hi) << 16); }
#define XB_TMO      128
#define XB_XCNT(j)  (256  + 64 * (j))
#define XB_XSUB(j)  (1280 + 64 * (j))
#define XB_XGEN(j)  (2304 + 64 * (j))
#define XB_TOP      3328
#define XB_TOPGEN   3392
#define XCD_BAR_WORDS 3456
#define XB_SPIN_CAP (1u << 18)

__device__ __forceinline__ unsigned xb_ld(unsigned* p)              { return __hip_atomic_load(p, __ATOMIC_RELAXED, __HIP_MEMORY_SCOPE_AGENT); }
__device__ __forceinline__ unsigned xb_add(unsigned* p, unsigned v) { return __hip_atomic_fetch_add(p, v, __ATOMIC_RELAXED, __HIP_MEMORY_SCOPE_AGENT); }
__device__ __forceinline__ unsigned xb_xcc_id() { return (unsigned)__builtin_amdgcn_s_getreg((3 << 11) | 20) & 0xFu; }
#define XB_SPIN(cond, bar) do { unsigned _sp = 0; while (cond) { __builtin_amdgcn_s_sleep(1); \
    if ((++_sp & 255u) == 0u) { if (xb_ld(&(bar)[XB_TMO])) break; if (_sp > XB_SPIN_CAP) { atomicAdd(&(bar)[XB_TMO], 1u); break; } } } } while (0)

struct XcdBarrier {
    unsigned* bar; unsigned x;
    volatile LAS unsigned* st;
};

__device__ __forceinline__ XcdBarrier xcd_barrier_post(unsigned* bar, volatile LAS unsigned* st) {
    XcdBarrier b; b.bar = bar; b.x = xb_xcc_id(); b.st = st;
    if (threadIdx.x == 0) (void)xb_add(&bar[XB_XCNT(b.x)], 1u);
    return b;
}
__device__ __forceinline__ void xcd_barrier_complete(unsigned* bar, unsigned x, unsigned& nloc, unsigned& nx) {
    const unsigned G = gridDim.x * gridDim.y * gridDim.z;
    unsigned sum, cnt, mine, sp = 0u;
    for (;;) {
        sum = 0u; cnt = 0u; mine = 0u;
#pragma unroll
        for (unsigned j = 0; j < 16; ++j) { const unsigned c = xb_ld(&bar[XB_XCNT(j)]); sum += c; cnt += (c > 0u) ? 1u : 0u; mine = (j == x) ? c : mine; }
        if (sum == G) break;
        __builtin_amdgcn_s_sleep(1);
        if ((++sp & 255u) == 0u) { if (xb_ld(&bar[XB_TMO])) break; if (sp > XB_SPIN_CAP) { atomicAdd(&bar[XB_TMO], 1u); break; } }
    }
    nloc = mine > 0u ? mine : 1u; nx = cnt > 0u ? cnt : 1u;
}

__device__ __forceinline__ void xcd_barrier(const XcdBarrier& b) {
    asm volatile("s_waitcnt vmcnt(0)" ::: "memory");
    __syncthreads();
    if (threadIdx.x == 0) {
        unsigned* bar = b.bar;
        __builtin_amdgcn_s_waitcnt(0);
        unsigned nloc = b.st[0], nx = b.st[1];
        if (nloc == 0u) { xcd_barrier_complete(bar, b.x, nloc, nx); b.st[0] = nloc; b.st[1] = nx; }
        const unsigned old = xb_add(&bar[XB_XSUB(b.x)], 1u);
        const unsigned gen = old / nloc;
        if (old + 1u == (gen + 1u) * nloc) {
            __builtin_amdgcn_fence(__ATOMIC_RELEASE, "agent");
            asm volatile("s_waitcnt vmcnt(0)" ::: "memory");
            const unsigned og = xb_add(&bar[XB_TOP], 1u);
            const unsigned tg = og / nx;
            if (og + 1u == (tg + 1u) * nx) xb_add(&bar[XB_TOPGEN], 1u);
            else XB_SPIN(xb_ld(&bar[XB_TOPGEN]) == tg, bar);
            __builtin_amdgcn_fence(__ATOMIC_ACQUIRE, "agent");
            xb_add(&bar[XB_XGEN(b.x)], 1u);
            asm volatile("s_waitcnt vmcnt(0)" ::: "memory");
        } else {
            XB_SPIN(xb_ld(&bar[XB_XGEN(b.x)]) == gen, bar);
            __builtin_amdgcn_fence(__ATOMIC_ACQUIRE, "agent");
            asm volatile("s_waitcnt vmcnt(0)" ::: "memory");
        }
    }
    __syncthreads();
}
struct TrItem { const float* W; bf16* WT; int K, N; long row_off; int item; };
__device__ __forceinline__ void p0_tr_load(const TrItem& it, float (&tv)[32], int lane) {
    const int nblk = it.N / 32, kb = it.item / nblk, nb = it.item % nblk, k0 = 64 * kb, n0 = 32 * nb;
#pragma unroll
    for (int i = 0; i < 32; ++i) tv[i] = it.W[(size_t)(k0 + 2 * i + (lane >> 5)) * it.N + n0 + (lane & 31)];
}
__device__ __forceinline__ void p0_tr_store(const TrItem& it, const float (&tv)[32], LAS float* scr, int lane) {
    const int nblk = it.N / 32, kb = it.item / nblk, nb = it.item % nblk, k0 = 64 * kb, n0 = 32 * nb;
#pragma unroll
    for (int i = 0; i < 32; ++i) scr[(2 * i + (lane >> 5)) * 33 + (lane & 31)] = tv[i];
    asm volatile("s_waitcnt lgkmcnt(0)" ::: "memory");
    const int c = lane & 7;
#pragma unroll
    for (int j = 0; j < 4; ++j) { const int n = (lane >> 3) + 8 * j; const LAS float* s = scr + (8 * c) * 33 + n;
        u32x4 o; o.x = pk2(s[0 * 33], s[1 * 33]); o.y = pk2(s[2 * 33], s[3 * 33]); o.z = pk2(s[4 * 33], s[5 * 33]); o.w = pk2(s[6 * 33], s[7 * 33]);
        *(u32x4*)(it.WT + (size_t)(it.row_off + n0 + n) * it.K + k0 + 8 * c) = o; }
    asm volatile("s_waitcnt lgkmcnt(0)" ::: "memory");
}
__device__ __forceinline__ void p0_mod_item(PRef p, LAS float* red, int item) {
    const int tid = otid(), col = tid & 63, ks = __builtin_amdgcn_readfirstlane(tid >> 6), n = item * 64 + col;
    const float* __restrict__ c = p.in[I_C]; const float* __restrict__ w = p.in[I_ADAW];
    float acc[8];
#pragma unroll
    for (int b = 0; b < 8; ++b) acc[b] = 0.f;
#pragma unroll 16
    for (int k = ks * 128; k < ks * 128 + 128; ++k) {
        const float wv = w[(size_t)k * (6 * D) + n];
#pragma unroll
        for (int b = 0; b < 8; ++b) acc[b] = fmaf(c[b * D + k], wv, acc[b]);
    }
#pragma unroll
    for (int b = 0; b < 8; ++b) red[(ks * 8 + b) * 64 + col] = acc[b];
    __syncthreads();
    { const int b = tid >> 6; float s = 0.f;
#pragma unroll
      for (int q = 0; q < 8; ++q) s += red[(q * 8 + b) * 64 + col];
      ((float*)(p.ws + W_MOD))[b * 6 * D + n] = s + p.in[I_ADAB][n]; }
    __syncthreads();
}
template <bool WITH_MOE>
__device__ __forceinline__ void p0_prep(PRef p, LAS unsigned char* lds, int bid, int nb) {
    const int tid = otid(), lane = tid & 63, wave = __builtin_amdgcn_readfirstlane(tid >> 6);
#ifndef P0DUP
#define P0DUP 0
#endif
#pragma unroll 1
    for (int d_ = 0; d_ < (P0DUP & 1) + 1; ++d_)
    for (int it = bid; it < 96; it += nb) p0_mod_item(p, (LAS float*)lds, it);
    { bf16* lt = (bf16*)(p.ws + W_LORAT);
      for (int i = bid * NTHR + tid; i < 1536 * 256; i += nb * NTHR) { const int n = i >> 8, k = i & 255; float v = 0.f;
          if (n < 512) { if (k < 32) v = p.in[I_W2][k * 512 + n]; }
          else if (n < 1024) { if (k >= 32 && k < 64) v = p.in[I_A2][(k - 32) * 512 + (n - 512)]; }
          else { if (k >= 64 && k < 160) v = p.in[I_G2][(k - 64) * 512 + (n - 1024)]; }
          lt[i] = (bf16)f2bf(v); }
      bf16* wc = (bf16*)(p.ws + W_WC);
      for (int i = bid * NTHR + tid; i < 8 * 128 * 128; i += nb * NTHR) { const int s = i & 127, t = (i >> 7) & 127; wc[i] = (s <= t) ? (bf16)f2bf(p.in[I_GWS][i]) : (bf16)0; }
      bf16* wpad = (bf16*)(p.ws + W_WINT) + (size_t)INW * D;
      for (int i = bid * NTHR + tid; i < (ZLD - INW) * D; i += nb * NTHR) wpad[i] = 0; }
    LAS float* scr = (LAS float*)(lds + wave * 16384);
    const int gw = bid * 8 + wave, NGW = nb * 8;
    constexpr int I_IN = (D / 64) * (INW / 32), I_OUT = (D / 64) * (D / 32), I_GU = (D / 64) * (EH / 32), I_DN = (EH / 64) * (D / 32);
    constexpr int NIT = I_IN + I_OUT + (WITH_MOE ? NE * (2 * I_GU + I_DN) : 0);
    auto decode = [&](int it) -> TrItem {
        int r = it;
        if (r < I_IN) return TrItem{p.in[I_WIN], (bf16*)(p.ws + W_WINT), D, INW, 0, r}; r -= I_IN;
        if (r < I_OUT) return TrItem{p.in[I_WOUT], (bf16*)(p.ws + W_WOUTT), D, D, 0, r}; r -= I_OUT;
        const int e = r / (2 * I_GU + I_DN); r -= e * (2 * I_GU + I_DN);
        if (r < 2 * I_GU) {
            const int up = r >= I_GU; if (up) r -= I_GU;
            const int nbk = r % (EH / 32), hb = nbk * 32;
            const long row_off = (long)e * 1024 + (hb / 128) * 256 + up * 128 + (hb % 128) - hb;
            return TrItem{(up ? p.in[I_WU] : p.in[I_WG]) + (size_t)e * D * EH, (bf16*)(p.ws + W_WGUT), D, EH, row_off, r}; }
        r -= 2 * I_GU;
        return TrItem{p.in[I_WD] + (size_t)e * EH * D, (bf16*)(p.ws + W_WDT), EH, D, (long)e * 1024, r};
    };
    float tvA[32], tvB[32];
#pragma unroll 1
    for (int d2_ = 0; d2_ < ((P0DUP >> 1) & 1) + 1; ++d2_) {
    int it = gw;
    if (it < NIT) { TrItem cur = decode(it); p0_tr_load(cur, tvA, lane);
#pragma unroll 1
        for (;;) {
            const int itn = it + NGW; TrItem nxt = cur;
            if (itn < NIT) { nxt = decode(itn); p0_tr_load(nxt, tvB, lane); }
            p0_tr_store(cur, tvA, scr, lane);
            if (itn >= NIT) break;
            const int itn2 = itn + NGW; cur = nxt;
            if (itn2 < NIT) { cur = decode(itn2); p0_tr_load(cur, tvA, lane); }
            p0_tr_store(nxt, tvB, scr, lane);
            if (itn2 >= NIT) break;
            it = itn2;
        } }
    }
}
__device__ __forceinline__ void p1_h1(PRef p, int bid, int nb) {
    const float* __restrict__ x = p.in[I_X]; const float* __restrict__ g = p.in[I_N1G]; const float* mod = (const float*)(p.ws + W_MOD);
    bf16* H1 = (bf16*)(p.ws + W_H1);
    const int tid_ = otid(), lane = tid_ & 63, wv = tid_ >> 6;
#pragma unroll 1
    for (int row = (bid * 8 + wv) * 2; row < NTOK; row += nb * 16) {
        const int b = row / SEQ;
        const f32x4* xr = (const f32x4*)(x + (size_t)row * D) + lane;
        f32x4 v[2][4]; float s0 = 0.f, s1 = 0.f;
#pragma unroll
        for (int j = 0; j < 4; ++j) { v[0][j] = xr[64 * j]; v[1][j] = xr[256 + 64 * j]; }
#pragma unroll
        for (int j = 0; j < 4; ++j) { s0 += (v[0][j][0] * v[0][j][0] + v[0][j][1] * v[0][j][1]) + (v[0][j][2] * v[0][j][2] + v[0][j][3] * v[0][j][3]);
                                      s1 += (v[1][j][0] * v[1][j][0] + v[1][j][1] * v[1][j][1]) + (v[1][j][2] * v[1][j][2] + v[1][j][3] * v[1][j][3]); }
        const float r0 = rsqrtf(wave_sum_dpp(s0) * (1.0f / D) + 1e-6f), r1 = rsqrtf(wave_sum_dpp(s1) * (1.0f / D) + 1e-6f);
        const float* sh = mod + b * 6 * D; const float* sc = mod + b * 6 * D + D;
        u32x2* o = (u32x2*)(H1 + (size_t)row * D) + lane;
#pragma unroll
        for (int j = 0; j < 4; ++j) {
            const int c0 = (lane + 64 * j) * 4;
            const f32x4 gg = *(const f32x4*)(g + c0), ss = *(const f32x4*)(sc + c0), hh = *(const f32x4*)(sh + c0);
            f32x4 y0, y1;
#pragma unroll
            for (int q = 0; q < 4; ++q) { const float m = gg[q] * (1.0f + ss[q]); y0[q] = v[0][j][q] * r0 * m + hh[q]; y1[q] = v[1][j][q] * r1 * m + hh[q]; }
            u32x2 w0, w1; w0.x = pk2(y0[0], y0[1]); w0.y = pk2(y0[2], y0[3]); w1.x = pk2(y1[0], y1[1]); w1.y = pk2(y1[2], y1[3]);
            o[64 * j] = w0; o[256 + 64 * j] = w1;
        }
    }
}
struct EpiZ {
    static constexpr bool PERM = true, AFTER_DRAIN = false;
    bf16* Z;
    __device__ __forceinline__ void operator()(const f32x4 (&acc)[2][2][4][2], const pg8::Unit& u, int wr, int wc, int fr, int fq) const {
        const int row0 = u.pm * 256 + wr * 64 + fr, col0 = u.pn * 256 + wc * 32 + 8 * fq;
        const bool act = u.pn < 4;
#pragma unroll
        for (int ai = 0; ai < 2; ++ai)
#pragma unroll
            for (int m = 0; m < 4; ++m) { bf16* rowp = Z + (size_t)(row0 + ai * 128 + m * 16) * ZLD + col0;
#pragma unroll
                for (int bj = 0; bj < 2; ++bj) { f32x4 v0 = acc[ai][bj][m][0], v1 = acc[ai][bj][m][1];
                    if (act) {
#pragma unroll
                        for (int q = 0; q < 4; ++q) { v0[q] = gelu_fast(v0[q]); v1[q] = gelu_fast(v1[q]); } }
                    u32x4 w; w.x = pg8::cvt_pk_bf16(v0[0], v0[1]); w.y = pg8::cvt_pk_bf16(v0[2], v0[3]); w.z = pg8::cvt_pk_bf16(v1[0], v1[1]); w.w = pg8::cvt_pk_bf16(v1[2], v1[3]);
                    *(u32x4*)(rowp + bj * 128) = w; } }
    }
};
constexpr int VNT_PITCH = 272;
__device__ __forceinline__ void p3_gmlp_unit(PRef p, LAS unsigned char* lds, int chunk) {
    typedef short bf16x8 __attribute__((ext_vector_type(8)));
    const int tid = otid(), lane = tid & 63, wave = __builtin_amdgcn_readfirstlane(tid >> 6);
    const bf16* Z = (const bf16*)(p.ws + W_Z); bf16* ycat = (bf16*)(p.ws + W_YCAT);
    const int t0 = chunk * CHUNK;
    { float lw[8], lb[8];
#pragma unroll
      for (int j = 0; j < 8; ++j) { lw[j] = p.in[I_GLNW][lane + 64 * j]; lb[j] = p.in[I_GLNB][lane + 64 * j]; }
#pragma unroll 1
      for (int sp4 = 0; sp4 < 4; ++sp4) {
          const int s4 = wave * 16 + sp4 * 4;
          float a4[4][8];
#pragma unroll
          for (int u = 0; u < 4; ++u) { const bf16* vp = Z + (size_t)(t0 + s4 + u) * ZLD + 512 + lane;
#pragma unroll
              for (int j = 0; j < 8; ++j) a4[u][j] = bf2f(vp[64 * j]); }
#pragma unroll
          for (int pr = 0; pr < 2; ++pr) {
              const int s = s4 + pr * 2;
              float (&a)[8] = a4[pr * 2]; float (&b)[8] = a4[pr * 2 + 1]; float sa = 0.f, sb = 0.f;
#pragma unroll
              for (int j = 0; j < 8; ++j) { sa += a[j]; sb += b[j]; }
              const float ma = wave_sum_dpp(sa) * (1.f / 512.f), mb = wave_sum_dpp(sb) * (1.f / 512.f); float qa = 0.f, qb = 0.f;
#pragma unroll
              for (int j = 0; j < 8; ++j) { a[j] -= ma; b[j] -= mb; qa += a[j] * a[j]; qb += b[j] * b[j]; }
              const float ra = rsqrtf(wave_sum_dpp(qa) * (1.f / 512.f) + 1e-5f), rb = rsqrtf(wave_sum_dpp(qb) * (1.f / 512.f) + 1e-5f);
#pragma unroll
              for (int j = 0; j < 8; ++j) { const unsigned w = pk2(a[j] * ra * lw[j] + lb[j], b[j] * rb * lw[j] + lb[j]);
                  *(LAS unsigned*)(lds + (lane + 64 * j) * VNT_PITCH + s * 2) = w; }
          }
      } }
    __syncthreads();
    const bf16* Wc = (const bf16*)(p.ws + W_WC) + (size_t)wave * CHUNK * CHUNK;
    const int fr = lane & 15, fq = lane >> 4;
    const LAS unsigned char* abase = lds + (wave * 64 + fr) * VNT_PITCH + fq * 16;
    for (int tt = 0; tt < 8; ++tt) {
        f32x4 acc[4];
#pragma unroll
        for (int dt = 0; dt < 4; ++dt) acc[dt] = (f32x4){0.f, 0.f, 0.f, 0.f};
        const int nks = ((tt * 16 + 15) >> 5) + 1;
        for (int ks = 0; ks < nks; ++ks) {
            const bf16x8 bfr = *(const bf16x8*)(Wc + (size_t)(tt * 16 + fr) * CHUNK + ks * 32 + fq * 8);
#pragma unroll
            for (int dt = 0; dt < 4; ++dt) {
                const bf16x8 afr = *(const LAS bf16x8*)(abase + dt * 16 * VNT_PITCH + ks * 64);
                acc[dt] = __builtin_amdgcn_mfma_f32_16x16x32_bf16(afr, bfr, acc[dt], 0, 0, 0);
            }
        }
        const int tl = tt * 16 + fr, t = t0 + tl;
        const float bsv = p.in[I_GBS][wave * CHUNK + tl];
#pragma unroll
        for (int dt = 0; dt < 4; ++dt) {
            const int c = wave * 64 + dt * 16 + fq * 4;
            const u32x2 uw = *(const u32x2*)(Z + (size_t)t * ZLD + c);
            u32x2 o; o.x = pk2(bflo(uw.x) * (acc[dt][0] + bsv), bfhi(uw.x) * (acc[dt][1] + bsv)); o.y = pk2(bflo(uw.y) * (acc[dt][2] + bsv), bfhi(uw.y) * (acc[dt][3] + bsv));
            *(u32x2*)(ycat + (size_t)t * 1024 + c) = o;
        }
    }
    __syncthreads();
}
constexpr size_t W_X1B = 240 * MiB;
struct EpiX1 {
    static constexpr bool PERM = true, AFTER_DRAIN = false;
    const float* x; const float* mod; bf16* x1;
    __device__ __forceinline__ void operator()(const f32x4 (&acc)[2][2][4][2], const pg8::Unit& u, int wr, int wc, int fr, int fq) const {
        const int row0 = u.pm * 256 + wr * 64 + fr, col0 = u.pn * 256 + wc * 32 + 8 * fq;
        const int b = (u.pm * 256) / SEQ;
        const float* gt = mod + b * 6 * D + 2 * D;
#pragma unroll
        for (int bj = 0; bj < 2; ++bj) { const f32x4 g0 = *(const f32x4*)(gt + col0 + bj * 128), g1 = *(const f32x4*)(gt + col0 + bj * 128 + 4);
#pragma unroll
            for (int ai = 0; ai < 2; ++ai)
#pragma unroll
                for (int m = 0; m < 4; ++m) { const size_t off = (size_t)(row0 + ai * 128 + m * 16) * D + col0 + bj * 128;
                    const f32x4 x0 = *(const f32x4*)(x + off), xb = *(const f32x4*)(x + off + 4);
                    const f32x4 v0 = x0 + g0 * acc[ai][bj][m][0], v1 = xb + g1 * acc[ai][bj][m][1];
                    u32x4 w; w.x = pg8::cvt_pk_bf16(v0[0], v0[1]); w.y = pg8::cvt_pk_bf16(v0[2], v0[3]); w.z = pg8::cvt_pk_bf16(v1[0], v1[1]); w.w = pg8::cvt_pk_bf16(v1[2], v1[3]);
                    *(u32x4*)(x1 + off) = w; } }
    }
};
constexpr size_t W_A2 = 112 * MiB;
constexpr size_t W_Q = 112 * MiB;
constexpr size_t W_Y2 = 144 * MiB;
constexpr size_t T_RK = W_TAB + 4 * MiB;
constexpr size_t O_M = 0, O_N = 64 * MiB;
constexpr size_t W_S = 176 * MiB;
constexpr int SCL = 64, NCH = SEQ / SCL;

__device__ __forceinline__ float sigmoid_fast(float x) { return __builtin_amdgcn_rcpf(1.0f + __builtin_amdgcn_exp2f(-1.4426950409f * x)); }
__device__ __forceinline__ void p3_lorain(PRef p, int bid, int nb) {
    const bf16* Z = (const bf16*)(p.ws + W_Z); bf16* A2 = (bf16*)(p.ws + W_A2);
    const int tid = otid(), j = tid & 255, sub = tid >> 8;
    const float muj = (j < 160) ? p.in[I_MU][1536 + j] : 0.f;
#pragma unroll 1
    for (int blk = bid; blk < NTOK / 128; blk += nb) {
        const int ts = blk * 128 + sub * 64;
        if (j < 160) {
            const bf16* zp = Z + (size_t)ts * ZLD + 2560 + j; bf16* ap = A2 + (size_t)ts * 256 + j;
            float prev = (ts % SEQ == 0) ? 0.f : bf2f(zp[-ZLD]);
#pragma unroll 1
            for (int t0 = 0; t0 < 64; t0 += 8) { float cur[8];
#pragma unroll
                for (int q = 0; q < 8; ++q) cur[q] = bf2f(zp[(size_t)(t0 + q) * ZLD]);
#pragma unroll
                for (int q = 0; q < 8; ++q) { float v = cur[q] + (prev - cur[q]) * muj; prev = cur[q];
                    if (j < 32) v = tanhf(v); else if (j >= 64) v = sigmoidf_(v);
                    ap[(size_t)(t0 + q) * 256] = (bf16)f2bf(v); } }
        } else { bf16* ap = A2 + (size_t)ts * 256 + j;
#pragma unroll 8
            for (int t = 0; t < 64; ++t) ap[(size_t)t * 256] = 0; }
    }
}
struct EpiLO {
    static constexpr bool PERM = true, AFTER_DRAIN = false;
    bf16* LO; const float* w0; const float* a0;
    __device__ __forceinline__ void operator()(const f32x4 (&acc)[2][2][4][2], const pg8::Unit& u, int wr, int wc, int fr, int fq) const {
        const int row0 = u.pm * 256 + wr * 64 + fr, col0 = u.pn * 256 + wc * 32 + 8 * fq, kind = u.pn >> 1;
#pragma unroll
        for (int bj = 0; bj < 2; ++bj) {
            f32x4 bv[2];
#pragma unroll
            for (int n = 0; n < 2; ++n) { const int ch = col0 + bj * 128 + 4 * n - kind * 512;
                bv[n] = kind == 0 ? *(const f32x4*)(w0 + ch) : kind == 1 ? *(const f32x4*)(a0 + ch) : (f32x4){0.f, 0.f, 0.f, 0.f}; }
#pragma unroll
            for (int ai = 0; ai < 2; ++ai)
#pragma unroll
                for (int m = 0; m < 4; ++m) { bf16* rowp = LO + (size_t)(row0 + ai * 128 + m * 16) * 1536 + col0 + bj * 128;
                    f32x4 v0 = acc[ai][bj][m][0] + bv[0], v1 = acc[ai][bj][m][1] + bv[1];
                    if (kind < 2) { const float sc = kind == 0 ? -0.6065306597f : 1.0f;
#pragma unroll
                        for (int q = 0; q < 4; ++q) { v0[q] = sc * sigmoid_fast(v0[q]); v1[q] = sc * sigmoid_fast(v1[q]); } }
                    u32x4 w; w.x = pg8::cvt_pk_bf16(v0[0], v0[1]); w.y = pg8::cvt_pk_bf16(v0[2], v0[3]); w.z = pg8::cvt_pk_bf16(v1[0], v1[1]); w.w = pg8::cvt_pk_bf16(v1[2], v1[3]);
                    *(u32x4*)rowp = w;
                    asm volatile("" ::: "memory"); }
        }
    }
};
constexpr int SC_TS = 8;
__device__ __forceinline__ void p5a_chunk(PRef p, LAS unsigned char* lds, int q) {
    typedef float f32x2 __attribute__((ext_vector_type(2)));
    const int tid_ = otid(), lane = tid_ & 63, wave = __builtin_amdgcn_readfirstlane(tid_ >> 6);
    const int seq = q / NCH, c = q % NCH, b = seq >> 3, h = seq & 7;
    const int tb = b * SEQ + c * SCL, hc = h * 64 + lane;
    const bf16* Z = (const bf16*)(p.ws + W_Z); const bf16* LO = (const bf16*)(p.ws + W_LO);
    bf16* Qo = (bf16*)(p.ws + W_Q); bf16* Y2o = (bf16*)(p.ws + W_Y2); bf16* VLo = (bf16*)(p.ws + W_YCAT); float* RKo = (float*)(p.ws + T_RK);
    LAS float* vec = (LAS float*)(lds + wave * (SC_TS * 6 * 256));
    const float mur = p.in[I_MU][hc], muk = p.in[I_MU][512 + hc], muv = p.in[I_MU][1024 + hc];
    const float kkc = p.in[I_KK][hc], kac = p.in[I_KA][hc], rkc = p.in[I_RK][hc];
    float rp = 0.f, kp = 0.f, vp = 0.f;
    if (c != 0) { const bf16* zp = Z + (size_t)(tb - 1) * ZLD + 1024 + hc; rp = bf2f(zp[0]); kp = bf2f(zp[512]); vp = bf2f(zp[1024]); }
    f32x2 Mr[32], Nr[32];
#pragma unroll
    for (int k = 0; k < 32; ++k) { Mr[k] = (f32x2){(2 * k == lane) ? 1.f : 0.f, (2 * k + 1 == lane) ? 1.f : 0.f}; Nr[k] = (f32x2){0.f, 0.f}; }
    for (int sb = 0; sb < SCL / SC_TS; ++sb) {
        const int t0 = tb + sb * SC_TS;
#pragma unroll 1
        for (int sg = 0; sg < SC_TS; sg += 4) { float zr[4], zk[4], zv[4], lw[4], as[4];
          const bf16* zp0 = Z + (unsigned)((t0 + sg) * ZLD + 1024 + hc); const bf16* lp0 = LO + (unsigned)((t0 + sg) * 1536 + hc);
#pragma unroll
          for (int s = 0; s < 4; ++s) { const bf16* zp = zp0 + s * ZLD; const bf16* lp = lp0 + s * 1536;
              zr[s] = bf2f(zp[0]); zk[s] = bf2f(zp[512]); zv[s] = bf2f(zp[1024]); lw[s] = bf2f(lp[0]); as[s] = bf2f(lp[512]); }
#pragma unroll
          for (int s = 0; s < 4; ++s) {
              const float r = zr[s] + (rp - zr[s]) * mur, k = zk[s] + (kp - zk[s]) * muk, v = zv[s] + (vp - zv[s]) * muv;
              rp = zr[s]; kp = zk[s]; vp = zv[s];
              const float kkv = k * kkc;
              const float nrm = sqrtf(wave_sum_dpp(kkv * kkv));
              const float kk = kkv / fmaxf(nrm, 1e-12f);
              const float k2 = k * (1.0f + (as[s] - 1.0f) * kac);
              const float rk = wave_sum_dpp(r * k2 * rkc);
              LAS float* o = vec + (sg + s) * 384 + lane;
              o[0] = __builtin_amdgcn_exp2f(1.4426950409f * lw[s]); o[64] = -kk; o[128] = kk * as[s]; o[192] = k2; o[256] = r; o[320] = v;
              VLo[(unsigned)((t0 + sg + s) * 1024 + 512 + hc)] = (bf16)f2bf(v);
              if (lane == 0) RKo[(unsigned)((t0 + sg + s) * 8 + h)] = rk;
          } }
        asm volatile("s_waitcnt lgkmcnt(0)" ::: "memory");
        for (int s = 0; s < SC_TS; ++s) {
            const LAS float* vs = vec + s * 384;
            const float vi = vs[320 + lane];
            f32x2 saM = {0.f, 0.f}, saN = {0.f, 0.f};
#pragma unroll
            for (int k4 = 0; k4 < 16; ++k4) { const f32x4 a4 = *(const LAS f32x4*)(vs + 64 + 4 * k4);
                const f32x2 a0 = {a4[0], a4[1]}, a1 = {a4[2], a4[3]};
                saM += Mr[2 * k4] * a0; saN += Nr[2 * k4] * a0; saM += Mr[2 * k4 + 1] * a1; saN += Nr[2 * k4 + 1] * a1;
                if ((k4 & 3) == 3) asm volatile("" ::: "memory"); }
            const float sM = saM[0] + saM[1], sN = saN[0] + saN[1];
            const f32x2 sM2 = {sM, sM}, sN2 = {sN, sN}, vi2 = {vi, vi};
            f32x2 yM = {0.f, 0.f}, yN = {0.f, 0.f};
#pragma unroll
            for (int k4 = 0; k4 < 16; ++k4) {
                const f32x4 w4 = *(const LAS f32x4*)(vs + 4 * k4), b4 = *(const LAS f32x4*)(vs + 128 + 4 * k4), k4v = *(const LAS f32x4*)(vs + 192 + 4 * k4), r4 = *(const LAS f32x4*)(vs + 256 + 4 * k4);
#pragma unroll
                for (int hh = 0; hh < 2; ++hh) {
                    const f32x2 w2 = {w4[2 * hh], w4[2 * hh + 1]}, b2 = {b4[2 * hh], b4[2 * hh + 1]}, k2 = {k4v[2 * hh], k4v[2 * hh + 1]}, r2 = {r4[2 * hh], r4[2 * hh + 1]};
                    const int kx = 2 * k4 + hh;
                    Mr[kx] = Mr[kx] * w2 + sM2 * b2;
                    Nr[kx] = Nr[kx] * w2 + (sN2 * b2 + vi2 * k2);
                    yM += Mr[kx] * r2; yN += Nr[kx] * r2;
                }
                asm volatile("" ::: "memory");
            }
            const unsigned oo = (unsigned)((t0 + s) * 512 + hc);
            Qo[oo] = (bf16)f2bf(yM[0] + yM[1]); Y2o[oo] = (bf16)f2bf(yN[0] + yN[1]);
        }
        asm volatile("s_waitcnt lgkmcnt(0)" ::: "memory");
    }
    f32x4* Mo = (f32x4*)((unsigned char*)p.out + O_M + (size_t)q * 16384 + lane * 256);
    f32x4* No = (f32x4*)((unsigned char*)p.out + O_N + (size_t)q * 16384 + lane * 256);
#pragma unroll
    for (int k4 = 0; k4 < 16; ++k4) { Mo[k4] = (f32x4){Mr[2 * k4][0], Mr[2 * k4][1], Mr[2 * k4 + 1][0], Mr[2 * k4 + 1][1]}; No[k4] = (f32x4){Nr[2 * k4][0], Nr[2 * k4][1], Nr[2 * k4 + 1][0], Nr[2 * k4 + 1][1]}; }
}
__device__ __forceinline__ void p5b_chain(PRef p, LAS unsigned char* lds, int item) {
    typedef float f32x2 __attribute__((ext_vector_type(2)));
    const int tid = otid(), r = tid >> 5, j0 = (tid & 31) * 2, seq = (item & 7) + 8 * (item >> 5), rg = (item >> 3) & 3;
    const unsigned char* Mb = (const unsigned char*)p.out + O_M + (size_t)seq * NCH * 16384;
    const unsigned char* Nb = (const unsigned char*)p.out + O_N + (size_t)seq * NCH * 16384 + (size_t)(rg * 16 + r) * 256 + j0 * 4;
    unsigned char* Sb = p.ws + W_S + (size_t)seq * NCH * 16384 + (size_t)(rg * 16 + r) * 256 + j0 * 4;
    f32x2 sreg = {0.f, 0.f};
    f32x4 m0[2], m1[2], m2[2], m3[2]; f32x2 n0, n1, n2, n3;
#define P5B_LOAD(mm, nn, cc) do { const f32x4* mp = (const f32x4*)(Mb + (size_t)(cc) * 16384) + tid; mm[0] = mp[0]; mm[1] = mp[512]; nn = *(const f32x2*)(Nb + (size_t)(cc) * 16384); } while (0)
#define P5B_BAR() do { asm volatile("s_waitcnt lgkmcnt(0)" ::: "memory"); __builtin_amdgcn_s_barrier(); asm volatile("" ::: "memory"); } while (0)
#define P5B_STEP(mm, nn, cc) do { \
        LAS float* Sl = (LAS float*)(lds + ((cc) & 1) * 20480); LAS float* Ml = Sl + 1024; \
        *(LAS f32x4*)(Ml + tid * 4) = mm[0]; *(LAS f32x4*)(Ml + 2048 + tid * 4) = mm[1]; *(LAS f32x2*)(Sl + r * 64 + j0) = sreg; \
        *(f32x2*)(Sb + (size_t)(cc) * 16384) = sreg; \
        f32x2 acc = nn; \
        P5B_BAR(); \
        if ((cc) + 4 < NCH) P5B_LOAD(mm, nn, (cc) + 4); \
        _Pragma("unroll 16") for (int i = 0; i < 64; ++i) { const float sv = Sl[r * 64 + i]; const f32x2 mv = *(const LAS f32x2*)(Ml + i * 64 + j0); acc += (f32x2){sv, sv} * mv; } \
        sreg = acc; } while (0)
    __syncthreads();
    P5B_LOAD(m0, n0, 0); P5B_LOAD(m1, n1, 1); P5B_LOAD(m2, n2, 2); P5B_LOAD(m3, n3, 3);
    for (int c = 0; c < NCH; c += 4) { P5B_STEP(m0, n0, c); P5B_STEP(m1, n1, c + 1); P5B_STEP(m2, n2, c + 2); P5B_STEP(m3, n3, c + 3); }
    __syncthreads();
#undef P5B_LOAD
#undef P5B_STEP
#undef P5B_BAR
}
#ifndef P5C_MASK
#define P5C_MASK(c, h, tt) true
#endif
__device__ __forceinline__ void p5c_chunk(PRef p, int q) {
    typedef short bf16x8 __attribute__((ext_vector_type(8)));
    const int lane = otid() & 63, fr = lane & 15, fq = lane >> 4;
    const int seq = q / NCH, c = q % NCH, b = seq >> 3, h = seq & 7, tb = b * SEQ + c * SCL;
    const bf16* Qi = (const bf16*)(p.ws + W_Q); const bf16* Y2i = (const bf16*)(p.ws + W_Y2);
    const float* RKi = (const float*)(p.ws + T_RK); const bf16* LO = (const bf16*)(p.ws + W_LO); bf16* ycat = (bf16*)(p.ws + W_YCAT);
    const float* Sc = (const float*)(p.ws + W_S + (size_t)q * 16384);
    bf16x8 sa[4][2];
#pragma unroll
    for (int vt = 0; vt < 4; ++vt)
#pragma unroll
        for (int ks = 0; ks < 2; ++ks) { const f32x4* sp = (const f32x4*)(Sc + (vt * 16 + fr) * 64 + ks * 32 + fq * 8); const f32x4 x0 = sp[0], x1 = sp[1];
            u32x4 w; w.x = pg8::cvt_pk_bf16(x0[0], x0[1]); w.y = pg8::cvt_pk_bf16(x0[2], x0[3]); w.z = pg8::cvt_pk_bf16(x1[0], x1[1]); w.w = pg8::cvt_pk_bf16(x1[2], x1[3]);
            sa[vt][ks] = __builtin_bit_cast(bf16x8, w); }
    f32x4 gw[4], gb[4];
#pragma unroll
    for (int vt = 0; vt < 4; ++vt) { gw[vt] = *(const f32x4*)(p.in[I_GNW] + h * 64 + vt * 16 + fq * 4); gb[vt] = *(const f32x4*)(p.in[I_GNB] + h * 64 + vt * 16 + fq * 4); }
#pragma unroll 1
    for (int tt = 0; tt < SCL / 16; ++tt) {
        const int t = tb + tt * 16 + fr;
        const unsigned tq = (unsigned)(t * 512 + h * 64);
        const bf16x8 qb0 = *(const bf16x8*)(Qi + (tq + fq * 8)), qb1 = *(const bf16x8*)(Qi + (tq + 32 + fq * 8));
        f32x4 y[4]; float s = 0.f;
#pragma unroll
        for (int vt = 0; vt < 4; ++vt) {
            const u32x2 yw = *(const u32x2*)(Y2i + (tq + vt * 16 + fq * 4));
            f32x4 a = {bflo(yw.x), bfhi(yw.x), bflo(yw.y), bfhi(yw.y)};
            a = __builtin_amdgcn_mfma_f32_16x16x32_bf16(sa[vt][0], qb0, a, 0, 0, 0);
            a = __builtin_amdgcn_mfma_f32_16x16x32_bf16(sa[vt][1], qb1, a, 0, 0, 0);
            y[vt] = a; s += (a[0] + a[1]) + (a[2] + a[3]);
        }
        s = xsum4(s);
        const float m = s * (1.f / 64.f); float qq = 0.f;
#pragma unroll
        for (int vt = 0; vt < 4; ++vt) { y[vt] = y[vt] - m; qq += (y[vt][0] * y[vt][0] + y[vt][1] * y[vt][1]) + (y[vt][2] * y[vt][2] + y[vt][3] * y[vt][3]); }
        qq = xsum4(qq);
        const float rs = rsqrtf(qq * (1.f / 64.f) + 64e-5f);
        const float rk = RKi[(unsigned)(t * 8 + h)];
#pragma unroll
        for (int vt = 0; vt < 4; ++vt) {
            const int cc = h * 64 + vt * 16 + fq * 4;
            const u32x2 vw = *(const u32x2*)(ycat + (unsigned)(t * 1024 + 512 + cc)); const u32x2 gwv = *(const u32x2*)(LO + (unsigned)(t * 1536 + 1024 + cc));
            const f32x4 vv = {bflo(vw.x), bfhi(vw.x), bflo(vw.y), bfhi(vw.y)}, gg = {bflo(gwv.x), bfhi(gwv.x), bflo(gwv.y), bfhi(gwv.y)};
            const f32x4 o = (y[vt] * rs * gw[vt] + gb[vt] + vv * rk) * gg;
            u32x2 ow; ow.x = pk2(o[0], o[1]); ow.y = pk2(o[2], o[3]);
            if (P5C_MASK(c, h, tt)) *(u32x2*)(ycat + (unsigned)(t * 1024 + 512 + cc)) = ow;
        }
    }
}
constexpr size_t W_H2 = 112 * MiB;
constexpr size_t W_XS = 176 * MiB;
constexpr size_t W_HB = 320 * MiB;
constexpr int PROWS = NTOK * 2 + NE * 256, PTILES = PROWS / 256;
constexpr size_t T_HIST = W_TAB + 3 * 1024 * 1024 + 8192;
constexpr size_t T_NT = W_TAB + 3 * 1024 * 1024 + 4096;
constexpr size_t T_BQ = W_TAB + 3 * 1024 * 1024 + 65536;
constexpr int TPW = NTOK / 256;

__device__ __forceinline__ void p1_bq(PRef p, LAS float* red, int b) {
    const int tid = otid();
    const float* sh = (const float*)(p.ws + W_MOD) + b * 6 * D + 3 * D;
    if (tid < 288) { const int q = tid % 36, part = tid / 36; float s = 0.f;
        for (int c = part * 128; c < part * 128 + 128; ++c) s = fmaf(sh[c], q < 4 ? p.in[I_RGW][c * 4 + q] : p.in[I_REW][c * 32 + q - 4], s);
        red[part * 36 + q] = s; }
    __syncthreads();
    if (tid < 36) { float s = 0.f;
#pragma unroll
        for (int k = 0; k < 8; ++k) s += red[k * 36 + tid];
        ((float*)(p.ws + T_BQ))[b * 36 + tid] = s + (tid < 4 ? p.in[I_RGB][tid] : p.in[I_REB][tid - 4]); }
    __syncthreads();
}
__device__ __forceinline__ void p7_route(PRef p, LAS unsigned char* lds, int bid) {
    const int tid = otid(), lane = tid & 63, wave = __builtin_amdgcn_readfirstlane(tid >> 6);
    const float* x1 = p.out; bf16* H2 = (bf16*)(p.ws + W_H2);
    LAS int* hist = (LAS int*)(lds + 147456);
    const int b = (bid * TPW) / SEQ;
    const float* mod = (const float*)(p.ws + W_MOD) + b * 6 * D;
    const float* n2g = p.in[I_N2G];
    for (int ch = tid; ch < 1024 * 8; ch += NTHR) { const int c = ch >> 3, i = ch & 7;
        *(LAS f32x4*)(lds + c * 128 + 16 * (i ^ ((c >> 1) & 7))) = *(const f32x4*)(p.in[I_REW] + c * 32 + i * 4); }
    for (int c = tid; c < 1024; c += NTHR) *(LAS f32x4*)(lds + 131072 + c * 16) = *(const f32x4*)(p.in[I_RGW] + c * 4);
    if (tid < 32) hist[tid] = 0;
    if (tid < 36) *(LAS float*)(lds + 147456 + 128 + 4 * tid) = tid < 4 ? p.in[I_RGB][tid] : p.in[I_REB][tid - 4];
    __syncthreads();
    const int sw = (lane >> 1) & 7;
#pragma unroll 1
    for (int tp = 0; tp < TPW / 8; tp += 2) {
        const int t0 = bid * TPW + wave * (TPW / 8) + tp;
        const float* xr0 = x1 + (size_t)t0 * D; bf16* hr0 = H2 + (size_t)t0 * D;
        float r0, r1;
        { float pa[16], pb[16];
#pragma unroll
          for (int j = 0; j < 16; ++j) { pa[j] = xr0[lane + 64 * j]; pb[j] = xr0[D + lane + 64 * j]; }
          float ss0 = 0.f, ss1 = 0.f;
#pragma unroll
          for (int j = 0; j < 16; ++j) { ss0 = fmaf(pa[j], pa[j], ss0); ss1 = fmaf(pb[j], pb[j], ss1); }
          r0 = rsqrtf(wave_sum_v(ss0) * (1.0f / D) + 1e-6f); r1 = rsqrtf(wave_sum_v(ss1) * (1.0f / D) + 1e-6f); }
        float acc[2][36];
#pragma unroll
        for (int u = 0; u < 2; ++u)
#pragma unroll
            for (int q = 0; q < 36; ++q) acc[u][q] = 0.f;
#pragma unroll 1
        for (int j0 = 0; j0 < 16; j0 += 4) {
            float xa[4], xb[4], gv[4], sv[4];
#pragma unroll
            for (int jj = 0; jj < 4; ++jj) { const int c = lane + 64 * (j0 + jj); xa[jj] = xr0[c]; xb[jj] = xr0[D + c]; gv[jj] = n2g[c] * (1.0f + mod[4 * D + c]); sv[jj] = mod[3 * D + c]; }
#pragma unroll
            for (int jj = 0; jj < 4; ++jj) {
                const int c = lane + 64 * (j0 + jj);
                const float a0 = xa[jj] * r0 * gv[jj] + sv[jj], a1 = xb[jj] * r1 * gv[jj] + sv[jj];
                hr0[c] = (bf16)f2bf(a0); hr0[D + c] = (bf16)f2bf(a1);
                const LAS unsigned char* rowp = lds + c * 128;
                { const f32x4 w = *(const LAS f32x4*)(lds + 131072 + c * 16);
#pragma unroll
                  for (int q = 0; q < 4; ++q) { acc[0][q] = fmaf(a0, w[q], acc[0][q]); acc[1][q] = fmaf(a1, w[q], acc[1][q]); } }
#pragma unroll
                for (int i = 0; i < 8; ++i) { const f32x4 w = *(const LAS f32x4*)(rowp + 16 * (i ^ sw));
#pragma unroll
                    for (int q = 0; q < 4; ++q) { acc[0][4 + 4 * i + q] = fmaf(a0, w[q], acc[0][4 + 4 * i + q]); acc[1][4 + 4 * i + q] = fmaf(a1, w[q], acc[1][4 + 4 * i + q]); } }
            }
        }
#pragma unroll
        for (int u = 0; u < 2; ++u) {
            float lg[36];
#pragma unroll
            for (int q = 0; q < 36; ++q) { lg[q] = wave_sum_v(acc[u][q]); if ((q & 3) == 3) __builtin_amdgcn_sched_barrier(0); }
            unsigned bqo = 147456u + 128u; asm volatile("" : "+v"(bqo));
#pragma unroll
            for (int q = 0; q < 36; ++q) lg[q] += *(const LAS float*)(lds + bqo + 4 * q);
            int gi = 0; float gm = lg[0];
#pragma unroll
            for (int q = 1; q < 4; ++q) if (lg[q] > gm) { gm = lg[q]; gi = q; }
            float gsum = 0.f;
#pragma unroll
            for (int q = 0; q < 4; ++q) gsum += expf(lg[q] - gm);
            const float gp = 1.0f / gsum;
            float el[8];
#pragma unroll
            for (int q = 0; q < 8; ++q) el[q] = gi == 0 ? lg[4 + q] : gi == 1 ? lg[12 + q] : gi == 2 ? lg[20 + q] : lg[28 + q];
            int i0 = 0; float m0 = el[0];
#pragma unroll
            for (int q = 1; q < 8; ++q) if (el[q] > m0) { m0 = el[q]; i0 = q; }
            int i1 = -1; float m1 = -3.0e38f;
#pragma unroll
            for (int q = 0; q < 8; ++q) if (q != i0 && el[q] > m1) { m1 = el[q]; i1 = q; }
            const float p1 = expf(m1 - m0);
            const float w0 = gp / (1.0f + p1), w1 = gp * p1 / (1.0f + p1);
            if (lane == 0) { const int t = t0 + u, e0 = gi * 8 + i0, e1 = gi * 8 + i1;
                int* toke = (int*)(p.ws + T_TOKE); float* tokw = (float*)(p.ws + T_TOKW);
                toke[t * 2] = e0; toke[t * 2 + 1] = e1; tokw[t * 2] = w0; tokw[t * 2 + 1] = w1;
                __hip_atomic_fetch_add(&hist[e0], 1, __ATOMIC_RELAXED, __HIP_MEMORY_SCOPE_WORKGROUP); __hip_atomic_fetch_add(&hist[e1], 1, __ATOMIC_RELAXED, __HIP_MEMORY_SCOPE_WORKGROUP); }
        }
    }
    __syncthreads();
    if (tid < 32) ((int*)(p.ws + T_HIST))[bid * 32 + tid] = hist[tid];
    __syncthreads();
}
__device__ __forceinline__ void p8_place(PRef p, LAS unsigned char* lds, int bid) {
    const int tid = otid(), lane = tid & 63, wave = __builtin_amdgcn_readfirstlane(tid >> 6);
    LAS int* ptot = (LAS int*)lds;
    LAS int* pbef = ptot + 512;
    LAS int* base = pbef + 512;
    LAS int* lcur = base + 32;
    LAS int* posl = lcur + 32;
    LAS int* padb = posl + 256;
    const int* hist = (const int*)(p.ws + T_HIST);
    { const int e = tid & 31, part = tid >> 5; int tot = 0, bef = 0;
#pragma unroll 4
      for (int w = part * 16; w < part * 16 + 16; ++w) { const int c = hist[w * 32 + e]; tot += c; bef += (w < bid) ? c : 0; }
      ptot[part * 32 + e] = tot; pbef[part * 32 + e] = bef; }
    __syncthreads();
    if (tid < 32) { int tot = 0, bef = 0;
#pragma unroll
        for (int k = 0; k < 16; ++k) { tot += ptot[k * 32 + tid]; bef += pbef[k * 32 + tid]; }
        ptot[tid] = tot; pbef[tid] = bef; lcur[tid] = 0; }
    __syncthreads();
    if (tid == 0) { int row = 0;
        for (int e = 0; e < NE; ++e) { const int cnt = ptot[e], nt = (cnt + 255) >> 8; base[e] = row + pbef[e]; padb[e] = row + cnt; padb[32 + e] = row + nt * 256;
            if (bid == 0) { int* te = (int*)(p.ws + T_TILEE); for (int k = 0; k < nt; ++k) te[(row >> 8) + k] = e; }
            row += nt * 256; }
        if (bid == 0) *(int*)(p.ws + T_NT) = row >> 8; }
    __syncthreads();
    int* rowaid = (int*)(p.ws + T_ROWAID); float* roww = (float*)(p.ws + T_ROWW);
    if (tid < 256) { const int a = bid * 256 + tid; const int e = ((const int*)(p.ws + T_TOKE))[a];
        const int pos = base[e] + __hip_atomic_fetch_add(&lcur[e], 1, __ATOMIC_RELAXED, __HIP_MEMORY_SCOPE_WORKGROUP);
        posl[tid] = pos; rowaid[pos] = a; roww[pos] = ((const float*)(p.ws + T_TOKW))[a]; }
    if (bid < NE) for (int r = padb[bid] + tid; r < padb[32 + bid]; r += NTHR) { rowaid[r] = -1; roww[r] = 0.f; }
    __syncthreads();
    __syncthreads();
}
template <bool GATHER_>
struct MoeOrder {
    static constexpr bool GATHER = GATHER_;
    const int* tile_e; const int* rowaid; int nM, G, c;
    __device__ __forceinline__ int rowsrc(int row) const { const int a = rowaid[row]; return (a < 0 ? 0 : a) >> 1; }
    __device__ __forceinline__ bool next(int i, pg8::Unit& u) const {
        const int nwg = nM * 4; const long L = (long)i * G + c; if (L >= nwg) return false;
        int wgid = (int)L; { const int q = nwg / 8, r = nwg % 8, xcd = wgid % 8, off = wgid / 8; wgid = (xcd < r ? xcd * (q + 1) : r * (q + 1) + (xcd - r) * q) + off; }
        const int nig = 8 * 4, gid = wgid / nig, fm = gid * 8, gsz = (nM - fm) < 8 ? (nM - fm) : 8;
        u.pm = fm + ((wgid % nig) % gsz); u.pn = (wgid % nig) / gsz; u.pb = tile_e[u.pm] * 4 + u.pn; return true;
    }
    __device__ __forceinline__ void a_ready(const pg8::Unit&) const {}
    __device__ __forceinline__ void done(const pg8::Unit&) const {}
};
__device__ __forceinline__ float silu_fast(float x) { return x * __builtin_amdgcn_rcpf(1.0f + __builtin_amdgcn_exp2f(-1.4426950409f * x)); }
struct EpiH {
    static constexpr bool PERM = true, AFTER_DRAIN = false;
    bf16* H;
    __device__ __forceinline__ void operator()(const f32x4 (&acc)[2][2][4][2], const pg8::Unit& u, int wr, int wc, int fr, int fq) const {
        const int row0 = u.pm * 256 + wr * 64 + fr, col0 = u.pn * 128 + wc * 32 + 8 * fq;
#pragma unroll
        for (int ai = 0; ai < 2; ++ai)
#pragma unroll
            for (int m = 0; m < 4; ++m) { const f32x4 g0 = acc[ai][0][m][0], g1 = acc[ai][0][m][1], u0 = acc[ai][1][m][0], u1 = acc[ai][1][m][1];
                f32x4 h0, h1;
#pragma unroll
                for (int q = 0; q < 4; ++q) { h0[q] = silu_fast(g0[q]) * u0[q]; h1[q] = silu_fast(g1[q]) * u1[q]; }
                u32x4 w; w.x = pg8::cvt_pk_bf16(h0[0], h0[1]); w.y = pg8::cvt_pk_bf16(h0[2], h0[3]); w.z = pg8::cvt_pk_bf16(h1[0], h1[1]); w.w = pg8::cvt_pk_bf16(h1[2], h1[3]);
                *(u32x4*)(H + (size_t)(row0 + ai * 128 + m * 16) * EH + col0) = w; }
    }
};
struct EpiY {
    static constexpr bool PERM = true, AFTER_DRAIN = false;
    bf16* YB; const int* rowaid; const float* roww;
    __device__ __forceinline__ void operator()(const f32x4 (&acc)[2][2][4][2], const pg8::Unit& u, int wr, int wc, int fr, int fq) const {
        const int row0 = u.pm * 256 + wr * 64 + fr, col0 = u.pn * 256 + wc * 32 + 8 * fq;
#pragma unroll
        for (int ai = 0; ai < 2; ++ai)
#pragma unroll
            for (int m = 0; m < 4; ++m) { const int row = row0 + ai * 128 + m * 16; const int a = rowaid[row]; const float w = roww[row];
                if (a >= 0) {
#pragma unroll
                    for (int bj = 0; bj < 2; ++bj) { const f32x4 v0 = acc[ai][bj][m][0] * w, v1 = acc[ai][bj][m][1] * w;
                        u32x4 o; o.x = pg8::cvt_pk_bf16(v0[0], v0[1]); o.y = pg8::cvt_pk_bf16(v0[2], v0[3]); o.z = pg8::cvt_pk_bf16(v1[0], v1[1]); o.w = pg8::cvt_pk_bf16(v1[2], v1[3]);
                        *(u32x4*)(YB + (size_t)a * D + col0 + bj * 128) = o; } } }
    }
};
__device__ __forceinline__ void p11_final(PRef p, int bid, int nb) {
    const int tid_ = otid(), lane = tid_ & 63, wv = tid_ >> 6;
    const float* mod = (const float*)(p.ws + W_MOD); const bf16* YB = (const bf16*)p.out; const bf16* X1 = (const bf16*)(p.ws + W_X1B); float* out = p.out; const float* g = p.in[I_FNG];
#pragma unroll 1
    for (int row = bid * 8 + wv; row < NTOK; row += nb * 8) {
        const float* gt = mod + (row / SEQ) * 6 * D + 5 * D;
        f32x4 v[4]; float s = 0.f;
#pragma unroll
        for (int j = 0; j < 4; ++j) { const int c0 = (lane + 64 * j) * 4;
            const u32x2 xw = *(const u32x2*)(X1 + (size_t)row * D + c0); const f32x4 xv = {bflo(xw.x), bfhi(xw.x), bflo(xw.y), bfhi(xw.y)}, gv = *(const f32x4*)(gt + c0);
            const u32x2 a = *(const u32x2*)(YB + (size_t)(2 * row) * D + c0), b = *(const u32x2*)(YB + (size_t)(2 * row + 1) * D + c0);
            const f32x4 y = {bflo(a.x) + bflo(b.x), bfhi(a.x) + bfhi(b.x), bflo(a.y) + bflo(b.y), bfhi(a.y) + bfhi(b.y)};
            v[j] = xv + gv * y; s += (v[j][0] * v[j][0] + v[j][1] * v[j][1]) + (v[j][2] * v[j][2] + v[j][3] * v[j][3]); }
        const float r = rsqrtf(wave_sum_dpp(s) * (1.0f / D) + 1e-6f);
#pragma unroll
        for (int j = 0; j < 4; ++j) { const int c0 = (lane + 64 * j) * 4; *(f32x4*)(out + (size_t)row * D + c0) = v[j] * r * *(const f32x4*)(g + c0); }
    }
}
constexpr int PM_PB = 144, PM_MAT = 64 * PM_PB;
enum { PM_AT = 0, PM_RT, PM_BT, PM_KT, PM_VT, PM_BPT, PM_KPT, PM_AAK, PM_ARB, PM_ARK, PM_W1T, PM_U2T, PM_NMAT };
constexpr int PM_AAB = PM_NMAT * PM_MAT, PM_P = PM_AAB + 16384, PM_TOT = PM_P + 16384, PM_G = PM_TOT + 2048, PM_END = PM_G + 256;
static_assert(PM_END <= LDS_BYTES, "pass-A LDS map");
struct PmRaw { float zr[9], zk[9], zv[9], lw[8], as[8]; };
__device__ __forceinline__ void p5m_load(PRef p, PmRaw& R, int q, int wave, int lane) {
    const int seq = q / NCH, c = q % NCH, b = seq >> 3, h = seq & 7, tg = b * SEQ + c * SCL + wave * 8, hc = h * 64 + lane;
    const bf16* Z = (const bf16*)(p.ws + W_Z); const bf16* LO = (const bf16*)(p.ws + W_LO);
    const bool has_prev = !(wave == 0 && c == 0);
    const bf16* zp0 = Z + (size_t)(tg - 1) * ZLD + 1024 + hc;
    R.zr[0] = has_prev ? bf2f(zp0[0]) : 0.f; R.zk[0] = has_prev ? bf2f(zp0[512]) : 0.f; R.zv[0] = has_prev ? bf2f(zp0[1024]) : 0.f;
#pragma unroll
    for (int s = 0; s < 8; ++s) { const bf16* zp = Z + (size_t)(tg + s) * ZLD + 1024 + hc; const bf16* lp = LO + (size_t)(tg + s) * 1536 + hc;
        R.zr[s + 1] = bf2f(zp[0]); R.zk[s + 1] = bf2f(zp[512]); R.zv[s + 1] = bf2f(zp[1024]); R.lw[s] = bf2f(lp[0]); R.as[s] = bf2f(lp[512]); }
}
#define PM_BAR() do { asm volatile("s_waitcnt lgkmcnt(0)" ::: "memory"); __builtin_amdgcn_s_barrier(); asm volatile("" ::: "memory"); } while (0)
__device__ __forceinline__ void p5m_chunk(PRef p, LAS unsigned char* lds, int q, int qnext, PmRaw& R) {
    typedef short bf16x8 __attribute__((ext_vector_type(8)));
    const int tid = otid(), lane = tid & 63, wave = __builtin_amdgcn_readfirstlane(tid >> 6), fr = lane & 15, fq = lane >> 4;
    const int seq = q / NCH, c = q % NCH, b = seq >> 3, h = seq & 7, tb = b * SEQ + c * SCL, hc = h * 64 + lane;
#define PMAT(i) (lds + (i) * PM_MAT)
#define PFRAG(mat, row, ks) (*(const LAS bf16x8*)((mat) + (row) * PM_PB + ((ks) * 32 + fq * 8) * 2))
#ifndef PM_DUP
#define PM_DUP 0
#endif
#pragma unroll 1
    for (int d0 = 0; d0 < ((PM_DUP >> 3) & 1) + 1; ++d0) { if (d0) PM_BAR();
        const int t8 = wave * 8, tg = tb + t8;
        float (&zr)[9] = R.zr; float (&zk)[9] = R.zk; float (&zv)[9] = R.zv; float (&lw)[8] = R.lw; float (&as)[8] = R.as;
        float cl[8]; { float run = 0.f;
#pragma unroll
          for (int s = 0; s < 8; ++s) { run += lw[s]; cl[s] = run; } }
        *(LAS float*)(lds + PM_TOT + (wave * 64 + lane) * 4) = cl[7];
        PM_BAR();
        float off = 0.f, lcL = 0.f;
#pragma unroll
        for (int w = 0; w < 8; ++w) { const float tv = *(const LAS float*)(lds + PM_TOT + (w * 64 + lane) * 4); lcL += tv; off += (w < wave) ? tv : 0.f; }
        if (wave == 0) *(LAS float*)(lds + PM_G + lane * 4) = __builtin_amdgcn_exp2f(1.4426950409f * lcL);
        const float mur = p.in[I_MU][hc], muk = p.in[I_MU][512 + hc], muv = p.in[I_MU][1024 + hc];
        const float kkc = p.in[I_KK][hc], kac = p.in[I_KA][hc], rkc = p.in[I_RK][hc];
        bf16* VLo = (bf16*)(p.ws + W_YCAT); float* RKo = (float*)(p.ws + T_RK);
        unsigned pv[4], pbp[4], pkp[4];
#pragma unroll
        for (int s = 0; s < 8; ++s) {
            const float r = zr[s + 1] + (zr[s] - zr[s + 1]) * mur, k = zk[s + 1] + (zk[s] - zk[s + 1]) * muk, v = zv[s + 1] + (zv[s] - zv[s + 1]) * muv;
            const float kkv = k * kkc;
            const float kk = kkv * rsqrtf(fmaxf(wave_sum_dpp(kkv * kkv), 1e-24f));
            const float k2 = k * (1.0f + (as[s] - 1.0f) * kac);
            const float rk = wave_sum_dpp(r * k2 * rkc);
            const float bb = kk * as[s];
            const float lc = off + cl[s], lcp = lc - lw[s];
            const float e_lc = __builtin_amdgcn_exp2f(1.4426950409f * lc), e_lcp = __builtin_amdgcn_exp2f(1.4426950409f * lcp);
            const float e_nlc = __builtin_amdgcn_exp2f(-1.4426950409f * lc), e_l = __builtin_amdgcn_exp2f(1.4426950409f * (lcL - lc));
            const int t = t8 + s;
            *(LAS bf16*)(PMAT(PM_AT) + t * PM_PB + lane * 2) = (bf16)f2bf(-kk * e_lcp);
            *(LAS bf16*)(PMAT(PM_RT) + t * PM_PB + lane * 2) = (bf16)f2bf(r * e_lc);
            *(LAS bf16*)(PMAT(PM_BT) + t * PM_PB + lane * 2) = (bf16)f2bf(bb * e_nlc);
            *(LAS bf16*)(PMAT(PM_KT) + t * PM_PB + lane * 2) = (bf16)f2bf(k2 * e_nlc);
            const unsigned vb = f2bf(v), bpb = f2bf(bb * e_l), kpb = f2bf(k2 * e_l);
            if (s & 1) { pv[s >> 1] |= vb << 16; pbp[s >> 1] |= bpb << 16; pkp[s >> 1] |= kpb << 16; } else { pv[s >> 1] = vb; pbp[s >> 1] = bpb; pkp[s >> 1] = kpb; }
            VLo[(unsigned)((tg + s) * 1024 + 512 + hc)] = (bf16)vb;
            if (lane == 0) RKo[(unsigned)((tg + s) * 8 + h)] = rk;
        }
        *(LAS u32x4*)(PMAT(PM_VT) + lane * PM_PB + wave * 16) = (u32x4){pv[0], pv[1], pv[2], pv[3]};
        *(LAS u32x4*)(PMAT(PM_BPT) + lane * PM_PB + wave * 16) = (u32x4){pbp[0], pbp[1], pbp[2], pbp[3]};
        *(LAS u32x4*)(PMAT(PM_KPT) + lane * PM_PB + wave * 16) = (u32x4){pkp[0], pkp[1], pkp[2], pkp[3]};
    }
    if (qnext >= 0) p5m_load(p, R, qnext, wave, lane);
    PM_BAR();
#pragma unroll 1
    for (int d1 = 0; d1 < ((PM_DUP >> 0) & 1) + 1; ++d1) {
        const int pp = wave >> 1, half = wave & 1;
        const LAS unsigned char* Xm = PMAT(pp < 2 ? PM_AT : PM_RT);
        const LAS unsigned char* Ym = PMAT((pp & 1) ? PM_KT : PM_BT);
#pragma unroll
        for (int ti = 0; ti < 2; ++ti) {
            const int tt = half ? (1 + ti) : (3 * ti);
            const bf16x8 xb0 = PFRAG(Xm, tt * 16 + fr, 0), xb1 = PFRAG(Xm, tt * 16 + fr, 1);
            const int t = tt * 16 + fr;
#pragma unroll
            for (int jt = 0; jt < 4; ++jt) {
                f32x4 acc = {0.f, 0.f, 0.f, 0.f};
                if (jt <= tt) { acc = __builtin_amdgcn_mfma_f32_16x16x32_bf16(PFRAG(Ym, jt * 16 + fr, 0), xb0, acc, 0, 0, 0);
                                acc = __builtin_amdgcn_mfma_f32_16x16x32_bf16(PFRAG(Ym, jt * 16 + fr, 1), xb1, acc, 0, 0, 0); }
                const int j0 = jt * 16 + 4 * fq;
#pragma unroll
                for (int rg = 0; rg < 4; ++rg) { const bool keep = (pp < 2) ? (j0 + rg < t) : (j0 + rg <= t); acc[rg] = keep ? acc[rg] : 0.f; }
                if (pp == 0) {
#pragma unroll
                    for (int rg = 0; rg < 4; ++rg) *(LAS float*)(lds + PM_AAB + (t * 64 + rg * 16 + jt * 4 + fq) * 4) = acc[rg];
                } else {
                    u32x2 w; w.x = pk2(acc[0], acc[1]); w.y = pk2(acc[2], acc[3]);
                    *(LAS u32x2*)(PMAT(PM_AAK + pp - 1) + t * PM_PB + j0 * 2) = w;
                }
            }
        }
    }
    PM_BAR();
#pragma unroll 1
    for (int d2 = 0; d2 < ((PM_DUP >> 1) & 1) + 1; ++d2) {
        const bool isw1 = wave < 4;
        const int colb = (wave & 3) * 16, cl = lane >> 2, part = lane & 3, col = colb + cl;
        if (!isw1) {
            const bf16x8 vb0 = PFRAG(PMAT(PM_VT), colb + fr, 0), vb1 = PFRAG(PMAT(PM_VT), colb + fr, 1);
#pragma unroll
            for (int tt = 0; tt < 4; ++tt) { f32x4 acc = {0.f, 0.f, 0.f, 0.f};
                acc = __builtin_amdgcn_mfma_f32_16x16x32_bf16(PFRAG(PMAT(PM_AAK), tt * 16 + fr, 0), vb0, acc, 0, 0, 0);
                acc = __builtin_amdgcn_mfma_f32_16x16x32_bf16(PFRAG(PMAT(PM_AAK), tt * 16 + fr, 1), vb1, acc, 0, 0, 0);
#pragma unroll
                for (int rg = 0; rg < 4; ++rg) *(LAS float*)(lds + PM_P + ((tt * 16 + 4 * fq + rg) * 64 + colb + fr) * 4) = acc[rg]; }
            asm volatile("s_waitcnt lgkmcnt(0)" ::: "memory");
        }
        float X[16];
#pragma unroll
        for (int jj = 0; jj < 16; ++jj) X[jj] = 0.f;
        const LAS unsigned char* arow = lds + PM_AAB + part * 64;
#define PM_LOADBLK(g, rh, a4, cf) do { \
            _Pragma("unroll") for (int r = 0; r < 4; ++r) { const int t = 4 * (g) + r; \
                rh[r] = isw1 ? bf2f(*(const LAS bf16*)(PMAT(PM_AT) + t * PM_PB + col * 2)) : *(const LAS float*)(lds + PM_P + (t * 64 + col) * 4); \
                _Pragma("unroll") for (int m = 0; m < 4; ++m) if (m * 4 < (g)) a4[r][m] = *(const LAS f32x4*)(arow + t * 256 + m * 16); } \
            { const LAS unsigned char* cb = lds + PM_AAB + (g) * 4; \
              cf[0] = *(const LAS float*)(cb + (4 * (g) + 1) * 256); cf[1] = *(const LAS float*)(cb + (4 * (g) + 2) * 256); cf[2] = *(const LAS float*)(cb + (4 * (g) + 2) * 256 + 64); \
              cf[3] = *(const LAS float*)(cb + (4 * (g) + 3) * 256); cf[4] = *(const LAS float*)(cb + (4 * (g) + 3) * 256 + 64); cf[5] = *(const LAS float*)(cb + (4 * (g) + 3) * 256 + 128); } } while (0)
#define PM_SOLVEBLK(g, rh, a4, cf) do { float sm[4]; \
            _Pragma("unroll") for (int r = 0; r < 4; ++r) { float s0 = 0.f, s1 = 0.f; \
                _Pragma("unroll") for (int m = 0; m < 4; ++m) if (m * 4 < (g)) { \
                    _Pragma("unroll") for (int i = 0; i < 4; ++i) if (m * 4 + i < (g)) { if (i & 1) s1 = fmaf(a4[r][m][i], X[m * 4 + i], s1); else s0 = fmaf(a4[r][m][i], X[m * 4 + i], s0); } } \
                sm[r] = s0 + s1; } \
            _Pragma("unroll") for (int r = 0; r < 4; ++r) { DPP_ADD(sm[r], 0xB1); DPP_ADD(sm[r], 0x4E); } \
            const float x0 = rh[0] + sm[0]; \
            const float x1 = fmaf(cf[0], x0, rh[1] + sm[1]); \
            const float x2 = fmaf(cf[2], x1, fmaf(cf[1], x0, rh[2] + sm[2])); \
            const float x3 = fmaf(cf[5], x2, fmaf(cf[4], x1, fmaf(cf[3], x0, rh[3] + sm[3]))); \
            X[g] = part == 0 ? x0 : part == 1 ? x1 : part == 2 ? x2 : x3; } while (0)
        { float rhA[4], cfA[6], rhB[4], cfB[6]; f32x4 aA[4][4], aB[4][4];
          PM_LOADBLK(0, rhA, aA, cfA);
#pragma unroll
          for (int g2 = 0; g2 < 16; g2 += 2) {
              PM_LOADBLK(g2 + 1, rhB, aB, cfB); __builtin_amdgcn_sched_barrier(0);
              PM_SOLVEBLK(g2, rhA, aA, cfA);
              if (g2 + 2 < 16) { PM_LOADBLK(g2 + 2, rhA, aA, cfA); } __builtin_amdgcn_sched_barrier(0);
              PM_SOLVEBLK(g2 + 1, rhB, aB, cfB);
          } }
#undef PM_LOADBLK
#undef PM_SOLVEBLK
        LAS unsigned char* om = PMAT(isw1 ? PM_W1T : PM_U2T) + col * PM_PB + part * 2;
#pragma unroll
        for (int jj = 0; jj < 16; ++jj) *(LAS bf16*)(om + jj * 8) = (bf16)f2bf(X[jj]);
    }
    PM_BAR();
#pragma unroll 1
    for (int d3 = 0; d3 < ((PM_DUP >> 2) & 1) + 1; ++d3) {
        float* Mo = (float*)((unsigned char*)p.out + O_M + (size_t)q * 16384); float* No = (float*)((unsigned char*)p.out + O_N + (size_t)q * 16384);
        bf16* Qo = (bf16*)(p.ws + W_Q); bf16* Y2o = (bf16*)(p.ws + W_Y2);
#pragma unroll
        for (int ti = 0; ti < 2; ++ti) {
            const int idx = wave * 2 + ti, rt = idx >> 2, ct = idx & 3;
            {
                f32x4 acc = {0.f, 0.f, 0.f, 0.f};
#pragma unroll
                for (int ks = 0; ks < 2; ++ks) acc = __builtin_amdgcn_mfma_f32_16x16x32_bf16(PFRAG(PMAT(PM_BPT), ct * 16 + fr, ks), PFRAG(PMAT(PM_W1T), rt * 16 + fr, ks), acc, 0, 0, 0);
                const int i = rt * 16 + fr, c0 = ct * 16 + 4 * fq;
#pragma unroll
                for (int rg = 0; rg < 4; ++rg) if (c0 + rg == i) acc[rg] += *(const LAS float*)(lds + PM_G + i * 4);
                *(f32x4*)(Mo + i * 64 + c0) = acc; }
            {
                f32x4 acc = {0.f, 0.f, 0.f, 0.f};
#pragma unroll
                for (int ks = 0; ks < 2; ++ks) { acc = __builtin_amdgcn_mfma_f32_16x16x32_bf16(PFRAG(PMAT(PM_BPT), ct * 16 + fr, ks), PFRAG(PMAT(PM_U2T), rt * 16 + fr, ks), acc, 0, 0, 0);
                                                  acc = __builtin_amdgcn_mfma_f32_16x16x32_bf16(PFRAG(PMAT(PM_KPT), ct * 16 + fr, ks), PFRAG(PMAT(PM_VT), rt * 16 + fr, ks), acc, 0, 0, 0); }
                *(f32x4*)(No + (rt * 16 + fr) * 64 + ct * 16 + 4 * fq) = acc; }
            {
                f32x4 acc = {0.f, 0.f, 0.f, 0.f};
#pragma unroll
                for (int ks = 0; ks < 2; ++ks) acc = __builtin_amdgcn_mfma_f32_16x16x32_bf16(PFRAG(PMAT(PM_W1T), ct * 16 + fr, ks), PFRAG(PMAT(PM_ARB), rt * 16 + fr, ks), acc, 0, 0, 0);
                const int t = rt * 16 + fr, i0 = ct * 16 + 4 * fq;
                const u32x2 rw = *(const LAS u32x2*)(PMAT(PM_RT) + t * PM_PB + i0 * 2);
                u32x2 o; o.x = pk2(acc[0] + bflo(rw.x), acc[1] + bfhi(rw.x)); o.y = pk2(acc[2] + bflo(rw.y), acc[3] + bfhi(rw.y));
                *(u32x2*)(Qo + (unsigned)((tb + t) * 512 + h * 64 + i0)) = o; }
            {
                f32x4 acc = {0.f, 0.f, 0.f, 0.f};
#pragma unroll
                for (int ks = 0; ks < 2; ++ks) { acc = __builtin_amdgcn_mfma_f32_16x16x32_bf16(PFRAG(PMAT(PM_U2T), ct * 16 + fr, ks), PFRAG(PMAT(PM_ARB), rt * 16 + fr, ks), acc, 0, 0, 0);
                                                  acc = __builtin_amdgcn_mfma_f32_16x16x32_bf16(PFRAG(PMAT(PM_VT), ct * 16 + fr, ks), PFRAG(PMAT(PM_ARK), rt * 16 + fr, ks), acc, 0, 0, 0); }
                const int t = rt * 16 + fr, v0 = ct * 16 + 4 * fq;
                u32x2 o; o.x = pk2(acc[0], acc[1]); o.y = pk2(acc[2], acc[3]);
                *(u32x2*)(Y2o + (unsigned)((tb + t) * 512 + h * 64 + v0)) = o; }
        }
    }
    PM_BAR();
#undef PMAT
#undef PFRAG
}

__device__ __forceinline__ void p5m_run(PRef p, LAS unsigned char* lds, int bid, int nb) {
    const int tid = otid(), lane = tid & 63, wave = __builtin_amdgcn_readfirstlane(tid >> 6);
    PmRaw R;
    if (bid < BATCH * 8 * NCH) p5m_load(p, R, bid, wave, lane);
#pragma unroll 1
    for (int q = bid; q < BATCH * 8 * NCH; q += nb) p5m_chunk(p, lds, q, (q + nb < BATCH * 8 * NCH) ? q + nb : -1, R);
}
constexpr int R7_WP = 1040, R7_WSZ = 48 * R7_WP, R7_AP = 144, R7_ASZ = 16 * R7_AP;
constexpr int R7_WAVE0 = 2 * R7_WSZ, R7_WAVESZ = 2 * R7_ASZ + 3072, R7_HIST = R7_WAVE0 + 8 * R7_WAVESZ;
static_assert(R7_HIST + 256 <= LDS_BYTES, "router LDS map");
__device__ __forceinline__ void p7m_route(PRef p, LAS unsigned char* lds, int bid) {
    typedef short bf16x8 __attribute__((ext_vector_type(8)));
    const int tid = otid(), lane = tid & 63, wave = __builtin_amdgcn_readfirstlane(tid >> 6), fr = lane & 15, fq = lane >> 4;
    const int tok = lane >> 2, sub = lane & 3;
    const bf16* x1 = (const bf16*)(p.ws + W_X1B); bf16* H2 = (bf16*)(p.ws + W_H2);
    LAS int* hist = (LAS int*)(lds + R7_HIST);
    const int b = (bid * TPW) / SEQ, t0 = bid * TPW + wave * 16;
    const float* mod = (const float*)(p.ws + W_MOD) + b * 6 * D;
    const float* n2g = p.in[I_N2G];
    LAS unsigned char* Ahi = lds + R7_WAVE0 + wave * R7_WAVESZ; LAS unsigned char* Alo = Ahi + R7_ASZ; LAS float* Lw = (LAS float*)(Alo + R7_ASZ);
    if (tid < 32) hist[tid] = 0;
    const bf16* xrow = x1 + (size_t)(t0 + tok) * D + sub * 16;
    float ss = 0.f;
#pragma unroll 1
    for (int s4 = 0; s4 < 16; s4 += 8) { u32x4 v[16];
#pragma unroll
        for (int s = 0; s < 8; ++s) { v[s * 2] = *(const u32x4*)(xrow + (s4 + s) * 64); v[s * 2 + 1] = *(const u32x4*)(xrow + (s4 + s) * 64 + 8); }
#pragma unroll
        for (int i = 0; i < 16; ++i)
#pragma unroll
            for (int q = 0; q < 4; ++q) { const float a = bflo(v[i][q]), bq = bfhi(v[i][q]); ss = fmaf(a, a, fmaf(bq, bq, ss)); } }
    DPP_ADD(ss, 0xB1); DPP_ADD(ss, 0x4E);
    const float r = rsqrtf(ss * (1.0f / D) + 1e-6f);
    f32x4 acc[3];
#pragma unroll
    for (int qt = 0; qt < 3; ++qt) acc[qt] = (f32x4){0.f, 0.f, 0.f, 0.f};
#pragma unroll 1
    for (int kh = 0; kh < 2; ++kh) {
        __syncthreads();
#pragma unroll 1
        for (int idx = tid; idx < 512 * 12; idx += NTHR) { const int cq = idx % 12, kl = idx / 12, k = kh * 512 + kl;
            f32x4 w = {0.f, 0.f, 0.f, 0.f};
            if (cq == 0) w = *(const f32x4*)(p.in[I_RGW] + k * 4); else if (cq < 9) w = *(const f32x4*)(p.in[I_REW] + k * 32 + (cq - 1) * 4);
#pragma unroll
            for (int i = 0; i < 4; ++i) { const unsigned hi = f2bf(w[i]); const unsigned lo = f2bf(w[i] - bflo(hi));
                *(LAS bf16*)(lds + (cq * 4 + i) * R7_WP + kl * 2) = (bf16)hi; *(LAS bf16*)(lds + R7_WSZ + (cq * 4 + i) * R7_WP + kl * 2) = (bf16)lo; } }
        __syncthreads();
#pragma unroll 1
        for (int sl = 0; sl < 8; ++sl) {
            const int k0 = kh * 512 + sl * 64 + sub * 16;
            f32x4 xv[4], gv[4], cv[4], sv[4];
            { const u32x4 xa = *(const u32x4*)(x1 + (size_t)(t0 + tok) * D + k0), xb = *(const u32x4*)(x1 + (size_t)(t0 + tok) * D + k0 + 8);
              xv[0] = (f32x4){bflo(xa.x), bfhi(xa.x), bflo(xa.y), bfhi(xa.y)}; xv[1] = (f32x4){bflo(xa.z), bfhi(xa.z), bflo(xa.w), bfhi(xa.w)};
              xv[2] = (f32x4){bflo(xb.x), bfhi(xb.x), bflo(xb.y), bfhi(xb.y)}; xv[3] = (f32x4){bflo(xb.z), bfhi(xb.z), bflo(xb.w), bfhi(xb.w)}; }
#pragma unroll
            for (int i = 0; i < 4; ++i) { gv[i] = *(const f32x4*)(n2g + k0 + i * 4); cv[i] = *(const f32x4*)(mod + 4 * D + k0 + i * 4); sv[i] = *(const f32x4*)(mod + 3 * D + k0 + i * 4); }
            unsigned hi[8], lo[8];
#pragma unroll
            for (int i = 0; i < 4; ++i)
#pragma unroll
                for (int j = 0; j < 4; j += 2) { const float h0 = xv[i][j] * r * gv[i][j] * (1.0f + cv[i][j]) + sv[i][j], h1 = xv[i][j + 1] * r * gv[i][j + 1] * (1.0f + cv[i][j + 1]) + sv[i][j + 1];
                    const unsigned a0 = f2bf(h0), a1 = f2bf(h1); hi[i * 2 + (j >> 1)] = a0 | (a1 << 16); lo[i * 2 + (j >> 1)] = f2bf(h0 - bflo(a0)) | (f2bf(h1 - bflo(a1)) << 16); }
            *(u32x4*)(H2 + (size_t)(t0 + tok) * D + k0) = (u32x4){hi[0], hi[1], hi[2], hi[3]}; *(u32x4*)(H2 + (size_t)(t0 + tok) * D + k0 + 8) = (u32x4){hi[4], hi[5], hi[6], hi[7]};
            *(LAS u32x4*)(Ahi + tok * R7_AP + sub * 32) = (u32x4){hi[0], hi[1], hi[2], hi[3]}; *(LAS u32x4*)(Ahi + tok * R7_AP + sub * 32 + 16) = (u32x4){hi[4], hi[5], hi[6], hi[7]};
            *(LAS u32x4*)(Alo + tok * R7_AP + sub * 32) = (u32x4){lo[0], lo[1], lo[2], lo[3]}; *(LAS u32x4*)(Alo + tok * R7_AP + sub * 32 + 16) = (u32x4){lo[4], lo[5], lo[6], lo[7]};
            asm volatile("s_waitcnt lgkmcnt(0)" ::: "memory");
#pragma unroll
            for (int ks = 0; ks < 2; ++ks) {
                const bf16x8 ah = *(const LAS bf16x8*)(Ahi + fr * R7_AP + (ks * 32 + fq * 8) * 2), al = *(const LAS bf16x8*)(Alo + fr * R7_AP + (ks * 32 + fq * 8) * 2);
#pragma unroll
                for (int qt = 0; qt < 3; ++qt) { const int wo = (qt * 16 + fr) * R7_WP + (sl * 64 + ks * 32 + fq * 8) * 2;
                    const bf16x8 bh = *(const LAS bf16x8*)(lds + wo), bl = *(const LAS bf16x8*)(lds + R7_WSZ + wo);
                    acc[qt] = __builtin_amdgcn_mfma_f32_16x16x32_bf16(ah, bh, acc[qt], 0, 0, 0);
                    acc[qt] = __builtin_amdgcn_mfma_f32_16x16x32_bf16(al, bh, acc[qt], 0, 0, 0);
                    acc[qt] = __builtin_amdgcn_mfma_f32_16x16x32_bf16(ah, bl, acc[qt], 0, 0, 0); } }
            asm volatile("s_waitcnt lgkmcnt(0)" ::: "memory");
        }
    }
#pragma unroll
    for (int qt = 0; qt < 3; ++qt)
#pragma unroll
        for (int rg = 0; rg < 4; ++rg) Lw[(4 * fq + rg) * 48 + qt * 16 + fr] = acc[qt][rg];
    asm volatile("s_waitcnt lgkmcnt(0)" ::: "memory");
    if (lane < 16) {
        const LAS float* lg = Lw + lane * 48;
        int gi = 0; float gm = lg[0] + p.in[I_RGB][0];
#pragma unroll
        for (int q = 1; q < 4; ++q) { const float v = lg[q] + p.in[I_RGB][q]; if (v > gm) { gm = v; gi = q; } }
        float gsum = 0.f;
#pragma unroll
        for (int q = 0; q < 4; ++q) gsum += expf(lg[q] + p.in[I_RGB][q] - gm);
        const float gp = 1.0f / gsum;
        const LAS float* el = lg + 4 + gi * 8; const float* eb = p.in[I_REB] + gi * 8;
        int i0 = 0; float m0 = el[0] + eb[0];
#pragma unroll
        for (int q = 1; q < 8; ++q) { const float v = el[q] + eb[q]; if (v > m0) { m0 = v; i0 = q; } }
        int i1 = -1; float m1 = -3.0e38f;
#pragma unroll
        for (int q = 0; q < 8; ++q) { const float v = el[q] + eb[q]; if (q != i0 && v > m1) { m1 = v; i1 = q; } }
        const float p1 = expf(m1 - m0);
        const float w0 = gp / (1.0f + p1), w1 = gp * p1 / (1.0f + p1);
        const int t = t0 + lane, e0 = gi * 8 + i0, e1 = gi * 8 + i1;
        int* toke = (int*)(p.ws + T_TOKE); float* tokw = (float*)(p.ws + T_TOKW);
        toke[t * 2] = e0; toke[t * 2 + 1] = e1; tokw[t * 2] = w0; tokw[t * 2 + 1] = w1;
        __hip_atomic_fetch_add(&hist[e0], 1, __ATOMIC_RELAXED, __HIP_MEMORY_SCOPE_WORKGROUP); __hip_atomic_fetch_add(&hist[e1], 1, __ATOMIC_RELAXED, __HIP_MEMORY_SCOPE_WORKGROUP);
    }
    __syncthreads();
    if (tid < 32) ((int*)(p.ws + T_HIST))[bid * 32 + tid] = hist[tid];
    __syncthreads();
}
constexpr int PB_PITCH = 68;
constexpr int PB_ML = 0, PB_SL = 64 * PB_PITCH * 4, PB_NL = PB_SL + 16 * PB_PITCH * 4, PB_IMG = PB_NL + 16 * PB_PITCH * 4;
__device__ __forceinline__ void p5b_chain_mfma(PRef p, LAS unsigned char* lds, int item) {
    const int tid = otid(), lane = tid & 63, wave = __builtin_amdgcn_readfirstlane(tid >> 6), fr = lane & 15, fq = lane >> 4;
    const int seq = (item & 7) + 8 * (item >> 5), rg = (item >> 3) & 3;
    const bool mm = wave < 4; const int ct = wave & 3, t2 = tid & 255, nrow = t2 >> 4, ncol = (t2 & 15) * 4;
    const unsigned char* Mb = (const unsigned char*)p.out + O_M + (size_t)seq * NCH * 16384;
    const unsigned char* Nb = (const unsigned char*)p.out + O_N + (size_t)seq * NCH * 16384 + (size_t)((rg * 16 + nrow) * 64 + ncol) * 4;
    unsigned char* Sb = p.ws + W_S + (size_t)seq * NCH * 16384 + (size_t)((rg * 16 + nrow) * 64 + ncol) * 4;
    const int mrow = tid >> 4, mcol = (tid & 15) * 4;
    f32x4 acc = {0.f, 0.f, 0.f, 0.f};
    f32x4 m0[2], m1[2], m2[2], m3[2], n0, n1, n2, n3;
#define PBM_LOAD(mmr, nn, cc) do { const f32x4* mp = (const f32x4*)(Mb + (size_t)(cc) * 16384) + tid; mmr[0] = mp[0]; mmr[1] = mp[512]; if (!mm) nn = *(const f32x4*)(Nb + (size_t)(cc) * 16384); } while (0)
#define PBM_STEP(mmr, nn, cc) do { \
        LAS unsigned char* img = lds + ((cc) & 1) * PB_IMG; \
        *(LAS f32x4*)(img + PB_ML + (mrow * PB_PITCH + mcol) * 4) = mmr[0]; *(LAS f32x4*)(img + PB_ML + ((mrow + 32) * PB_PITCH + mcol) * 4) = mmr[1]; \
        if (mm) { _Pragma("unroll") for (int rg_ = 0; rg_ < 4; ++rg_) *(LAS float*)(img + PB_SL + ((4 * fq + rg_) * PB_PITCH + ct * 16 + fr) * 4) = acc[rg_]; } \
        else *(LAS f32x4*)(img + PB_NL + (nrow * PB_PITCH + ncol) * 4) = nn; \
        asm volatile("s_waitcnt lgkmcnt(0)" ::: "memory"); __builtin_amdgcn_s_barrier(); asm volatile("" ::: "memory"); \
        if ((cc) + 4 < NCH) PBM_LOAD(mmr, nn, (cc) + 4); \
        if (mm) { \
            _Pragma("unroll") for (int rg_ = 0; rg_ < 4; ++rg_) acc[rg_] = *(const LAS float*)(img + PB_NL + ((4 * fq + rg_) * PB_PITCH + ct * 16 + fr) * 4); \
            _Pragma("unroll") for (int ks = 0; ks < 16; ++ks) { \
                const float a_ = *(const LAS float*)(img + PB_SL + (fr * PB_PITCH + ks * 4 + fq) * 4), b_ = *(const LAS float*)(img + PB_ML + ((ks * 4 + fq) * PB_PITCH + ct * 16 + fr) * 4); \
                acc = __builtin_amdgcn_mfma_f32_16x16x4f32(a_, b_, acc, 0, 0, 0); } \
        } else { const f32x4 sv = *(const LAS f32x4*)(img + PB_SL + (nrow * PB_PITCH + ncol) * 4); *(f32x4*)(Sb + (size_t)(cc) * 16384) = sv; } \
    } while (0)
    __syncthreads();
    PBM_LOAD(m0, n0, 0); PBM_LOAD(m1, n1, 1); PBM_LOAD(m2, n2, 2); PBM_LOAD(m3, n3, 3);
#pragma unroll 1
    for (int c = 0; c < NCH; c += 4) { PBM_STEP(m0, n0, c); PBM_STEP(m1, n1, c + 1); PBM_STEP(m2, n2, c + 2); PBM_STEP(m3, n3, c + 3); }
    __syncthreads();
#undef PBM_LOAD
#undef PBM_STEP
}
__global__ void __launch_bounds__(NTHR, 2) k_mega(Params p_unused) {
    extern __shared__ __attribute__((aligned(16))) unsigned char lds_raw[];
    PPtr kp = (PPtr)__builtin_amdgcn_kernarg_segment_ptr();
#define p (*opq(kp))
    cg::grid_group grid = cg::this_grid();
    const int bid = blockIdx.x, nb = gridDim.x;
    LAS unsigned char* lds = (LAS unsigned char*)lds_raw;
    volatile LAS unsigned* bst = (volatile LAS unsigned*)(lds + LDS_BYTES - 64);
    if (otid() < 2) bst[otid()] = 0u;
    __syncthreads();
    XcdBarrier xb = xcd_barrier_post((unsigned*)(p.ws + T_BAR), bst);
#define GSYNC() xcd_barrier(xb)
    p0_prep<true>(p, lds, bid, nb); grid.sync();
    p1_h1(p, bid, nb); if (bid < BATCH) p1_bq(p, (LAS float*)lds, bid); GSYNC();
    { pg8::Gemm g{(const pg8::bf16_t*)(p.ws + W_H1), (const pg8::bf16_t*)(p.ws + W_WINT), NTOK, ZLD, D}; pg8::StaticOrder S; S.init(NTOK, ZLD, nb, bid);
      EpiZ E{(bf16*)(p.ws + W_Z)};
      pg8::gemm_phase<EpiZ, pg8::StaticOrder, true, true>(lds, g, S, E); }
    GSYNC();
#pragma unroll 1
    for (int ch = bid; ch < NTOK / CHUNK; ch += nb) p3_gmlp_unit(p, lds, ch);
    p3_lorain(p, bid, nb);
    GSYNC();
    { int kop = 256; asm volatile("" : "+s"(kop));
      pg8::Gemm g{(const pg8::bf16_t*)(p.ws + W_A2), (const pg8::bf16_t*)(p.ws + W_LORAT), NTOK, 1536, kop}; pg8::StaticOrder S; S.init(NTOK, 1536, nb, bid);
      EpiLO E{(bf16*)(p.ws + W_LO), p.in[I_W0], p.in[I_A0]};
      pg8::gemm_phase<EpiLO, pg8::StaticOrder, true, true>(lds, g, S, E); }
    GSYNC();
    p5m_run(p, lds, bid, nb);
    GSYNC();
#pragma unroll 1
    for (int it = bid; it < BATCH * 8 * 4; it += nb) p5b_chain_mfma(p, lds, it);
    GSYNC();
#pragma unroll 1
    for (int q = bid * 8 + __builtin_amdgcn_readfirstlane(otid() >> 6); q < BATCH * 8 * NCH; q += nb * 8) p5c_chunk(p, q);
    GSYNC();
    { pg8::Gemm g{(const pg8::bf16_t*)(p.ws + W_YCAT), (const pg8::bf16_t*)(p.ws + W_WOUTT), NTOK, D, D}; pg8::StaticOrder S; S.init(NTOK, D, nb, bid);
      EpiX1 E{p.in[I_X], (const float*)(p.ws + W_MOD), (bf16*)(p.ws + W_X1B)};
      pg8::gemm_phase<EpiX1, pg8::StaticOrder, true, true>(lds, g, S, E); }
    GSYNC();
    p7m_route(p, lds, bid); GSYNC();
    p8_place(p, lds, bid); GSYNC();
    { const int nM = *(const int*)(p.ws + T_NT);
      pg8::Gemm g{(const pg8::bf16_t*)(p.ws + W_H2), (const pg8::bf16_t*)(p.ws + W_WGUT), PROWS, 1024, D}; MoeOrder<true> S{(const int*)(p.ws + T_TILEE), (const int*)(p.ws + T_ROWAID), nM, nb, bid};
      EpiH E{(bf16*)(p.ws + W_HB)};
      pg8::gemm_phase<EpiH, MoeOrder<true>, true, true>(lds, g, S, E); }
    GSYNC();
    { const int nM = *(const int*)(p.ws + T_NT);
      pg8::Gemm g{(const pg8::bf16_t*)(p.ws + W_HB), (const pg8::bf16_t*)(p.ws + W_WDT), PROWS, 1024, EH}; MoeOrder<false> S{(const int*)(p.ws + T_TILEE), (const int*)(p.ws + T_ROWAID), nM, nb, bid};
      EpiY E{(bf16*)p.out, (const int*)(p.ws + T_ROWAID), (const float*)(p.ws + T_ROWW)};
      pg8::gemm_phase<EpiY, MoeOrder<false>, true, true>(lds, g, S, E); }
    GSYNC();
    p11_final(p, bid, nb);
#undef GSYNC
#undef p
}
extern "C" void kernel_launch(void* const* d_in, const int* in_sizes, int n_in, void* d_out, int out_size, void* d_ws, size_t ws_size, hipStream_t stream) {
    if (n_in != 31 || ws_size < WS_NEED || out_size != NTOK * D) { fprintf(stderr, "kernel_launch: unexpected sizes n_in %d ws %zu out %d\n", n_in, ws_size, out_size); return; }
    static int grid_blocks = 0;
    if (!grid_blocks) {
        int dev = 0, cus = 0, per_cu = 0;
        (void)hipGetDevice(&dev);
        (void)hipDeviceGetAttribute(&cus, hipDeviceAttributeMultiprocessorCount, dev);
        (void)hipFuncSetAttribute((const void*)k_mega, hipFuncAttributeMaxDynamicSharedMemorySize, LDS_BYTES);
        (void)hipOccupancyMaxActiveBlocksPerMultiprocessor(&per_cu, (const void*)k_mega, NTHR, LDS_BYTES);
        if (per_cu < 1) fprintf(stderr, "kernel_launch: occupancy query says %d blocks/CU\n", per_cu);
        grid_blocks = cus;
    }
    Params p{};
    for (int i = 0; i < 31; ++i) p.in[i] = (const float*)d_in[i];
    p.out = (float*)d_out; p.ws = (unsigned char*)d_ws;
    (void)hipMemsetAsync((char*)d_ws + T_BAR, 0, 16384, stream);
    void* args[] = {&p};
    hipError_t e = hipLaunchCooperativeKernel((void*)k_mega, dim3(grid_blocks), dim3(NTHR), args, LDS_BYTES, stream);
    if (e != hipSuccess) fprintf(stderr, "cooperative launch failed: %s (grid %d)\n", hipGetErrorString(e), grid_blocks);
}
```

```cpp
#include <hip/hip_runtime.h>
#include <hip/hip_cooperative_groups.h>
#include <cstdio>
#include <cstdint>
namespace cg = cooperative_groups;
__device__ __forceinline__ int otid() { int t = threadIdx.x; asm volatile("" : "+v"(t)); return t; }

namespace pg8 {
#define PG8_LAS __attribute__((address_space(3)))
typedef unsigned short bf16_t;
typedef short bf16x8 __attribute__((ext_vector_type(8)));
typedef float f32x4 __attribute__((ext_vector_type(4)));
typedef unsigned u32x4 __attribute__((ext_vector_type(4)));
constexpr int BM = 256, BK = 64, HALF = 128, HTB = HALF * BK * 2  , STAGE_BYTES = 8 * HTB, NXCD = 8, WGM = 8;

__host__ __device__ __forceinline__ int lds_byte(int r, int c) { const int st = (r >> 4) * 2 + (c >> 5), rr = r & 15, cc = c & 31, ob = rr * 64 + cc * 2; return st * 1024 + (ob ^ (((ob >> 9) & 1) << 5)); }
__host__ __device__ __forceinline__ void stage_rc(int b, int& R, int& C) { const int st = b / 1024, sb = b % 1024, swz = sb ^ (((sb >> 9) & 1) << 5); R = (st >> 1) * 16 + swz / 64; C = (st & 1) * 32 + (swz % 64) / 2; }
__host__ __device__ __forceinline__ int perm32(int rho) { const int n = rho >> 4, i = rho & 15; return 8 * (i >> 2) + 4 * n + (i & 3); }

struct Unit { int pm, pn, pb; };
struct Gemm { const bf16_t* A; const bf16_t* Bt; int M, N, K; };

struct StaticOrder {
    static constexpr bool GATHER = false;
    int nM, nN, nwg, G, c;
    __device__ __forceinline__ int rowsrc(int) const { return 0; }
    __host__ __device__ void init(int M, int N, int G_, int c_) { nM = M / BM; nN = N / BM; nwg = nM * nN; G = G_; c = c_; }
    __host__ __device__ bool next(int i, Unit& u) const {
        const long L = (long)i * G + c; if (L >= nwg) return false;
        int wgid = (int)L; { const int q = nwg / NXCD, r = nwg % NXCD, xcd = wgid % NXCD, off = wgid / NXCD; wgid = (xcd < r ? xcd * (q + 1) : r * (q + 1) + (xcd - r) * q) + off; }
        const int nig = WGM * nN, gid = wgid / nig, fm = gid * WGM, gsz = (nM - fm) < WGM ? (nM - fm) : WGM;
        u.pm = fm + ((wgid % nig) % gsz); u.pn = (wgid % nig) / gsz; u.pb = u.pn; return true;
    }
    __device__ __forceinline__ void a_ready(const Unit&) const {}
    __device__ __forceinline__ void done(const Unit&) const {}
};

__device__ __forceinline__ unsigned cvt_pk_bf16(float lo, float hi) { unsigned r; asm volatile("v_cvt_pk_bf16_f32 %0, %1, %2" : "=v"(r) : "v"(lo), "v"(hi)); return r; }
typedef float f32x2 __attribute__((ext_vector_type(2)));
template <class Epi, class Sched, bool ALIGN_EPI = false, bool SP2 = false>
__device__ __forceinline__ void gemm_phase(PG8_LAS unsigned char* lds, const Gemm g, const Sched& S, const Epi& E) {
    const int tid = otid(), wid = __builtin_amdgcn_readfirstlane(tid >> 6), lane = tid & 63, wr = wid >> 2, wc = wid & 3, fr = lane & 15, fq = lane >> 4;
    const int K = g.K, nt = K / BK;
    unsigned voffA[2], voffB[2];
#pragma unroll
    for (int i = 0; i < 2; ++i) { int R, C; stage_rc(tid * 16 + i * 8192, R, C); const int Rb = Epi::PERM ? ((R & ~31) + perm32(R & 31)) : R;
        voffA[i] = (unsigned)(R * K + C) * 2u; voffB[i] = (unsigned)(Rb * K + C) * 2u; }
    const size_t kstep = (size_t)(BK * 2);
    const size_t hstep = (size_t)HALF * K * 2;
    const size_t tstep = 2 * hstep;
    unsigned vA0[2], vA1[2], nA0[2], nA1[2];
    PG8_LAS int* rtab = (PG8_LAS int*)(lds + STAGE_BYTES);
    auto fillA = [&](int ui_, unsigned (&o0)[2], unsigned (&o1)[2]) {
#pragma unroll
        for (int i = 0; i < 2; ++i) {
            if constexpr (Sched::GATHER) { int R, C; stage_rc(tid * 16 + i * 8192, R, C);
                o0[i] = (unsigned)(rtab[ui_ * 256 + R] * K + C) * 2u; o1[i] = (unsigned)(rtab[ui_ * 256 + 128 + R] * K + C) * 2u; }
            else { o0[i] = voffA[i]; o1[i] = voffA[i] + (unsigned)hstep; } } };
    const unsigned ldsw = (unsigned)wid * 1024u;
    const int aoff = lds_byte(wr * 64 + fr, fq * 8), boff = lds_byte(wc * 32 + fr, fq * 8);
#define PG8_SA(b, h) (((b) * 2 + (h)) * HTB)
#define PG8_SB(b, h) ((4 + (b) * 2 + (h)) * HTB)
#define PG8_STAGE(bufoff, gbase, voff) do { _Pragma("unroll") for (int _i = 0; _i < 2; ++_i) \
        __builtin_amdgcn_global_load_lds((const unsigned*)((const char*)(gbase) + (voff)[_i]), (PG8_LAS unsigned*)(lds + (bufoff) + ldsw + _i * 8192), 16, 0, 0); } while (0)
#define PG8_LDA(dst, b, h) do { _Pragma("unroll") for (int m = 0; m < 4; ++m) _Pragma("unroll") for (int k = 0; k < 2; ++k) dst[m][k] = *(const PG8_LAS bf16x8*)(lds + PG8_SA(b, h) + aoff + m * 2048 + k * 1024); } while (0)
#define PG8_LDB(dst, b, h) do { _Pragma("unroll") for (int n = 0; n < 2; ++n) _Pragma("unroll") for (int k = 0; k < 2; ++k) dst[n][k] = *(const PG8_LAS bf16x8*)(lds + PG8_SB(b, h) + boff + n * 2048 + k * 1024); } while (0)
#define PG8_MMA(ai, bj, At, Bt) do { __builtin_amdgcn_s_setprio(1); _Pragma("unroll") for (int m = 0; m < 4; ++m) _Pragma("unroll") for (int n = 0; n < 2; ++n) _Pragma("unroll") for (int k = 0; k < 2; ++k) \
        acc[ai][bj][m][n] = __builtin_amdgcn_mfma_f32_16x16x32_bf16(Bt[n][k], At[m][k], acc[ai][bj][m][n], 0, 0, 0); __builtin_amdgcn_s_setprio(0); } while (0)
#define PG8_WAIT_V(n) asm volatile("s_waitcnt vmcnt(" #n ")" ::: "memory")
#define PG8_WAIT_L(n) asm volatile("s_waitcnt lgkmcnt(" #n ")" ::: "memory")
#define PG8_BAR __builtin_amdgcn_s_barrier()
#define PG8_SCHED __builtin_amdgcn_sched_barrier(0)
    Unit cur, nxt; int ui = 0;
    if (!S.next(0, cur)) return;
    f32x4 acc[2][2][4][2];
#pragma unroll
    for (int a = 0; a < 2; ++a)
#pragma unroll
        for (int b = 0; b < 2; ++b)
#pragma unroll
            for (int m = 0; m < 4; ++m)
#pragma unroll
                for (int n = 0; n < 2; ++n) acc[a][b][m][n] = (f32x4){0.f, 0.f, 0.f, 0.f};
    bf16x8 At[4][2], B0[2][2], B1[2][2];
    if constexpr (Sched::GATHER) {
        for (int ui_ = 0; ; ++ui_) { Unit u_; if (!S.next(ui_, u_)) break; if (tid < 256) rtab[ui_ * 256 + tid] = S.rowsrc(u_.pm * 256 + tid); }
        __syncthreads();
    }
    fillA(0, vA0, vA1);
    const char* cA = Sched::GATHER ? (const char*)g.A : (const char*)g.A + (size_t)cur.pm * tstep; const char* cB = (const char*)g.Bt + (size_t)cur.pb * tstep;
    S.a_ready(cur);
    if constexpr (SP2) {
        PG8_STAGE(PG8_SB(0, 0), cB, voffB); PG8_STAGE(PG8_SB(0, 1), cB + hstep, voffB); PG8_STAGE(PG8_SA(0, 0), cA, vA0); PG8_STAGE(PG8_SA(0, 1), cA, vA1);
        if (wr == 1) PG8_BAR;
        PG8_WAIT_V(2); PG8_BAR;
        PG8_STAGE(PG8_SB(1, 0), cB + kstep, voffB); PG8_STAGE(PG8_SA(1, 0), cA + kstep, vA0); PG8_STAGE(PG8_SB(1, 1), cB + hstep + kstep, voffB);
        PG8_WAIT_V(6); PG8_BAR;
    } else {
        PG8_STAGE(PG8_SB(0, 0), cB, voffB); PG8_STAGE(PG8_SA(0, 0), cA, vA0); PG8_STAGE(PG8_SB(0, 1), cB + hstep, voffB); PG8_STAGE(PG8_SA(0, 1), cA, vA1);
        if (wr == 1) PG8_BAR;
        PG8_WAIT_V(4); PG8_BAR;
        PG8_STAGE(PG8_SB(1, 0), cB + kstep, voffB); PG8_STAGE(PG8_SA(1, 0), cA + kstep, vA0); PG8_STAGE(PG8_SB(1, 1), cB + hstep + kstep, voffB);
        PG8_WAIT_V(6); PG8_BAR;
    }
    for (;;) {
        const bool has_next = S.next(ui + 1, nxt);
        const char* nA = has_next ? (Sched::GATHER ? (const char*)g.A : (const char*)g.A + (size_t)nxt.pm * tstep) : cA; const char* nB = has_next ? (const char*)g.Bt + (size_t)nxt.pb * tstep : cB;
        if (has_next) fillA(ui + 1, nA0, nA1); else {
#pragma unroll
            for (int i = 0; i < 2; ++i) { nA0[i] = vA0[i]; nA1[i] = vA1[i]; } }
        for (int t = 0; t < nt; t += 2) {
            const bool last = (t == nt - 2);
            const char* a1 = cA + (size_t)(t + 1) * kstep;
            const char* a2 = last ? nA : cA + (size_t)(t + 2) * kstep; const char* b2 = last ? nB : cB + (size_t)(t + 2) * kstep;
            const char* a3 = a2 + kstep; const char* b3 = b2 + kstep;
            unsigned sA0[2], sA1[2];
#pragma unroll
            for (int i = 0; i < 2; ++i) { sA0[i] = last ? nA0[i] : vA0[i]; sA1[i] = last ? nA1[i] : vA1[i]; }
            if (last && has_next) S.a_ready(nxt);
            if constexpr (SP2) {
            PG8_LDB(B0, 0, 0); PG8_LDB(B1, 0, 1); PG8_SCHED; PG8_LDA(At, 0, 0); PG8_STAGE(PG8_SA(1, 1), a1, vA1);
            PG8_WAIT_V(8); PG8_WAIT_L(0); PG8_BAR; PG8_MMA(0, 0, At, B0); PG8_MMA(0, 1, At, B1); PG8_BAR; PG8_SCHED;
            PG8_LDA(At, 0, 1); PG8_STAGE(PG8_SB(0, 0), b2, voffB); PG8_STAGE(PG8_SB(0, 1), b2 + hstep, voffB); PG8_STAGE(PG8_SA(0, 0), a2, sA0);
            PG8_WAIT_V(8); PG8_WAIT_L(0); PG8_BAR; PG8_MMA(1, 0, At, B0); PG8_MMA(1, 1, At, B1); PG8_BAR; PG8_SCHED;
            PG8_LDB(B0, 1, 0); PG8_LDB(B1, 1, 1); PG8_SCHED; PG8_LDA(At, 1, 0); PG8_STAGE(PG8_SA(0, 1), a2, sA1);
            PG8_WAIT_V(8); PG8_WAIT_L(0); PG8_BAR; PG8_MMA(0, 0, At, B0); PG8_MMA(0, 1, At, B1); PG8_BAR; PG8_SCHED;
            PG8_LDA(At, 1, 1); PG8_STAGE(PG8_SB(1, 0), b3, voffB); PG8_STAGE(PG8_SB(1, 1), b3 + hstep, voffB); PG8_STAGE(PG8_SA(1, 0), a3, sA0);
            PG8_WAIT_V(8); PG8_WAIT_L(0); PG8_BAR; PG8_MMA(1, 0, At, B0); PG8_MMA(1, 1, At, B1); PG8_BAR; PG8_SCHED;
            } else {
            PG8_LDB(B0, 0, 0); PG8_SCHED; PG8_LDA(At, 0, 0); PG8_STAGE(PG8_SA(1, 1), a1, vA1);
            PG8_WAIT_L(8); PG8_BAR; PG8_WAIT_L(0); PG8_MMA(0, 0, At, B0); PG8_BAR; PG8_SCHED;
            PG8_LDB(B1, 0, 1); PG8_STAGE(PG8_SB(0, 0), b2, voffB);
            PG8_BAR; PG8_WAIT_L(0); PG8_MMA(0, 1, At, B1); PG8_BAR;
            PG8_LDA(At, 0, 1); PG8_STAGE(PG8_SA(0, 0), a2, sA0);
            PG8_BAR; PG8_WAIT_L(0); PG8_MMA(1, 0, At, B0); PG8_BAR; PG8_SCHED;
            PG8_STAGE(PG8_SB(0, 1), b2 + hstep, voffB);
            PG8_WAIT_V(6); PG8_BAR; PG8_MMA(1, 1, At, B1); PG8_BAR;
            PG8_LDB(B0, 1, 0); PG8_SCHED; PG8_LDA(At, 1, 0); PG8_STAGE(PG8_SA(0, 1), a2, sA1);
            PG8_WAIT_L(8); PG8_BAR; PG8_WAIT_L(0); PG8_MMA(0, 0, At, B0); PG8_BAR; PG8_SCHED;
            PG8_LDB(B1, 1, 1); PG8_STAGE(PG8_SB(1, 0), b3, voffB);
            PG8_BAR; PG8_WAIT_L(0); PG8_MMA(0, 1, At, B1); PG8_BAR;
            PG8_LDA(At, 1, 1); PG8_STAGE(PG8_SA(1, 0), a3, sA0);
            PG8_BAR; PG8_WAIT_L(0); PG8_MMA(1, 0, At, B0); PG8_BAR; PG8_SCHED;
            PG8_STAGE(PG8_SB(1, 1), b3 + hstep, voffB);
            PG8_WAIT_V(6); PG8_BAR; PG8_MMA(1, 1, At, B1); PG8_BAR;
            }
        }
        if constexpr (ALIGN_EPI) { if (wr == 0) PG8_BAR; }
        if constexpr (!Epi::AFTER_DRAIN) { E(acc, cur, wr, wc, fr, fq); S.done(cur); }
        if (!has_next) break;
#pragma unroll
        for (int a = 0; a < 2; ++a)
#pragma unroll
            for (int b = 0; b < 2; ++b)
#pragma unroll
                for (int m = 0; m < 4; ++m)
#pragma unroll
                    for (int n = 0; n < 2; ++n) acc[a][b][m][n] = (f32x4){0.f, 0.f, 0.f, 0.f};
        cur = nxt; cA = nA; cB = nB; ++ui;
#pragma unroll
        for (int i = 0; i < 2; ++i) { vA0[i] = nA0[i]; vA1[i] = nA1[i]; }
        if constexpr (ALIGN_EPI) { if (wr == 1) PG8_BAR; }
    }
    PG8_WAIT_V(0);
    if constexpr (!ALIGN_EPI) { if (wr == 0) PG8_BAR; }
    PG8_BAR;
    if constexpr (Epi::AFTER_DRAIN) { E.fused(acc, cur, wr, wc, fr, fq, lds, wid, lane); S.done(cur); }
#undef PG8_SA
#undef PG8_SB
#undef PG8_STAGE
#undef PG8_LDA
#undef PG8_LDB
#undef PG8_MMA
#undef PG8_WAIT_V
#undef PG8_WAIT_L
#undef PG8_BAR
#undef PG8_SCHED
}
}
constexpr int D = 1024, BATCH = 8, SEQ = 4096, NTOK = BATCH * SEQ;
constexpr int GW = 512, RW = 512, HD = 64, CHUNK = 128;
constexpr int RPROJ = 1696, INW = 2720, ZLD = 2816;
constexpr int NG = 4, EPG = 8, NE = 32, EH = 512;
constexpr int NTHR = 512;
constexpr int LDS_BYTES = 163840;

typedef float f32x16 __attribute__((ext_vector_type(16)));
typedef float f32x4 __attribute__((ext_vector_type(4)));
typedef unsigned u32x4 __attribute__((ext_vector_type(4)));
typedef unsigned u32x2 __attribute__((ext_vector_type(2)));
typedef unsigned short bf16;
#define LAS __attribute__((address_space(3)))

constexpr size_t MiB = 1u << 20;
constexpr size_t W_WINT = 0;
constexpr size_t W_WOUTT = 6 * MiB;
constexpr size_t W_LORAT = 8 * MiB;
constexpr size_t W_WC = 9 * MiB;
constexpr size_t W_MOD = 10 * MiB;
constexpr size_t W_TAB = 11 * MiB;
constexpr size_t W_WGUT = 16 * MiB;
constexpr size_t W_WDT = 80 * MiB;
constexpr size_t W_H1 = 112 * MiB;
constexpr size_t W_Z = 176 * MiB;
constexpr size_t W_YCAT = 352 * MiB;
constexpr size_t W_LO = 416 * MiB;
constexpr size_t WS_NEED = 512 * MiB;
constexpr size_t T_TOKE = W_TAB;
constexpr size_t T_TOKW = W_TAB + 512 * 1024;
constexpr size_t T_ROWTOK = W_TAB + 1024 * 1024;
constexpr size_t T_ROWAID = W_TAB + 1536 * 1024;
constexpr size_t T_ROWW = W_TAB + 2048 * 1024;
constexpr size_t T_TILEE = W_TAB + 2560 * 1024;
constexpr size_t T_CTL = W_TAB + 3072 * 1024;
constexpr size_t T_BAR = W_TAB + 3584 * 1024;

struct Params {
    const float* in[31];
    float* out;
    unsigned char* ws;
};
typedef const __attribute__((address_space(4))) Params& PRef;
typedef const __attribute__((address_space(4))) Params* PPtr;
__device__ __forceinline__ PPtr opq(PPtr k) { asm volatile("" : "+s"(k)); return k; }
enum { I_X = 0, I_C, I_ADAW, I_ADAB, I_N1G, I_WIN, I_GLNW, I_GLNB, I_GWS, I_GBS, I_MU, I_W0, I_W2, I_A0, I_A2, I_G2, I_KK, I_KA, I_RK, I_GNW, I_GNB, I_WOUT, I_N2G, I_RGW, I_RGB, I_REW, I_REB, I_WG, I_WU, I_WD, I_FNG };

__device__ __forceinline__ float wave_sum(float v) {
#pragma unroll
    for (int o = 1; o < 64; o <<= 1) v += __shfl_xor(v, o);
    return v;
}
#define DPP_ADD(v, ctrl) v += __builtin_bit_cast(float, __builtin_amdgcn_update_dpp(0, __builtin_bit_cast(int, v), ctrl, 0xf, 0xf, false))
__device__ __forceinline__ float wave_sum_dpp(float v) {
    DPP_ADD(v, 0xB1); DPP_ADD(v, 0x4E); DPP_ADD(v, 0x141); DPP_ADD(v, 0x140);
    const int iv = __builtin_bit_cast(int, v);
    const float a = __builtin_bit_cast(float, __builtin_amdgcn_readlane(iv, 0)), b = __builtin_bit_cast(float, __builtin_amdgcn_readlane(iv, 16));
    const float c = __builtin_bit_cast(float, __builtin_amdgcn_readlane(iv, 32)), d = __builtin_bit_cast(float, __builtin_amdgcn_readlane(iv, 48));
    return (a + b) + (c + d);
}
__device__ __forceinline__ float xsum4(float s) {
    s += __builtin_bit_cast(float, __builtin_amdgcn_ds_swizzle(__builtin_bit_cast(int, s), 0x401F));
    float a = s, b = s;
    asm volatile("s_nop 1\n\tv_permlane32_swap_b32 %0, %1\n\ts_nop 1" : "+v"(a), "+v"(b));
    return a + b;
}
__device__ __forceinline__ float wave_sum_v(float v) {
    DPP_ADD(v, 0xB1); DPP_ADD(v, 0x4E); DPP_ADD(v, 0x141); DPP_ADD(v, 0x140);
    return xsum4(v);
}
__device__ __forceinline__ float gelu_tanh(float x) {
    const float u = 0.7978845608028654f * (x + 0.044715f * x * x * x);
    return 0.5f * x * (1.0f + tanhf(u));
}
__device__ __forceinline__ float gelu_fast(float x) {
    const float u2 = -2.302208198f * (x + 0.044715f * x * x * x);
    return x * __builtin_amdgcn_rcpf(1.0f + __builtin_amdgcn_exp2f(u2));
}
__device__ __forceinline__ float sigmoidf_(float x) { return 1.0f / (1.0f + expf(-x)); }
__device__ __forceinline__ float softplusf_(float x) { return fmaxf(x, 0.f) + log1pf(expf(-fabsf(x))); }
__device__ __forceinline__ float bf2f(unsigned short b) { return __uint_as_float(((unsigned)b) << 16); }
__device__ __forceinline__ float bflo(unsigned w) { return __uint_as_float(w << 16); }
__device__ __forceinline__ float bfhi(unsigned w) { return __uint_as_float(w & 0xffff0000u); }
__device__ __forceinline__ unsigned f2bf(float f) { unsigned u = __float_as_uint(f); return (u + 0x7fffu + ((u >> 16) & 1u)) >> 16; }
__device__ __forceinline__ unsigned pk2(float lo, float hi) { return f2bf(lo) | (f2bf(hi) << 16); }
#define XB_TMO      128
#define XB_XCNT(j)  (256  + 64 * (j))
#define XB_XSUB(j)  (1280 + 64 * (j))
#define XB_XGEN(j)  (2304 + 64 * (j))
#define XB_TOP      3328
#define XB_TOPGEN   3392
#define XCD_BAR_WORDS 3456
#define XB_SPIN_CAP (1u << 18)

__device__ __forceinline__ unsigned xb_ld(unsigned* p)              { return __hip_atomic_load(p, __ATOMIC_RELAXED, __HIP_MEMORY_SCOPE_AGENT); }
__device__ __forceinline__ unsigned xb_add(unsigned* p, unsigned v) { return __hip_atomic_fetch_add(p, v, __ATOMIC_RELAXED, __HIP_MEMORY_SCOPE_AGENT); }
__device__ __forceinline__ unsigned xb_xcc_id() { return (unsigned)__builtin_amdgcn_s_getreg((3 << 11) | 20) & 0xFu; }
#define XB_SPIN(cond, bar) do { unsigned _sp = 0; while (cond) { __builtin_amdgcn_s_sleep(1); \
    if ((++_sp & 255u) == 0u) { if (xb_ld(&(bar)[XB_TMO])) break; if (_sp > XB_SPIN_CAP) { atomicAdd(&(bar)[XB_TMO], 1u); break; } } } } while (0)

struct XcdBarrier {
    unsigned* bar; unsigned x;
    volatile LAS unsigned* st;
};

__device__ __forceinline__ XcdBarrier xcd_barrier_post(unsigned* bar, volatile LAS unsigned* st) {
    XcdBarrier b; b.bar = bar; b.x = xb_xcc_id(); b.st = st;
    if (threadIdx.x == 0) (void)xb_add(&bar[XB_XCNT(b.x)], 1u);
    return b;
}
__device__ __forceinline__ void xcd_barrier_complete(unsigned* bar, unsigned x, unsigned& nloc, unsigned& nx) {
    const unsigned G = gridDim.x * gridDim.y * gridDim.z;
    unsigned sum, cnt, mine, sp = 0u;
    for (;;) {
        sum = 0u; cnt = 0u; mine = 0u;
#pragma unroll
        for (unsigned j = 0; j < 16; ++j) { const unsigned c = xb_ld(&bar[XB_XCNT(j)]); sum += c; cnt += (c > 0u) ? 1u : 0u; mine = (j == x) ? c : mine; }
        if (sum == G) break;
        __builtin_amdgcn_s_sleep(1);
        if ((++sp & 255u) == 0u) { if (xb_ld(&bar[XB_TMO])) break; if (sp > XB_SPIN_CAP) { atomicAdd(&bar[XB_TMO], 1u); break; } }
    }
    nloc = mine > 0u ? mine : 1u; nx = cnt > 0u ? cnt : 1u;
}

__device__ __forceinline__ void xcd_barrier(const XcdBarrier& b) {
    asm volatile("s_waitcnt vmcnt(0)" ::: "memory");
    __syncthreads();
    if (threadIdx.x == 0) {
        unsigned* bar = b.bar;
        __builtin_amdgcn_s_waitcnt(0);
        unsigned nloc = b.st[0], nx = b.st[1];
        if (nloc == 0u) { xcd_barrier_complete(bar, b.x, nloc, nx); b.st[0] = nloc; b.st[1] = nx; }
        const unsigned old = xb_add(&bar[XB_XSUB(b.x)], 1u);
        const unsigned gen = old / nloc;
        if (old + 1u == (gen + 1u) * nloc) {
            __builtin_amdgcn_fence(__ATOMIC_RELEASE, "agent");
            asm volatile("s_waitcnt vmcnt(0)" ::: "memory");
            const unsigned og = xb_add(&bar[XB_TOP], 1u);
            const unsigned tg = og / nx;
            if (og + 1u == (tg + 1u) * nx) xb_add(&bar[XB_TOPGEN], 1u);
            else XB_SPIN(xb_ld(&bar[XB_TOPGEN]) == tg, bar);
            __builtin_amdgcn_fence(__ATOMIC_ACQUIRE, "agent");
            xb_add(&bar[XB_XGEN(b.x)], 1u);
            asm volatile("s_waitcnt vmcnt(0)" ::: "memory");
        } else {
            XB_SPIN(xb_ld(&bar[XB_XGEN(b.x)]) == gen, bar);
            __builtin_amdgcn_fence(__ATOMIC_ACQUIRE, "agent");
            asm volatile("s_waitcnt vmcnt(0)" ::: "memory");
        }
    }
    __syncthreads();
}
struct TrItem { const float* W; bf16* WT; int K, N; long row_off; int item; };
__device__ __forceinline__ void p0_tr_load(const TrItem& it, float (&tv)[32], int lane) {
    const int nblk = it.N / 32, kb = it.item / nblk, nb = it.item % nblk, k0 = 64 * kb, n0 = 32 * nb;
#pragma unroll
    for (int i = 0; i < 32; ++i) tv[i] = it.W[(size_t)(k0 + 2 * i + (lane >> 5)) * it.N + n0 + (lane & 31)];
}
__device__ __forceinline__ void p0_tr_store(const TrItem& it, const float (&tv)[32], LAS float* scr, int lane) {
    const int nblk = it.N / 32, kb = it.item / nblk, nb = it.item % nblk, k0 = 64 * kb, n0 = 32 * nb;
#pragma unroll
    for (int i = 0; i < 32; ++i) scr[(2 * i + (lane >> 5)) * 33 + (lane & 31)] = tv[i];
    asm volatile("s_waitcnt lgkmcnt(0)" ::: "memory");
    const int c = lane & 7;
#pragma unroll
    for (int j = 0; j < 4; ++j) { const int n = (lane >> 3) + 8 * j; const LAS float* s = scr + (8 * c) * 33 + n;
        u32x4 o; o.x = pk2(s[0 * 33], s[1 * 33]); o.y = pk2(s[2 * 33], s[3 * 33]); o.z = pk2(s[4 * 33], s[5 * 33]); o.w = pk2(s[6 * 33], s[7 * 33]);
        *(u32x4*)(it.WT + (size_t)(it.row_off + n0 + n) * it.K + k0 + 8 * c) = o; }
    asm volatile("s_waitcnt lgkmcnt(0)" ::: "memory");
}
__device__ __forceinline__ void p0_mod_item(PRef p, LAS float* red, int item) {
    const int tid = otid(), col = tid & 63, ks = __builtin_amdgcn_readfirstlane(tid >> 6), n = item * 64 + col;
    const float* __restrict__ c = p.in[I_C]; const float* __restrict__ w = p.in[I_ADAW];
    float acc[8];
#pragma unroll
    for (int b = 0; b < 8; ++b) acc[b] = 0.f;
#pragma unroll 16
    for (int k = ks * 128; k < ks * 128 + 128; ++k) {
        const float wv = w[(size_t)k * (6 * D) + n];
#pragma unroll
        for (int b = 0; b < 8; ++b) acc[b] = fmaf(c[b * D + k], wv, acc[b]);
    }
#pragma unroll
    for (int b = 0; b < 8; ++b) red[(ks * 8 + b) * 64 + col] = acc[b];
    __syncthreads();
    { const int b = tid >> 6; float s = 0.f;
#pragma unroll
      for (int q = 0; q < 8; ++q) s += red[(q * 8 + b) * 64 + col];
      ((float*)(p.ws + W_MOD))[b * 6 * D + n] = s + p.in[I_ADAB][n]; }
    __syncthreads();
}
template <bool WITH_MOE>
__device__ __forceinline__ void p0_prep(PRef p, LAS unsigned char* lds, int bid, int nb) {
    const int tid = otid(), lane = tid & 63, wave = __builtin_amdgcn_readfirstlane(tid >> 6);
#ifndef P0DUP
#define P0DUP 0
#endif
#pragma unroll 1
    for (int d_ = 0; d_ < (P0DUP & 1) + 1; ++d_)
    for (int it = bid; it < 96; it += nb) p0_mod_item(p, (LAS float*)lds, it);
    { bf16* lt = (bf16*)(p.ws + W_LORAT);
      for (int i = bid * NTHR + tid; i < 1536 * 256; i += nb * NTHR) { const int n = i >> 8, k = i & 255; float v = 0.f;
          if (n < 512) { if (k < 32) v = p.in[I_W2][k * 512 + n]; }
          else if (n < 1024) { if (k >= 32 && k < 64) v = p.in[I_A2][(k - 32) * 512 + (n - 512)]; }
          else { if (k >= 64 && k < 160) v = p.in[I_G2][(k - 64) * 512 + (n - 1024)]; }
          lt[i] = (bf16)f2bf(v); }
      bf16* wc = (bf16*)(p.ws + W_WC);
      for (int i = bid * NTHR + tid; i < 8 * 128 * 128; i += nb * NTHR) { const int s = i & 127, t = (i >> 7) & 127; wc[i] = (s <= t) ? (bf16)f2bf(p.in[I_GWS][i]) : (bf16)0; }
      bf16* wpad = (bf16*)(p.ws + W_WINT) + (size_t)INW * D;
      for (int i = bid * NTHR + tid; i < (ZLD - INW) * D; i += nb * NTHR) wpad[i] = 0; }
    LAS float* scr = (LAS float*)(lds + wave * 16384);
    const int gw = bid * 8 + wave, NGW = nb * 8;
    constexpr int I_IN = (D / 64) * (INW / 32), I_OUT = (D / 64) * (D / 32), I_GU = (D / 64) * (EH / 32), I_DN = (EH / 64) * (D / 32);
    constexpr int NIT = I_IN + I_OUT + (WITH_MOE ? NE * (2 * I_GU + I_DN) : 0);
    auto decode = [&](int it) -> TrItem {
        int r = it;
        if (r < I_IN) return TrItem{p.in[I_WIN], (bf16*)(p.ws + W_WINT), D, INW, 0, r}; r -= I_IN;
        if (r < I_OUT) return TrItem{p.in[I_WOUT], (bf16*)(p.ws + W_WOUTT), D, D, 0, r}; r -= I_OUT;
        const int e = r / (2 * I_GU + I_DN); r -= e * (2 * I_GU + I_DN);
        if (r < 2 * I_GU) {
            const int up = r >= I_GU; if (up) r -= I_GU;
            const int nbk = r % (EH / 32), hb = nbk * 32;
            const long row_off = (long)e * 1024 + (hb / 128) * 256 + up * 128 + (hb % 128) - hb;
            return TrItem{(up ? p.in[I_WU] : p.in[I_WG]) + (size_t)e * D * EH, (bf16*)(p.ws + W_WGUT), D, EH, row_off, r}; }
        r -= 2 * I_GU;
        return TrItem{p.in[I_WD] + (size_t)e * EH * D, (bf16*)(p.ws + W_WDT), EH, D, (long)e * 1024, r};
    };
    float tvA[32], tvB[32];
#pragma unroll 1
    for (int d2_ = 0; d2_ < ((P0DUP >> 1) & 1) + 1; ++d2_) {
    int it = gw;
    if (it < NIT) { TrItem cur = decode(it); p0_tr_load(cur, tvA, lane);
#pragma unroll 1
        for (;;) {
            const int itn = it + NGW; TrItem nxt = cur;
            if (itn < NIT) { nxt = decode(itn); p0_tr_load(nxt, tvB, lane); }
            p0_tr_store(cur, tvA, scr, lane);
            if (itn >= NIT) break;
            const int itn2 = itn + NGW; cur = nxt;
            if (itn2 < NIT) { cur = decode(itn2); p0_tr_load(cur, tvA, lane); }
            p0_tr_store(nxt, tvB, scr, lane);
            if (itn2 >= NIT) break;
            it = itn2;
        } }
    }
}
__device__ __forceinline__ void p1_h1(PRef p, int bid, int nb) {
    const float* __restrict__ x = p.in[I_X]; const float* __restrict__ g = p.in[I_N1G]; const float* mod = (const float*)(p.ws + W_MOD);
    bf16* H1 = (bf16*)(p.ws + W_H1);
    const int tid_ = otid(), lane = tid_ & 63, wv = tid_ >> 6;
#pragma unroll 1
    for (int row = (bid * 8 + wv) * 2; row < NTOK; row += nb * 16) {
        const int b = row / SEQ;
        const f32x4* xr = (const f32x4*)(x + (size_t)row * D) + lane;
        f32x4 v[2][4]; float s0 = 0.f, s1 = 0.f;
#pragma unroll
        for (int j = 0; j < 4; ++j) { v[0][j] = xr[64 * j]; v[1][j] = xr[256 + 64 * j]; }
#pragma unroll
        for (int j = 0; j < 4; ++j) { s0 += (v[0][j][0] * v[0][j][0] + v[0][j][1] * v[0][j][1]) + (v[0][j][2] * v[0][j][2] + v[0][j][3] * v[0][j][3]);
                                      s1 += (v[1][j][0] * v[1][j][0] + v[1][j][1] * v[1][j][1]) + (v[1][j][2] * v[1][j][2] + v[1][j][3] * v[1][j][3]); }
        const float r0 = rsqrtf(wave_sum_dpp(s0) * (1.0f / D) + 1e-6f), r1 = rsqrtf(wave_sum_dpp(s1) * (1.0f / D) + 1e-6f);
        const float* sh = mod + b * 6 * D; const float* sc = mod + b * 6 * D + D;
        u32x2* o = (u32x2*)(H1 + (size_t)row * D) + lane;
#pragma unroll
        for (int j = 0; j < 4; ++j) {
            const int c0 = (lane + 64 * j) * 4;
            const f32x4 gg = *(const f32x4*)(g + c0), ss = *(const f32x4*)(sc + c0), hh = *(const f32x4*)(sh + c0);
            f32x4 y0, y1;
#pragma unroll
            for (int q = 0; q < 4; ++q) { const float m = gg[q] * (1.0f + ss[q]); y0[q] = v[0][j][q] * r0 * m + hh[q]; y1[q] = v[1][j][q] * r1 * m + hh[q]; }
            u32x2 w0, w1; w0.x = pk2(y0[0], y0[1]); w0.y = pk2(y0[2], y0[3]); w1.x = pk2(y1[0], y1[1]); w1.y = pk2(y1[2], y1[3]);
            o[64 * j] = w0; o[256 + 64 * j] = w1;
        }
    }
}
struct EpiZ {
    static constexpr bool PERM = true, AFTER_DRAIN = false;
    bf16* Z;
    __device__ __forceinline__ void operator()(const f32x4 (&acc)[2][2][4][2], const pg8::Unit& u, int wr, int wc, int fr, int fq) const {
        const int row0 = u.pm * 256 + wr * 64 + fr, col0 = u.pn * 256 + wc * 32 + 8 * fq;
        const bool act = u.pn < 4;
#pragma unroll
        for (int ai = 0; ai < 2; ++ai)
#pragma unroll
            for (int m = 0; m < 4; ++m) { bf16* rowp = Z + (size_t)(row0 + ai * 128 + m * 16) * ZLD + col0;
#pragma unroll
                for (int bj = 0; bj < 2; ++bj) { f32x4 v0 = acc[ai][bj][m][0], v1 = acc[ai][bj][m][1];
                    if (act) {
#pragma unroll
                        for (int q = 0; q < 4; ++q) { v0[q] = gelu_fast(v0[q]); v1[q] = gelu_fast(v1[q]); } }
                    u32x4 w; w.x = pg8::cvt_pk_bf16(v0[0], v0[1]); w.y = pg8::cvt_pk_bf16(v0[2], v0[3]); w.z = pg8::cvt_pk_bf16(v1[0], v1[1]); w.w = pg8::cvt_pk_bf16(v1[2], v1[3]);
                    *(u32x4*)(rowp + bj * 128) = w; } }
    }
};
constexpr int VNT_PITCH = 272;
__device__ __forceinline__ void p3_gmlp_unit(PRef p, LAS unsigned char* lds, int chunk) {
    typedef short bf16x8 __attribute__((ext_vector_type(8)));
    const int tid = otid(), lane = tid & 63, wave = __builtin_amdgcn_readfirstlane(tid >> 6);
    const bf16* Z = (const bf16*)(p.ws + W_Z); bf16* ycat = (bf16*)(p.ws + W_YCAT);
    const int t0 = chunk * CHUNK;
    { float lw[8], lb[8];
#pragma unroll
      for (int j = 0; j < 8; ++j) { lw[j] = p.in[I_GLNW][lane + 64 * j]; lb[j] = p.in[I_GLNB][lane + 64 * j]; }
#pragma unroll 1
      for (int sp4 = 0; sp4 < 4; ++sp4) {
          const int s4 = wave * 16 + sp4 * 4;
          float a4[4][8];
#pragma unroll
          for (int u = 0; u < 4; ++u) { const bf16* vp = Z + (size_t)(t0 + s4 + u) * ZLD + 512 + lane;
#pragma unroll
              for (int j = 0; j < 8; ++j) a4[u][j] = bf2f(vp[64 * j]); }
#pragma unroll
          for (int pr = 0; pr < 2; ++pr) {
              const int s = s4 + pr * 2;
              float (&a)[8] = a4[pr * 2]; float (&b)[8] = a4[pr * 2 + 1]; float sa = 0.f, sb = 0.f;
#pragma unroll
              for (int j = 0; j < 8; ++j) { sa += a[j]; sb += b[j]; }
              const float ma = wave_sum_dpp(sa) * (1.f / 512.f), mb = wave_sum_dpp(sb) * (1.f / 512.f); float qa = 0.f, qb = 0.f;
#pragma unroll
              for (int j = 0; j < 8; ++j) { a[j] -= ma; b[j] -= mb; qa += a[j] * a[j]; qb += b[j] * b[j]; }
              const float ra = rsqrtf(wave_sum_dpp(qa) * (1.f / 512.f) + 1e-5f), rb = rsqrtf(wave_sum_dpp(qb) * (1.f / 512.f) + 1e-5f);
#pragma unroll
              for (int j = 0; j < 8; ++j) { const unsigned w = pk2(a[j] * ra * lw[j] + lb[j], b[j] * rb * lw[j] + lb[j]);
                  *(LAS unsigned*)(lds + (lane + 64 * j) * VNT_PITCH + s * 2) = w; }
          }
      } }
    __syncthreads();
    const bf16* Wc = (const bf16*)(p.ws + W_WC) + (size_t)wave * CHUNK * CHUNK;
    const int fr = lane & 15, fq = lane >> 4;
    const LAS unsigned char* abase = lds + (wave * 64 + fr) * VNT_PITCH + fq * 16;
    for (int tt = 0; tt < 8; ++tt) {
        f32x4 acc[4];
#pragma unroll
        for (int dt = 0; dt < 4; ++dt) acc[dt] = (f32x4){0.f, 0.f, 0.f, 0.f};
        const int nks = ((tt * 16 + 15) >> 5) + 1;
        for (int ks = 0; ks < nks; ++ks) {
            const bf16x8 bfr = *(const bf16x8*)(Wc + (size_t)(tt * 16 + fr) * CHUNK + ks * 32 + fq * 8);
#pragma unroll
            for (int dt = 0; dt < 4; ++dt) {
                const bf16x8 afr = *(const LAS bf16x8*)(abase + dt * 16 * VNT_PITCH + ks * 64);
                acc[dt] = __builtin_amdgcn_mfma_f32_16x16x32_bf16(afr, bfr, acc[dt], 0, 0, 0);
            }
        }
        const int tl = tt * 16 + fr, t = t0 + tl;
        const float bsv = p.in[I_GBS][wave * CHUNK + tl];
#pragma unroll
        for (int dt = 0; dt < 4; ++dt) {
            const int c = wave * 64 + dt * 16 + fq * 4;
            const u32x2 uw = *(const u32x2*)(Z + (size_t)t * ZLD + c);
            u32x2 o; o.x = pk2(bflo(uw.x) * (acc[dt][0] + bsv), bfhi(uw.x) * (acc[dt][1] + bsv)); o.y = pk2(bflo(uw.y) * (acc[dt][2] + bsv), bfhi(uw.y) * (acc[dt][3] + bsv));
            *(u32x2*)(ycat + (size_t)t * 1024 + c) = o;
        }
    }
    __syncthreads();
}
constexpr size_t W_X1B = 240 * MiB;
struct EpiX1 {
    static constexpr bool PERM = true, AFTER_DRAIN = false;
    const float* x; const float* mod; bf16* x1;
    __device__ __forceinline__ void operator()(const f32x4 (&acc)[2][2][4][2], const pg8::Unit& u, int wr, int wc, int fr, int fq) const {
        const int row0 = u.pm * 256 + wr * 64 + fr, col0 = u.pn * 256 + wc * 32 + 8 * fq;
        const int b = (u.pm * 256) / SEQ;
        const float* gt = mod + b * 6 * D + 2 * D;
#pragma unroll
        for (int bj = 0; bj < 2; ++bj) { const f32x4 g0 = *(const f32x4*)(gt + col0 + bj * 128), g1 = *(const f32x4*)(gt + col0 + bj * 128 + 4);
#pragma unroll
            for (int ai = 0; ai < 2; ++ai)
#pragma unroll
                for (int m = 0; m < 4; ++m) { const size_t off = (size_t)(row0 + ai * 128 + m * 16) * D + col0 + bj * 128;
                    const f32x4 x0 = *(const f32x4*)(x + off), xb = *(const f32x4*)(x + off + 4);
                    const f32x4 v0 = x0 + g0 * acc[ai][bj][m][0], v1 = xb + g1 * acc[ai][bj][m][1];
                    u32x4 w; w.x = pg8::cvt_pk_bf16(v0[0], v0[1]); w.y = pg8::cvt_pk_bf16(v0[2], v0[3]); w.z = pg8::cvt_pk_bf16(v1[0], v1[1]); w.w = pg8::cvt_pk_bf16(v1[2], v1[3]);
                    *(u32x4*)(x1 + off) = w; } }
    }
};
constexpr size_t W_A2 = 112 * MiB;
constexpr size_t W_Q = 112 * MiB;
constexpr size_t W_Y2 = 144 * MiB;
constexpr size_t T_RK = W_TAB + 4 * MiB;
constexpr size_t O_M = 0, O_N = 64 * MiB;
constexpr size_t W_S = 176 * MiB;
constexpr int SCL = 64, NCH = SEQ / SCL;

__device__ __forceinline__ float sigmoid_fast(float x) { return __builtin_amdgcn_rcpf(1.0f + __builtin_amdgcn_exp2f(-1.4426950409f * x)); }
__device__ __forceinline__ void p3_lorain(PRef p, int bid, int nb) {
    const bf16* Z = (const bf16*)(p.ws + W_Z); bf16* A2 = (bf16*)(p.ws + W_A2);
    const int tid = otid(), j = tid & 255, sub = tid >> 8;
    const float muj = (j < 160) ? p.in[I_MU][1536 + j] : 0.f;
#pragma unroll 1
    for (int blk = bid; blk < NTOK / 128; blk += nb) {
        const int ts = blk * 128 + sub * 64;
        if (j < 160) {
            const bf16* zp = Z + (size_t)ts * ZLD + 2560 + j; bf16* ap = A2 + (size_t)ts * 256 + j;
            float prev = (ts % SEQ == 0) ? 0.f : bf2f(zp[-ZLD]);
#pragma unroll 1
            for (int t0 = 0; t0 < 64; t0 += 8) { float cur[8];
#pragma unroll
                for (int q = 0; q < 8; ++q) cur[q] = bf2f(zp[(size_t)(t0 + q) * ZLD]);
#pragma unroll
                for (int q = 0; q < 8; ++q) { float v = cur[q] + (prev - cur[q]) * muj; prev = cur[q];
                    if (j < 32) v = tanhf(v); else if (j >= 64) v = sigmoidf_(v);
                    ap[(size_t)(t0 + q) * 256] = (bf16)f2bf(v); } }
        } else { bf16* ap = A2 + (size_t)ts * 256 + j;
#pragma unroll 8
            for (int t = 0; t < 64; ++t) ap[(size_t)t * 256] = 0; }
    }
}
struct EpiLO {
    static constexpr bool PERM = true, AFTER_DRAIN = false;
    bf16* LO; const float* w0; const float* a0;
    __device__ __forceinline__ void operator()(const f32x4 (&acc)[2][2][4][2], const pg8::Unit& u, int wr, int wc, int fr, int fq) const {
        const int row0 = u.pm * 256 + wr * 64 + fr, col0 = u.pn * 256 + wc * 32 + 8 * fq, kind = u.pn >> 1;
#pragma unroll
        for (int bj = 0; bj < 2; ++bj) {
            f32x4 bv[2];
#pragma unroll
            for (int n = 0; n < 2; ++n) { const int ch = col0 + bj * 128 + 4 * n - kind * 512;
                bv[n] = kind == 0 ? *(const f32x4*)(w0 + ch) : kind == 1 ? *(const f32x4*)(a0 + ch) : (f32x4){0.f, 0.f, 0.f, 0.f}; }
#pragma unroll
            for (int ai = 0; ai < 2; ++ai)
#pragma unroll
                for (int m = 0; m < 4; ++m) { bf16* rowp = LO + (size_t)(row0 + ai * 128 + m * 16) * 1536 + col0 + bj * 128;
                    f32x4 v0 = acc[ai][bj][m][0] + bv[0], v1 = acc[ai][bj][m][1] + bv[1];
                    if (kind < 2) { const float sc = kind == 0 ? -0.6065306597f : 1.0f;
#pragma unroll
                        for (int q = 0; q < 4; ++q) { v0[q] = sc * sigmoid_fast(v0[q]); v1[q] = sc * sigmoid_fast(v1[q]); } }
                    u32x4 w; w.x = pg8::cvt_pk_bf16(v0[0], v0[1]); w.y = pg8::cvt_pk_bf16(v0[2], v0[3]); w.z = pg8::cvt_pk_bf16(v1[0], v1[1]); w.w = pg8::cvt_pk_bf16(v1[2], v1[3]);
                    *(u32x4*)rowp = w;
                    asm volatile("" ::: "memory"); }
        }
    }
};
constexpr int SC_TS = 8;
__device__ __forceinline__ void p5a_chunk(PRef p, LAS unsigned char* lds, int q) {
    typedef float f32x2 __attribute__((ext_vector_type(2)));
    const int tid_ = otid(), lane = tid_ & 63, wave = __builtin_amdgcn_readfirstlane(tid_ >> 6);
    const int seq = q / NCH, c = q % NCH, b = seq >> 3, h = seq & 7;
    const int tb = b * SEQ + c * SCL, hc = h * 64 + lane;
    const bf16* Z = (const bf16*)(p.ws + W_Z); const bf16* LO = (const bf16*)(p.ws + W_LO);
    bf16* Qo = (bf16*)(p.ws + W_Q); bf16* Y2o = (bf16*)(p.ws + W_Y2); bf16* VLo = (bf16*)(p.ws + W_YCAT); float* RKo = (float*)(p.ws + T_RK);
    LAS float* vec = (LAS float*)(lds + wave * (SC_TS * 6 * 256));
    const float mur = p.in[I_MU][hc], muk = p.in[I_MU][512 + hc], muv = p.in[I_MU][1024 + hc];
    const float kkc = p.in[I_KK][hc], kac = p.in[I_KA][hc], rkc = p.in[I_RK][hc];
    float rp = 0.f, kp = 0.f, vp = 0.f;
    if (c != 0) { const bf16* zp = Z + (size_t)(tb - 1) * ZLD + 1024 + hc; rp = bf2f(zp[0]); kp = bf2f(zp[512]); vp = bf2f(zp[1024]); }
    f32x2 Mr[32], Nr[32];
#pragma unroll
    for (int k = 0; k < 32; ++k) { Mr[k] = (f32x2){(2 * k == lane) ? 1.f : 0.f, (2 * k + 1 == lane) ? 1.f : 0.f}; Nr[k] = (f32x2){0.f, 0.f}; }
    for (int sb = 0; sb < SCL / SC_TS; ++sb) {
        const int t0 = tb + sb * SC_TS;
#pragma unroll 1
        for (int sg = 0; sg < SC_TS; sg += 4) { float zr[4], zk[4], zv[4], lw[4], as[4];
          const bf16* zp0 = Z + (unsigned)((t0 + sg) * ZLD + 1024 + hc); const bf16* lp0 = LO + (unsigned)((t0 + sg) * 1536 + hc);
#pragma unroll
          for (int s = 0; s < 4; ++s) { const bf16* zp = zp0 + s * ZLD; const bf16* lp = lp0 + s * 1536;
              zr[s] = bf2f(zp[0]); zk[s] = bf2f(zp[512]); zv[s] = bf2f(zp[1024]); lw[s] = bf2f(lp[0]); as[s] = bf2f(lp[512]); }
#pragma unroll
          for (int s = 0; s < 4; ++s) {
              const float r = zr[s] + (rp - zr[s]) * mur, k = zk[s] + (kp - zk[s]) * muk, v = zv[s] + (vp - zv[s]) * muv;
              rp = zr[s]; kp = zk[s]; vp = zv[s];
              const float kkv = k * kkc;
              const float nrm = sqrtf(wave_sum_dpp(kkv * kkv));
              const float kk = kkv / fmaxf(nrm, 1e-12f);
              const float k2 = k * (1.0f + (as[s] - 1.0f) * kac);
              const float rk = wave_sum_dpp(r * k2 * rkc);
              LAS float* o = vec + (sg + s) * 384 + lane;
              o[0] = __builtin_amdgcn_exp2f(1.4426950409f * lw[s]); o[64] = -kk; o[128] = kk * as[s]; o[192] = k2; o[256] = r; o[320] = v;
              VLo[(unsigned)((t0 + sg + s) * 1024 + 512 + hc)] = (bf16)f2bf(v);
              if (lane == 0) RKo[(unsigned)((t0 + sg + s) * 8 + h)] = rk;
          } }
        asm volatile("s_waitcnt lgkmcnt(0)" ::: "memory");
        for (int s = 0; s < SC_TS; ++s) {
            const LAS float* vs = vec + s * 384;
            const float vi = vs[320 + lane];
            f32x2 saM = {0.f, 0.f}, saN = {0.f, 0.f};
#pragma unroll
            for (int k4 = 0; k4 < 16; ++k4) { const f32x4 a4 = *(const LAS f32x4*)(vs + 64 + 4 * k4);
                const f32x2 a0 = {a4[0], a4[1]}, a1 = {a4[2], a4[3]};
                saM += Mr[2 * k4] * a0; saN += Nr[2 * k4] * a0; saM += Mr[2 * k4 + 1] * a1; saN += Nr[2 * k4 + 1] * a1;
                if ((k4 & 3) == 3) asm volatile("" ::: "memory"); }
            const float sM = saM[0] + saM[1], sN = saN[0] + saN[1];
            const f32x2 sM2 = {sM, sM}, sN2 = {sN, sN}, vi2 = {vi, vi};
            f32x2 yM = {0.f, 0.f}, yN = {0.f, 0.f};
#pragma unroll
            for (int k4 = 0; k4 < 16; ++k4) {
                const f32x4 w4 = *(const LAS f32x4*)(vs + 4 * k4), b4 = *(const LAS f32x4*)(vs + 128 + 4 * k4), k4v = *(const LAS f32x4*)(vs + 192 + 4 * k4), r4 = *(const LAS f32x4*)(vs + 256 + 4 * k4);
#pragma unroll
                for (int hh = 0; hh < 2; ++hh) {
                    const f32x2 w2 = {w4[2 * hh], w4[2 * hh + 1]}, b2 = {b4[2 * hh], b4[2 * hh + 1]}, k2 = {k4v[2 * hh], k4v[2 * hh + 1]}, r2 = {r4[2 * hh], r4[2 * hh + 1]};
                    const int kx = 2 * k4 + hh;
                    Mr[kx] = Mr[kx] * w2 + sM2 * b2;
                    Nr[kx] = Nr[kx] * w2 + (sN2 * b2 + vi2 * k2);
                    yM += Mr[kx] * r2; yN += Nr[kx] * r2;
                }
                asm volatile("" ::: "memory");
            }
            const unsigned oo = (unsigned)((t0 + s) * 512 + hc);
            Qo[oo] = (bf16)f2bf(yM[0] + yM[1]); Y2o[oo] = (bf16)f2bf(yN[0] + yN[1]);
        }
        asm volatile("s_waitcnt lgkmcnt(0)" ::: "memory");
    }
    f32x4* Mo = (f32x4*)((unsigned char*)p.out + O_M + (size_t)q * 16384 + lane * 256);
    f32x4* No = (f32x4*)((unsigned char*)p.out + O_N + (size_t)q * 16384 + lane * 256);
#pragma unroll
    for (int k4 = 0; k4 < 16; ++k4) { Mo[k4] = (f32x4){Mr[2 * k4][0], Mr[2 * k4][1], Mr[2 * k4 + 1][0], Mr[2 * k4 + 1][1]}; No[k4] = (f32x4){Nr[2 * k4][0], Nr[2 * k4][1], Nr[2 * k4 + 1][0], Nr[2 * k4 + 1][1]}; }
}
__device__ __forceinline__ void p5b_chain(PRef p, LAS unsigned char* lds, int item) {
    typedef float f32x2 __attribute__((ext_vector_type(2)));
    const int tid = otid(), r = tid >> 5, j0 = (tid & 31) * 2, seq = (item & 7) + 8 * (item >> 5), rg = (item >> 3) & 3;
    const unsigned char* Mb = (const unsigned char*)p.out + O_M + (size_t)seq * NCH * 16384;
    const unsigned char* Nb = (const unsigned char*)p.out + O_N + (size_t)seq * NCH * 16384 + (size_t)(rg * 16 + r) * 256 + j0 * 4;
    unsigned char* Sb = p.ws + W_S + (size_t)seq * NCH * 16384 + (size_t)(rg * 16 + r) * 256 + j0 * 4;
    f32x2 sreg = {0.f, 0.f};
    f32x4 m0[2], m1[2], m2[2], m3[2]; f32x2 n0, n1, n2, n3;
#define P5B_LOAD(mm, nn, cc) do { const f32x4* mp = (const f32x4*)(Mb + (size_t)(cc) * 16384) + tid; mm[0] = mp[0]; mm[1] = mp[512]; nn = *(const f32x2*)(Nb + (size_t)(cc) * 16384); } while (0)
#define P5B_BAR() do { asm volatile("s_waitcnt lgkmcnt(0)" ::: "memory"); __builtin_amdgcn_s_barrier(); asm volatile("" ::: "memory"); } while (0)
#define P5B_STEP(mm, nn, cc) do { \
        LAS float* Sl = (LAS float*)(lds + ((cc) & 1) * 20480); LAS float* Ml = Sl + 1024; \
        *(LAS f32x4*)(Ml + tid * 4) = mm[0]; *(LAS f32x4*)(Ml + 2048 + tid * 4) = mm[1]; *(LAS f32x2*)(Sl + r * 64 + j0) = sreg; \
        *(f32x2*)(Sb + (size_t)(cc) * 16384) = sreg; \
        f32x2 acc = nn; \
        P5B_BAR(); \
        if ((cc) + 4 < NCH) P5B_LOAD(mm, nn, (cc) + 4); \
        _Pragma("unroll 16") for (int i = 0; i < 64; ++i) { const float sv = Sl[r * 64 + i]; const f32x2 mv = *(const LAS f32x2*)(Ml + i * 64 + j0); acc += (f32x2){sv, sv} * mv; } \
        sreg = acc; } while (0)
    __syncthreads();
    P5B_LOAD(m0, n0, 0); P5B_LOAD(m1, n1, 1); P5B_LOAD(m2, n2, 2); P5B_LOAD(m3, n3, 3);
    for (int c = 0; c < NCH; c += 4) { P5B_STEP(m0, n0, c); P5B_STEP(m1, n1, c + 1); P5B_STEP(m2, n2, c + 2); P5B_STEP(m3, n3, c + 3); }
    __syncthreads();
#undef P5B_LOAD
#undef P5B_STEP
#undef P5B_BAR
}
#ifndef P5C_MASK
#define P5C_MASK(c, h, tt) true
#endif
__device__ __forceinline__ void p5c_chunk(PRef p, int q) {
    typedef short bf16x8 __attribute__((ext_vector_type(8)));
    const int lane = otid() & 63, fr = lane & 15, fq = lane >> 4;
    const int seq = q / NCH, c = q % NCH, b = seq >> 3, h = seq & 7, tb = b * SEQ + c * SCL;
    const bf16* Qi = (const bf16*)(p.ws + W_Q); const bf16* Y2i = (const bf16*)(p.ws + W_Y2);
    const float* RKi = (const float*)(p.ws + T_RK); const bf16* LO = (const bf16*)(p.ws + W_LO); bf16* ycat = (bf16*)(p.ws + W_YCAT);
    const float* Sc = (const float*)(p.ws + W_S + (size_t)q * 16384);
    bf16x8 sa[4][2];
#pragma unroll
    for (int vt = 0; vt < 4; ++vt)
#pragma unroll
        for (int ks = 0; ks < 2; ++ks) { const f32x4* sp = (const f32x4*)(Sc + (vt * 16 + fr) * 64 + ks * 32 + fq * 8); const f32x4 x0 = sp[0], x1 = sp[1];
            u32x4 w; w.x = pg8::cvt_pk_bf16(x0[0], x0[1]); w.y = pg8::cvt_pk_bf16(x0[2], x0[3]); w.z = pg8::cvt_pk_bf16(x1[0], x1[1]); w.w = pg8::cvt_pk_bf16(x1[2], x1[3]);
            sa[vt][ks] = __builtin_bit_cast(bf16x8, w); }
    f32x4 gw[4], gb[4];
#pragma unroll
    for (int vt = 0; vt < 4; ++vt) { gw[vt] = *(const f32x4*)(p.in[I_GNW] + h * 64 + vt * 16 + fq * 4); gb[vt] = *(const f32x4*)(p.in[I_GNB] + h * 64 + vt * 16 + fq * 4); }
#pragma unroll 1
    for (int tt = 0; tt < SCL / 16; ++tt) {
        const int t = tb + tt * 16 + fr;
        const unsigned tq = (unsigned)(t * 512 + h * 64);
        const bf16x8 qb0 = *(const bf16x8*)(Qi + (tq + fq * 8)), qb1 = *(const bf16x8*)(Qi + (tq + 32 + fq * 8));
        f32x4 y[4]; float s = 0.f;
#pragma unroll
        for (int vt = 0; vt < 4; ++vt) {
            const u32x2 yw = *(const u32x2*)(Y2i + (tq + vt * 16 + fq * 4));
            f32x4 a = {bflo(yw.x), bfhi(yw.x), bflo(yw.y), bfhi(yw.y)};
            a = __builtin_amdgcn_mfma_f32_16x16x32_bf16(sa[vt][0], qb0, a, 0, 0, 0);
            a = __builtin_amdgcn_mfma_f32_16x16x32_bf16(sa[vt][1], qb1, a, 0, 0, 0);
            y[vt] = a; s += (a[0] + a[1]) + (a[2] + a[3]);
        }
        s = xsum4(s);
        const float m = s * (1.f / 64.f); float qq = 0.f;
#pragma unroll
        for (int vt = 0; vt < 4; ++vt) { y[vt] = y[vt] - m; qq += (y[vt][0] * y[vt][0] + y[vt][1] * y[vt][1]) + (y[vt][2] * y[vt][2] + y[vt][3] * y[vt][3]); }
        qq = xsum4(qq);
        const float rs = rsqrtf(qq * (1.f / 64.f) + 64e-5f);
        const float rk = RKi[(unsigned)(t * 8 + h)];
#pragma unroll
        for (int vt = 0; vt < 4; ++vt) {
            const int cc = h * 64 + vt * 16 + fq * 4;
            const u32x2 vw = *(const u32x2*)(ycat + (unsigned)(t * 1024 + 512 + cc)); const u32x2 gwv = *(const u32x2*)(LO + (unsigned)(t * 1536 + 1024 + cc));
            const f32x4 vv = {bflo(vw.x), bfhi(vw.x), bflo(vw.y), bfhi(vw.y)}, gg = {bflo(gwv.x), bfhi(gwv.x), bflo(gwv.y), bfhi(gwv.y)};
            const f32x4 o = (y[vt] * rs * gw[vt] + gb[vt] + vv * rk) * gg;
            u32x2 ow; ow.x = pk2(o[0], o[1]); ow.y = pk2(o[2], o[3]);
            if (P5C_MASK(c, h, tt)) *(u32x2*)(ycat + (unsigned)(t * 1024 + 512 + cc)) = ow;
        }
    }
}
constexpr size_t W_H2 = 112 * MiB;
constexpr size_t W_XS = 176 * MiB;
constexpr size_t W_HB = 320 * MiB;
constexpr int PROWS = NTOK * 2 + NE * 256, PTILES = PROWS / 256;
constexpr size_t T_HIST = W_TAB + 3 * 1024 * 1024 + 8192;
constexpr size_t T_NT = W_TAB + 3 * 1024 * 1024 + 4096;
constexpr size_t T_BQ = W_TAB + 3 * 1024 * 1024 + 65536;
constexpr int TPW = NTOK / 256;

__device__ __forceinline__ void p1_bq(PRef p, LAS float* red, int b) {
    const int tid = otid();
    const float* sh = (const float*)(p.ws + W_MOD) + b * 6 * D + 3 * D;
    if (tid < 288) { const int q = tid % 36, part = tid / 36; float s = 0.f;
        for (int c = part * 128; c < part * 128 + 128; ++c) s = fmaf(sh[c], q < 4 ? p.in[I_RGW][c * 4 + q] : p.in[I_REW][c * 32 + q - 4], s);
        red[part * 36 + q] = s; }
    __syncthreads();
    if (tid < 36) { float s = 0.f;
#pragma unroll
        for (int k = 0; k < 8; ++k) s += red[k * 36 + tid];
        ((float*)(p.ws + T_BQ))[b * 36 + tid] = s + (tid < 4 ? p.in[I_RGB][tid] : p.in[I_REB][tid - 4]); }
    __syncthreads();
}
__device__ __forceinline__ void p7_route(PRef p, LAS unsigned char* lds, int bid) {
    const int tid = otid(), lane = tid & 63, wave = __builtin_amdgcn_readfirstlane(tid >> 6);
    const float* x1 = p.out; bf16* H2 = (bf16*)(p.ws + W_H2);
    LAS int* hist = (LAS int*)(lds + 147456);
    const int b = (bid * TPW) / SEQ;
    const float* mod = (const float*)(p.ws + W_MOD) + b * 6 * D;
    const float* n2g = p.in[I_N2G];
    for (int ch = tid; ch < 1024 * 8; ch += NTHR) { const int c = ch >> 3, i = ch & 7;
        *(LAS f32x4*)(lds + c * 128 + 16 * (i ^ ((c >> 1) & 7))) = *(const f32x4*)(p.in[I_REW] + c * 32 + i * 4); }
    for (int c = tid; c < 1024; c += NTHR) *(LAS f32x4*)(lds + 131072 + c * 16) = *(const f32x4*)(p.in[I_RGW] + c * 4);
    if (tid < 32) hist[tid] = 0;
    if (tid < 36) *(LAS float*)(lds + 147456 + 128 + 4 * tid) = tid < 4 ? p.in[I_RGB][tid] : p.in[I_REB][tid - 4];
    __syncthreads();
    const int sw = (lane >> 1) & 7;
#pragma unroll 1
    for (int tp = 0; tp < TPW / 8; tp += 2) {
        const int t0 = bid * TPW + wave * (TPW / 8) + tp;
        const float* xr0 = x1 + (size_t)t0 * D; bf16* hr0 = H2 + (size_t)t0 * D;
        float r0, r1;
        { float pa[16], pb[16];
#pragma unroll
          for (int j = 0; j < 16; ++j) { pa[j] = xr0[lane + 64 * j]; pb[j] = xr0[D + lane + 64 * j]; }
          float ss0 = 0.f, ss1 = 0.f;
#pragma unroll
          for (int j = 0; j < 16; ++j) { ss0 = fmaf(pa[j], pa[j], ss0); ss1 = fmaf(pb[j], pb[j], ss1); }
          r0 = rsqrtf(wave_sum_v(ss0) * (1.0f / D) + 1e-6f); r1 = rsqrtf(wave_sum_v(ss1) * (1.0f / D) + 1e-6f); }
        float acc[2][36];
#pragma unroll
        for (int u = 0; u < 2; ++u)
#pragma unroll
            for (int q = 0; q < 36; ++q) acc[u][q] = 0.f;
#pragma unroll 1
        for (int j0 = 0; j0 < 16; j0 += 4) {
            float xa[4], xb[4], gv[4], sv[4];
#pragma unroll
            for (int jj = 0; jj < 4; ++jj) { const int c = lane + 64 * (j0 + jj); xa[jj] = xr0[c]; xb[jj] = xr0[D + c]; gv[jj] = n2g[c] * (1.0f + mod[4 * D + c]); sv[jj] = mod[3 * D + c]; }
#pragma unroll
            for (int jj = 0; jj < 4; ++jj) {
                const int c = lane + 64 * (j0 + jj);
                const float a0 = xa[jj] * r0 * gv[jj] + sv[jj], a1 = xb[jj] * r1 * gv[jj] + sv[jj];
                hr0[c] = (bf16)f2bf(a0); hr0[D + c] = (bf16)f2bf(a1);
                const LAS unsigned char* rowp = lds + c * 128;
                { const f32x4 w = *(const LAS f32x4*)(lds + 131072 + c * 16);
#pragma unroll
                  for (int q = 0; q < 4; ++q) { acc[0][q] = fmaf(a0, w[q], acc[0][q]); acc[1][q] = fmaf(a1, w[q], acc[1][q]); } }
#pragma unroll
                for (int i = 0; i < 8; ++i) { const f32x4 w = *(const LAS f32x4*)(rowp + 16 * (i ^ sw));
#pragma unroll
                    for (int q = 0; q < 4; ++q) { acc[0][4 + 4 * i + q] = fmaf(a0, w[q], acc[0][4 + 4 * i + q]); acc[1][4 + 4 * i + q] = fmaf(a1, w[q], acc[1][4 + 4 * i + q]); } }
            }
        }
#pragma unroll
        for (int u = 0; u < 2; ++u) {
            float lg[36];
#pragma unroll
            for (int q = 0; q < 36; ++q) { lg[q] = wave_sum_v(acc[u][q]); if ((q & 3) == 3) __builtin_amdgcn_sched_barrier(0); }
            unsigned bqo = 147456u + 128u; asm volatile("" : "+v"(bqo));
#pragma unroll
            for (int q = 0; q < 36; ++q) lg[q] += *(const LAS float*)(lds + bqo + 4 * q);
            int gi = 0; float gm = lg[0];
#pragma unroll
            for (int q = 1; q < 4; ++q) if (lg[q] > gm) { gm = lg[q]; gi = q; }
            float gsum = 0.f;
#pragma unroll
            for (int q = 0; q < 4; ++q) gsum += expf(lg[q] - gm);
            const float gp = 1.0f / gsum;
            float el[8];
#pragma unroll
            for (int q = 0; q < 8; ++q) el[q] = gi == 0 ? lg[4 + q] : gi == 1 ? lg[12 + q] : gi == 2 ? lg[20 + q] : lg[28 + q];
            int i0 = 0; float m0 = el[0];
#pragma unroll
            for (int q = 1; q < 8; ++q) if (el[q] > m0) { m0 = el[q]; i0 = q; }
            int i1 = -1; float m1 = -3.0e38f;
#pragma unroll
            for (int q = 0; q < 8; ++q) if (q != i0 && el[q] > m1) { m1 = el[q]; i1 = q; }
            const float p1 = expf(m1 - m0);
            const float w0 = gp / (1.0f + p1), w1 = gp * p1 / (1.0f + p1);
            if (lane == 0) { const int t = t0 + u, e0 = gi * 8 + i0, e1 = gi * 8 + i1;
                int* toke = (int*)(p.ws + T_TOKE); float* tokw = (float*)(p.ws + T_TOKW);
                toke[t * 2] = e0; toke[t * 2 + 1] = e1; tokw[t * 2] = w0; tokw[t * 2 + 1] = w1;
                __hip_atomic_fetch_add(&hist[e0], 1, __ATOMIC_RELAXED, __HIP_MEMORY_SCOPE_WORKGROUP); __hip_atomic_fetch_add(&hist[e1], 1, __ATOMIC_RELAXED, __HIP_MEMORY_SCOPE_WORKGROUP); }
        }
    }
    __syncthreads();
    if (tid < 32) ((int*)(p.ws + T_HIST))[bid * 32 + tid] = hist[tid];
    __syncthreads();
}
__device__ __forceinline__ void p8_place(PRef p, LAS unsigned char* lds, int bid) {
    const int tid = otid(), lane = tid & 63, wave = __builtin_amdgcn_readfirstlane(tid >> 6);
    LAS int* ptot = (LAS int*)lds;
    LAS int* pbef = ptot + 512;
    LAS int* base = pbef + 512;
    LAS int* lcur = base + 32;
    LAS int* posl = lcur + 32;
    LAS int* padb = posl + 256;
    const int* hist = (const int*)(p.ws + T_HIST);
    { const int e = tid & 31, part = tid >> 5; int tot = 0, bef = 0;
#pragma unroll 4
      for (int w = part * 16; w < part * 16 + 16; ++w) { const int c = hist[w * 32 + e]; tot += c; bef += (w < bid) ? c : 0; }
      ptot[part * 32 + e] = tot; pbef[part * 32 + e] = bef; }
    __syncthreads();
    if (tid < 32) { int tot = 0, bef = 0;
#pragma unroll
        for (int k = 0; k < 16; ++k) { tot += ptot[k * 32 + tid]; bef += pbef[k * 32 + tid]; }
        ptot[tid] = tot; pbef[tid] = bef; lcur[tid] = 0; }
    __syncthreads();
    if (tid == 0) { int row = 0;
        for (int e = 0; e < NE; ++e) { const int cnt = ptot[e], nt = (cnt + 255) >> 8; base[e] = row + pbef[e]; padb[e] = row + cnt; padb[32 + e] = row + nt * 256;
            if (bid == 0) { int* te = (int*)(p.ws + T_TILEE); for (int k = 0; k < nt; ++k) te[(row >> 8) + k] = e; }
            row += nt * 256; }
        if (bid == 0) *(int*)(p.ws + T_NT) = row >> 8; }
    __syncthreads();
    int* rowaid = (int*)(p.ws + T_ROWAID); float* roww = (float*)(p.ws + T_ROWW);
    if (tid < 256) { const int a = bid * 256 + tid; const int e = ((const int*)(p.ws + T_TOKE))[a];
        const int pos = base[e] + __hip_atomic_fetch_add(&lcur[e], 1, __ATOMIC_RELAXED, __HIP_MEMORY_SCOPE_WORKGROUP);
        posl[tid] = pos; rowaid[pos] = a; roww[pos] = ((const float*)(p.ws + T_TOKW))[a]; }
    if (bid < NE) for (int r = padb[bid] + tid; r < padb[32 + bid]; r += NTHR) { rowaid[r] = -1; roww[r] = 0.f; }
    __syncthreads();
    __syncthreads();
}
template <bool GATHER_>
struct MoeOrder {
    static constexpr bool GATHER = GATHER_;
    const int* tile_e; const int* rowaid; int nM, G, c;
    __device__ __forceinline__ int rowsrc(int row) const { const int a = rowaid[row]; return (a < 0 ? 0 : a) >> 1; }
    __device__ __forceinline__ bool next(int i, pg8::Unit& u) const {
        const int nwg = nM * 4; const long L = (long)i * G + c; if (L >= nwg) return false;
        int wgid = (int)L; { const int q = nwg / 8, r = nwg % 8, xcd = wgid % 8, off = wgid / 8; wgid = (xcd < r ? xcd * (q + 1) : r * (q + 1) + (xcd - r) * q) + off; }
        const int nig = 8 * 4, gid = wgid / nig, fm = gid * 8, gsz = (nM - fm) < 8 ? (nM - fm) : 8;
        u.pm = fm + ((wgid % nig) % gsz); u.pn = (wgid % nig) / gsz; u.pb = tile_e[u.pm] * 4 + u.pn; return true;
    }
    __device__ __forceinline__ void a_ready(const pg8::Unit&) const {}
    __device__ __forceinline__ void done(const pg8::Unit&) const {}
};
__device__ __forceinline__ float silu_fast(float x) { return x * __builtin_amdgcn_rcpf(1.0f + __builtin_amdgcn_exp2f(-1.4426950409f * x)); }
struct EpiH {
    static constexpr bool PERM = true, AFTER_DRAIN = false;
    bf16* H;
    __device__ __forceinline__ void operator()(const f32x4 (&acc)[2][2][4][2], const pg8::Unit& u, int wr, int wc, int fr, int fq) const {
        const int row0 = u.pm * 256 + wr * 64 + fr, col0 = u.pn * 128 + wc * 32 + 8 * fq;
#pragma unroll
        for (int ai = 0; ai < 2; ++ai)
#pragma unroll
            for (int m = 0; m < 4; ++m) { const f32x4 g0 = acc[ai][0][m][0], g1 = acc[ai][0][m][1], u0 = acc[ai][1][m][0], u1 = acc[ai][1][m][1];
                f32x4 h0, h1;
#pragma unroll
                for (int q = 0; q < 4; ++q) { h0[q] = silu_fast(g0[q]) * u0[q]; h1[q] = silu_fast(g1[q]) * u1[q]; }
                u32x4 w; w.x = pg8::cvt_pk_bf16(h0[0], h0[1]); w.y = pg8::cvt_pk_bf16(h0[2], h0[3]); w.z = pg8::cvt_pk_bf16(h1[0], h1[1]); w.w = pg8::cvt_pk_bf16(h1[2], h1[3]);
                *(u32x4*)(H + (size_t)(row0 + ai * 128 + m * 16) * EH + col0) = w; }
    }
};
struct EpiY {
    static constexpr bool PERM = true, AFTER_DRAIN = false;
    bf16* YB; const int* rowaid; const float* roww;
    __device__ __forceinline__ void operator()(const f32x4 (&acc)[2][2][4][2], const pg8::Unit& u, int wr, int wc, int fr, int fq) const {
        const int row0 = u.pm * 256 + wr * 64 + fr, col0 = u.pn * 256 + wc * 32 + 8 * fq;
#pragma unroll
        for (int ai = 0; ai < 2; ++ai)
#pragma unroll
            for (int m = 0; m < 4; ++m) { const int row = row0 + ai * 128 + m * 16; const int a = rowaid[row]; const float w = roww[row];
                if (a >= 0) {
#pragma unroll
                    for (int bj = 0; bj < 2; ++bj) { const f32x4 v0 = acc[ai][bj][m][0] * w, v1 = acc[ai][bj][m][1] * w;
                        u32x4 o; o.x = pg8::cvt_pk_bf16(v0[0], v0[1]); o.y = pg8::cvt_pk_bf16(v0[2], v0[3]); o.z = pg8::cvt_pk_bf16(v1[0], v1[1]); o.w = pg8::cvt_pk_bf16(v1[2], v1[3]);
                        *(u32x4*)(YB + (size_t)a * D + col0 + bj * 128) = o; } } }
    }
};
__device__ __forceinline__ void p11_final(PRef p, int bid, int nb) {
    const int tid_ = otid(), lane = tid_ & 63, wv = tid_ >> 6;
    const float* mod = (const float*)(p.ws + W_MOD); const bf16* YB = (const bf16*)p.out; const bf16* X1 = (const bf16*)(p.ws + W_X1B); float* out = p.out; const float* g = p.in[I_FNG];
#pragma unroll 1
    for (int row = bid * 8 + wv; row < NTOK; row += nb * 8) {
        const float* gt = mod + (row / SEQ) * 6 * D + 5 * D;
        f32x4 v[4]; float s = 0.f;
#pragma unroll
        for (int j = 0; j < 4; ++j) { const int c0 = (lane + 64 * j) * 4;
            const u32x2 xw = *(const u32x2*)(X1 + (size_t)row * D + c0); const f32x4 xv = {bflo(xw.x), bfhi(xw.x), bflo(xw.y), bfhi(xw.y)}, gv = *(const f32x4*)(gt + c0);
            const u32x2 a = *(const u32x2*)(YB + (size_t)(2 * row) * D + c0), b = *(const u32x2*)(YB + (size_t)(2 * row + 1) * D + c0);
            const f32x4 y = {bflo(a.x) + bflo(b.x), bfhi(a.x) + bfhi(b.x), bflo(a.y) + bflo(b.y), bfhi(a.y) + bfhi(b.y)};
            v[j] = xv + gv * y; s += (v[j][0] * v[j][0] + v[j][1] * v[j][1]) + (v[j][2] * v[j][2] + v[j][3] * v[j][3]); }
        const float r = rsqrtf(wave_sum_dpp(s) * (1.0f / D) + 1e-6f);
#pragma unroll
        for (int j = 0; j < 4; ++j) { const int c0 = (lane + 64 * j) * 4; *(f32x4*)(out + (size_t)row * D + c0) = v[j] * r * *(const f32x4*)(g + c0); }
    }
}
constexpr int PM_PB = 144, PM_MAT = 64 * PM_PB;
enum { PM_AT = 0, PM_RT, PM_BT, PM_KT, PM_VT, PM_BPT, PM_KPT, PM_AAK, PM_ARB, PM_ARK, PM_W1T, PM_U2T, PM_NMAT };
constexpr int PM_AAB = PM_NMAT * PM_MAT, PM_P = PM_AAB + 16384, PM_TOT = PM_P + 16384, PM_G = PM_TOT + 2048, PM_END = PM_G + 256;
static_assert(PM_END <= LDS_BYTES, "pass-A LDS map");
struct PmRaw { float zr[9], zk[9], zv[9], lw[8], as[8]; };
__device__ __forceinline__ void p5m_load(PRef p, PmRaw& R, int q, int wave, int lane) {
    const int seq = q / NCH, c = q % NCH, b = seq >> 3, h = seq & 7, tg = b * SEQ + c * SCL + wave * 8, hc = h * 64 + lane;
    const bf16* Z = (const bf16*)(p.ws + W_Z); const bf16* LO = (const bf16*)(p.ws + W_LO);
    const bool has_prev = !(wave == 0 && c == 0);
    const bf16* zp0 = Z + (size_t)(tg - 1) * ZLD + 1024 + hc;
    R.zr[0] = has_prev ? bf2f(zp0[0]) : 0.f; R.zk[0] = has_prev ? bf2f(zp0[512]) : 0.f; R.zv[0] = has_prev ? bf2f(zp0[1024]) : 0.f;
#pragma unroll
    for (int s = 0; s < 8; ++s) { const bf16* zp = Z + (size_t)(tg + s) * ZLD + 1024 + hc; const bf16* lp = LO + (size_t)(tg + s) * 1536 + hc;
        R.zr[s + 1] = bf2f(zp[0]); R.zk[s + 1] = bf2f(zp[512]); R.zv[s + 1] = bf2f(zp[1024]); R.lw[s] = bf2f(lp[0]); R.as[s] = bf2f(lp[512]); }
}
#define PM_BAR() do { asm volatile("s_waitcnt lgkmcnt(0)" ::: "memory"); __builtin_amdgcn_s_barrier(); asm volatile("" ::: "memory"); } while (0)
__device__ __forceinline__ void p5m_chunk(PRef p, LAS unsigned char* lds, int q, int qnext, PmRaw& R) {
    typedef short bf16x8 __attribute__((ext_vector_type(8)));
    const int tid = otid(), lane = tid & 63, wave = __builtin_amdgcn_readfirstlane(tid >> 6), fr = lane & 15, fq = lane >> 4;
    const int seq = q / NCH, c = q % NCH, b = seq >> 3, h = seq & 7, tb = b * SEQ + c * SCL, hc = h * 64 + lane;
#define PMAT(i) (lds + (i) * PM_MAT)
#define PFRAG(mat, row, ks) (*(const LAS bf16x8*)((mat) + (row) * PM_PB + ((ks) * 32 + fq * 8) * 2))
#ifndef PM_DUP
#define PM_DUP 0
#endif
#pragma unroll 1
    for (int d0 = 0; d0 < ((PM_DUP >> 3) & 1) + 1; ++d0) { if (d0) PM_BAR();
        const int t8 = wave * 8, tg = tb + t8;
        float (&zr)[9] = R.zr; float (&zk)[9] = R.zk; float (&zv)[9] = R.zv; float (&lw)[8] = R.lw; float (&as)[8] = R.as;
        float cl[8]; { float run = 0.f;
#pragma unroll
          for (int s = 0; s < 8; ++s) { run += lw[s]; cl[s] = run; } }
        *(LAS float*)(lds + PM_TOT + (wave * 64 + lane) * 4) = cl[7];
        PM_BAR();
        float off = 0.f, lcL = 0.f;
#pragma unroll
        for (int w = 0; w < 8; ++w) { const float tv = *(const LAS float*)(lds + PM_TOT + (w * 64 + lane) * 4); lcL += tv; off += (w < wave) ? tv : 0.f; }
        if (wave == 0) *(LAS float*)(lds + PM_G + lane * 4) = __builtin_amdgcn_exp2f(1.4426950409f * lcL);
        const float mur = p.in[I_MU][hc], muk = p.in[I_MU][512 + hc], muv = p.in[I_MU][1024 + hc];
        const float kkc = p.in[I_KK][hc], kac = p.in[I_KA][hc], rkc = p.in[I_RK][hc];
        bf16* VLo = (bf16*)(p.ws + W_YCAT); float* RKo = (float*)(p.ws + T_RK);
        unsigned pv[4], pbp[4], pkp[4];
#pragma unroll
        for (int s = 0; s < 8; ++s) {
            const float r = zr[s + 1] + (zr[s] - zr[s + 1]) * mur, k = zk[s + 1] + (zk[s] - zk[s + 1]) * muk, v = zv[s + 1] + (zv[s] - zv[s + 1]) * muv;
            const float kkv = k * kkc;
            const float kk = kkv * rsqrtf(fmaxf(wave_sum_dpp(kkv * kkv), 1e-24f));
            const float k2 = k * (1.0f + (as[s] - 1.0f) * kac);
            const float rk = wave_sum_dpp(r * k2 * rkc);
            const float bb = kk * as[s];
            const float lc = off + cl[s], lcp = lc - lw[s];
            const float e_lc = __builtin_amdgcn_exp2f(1.4426950409f * lc), e_lcp = __builtin_amdgcn_exp2f(1.4426950409f * lcp);
            const float e_nlc = __builtin_amdgcn_exp2f(-1.4426950409f * lc), e_l = __builtin_amdgcn_exp2f(1.4426950409f * (lcL - lc));
            const int t = t8 + s;
            *(LAS bf16*)(PMAT(PM_AT) + t * PM_PB + lane * 2) = (bf16)f2bf(-kk * e_lcp);
            *(LAS bf16*)(PMAT(PM_RT) + t * PM_PB + lane * 2) = (bf16)f2bf(r * e_lc);
            *(LAS bf16*)(PMAT(PM_BT) + t * PM_PB + lane * 2) = (bf16)f2bf(bb * e_nlc);
            *(LAS bf16*)(PMAT(PM_KT) + t * PM_PB + lane * 2) = (bf16)f2bf(k2 * e_nlc);
            const unsigned vb = f2bf(v), bpb = f2bf(bb * e_l), kpb = f2bf(k2 * e_l);
            if (s & 1) { pv[s >> 1] |= vb << 16; pbp[s >> 1] |= bpb << 16; pkp[s >> 1] |= kpb << 16; } else { pv[s >> 1] = vb; pbp[s >> 1] = bpb; pkp[s >> 1] = kpb; }
            VLo[(unsigned)((tg + s) * 1024 + 512 + hc)] = (bf16)vb;
            if (lane == 0) RKo[(unsigned)((tg + s) * 8 + h)] = rk;
        }
        *(LAS u32x4*)(PMAT(PM_VT) + lane * PM_PB + wave * 16) = (u32x4){pv[0], pv[1], pv[2], pv[3]};
        *(LAS u32x4*)(PMAT(PM_BPT) + lane * PM_PB + wave * 16) = (u32x4){pbp[0], pbp[1], pbp[2], pbp[3]};
        *(LAS u32x4*)(PMAT(PM_KPT) + lane * PM_PB + wave * 16) = (u32x4){pkp[0], pkp[1], pkp[2], pkp[3]};
    }
    if (qnext >= 0) p5m_load(p, R, qnext, wave, lane);
    PM_BAR();
#pragma unroll 1
    for (int d1 = 0; d1 < ((PM_DUP >> 0) & 1) + 1; ++d1) {
        const int pp = wave >> 1, half = wave & 1;
        const LAS unsigned char* Xm = PMAT(pp < 2 ? PM_AT : PM_RT);
        const LAS unsigned char* Ym = PMAT((pp & 1) ? PM_KT : PM_BT);
#pragma unroll
        for (int ti = 0; ti < 2; ++ti) {
            const int tt = half ? (1 + ti) : (3 * ti);
            const bf16x8 xb0 = PFRAG(Xm, tt * 16 + fr, 0), xb1 = PFRAG(Xm, tt * 16 + fr, 1);
            const int t = tt * 16 + fr;
#pragma unroll
            for (int jt = 0; jt < 4; ++jt) {
                f32x4 acc = {0.f, 0.f, 0.f, 0.f};
                if (jt <= tt) { acc = __builtin_amdgcn_mfma_f32_16x16x32_bf16(PFRAG(Ym, jt * 16 + fr, 0), xb0, acc, 0, 0, 0);
                                acc = __builtin_amdgcn_mfma_f32_16x16x32_bf16(PFRAG(Ym, jt * 16 + fr, 1), xb1, acc, 0, 0, 0); }
                const int j0 = jt * 16 + 4 * fq;
#pragma unroll
                for (int rg = 0; rg < 4; ++rg) { const bool keep = (pp < 2) ? (j0 + rg < t) : (j0 + rg <= t); acc[rg] = keep ? acc[rg] : 0.f; }
                if (pp == 0) {
#pragma unroll
                    for (int rg = 0; rg < 4; ++rg) *(LAS float*)(lds + PM_AAB + (t * 64 + rg * 16 + jt * 4 + fq) * 4) = acc[rg];
                } else {
                    u32x2 w; w.x = pk2(acc[0], acc[1]); w.y = pk2(acc[2], acc[3]);
                    *(LAS u32x2*)(PMAT(PM_AAK + pp - 1) + t * PM_PB + j0 * 2) = w;
                }
            }
        }
    }
    PM_BAR();
#pragma unroll 1
    for (int d2 = 0; d2 < ((PM_DUP >> 1) & 1) + 1; ++d2) {
        const bool isw1 = wave < 4;
        const int colb = (wave & 3) * 16, cl = lane >> 2, part = lane & 3, col = colb + cl;
        if (!isw1) {
            const bf16x8 vb0 = PFRAG(PMAT(PM_VT), colb + fr, 0), vb1 = PFRAG(PMAT(PM_VT), colb + fr, 1);
#pragma unroll
            for (int tt = 0; tt < 4; ++tt) { f32x4 acc = {0.f, 0.f, 0.f, 0.f};
                acc = __builtin_amdgcn_mfma_f32_16x16x32_bf16(PFRAG(PMAT(PM_AAK), tt * 16 + fr, 0), vb0, acc, 0, 0, 0);
                acc = __builtin_amdgcn_mfma_f32_16x16x32_bf16(PFRAG(PMAT(PM_AAK), tt * 16 + fr, 1), vb1, acc, 0, 0, 0);
#pragma unroll
                for (int rg = 0; rg < 4; ++rg) *(LAS float*)(lds + PM_P + ((tt * 16 + 4 * fq + rg) * 64 + colb + fr) * 4) = acc[rg]; }
            asm volatile("s_waitcnt lgkmcnt(0)" ::: "memory");
        }
        float X[16];
#pragma unroll
        for (int jj = 0; jj < 16; ++jj) X[jj] = 0.f;
        const LAS unsigned char* arow = lds + PM_AAB + part * 64;
#define PM_LOADBLK(g, rh, a4, cf) do { \
            _Pragma("unroll") for (int r = 0; r < 4; ++r) { const int t = 4 * (g) + r; \
                rh[r] = isw1 ? bf2f(*(const LAS bf16*)(PMAT(PM_AT) + t * PM_PB + col * 2)) : *(const LAS float*)(lds + PM_P + (t * 64 + col) * 4); \
                _Pragma("unroll") for (int m = 0; m < 4; ++m) if (m * 4 < (g)) a4[r][m] = *(const LAS f32x4*)(arow + t * 256 + m * 16); } \
            { const LAS unsigned char* cb = lds + PM_AAB + (g) * 4; \
              cf[0] = *(const LAS float*)(cb + (4 * (g) + 1) * 256); cf[1] = *(const LAS float*)(cb + (4 * (g) + 2) * 256); cf[2] = *(const LAS float*)(cb + (4 * (g) + 2) * 256 + 64); \
              cf[3] = *(const LAS float*)(cb + (4 * (g) + 3) * 256); cf[4] = *(const LAS float*)(cb + (4 * (g) + 3) * 256 + 64); cf[5] = *(const LAS float*)(cb + (4 * (g) + 3) * 256 + 128); } } while (0)
#define PM_SOLVEBLK(g, rh, a4, cf) do { float sm[4]; \
            _Pragma("unroll") for (int r = 0; r < 4; ++r) { float s0 = 0.f, s1 = 0.f; \
                _Pragma("unroll") for (int m = 0; m < 4; ++m) if (m * 4 < (g)) { \
                    _Pragma("unroll") for (int i = 0; i < 4; ++i) if (m * 4 + i < (g)) { if (i & 1) s1 = fmaf(a4[r][m][i], X[m * 4 + i], s1); else s0 = fmaf(a4[r][m][i], X[m * 4 + i], s0); } } \
                sm[r] = s0 + s1; } \
            _Pragma("unroll") for (int r = 0; r < 4; ++r) { DPP_ADD(sm[r], 0xB1); DPP_ADD(sm[r], 0x4E); } \
            const float x0 = rh[0] + sm[0]; \
            const float x1 = fmaf(cf[0], x0, rh[1] + sm[1]); \
            const float x2 = fmaf(cf[2], x1, fmaf(cf[1], x0, rh[2] + sm[2])); \
            const float x3 = fmaf(cf[5], x2, fmaf(cf[4], x1, fmaf(cf[3], x0, rh[3] + sm[3]))); \
            X[g] = part == 0 ? x0 : part == 1 ? x1 : part == 2 ? x2 : x3; } while (0)
        { float rhA[4], cfA[6], rhB[4], cfB[6]; f32x4 aA[4][4], aB[4][4];
          PM_LOADBLK(0, rhA, aA, cfA);
#pragma unroll
          for (int g2 = 0; g2 < 16; g2 += 2) {
              PM_LOADBLK(g2 + 1, rhB, aB, cfB); __builtin_amdgcn_sched_barrier(0);
              PM_SOLVEBLK(g2, rhA, aA, cfA);
              if (g2 + 2 < 16) { PM_LOADBLK(g2 + 2, rhA, aA, cfA); } __builtin_amdgcn_sched_barrier(0);
              PM_SOLVEBLK(g2 + 1, rhB, aB, cfB);
          } }
#undef PM_LOADBLK
#undef PM_SOLVEBLK
        LAS unsigned char* om = PMAT(isw1 ? PM_W1T : PM_U2T) + col * PM_PB + part * 2;
#pragma unroll
        for (int jj = 0; jj < 16; ++jj) *(LAS bf16*)(om + jj * 8) = (bf16)f2bf(X[jj]);
    }
    PM_BAR();
#pragma unroll 1
    for (int d3 = 0; d3 < ((PM_DUP >> 2) & 1) + 1; ++d3) {
        float* Mo = (float*)((unsigned char*)p.out + O_M + (size_t)q * 16384); float* No = (float*)((unsigned char*)p.out + O_N + (size_t)q * 16384);
        bf16* Qo = (bf16*)(p.ws + W_Q); bf16* Y2o = (bf16*)(p.ws + W_Y2);
#pragma unroll
        for (int ti = 0; ti < 2; ++ti) {
            const int idx = wave * 2 + ti, rt = idx >> 2, ct = idx & 3;
            {
                f32x4 acc = {0.f, 0.f, 0.f, 0.f};
#pragma unroll
                for (int ks = 0; ks < 2; ++ks) acc = __builtin_amdgcn_mfma_f32_16x16x32_bf16(PFRAG(PMAT(PM_BPT), ct * 16 + fr, ks), PFRAG(PMAT(PM_W1T), rt * 16 + fr, ks), acc, 0, 0, 0);
                const int i = rt * 16 + fr, c0 = ct * 16 + 4 * fq;
#pragma unroll
                for (int rg = 0; rg < 4; ++rg) if (c0 + rg == i) acc[rg] += *(const LAS float*)(lds + PM_G + i * 4);
                *(f32x4*)(Mo + i * 64 + c0) = acc; }
            {
                f32x4 acc = {0.f, 0.f, 0.f, 0.f};
#pragma unroll
                for (int ks = 0; ks < 2; ++ks) { acc = __builtin_amdgcn_mfma_f32_16x16x32_bf16(PFRAG(PMAT(PM_BPT), ct * 16 + fr, ks), PFRAG(PMAT(PM_U2T), rt * 16 + fr, ks), acc, 0, 0, 0);
                                                  acc = __builtin_amdgcn_mfma_f32_16x16x32_bf16(PFRAG(PMAT(PM_KPT), ct * 16 + fr, ks), PFRAG(PMAT(PM_VT), rt * 16 + fr, ks), acc, 0, 0, 0); }
                *(f32x4*)(No + (rt * 16 + fr) * 64 + ct * 16 + 4 * fq) = acc; }
            {
                f32x4 acc = {0.f, 0.f, 0.f, 0.f};
#pragma unroll
                for (int ks = 0; ks < 2; ++ks) acc = __builtin_amdgcn_mfma_f32_16x16x32_bf16(PFRAG(PMAT(PM_W1T), ct * 16 + fr, ks), PFRAG(PMAT(PM_ARB), rt * 16 + fr, ks), acc, 0, 0, 0);
                const int t = rt * 16 + fr, i0 = ct * 16 + 4 * fq;
                const u32x2 rw = *(const LAS u32x2*)(PMAT(PM_RT) + t * PM_PB + i0 * 2);
                u32x2 o; o.x = pk2(acc[0] + bflo(rw.x), acc[1] + bfhi(rw.x)); o.y = pk2(acc[2] + bflo(rw.y), acc[3] + bfhi(rw.y));
                *(u32x2*)(Qo + (unsigned)((tb + t) * 512 + h * 64 + i0)) = o; }
            {
                f32x4 acc = {0.f, 0.f, 0.f, 0.f};
#pragma unroll
                for (int ks = 0; ks < 2; ++ks) { acc = __builtin_amdgcn_mfma_f32_16x16x32_bf16(PFRAG(PMAT(PM_U2T), ct * 16 + fr, ks), PFRAG(PMAT(PM_ARB), rt * 16 + fr, ks), acc, 0, 0, 0);
                                                  acc = __builtin_amdgcn_mfma_f32_16x16x32_bf16(PFRAG(PMAT(PM_VT), ct * 16 + fr, ks), PFRAG(PMAT(PM_ARK), rt * 16 + fr, ks), acc, 0, 0, 0); }
                const int t = rt * 16 + fr, v0 = ct * 16 + 4 * fq;
                u32x2 o; o.x = pk2(acc[0], acc[1]); o.y = pk2(acc[2], acc[3]);
                *(u32x2*)(Y2o + (unsigned)((tb + t) * 512 + h * 64 + v0)) = o; }
        }
    }
    PM_BAR();
#undef PMAT
#undef PFRAG
}

__device__ __forceinline__ void p5m_run(PRef p, LAS unsigned char* lds, int bid, int nb) {
    const int tid = otid(), lane = tid & 63, wave = __builtin_amdgcn_readfirstlane(tid >> 6);
    PmRaw R;
    if (bid < BATCH * 8 * NCH) p5m_load(p, R, bid, wave, lane);
#pragma unroll 1
    for (int q = bid; q < BATCH * 8 * NCH; q += nb) p5m_chunk(p, lds, q, (q + nb < BATCH * 8 * NCH) ? q + nb : -1, R);
}
constexpr int R7_WP = 1040, R7_WSZ = 48 * R7_WP, R7_AP = 144, R7_ASZ = 16 * R7_AP;
constexpr int R7_WAVE0 = 2 * R7_WSZ, R7_WAVESZ = 2 * R7_ASZ + 3072, R7_HIST = R7_WAVE0 + 8 * R7_WAVESZ;
static_assert(R7_HIST + 256 <= LDS_BYTES, "router LDS map");
__device__ __forceinline__ void p7m_route(PRef p, LAS unsigned char* lds, int bid) {
    typedef short bf16x8 __attribute__((ext_vector_type(8)));
    const int tid = otid(), lane = tid & 63, wave = __builtin_amdgcn_readfirstlane(tid >> 6), fr = lane & 15, fq = lane >> 4;
    const int tok = lane >> 2, sub = lane & 3;
    const bf16* x1 = (const bf16*)(p.ws + W_X1B); bf16* H2 = (bf16*)(p.ws + W_H2);
    LAS int* hist = (LAS int*)(lds + R7_HIST);
    const int b = (bid * TPW) / SEQ, t0 = bid * TPW + wave * 16;
    const float* mod = (const float*)(p.ws + W_MOD) + b * 6 * D;
    const float* n2g = p.in[I_N2G];
    LAS unsigned char* Ahi = lds + R7_WAVE0 + wave * R7_WAVESZ; LAS unsigned char* Alo = Ahi + R7_ASZ; LAS float* Lw = (LAS float*)(Alo + R7_ASZ);
    if (tid < 32) hist[tid] = 0;
    const bf16* xrow = x1 + (size_t)(t0 + tok) * D + sub * 16;
    float ss = 0.f;
#pragma unroll 1
    for (int s4 = 0; s4 < 16; s4 += 8) { u32x4 v[16];
#pragma unroll
        for (int s = 0; s < 8; ++s) { v[s * 2] = *(const u32x4*)(xrow + (s4 + s) * 64); v[s * 2 + 1] = *(const u32x4*)(xrow + (s4 + s) * 64 + 8); }
#pragma unroll
        for (int i = 0; i < 16; ++i)
#pragma unroll
            for (int q = 0; q < 4; ++q) { const float a = bflo(v[i][q]), bq = bfhi(v[i][q]); ss = fmaf(a, a, fmaf(bq, bq, ss)); } }
    DPP_ADD(ss, 0xB1); DPP_ADD(ss, 0x4E);
    const float r = rsqrtf(ss * (1.0f / D) + 1e-6f);
    f32x4 acc[3];
#pragma unroll
    for (int qt = 0; qt < 3; ++qt) acc[qt] = (f32x4){0.f, 0.f, 0.f, 0.f};
#pragma unroll 1
    for (int kh = 0; kh < 2; ++kh) {
        __syncthreads();
#pragma unroll 1
        for (int idx = tid; idx < 512 * 12; idx += NTHR) { const int cq = idx % 12, kl = idx / 12, k = kh * 512 + kl;
            f32x4 w = {0.f, 0.f, 0.f, 0.f};
            if (cq == 0) w = *(const f32x4*)(p.in[I_RGW] + k * 4); else if (cq < 9) w = *(const f32x4*)(p.in[I_REW] + k * 32 + (cq - 1) * 4);
#pragma unroll
            for (int i = 0; i < 4; ++i) { const unsigned hi = f2bf(w[i]); const unsigned lo = f2bf(w[i] - bflo(hi));
                *(LAS bf16*)(lds + (cq * 4 + i) * R7_WP + kl * 2) = (bf16)hi; *(LAS bf16*)(lds + R7_WSZ + (cq * 4 + i) * R7_WP + kl * 2) = (bf16)lo; } }
        __syncthreads();
#pragma unroll 1
        for (int sl = 0; sl < 8; ++sl) {
            const int k0 = kh * 512 + sl * 64 + sub * 16;
            f32x4 xv[4], gv[4], cv[4], sv[4];
            { const u32x4 xa = *(const u32x4*)(x1 + (size_t)(t0 + tok) * D + k0), xb = *(const u32x4*)(x1 + (size_t)(t0 + tok) * D + k0 + 8);
              xv[0] = (f32x4){bflo(xa.x), bfhi(xa.x), bflo(xa.y), bfhi(xa.y)}; xv[1] = (f32x4){bflo(xa.z), bfhi(xa.z), bflo(xa.w), bfhi(xa.w)};
              xv[2] = (f32x4){bflo(xb.x), bfhi(xb.x), bflo(xb.y), bfhi(xb.y)}; xv[3] = (f32x4){bflo(xb.z), bfhi(xb.z), bflo(xb.w), bfhi(xb.w)}; }
#pragma unroll
            for (int i = 0; i < 4; ++i) { gv[i] = *(const f32x4*)(n2g + k0 + i * 4); cv[i] = *(const f32x4*)(mod + 4 * D + k0 + i * 4); sv[i] = *(const f32x4*)(mod + 3 * D + k0 + i * 4); }
            unsigned hi[8], lo[8];
#pragma unroll
            for (int i = 0; i < 4; ++i)
#pragma unroll
                for (int j = 0; j < 4; j += 2) { const float h0 = xv[i][j] * r * gv[i][j] * (1.0f + cv[i][j]) + sv[i][j], h1 = xv[i][j + 1] * r * gv[i][j + 1] * (1.0f + cv[i][j + 1]) + sv[i][j + 1];
                    const unsigned a0 = f2bf(h0), a1 = f2bf(h1); hi[i * 2 + (j >> 1)] = a0 | (a1 << 16); lo[i * 2 + (j >> 1)] = f2bf(h0 - bflo(a0)) | (f2bf(h1 - bflo(a1)) << 16); }
            *(u32x4*)(H2 + (size_t)(t0 + tok) * D + k0) = (u32x4){hi[0], hi[1], hi[2], hi[3]}; *(u32x4*)(H2 + (size_t)(t0 + tok) * D + k0 + 8) = (u32x4){hi[4], hi[5], hi[6], hi[7]};
            *(LAS u32x4*)(Ahi + tok * R7_AP + sub * 32) = (u32x4){hi[0], hi[1], hi[2], hi[3]}; *(LAS u32x4*)(Ahi + tok * R7_AP + sub * 32 + 16) = (u32x4){hi[4], hi[5], hi[6], hi[7]};
            *(LAS u32x4*)(Alo + tok * R7_AP + sub * 32) = (u32x4){lo[0], lo[1], lo[2], lo[3]}; *(LAS u32x4*)(Alo + tok * R7_AP + sub * 32 + 16) = (u32x4){lo[4], lo[5], lo[6], lo[7]};
            asm volatile("s_waitcnt lgkmcnt(0)" ::: "memory");
#pragma unroll
            for (int ks = 0; ks < 2; ++ks) {
                const bf16x8 ah = *(const LAS bf16x8*)(Ahi + fr * R7_AP + (ks * 32 + fq * 8) * 2), al = *(const LAS bf16x8*)(Alo + fr * R7_AP + (ks * 32 + fq * 8) * 2);
#pragma unroll
                for (int qt = 0; qt < 3; ++qt) { const int wo = (qt * 16 + fr) * R7_WP + (sl * 64 + ks * 32 + fq * 8) * 2;
                    const bf16x8 bh = *(const LAS bf16x8*)(lds + wo), bl = *(const LAS bf16x8*)(lds + R7_WSZ + wo);
                    acc[qt] = __builtin_amdgcn_mfma_f32_16x16x32_bf16(ah, bh, acc[qt], 0, 0, 0);
                    acc[qt] = __builtin_amdgcn_mfma_f32_16x16x32_bf16(al, bh, acc[qt], 0, 0, 0);
                    acc[qt] = __builtin_amdgcn_mfma_f32_16x16x32_bf16(ah, bl, acc[qt], 0, 0, 0); } }
            asm volatile("s_waitcnt lgkmcnt(0)" ::: "memory");
        }
    }
#pragma unroll
    for (int qt = 0; qt < 3; ++qt)
#pragma unroll
        for (int rg = 0; rg < 4; ++rg) Lw[(4 * fq + rg) * 48 + qt * 16 + fr] = acc[qt][rg];
    asm volatile("s_waitcnt lgkmcnt(0)" ::: "memory");
    if (lane < 16) {
        const LAS float* lg = Lw + lane * 48;
        int gi = 0; float gm = lg[0] + p.in[I_RGB][0];
#pragma unroll
        for (int q = 1; q < 4; ++q) { const float v = lg[q] + p.in[I_RGB][q]; if (v > gm) { gm = v; gi = q; } }
        float gsum = 0.f;
#pragma unroll
        for (int q = 0; q < 4; ++q) gsum += expf(lg[q] + p.in[I_RGB][q] - gm);
        const float gp = 1.0f / gsum;
        const LAS float* el = lg + 4 + gi * 8; const float* eb = p.in[I_REB] + gi * 8;
        int i0 = 0; float m0 = el[0] + eb[0];
#pragma unroll
        for (int q = 1; q < 8; ++q) { const float v = el[q] + eb[q]; if (v > m0) { m0 = v; i0 = q; } }
        int i1 = -1; float m1 = -3.0e38f;
#pragma unroll
        for (int q = 0; q < 8; ++q) { const float v = el[q] + eb[q]; if (q != i0 && v > m1) { m1 = v; i1 = q; } }
        const float p1 = expf(m1 - m0);
        const float w0 = gp / (1.0f + p1), w1 = gp * p1 / (1.0f + p1);
        const int t = t0 + lane, e0 = gi * 8 + i0, e1 = gi * 8 + i1;
        int* toke = (int*)(p.ws + T_TOKE); float* tokw = (float*)(p.ws + T_TOKW);
        toke[t * 2] = e0; toke[t * 2 + 1] = e1; tokw[t * 2] = w0; tokw[t * 2 + 1] = w1;
        __hip_atomic_fetch_add(&hist[e0], 1, __ATOMIC_RELAXED, __HIP_MEMORY_SCOPE_WORKGROUP); __hip_atomic_fetch_add(&hist[e1], 1, __ATOMIC_RELAXED, __HIP_MEMORY_SCOPE_WORKGROUP);
    }
    __syncthreads();
    if (tid < 32) ((int*)(p.ws + T_HIST))[bid * 32 + tid] = hist[tid];
    __syncthreads();
}
constexpr int PB_PITCH = 68;
constexpr int PB_ML = 0, PB_SL = 64 * PB_PITCH * 4, PB_NL = PB_SL + 16 * PB_PITCH * 4, PB_IMG = PB_NL + 16 * PB_PITCH * 4;
__device__ __forceinline__ void p5b_chain_mfma(PRef p, LAS unsigned char* lds, int item) {
    const int tid = otid(), lane = tid & 63, wave = __builtin_amdgcn_readfirstlane(tid >> 6), fr = lane & 15, fq = lane >> 4;
    const int seq = (item & 7) + 8 * (item >> 5), rg = (item >> 3) & 3;
    const bool mm = wave < 4; const int ct = wave & 3, t2 = tid & 255, nrow = t2 >> 4, ncol = (t2 & 15) * 4;
    const unsigned char* Mb = (const unsigned char*)p.out + O_M + (size_t)seq * NCH * 16384;
    const unsigned char* Nb = (const unsigned char*)p.out + O_N + (size_t)seq * NCH * 16384 + (size_t)((rg * 16 + nrow) * 64 + ncol) * 4;
    unsigned char* Sb = p.ws + W_S + (size_t)seq * NCH * 16384 + (size_t)((rg * 16 + nrow) * 64 + ncol) * 4;
    const int mrow = tid >> 4, mcol = (tid & 15) * 4;
    f32x4 acc = {0.f, 0.f, 0.f, 0.f};
    f32x4 m0[2], m1[2], m2[2], m3[2], n0, n1, n2, n3;
#define PBM_LOAD(mmr, nn, cc) do { const f32x4* mp = (const f32x4*)(Mb + (size_t)(cc) * 16384) + tid; mmr[0] = mp[0]; mmr[1] = mp[512]; if (!mm) nn = *(const f32x4*)(Nb + (size_t)(cc) * 16384); } while (0)
#define PBM_STEP(mmr, nn, cc) do { \
        LAS unsigned char* img = lds + ((cc) & 1) * PB_IMG; \
        *(LAS f32x4*)(img + PB_ML + (mrow * PB_PITCH + mcol) * 4) = mmr[0]; *(LAS f32x4*)(img + PB_ML + ((mrow + 32) * PB_PITCH + mcol) * 4) = mmr[1]; \
        if (mm) { _Pragma("unroll") for (int rg_ = 0; rg_ < 4; ++rg_) *(LAS float*)(img + PB_SL + ((4 * fq + rg_) * PB_PITCH + ct * 16 + fr) * 4) = acc[rg_]; } \
        else *(LAS f32x4*)(img + PB_NL + (nrow * PB_PITCH + ncol) * 4) = nn; \
        asm volatile("s_waitcnt lgkmcnt(0)" ::: "memory"); __builtin_amdgcn_s_barrier(); asm volatile("" ::: "memory"); \
        if ((cc) + 4 < NCH) PBM_LOAD(mmr, nn, (cc) + 4); \
        if (mm) { \
            _Pragma("unroll") for (int rg_ = 0; rg_ < 4; ++rg_) acc[rg_] = *(const LAS float*)(img + PB_NL + ((4 * fq + rg_) * PB_PITCH + ct * 16 + fr) * 4); \
            _Pragma("unroll") for (int ks = 0; ks < 16; ++ks) { \
                const float a_ = *(const LAS float*)(img + PB_SL + (fr * PB_PITCH + ks * 4 + fq) * 4), b_ = *(const LAS float*)(img + PB_ML + ((ks * 4 + fq) * PB_PITCH + ct * 16 + fr) * 4); \
                acc = __builtin_amdgcn_mfma_f32_16x16x4f32(a_, b_, acc, 0, 0, 0); } \
        } else { const f32x4 sv = *(const LAS f32x4*)(img + PB_SL + (nrow * PB_PITCH + ncol) * 4); *(f32x4*)(Sb + (size_t)(cc) * 16384) = sv; } \
    } while (0)
    __syncthreads();
    PBM_LOAD(m0, n0, 0); PBM_LOAD(m1, n1, 1); PBM_LOAD(m2, n2, 2); PBM_LOAD(m3, n3, 3);
#pragma unroll 1
    for (int c = 0; c < NCH; c += 4) { PBM_STEP(m0, n0, c); PBM_STEP(m1, n1, c + 1); PBM_STEP(m2, n2, c + 2); PBM_STEP(m3, n3, c + 3); }
    __syncthreads();
#undef PBM_LOAD
#undef PBM_STEP
}
__global__ void __launch_bounds__(NTHR, 2) k_mega(Params p_unused) {
    extern __shared__ __attribute__((aligned(16))) unsigned char lds_raw[];
    PPtr kp = (PPtr)__builtin_amdgcn_kernarg_segment_ptr();
#define p (*opq(kp))
    cg::grid_group grid = cg::this_grid();
    const int bid = blockIdx.x, nb = gridDim.x;
    LAS unsigned char* lds = (LAS unsigned char*)lds_raw;
    volatile LAS unsigned* bst = (volatile LAS unsigned*)(lds + LDS_BYTES - 64);
    if (otid() < 2) bst[otid()] = 0u;
    __syncthreads();
    XcdBarrier xb = xcd_barrier_post((unsigned*)(p.ws + T_BAR), bst);
#define GSYNC() xcd_barrier(xb)
    p0_prep<true>(p, lds, bid, nb); grid.sync();
    p1_h1(p, bid, nb); GSYNC();
    { pg8::Gemm g{(const pg8::bf16_t*)(p.ws + W_H1), (const pg8::bf16_t*)(p.ws + W_WINT), NTOK, ZLD, D}; pg8::StaticOrder S; S.init(NTOK, ZLD, nb, bid);
      EpiZ E{(bf16*)(p.ws + W_Z)};
      pg8::gemm_phase<EpiZ, pg8::StaticOrder, true, true>(lds, g, S, E); }
    GSYNC();
#pragma unroll 1
    for (int ch = bid; ch < NTOK / CHUNK; ch += nb) p3_gmlp_unit(p, lds, ch);
    p3_lorain(p, bid, nb);
    GSYNC();
    { int kop = 256; asm volatile("" : "+s"(kop));
      pg8::Gemm g{(const pg8::bf16_t*)(p.ws + W_A2), (const pg8::bf16_t*)(p.ws + W_LORAT), NTOK, 1536, kop}; pg8::StaticOrder S; S.init(NTOK, 1536, nb, bid);
      EpiLO E{(bf16*)(p.ws + W_LO), p.in[I_W0], p.in[I_A0]};
      pg8::gemm_phase<EpiLO, pg8::StaticOrder, true, true>(lds, g, S, E); }
    GSYNC();
    p5m_run(p, lds, bid, nb);
    GSYNC();
#pragma unroll 1
    for (int it = bid; it < BATCH * 8 * 4; it += nb) p5b_chain_mfma(p, lds, it);
    GSYNC();
#pragma unroll 1
    for (int q = bid * 8 + __builtin_amdgcn_readfirstlane(otid() >> 6); q < BATCH * 8 * NCH; q += nb * 8) p5c_chunk(p, q);
    GSYNC();
    { pg8::Gemm g{(const pg8::bf16_t*)(p.ws + W_YCAT), (const pg8::bf16_t*)(p.ws + W_WOUTT), NTOK, D, D}; pg8::StaticOrder S; S.init(NTOK, D, nb, bid);
      EpiX1 E{p.in[I_X], (const float*)(p.ws + W_MOD), (bf16*)(p.ws + W_X1B)};
      pg8::gemm_phase<EpiX1, pg8::StaticOrder, true, true>(lds, g, S, E); }
    GSYNC();
    p7m_route(p, lds, bid); GSYNC();
    p8_place(p, lds, bid); GSYNC();
    { const int nM = *(const int*)(p.ws + T_NT);
      pg8::Gemm g{(const pg8::bf16_t*)(p.ws + W_H2), (const pg8::bf16_t*)(p.ws + W_WGUT), PROWS, 1024, D}; MoeOrder<true> S{(const int*)(p.ws + T_TILEE), (const int*)(p.ws + T_ROWAID), nM, nb, bid};
      EpiH E{(bf16*)(p.ws + W_HB)};
      pg8::gemm_phase<EpiH, MoeOrder<true>, true, true>(lds, g, S, E); }
    GSYNC();
    { const int nM = *(const int*)(p.ws + T_NT);
      pg8::Gemm g{(const pg8::bf16_t*)(p.ws + W_HB), (const pg8::bf16_t*)(p.ws + W_WDT), PROWS, 1024, EH}; MoeOrder<false> S{(const int*)(p.ws + T_TILEE), (const int*)(p.ws + T_ROWAID), nM, nb, bid};
      EpiY E{(bf16*)p.out, (const int*)(p.ws + T_ROWAID), (const float*)(p.ws + T_ROWW)};
      pg8::gemm_phase<EpiY, MoeOrder<false>, true, true>(lds, g, S, E); }
    GSYNC();
    p11_final(p, bid, nb);
#undef GSYNC
#undef p
}
extern "C" void kernel_launch(void* const* d_in, const int* in_sizes, int n_in, void* d_out, int out_size, void* d_ws, size_t ws_size, hipStream_t stream) {
    if (n_in != 31 || ws_size < WS_NEED || out_size != NTOK * D) { fprintf(stderr, "kernel_launch: unexpected sizes n_in %d ws %zu out %d\n", n_in, ws_size, out_size); return; }
    static int grid_blocks = 0;
    if (!grid_blocks) {
        int dev = 0, cus = 0, per_cu = 0;
        (void)hipGetDevice(&dev);
        (void)hipDeviceGetAttribute(&cus, hipDeviceAttributeMultiprocessorCount, dev);
        (void)hipFuncSetAttribute((const void*)k_mega, hipFuncAttributeMaxDynamicSharedMemorySize, LDS_BYTES);
        (void)hipOccupancyMaxActiveBlocksPerMultiprocessor(&per_cu, (const void*)k_mega, NTHR, LDS_BYTES);
        if (per_cu < 1) fprintf(stderr, "kernel_launch: occupancy query says %d blocks/CU\n", per_cu);
        grid_blocks = cus;
    }
    Params p{};
    for (int i = 0; i < 31; ++i) p.in[i] = (const float*)d_in[i];
    p.out = (float*)d_out; p.ws = (unsigned char*)d_ws;
    (void)hipMemsetAsync((char*)d_ws + T_BAR, 0, 16384, stream);
    void* args[] = {&p};
    hipError_t e = hipLaunchCooperativeKernel((void*)k_mega, dim3(grid_blocks), dim3(NTHR), args, LDS_BYTES, stream);
    if (e != hipSuccess) fprintf(stderr, "cooperative launch failed: %s (grid %d)\n", hipGetErrorString(e), grid_blocks);
}
```

```cpp
#include <hip/hip_runtime.h>
#include <hip/hip_cooperative_groups.h>
#include <cstdio>
#include <cstdint>
namespace cg = cooperative_groups;
__device__ __forceinline__ int otid() { int t = threadIdx.x; asm volatile("" : "+v"(t)); return t; }

namespace pg8 {
#define PG8_LAS __attribute__((address_space(3)))
typedef unsigned short bf16_t;
typedef short bf16x8 __attribute__((ext_vector_type(8)));
typedef float f32x4 __attribute__((ext_vector_type(4)));
typedef unsigned u32x4 __attribute__((ext_vector_type(4)));
constexpr int BM = 256, BK = 64, HALF = 128, HTB = HALF * BK * 2  , STAGE_BYTES = 8 * HTB, NXCD = 8, WGM = 8;

__host__ __device__ __forceinline__ int lds_byte(int r, int c) { const int st = (r >> 4) * 2 + (c >> 5), rr = r & 15, cc = c & 31, ob = rr * 64 + cc * 2; return st * 1024 + (ob ^ (((ob >> 9) & 1) << 5)); }
__host__ __device__ __forceinline__ void stage_rc(int b, int& R, int& C) { const int st = b / 1024, sb = b % 1024, swz = sb ^ (((sb >> 9) & 1) << 5); R = (st >> 1) * 16 + swz / 64; C = (st & 1) * 32 + (swz % 64) / 2; }
__host__ __device__ __forceinline__ int perm32(int rho) { const int n = rho >> 4, i = rho & 15; return 8 * (i >> 2) + 4 * n + (i & 3); }

struct Unit { int pm, pn, pb; };
struct Gemm { const bf16_t* A; const bf16_t* Bt; int M, N, K; };

struct StaticOrder {
    static constexpr bool GATHER = false;
    int nM, nN, nwg, G, c;
    __device__ __forceinline__ int rowsrc(int) const { return 0; }
    __host__ __device__ void init(int M, int N, int G_, int c_) { nM = M / BM; nN = N / BM; nwg = nM * nN; G = G_; c = c_; }
    __host__ __device__ bool next(int i, Unit& u) const {
        const long L = (long)i * G + c; if (L >= nwg) return false;
        int wgid = (int)L; { const int q = nwg / NXCD, r = nwg % NXCD, xcd = wgid % NXCD, off = wgid / NXCD; wgid = (xcd < r ? xcd * (q + 1) : r * (q + 1) + (xcd - r) * q) + off; }
        const int nig = WGM * nN, gid = wgid / nig, fm = gid * WGM, gsz = (nM - fm) < WGM ? (nM - fm) : WGM;
        u.pm = fm + ((wgid % nig) % gsz); u.pn = (wgid % nig) / gsz; u.pb = u.pn; return true;
    }
    __device__ __forceinline__ void a_ready(const Unit&) const {}
    __device__ __forceinline__ void done(const Unit&) const {}
};

__device__ __forceinline__ unsigned cvt_pk_bf16(float lo, float hi) { unsigned r; asm volatile("v_cvt_pk_bf16_f32 %0, %1, %2" : "=v"(r) : "v"(lo), "v"(hi)); return r; }
typedef float f32x2 __attribute__((ext_vector_type(2)));
template <class Epi, class Sched, bool ALIGN_EPI = false, bool SP2 = false>
__device__ __forceinline__ void gemm_phase(PG8_LAS unsigned char* lds, const Gemm g, const Sched& S, const Epi& E) {
    const int tid = otid(), wid = __builtin_amdgcn_readfirstlane(tid >> 6), lane = tid & 63, wr = wid >> 2, wc = wid & 3, fr = lane & 15, fq = lane >> 4;
    const int K = g.K, nt = K / BK;
    unsigned voffA[2], voffB[2];
#pragma unroll
    for (int i = 0; i < 2; ++i) { int R, C; stage_rc(tid * 16 + i * 8192, R, C); const int Rb = Epi::PERM ? ((R & ~31) + perm32(R & 31)) : R;
        voffA[i] = (unsigned)(R * K + C) * 2u; voffB[i] = (unsigned)(Rb * K + C) * 2u; }
    const size_t kstep = (size_t)(BK * 2);
    const size_t hstep = (size_t)HALF * K * 2;
    const size_t tstep = 2 * hstep;
    unsigned vA0[2], vA1[2], nA0[2], nA1[2];
    PG8_LAS int* rtab = (PG8_LAS int*)(lds + STAGE_BYTES);
    auto fillA = [&](int ui_, unsigned (&o0)[2], unsigned (&o1)[2]) {
#pragma unroll
        for (int i = 0; i < 2; ++i) {
            if constexpr (Sched::GATHER) { int R, C; stage_rc(tid * 16 + i * 8192, R, C);
                o0[i] = (unsigned)(rtab[ui_ * 256 + R] * K + C) * 2u; o1[i] = (unsigned)(rtab[ui_ * 256 + 128 + R] * K + C) * 2u; }
            else { o0[i] = voffA[i]; o1[i] = voffA[i] + (unsigned)hstep; } } };
    const unsigned ldsw = (unsigned)wid * 1024u;
    const int aoff = lds_byte(wr * 64 + fr, fq * 8), boff = lds_byte(wc * 32 + fr, fq * 8);
#define PG8_SA(b, h) (((b) * 2 + (h)) * HTB)
#define PG8_SB(b, h) ((4 + (b) * 2 + (h)) * HTB)
#define PG8_STAGE(bufoff, gbase, voff) do { _Pragma("unroll") for (int _i = 0; _i < 2; ++_i) \
        __builtin_amdgcn_global_load_lds((const unsigned*)((const char*)(gbase) + (voff)[_i]), (PG8_LAS unsigned*)(lds + (bufoff) + ldsw + _i * 8192), 16, 0, 0); } while (0)
#define PG8_LDA(dst, b, h) do { _Pragma("unroll") for (int m = 0; m < 4; ++m) _Pragma("unroll") for (int k = 0; k < 2; ++k) dst[m][k] = *(const PG8_LAS bf16x8*)(lds + PG8_SA(b, h) + aoff + m * 2048 + k * 1024); } while (0)
#define PG8_LDB(dst, b, h) do { _Pragma("unroll") for (int n = 0; n < 2; ++n) _Pragma("unroll") for (int k = 0; k < 2; ++k) dst[n][k] = *(const PG8_LAS bf16x8*)(lds + PG8_SB(b, h) + boff + n * 2048 + k * 1024); } while (0)
#define PG8_MMA(ai, bj, At, Bt) do { __builtin_amdgcn_s_setprio(1); _Pragma("unroll") for (int m = 0; m < 4; ++m) _Pragma("unroll") for (int n = 0; n < 2; ++n) _Pragma("unroll") for (int k = 0; k < 2; ++k) \
        acc[ai][bj][m][n] = __builtin_amdgcn_mfma_f32_16x16x32_bf16(Bt[n][k], At[m][k], acc[ai][bj][m][n], 0, 0, 0); __builtin_amdgcn_s_setprio(0); } while (0)
#define PG8_WAIT_V(n) asm volatile("s_waitcnt vmcnt(" #n ")" ::: "memory")
#define PG8_WAIT_L(n) asm volatile("s_waitcnt lgkmcnt(" #n ")" ::: "memory")
#define PG8_BAR __builtin_amdgcn_s_barrier()
#define PG8_SCHED __builtin_amdgcn_sched_barrier(0)
    Unit cur, nxt; int ui = 0;
    if (!S.next(0, cur)) return;
    f32x4 acc[2][2][4][2];
#pragma unroll
    for (int a = 0; a < 2; ++a)
#pragma unroll
        for (int b = 0; b < 2; ++b)
#pragma unroll
            for (int m = 0; m < 4; ++m)
#pragma unroll
                for (int n = 0; n < 2; ++n) acc[a][b][m][n] = (f32x4){0.f, 0.f, 0.f, 0.f};
    bf16x8 At[4][2], B0[2][2], B1[2][2];
    if constexpr (Sched::GATHER) {
        for (int ui_ = 0; ; ++ui_) { Unit u_; if (!S.next(ui_, u_)) break; if (tid < 256) rtab[ui_ * 256 + tid] = S.rowsrc(u_.pm * 256 + tid); }
        __syncthreads();
    }
    fillA(0, vA0, vA1);
    const char* cA = Sched::GATHER ? (const char*)g.A : (const char*)g.A + (size_t)cur.pm * tstep; const char* cB = (const char*)g.Bt + (size_t)cur.pb * tstep;
    S.a_ready(cur);
    if constexpr (SP2) {
        PG8_STAGE(PG8_SB(0, 0), cB, voffB); PG8_STAGE(PG8_SB(0, 1), cB + hstep, voffB); PG8_STAGE(PG8_SA(0, 0), cA, vA0); PG8_STAGE(PG8_SA(0, 1), cA, vA1);
        if (wr == 1) PG8_BAR;
        PG8_WAIT_V(2); PG8_BAR;
        PG8_STAGE(PG8_SB(1, 0), cB + kstep, voffB); PG8_STAGE(PG8_SA(1, 0), cA + kstep, vA0); PG8_STAGE(PG8_SB(1, 1), cB + hstep + kstep, voffB);
        PG8_WAIT_V(6); PG8_BAR;
    } else {
        PG8_STAGE(PG8_SB(0, 0), cB, voffB); PG8_STAGE(PG8_SA(0, 0), cA, vA0); PG8_STAGE(PG8_SB(0, 1), cB + hstep, voffB); PG8_STAGE(PG8_SA(0, 1), cA, vA1);
        if (wr == 1) PG8_BAR;
        PG8_WAIT_V(4); PG8_BAR;
        PG8_STAGE(PG8_SB(1, 0), cB + kstep, voffB); PG8_STAGE(PG8_SA(1, 0), cA + kstep, vA0); PG8_STAGE(PG8_SB(1, 1), cB + hstep + kstep, voffB);
        PG8_WAIT_V(6); PG8_BAR;
    }
    for (;;) {
        const bool has_next = S.next(ui + 1, nxt);
        const char* nA = has_next ? (Sched::GATHER ? (const char*)g.A : (const char*)g.A + (size_t)nxt.pm * tstep) : cA; const char* nB = has_next ? (const char*)g.Bt + (size_t)nxt.pb * tstep : cB;
        if (has_next) fillA(ui + 1, nA0, nA1); else {
#pragma unroll
            for (int i = 0; i < 2; ++i) { nA0[i] = vA0[i]; nA1[i] = vA1[i]; } }
        for (int t = 0; t < nt; t += 2) {
            const bool last = (t == nt - 2);
            const char* a1 = cA + (size_t)(t + 1) * kstep;
            const char* a2 = last ? nA : cA + (size_t)(t + 2) * kstep; const char* b2 = last ? nB : cB + (size_t)(t + 2) * kstep;
            const char* a3 = a2 + kstep; const char* b3 = b2 + kstep;
            unsigned sA0[2], sA1[2];
#pragma unroll
            for (int i = 0; i < 2; ++i) { sA0[i] = last ? nA0[i] : vA0[i]; sA1[i] = last ? nA1[i] : vA1[i]; }
            if (last && has_next) S.a_ready(nxt);
            if constexpr (SP2) {
            PG8_LDB(B0, 0, 0); PG8_LDB(B1, 0, 1); PG8_SCHED; PG8_LDA(At, 0, 0); PG8_STAGE(PG8_SA(1, 1), a1, vA1);
            PG8_WAIT_V(8); PG8_WAIT_L(0); PG8_BAR; PG8_MMA(0, 0, At, B0); PG8_MMA(0, 1, At, B1); PG8_BAR; PG8_SCHED;
            PG8_LDA(At, 0, 1); PG8_STAGE(PG8_SB(0, 0), b2, voffB); PG8_STAGE(PG8_SB(0, 1), b2 + hstep, voffB); PG8_STAGE(PG8_SA(0, 0), a2, sA0);
            PG8_WAIT_V(8); PG8_WAIT_L(0); PG8_BAR; PG8_MMA(1, 0, At, B0); PG8_MMA(1, 1, At, B1); PG8_BAR; PG8_SCHED;
            PG8_LDB(B0, 1, 0); PG8_LDB(B1, 1, 1); PG8_SCHED; PG8_LDA(At, 1, 0); PG8_STAGE(PG8_SA(0, 1), a2, sA1);
            PG8_WAIT_V(8); PG8_WAIT_L(0); PG8_BAR; PG8_MMA(0, 0, At, B0); PG8_MMA(0, 1, At, B1); PG8_BAR; PG8_SCHED;
            PG8_LDA(At, 1, 1); PG8_STAGE(PG8_SB(1, 0), b3, voffB); PG8_STAGE(PG8_SB(1, 1), b3 + hstep, voffB); PG8_STAGE(PG8_SA(1, 0), a3, sA0);
            PG8_WAIT_V(8); PG8_WAIT_L(0); PG8_BAR; PG8_MMA(1, 0, At, B0); PG8_MMA(1, 1, At, B1); PG8_BAR; PG8_SCHED;
            } else {
            PG8_LDB(B0, 0, 0); PG8_SCHED; PG8_LDA(At, 0, 0); PG8_STAGE(PG8_SA(1, 1), a1, vA1);
            PG8_WAIT_L(8); PG8_BAR; PG8_WAIT_L(0); PG8_MMA(0, 0, At, B0); PG8_BAR; PG8_SCHED;
            PG8_LDB(B1, 0, 1); PG8_STAGE(PG8_SB(0, 0), b2, voffB);
            PG8_BAR; PG8_WAIT_L(0); PG8_MMA(0, 1, At, B1); PG8_BAR;
            PG8_LDA(At, 0, 1); PG8_STAGE(PG8_SA(0, 0), a2, sA0);
            PG8_BAR; PG8_WAIT_L(0); PG8_MMA(1, 0, At, B0); PG8_BAR; PG8_SCHED;
            PG8_STAGE(PG8_SB(0, 1), b2 + hstep, voffB);
            PG8_WAIT_V(6); PG8_BAR; PG8_MMA(1, 1, At, B1); PG8_BAR;
            PG8_LDB(B0, 1, 0); PG8_SCHED; PG8_LDA(At, 1, 0); PG8_STAGE(PG8_SA(0, 1), a2, sA1);
            PG8_WAIT_L(8); PG8_BAR; PG8_WAIT_L(0); PG8_MMA(0, 0, At, B0); PG8_BAR; PG8_SCHED;
            PG8_LDB(B1, 1, 1); PG8_STAGE(PG8_SB(1, 0), b3, voffB);
            PG8_BAR; PG8_WAIT_L(0); PG8_MMA(0, 1, At, B1); PG8_BAR;
            PG8_LDA(At, 1, 1); PG8_STAGE(PG8_SA(1, 0), a3, sA0);
            PG8_BAR; PG8_WAIT_L(0); PG8_MMA(1, 0, At, B0); PG8_BAR; PG8_SCHED;
            PG8_STAGE(PG8_SB(1, 1), b3 + hstep, voffB);
            PG8_WAIT_V(6); PG8_BAR; PG8_MMA(1, 1, At, B1); PG8_BAR;
            }
        }
        if constexpr (ALIGN_EPI) { if (wr == 0) PG8_BAR; }
        if constexpr (!Epi::AFTER_DRAIN) { E(acc, cur, wr, wc, fr, fq); S.done(cur); }
        if (!has_next) break;
#pragma unroll
        for (int a = 0; a < 2; ++a)
#pragma unroll
            for (int b = 0; b < 2; ++b)
#pragma unroll
                for (int m = 0; m < 4; ++m)
#pragma unroll
                    for (int n = 0; n < 2; ++n) acc[a][b][m][n] = (f32x4){0.f, 0.f, 0.f, 0.f};
        cur = nxt; cA = nA; cB = nB; ++ui;
#pragma unroll
        for (int i = 0; i < 2; ++i) { vA0[i] = nA0[i]; vA1[i] = nA1[i]; }
        if constexpr (ALIGN_EPI) { if (wr == 1) PG8_BAR; }
    }
    PG8_WAIT_V(0);
    if constexpr (!ALIGN_EPI) { if (wr == 0) PG8_BAR; }
    PG8_BAR;
    if constexpr (Epi::AFTER_DRAIN) { E.fused(acc, cur, wr, wc, fr, fq, lds, wid, lane); S.done(cur); }
#undef PG8_SA
#undef PG8_SB
#undef PG8_STAGE
#undef PG8_LDA
#undef PG8_LDB
#undef PG8_MMA
#undef PG8_WAIT_V
#undef PG8_WAIT_L
#undef PG8_BAR
#undef PG8_SCHED
}
}
constexpr int D = 1024, BATCH = 8, SEQ = 4096, NTOK = BATCH * SEQ;
constexpr int GW = 512, RW = 512, HD = 64, CHUNK = 128;
constexpr int RPROJ = 1696, INW = 2720, ZLD = 2816;
constexpr int NG = 4, EPG = 8, NE = 32, EH = 512;
constexpr int NTHR = 512;
constexpr int LDS_BYTES = 163840;

typedef float f32x16 __attribute__((ext_vector_type(16)));
typedef float f32x4 __attribute__((ext_vector_type(4)));
typedef unsigned u32x4 __attribute__((ext_vector_type(4)));
typedef unsigned u32x2 __attribute__((ext_vector_type(2)));
typedef unsigned short bf16;
#define LAS __attribute__((address_space(3)))

constexpr size_t MiB = 1u << 20;
constexpr size_t W_WINT = 0;
constexpr size_t W_WOUTT = 6 * MiB;
constexpr size_t W_LORAT = 8 * MiB;
constexpr size_t W_WC = 9 * MiB;
constexpr size_t W_MOD = 10 * MiB;
constexpr size_t W_RA = W_MOD + 256 * 1024;
constexpr size_t W_RW = W_MOD + 512 * 1024;
constexpr size_t W_TAB = 11 * MiB;
constexpr size_t W_WGUT = 16 * MiB;
constexpr size_t W_WDT = 80 * MiB;
constexpr size_t W_H1 = 112 * MiB;
constexpr size_t W_Z = 176 * MiB;
constexpr size_t W_YCAT = 352 * MiB;
constexpr size_t W_LO = 416 * MiB;
constexpr size_t WS_NEED = 512 * MiB;
constexpr size_t T_TOKE = W_TAB;
constexpr size_t T_TOKW = W_TAB + 512 * 1024;
constexpr size_t T_ROWTOK = W_TAB + 1024 * 1024;
constexpr size_t T_ROWAID = W_TAB + 1536 * 1024;
constexpr size_t T_ROWW = W_TAB + 2048 * 1024;
constexpr size_t T_TILEE = W_TAB + 2560 * 1024;
constexpr size_t T_CTL = W_TAB + 3072 * 1024;
constexpr size_t T_BAR = W_TAB + 3584 * 1024;

struct Params {
    const float* in[31];
    float* out;
    unsigned char* ws;
};
typedef const __attribute__((address_space(4))) Params& PRef;
typedef const __attribute__((address_space(4))) Params* PPtr;
__device__ __forceinline__ PPtr opq(PPtr k) { asm volatile("" : "+s"(k)); return k; }
enum { I_X = 0, I_C, I_ADAW, I_ADAB, I_N1G, I_WIN, I_GLNW, I_GLNB, I_GWS, I_GBS, I_MU, I_W0, I_W2, I_A0, I_A2, I_G2, I_KK, I_KA, I_RK, I_GNW, I_GNB, I_WOUT, I_N2G, I_RGW, I_RGB, I_REW, I_REB, I_WG, I_WU, I_WD, I_FNG };

__device__ __forceinline__ float wave_sum(float v) {
#pragma unroll
    for (int o = 1; o < 64; o <<= 1) v += __shfl_xor(v, o);
    return v;
}
#define DPP_ADD(v, ctrl) v += __builtin_bit_cast(float, __builtin_amdgcn_update_dpp(0, __builtin_bit_cast(int, v), ctrl, 0xf, 0xf, false))
__device__ __forceinline__ float wave_sum_dpp(float v) {
    DPP_ADD(v, 0xB1); DPP_ADD(v, 0x4E); DPP_ADD(v, 0x141); DPP_ADD(v, 0x140);
    const int iv = __builtin_bit_cast(int, v);
    const float a = __builtin_bit_cast(float, __builtin_amdgcn_readlane(iv, 0)), b = __builtin_bit_cast(float, __builtin_amdgcn_readlane(iv, 16));
    const float c = __builtin_bit_cast(float, __builtin_amdgcn_readlane(iv, 32)), d = __builtin_bit_cast(float, __builtin_amdgcn_readlane(iv, 48));
    return (a + b) + (c + d);
}
__device__ __forceinline__ float xsum4(float s) {
    s += __builtin_bit_cast(float, __builtin_amdgcn_ds_swizzle(__builtin_bit_cast(int, s), 0x401F));
    float a = s, b = s;
    asm volatile("s_nop 1\n\tv_permlane32_swap_b32 %0, %1\n\ts_nop 1" : "+v"(a), "+v"(b));
    return a + b;
}
__device__ __forceinline__ float wave_sum_v(float v) {
    DPP_ADD(v, 0xB1); DPP_ADD(v, 0x4E); DPP_ADD(v, 0x141); DPP_ADD(v, 0x140);
    return xsum4(v);
}
__device__ __forceinline__ float gelu_tanh(float x) {
    const float u = 0.7978845608028654f * (x + 0.044715f * x * x * x);
    return 0.5f * x * (1.0f + tanhf(u));
}
__device__ __forceinline__ float gelu_fast(float x) {
    const float u2 = -2.302208198f * (x + 0.044715f * x * x * x);
    return x * __builtin_amdgcn_rcpf(1.0f + __builtin_amdgcn_exp2f(u2));
}
__device__ __forceinline__ float sigmoidf_(float x) { return 1.0f / (1.0f + expf(-x)); }
__device__ __forceinline__ float softplusf_(float x) { return fmaxf(x, 0.f) + log1pf(expf(-fabsf(x))); }
__device__ __forceinline__ float bf2f(unsigned short b) { return __uint_as_float(((unsigned)b) << 16); }
__device__ __forceinline__ float bflo(unsigned w) { return __uint_as_float(w << 16); }
__device__ __forceinline__ float bfhi(unsigned w) { return __uint_as_float(w & 0xffff0000u); }
__device__ __forceinline__ unsigned f2bf(float f) { unsigned u = __float_as_uint(f); return (u + 0x7fffu + ((u >> 16) & 1u)) >> 16; }
__device__ __forceinline__ unsigned pk2(float lo, float hi) { return f2bf(lo) | (f2bf(hi) << 16); }
#define XB_TMO      128
#define XB_XCNT(j)  (256  + 64 * (j))
#define XB_XSUB(j)  (1280 + 64 * (j))
#define XB_XGEN(j)  (2304 + 64 * (j))
#define XB_TOP      3328
#define XB_TOPGEN   3392
#define XCD_BAR_WORDS 3456
#define XB_SPIN_CAP (1u << 18)

__device__ __forceinline__ unsigned xb_ld(unsigned* p)              { return __hip_atomic_load(p, __ATOMIC_RELAXED, __HIP_MEMORY_SCOPE_AGENT); }
__device__ __forceinline__ unsigned xb_add(unsigned* p, unsigned v) { return __hip_atomic_fetch_add(p, v, __ATOMIC_RELAXED, __HIP_MEMORY_SCOPE_AGENT); }
__device__ __forceinline__ unsigned xb_xcc_id() { return (unsigned)__builtin_amdgcn_s_getreg((3 << 11) | 20) & 0xFu; }
#define XB_SPIN(cond, bar) do { unsigned _sp = 0; while (cond) { __builtin_amdgcn_s_sleep(1); \
    if ((++_sp & 255u) == 0u) { if (xb_ld(&(bar)[XB_TMO])) break; if (_sp > XB_SPIN_CAP) { atomicAdd(&(bar)[XB_TMO], 1u); break; } } } } while (0)

struct XcdBarrier {
    unsigned* bar; unsigned x;
    volatile LAS unsigned* st;
};

__device__ __forceinline__ XcdBarrier xcd_barrier_post(unsigned* bar, volatile LAS unsigned* st) {
    XcdBarrier b; b.bar = bar; b.x = xb_xcc_id(); b.st = st;
    if (threadIdx.x == 0) (void)xb_add(&bar[XB_XCNT(b.x)], 1u);
    return b;
}
__device__ __forceinline__ void xcd_barrier_complete(unsigned* bar, unsigned x, unsigned& nloc, unsigned& nx) {
    const unsigned G = gridDim.x * gridDim.y * gridDim.z;
    unsigned sum, cnt, mine, sp = 0u;
    for (;;) {
        sum = 0u; cnt = 0u; mine = 0u;
#pragma unroll
        for (unsigned j = 0; j < 16; ++j) { const unsigned c = xb_ld(&bar[XB_XCNT(j)]); sum += c; cnt += (c > 0u) ? 1u : 0u; mine = (j == x) ? c : mine; }
        if (sum == G) break;
        __builtin_amdgcn_s_sleep(1);
        if ((++sp & 255u) == 0u) { if (xb_ld(&bar[XB_TMO])) break; if (sp > XB_SPIN_CAP) { atomicAdd(&bar[XB_TMO], 1u); break; } }
    }
    nloc = mine > 0u ? mine : 1u; nx = cnt > 0u ? cnt : 1u;
}

__device__ __forceinline__ void xcd_barrier(const XcdBarrier& b) {
    asm volatile("s_waitcnt vmcnt(0)" ::: "memory");
    __syncthreads();
    if (threadIdx.x == 0) {
        unsigned* bar = b.bar;
        __builtin_amdgcn_s_waitcnt(0);
        unsigned nloc = b.st[0], nx = b.st[1];
        if (nloc == 0u) { xcd_barrier_complete(bar, b.x, nloc, nx); b.st[0] = nloc; b.st[1] = nx; }
        const unsigned old = xb_add(&bar[XB_XSUB(b.x)], 1u);
        const unsigned gen = old / nloc;
        if (old + 1u == (gen + 1u) * nloc) {
            __builtin_amdgcn_fence(__ATOMIC_RELEASE, "agent");
            asm volatile("s_waitcnt vmcnt(0)" ::: "memory");
            const unsigned og = xb_add(&bar[XB_TOP], 1u);
            const unsigned tg = og / nx;
            if (og + 1u == (tg + 1u) * nx) xb_add(&bar[XB_TOPGEN], 1u);
            else XB_SPIN(xb_ld(&bar[XB_TOPGEN]) == tg, bar);
            __builtin_amdgcn_fence(__ATOMIC_ACQUIRE, "agent");
            xb_add(&bar[XB_XGEN(b.x)], 1u);
            asm volatile("s_waitcnt vmcnt(0)" ::: "memory");
        } else {
            XB_SPIN(xb_ld(&bar[XB_XGEN(b.x)]) == gen, bar);
            __builtin_amdgcn_fence(__ATOMIC_ACQUIRE, "agent");
            asm volatile("s_waitcnt vmcnt(0)" ::: "memory");
        }
    }
    __syncthreads();
}
struct TrItem { const float* W; bf16* WT; int K, N; long row_off; int item; };
__device__ __forceinline__ void p0_tr_load(const TrItem& it, float (&tv)[32], int lane) {
    const int nblk = it.N / 32, kb = it.item / nblk, nb = it.item % nblk, k0 = 64 * kb, n0 = 32 * nb;
#pragma unroll
    for (int i = 0; i < 32; ++i) tv[i] = it.W[(size_t)(k0 + 2 * i + (lane >> 5)) * it.N + n0 + (lane & 31)];
}
__device__ __forceinline__ void p0_tr_store(const TrItem& it, const float (&tv)[32], LAS float* scr, int lane) {
    const int nblk = it.N / 32, kb = it.item / nblk, nb = it.item % nblk, k0 = 64 * kb, n0 = 32 * nb;
#pragma unroll
    for (int i = 0; i < 32; ++i) scr[(2 * i + (lane >> 5)) * 33 + (lane & 31)] = tv[i];
    asm volatile("s_waitcnt lgkmcnt(0)" ::: "memory");
    const int c = lane & 7;
#pragma unroll
    for (int j = 0; j < 4; ++j) { const int n = (lane >> 3) + 8 * j; const LAS float* s = scr + (8 * c) * 33 + n;
        u32x4 o; o.x = pk2(s[0 * 33], s[1 * 33]); o.y = pk2(s[2 * 33], s[3 * 33]); o.z = pk2(s[4 * 33], s[5 * 33]); o.w = pk2(s[6 * 33], s[7 * 33]);
        *(u32x4*)(it.WT + (size_t)(it.row_off + n0 + n) * it.K + k0 + 8 * c) = o; }
    asm volatile("s_waitcnt lgkmcnt(0)" ::: "memory");
}
__device__ __forceinline__ void p0_tr_store_half(const TrItem& it, const float (&tv)[32], LAS float* scr, int lane, int half) {
    const int nblk = it.N / 32, kb = it.item / nblk, nb = it.item % nblk, k0 = 64 * kb, n0 = 32 * nb;
    if (half == 0) {
#pragma unroll
        for (int i = 0; i < 32; ++i) scr[(2 * i + (lane >> 5)) * 33 + (lane & 31)] = tv[i];
        asm volatile("s_waitcnt lgkmcnt(0)" ::: "memory"); }
    const int c = lane & 7;
#pragma unroll
    for (int jj = 0; jj < 2; ++jj) { const int j = half * 2 + jj; const int n = (lane >> 3) + 8 * j; const LAS float* s = scr + (8 * c) * 33 + n;
        u32x4 o; o.x = pk2(s[0 * 33], s[1 * 33]); o.y = pk2(s[2 * 33], s[3 * 33]); o.z = pk2(s[4 * 33], s[5 * 33]); o.w = pk2(s[6 * 33], s[7 * 33]);
        *(u32x4*)(it.WT + (size_t)(it.row_off + n0 + n) * it.K + k0 + 8 * c) = o; }
    asm volatile("s_waitcnt lgkmcnt(0)" ::: "memory");
}
constexpr int MOE_I_GU = (D / 64) * (EH / 32), MOE_I_DN = (EH / 64) * (D / 32), MOE_ITEMS = NE * (2 * MOE_I_GU + MOE_I_DN);
__device__ __forceinline__ TrItem moe_item(PRef p, int r) {
    const int e = r / (2 * MOE_I_GU + MOE_I_DN); r -= e * (2 * MOE_I_GU + MOE_I_DN);
    if (r < 2 * MOE_I_GU) {
        const int up = r >= MOE_I_GU; if (up) r -= MOE_I_GU;
        const int nbk = r % (EH / 32), hb = nbk * 32;
        const long row_off = (long)e * 1024 + (hb / 128) * 256 + up * 128 + (hb % 128) - hb;
        return TrItem{(up ? p.in[I_WU] : p.in[I_WG]) + (size_t)e * D * EH, (bf16*)(p.ws + W_WGUT), D, EH, row_off, r}; }
    r -= 2 * MOE_I_GU;
    return TrItem{p.in[I_WD] + (size_t)e * EH * D, (bf16*)(p.ws + W_WDT), EH, D, (long)e * 1024, r};
}
__device__ __forceinline__ void p0_mod_item(PRef p, LAS float* lf, int item) {
    const int tid = otid(), cg = tid & 7, kq = tid >> 3;
    const float* __restrict__ c = p.in[I_C]; const float* w = p.in[I_ADAW] + (size_t)(kq * 16) * (6 * D) + item * 32 + cg * 4;
    f32x4 wv[16];
#pragma unroll
    for (int i = 0; i < 16; ++i) wv[i] = *(const f32x4*)(w + (size_t)i * (6 * D));
    LAS float* cs = lf; LAS float* red = lf + BATCH * D;
#pragma unroll
    for (int q = 0; q < 4; ++q) { const int idx = (tid + q * NTHR) * 4; *(LAS f32x4*)(cs + idx) = *(const f32x4*)(c + idx); }
    __syncthreads();
    f32x4 acc[8];
#pragma unroll
    for (int b = 0; b < 8; ++b) { acc[b] = (f32x4){0.f, 0.f, 0.f, 0.f};
#pragma unroll
        for (int i4 = 0; i4 < 4; ++i4) { const f32x4 cv = *(const LAS f32x4*)(cs + b * D + kq * 16 + i4 * 4);
#pragma unroll
            for (int j = 0; j < 4; ++j) acc[b] += wv[i4 * 4 + j] * cv[j]; } }
#pragma unroll
    for (int b = 0; b < 8; ++b) *(LAS f32x4*)(red + (kq * 8 + b) * 32 + cg * 4) = acc[b];
    __syncthreads();
    if (tid < 256) { const int b = tid >> 5, col = tid & 31; float s = 0.f;
#pragma unroll 16
      for (int q = 0; q < 64; ++q) s += red[(q * 8 + b) * 32 + col];
      ((float*)(p.ws + W_MOD))[b * 6 * D + item * 32 + col] = s + p.in[I_ADAB][item * 32 + col]; }
    __syncthreads();
}
template <bool WITH_MOE>
__device__ __forceinline__ void p0_prep(PRef p, LAS unsigned char* lds, int bid, int nb) {
    const int tid = otid(), lane = tid & 63, wave = __builtin_amdgcn_readfirstlane(tid >> 6);
    LAS float* scr = (LAS float*)(lds + wave * 16384);
    const int gw = bid * 8 + wave, NGW = nb * 8;
    constexpr int I_IN = (D / 64) * (INW / 32), I_OUT = (D / 64) * (D / 32), I_GU = (D / 64) * (EH / 32), I_DN = (EH / 64) * (D / 32);
    constexpr int NIT = I_IN + I_OUT + (WITH_MOE ? NE * (2 * I_GU + I_DN) : 0);
    auto decode = [&](int it) -> TrItem {
        int r = it;
        if (r < I_IN) return TrItem{p.in[I_WIN], (bf16*)(p.ws + W_WINT), D, INW, 0, r}; r -= I_IN;
        if (r < I_OUT) return TrItem{p.in[I_WOUT], (bf16*)(p.ws + W_WOUTT), D, D, 0, r}; r -= I_OUT;
        return moe_item(p, r);
    };
    float tvA[32], tvB[32];
    TrItem cur = decode(gw < NIT ? gw : 0);
    if (gw < NIT) p0_tr_load(cur, tvA, lane);
    { constexpr int NLT = 1536 * 256, NWC = 8 * 128 * 128, NRW = 2 * 2 * 48 * 520;
      const int i0 = bid * NTHR + tid, st = nb * NTHR;
      float vlt[3], vwc, vrw[2];
#pragma unroll
      for (int q = 0; q < 3; ++q) { const int i = i0 + q * st, ic = i < NLT ? i : 0, n = ic >> 8, k = ic & 255;
          const float* src = n < 512 ? p.in[I_W2] + (k & 31) * 512 + n : n < 1024 ? p.in[I_A2] + (k & 31) * 512 + (n - 512) : p.in[I_G2] + ((k >= 64 && k < 160) ? k - 64 : 0) * 512 + (n - 1024);
          const bool ok = n < 512 ? k < 32 : n < 1024 ? (k >= 32 && k < 64) : (k >= 64 && k < 160);
          const float v = *src; vlt[q] = ok ? v : 0.f; }
      { const int ic = i0 < NWC ? i0 : 0, s = ic & 127, t = (ic >> 7) & 127; const float v = p.in[I_GWS][ic]; vwc = (s <= t) ? v : 0.f; }
#pragma unroll
      for (int q = 0; q < 2; ++q) { const int i = i0 + q * st, ic = i < NRW ? i : 0; const int kl = ic % 520, qq = (ic / 520) % 48, kh = ic / (520 * 48 * 2); const int k = kh * 512 + (kl < 512 ? kl : 0);
          const float* src = qq < 4 ? p.in[I_RGW] + k * 4 + qq : p.in[I_REW] + k * 32 + (qq < 36 ? qq - 4 : 0);
          const float v = *src; vrw[q] = (kl < 512 && qq < 36) ? v : 0.f; }
      bf16* lt = (bf16*)(p.ws + W_LORAT); bf16* wc = (bf16*)(p.ws + W_WC); bf16* rw = (bf16*)(p.ws + W_RW);
#pragma unroll
      for (int q = 0; q < 3; ++q) { const int i = i0 + q * st; if (i < NLT) lt[i] = (bf16)f2bf(vlt[q]); }
      if (i0 < NWC) wc[i0] = (bf16)f2bf(vwc);
#pragma unroll
      for (int q = 0; q < 2; ++q) { const int i = i0 + q * st; if (i < NRW) { const int hl = (i / (520 * 48)) & 1; const unsigned hi = f2bf(vrw[q]); rw[i] = hl ? (bf16)f2bf(vrw[q] - bflo(hi)) : (bf16)hi; } }
      static_assert(NLT <= 3 * 256 * NTHR && NWC <= 256 * NTHR && NRW <= 2 * 256 * NTHR, "table loops assume a 256-workgroup grid");
      bf16* wpad = (bf16*)(p.ws + W_WINT) + (size_t)INW * D;
      for (int i = i0; i < (ZLD - INW) * D; i += st) wpad[i] = 0; }
#ifndef P0DUP
#define P0DUP 0
#endif
#pragma unroll 1
    for (int it = bid; it < 192; it += nb) p0_mod_item(p, (LAS float*)lds, it);
    { int it = gw;
    if (it < NIT) {
#pragma unroll 1
        for (;;) {
            const int itn = it + NGW; TrItem nxt = cur;
            if (itn < NIT) { nxt = decode(itn); p0_tr_load(nxt, tvB, lane); }
            p0_tr_store(cur, tvA, scr, lane);
            if (itn >= NIT) break;
            const int itn2 = itn + NGW; cur = nxt;
            if (itn2 < NIT) { cur = decode(itn2); p0_tr_load(cur, tvA, lane); }
            p0_tr_store(nxt, tvB, scr, lane);
            if (itn2 >= NIT) break;
            it = itn2;
        } }
    }
}
__device__ __forceinline__ void p1_h1(PRef p, int bid, int nb) {
    const float* __restrict__ x = p.in[I_X]; const float* __restrict__ g = p.in[I_N1G]; const float* mod = (const float*)(p.ws + W_MOD);
    bf16* H1 = (bf16*)(p.ws + W_H1);
    const int tid_ = otid(), lane = tid_ & 63, wv = tid_ >> 6;
    { float* ra = (float*)(p.ws + W_RA);
      for (int i = bid * NTHR + tid_; i < BATCH * D; i += nb * NTHR) { const int b = i >> 10, k = i & 1023; ra[i] = p.in[I_N2G][k] * (1.0f + mod[b * 6 * D + 4 * D + k]); } }
#pragma unroll 1
    for (int gw = bid * 8 + wv; gw < NTOK / 16; gw += nb * 8) {
        const int b = gw >> 8, row0 = b * SEQ + (gw & 255) * 2;
        const float* sh = mod + b * 6 * D; const float* sc = mod + b * 6 * D + D;
        f32x4 mm[4], hh[4];
#pragma unroll
        for (int j = 0; j < 4; ++j) { const int c0 = (lane + 64 * j) * 4; const f32x4 gg = *(const f32x4*)(g + c0), ss = *(const f32x4*)(sc + c0); hh[j] = *(const f32x4*)(sh + c0);
#pragma unroll
            for (int q = 0; q < 4; ++q) mm[j][q] = gg[q] * (1.0f + ss[q]); }
        const f32x4* xr = (const f32x4*)(x + (size_t)row0 * D) + lane;
        u32x2* o = (u32x2*)(H1 + (size_t)row0 * D) + lane;
        f32x4 va[2][4], vb[2][4];
        auto ld = [&](f32x4 (&v)[2][4], int s) __attribute__((always_inline)) {
#pragma unroll
            for (int j = 0; j < 4; ++j) { v[0][j] = __builtin_nontemporal_load(xr + s * (512 * 256) + 64 * j); v[1][j] = __builtin_nontemporal_load(xr + s * (512 * 256) + 256 + 64 * j); } };
        auto proc = [&](const f32x4 (&v)[2][4], int s) __attribute__((always_inline)) {
            float s0 = 0.f, s1 = 0.f;
#pragma unroll
            for (int j = 0; j < 4; ++j) { s0 += (v[0][j][0] * v[0][j][0] + v[0][j][1] * v[0][j][1]) + (v[0][j][2] * v[0][j][2] + v[0][j][3] * v[0][j][3]);
                                          s1 += (v[1][j][0] * v[1][j][0] + v[1][j][1] * v[1][j][1]) + (v[1][j][2] * v[1][j][2] + v[1][j][3] * v[1][j][3]); }
            const float r0 = rsqrtf(wave_sum_dpp(s0) * (1.0f / D) + 1e-6f), r1 = rsqrtf(wave_sum_dpp(s1) * (1.0f / D) + 1e-6f);
#pragma unroll
            for (int j = 0; j < 4; ++j) {
                f32x4 y0, y1;
#pragma unroll
                for (int q = 0; q < 4; ++q) { y0[q] = v[0][j][q] * r0 * mm[j][q] + hh[j][q]; y1[q] = v[1][j][q] * r1 * mm[j][q] + hh[j][q]; }
                u32x2 w0, w1; w0.x = pk2(y0[0], y0[1]); w0.y = pk2(y0[2], y0[3]); w1.x = pk2(y1[0], y1[1]); w1.y = pk2(y1[2], y1[3]);
                o[s * (512 * 256) + 64 * j] = w0; o[s * (512 * 256) + 256 + 64 * j] = w1;
            } };
        ld(va, 0);
#pragma unroll 1
        for (int s = 0; s < 8; s += 2) {
            ld(vb, s + 1);
            proc(va, s);
            ld(va, s + 2 < 8 ? s + 2 : 7);
            proc(vb, s + 1);
        }
    }
}
struct EpiZ {
    static constexpr bool PERM = true, AFTER_DRAIN = false;
    bf16* Z;
    __device__ __forceinline__ void operator()(const f32x4 (&acc)[2][2][4][2], const pg8::Unit& u, int wr, int wc, int fr, int fq) const {
        const int row0 = u.pm * 256 + wr * 64 + fr, col0 = u.pn * 256 + wc * 32 + 8 * fq;
        const bool act = u.pn < 4;
#pragma unroll
        for (int ai = 0; ai < 2; ++ai)
#pragma unroll
            for (int m = 0; m < 4; ++m) { bf16* rowp = Z + (size_t)(row0 + ai * 128 + m * 16) * ZLD + col0;
#pragma unroll
                for (int bj = 0; bj < 2; ++bj) { f32x4 v0 = acc[ai][bj][m][0], v1 = acc[ai][bj][m][1];
                    if (act) {
#pragma unroll
                        for (int q = 0; q < 4; ++q) { v0[q] = gelu_fast(v0[q]); v1[q] = gelu_fast(v1[q]); } }
                    u32x4 w; w.x = pg8::cvt_pk_bf16(v0[0], v0[1]); w.y = pg8::cvt_pk_bf16(v0[2], v0[3]); w.z = pg8::cvt_pk_bf16(v1[0], v1[1]); w.w = pg8::cvt_pk_bf16(v1[2], v1[3]);
                    *(u32x4*)(rowp + bj * 128) = w; } }
    }
};
constexpr int VNT_PITCH = 272;
__device__ __forceinline__ void p3_gmlp_unit(PRef p, LAS unsigned char* lds, int chunk) {
    typedef short bf16x8 __attribute__((ext_vector_type(8)));
    const int tid = otid(), lane = tid & 63, wave = __builtin_amdgcn_readfirstlane(tid >> 6);
    const bf16* Z = (const bf16*)(p.ws + W_Z); bf16* ycat = (bf16*)(p.ws + W_YCAT);
    const int t0 = chunk * CHUNK;
    { float lw[8], lb[8];
#pragma unroll
      for (int j = 0; j < 8; ++j) { lw[j] = p.in[I_GLNW][lane + 64 * j]; lb[j] = p.in[I_GLNB][lane + 64 * j]; }
      unsigned short raw[16][8];
      { const bf16* vp = Z + (size_t)(t0 + wave * 16) * ZLD + 512 + lane;
#pragma unroll
        for (int u = 0; u < 16; ++u)
#pragma unroll
            for (int j = 0; j < 8; ++j) raw[u][j] = vp[u * ZLD + 64 * j]; }
#pragma unroll
      for (int pr = 0; pr < 8; ++pr) {
          const int s = wave * 16 + pr * 2;
          float a[8], b[8]; float sa = 0.f, sb = 0.f;
#pragma unroll
          for (int j = 0; j < 8; ++j) { a[j] = bf2f(raw[pr * 2][j]); b[j] = bf2f(raw[pr * 2 + 1][j]); sa += a[j]; sb += b[j]; }
          const float ma = wave_sum_dpp(sa) * (1.f / 512.f), mb = wave_sum_dpp(sb) * (1.f / 512.f); float qa = 0.f, qb = 0.f;
#pragma unroll
          for (int j = 0; j < 8; ++j) { a[j] -= ma; b[j] -= mb; qa += a[j] * a[j]; qb += b[j] * b[j]; }
          const float ra = rsqrtf(wave_sum_dpp(qa) * (1.f / 512.f) + 1e-5f), rb = rsqrtf(wave_sum_dpp(qb) * (1.f / 512.f) + 1e-5f);
#pragma unroll
          for (int j = 0; j < 8; ++j) { const unsigned w = pk2(a[j] * ra * lw[j] + lb[j], b[j] * rb * lw[j] + lb[j]);
              *(LAS unsigned*)(lds + (lane + 64 * j) * VNT_PITCH + s * 2) = w; }
      } }
    const bf16* Wc = (const bf16*)(p.ws + W_WC) + (size_t)wave * CHUNK * CHUNK;
    const int fr = lane & 15, fq = lane >> 4;
    const LAS unsigned char* abase = lds + (wave * 64 + fr) * VNT_PITCH + fq * 16;
    bf16x8 bfr[20]; u32x2 uw[8][4]; float bsv[8];
    { int fi = 0;
#pragma unroll
      for (int tt = 0; tt < 8; ++tt) { const int nks = ((tt * 16 + 15) >> 5) + 1;
#pragma unroll
          for (int ks = 0; ks < nks; ++ks) bfr[fi++] = *(const bf16x8*)(Wc + (tt * 16 + fr) * CHUNK + ks * 32 + fq * 8); } }
    { const bf16* zu = Z + (size_t)(t0 + fr) * ZLD + wave * 64 + fq * 4;
#pragma unroll
      for (int tt = 0; tt < 8; ++tt) { bsv[tt] = p.in[I_GBS][wave * CHUNK + tt * 16 + fr];
#pragma unroll
          for (int dt = 0; dt < 4; ++dt) uw[tt][dt] = *(const u32x2*)(zu + tt * 16 * ZLD + dt * 16); } }
    __syncthreads();
    { int fi = 0;
      bf16* yo = ycat + (size_t)(t0 + fr) * 1024 + wave * 64 + fq * 4;
#pragma unroll
      for (int tt = 0; tt < 8; ++tt) {
        f32x4 acc[4];
#pragma unroll
        for (int dt = 0; dt < 4; ++dt) acc[dt] = (f32x4){0.f, 0.f, 0.f, 0.f};
        const int nks = ((tt * 16 + 15) >> 5) + 1;
#pragma unroll
        for (int ks = 0; ks < nks; ++ks) {
#pragma unroll
            for (int dt = 0; dt < 4; ++dt) {
                const bf16x8 afr = *(const LAS bf16x8*)(abase + dt * 16 * VNT_PITCH + ks * 64);
                acc[dt] = __builtin_amdgcn_mfma_f32_16x16x32_bf16(afr, bfr[fi], acc[dt], 0, 0, 0);
            }
            ++fi;
        }
#pragma unroll
        for (int dt = 0; dt < 4; ++dt) {
            const u32x2 w2 = uw[tt][dt];
            u32x2 o; o.x = pk2(bflo(w2.x) * (acc[dt][0] + bsv[tt]), bfhi(w2.x) * (acc[dt][1] + bsv[tt])); o.y = pk2(bflo(w2.y) * (acc[dt][2] + bsv[tt]), bfhi(w2.y) * (acc[dt][3] + bsv[tt]));
            *(u32x2*)(yo + tt * 16 * 1024 + dt * 16) = o;
        }
      } }
    __syncthreads();
}
constexpr size_t W_X1B = 240 * MiB;
struct EpiX1 {
    static constexpr bool PERM = true, AFTER_DRAIN = false;
    const float* x; const float* mod; bf16* x1;
    __device__ __forceinline__ void operator()(const f32x4 (&acc)[2][2][4][2], const pg8::Unit& u, int wr, int wc, int fr, int fq) const {
        const int row0 = u.pm * 256 + wr * 64 + fr, col0 = u.pn * 256 + wc * 32 + 8 * fq;
        const int b = (u.pm * 256) / SEQ;
        const float* gt = mod + b * 6 * D + 2 * D;
#pragma unroll
        for (int bj = 0; bj < 2; ++bj) { const f32x4 g0 = *(const f32x4*)(gt + col0 + bj * 128), g1 = *(const f32x4*)(gt + col0 + bj * 128 + 4);
#pragma unroll
            for (int ai = 0; ai < 2; ++ai)
#pragma unroll
                for (int m = 0; m < 4; ++m) { const size_t off = (size_t)(row0 + ai * 128 + m * 16) * D + col0 + bj * 128;
                    const f32x4 x0 = *(const f32x4*)(x + off), xb = *(const f32x4*)(x + off + 4);
                    const f32x4 v0 = x0 + g0 * acc[ai][bj][m][0], v1 = xb + g1 * acc[ai][bj][m][1];
                    u32x4 w; w.x = pg8::cvt_pk_bf16(v0[0], v0[1]); w.y = pg8::cvt_pk_bf16(v0[2], v0[3]); w.z = pg8::cvt_pk_bf16(v1[0], v1[1]); w.w = pg8::cvt_pk_bf16(v1[2], v1[3]);
                    *(u32x4*)(x1 + off) = w; } }
    }
};
constexpr size_t W_A2 = 112 * MiB;
constexpr size_t W_Q = 112 * MiB;
constexpr size_t W_Y2 = 144 * MiB;
constexpr size_t T_RK = W_TAB + 4 * MiB;
constexpr size_t O_M = 0, O_N = 64 * MiB;
constexpr size_t W_S = 176 * MiB;
constexpr int SCL = 64, NCH = SEQ / SCL;

__device__ __forceinline__ float sigmoid_fast(float x) { return __builtin_amdgcn_rcpf(1.0f + __builtin_amdgcn_exp2f(-1.4426950409f * x)); }
__device__ __forceinline__ void p3_lorain(PRef p, int bid, int nb) {
    const bf16* Z = (const bf16*)(p.ws + W_Z); bf16* A2 = (bf16*)(p.ws + W_A2);
    const int tid = otid(), j = tid & 255, sub = tid >> 8;
    const int jc = j < 160 ? j : 159;
    const float muj = p.in[I_MU][1536 + jc];
    const float sm = j < 32 ? 2.f : 1.f, sa = j < 32 ? 2.f : (j >= 64 && j < 160) ? 1.f : 0.f, sb = j < 32 ? -1.f : 0.f, sl = (j >= 32 && j < 64) ? 1.f : 0.f;
#pragma unroll 1
    for (int blk = bid; blk < NTOK / 128; blk += nb) {
        const int ts = blk * 128 + sub * 64;
        const bf16* zp = Z + (size_t)ts * ZLD + 2560 + jc; bf16* ap = A2 + (size_t)ts * 256 + j;
        unsigned short raw[64];
        const unsigned short pv = zp[(ts % SEQ == 0) ? 0 : -ZLD];
#pragma unroll
        for (int t = 0; t < 64; ++t) raw[t] = zp[t * ZLD];
        float prev = (ts % SEQ == 0) ? 0.f : bf2f(pv);
#pragma unroll
        for (int t = 0; t < 64; ++t) { const float cur = bf2f(raw[t]); const float v = cur + (prev - cur) * muj; prev = cur;
            ap[t * 256] = (bf16)f2bf(sa * sigmoid_fast(sm * v) + sb + sl * v); }
    }
}
struct EpiLO {
    static constexpr bool PERM = true, AFTER_DRAIN = false;
    bf16* LO; const float* w0; const float* a0;
    __device__ __forceinline__ void operator()(const f32x4 (&acc)[2][2][4][2], const pg8::Unit& u, int wr, int wc, int fr, int fq) const {
        const int row0 = u.pm * 256 + wr * 64 + fr, col0 = u.pn * 256 + wc * 32 + 8 * fq, kind = u.pn >> 1;
#pragma unroll
        for (int bj = 0; bj < 2; ++bj) {
            f32x4 bv[2];
#pragma unroll
            for (int n = 0; n < 2; ++n) { const int ch = col0 + bj * 128 + 4 * n - kind * 512;
                bv[n] = kind == 0 ? *(const f32x4*)(w0 + ch) : kind == 1 ? *(const f32x4*)(a0 + ch) : (f32x4){0.f, 0.f, 0.f, 0.f}; }
#pragma unroll
            for (int ai = 0; ai < 2; ++ai)
#pragma unroll
                for (int m = 0; m < 4; ++m) { bf16* rowp = LO + (size_t)(row0 + ai * 128 + m * 16) * 1536 + col0 + bj * 128;
                    f32x4 v0 = acc[ai][bj][m][0] + bv[0], v1 = acc[ai][bj][m][1] + bv[1];
                    if (kind < 2) { const float sc = kind == 0 ? -0.6065306597f : 1.0f;
#pragma unroll
                        for (int q = 0; q < 4; ++q) { v0[q] = sc * sigmoid_fast(v0[q]); v1[q] = sc * sigmoid_fast(v1[q]); } }
                    u32x4 w; w.x = pg8::cvt_pk_bf16(v0[0], v0[1]); w.y = pg8::cvt_pk_bf16(v0[2], v0[3]); w.z = pg8::cvt_pk_bf16(v1[0], v1[1]); w.w = pg8::cvt_pk_bf16(v1[2], v1[3]);
                    *(u32x4*)rowp = w;
                    asm volatile("" ::: "memory"); }
        }
    }
};
constexpr int SC_TS = 8;
__device__ __forceinline__ void p5a_chunk(PRef p, LAS unsigned char* lds, int q) {
    typedef float f32x2 __attribute__((ext_vector_type(2)));
    const int tid_ = otid(), lane = tid_ & 63, wave = __builtin_amdgcn_readfirstlane(tid_ >> 6);
    const int seq = q / NCH, c = q % NCH, b = seq >> 3, h = seq & 7;
    const int tb = b * SEQ + c * SCL, hc = h * 64 + lane;
    const bf16* Z = (const bf16*)(p.ws + W_Z); const bf16* LO = (const bf16*)(p.ws + W_LO);
    bf16* Qo = (bf16*)(p.ws + W_Q); bf16* Y2o = (bf16*)(p.ws + W_Y2); bf16* VLo = (bf16*)(p.ws + W_YCAT); float* RKo = (float*)(p.ws + T_RK);
    LAS float* vec = (LAS float*)(lds + wave * (SC_TS * 6 * 256));
    const float mur = p.in[I_MU][hc], muk = p.in[I_MU][512 + hc], muv = p.in[I_MU][1024 + hc];
    const float kkc = p.in[I_KK][hc], kac = p.in[I_KA][hc], rkc = p.in[I_RK][hc];
    float rp = 0.f, kp = 0.f, vp = 0.f;
    if (c != 0) { const bf16* zp = Z + (size_t)(tb - 1) * ZLD + 1024 + hc; rp = bf2f(zp[0]); kp = bf2f(zp[512]); vp = bf2f(zp[1024]); }
    f32x2 Mr[32], Nr[32];
#pragma unroll
    for (int k = 0; k < 32; ++k) { Mr[k] = (f32x2){(2 * k == lane) ? 1.f : 0.f, (2 * k + 1 == lane) ? 1.f : 0.f}; Nr[k] = (f32x2){0.f, 0.f}; }
    for (int sb = 0; sb < SCL / SC_TS; ++sb) {
        const int t0 = tb + sb * SC_TS;
#pragma unroll 1
        for (int sg = 0; sg < SC_TS; sg += 4) { float zr[4], zk[4], zv[4], lw[4], as[4];
          const bf16* zp0 = Z + (unsigned)((t0 + sg) * ZLD + 1024 + hc); const bf16* lp0 = LO + (unsigned)((t0 + sg) * 1536 + hc);
#pragma unroll
          for (int s = 0; s < 4; ++s) { const bf16* zp = zp0 + s * ZLD; const bf16* lp = lp0 + s * 1536;
              zr[s] = bf2f(zp[0]); zk[s] = bf2f(zp[512]); zv[s] = bf2f(zp[1024]); lw[s] = bf2f(lp[0]); as[s] = bf2f(lp[512]); }
#pragma unroll
          for (int s = 0; s < 4; ++s) {
              const float r = zr[s] + (rp - zr[s]) * mur, k = zk[s] + (kp - zk[s]) * muk, v = zv[s] + (vp - zv[s]) * muv;
              rp = zr[s]; kp = zk[s]; vp = zv[s];
              const float kkv = k * kkc;
              const float nrm = sqrtf(wave_sum_dpp(kkv * kkv));
              const float kk = kkv / fmaxf(nrm, 1e-12f);
              const float k2 = k * (1.0f + (as[s] - 1.0f) * kac);
              const float rk = wave_sum_dpp(r * k2 * rkc);
              LAS float* o = vec + (sg + s) * 384 + lane;
              o[0] = __builtin_amdgcn_exp2f(1.4426950409f * lw[s]); o[64] = -kk; o[128] = kk * as[s]; o[192] = k2; o[256] = r; o[320] = v;
              VLo[(unsigned)((t0 + sg + s) * 1024 + 512 + hc)] = (bf16)f2bf(v);
              if (lane == 0) RKo[(unsigned)((t0 + sg + s) * 8 + h)] = rk;
          } }
        asm volatile("s_waitcnt lgkmcnt(0)" ::: "memory");
        for (int s = 0; s < SC_TS; ++s) {
            const LAS float* vs = vec + s * 384;
            const float vi = vs[320 + lane];
            f32x2 saM = {0.f, 0.f}, saN = {0.f, 0.f};
#pragma unroll
            for (int k4 = 0; k4 < 16; ++k4) { const f32x4 a4 = *(const LAS f32x4*)(vs + 64 + 4 * k4);
                const f32x2 a0 = {a4[0], a4[1]}, a1 = {a4[2], a4[3]};
                saM += Mr[2 * k4] * a0; saN += Nr[2 * k4] * a0; saM += Mr[2 * k4 + 1] * a1; saN += Nr[2 * k4 + 1] * a1;
                if ((k4 & 3) == 3) asm volatile("" ::: "memory"); }
            const float sM = saM[0] + saM[1], sN = saN[0] + saN[1];
            const f32x2 sM2 = {sM, sM}, sN2 = {sN, sN}, vi2 = {vi, vi};
            f32x2 yM = {0.f, 0.f}, yN = {0.f, 0.f};
#pragma unroll
            for (int k4 = 0; k4 < 16; ++k4) {
                const f32x4 w4 = *(const LAS f32x4*)(vs + 4 * k4), b4 = *(const LAS f32x4*)(vs + 128 + 4 * k4), k4v = *(const LAS f32x4*)(vs + 192 + 4 * k4), r4 = *(const LAS f32x4*)(vs + 256 + 4 * k4);
#pragma unroll
                for (int hh = 0; hh < 2; ++hh) {
                    const f32x2 w2 = {w4[2 * hh], w4[2 * hh + 1]}, b2 = {b4[2 * hh], b4[2 * hh + 1]}, k2 = {k4v[2 * hh], k4v[2 * hh + 1]}, r2 = {r4[2 * hh], r4[2 * hh + 1]};
                    const int kx = 2 * k4 + hh;
                    Mr[kx] = Mr[kx] * w2 + sM2 * b2;
                    Nr[kx] = Nr[kx] * w2 + (sN2 * b2 + vi2 * k2);
                    yM += Mr[kx] * r2; yN += Nr[kx] * r2;
                }
                asm volatile("" ::: "memory");
            }
            const unsigned oo = (unsigned)((t0 + s) * 512 + hc);
            Qo[oo] = (bf16)f2bf(yM[0] + yM[1]); Y2o[oo] = (bf16)f2bf(yN[0] + yN[1]);
        }
        asm volatile("s_waitcnt lgkmcnt(0)" ::: "memory");
    }
    f32x4* Mo = (f32x4*)((unsigned char*)p.out + O_M + (size_t)q * 16384 + lane * 256);
    f32x4* No = (f32x4*)((unsigned char*)p.out + O_N + (size_t)q * 16384 + lane * 256);
#pragma unroll
    for (int k4 = 0; k4 < 16; ++k4) { Mo[k4] = (f32x4){Mr[2 * k4][0], Mr[2 * k4][1], Mr[2 * k4 + 1][0], Mr[2 * k4 + 1][1]}; No[k4] = (f32x4){Nr[2 * k4][0], Nr[2 * k4][1], Nr[2 * k4 + 1][0], Nr[2 * k4 + 1][1]}; }
}
__device__ __forceinline__ void p5b_chain(PRef p, LAS unsigned char* lds, int item) {
    typedef float f32x2 __attribute__((ext_vector_type(2)));
    const int tid = otid(), r = tid >> 5, j0 = (tid & 31) * 2, seq = (item & 7) + 8 * (item >> 5), rg = (item >> 3) & 3;
    const unsigned char* Mb = (const unsigned char*)p.out + O_M + (size_t)seq * NCH * 16384;
    const unsigned char* Nb = (const unsigned char*)p.out + O_N + (size_t)seq * NCH * 16384 + (size_t)(rg * 16 + r) * 256 + j0 * 4;
    unsigned char* Sb = p.ws + W_S + (size_t)seq * NCH * 16384 + (size_t)(rg * 16 + r) * 256 + j0 * 4;
    f32x2 sreg = {0.f, 0.f};
    f32x4 m0[2], m1[2], m2[2], m3[2]; f32x2 n0, n1, n2, n3;
#define P5B_LOAD(mm, nn, cc) do { const f32x4* mp = (const f32x4*)(Mb + (size_t)(cc) * 16384) + tid; mm[0] = mp[0]; mm[1] = mp[512]; nn = *(const f32x2*)(Nb + (size_t)(cc) * 16384); } while (0)
#define P5B_BAR() do { asm volatile("s_waitcnt lgkmcnt(0)" ::: "memory"); __builtin_amdgcn_s_barrier(); asm volatile("" ::: "memory"); } while (0)
#define P5B_STEP(mm, nn, cc) do { \
        LAS float* Sl = (LAS float*)(lds + ((cc) & 1) * 20480); LAS float* Ml = Sl + 1024; \
        *(LAS f32x4*)(Ml + tid * 4) = mm[0]; *(LAS f32x4*)(Ml + 2048 + tid * 4) = mm[1]; *(LAS f32x2*)(Sl + r * 64 + j0) = sreg; \
        *(f32x2*)(Sb + (size_t)(cc) * 16384) = sreg; \
        f32x2 acc = nn; \
        P5B_BAR(); \
        if ((cc) + 4 < NCH) P5B_LOAD(mm, nn, (cc) + 4); \
        _Pragma("unroll 16") for (int i = 0; i < 64; ++i) { const float sv = Sl[r * 64 + i]; const f32x2 mv = *(const LAS f32x2*)(Ml + i * 64 + j0); acc += (f32x2){sv, sv} * mv; } \
        sreg = acc; } while (0)
    __syncthreads();
    P5B_LOAD(m0, n0, 0); P5B_LOAD(m1, n1, 1); P5B_LOAD(m2, n2, 2); P5B_LOAD(m3, n3, 3);
    for (int c = 0; c < NCH; c += 4) { P5B_STEP(m0, n0, c); P5B_STEP(m1, n1, c + 1); P5B_STEP(m2, n2, c + 2); P5B_STEP(m3, n3, c + 3); }
    __syncthreads();
#undef P5B_LOAD
#undef P5B_STEP
#undef P5B_BAR
}
#ifndef P5C_MASK
#define P5C_MASK(c, h, tt) true
#endif
struct P5cOps { short __attribute__((ext_vector_type(8))) qb0, qb1; u32x4 y2a, y2b, vla, vlb, ga, gbv; float rk; };
__device__ __forceinline__ void p5c_chunk(PRef p, LAS unsigned char* lds, int q) {
    typedef short bf16x8 __attribute__((ext_vector_type(8)));
    const int tid_ = otid(), lane = tid_ & 63, wave = __builtin_amdgcn_readfirstlane(tid_ >> 6), fr = lane & 15, fq = lane >> 4;
    const int tk = lane >> 2, pc = lane & 3;
    const int seq = q / NCH, c = q % NCH, b = seq >> 3, h = seq & 7, tb = b * SEQ + c * SCL;
    const bf16* Qi = (const bf16*)(p.ws + W_Q); const bf16* Y2i = (const bf16*)(p.ws + W_Y2);
    const float* RKi = (const float*)(p.ws + T_RK); const bf16* LO = (const bf16*)(p.ws + W_LO); bf16* ycat = (bf16*)(p.ws + W_YCAT);
    const bf16* Sc = (const bf16*)(p.ws + W_S + (size_t)q * 8192);
    LAS float* yt = (LAS float*)(lds + wave * 4352);
    bf16x8 sa[4][2];
#pragma unroll
    for (int vt = 0; vt < 4; ++vt)
#pragma unroll
        for (int ks = 0; ks < 2; ++ks) sa[vt][ks] = *(const bf16x8*)(Sc + (vt * 16 + fr) * 64 + ks * 32 + fq * 8);
    auto ld = [&](P5cOps& o, int tt) __attribute__((always_inline)) {
        const unsigned tq = (unsigned)((tb + tt * 16 + fr) * 512 + h * 64);
        o.qb0 = *(const bf16x8*)(Qi + (tq + fq * 8)); o.qb1 = *(const bf16x8*)(Qi + (tq + 32 + fq * 8));
        const int t = tb + tt * 16 + tk;
        const unsigned o512 = (unsigned)(t * 512 + h * 64 + pc * 16), o1024 = (unsigned)(t * 1024 + 512 + h * 64 + pc * 16), olo = (unsigned)(t * 1536 + 1024 + h * 64 + pc * 16);
        o.y2a = *(const u32x4*)(Y2i + o512); o.y2b = *(const u32x4*)(Y2i + o512 + 8);
        o.vla = *(const u32x4*)(ycat + o1024); o.vlb = *(const u32x4*)(ycat + o1024 + 8);
        o.ga = *(const u32x4*)(LO + olo); o.gbv = *(const u32x4*)(LO + olo + 8);
        o.rk = RKi[(unsigned)(t * 8 + h)]; };
    P5cOps oa, ob; ld(oa, 0);
    f32x4 gw[4], gb[4];
#pragma unroll
    for (int i = 0; i < 4; ++i) { gw[i] = *(const f32x4*)(p.in[I_GNW] + h * 64 + pc * 16 + i * 4); gb[i] = *(const f32x4*)(p.in[I_GNB] + h * 64 + pc * 16 + i * 4); }
    auto proc = [&](const P5cOps& o, int tt) __attribute__((always_inline)) {
        const unsigned o1024 = (unsigned)((tb + tt * 16 + tk) * 1024 + 512 + h * 64 + pc * 16);
#pragma unroll
        for (int vt = 0; vt < 4; ++vt) {
            f32x4 a = {0.f, 0.f, 0.f, 0.f};
            a = __builtin_amdgcn_mfma_f32_16x16x32_bf16(sa[vt][0], o.qb0, a, 0, 0, 0);
            a = __builtin_amdgcn_mfma_f32_16x16x32_bf16(sa[vt][1], o.qb1, a, 0, 0, 0);
            *(LAS f32x4*)(yt + fr * 68 + vt * 16 + 4 * fq) = a;
        }
        asm volatile("s_waitcnt lgkmcnt(0)" ::: "memory");
        f32x4 y[4];
#pragma unroll
        for (int i = 0; i < 4; ++i) y[i] = *(const LAS f32x4*)(yt + tk * 68 + pc * 16 + i * 4);
        asm volatile("s_waitcnt lgkmcnt(0)" ::: "memory");
        const unsigned y2w[8] = {o.y2a.x, o.y2a.y, o.y2a.z, o.y2a.w, o.y2b.x, o.y2b.y, o.y2b.z, o.y2b.w};
        float s = 0.f;
#pragma unroll
        for (int i = 0; i < 4; ++i) { y[i][0] += bflo(y2w[2 * i]); y[i][1] += bfhi(y2w[2 * i]); y[i][2] += bflo(y2w[2 * i + 1]); y[i][3] += bfhi(y2w[2 * i + 1]); s += (y[i][0] + y[i][1]) + (y[i][2] + y[i][3]); }
        DPP_ADD(s, 0xB1); DPP_ADD(s, 0x4E);
        const float m = s * (1.f / 64.f); float qq = 0.f;
#pragma unroll
        for (int i = 0; i < 4; ++i) { y[i] = y[i] - m; qq += (y[i][0] * y[i][0] + y[i][1] * y[i][1]) + (y[i][2] * y[i][2] + y[i][3] * y[i][3]); }
        DPP_ADD(qq, 0xB1); DPP_ADD(qq, 0x4E);
        const float rs = rsqrtf(qq * (1.f / 64.f) + 64e-5f);
        const unsigned vw[8] = {o.vla.x, o.vla.y, o.vla.z, o.vla.w, o.vlb.x, o.vlb.y, o.vlb.z, o.vlb.w}, gwd[8] = {o.ga.x, o.ga.y, o.ga.z, o.ga.w, o.gbv.x, o.gbv.y, o.gbv.z, o.gbv.w};
        unsigned ow[8];
#pragma unroll
        for (int i = 0; i < 4; ++i) {
            const f32x4 vv = {bflo(vw[2 * i]), bfhi(vw[2 * i]), bflo(vw[2 * i + 1]), bfhi(vw[2 * i + 1])}, gg = {bflo(gwd[2 * i]), bfhi(gwd[2 * i]), bflo(gwd[2 * i + 1]), bfhi(gwd[2 * i + 1])};
            const f32x4 ov = (y[i] * rs * gw[i] + gb[i] + vv * o.rk) * gg;
            ow[2 * i] = pg8::cvt_pk_bf16(ov[0], ov[1]); ow[2 * i + 1] = pg8::cvt_pk_bf16(ov[2], ov[3]); }
        *(u32x4*)(ycat + o1024) = (u32x4){ow[0], ow[1], ow[2], ow[3]}; *(u32x4*)(ycat + o1024 + 8) = (u32x4){ow[4], ow[5], ow[6], ow[7]}; };
#pragma unroll 1
    for (int tt = 0; tt < SCL / 16; tt += 2) { ld(ob, tt + 1); proc(oa, tt); ld(oa, tt + 2 < SCL / 16 ? tt + 2 : tt + 1); proc(ob, tt + 1); }
}
constexpr size_t W_H2 = 112 * MiB;
constexpr size_t W_XS = 176 * MiB;
constexpr size_t W_HB = 320 * MiB;
constexpr int PROWS = NTOK * 2 + NE * 256, PTILES = PROWS / 256;
constexpr size_t T_HIST = W_TAB + 3 * 1024 * 1024 + 8192;
constexpr size_t T_NT = W_TAB + 3 * 1024 * 1024 + 4096;
constexpr size_t T_BQ = W_TAB + 3 * 1024 * 1024 + 65536;
constexpr int TPW = NTOK / 256;

__device__ __forceinline__ void p1_bq(PRef p, LAS float* red, int b) {
    const int tid = otid();
    const float* sh = (const float*)(p.ws + W_MOD) + b * 6 * D + 3 * D;
    if (tid < 288) { const int q = tid % 36, part = tid / 36; float s = 0.f;
        for (int c = part * 128; c < part * 128 + 128; ++c) s = fmaf(sh[c], q < 4 ? p.in[I_RGW][c * 4 + q] : p.in[I_REW][c * 32 + q - 4], s);
        red[part * 36 + q] = s; }
    __syncthreads();
    if (tid < 36) { float s = 0.f;
#pragma unroll
        for (int k = 0; k < 8; ++k) s += red[k * 36 + tid];
        ((float*)(p.ws + T_BQ))[b * 36 + tid] = s + (tid < 4 ? p.in[I_RGB][tid] : p.in[I_REB][tid - 4]); }
    __syncthreads();
}
__device__ __forceinline__ void p7_route(PRef p, LAS unsigned char* lds, int bid) {
    const int tid = otid(), lane = tid & 63, wave = __builtin_amdgcn_readfirstlane(tid >> 6);
    const float* x1 = p.out; bf16* H2 = (bf16*)(p.ws + W_H2);
    LAS int* hist = (LAS int*)(lds + 147456);
    const int b = (bid * TPW) / SEQ;
    const float* mod = (const float*)(p.ws + W_MOD) + b * 6 * D;
    const float* n2g = p.in[I_N2G];
    for (int ch = tid; ch < 1024 * 8; ch += NTHR) { const int c = ch >> 3, i = ch & 7;
        *(LAS f32x4*)(lds + c * 128 + 16 * (i ^ ((c >> 1) & 7))) = *(const f32x4*)(p.in[I_REW] + c * 32 + i * 4); }
    for (int c = tid; c < 1024; c += NTHR) *(LAS f32x4*)(lds + 131072 + c * 16) = *(const f32x4*)(p.in[I_RGW] + c * 4);
    if (tid < 32) hist[tid] = 0;
    if (tid < 36) *(LAS float*)(lds + 147456 + 128 + 4 * tid) = tid < 4 ? p.in[I_RGB][tid] : p.in[I_REB][tid - 4];
    __syncthreads();
    const int sw = (lane >> 1) & 7;
#pragma unroll 1
    for (int tp = 0; tp < TPW / 8; tp += 2) {
        const int t0 = bid * TPW + wave * (TPW / 8) + tp;
        const float* xr0 = x1 + (size_t)t0 * D; bf16* hr0 = H2 + (size_t)t0 * D;
        float r0, r1;
        { float pa[16], pb[16];
#pragma unroll
          for (int j = 0; j < 16; ++j) { pa[j] = xr0[lane + 64 * j]; pb[j] = xr0[D + lane + 64 * j]; }
          float ss0 = 0.f, ss1 = 0.f;
#pragma unroll
          for (int j = 0; j < 16; ++j) { ss0 = fmaf(pa[j], pa[j], ss0); ss1 = fmaf(pb[j], pb[j], ss1); }
          r0 = rsqrtf(wave_sum_v(ss0) * (1.0f / D) + 1e-6f); r1 = rsqrtf(wave_sum_v(ss1) * (1.0f / D) + 1e-6f); }
        float acc[2][36];
#pragma unroll
        for (int u = 0; u < 2; ++u)
#pragma unroll
            for (int q = 0; q < 36; ++q) acc[u][q] = 0.f;
#pragma unroll 1
        for (int j0 = 0; j0 < 16; j0 += 4) {
            float xa[4], xb[4], gv[4], sv[4];
#pragma unroll
            for (int jj = 0; jj < 4; ++jj) { const int c = lane + 64 * (j0 + jj); xa[jj] = xr0[c]; xb[jj] = xr0[D + c]; gv[jj] = n2g[c] * (1.0f + mod[4 * D + c]); sv[jj] = mod[3 * D + c]; }
#pragma unroll
            for (int jj = 0; jj < 4; ++jj) {
                const int c = lane + 64 * (j0 + jj);
                const float a0 = xa[jj] * r0 * gv[jj] + sv[jj], a1 = xb[jj] * r1 * gv[jj] + sv[jj];
                hr0[c] = (bf16)f2bf(a0); hr0[D + c] = (bf16)f2bf(a1);
                const LAS unsigned char* rowp = lds + c * 128;
                { const f32x4 w = *(const LAS f32x4*)(lds + 131072 + c * 16);
#pragma unroll
                  for (int q = 0; q < 4; ++q) { acc[0][q] = fmaf(a0, w[q], acc[0][q]); acc[1][q] = fmaf(a1, w[q], acc[1][q]); } }
#pragma unroll
                for (int i = 0; i < 8; ++i) { const f32x4 w = *(const LAS f32x4*)(rowp + 16 * (i ^ sw));
#pragma unroll
                    for (int q = 0; q < 4; ++q) { acc[0][4 + 4 * i + q] = fmaf(a0, w[q], acc[0][4 + 4 * i + q]); acc[1][4 + 4 * i + q] = fmaf(a1, w[q], acc[1][4 + 4 * i + q]); } }
            }
        }
#pragma unroll
        for (int u = 0; u < 2; ++u) {
            float lg[36];
#pragma unroll
            for (int q = 0; q < 36; ++q) { lg[q] = wave_sum_v(acc[u][q]); if ((q & 3) == 3) __builtin_amdgcn_sched_barrier(0); }
            unsigned bqo = 147456u + 128u; asm volatile("" : "+v"(bqo));
#pragma unroll
            for (int q = 0; q < 36; ++q) lg[q] += *(const LAS float*)(lds + bqo + 4 * q);
            int gi = 0; float gm = lg[0];
#pragma unroll
            for (int q = 1; q < 4; ++q) if (lg[q] > gm) { gm = lg[q]; gi = q; }
            float gsum = 0.f;
#pragma unroll
            for (int q = 0; q < 4; ++q) gsum += expf(lg[q] - gm);
            const float gp = 1.0f / gsum;
            float el[8];
#pragma unroll
            for (int q = 0; q < 8; ++q) el[q] = gi == 0 ? lg[4 + q] : gi == 1 ? lg[12 + q] : gi == 2 ? lg[20 + q] : lg[28 + q];
            int i0 = 0; float m0 = el[0];
#pragma unroll
            for (int q = 1; q < 8; ++q) if (el[q] > m0) { m0 = el[q]; i0 = q; }
            int i1 = -1; float m1 = -3.0e38f;
#pragma unroll
            for (int q = 0; q < 8; ++q) if (q != i0 && el[q] > m1) { m1 = el[q]; i1 = q; }
            const float p1 = expf(m1 - m0);
            const float w0 = gp / (1.0f + p1), w1 = gp * p1 / (1.0f + p1);
            if (lane == 0) { const int t = t0 + u, e0 = gi * 8 + i0, e1 = gi * 8 + i1;
                int* toke = (int*)(p.ws + T_TOKE); float* tokw = (float*)(p.ws + T_TOKW);
                toke[t * 2] = e0; toke[t * 2 + 1] = e1; tokw[t * 2] = w0; tokw[t * 2 + 1] = w1;
                __hip_atomic_fetch_add(&hist[e0], 1, __ATOMIC_RELAXED, __HIP_MEMORY_SCOPE_WORKGROUP); __hip_atomic_fetch_add(&hist[e1], 1, __ATOMIC_RELAXED, __HIP_MEMORY_SCOPE_WORKGROUP); }
        }
    }
    __syncthreads();
    if (tid < 32) ((int*)(p.ws + T_HIST))[bid * 32 + tid] = hist[tid];
    __syncthreads();
}
__device__ __forceinline__ void p8_place(PRef p, LAS unsigned char* lds, int bid) {
    const int tid = otid(), lane = tid & 63, wave = __builtin_amdgcn_readfirstlane(tid >> 6);
    LAS int* ptot = (LAS int*)lds;
    LAS int* pbef = ptot + 512;
    LAS int* base = pbef + 512;
    LAS int* lcur = base + 32;
    LAS int* posl = lcur + 32;
    LAS int* padb = posl + 256;
    const int* hist = (const int*)(p.ws + T_HIST);
    const int a_pre = bid * 256 + (tid & 255); const int e_pre = ((const int*)(p.ws + T_TOKE))[a_pre]; const float w_pre = ((const float*)(p.ws + T_TOKW))[a_pre];
    { const int e = tid & 31, part = tid >> 5; int tot = 0, bef = 0; int hc[16];
#pragma unroll
      for (int w = 0; w < 16; ++w) hc[w] = hist[(part * 16 + w) * 32 + e];
#pragma unroll
      for (int w = 0; w < 16; ++w) { tot += hc[w]; bef += (part * 16 + w < bid) ? hc[w] : 0; }
      ptot[part * 32 + e] = tot; pbef[part * 32 + e] = bef; }
    __syncthreads();
    if (tid < 32) { int tot = 0, bef = 0;
#pragma unroll
        for (int k = 0; k < 16; ++k) { tot += ptot[k * 32 + tid]; bef += pbef[k * 32 + tid]; }
        ptot[tid] = tot; pbef[tid] = bef; lcur[tid] = 0; }
    __syncthreads();
    if (tid == 0) { int row = 0;
        for (int e = 0; e < NE; ++e) { const int cnt = ptot[e], nt = (cnt + 255) >> 8; base[e] = row + pbef[e]; padb[e] = row + cnt; padb[32 + e] = row + nt * 256;
            if (bid == 0) { int* te = (int*)(p.ws + T_TILEE); for (int k = 0; k < nt; ++k) te[(row >> 8) + k] = e; }
            row += nt * 256; }
        if (bid == 0) *(int*)(p.ws + T_NT) = row >> 8; }
    __syncthreads();
    int* rowaid = (int*)(p.ws + T_ROWAID); float* roww = (float*)(p.ws + T_ROWW);
    if (tid < 256) { const int a = a_pre, e = e_pre;
        const int pos = base[e] + __hip_atomic_fetch_add(&lcur[e], 1, __ATOMIC_RELAXED, __HIP_MEMORY_SCOPE_WORKGROUP);
        posl[tid] = pos; rowaid[pos] = a; roww[pos] = w_pre; }
    if (bid < NE) for (int r = padb[bid] + tid; r < padb[32 + bid]; r += NTHR) { rowaid[r] = -1; roww[r] = 0.f; }
    __syncthreads();
    __syncthreads();
}
template <bool GATHER_>
struct MoeOrder {
    static constexpr bool GATHER = GATHER_;
    const int* tile_e; const int* rowaid; int nM, G, c;
    __device__ __forceinline__ int rowsrc(int row) const { const int a = rowaid[row]; return (a < 0 ? 0 : a) >> 1; }
    __device__ __forceinline__ bool next(int i, pg8::Unit& u) const {
        const int nwg = nM * 4; const long L = (long)i * G + c; if (L >= nwg) return false;
        int wgid = (int)L; { const int q = nwg / 8, r = nwg % 8, xcd = wgid % 8, off = wgid / 8; wgid = (xcd < r ? xcd * (q + 1) : r * (q + 1) + (xcd - r) * q) + off; }
        const int nig = 8 * 4, gid = wgid / nig, fm = gid * 8, gsz = (nM - fm) < 8 ? (nM - fm) : 8;
        u.pm = fm + ((wgid % nig) % gsz); u.pn = (wgid % nig) / gsz; u.pb = tile_e[u.pm] * 4 + u.pn; return true;
    }
    __device__ __forceinline__ void a_ready(const pg8::Unit&) const {}
    __device__ __forceinline__ void done(const pg8::Unit&) const {}
};
__device__ __forceinline__ float silu_fast(float x) { return x * __builtin_amdgcn_rcpf(1.0f + __builtin_amdgcn_exp2f(-1.4426950409f * x)); }
struct EpiH {
    static constexpr bool PERM = true, AFTER_DRAIN = false;
    bf16* H;
    __device__ __forceinline__ void operator()(const f32x4 (&acc)[2][2][4][2], const pg8::Unit& u, int wr, int wc, int fr, int fq) const {
        const int row0 = u.pm * 256 + wr * 64 + fr, col0 = u.pn * 128 + wc * 32 + 8 * fq;
#pragma unroll
        for (int ai = 0; ai < 2; ++ai)
#pragma unroll
            for (int m = 0; m < 4; ++m) { const f32x4 g0 = acc[ai][0][m][0], g1 = acc[ai][0][m][1], u0 = acc[ai][1][m][0], u1 = acc[ai][1][m][1];
                f32x4 h0, h1;
#pragma unroll
                for (int q = 0; q < 4; ++q) { h0[q] = silu_fast(g0[q]) * u0[q]; h1[q] = silu_fast(g1[q]) * u1[q]; }
                u32x4 w; w.x = pg8::cvt_pk_bf16(h0[0], h0[1]); w.y = pg8::cvt_pk_bf16(h0[2], h0[3]); w.z = pg8::cvt_pk_bf16(h1[0], h1[1]); w.w = pg8::cvt_pk_bf16(h1[2], h1[3]);
                *(u32x4*)(H + (size_t)(row0 + ai * 128 + m * 16) * EH + col0) = w; }
    }
};
struct EpiY {
    static constexpr bool PERM = true, AFTER_DRAIN = false;
    bf16* YB; const int* rowaid; const float* roww;
    __device__ __forceinline__ void operator()(const f32x4 (&acc)[2][2][4][2], const pg8::Unit& u, int wr, int wc, int fr, int fq) const {
        const int row0 = u.pm * 256 + wr * 64 + fr, col0 = u.pn * 256 + wc * 32 + 8 * fq;
#pragma unroll
        for (int ai = 0; ai < 2; ++ai)
#pragma unroll
            for (int m = 0; m < 4; ++m) { const int row = row0 + ai * 128 + m * 16; const int a = rowaid[row]; const float w = roww[row];
                if (a >= 0) {
#pragma unroll
                    for (int bj = 0; bj < 2; ++bj) { const f32x4 v0 = acc[ai][bj][m][0] * w, v1 = acc[ai][bj][m][1] * w;
                        u32x4 o; o.x = pg8::cvt_pk_bf16(v0[0], v0[1]); o.y = pg8::cvt_pk_bf16(v0[2], v0[3]); o.z = pg8::cvt_pk_bf16(v1[0], v1[1]); o.w = pg8::cvt_pk_bf16(v1[2], v1[3]);
                        *(u32x4*)(YB + (size_t)a * D + col0 + bj * 128) = o; } } }
    }
};
__device__ __forceinline__ void p11_final(PRef p, int bid, int nb) {
    const int tid_ = otid(), lane = tid_ & 63, wv = tid_ >> 6;
    const float* mod = (const float*)(p.ws + W_MOD); const bf16* YB = (const bf16*)p.out; const bf16* X1 = (const bf16*)(p.ws + W_X1B); float* out = p.out; const float* g = p.in[I_FNG];
#pragma unroll 1
    for (int gw = bid * 8 + wv; gw < NTOK / 16; gw += nb * 8) {
        const int b = gw >> 8, row0 = b * SEQ + (gw & 255);
        const float* gt = mod + b * 6 * D + 5 * D;
        f32x4 gv[4], fg[4];
#pragma unroll
        for (int j = 0; j < 4; ++j) { const int c0 = (lane + 64 * j) * 4; gv[j] = *(const f32x4*)(gt + c0); fg[j] = *(const f32x4*)(g + c0); }
        struct Ops { u32x2 xw[4], a[4], b[4]; };
        auto ld = [&](Ops& o, int s) __attribute__((always_inline)) { const size_t row = (size_t)(row0 + s * 256);
#pragma unroll
            for (int j = 0; j < 4; ++j) { const int c0 = (lane + 64 * j) * 4;
                o.xw[j] = *(const u32x2*)(X1 + row * D + c0); o.a[j] = *(const u32x2*)(YB + 2 * row * D + c0); o.b[j] = *(const u32x2*)(YB + (2 * row + 1) * D + c0); } };
        auto proc = [&](const Ops& o, int s) __attribute__((always_inline)) { const size_t row = (size_t)(row0 + s * 256);
            f32x4 v[4]; float sq = 0.f;
#pragma unroll
            for (int j = 0; j < 4; ++j) { const u32x2 xw = o.xw[j], a = o.a[j], bb = o.b[j];
                const f32x4 xv = {bflo(xw.x), bfhi(xw.x), bflo(xw.y), bfhi(xw.y)};
                const f32x4 y = {bflo(a.x) + bflo(bb.x), bfhi(a.x) + bfhi(bb.x), bflo(a.y) + bflo(bb.y), bfhi(a.y) + bfhi(bb.y)};
                v[j] = xv + gv[j] * y; sq += (v[j][0] * v[j][0] + v[j][1] * v[j][1]) + (v[j][2] * v[j][2] + v[j][3] * v[j][3]); }
            const float r = rsqrtf(wave_sum_dpp(sq) * (1.0f / D) + 1e-6f);
#pragma unroll
            for (int j = 0; j < 4; ++j) { const int c0 = (lane + 64 * j) * 4; *(f32x4*)(out + row * D + c0) = v[j] * r * fg[j]; } };
        Ops oa, ob; ld(oa, 0);
#pragma unroll 1
        for (int s = 0; s < 16; s += 2) { ld(ob, s + 1); proc(oa, s); ld(oa, s + 2 < 16 ? s + 2 : 15); proc(ob, s + 1); }
    }
}
constexpr int PM_PB = 144, PM_MAT = 64 * PM_PB;
enum { PM_AT = 0, PM_RT, PM_BT, PM_KT, PM_VT, PM_BPT, PM_KPT, PM_AAK, PM_ARB, PM_ARK, PM_W1T, PM_U2T, PM_NMAT };
constexpr int PM_AAB = PM_NMAT * PM_MAT, PM_P = PM_AAB + 16384, PM_TOT = PM_P + 16384, PM_G = PM_TOT + 2048, PM_AABB = PM_G + 256, PM_XS = PM_AABB + PM_MAT, PM_END = PM_XS + 8192;
static_assert(PM_END <= LDS_BYTES, "pass-A LDS map");
#ifndef PMPROBE
#define PMPROBE -1
#endif
struct PmRaw { float zr[9], zk[9], zv[9], lw[8], as[8], par[6]; unsigned long long tacc, tlast; };
#define PMT(k) do { if (PMPROBE >= 0) { const unsigned long long n_ = __builtin_amdgcn_s_memrealtime(); if ((k) == PMPROBE) R.tacc += n_ - R.tlast; R.tlast = n_; } } while (0)
__device__ __forceinline__ void p5m_load(PRef p, PmRaw& R, int q, int wave, int lane) {
    const int seq = q / NCH, c = q % NCH, b = seq >> 3, h = seq & 7, tg = b * SEQ + c * SCL + wave * 8, hc = h * 64 + lane;
    const bf16* Z = (const bf16*)(p.ws + W_Z); const bf16* LO = (const bf16*)(p.ws + W_LO);
    const float pm = (wave == 0 && c == 0) ? 0.f : 1.f;
    const bf16* zp0 = Z + (size_t)(tg - (pm != 0.f ? 1 : 0)) * ZLD + 1024 + hc;
    R.zr[0] = bf2f(zp0[0]) * pm; R.zk[0] = bf2f(zp0[512]) * pm; R.zv[0] = bf2f(zp0[1024]) * pm;
#pragma unroll
    for (int s = 0; s < 8; ++s) { const bf16* zp = Z + (size_t)(tg + s) * ZLD + 1024 + hc; const bf16* lp = LO + (size_t)(tg + s) * 1536 + hc;
        R.zr[s + 1] = bf2f(zp[0]); R.zk[s + 1] = bf2f(zp[512]); R.zv[s + 1] = bf2f(zp[1024]); R.lw[s] = bf2f(lp[0]); R.as[s] = bf2f(lp[512]); }
    R.par[0] = p.in[I_MU][hc]; R.par[1] = p.in[I_MU][512 + hc]; R.par[2] = p.in[I_MU][1024 + hc]; R.par[3] = p.in[I_KK][hc]; R.par[4] = p.in[I_KA][hc]; R.par[5] = p.in[I_RK][hc];
}
template <bool ISW1>
__device__ __forceinline__ void p5m_solve(LAS unsigned char* lds, int wave, int lane) {
    typedef short bf16x8 __attribute__((ext_vector_type(8)));
    const int fr = lane & 15, fq = lane >> 4;
#define PMAT(i) (lds + (i) * PM_MAT)
#define PFRAG(mat, row, ks) (*(const LAS bf16x8*)((mat) + (row) * PM_PB + ((ks) * 32 + fq * 8) * 2))

        const int colb = (wave & 3) * 16, cl = lane >> 2, part = lane & 3, col = colb + cl;
        if constexpr (!ISW1) {
            const bf16x8 vb0 = PFRAG(PMAT(PM_VT), colb + fr, 0), vb1 = PFRAG(PMAT(PM_VT), colb + fr, 1);
#pragma unroll
            for (int tt = 0; tt < 4; ++tt) { f32x4 acc = {0.f, 0.f, 0.f, 0.f};
                acc = __builtin_amdgcn_mfma_f32_16x16x32_bf16(PFRAG(PMAT(PM_AAK), tt * 16 + fr, 0), vb0, acc, 0, 0, 0);
                acc = __builtin_amdgcn_mfma_f32_16x16x32_bf16(PFRAG(PMAT(PM_AAK), tt * 16 + fr, 1), vb1, acc, 0, 0, 0);
#pragma unroll
                for (int rg = 0; rg < 4; ++rg) *(LAS float*)(lds + PM_P + ((tt * 16 + 4 * fq + rg) * 64 + colb + fr) * 4) = acc[rg]; }
            asm volatile("s_waitcnt lgkmcnt(0)" ::: "memory");
        }
        LAS unsigned char* XT = PMAT(ISW1 ? PM_W1T : PM_U2T);
        { const u32x4 z = {0u, 0u, 0u, 0u}; LAS unsigned char* zp = XT + (colb + (lane >> 2)) * PM_PB + (lane & 3) * 32; *(LAS u32x4*)zp = z; *(LAS u32x4*)(zp + 16) = z; }
        LAS float* xs = (LAS float*)(lds + PM_XS + wave * 1024);
        const LAS unsigned char* arow = lds + PM_AAB + part * 64;
#pragma unroll
        for (int I = 0; I < 4; ++I) {
            f32x4 a4[16]; float rhv[16], cf[4][6]; bf16x8 af0, af1;
#pragma unroll
            for (int tl = 0; tl < 16; ++tl) { const int t = 16 * I + tl;
                if ((tl >> 2) > 0) a4[tl] = *(const LAS f32x4*)(arow + t * 256 + I * 16);
                rhv[tl] = ISW1 ? bf2f(*(const LAS bf16*)(PMAT(PM_AT) + t * PM_PB + col * 2)) : *(const LAS float*)(lds + PM_P + (t * 64 + col) * 4); }
#pragma unroll
            for (int gp = 0; gp < 4; ++gp) { const int tq = 16 * I + 4 * gp; const LAS unsigned char* cb = lds + PM_AAB + (4 * I + gp) * 4;
                cf[gp][0] = *(const LAS float*)(cb + (tq + 1) * 256); cf[gp][1] = *(const LAS float*)(cb + (tq + 2) * 256); cf[gp][2] = *(const LAS float*)(cb + (tq + 2) * 256 + 64);
                cf[gp][3] = *(const LAS float*)(cb + (tq + 3) * 256); cf[gp][4] = *(const LAS float*)(cb + (tq + 3) * 256 + 64); cf[gp][5] = *(const LAS float*)(cb + (tq + 3) * 256 + 128); }
            if (I > 0) { af0 = *(const LAS bf16x8*)(lds + PM_AABB + (16 * I + fr) * PM_PB + (fq * 8) * 2); if (I == 3) af1 = *(const LAS bf16x8*)(lds + PM_AABB + (16 * I + fr) * PM_PB + (32 + fq * 8) * 2); }
            f32x4 cr[4];
#pragma unroll
            for (int gp = 0; gp < 4; ++gp) cr[gp] = (f32x4){0.f, 0.f, 0.f, 0.f};
            if (I > 0) {
                f32x4 acc = {0.f, 0.f, 0.f, 0.f};
                acc = __builtin_amdgcn_mfma_f32_16x16x32_bf16(af0, *(const LAS bf16x8*)(XT + (colb + fr) * PM_PB + (fq * 8) * 2), acc, 0, 0, 0);
                if (I == 3) acc = __builtin_amdgcn_mfma_f32_16x16x32_bf16(af1, *(const LAS bf16x8*)(XT + (colb + fr) * PM_PB + (32 + fq * 8) * 2), acc, 0, 0, 0);
                *(LAS f32x4*)(xs + fr * 16 + 4 * fq) = acc;
                asm volatile("s_waitcnt lgkmcnt(0)" ::: "memory");
#pragma unroll
                for (int gp = 0; gp < 4; ++gp) cr[gp] = *(const LAS f32x4*)(xs + cl * 16 + 4 * gp);
            }
            float Xq[4];
#pragma unroll
            for (int gp = 0; gp < 4; ++gp) {
                const int tq = 16 * I + 4 * gp;
                float sm[4];
#pragma unroll
                for (int r = 0; r < 4; ++r) { float s = 0.f;
#pragma unroll
                    for (int i = 0; i < 4; ++i) if (i < gp) s = fmaf(a4[4 * gp + r][i], Xq[i], s);
                    sm[r] = s; }
                if (gp > 0) {
#pragma unroll
                    for (int r = 0; r < 4; ++r) { DPP_ADD(sm[r], 0xB1); DPP_ADD(sm[r], 0x4E); } }
                const float x0 = rhv[4 * gp] + cr[gp][0] + sm[0];
                const float x1 = fmaf(cf[gp][0], x0, rhv[4 * gp + 1] + cr[gp][1] + sm[1]);
                const float x2 = fmaf(cf[gp][2], x1, fmaf(cf[gp][1], x0, rhv[4 * gp + 2] + cr[gp][2] + sm[2]));
                const float x3 = fmaf(cf[gp][5], x2, fmaf(cf[gp][4], x1, fmaf(cf[gp][3], x0, rhv[4 * gp + 3] + cr[gp][3] + sm[3])));
                { float y0 = x0, y1 = x1, y2 = x2, y3 = x3;
                  asm volatile("" : "+v"(y0), "+v"(y1), "+v"(y2), "+v"(y3));
                  const float lo_ = (part & 1) ? y1 : y0, hi_ = (part & 1) ? y3 : y2;
                  Xq[gp] = (part & 2) ? hi_ : lo_; }
                *(LAS bf16*)(XT + col * PM_PB + (tq + part) * 2) = (bf16)(pg8::cvt_pk_bf16(Xq[gp], 0.f) & 0xffffu);
            }
        }

#undef PMAT
#undef PFRAG
}
#define PM_BAR() do { asm volatile("s_waitcnt lgkmcnt(0)" ::: "memory"); __builtin_amdgcn_s_barrier(); asm volatile("" ::: "memory"); } while (0)
__device__ __forceinline__ void p5m_chunk(PRef p, LAS unsigned char* lds, int q, int qnext, PmRaw& R) {
    typedef short bf16x8 __attribute__((ext_vector_type(8)));
    const int tid = otid(), lane = tid & 63, wave = __builtin_amdgcn_readfirstlane(tid >> 6), fr = lane & 15, fq = lane >> 4;
    const int seq = q / NCH, c = q % NCH, b = seq >> 3, h = seq & 7, tb = b * SEQ + c * SCL, hc = h * 64 + lane;
#define PMAT(i) (lds + (i) * PM_MAT)
#define PFRAG(mat, row, ks) (*(const LAS bf16x8*)((mat) + (row) * PM_PB + ((ks) * 32 + fq * 8) * 2))
    if (PMPROBE >= 0) R.tlast = __builtin_amdgcn_s_memrealtime();
#ifndef PM_DUP
#define PM_DUP 0
#endif
#pragma unroll 1
    for (int d0 = 0; d0 < ((PM_DUP >> 3) & 1) + 1; ++d0) { if (d0) PM_BAR();
        const int t8 = wave * 8, tg = tb + t8;
        float (&zr)[9] = R.zr; float (&zk)[9] = R.zk; float (&zv)[9] = R.zv; float (&lw)[8] = R.lw; float (&as)[8] = R.as;
        float cl[8]; { float run = 0.f;
#pragma unroll
          for (int s = 0; s < 8; ++s) { run += lw[s]; cl[s] = run; } }
        *(LAS float*)(lds + PM_TOT + (wave * 64 + lane) * 4) = cl[7];
        PM_BAR();
        float off = 0.f, lcL = 0.f;
#pragma unroll
        for (int w = 0; w < 8; ++w) { const float tv = *(const LAS float*)(lds + PM_TOT + (w * 64 + lane) * 4); lcL += tv; off += (w < wave) ? tv : 0.f; }
        if (wave == 0) *(LAS float*)(lds + PM_G + lane * 4) = __builtin_amdgcn_exp2f(1.4426950409f * lcL);
        const float mur = R.par[0], muk = R.par[1], muv = R.par[2], kkc = R.par[3], kac = R.par[4], rkc = R.par[5];
        bf16* VLo = (bf16*)(p.ws + W_YCAT); float* RKo = (float*)(p.ws + T_RK);
        unsigned pv[4], pbp[4], pkp[4]; float rkv = 0.f;
#pragma unroll
        for (int s = 0; s < 8; ++s) {
            const float r = zr[s + 1] + (zr[s] - zr[s + 1]) * mur, k = zk[s + 1] + (zk[s] - zk[s + 1]) * muk, v = zv[s + 1] + (zv[s] - zv[s + 1]) * muv;
            const float kkv = k * kkc;
            const float kk = kkv * rsqrtf(fmaxf(wave_sum_dpp(kkv * kkv), 1e-24f));
            const float k2 = k * (1.0f + (as[s] - 1.0f) * kac);
            const float rk = wave_sum_dpp(r * k2 * rkc);
            const float bb = kk * as[s];
            const float lc = off + cl[s], lcp = lc - lw[s];
            const float e_lc = __builtin_amdgcn_exp2f(1.4426950409f * lc), e_lcp = __builtin_amdgcn_exp2f(1.4426950409f * lcp);
            const float e_nlc = __builtin_amdgcn_exp2f(-1.4426950409f * lc), e_l = __builtin_amdgcn_exp2f(1.4426950409f * (lcL - lc));
            const int t = t8 + s;
            { const unsigned w0 = pg8::cvt_pk_bf16(-kk * e_lcp, r * e_lc), w1 = pg8::cvt_pk_bf16(bb * e_nlc, k2 * e_nlc);
              *(LAS bf16*)(PMAT(PM_AT) + t * PM_PB + lane * 2) = (bf16)(w0 & 0xffffu); *(LAS bf16*)(PMAT(PM_RT) + t * PM_PB + lane * 2) = (bf16)(w0 >> 16);
              *(LAS bf16*)(PMAT(PM_BT) + t * PM_PB + lane * 2) = (bf16)(w1 & 0xffffu); *(LAS bf16*)(PMAT(PM_KT) + t * PM_PB + lane * 2) = (bf16)(w1 >> 16); }
            const unsigned w2 = pg8::cvt_pk_bf16(v, bb * e_l);
            const unsigned vb = w2 & 0xffffu, bpb = w2 >> 16, kpb = pg8::cvt_pk_bf16(k2 * e_l, 0.f) & 0xffffu;
            if (s & 1) { pv[s >> 1] |= vb << 16; pbp[s >> 1] |= bpb << 16; pkp[s >> 1] |= kpb << 16; } else { pv[s >> 1] = vb; pbp[s >> 1] = bpb; pkp[s >> 1] = kpb; }
            VLo[(unsigned)((tg + s) * 1024 + 512 + hc)] = (bf16)vb;
            rkv = (lane == s) ? rk : rkv;
        }
        if (lane < 8) RKo[(unsigned)((tg + lane) * 8 + h)] = rkv;
        *(LAS u32x4*)(PMAT(PM_VT) + lane * PM_PB + wave * 16) = (u32x4){pv[0], pv[1], pv[2], pv[3]};
        *(LAS u32x4*)(PMAT(PM_BPT) + lane * PM_PB + wave * 16) = (u32x4){pbp[0], pbp[1], pbp[2], pbp[3]};
        *(LAS u32x4*)(PMAT(PM_KPT) + lane * PM_PB + wave * 16) = (u32x4){pkp[0], pkp[1], pkp[2], pkp[3]};
    }
    if (qnext >= 0) p5m_load(p, R, qnext, wave, lane);
    PM_BAR(); PMT(0);
#pragma unroll 1
    for (int d1 = 0; d1 < ((PM_DUP >> 0) & 1) + 1; ++d1) {
        const int pp = wave >> 1, half = wave & 1;
        const LAS unsigned char* Xm = PMAT(pp < 2 ? PM_AT : PM_RT);
        const LAS unsigned char* Ym = PMAT((pp & 1) ? PM_KT : PM_BT);
#pragma unroll
        for (int ti = 0; ti < 2; ++ti) {
            const int tt = half ? (1 + ti) : (3 * ti);
            const bf16x8 xb0 = PFRAG(Xm, tt * 16 + fr, 0), xb1 = PFRAG(Xm, tt * 16 + fr, 1);
            const int t = tt * 16 + fr;
#pragma unroll
            for (int jt = 0; jt < 4; ++jt) {
                f32x4 acc = {0.f, 0.f, 0.f, 0.f};
                if (jt <= tt) { acc = __builtin_amdgcn_mfma_f32_16x16x32_bf16(PFRAG(Ym, jt * 16 + fr, 0), xb0, acc, 0, 0, 0);
                                acc = __builtin_amdgcn_mfma_f32_16x16x32_bf16(PFRAG(Ym, jt * 16 + fr, 1), xb1, acc, 0, 0, 0); }
                const int j0 = jt * 16 + 4 * fq;
#pragma unroll
                for (int rg = 0; rg < 4; ++rg) { const bool keep = (pp < 2) ? (j0 + rg < t) : (j0 + rg <= t); acc[rg] = keep ? acc[rg] : 0.f; }
                if (pp == 0) {
#pragma unroll
                    for (int rg = 0; rg < 4; ++rg) *(LAS float*)(lds + PM_AAB + (t * 64 + rg * 16 + jt * 4 + fq) * 4) = acc[rg];
                    { u32x2 w; w.x = pk2(acc[0], acc[1]); w.y = pk2(acc[2], acc[3]); *(LAS u32x2*)(lds + PM_AABB + t * PM_PB + j0 * 2) = w; }
                } else {
                    u32x2 w; w.x = pk2(acc[0], acc[1]); w.y = pk2(acc[2], acc[3]);
                    *(LAS u32x2*)(PMAT(PM_AAK + pp - 1) + t * PM_PB + j0 * 2) = w;
                }
            }
        }
    }
    PM_BAR(); PMT(1);
#pragma unroll 1
    for (int d2 = 0; d2 < ((PM_DUP >> 1) & 1) + 1; ++d2) {
        if (wave < 4) p5m_solve<true>(lds, wave, lane); else p5m_solve<false>(lds, wave, lane);
    }
    PM_BAR(); PMT(2);
#pragma unroll 1
    for (int d3 = 0; d3 < ((PM_DUP >> 2) & 1) + 1; ++d3) {
        float* Mo = (float*)((unsigned char*)p.out + O_M + (size_t)q * 16384); float* No = (float*)((unsigned char*)p.out + O_N + (size_t)q * 16384);
        bf16* Qo = (bf16*)(p.ws + W_Q); bf16* Y2o = (bf16*)(p.ws + W_Y2);
#pragma unroll
        for (int ti = 0; ti < 2; ++ti) {
            const int idx = wave * 2 + ti, rt = idx >> 2, ct = idx & 3;
            {
                f32x4 acc = {0.f, 0.f, 0.f, 0.f};
#pragma unroll
                for (int ks = 0; ks < 2; ++ks) acc = __builtin_amdgcn_mfma_f32_16x16x32_bf16(PFRAG(PMAT(PM_BPT), ct * 16 + fr, ks), PFRAG(PMAT(PM_W1T), rt * 16 + fr, ks), acc, 0, 0, 0);
                const int i = rt * 16 + fr, c0 = ct * 16 + 4 * fq;
#pragma unroll
                for (int rg = 0; rg < 4; ++rg) if (c0 + rg == i) acc[rg] += *(const LAS float*)(lds + PM_G + i * 4);
                *(f32x4*)(Mo + i * 64 + c0) = acc; }
            {
                f32x4 acc = {0.f, 0.f, 0.f, 0.f};
#pragma unroll
                for (int ks = 0; ks < 2; ++ks) { acc = __builtin_amdgcn_mfma_f32_16x16x32_bf16(PFRAG(PMAT(PM_BPT), ct * 16 + fr, ks), PFRAG(PMAT(PM_U2T), rt * 16 + fr, ks), acc, 0, 0, 0);
                                                  acc = __builtin_amdgcn_mfma_f32_16x16x32_bf16(PFRAG(PMAT(PM_KPT), ct * 16 + fr, ks), PFRAG(PMAT(PM_VT), rt * 16 + fr, ks), acc, 0, 0, 0); }
                *(f32x4*)(No + (rt * 16 + fr) * 64 + ct * 16 + 4 * fq) = acc; }
            {
                f32x4 acc = {0.f, 0.f, 0.f, 0.f};
#pragma unroll
                for (int ks = 0; ks < 2; ++ks) acc = __builtin_amdgcn_mfma_f32_16x16x32_bf16(PFRAG(PMAT(PM_W1T), ct * 16 + fr, ks), PFRAG(PMAT(PM_ARB), rt * 16 + fr, ks), acc, 0, 0, 0);
                const int t = rt * 16 + fr, i0 = ct * 16 + 4 * fq;
                const u32x2 rw = *(const LAS u32x2*)(PMAT(PM_RT) + t * PM_PB + i0 * 2);
                u32x2 o; o.x = pk2(acc[0] + bflo(rw.x), acc[1] + bfhi(rw.x)); o.y = pk2(acc[2] + bflo(rw.y), acc[3] + bfhi(rw.y));
                *(u32x2*)(Qo + (unsigned)((tb + t) * 512 + h * 64 + i0)) = o; }
            {
                f32x4 acc = {0.f, 0.f, 0.f, 0.f};
#pragma unroll
                for (int ks = 0; ks < 2; ++ks) { acc = __builtin_amdgcn_mfma_f32_16x16x32_bf16(PFRAG(PMAT(PM_U2T), ct * 16 + fr, ks), PFRAG(PMAT(PM_ARB), rt * 16 + fr, ks), acc, 0, 0, 0);
                                                  acc = __builtin_amdgcn_mfma_f32_16x16x32_bf16(PFRAG(PMAT(PM_VT), ct * 16 + fr, ks), PFRAG(PMAT(PM_ARK), rt * 16 + fr, ks), acc, 0, 0, 0); }
                const int t = rt * 16 + fr, v0 = ct * 16 + 4 * fq;
                u32x2 o; o.x = pk2(acc[0], acc[1]); o.y = pk2(acc[2], acc[3]);
                *(u32x2*)(Y2o + (unsigned)((tb + t) * 512 + h * 64 + v0)) = o; }
        }
    }
    PM_BAR(); PMT(3);
#undef PMAT
#undef PFRAG
}

__device__ __forceinline__ void p5m_run(PRef p, LAS unsigned char* lds, int bid, int nb) {
    const int tid = otid(), lane = tid & 63, wave = __builtin_amdgcn_readfirstlane(tid >> 6);
    PmRaw R; R.tacc = 0; R.tlast = 0;
    if (bid < BATCH * 8 * NCH) p5m_load(p, R, bid, wave, lane);
#pragma unroll 1
    for (int q = bid; q < BATCH * 8 * NCH; q += nb) p5m_chunk(p, lds, q, (q + nb < BATCH * 8 * NCH) ? q + nb : -1, R);
    if (PMPROBE >= 0 && bid == 0 && tid == 0) { const unsigned long long t0_ = __builtin_amdgcn_s_memrealtime(), w_ = R.tacc * 4ull; while (__builtin_amdgcn_s_memrealtime() - t0_ < w_) __builtin_amdgcn_s_sleep(8); }
}
constexpr int R7_WP = 1040, R7_WSZ = 48 * R7_WP, R7_AP = 144, R7_ASZ = 16 * R7_AP;
constexpr int R7_WAVE0 = 2 * R7_WSZ, R7_WAVESZ = 2 * R7_ASZ + 3072, R7_HIST = R7_WAVE0 + 8 * R7_WAVESZ;
static_assert(R7_HIST + 256 <= LDS_BYTES, "router LDS map");
struct R7Ops { u32x4 xa, xb; f32x4 av[4], sv[4]; };
__device__ __forceinline__ void r7_load(R7Ops& o, const bf16* xrow, const float* ra, const float* sh, int k0) {
    o.xa = *(const u32x4*)(xrow + k0); o.xb = *(const u32x4*)(xrow + k0 + 8);
#pragma unroll
    for (int i = 0; i < 4; ++i) { o.av[i] = *(const f32x4*)(ra + k0 + i * 4); o.sv[i] = *(const f32x4*)(sh + k0 + i * 4); }
}
__device__ __forceinline__ void p7m_route(PRef p, LAS unsigned char* lds, int bid) {
    typedef short bf16x8 __attribute__((ext_vector_type(8)));
    const int tid = otid(), lane = tid & 63, wave = __builtin_amdgcn_readfirstlane(tid >> 6), fr = lane & 15, fq = lane >> 4;
    const int tok = lane >> 2, sub = lane & 3;
    const bf16* x1 = (const bf16*)(p.ws + W_X1B); bf16* H2 = (bf16*)(p.ws + W_H2);
    LAS int* hist = (LAS int*)(lds + R7_HIST);
    const int b = (bid * TPW) / SEQ, t0 = bid * TPW + wave * 16;
    const float* sh = (const float*)(p.ws + W_MOD) + b * 6 * D + 3 * D + sub * 16;
    const float* ra = (const float*)(p.ws + W_RA) + b * D + sub * 16;
    LAS unsigned char* Ahi = lds + R7_WAVE0 + wave * R7_WAVESZ; LAS unsigned char* Alo = Ahi + R7_ASZ; LAS float* Lw = (LAS float*)(Alo + R7_ASZ);
    if (tid < 32) hist[tid] = 0;
    constexpr int WCH = 2 * R7_WSZ / 16, WTR = (WCH + NTHR - 1) / NTHR;
    u32x4 wreg[WTR];
    { const u32x4* gi = (const u32x4*)(p.ws + W_RW);
#pragma unroll
      for (int i = 0; i < WTR; ++i) { const int c = tid + i * NTHR; wreg[i] = gi[c < WCH ? c : WCH - 1]; } }
    const bf16* xrow = x1 + (size_t)(t0 + tok) * D + sub * 16;
    float ss = 0.f;
    { u32x4 v[32];
#pragma unroll
      for (int s = 0; s < 16; ++s) { v[s * 2] = *(const u32x4*)(xrow + s * 64); v[s * 2 + 1] = *(const u32x4*)(xrow + s * 64 + 8); }
#pragma unroll
      for (int i = 0; i < 32; ++i)
#pragma unroll
          for (int q = 0; q < 4; ++q) { const float a = bflo(v[i][q]), bq = bfhi(v[i][q]); ss = fmaf(a, a, fmaf(bq, bq, ss)); } }
    DPP_ADD(ss, 0xB1); DPP_ADD(ss, 0x4E);
    const float r = rsqrtf(ss * (1.0f / D) + 1e-6f);
    f32x4 acc[3];
    { const float b0 = fr < 4 ? p.in[I_RGB][fr & 3] : p.in[I_REB][fr >= 4 ? fr - 4 : 0], b1 = p.in[I_REB][12 + fr], b2 = fr < 4 ? p.in[I_REB][28 + (fr & 3)] : 0.f;
      acc[0] = (f32x4){b0, b0, b0, b0}; acc[1] = (f32x4){b1, b1, b1, b1}; acc[2] = (f32x4){b2, b2, b2, b2}; }
    R7Ops oa, ob; r7_load(oa, xrow, ra, sh, 0);
    bf16* hrow0 = H2 + (size_t)(t0 + tok) * D + sub * 16;
    auto slice = [&](const R7Ops& cur, int gs) __attribute__((always_inline)) {
        const int k0 = gs * 64, sl = gs & 7;
        f32x4 xv[4];
        { const u32x4 xa = cur.xa, xb = cur.xb;
          xv[0] = (f32x4){bflo(xa.x), bfhi(xa.x), bflo(xa.y), bfhi(xa.y)}; xv[1] = (f32x4){bflo(xa.z), bfhi(xa.z), bflo(xa.w), bfhi(xa.w)};
          xv[2] = (f32x4){bflo(xb.x), bfhi(xb.x), bflo(xb.y), bfhi(xb.y)}; xv[3] = (f32x4){bflo(xb.z), bfhi(xb.z), bflo(xb.w), bfhi(xb.w)}; }
        unsigned hi[8], lo[8];
#pragma unroll
        for (int i = 0; i < 4; ++i)
#pragma unroll
            for (int j = 0; j < 4; j += 2) { const float h0 = xv[i][j] * r * cur.av[i][j] + cur.sv[i][j], h1 = xv[i][j + 1] * r * cur.av[i][j + 1] + cur.sv[i][j + 1];
                const unsigned a0 = f2bf(h0), a1 = f2bf(h1); hi[i * 2 + (j >> 1)] = a0 | (a1 << 16); lo[i * 2 + (j >> 1)] = f2bf(h0 - bflo(a0)) | (f2bf(h1 - bflo(a1)) << 16); }
        bf16* hrow = hrow0 + k0;
        *(u32x4*)hrow = (u32x4){hi[0], hi[1], hi[2], hi[3]}; *(u32x4*)(hrow + 8) = (u32x4){hi[4], hi[5], hi[6], hi[7]};
        *(LAS u32x4*)(Ahi + tok * R7_AP + sub * 32) = (u32x4){hi[0], hi[1], hi[2], hi[3]}; *(LAS u32x4*)(Ahi + tok * R7_AP + sub * 32 + 16) = (u32x4){hi[4], hi[5], hi[6], hi[7]};
        *(LAS u32x4*)(Alo + tok * R7_AP + sub * 32) = (u32x4){lo[0], lo[1], lo[2], lo[3]}; *(LAS u32x4*)(Alo + tok * R7_AP + sub * 32 + 16) = (u32x4){lo[4], lo[5], lo[6], lo[7]};
        asm volatile("s_waitcnt lgkmcnt(0)" ::: "memory");
#pragma unroll
        for (int ks = 0; ks < 2; ++ks) {
            const bf16x8 ah = *(const LAS bf16x8*)(Ahi + fr * R7_AP + (ks * 32 + fq * 8) * 2), al = *(const LAS bf16x8*)(Alo + fr * R7_AP + (ks * 32 + fq * 8) * 2);
#pragma unroll
            for (int qt = 0; qt < 3; ++qt) { const int wo = (qt * 16 + fr) * R7_WP + (sl * 64 + ks * 32 + fq * 8) * 2;
                const bf16x8 bh = *(const LAS bf16x8*)(lds + wo), bl = *(const LAS bf16x8*)(lds + R7_WSZ + wo);
                acc[qt] = __builtin_amdgcn_mfma_f32_16x16x32_bf16(ah, bh, acc[qt], 0, 0, 0);
                acc[qt] = __builtin_amdgcn_mfma_f32_16x16x32_bf16(al, bh, acc[qt], 0, 0, 0);
                acc[qt] = __builtin_amdgcn_mfma_f32_16x16x32_bf16(ah, bl, acc[qt], 0, 0, 0); } }
        asm volatile("s_waitcnt lgkmcnt(0)" ::: "memory");
    };
#pragma unroll 1
    for (int kh = 0; kh < 2; ++kh) {
        __syncthreads();
#pragma unroll
        for (int i = 0; i < WTR; ++i) { const int c = tid + i * NTHR; if (c < WCH) *(LAS u32x4*)(lds + c * 16) = wreg[i]; }
        if (kh == 0) {
            const u32x4* gi = (const u32x4*)(p.ws + W_RW) + WCH;
#pragma unroll
            for (int i = 0; i < WTR; ++i) { const int c = tid + i * NTHR; wreg[i] = gi[c < WCH ? c : WCH - 1]; } }
        __syncthreads();
#pragma unroll 1
        for (int sl = 0; sl < 8; sl += 2) {
            const int gs = kh * 8 + sl;
            r7_load(ob, xrow, ra, sh, (gs + 1) * 64);
            slice(oa, gs);
            r7_load(oa, xrow, ra, sh, (gs + 2 < 16 ? gs + 2 : 15) * 64);
            slice(ob, gs + 1);
        }
    }
#pragma unroll
    for (int qt = 0; qt < 3; ++qt)
#pragma unroll
        for (int rg = 0; rg < 4; ++rg) Lw[(4 * fq + rg) * 48 + qt * 16 + fr] = acc[qt][rg];
    asm volatile("s_waitcnt lgkmcnt(0)" ::: "memory");
    if (lane < 16) {
        const LAS float* lg = Lw + lane * 48;
        int gi = 0; float gm = lg[0];
#pragma unroll
        for (int q = 1; q < 4; ++q) { const float v = lg[q]; if (v > gm) { gm = v; gi = q; } }
        float gsum = 0.f;
#pragma unroll
        for (int q = 0; q < 4; ++q) gsum += expf(lg[q] - gm);
        const float gp = 1.0f / gsum;
        const LAS float* el = lg + 4 + gi * 8;
        int i0 = 0; float m0 = el[0];
#pragma unroll
        for (int q = 1; q < 8; ++q) { const float v = el[q]; if (v > m0) { m0 = v; i0 = q; } }
        int i1 = -1; float m1 = -3.0e38f;
#pragma unroll
        for (int q = 0; q < 8; ++q) { const float v = el[q]; if (q != i0 && v > m1) { m1 = v; i1 = q; } }
        const float p1 = expf(m1 - m0);
        const float w0 = gp / (1.0f + p1), w1 = gp * p1 / (1.0f + p1);
        const int t = t0 + lane, e0 = gi * 8 + i0, e1 = gi * 8 + i1;
        int* toke = (int*)(p.ws + T_TOKE); float* tokw = (float*)(p.ws + T_TOKW);
        toke[t * 2] = e0; toke[t * 2 + 1] = e1; tokw[t * 2] = w0; tokw[t * 2 + 1] = w1;
        __hip_atomic_fetch_add(&hist[e0], 1, __ATOMIC_RELAXED, __HIP_MEMORY_SCOPE_WORKGROUP); __hip_atomic_fetch_add(&hist[e1], 1, __ATOMIC_RELAXED, __HIP_MEMORY_SCOPE_WORKGROUP);
    }
    __syncthreads();
    if (tid < 32) ((int*)(p.ws + T_HIST))[bid * 32 + tid] = hist[tid];
    __syncthreads();
}
constexpr int PB_PITCH = 68;
constexpr int PB_ML = 0, PB_SL = 64 * PB_PITCH * 4, PB_NL = PB_SL + 16 * PB_PITCH * 4, PB_IMG = PB_NL + 16 * PB_PITCH * 4;
__device__ __forceinline__ void p5b_chain_mfma(PRef p, LAS unsigned char* lds, int item) {
    const int tid = otid(), lane = tid & 63, wave = __builtin_amdgcn_readfirstlane(tid >> 6), fr = lane & 15, fq = lane >> 4;
    const int seq = (item & 7) + 8 * (item >> 5), rg = (item >> 3) & 3;
    const bool mm = wave < 4; const int ct = wave & 3, t2 = tid & 255, nrow = t2 >> 4, ncol = (t2 & 15) * 4;
    const unsigned char* Mb = (const unsigned char*)p.out + O_M + (size_t)seq * NCH * 16384;
    const unsigned char* Nb = (const unsigned char*)p.out + O_N + (size_t)seq * NCH * 16384 + (size_t)((rg * 16 + nrow) * 64 + ncol) * 4;
    unsigned char* Sb = p.ws + W_S + (size_t)seq * NCH * 8192 + (size_t)((rg * 16 + nrow) * 64 + ncol) * 2;
    const int mrow = tid >> 4, mcol = (tid & 15) * 4;
    f32x4 acc = {0.f, 0.f, 0.f, 0.f};
    float tv[32]; TrItem citem = TrItem{nullptr, nullptr, 0, 0, 0, 0}, bitem = citem;
    LAS float* cscr = (LAS float*)(lds + 2 * PB_IMG + (wave & 3) * 8704);
    const int gcw = item * 4 + (wave & 3);
#define PBM_CONV(cc) do { if (!mm) { const int ph_ = (cc) & 7, i3_ = ((cc) >> 3) * 3; \
          \
        if (ph_ == 2 || ph_ == 4 || ph_ == 6) { p0_tr_store_half(citem, tv, cscr, lane, 0); bitem = citem; } \
        if (ph_ == 3 || ph_ == 5 || ph_ == 7) p0_tr_store_half(bitem, tv, cscr, lane, 1); \
        if (ph_ == 0 || ph_ == 2 || ph_ == 4) { citem = moe_item(p, gcw + (i3_ + (ph_ >> 1)) * (MOE_ITEMS / 24)); p0_tr_load(citem, tv, lane); } } } while (0)
    f32x4 m0[2], m1[2], m2[2], m3[2], n0, n1, n2, n3;
#define PBM_LOAD(mmr, nn, cc) do { const f32x4* mp = (const f32x4*)(Mb + (size_t)(cc) * 16384) + tid; mmr[0] = mp[0]; mmr[1] = mp[512]; if (!mm) nn = *(const f32x4*)(Nb + (size_t)(cc) * 16384); } while (0)
#define PBM_STEP(mmr, nn, cc) do { \
        LAS unsigned char* img = lds + ((cc) & 1) * PB_IMG; \
        *(LAS f32x4*)(img + PB_ML + (mrow * PB_PITCH + mcol) * 4) = mmr[0]; *(LAS f32x4*)(img + PB_ML + ((mrow + 32) * PB_PITCH + mcol) * 4) = mmr[1]; \
        if (mm) { _Pragma("unroll") for (int rg_ = 0; rg_ < 4; ++rg_) *(LAS float*)(img + PB_SL + ((4 * fq + rg_) * PB_PITCH + ct * 16 + fr) * 4) = acc[rg_]; } \
        else *(LAS f32x4*)(img + PB_NL + (nrow * PB_PITCH + ncol) * 4) = nn; \
        asm volatile("s_waitcnt lgkmcnt(0)" ::: "memory"); __builtin_amdgcn_s_barrier(); asm volatile("" ::: "memory"); \
        if ((cc) + 4 < NCH) PBM_LOAD(mmr, nn, (cc) + 4); \
        if (mm) { \
            _Pragma("unroll") for (int rg_ = 0; rg_ < 4; ++rg_) acc[rg_] = *(const LAS float*)(img + PB_NL + ((4 * fq + rg_) * PB_PITCH + ct * 16 + fr) * 4); \
            _Pragma("unroll") for (int ks = 0; ks < 16; ++ks) { \
                const float a_ = *(const LAS float*)(img + PB_SL + (fr * PB_PITCH + ks * 4 + fq) * 4), b_ = *(const LAS float*)(img + PB_ML + ((ks * 4 + fq) * PB_PITCH + ct * 16 + fr) * 4); \
                acc = __builtin_amdgcn_mfma_f32_16x16x4f32(a_, b_, acc, 0, 0, 0); } \
        } else { const f32x4 sv = *(const LAS f32x4*)(img + PB_SL + (nrow * PB_PITCH + ncol) * 4); u32x2 sw_; sw_.x = pg8::cvt_pk_bf16(sv[0], sv[1]); sw_.y = pg8::cvt_pk_bf16(sv[2], sv[3]); *(u32x2*)(Sb + (size_t)(cc) * 8192) = sw_; } \
        PBM_CONV(cc); \
    } while (0)
    __syncthreads();
    PBM_LOAD(m0, n0, 0); PBM_LOAD(m1, n1, 1); PBM_LOAD(m2, n2, 2); PBM_LOAD(m3, n3, 3);
#pragma unroll 1
    for (int c = 0; c < NCH; c += 4) { PBM_STEP(m0, n0, c); PBM_STEP(m1, n1, c + 1); PBM_STEP(m2, n2, c + 2); PBM_STEP(m3, n3, c + 3); }
    __syncthreads();
#undef PBM_LOAD
#undef PBM_STEP
#undef PBM_CONV
}
__global__ void __launch_bounds__(NTHR, 2) k_mega(Params p_unused) {
    extern __shared__ __attribute__((aligned(16))) unsigned char lds_raw[];
    PPtr kp = (PPtr)__builtin_amdgcn_kernarg_segment_ptr();
#define p (*opq(kp))
    cg::grid_group grid = cg::this_grid();
    const int bid = blockIdx.x, nb = gridDim.x;
    LAS unsigned char* lds = (LAS unsigned char*)lds_raw;
    volatile LAS unsigned* bst = (volatile LAS unsigned*)(lds + LDS_BYTES - 64);
    if (otid() < 2) bst[otid()] = 0u;
    __syncthreads();
    XcdBarrier xb = xcd_barrier_post((unsigned*)(p.ws + T_BAR), bst);
#define GSYNC() xcd_barrier(xb)
    p0_prep<false>(p, lds, bid, nb); grid.sync();
#ifdef GS2PROBE
    grid.sync(); grid.sync(); grid.sync(); grid.sync();
#endif
    p1_h1(p, bid, nb); GSYNC();
    { pg8::Gemm g{(const pg8::bf16_t*)(p.ws + W_H1), (const pg8::bf16_t*)(p.ws + W_WINT), NTOK, ZLD, D}; pg8::StaticOrder S; S.init(NTOK, ZLD, nb, bid);
      EpiZ E{(bf16*)(p.ws + W_Z)};
      pg8::gemm_phase<EpiZ, pg8::StaticOrder, true, true>(lds, g, S, E); }
    GSYNC();
#pragma unroll 1
    for (int ch = bid; ch < NTOK / CHUNK; ch += nb) p3_gmlp_unit(p, lds, ch);
    p3_lorain(p, bid, nb);
    GSYNC();
    { int kop = 256; asm volatile("" : "+s"(kop));
      pg8::Gemm g{(const pg8::bf16_t*)(p.ws + W_A2), (const pg8::bf16_t*)(p.ws + W_LORAT), NTOK, 1536, kop}; pg8::StaticOrder S; S.init(NTOK, 1536, nb, bid);
      EpiLO E{(bf16*)(p.ws + W_LO), p.in[I_W0], p.in[I_A0]};
      pg8::gemm_phase<EpiLO, pg8::StaticOrder, true, true>(lds, g, S, E); }
    GSYNC();
    p5m_run(p, lds, bid, nb);
    GSYNC();
#pragma unroll 1
    for (int it = bid; it < BATCH * 8 * 4; it += nb) p5b_chain_mfma(p, lds, it);
    GSYNC();
#pragma unroll 1
    for (int q = bid * 8 + __builtin_amdgcn_readfirstlane(otid() >> 6); q < BATCH * 8 * NCH; q += nb * 8) p5c_chunk(p, lds, q);
    GSYNC();
    { pg8::Gemm g{(const pg8::bf16_t*)(p.ws + W_YCAT), (const pg8::bf16_t*)(p.ws + W_WOUTT), NTOK, D, D}; pg8::StaticOrder S; S.init(NTOK, D, nb, bid);
      EpiX1 E{p.in[I_X], (const float*)(p.ws + W_MOD), (bf16*)(p.ws + W_X1B)};
      pg8::gemm_phase<EpiX1, pg8::StaticOrder, true, true>(lds, g, S, E); }
    GSYNC();
    p7m_route(p, lds, bid); GSYNC();
    p8_place(p, lds, bid); GSYNC();
    { const int nM = *(const int*)(p.ws + T_NT);
      pg8::Gemm g{(const pg8::bf16_t*)(p.ws + W_H2), (const pg8::bf16_t*)(p.ws + W_WGUT), PROWS, 1024, D}; MoeOrder<true> S{(const int*)(p.ws + T_TILEE), (const int*)(p.ws + T_ROWAID), nM, nb, bid};
      EpiH E{(bf16*)(p.ws + W_HB)};
      pg8::gemm_phase<EpiH, MoeOrder<true>, true, true>(lds, g, S, E); }
    GSYNC();
    { const int nM = *(const int*)(p.ws + T_NT);
      pg8::Gemm g{(const pg8::bf16_t*)(p.ws + W_HB), (const pg8::bf16_t*)(p.ws + W_WDT), PROWS, 1024, EH}; MoeOrder<false> S{(const int*)(p.ws + T_TILEE), (const int*)(p.ws + T_ROWAID), nM, nb, bid};
      EpiY E{(bf16*)p.out, (const int*)(p.ws + T_ROWAID), (const float*)(p.ws + T_ROWW)};
      pg8::gemm_phase<EpiY, MoeOrder<false>, true, true>(lds, g, S, E); }
    GSYNC();
    p11_final(p, bid, nb);
#undef GSYNC
#undef p
}
extern "C" void kernel_launch(void* const* d_in, const int* in_sizes, int n_in, void* d_out, int out_size, void* d_ws, size_t ws_size, hipStream_t stream) {
    if (n_in != 31 || ws_size < WS_NEED || out_size != NTOK * D) { fprintf(stderr, "kernel_launch: unexpected sizes n_in %d ws %zu out %d\n", n_in, ws_size, out_size); return; }
    static int grid_blocks = 0;
    if (!grid_blocks) {
        int dev = 0, cus = 0, per_cu = 0;
        (void)hipGetDevice(&dev);
        (void)hipDeviceGetAttribute(&cus, hipDeviceAttributeMultiprocessorCount, dev);
        (void)hipFuncSetAttribute((const void*)k_mega, hipFuncAttributeMaxDynamicSharedMemorySize, LDS_BYTES);
        (void)hipOccupancyMaxActiveBlocksPerMultiprocessor(&per_cu, (const void*)k_mega, NTHR, LDS_BYTES);
        if (per_cu < 1) fprintf(stderr, "kernel_launch: occupancy query says %d blocks/CU\n", per_cu);
        grid_blocks = cus;
    }
    Params p{};
    for (int i = 0; i < 31; ++i) p.in[i] = (const float*)d_in[i];
    p.out = (float*)d_out; p.ws = (unsigned char*)d_ws;
    (void)hipMemsetAsync((char*)d_ws + T_BAR, 0, 16384, stream);
    void* args[] = {&p};
    hipError_t e = hipLaunchCooperativeKernel((void*)k_mega, dim3(grid_blocks), dim3(NTHR), args, LDS_BYTES, stream);
    if (e != hipSuccess) fprintf(stderr, "cooperative launch failed: %s (grid %d)\n", hipGetErrorString(e), grid_blocks);
}
```

```cpp
#include <hip/hip_runtime.h>
#include <hip/hip_cooperative_groups.h>
#include <cstdio>
#include <cstdint>
namespace cg = cooperative_groups;
__device__ __forceinline__ int otid() { int t = threadIdx.x; asm volatile("" : "+v"(t)); return t; }

namespace pg8 {
#define PG8_LAS __attribute__((address_space(3)))
typedef unsigned short bf16_t;
typedef short bf16x8 __attribute__((ext_vector_type(8)));
typedef float f32x4 __attribute__((ext_vector_type(4)));
typedef unsigned u32x4 __attribute__((ext_vector_type(4)));
constexpr int BM = 256, BK = 64, HALF = 128, HTB = HALF * BK * 2  , STAGE_BYTES = 8 * HTB, NXCD = 8, WGM = 8;

__host__ __device__ __forceinline__ int lds_byte(int r, int c) { const int st = (r >> 4) * 2 + (c >> 5), rr = r & 15, cc = c & 31, ob = rr * 64 + cc * 2; return st * 1024 + (ob ^ (((ob >> 9) & 1) << 5)); }
__host__ __device__ __forceinline__ void stage_rc(int b, int& R, int& C) { const int st = b / 1024, sb = b % 1024, swz = sb ^ (((sb >> 9) & 1) << 5); R = (st >> 1) * 16 + swz / 64; C = (st & 1) * 32 + (swz % 64) / 2; }
__host__ __device__ __forceinline__ int perm32(int rho) { const int n = rho >> 4, i = rho & 15; return 8 * (i >> 2) + 4 * n + (i & 3); }

struct Unit { int pm, pn, pb; };
struct Gemm { const bf16_t* A; const bf16_t* Bt; int M, N, K; };

struct StaticOrder {
    static constexpr bool GATHER = false;
    int nM, nN, nwg, G, c;
    __device__ __forceinline__ int rowsrc(int) const { return 0; }
    __host__ __device__ void init(int M, int N, int G_, int c_) { nM = M / BM; nN = N / BM; nwg = nM * nN; G = G_; c = c_; }
    __host__ __device__ bool next(int i, Unit& u) const {
        const long L = (long)i * G + c; if (L >= nwg) return false;
        int wgid = (int)L; { const int q = nwg / NXCD, r = nwg % NXCD, xcd = wgid % NXCD, off = wgid / NXCD; wgid = (xcd < r ? xcd * (q + 1) : r * (q + 1) + (xcd - r) * q) + off; }
        const int nig = WGM * nN, gid = wgid / nig, fm = gid * WGM, gsz = (nM - fm) < WGM ? (nM - fm) : WGM;
        u.pm = fm + ((wgid % nig) % gsz); u.pn = (wgid % nig) / gsz; u.pb = u.pn; return true;
    }
    __device__ __forceinline__ void a_ready(const Unit&) const {}
    __device__ __forceinline__ void done(const Unit&) const {}
};

__device__ __forceinline__ unsigned cvt_pk_bf16(float lo, float hi) { unsigned r; asm volatile("v_cvt_pk_bf16_f32 %0, %1, %2" : "=v"(r) : "v"(lo), "v"(hi)); return r; }
typedef float f32x2 __attribute__((ext_vector_type(2)));
template <class Epi, class Sched, bool ALIGN_EPI = false, bool SP2 = false>
__device__ __forceinline__ void gemm_phase(PG8_LAS unsigned char* lds, const Gemm g, const Sched& S, const Epi& E) {
    const int tid = otid(), wid = __builtin_amdgcn_readfirstlane(tid >> 6), lane = tid & 63, wr = wid >> 2, wc = wid & 3, fr = lane & 15, fq = lane >> 4;
    const int K = g.K, nt = K / BK;
    unsigned voffA[2], voffB[2];
#pragma unroll
    for (int i = 0; i < 2; ++i) { int R, C; stage_rc(tid * 16 + i * 8192, R, C); const int Rb = Epi::PERM ? ((R & ~31) + perm32(R & 31)) : R;
        voffA[i] = (unsigned)(R * K + C) * 2u; voffB[i] = (unsigned)(Rb * K + C) * 2u; }
    const size_t kstep = (size_t)(BK * 2);
    const size_t hstep = (size_t)HALF * K * 2;
    const size_t tstep = 2 * hstep;
    unsigned vA0[2], vA1[2], nA0[2], nA1[2];
    PG8_LAS int* rtab = (PG8_LAS int*)(lds + STAGE_BYTES);
    auto fillA = [&](int ui_, unsigned (&o0)[2], unsigned (&o1)[2]) {
#pragma unroll
        for (int i = 0; i < 2; ++i) {
            if constexpr (Sched::GATHER) { int R, C; stage_rc(tid * 16 + i * 8192, R, C);
                o0[i] = (unsigned)(rtab[ui_ * 256 + R] * K + C) * 2u; o1[i] = (unsigned)(rtab[ui_ * 256 + 128 + R] * K + C) * 2u; }
            else { o0[i] = voffA[i]; o1[i] = voffA[i] + (unsigned)hstep; } } };
    const unsigned ldsw = (unsigned)wid * 1024u;
    const int aoff = lds_byte(wr * 64 + fr, fq * 8), boff = lds_byte(wc * 32 + fr, fq * 8);
#define PG8_SA(b, h) (((b) * 2 + (h)) * HTB)
#define PG8_SB(b, h) ((4 + (b) * 2 + (h)) * HTB)
#define PG8_STAGE(bufoff, gbase, voff) do { _Pragma("unroll") for (int _i = 0; _i < 2; ++_i) \
        __builtin_amdgcn_global_load_lds((const unsigned*)((const char*)(gbase) + (voff)[_i]), (PG8_LAS unsigned*)(lds + (bufoff) + ldsw + _i * 8192), 16, 0, 0); } while (0)
#define PG8_LDA(dst, b, h) do { _Pragma("unroll") for (int m = 0; m < 4; ++m) _Pragma("unroll") for (int k = 0; k < 2; ++k) dst[m][k] = *(const PG8_LAS bf16x8*)(lds + PG8_SA(b, h) + aoff + m * 2048 + k * 1024); } while (0)
#define PG8_LDB(dst, b, h) do { _Pragma("unroll") for (int n = 0; n < 2; ++n) _Pragma("unroll") for (int k = 0; k < 2; ++k) dst[n][k] = *(const PG8_LAS bf16x8*)(lds + PG8_SB(b, h) + boff + n * 2048 + k * 1024); } while (0)
#define PG8_MMA(ai, bj, At, Bt) do { __builtin_amdgcn_s_setprio(1); _Pragma("unroll") for (int m = 0; m < 4; ++m) _Pragma("unroll") for (int n = 0; n < 2; ++n) _Pragma("unroll") for (int k = 0; k < 2; ++k) \
        acc[ai][bj][m][n] = __builtin_amdgcn_mfma_f32_16x16x32_bf16(Bt[n][k], At[m][k], acc[ai][bj][m][n], 0, 0, 0); __builtin_amdgcn_s_setprio(0); } while (0)
#define PG8_WAIT_V(n) asm volatile("s_waitcnt vmcnt(" #n ")" ::: "memory")
#define PG8_WAIT_L(n) asm volatile("s_waitcnt lgkmcnt(" #n ")" ::: "memory")
#define PG8_BAR __builtin_amdgcn_s_barrier()
#define PG8_SCHED __builtin_amdgcn_sched_barrier(0)
    Unit cur, nxt; int ui = 0;
    if (!S.next(0, cur)) return;
    f32x4 acc[2][2][4][2];
#pragma unroll
    for (int a = 0; a < 2; ++a)
#pragma unroll
        for (int b = 0; b < 2; ++b)
#pragma unroll
            for (int m = 0; m < 4; ++m)
#pragma unroll
                for (int n = 0; n < 2; ++n) acc[a][b][m][n] = (f32x4){0.f, 0.f, 0.f, 0.f};
    bf16x8 At[4][2], B0[2][2], B1[2][2];
    if constexpr (Sched::GATHER) {
        for (int ui_ = 0; ; ++ui_) { Unit u_; if (!S.next(ui_, u_)) break; if (tid < 256) rtab[ui_ * 256 + tid] = S.rowsrc(u_.pm * 256 + tid); }
        __syncthreads();
    }
    fillA(0, vA0, vA1);
    const char* cA = Sched::GATHER ? (const char*)g.A : (const char*)g.A + (size_t)cur.pm * tstep; const char* cB = (const char*)g.Bt + (size_t)cur.pb * tstep;
    S.a_ready(cur);
    if constexpr (SP2) {
        PG8_STAGE(PG8_SB(0, 0), cB, voffB); PG8_STAGE(PG8_SB(0, 1), cB + hstep, voffB); PG8_STAGE(PG8_SA(0, 0), cA, vA0); PG8_STAGE(PG8_SA(0, 1), cA, vA1);
        if (wr == 1) PG8_BAR;
        PG8_WAIT_V(2); PG8_BAR;
        PG8_STAGE(PG8_SB(1, 0), cB + kstep, voffB); PG8_STAGE(PG8_SA(1, 0), cA + kstep, vA0); PG8_STAGE(PG8_SB(1, 1), cB + hstep + kstep, voffB);
        PG8_WAIT_V(6); PG8_BAR;
    } else {
        PG8_STAGE(PG8_SB(0, 0), cB, voffB); PG8_STAGE(PG8_SA(0, 0), cA, vA0); PG8_STAGE(PG8_SB(0, 1), cB + hstep, voffB); PG8_STAGE(PG8_SA(0, 1), cA, vA1);
        if (wr == 1) PG8_BAR;
        PG8_WAIT_V(4); PG8_BAR;
        PG8_STAGE(PG8_SB(1, 0), cB + kstep, voffB); PG8_STAGE(PG8_SA(1, 0), cA + kstep, vA0); PG8_STAGE(PG8_SB(1, 1), cB + hstep + kstep, voffB);
        PG8_WAIT_V(6); PG8_BAR;
    }
    for (;;) {
        const bool has_next = S.next(ui + 1, nxt);
        const char* nA = has_next ? (Sched::GATHER ? (const char*)g.A : (const char*)g.A + (size_t)nxt.pm * tstep) : cA; const char* nB = has_next ? (const char*)g.Bt + (size_t)nxt.pb * tstep : cB;
        if (has_next) fillA(ui + 1, nA0, nA1); else {
#pragma unroll
            for (int i = 0; i < 2; ++i) { nA0[i] = vA0[i]; nA1[i] = vA1[i]; } }
        for (int t = 0; t < nt; t += 2) {
            const bool last = (t == nt - 2);
            const char* a1 = cA + (size_t)(t + 1) * kstep;
            const char* a2 = last ? nA : cA + (size_t)(t + 2) * kstep; const char* b2 = last ? nB : cB + (size_t)(t + 2) * kstep;
            const char* a3 = a2 + kstep; const char* b3 = b2 + kstep;
            unsigned sA0[2], sA1[2];
#pragma unroll
            for (int i = 0; i < 2; ++i) { sA0[i] = last ? nA0[i] : vA0[i]; sA1[i] = last ? nA1[i] : vA1[i]; }
            if (last && has_next) S.a_ready(nxt);
            if constexpr (SP2) {
            PG8_LDB(B0, 0, 0); PG8_LDB(B1, 0, 1); PG8_SCHED; PG8_LDA(At, 0, 0); PG8_STAGE(PG8_SA(1, 1), a1, vA1);
            PG8_WAIT_V(8); PG8_WAIT_L(0); PG8_BAR; PG8_MMA(0, 0, At, B0); PG8_MMA(0, 1, At, B1); PG8_BAR; PG8_SCHED;
            PG8_LDA(At, 0, 1); PG8_STAGE(PG8_SB(0, 0), b2, voffB); PG8_STAGE(PG8_SB(0, 1), b2 + hstep, voffB); PG8_STAGE(PG8_SA(0, 0), a2, sA0);
            PG8_WAIT_V(8); PG8_WAIT_L(0); PG8_BAR; PG8_MMA(1, 0, At, B0); PG8_MMA(1, 1, At, B1); PG8_BAR; PG8_SCHED;
            PG8_LDB(B0, 1, 0); PG8_LDB(B1, 1, 1); PG8_SCHED; PG8_LDA(At, 1, 0); PG8_STAGE(PG8_SA(0, 1), a2, sA1);
            PG8_WAIT_V(8); PG8_WAIT_L(0); PG8_BAR; PG8_MMA(0, 0, At, B0); PG8_MMA(0, 1, At, B1); PG8_BAR; PG8_SCHED;
            PG8_LDA(At, 1, 1); PG8_STAGE(PG8_SB(1, 0), b3, voffB); PG8_STAGE(PG8_SB(1, 1), b3 + hstep, voffB); PG8_STAGE(PG8_SA(1, 0), a3, sA0);
            PG8_WAIT_V(8); PG8_WAIT_L(0); PG8_BAR; PG8_MMA(1, 0, At, B0); PG8_MMA(1, 1, At, B1); PG8_BAR; PG8_SCHED;
            } else {
            PG8_LDB(B0, 0, 0); PG8_SCHED; PG8_LDA(At, 0, 0); PG8_STAGE(PG8_SA(1, 1), a1, vA1);
            PG8_WAIT_L(8); PG8_BAR; PG8_WAIT_L(0); PG8_MMA(0, 0, At, B0); PG8_BAR; PG8_SCHED;
            PG8_LDB(B1, 0, 1); PG8_STAGE(PG8_SB(0, 0), b2, voffB);
            PG8_BAR; PG8_WAIT_L(0); PG8_MMA(0, 1, At, B1); PG8_BAR;
            PG8_LDA(At, 0, 1); PG8_STAGE(PG8_SA(0, 0), a2, sA0);
            PG8_BAR; PG8_WAIT_L(0); PG8_MMA(1, 0, At, B0); PG8_BAR; PG8_SCHED;
            PG8_STAGE(PG8_SB(0, 1), b2 + hstep, voffB);
            PG8_WAIT_V(6); PG8_BAR; PG8_MMA(1, 1, At, B1); PG8_BAR;
            PG8_LDB(B0, 1, 0); PG8_SCHED; PG8_LDA(At, 1, 0); PG8_STAGE(PG8_SA(0, 1), a2, sA1);
            PG8_WAIT_L(8); PG8_BAR; PG8_WAIT_L(0); PG8_MMA(0, 0, At, B0); PG8_BAR; PG8_SCHED;
            PG8_LDB(B1, 1, 1); PG8_STAGE(PG8_SB(1, 0), b3, voffB);
            PG8_BAR; PG8_WAIT_L(0); PG8_MMA(0, 1, At, B1); PG8_BAR;
            PG8_LDA(At, 1, 1); PG8_STAGE(PG8_SA(1, 0), a3, sA0);
            PG8_BAR; PG8_WAIT_L(0); PG8_MMA(1, 0, At, B0); PG8_BAR; PG8_SCHED;
            PG8_STAGE(PG8_SB(1, 1), b3 + hstep, voffB);
            PG8_WAIT_V(6); PG8_BAR; PG8_MMA(1, 1, At, B1); PG8_BAR;
            }
        }
        if constexpr (ALIGN_EPI) { if (wr == 0) PG8_BAR; }
        if constexpr (!Epi::AFTER_DRAIN) { E(acc, cur, wr, wc, fr, fq); S.done(cur); }
        if (!has_next) break;
#pragma unroll
        for (int a = 0; a < 2; ++a)
#pragma unroll
            for (int b = 0; b < 2; ++b)
#pragma unroll
                for (int m = 0; m < 4; ++m)
#pragma unroll
                    for (int n = 0; n < 2; ++n) acc[a][b][m][n] = (f32x4){0.f, 0.f, 0.f, 0.f};
        cur = nxt; cA = nA; cB = nB; ++ui;
#pragma unroll
        for (int i = 0; i < 2; ++i) { vA0[i] = nA0[i]; vA1[i] = nA1[i]; }
        if constexpr (ALIGN_EPI) { if (wr == 1) PG8_BAR; }
    }
    PG8_WAIT_V(0);
    if constexpr (!ALIGN_EPI) { if (wr == 0) PG8_BAR; }
    PG8_BAR;
    if constexpr (Epi::AFTER_DRAIN) { E.fused(acc, cur, wr, wc, fr, fq, lds, wid, lane); S.done(cur); }
#undef PG8_SA
#undef PG8_SB
#undef PG8_STAGE
#undef PG8_LDA
#undef PG8_LDB
#undef PG8_MMA
#undef PG8_WAIT_V
#undef PG8_WAIT_L
#undef PG8_BAR
#undef PG8_SCHED
}
}
constexpr int D = 1024, BATCH = 8, SEQ = 4096, NTOK = BATCH * SEQ;
constexpr int GW = 512, RW = 512, HD = 64, CHUNK = 128;
constexpr int RPROJ = 1696, INW = 2720, ZLD = 2816;
constexpr int NG = 4, EPG = 8, NE = 32, EH = 512;
constexpr int NTHR = 512;
constexpr int LDS_BYTES = 163840;

typedef float f32x16 __attribute__((ext_vector_type(16)));
typedef float f32x4 __attribute__((ext_vector_type(4)));
typedef unsigned u32x4 __attribute__((ext_vector_type(4)));
typedef unsigned u32x2 __attribute__((ext_vector_type(2)));
typedef unsigned short bf16;
#define LAS __attribute__((address_space(3)))

constexpr size_t MiB = 1u << 20;
constexpr size_t W_WINT = 0;
constexpr size_t W_WOUTT = 6 * MiB;
constexpr size_t W_LORAT = 8 * MiB;
constexpr size_t W_WC = 9 * MiB;
constexpr size_t W_MOD = 10 * MiB;
constexpr size_t W_RA = W_MOD + 256 * 1024;
constexpr size_t W_RW = W_MOD + 512 * 1024;
constexpr size_t W_TAB = 11 * MiB;
constexpr size_t W_WGUT = 16 * MiB;
constexpr size_t W_WDT = 80 * MiB;
constexpr size_t W_H1 = 112 * MiB;
constexpr size_t W_Z = 176 * MiB;
constexpr size_t W_YCAT = 352 * MiB;
constexpr size_t W_LO = 416 * MiB;
constexpr size_t WS_NEED = 512 * MiB;
constexpr size_t T_TOKE = W_TAB;
constexpr size_t T_TOKW = W_TAB + 512 * 1024;
constexpr size_t T_ROWTOK = W_TAB + 1024 * 1024;
constexpr size_t T_ROWAID = W_TAB + 1536 * 1024;
constexpr size_t T_ROWW = W_TAB + 2048 * 1024;
constexpr size_t T_TILEE = W_TAB + 2560 * 1024;
constexpr size_t T_CTL = W_TAB + 3072 * 1024;
constexpr size_t T_BAR = W_TAB + 3584 * 1024;

struct Params {
    const float* in[31];
    float* out;
    unsigned char* ws;
};
typedef const __attribute__((address_space(4))) Params& PRef;
typedef const __attribute__((address_space(4))) Params* PPtr;
__device__ __forceinline__ PPtr opq(PPtr k) { asm volatile("" : "+s"(k)); return k; }
enum { I_X = 0, I_C, I_ADAW, I_ADAB, I_N1G, I_WIN, I_GLNW, I_GLNB, I_GWS, I_GBS, I_MU, I_W0, I_W2, I_A0, I_A2, I_G2, I_KK, I_KA, I_RK, I_GNW, I_GNB, I_WOUT, I_N2G, I_RGW, I_RGB, I_REW, I_REB, I_WG, I_WU, I_WD, I_FNG };

__device__ __forceinline__ float wave_sum(float v) {
#pragma unroll
    for (int o = 1; o < 64; o <<= 1) v += __shfl_xor(v, o);
    return v;
}
#define DPP_ADD(v, ctrl) v += __builtin_bit_cast(float, __builtin_amdgcn_update_dpp(0, __builtin_bit_cast(int, v), ctrl, 0xf, 0xf, false))
__device__ __forceinline__ float wave_sum_dpp(float v) {
    DPP_ADD(v, 0xB1); DPP_ADD(v, 0x4E); DPP_ADD(v, 0x141); DPP_ADD(v, 0x140);
    const int iv = __builtin_bit_cast(int, v);
    const float a = __builtin_bit_cast(float, __builtin_amdgcn_readlane(iv, 0)), b = __builtin_bit_cast(float, __builtin_amdgcn_readlane(iv, 16));
    const float c = __builtin_bit_cast(float, __builtin_amdgcn_readlane(iv, 32)), d = __builtin_bit_cast(float, __builtin_amdgcn_readlane(iv, 48));
    return (a + b) + (c + d);
}
__device__ __forceinline__ float xsum4(float s) {
    s += __builtin_bit_cast(float, __builtin_amdgcn_ds_swizzle(__builtin_bit_cast(int, s), 0x401F));
    float a = s, b = s;
    asm volatile("s_nop 1\n\tv_permlane32_swap_b32 %0, %1\n\ts_nop 1" : "+v"(a), "+v"(b));
    return a + b;
}
__device__ __forceinline__ float wave_sum_v(float v) {
    DPP_ADD(v, 0xB1); DPP_ADD(v, 0x4E); DPP_ADD(v, 0x141); DPP_ADD(v, 0x140);
    return xsum4(v);
}
__device__ __forceinline__ float gelu_tanh(float x) {
    const float u = 0.7978845608028654f * (x + 0.044715f * x * x * x);
    return 0.5f * x * (1.0f + tanhf(u));
}
__device__ __forceinline__ float gelu_fast(float x) {
    const float u2 = -2.302208198f * (x + 0.044715f * x * x * x);
    return x * __builtin_amdgcn_rcpf(1.0f + __builtin_amdgcn_exp2f(u2));
}
__device__ __forceinline__ float sigmoidf_(float x) { return 1.0f / (1.0f + expf(-x)); }
__device__ __forceinline__ float softplusf_(float x) { return fmaxf(x, 0.f) + log1pf(expf(-fabsf(x))); }
__device__ __forceinline__ float bf2f(unsigned short b) { return __uint_as_float(((unsigned)b) << 16); }
__device__ __forceinline__ float bflo(unsigned w) { return __uint_as_float(w << 16); }
__device__ __forceinline__ float bfhi(unsigned w) { return __uint_as_float(w & 0xffff0000u); }
__device__ __forceinline__ unsigned f2bf(float f) { unsigned u = __float_as_uint(f); return (u + 0x7fffu + ((u >> 16) & 1u)) >> 16; }
__device__ __forceinline__ unsigned pk2(float lo, float hi) { return f2bf(lo) | (f2bf(hi) << 16); }
#define XB_TMO      128
#define XB_XCNT(j)  (256  + 64 * (j))
#define XB_XSUB(j)  (1280 + 64 * (j))
#define XB_XGEN(j)  (2304 + 64 * (j))
#define XB_TOP      3328
#define XB_TOPGEN   3392
#define XCD_BAR_WORDS 3456
#define XB_SPIN_CAP (1u << 18)

__device__ __forceinline__ unsigned xb_ld(unsigned* p)              { return __hip_atomic_load(p, __ATOMIC_RELAXED, __HIP_MEMORY_SCOPE_AGENT); }
__device__ __forceinline__ unsigned xb_add(unsigned* p, unsigned v) { return __hip_atomic_fetch_add(p, v, __ATOMIC_RELAXED, __HIP_MEMORY_SCOPE_AGENT); }
__device__ __forceinline__ unsigned xb_xcc_id() { return (unsigned)__builtin_amdgcn_s_getreg((3 << 11) | 20) & 0xFu; }
#define XB_SPIN(cond, bar) do { unsigned _sp = 0; while (cond) { __builtin_amdgcn_s_sleep(1); \
    if ((++_sp & 255u) == 0u) { if (xb_ld(&(bar)[XB_TMO])) break; if (_sp > XB_SPIN_CAP) { atomicAdd(&(bar)[XB_TMO], 1u); break; } } } } while (0)

struct XcdBarrier {
    unsigned* bar; unsigned x;
    volatile LAS unsigned* st;
};

__device__ __forceinline__ XcdBarrier xcd_barrier_post(unsigned* bar, volatile LAS unsigned* st) {
    XcdBarrier b; b.bar = bar; b.x = xb_xcc_id(); b.st = st;
    if (threadIdx.x == 0) (void)xb_add(&bar[XB_XCNT(b.x)], 1u);
    return b;
}
__device__ __forceinline__ void xcd_barrier_complete(unsigned* bar, unsigned x, unsigned& nloc, unsigned& nx) {
    const unsigned G = gridDim.x * gridDim.y * gridDim.z;
    unsigned sum, cnt, mine, sp = 0u;
    for (;;) {
        sum = 0u; cnt = 0u; mine = 0u;
#pragma unroll
        for (unsigned j = 0; j < 16; ++j) { const unsigned c = xb_ld(&bar[XB_XCNT(j)]); sum += c; cnt += (c > 0u) ? 1u : 0u; mine = (j == x) ? c : mine; }
        if (sum == G) break;
        __builtin_amdgcn_s_sleep(1);
        if ((++sp & 255u) == 0u) { if (xb_ld(&bar[XB_TMO])) break; if (sp > XB_SPIN_CAP) { atomicAdd(&bar[XB_TMO], 1u); break; } }
    }
    nloc = mine > 0u ? mine : 1u; nx = cnt > 0u ? cnt : 1u;
}

__device__ __forceinline__ void xcd_barrier(const XcdBarrier& b) {
    asm volatile("s_waitcnt vmcnt(0)" ::: "memory");
    __syncthreads();
    if (threadIdx.x == 0) {
        unsigned* bar = b.bar;
        __builtin_amdgcn_s_waitcnt(0);
        unsigned nloc = b.st[0], nx = b.st[1];
        if (nloc == 0u) { xcd_barrier_complete(bar, b.x, nloc, nx); b.st[0] = nloc; b.st[1] = nx; }
        const unsigned old = xb_add(&bar[XB_XSUB(b.x)], 1u);
        const unsigned gen = old / nloc;
        if (old + 1u == (gen + 1u) * nloc) {
            __builtin_amdgcn_fence(__ATOMIC_RELEASE, "agent");
            asm volatile("s_waitcnt vmcnt(0)" ::: "memory");
            const unsigned og = xb_add(&bar[XB_TOP], 1u);
            const unsigned tg = og / nx;
            if (og + 1u == (tg + 1u) * nx) xb_add(&bar[XB_TOPGEN], 1u);
            else XB_SPIN(xb_ld(&bar[XB_TOPGEN]) == tg, bar);
            __builtin_amdgcn_fence(__ATOMIC_ACQUIRE, "agent");
            xb_add(&bar[XB_XGEN(b.x)], 1u);
            asm volatile("s_waitcnt vmcnt(0)" ::: "memory");
        } else {
            XB_SPIN(xb_ld(&bar[XB_XGEN(b.x)]) == gen, bar);
            __builtin_amdgcn_fence(__ATOMIC_ACQUIRE, "agent");
            asm volatile("s_waitcnt vmcnt(0)" ::: "memory");
        }
    }
    __syncthreads();
}
struct TrItem { const float* W; bf16* WT; int K, N; long row_off; int item; };
__device__ __forceinline__ void p0_tr_load(const TrItem& it, float (&tv)[32], int lane) {
    const int nblk = it.N / 32, kb = it.item / nblk, nb = it.item % nblk, k0 = 64 * kb, n0 = 32 * nb;
#pragma unroll
    for (int i = 0; i < 32; ++i) tv[i] = it.W[(size_t)(k0 + 2 * i + (lane >> 5)) * it.N + n0 + (lane & 31)];
}
__device__ __forceinline__ void p0_tr_store(const TrItem& it, const float (&tv)[32], LAS float* scr, int lane) {
    const int nblk = it.N / 32, kb = it.item / nblk, nb = it.item % nblk, k0 = 64 * kb, n0 = 32 * nb;
#pragma unroll
    for (int i = 0; i < 32; ++i) scr[(2 * i + (lane >> 5)) * 33 + (lane & 31)] = tv[i];
    asm volatile("s_waitcnt lgkmcnt(0)" ::: "memory");
    const int c = lane & 7;
#pragma unroll
    for (int j = 0; j < 4; ++j) { const int n = (lane >> 3) + 8 * j; const LAS float* s = scr + (8 * c) * 33 + n;
        u32x4 o; o.x = pk2(s[0 * 33], s[1 * 33]); o.y = pk2(s[2 * 33], s[3 * 33]); o.z = pk2(s[4 * 33], s[5 * 33]); o.w = pk2(s[6 * 33], s[7 * 33]);
        *(u32x4*)(it.WT + (size_t)(it.row_off + n0 + n) * it.K + k0 + 8 * c) = o; }
    asm volatile("s_waitcnt lgkmcnt(0)" ::: "memory");
}
__device__ __forceinline__ void p0_tr_store_half(const TrItem& it, const float (&tv)[32], LAS float* scr, int lane, int half) {
    const int nblk = it.N / 32, kb = it.item / nblk, nb = it.item % nblk, k0 = 64 * kb, n0 = 32 * nb;
    if (half == 0) {
#pragma unroll
        for (int i = 0; i < 32; ++i) scr[(2 * i + (lane >> 5)) * 33 + (lane & 31)] = tv[i];
        asm volatile("s_waitcnt lgkmcnt(0)" ::: "memory"); }
    const int c = lane & 7;
#pragma unroll
    for (int jj = 0; jj < 2; ++jj) { const int j = half * 2 + jj; const int n = (lane >> 3) + 8 * j; const LAS float* s = scr + (8 * c) * 33 + n;
        u32x4 o; o.x = pk2(s[0 * 33], s[1 * 33]); o.y = pk2(s[2 * 33], s[3 * 33]); o.z = pk2(s[4 * 33], s[5 * 33]); o.w = pk2(s[6 * 33], s[7 * 33]);
        *(u32x4*)(it.WT + (size_t)(it.row_off + n0 + n) * it.K + k0 + 8 * c) = o; }
    asm volatile("s_waitcnt lgkmcnt(0)" ::: "memory");
}
constexpr int MOE_I_GU = (D / 64) * (EH / 32), MOE_I_DN = (EH / 64) * (D / 32), MOE_ITEMS = NE * (2 * MOE_I_GU + MOE_I_DN);
__device__ __forceinline__ TrItem moe_item(PRef p, int r) {
    const int e = r / (2 * MOE_I_GU + MOE_I_DN); r -= e * (2 * MOE_I_GU + MOE_I_DN);
    if (r < 2 * MOE_I_GU) {
        const int up = r >= MOE_I_GU; if (up) r -= MOE_I_GU;
        const int nbk = r % (EH / 32), hb = nbk * 32;
        const long row_off = (long)e * 1024 + (hb / 128) * 256 + up * 128 + (hb % 128) - hb;
        return TrItem{(up ? p.in[I_WU] : p.in[I_WG]) + (size_t)e * D * EH, (bf16*)(p.ws + W_WGUT), D, EH, row_off, r}; }
    r -= 2 * MOE_I_GU;
    return TrItem{p.in[I_WD] + (size_t)e * EH * D, (bf16*)(p.ws + W_WDT), EH, D, (long)e * 1024, r};
}
__device__ __forceinline__ void p0_mod_item(PRef p, LAS float* lf, int item) {
    const int tid = otid(), cg = tid & 7, kq = tid >> 3;
    const float* __restrict__ c = p.in[I_C]; const float* w = p.in[I_ADAW] + (size_t)(kq * 16) * (6 * D) + item * 32 + cg * 4;
    f32x4 wv[16];
#pragma unroll
    for (int i = 0; i < 16; ++i) wv[i] = *(const f32x4*)(w + (size_t)i * (6 * D));
    LAS float* cs = lf; LAS float* red = lf + BATCH * D;
#pragma unroll
    for (int q = 0; q < 4; ++q) { const int idx = (tid + q * NTHR) * 4; *(LAS f32x4*)(cs + idx) = *(const f32x4*)(c + idx); }
    __syncthreads();
    f32x4 acc[8];
#pragma unroll
    for (int b = 0; b < 8; ++b) { acc[b] = (f32x4){0.f, 0.f, 0.f, 0.f};
#pragma unroll
        for (int i4 = 0; i4 < 4; ++i4) { const f32x4 cv = *(const LAS f32x4*)(cs + b * D + kq * 16 + i4 * 4);
#pragma unroll
            for (int j = 0; j < 4; ++j) acc[b] += wv[i4 * 4 + j] * cv[j]; } }
#pragma unroll
    for (int b = 0; b < 8; ++b) *(LAS f32x4*)(red + (kq * 8 + b) * 32 + cg * 4) = acc[b];
    __syncthreads();
    if (tid < 256) { const int b = tid >> 5, col = tid & 31; float s = 0.f;
#pragma unroll 16
      for (int q = 0; q < 64; ++q) s += red[(q * 8 + b) * 32 + col];
      ((float*)(p.ws + W_MOD))[b * 6 * D + item * 32 + col] = s + p.in[I_ADAB][item * 32 + col]; }
    __syncthreads();
}
template <bool WITH_MOE>
__device__ __forceinline__ void p0_prep(PRef p, LAS unsigned char* lds, int bid, int nb) {
    const int tid = otid(), lane = tid & 63, wave = __builtin_amdgcn_readfirstlane(tid >> 6);
    LAS float* scr = (LAS float*)(lds + wave * 16384);
    const int gw = bid * 8 + wave, NGW = nb * 8;
    constexpr int I_IN = (D / 64) * (INW / 32), I_OUT = (D / 64) * (D / 32), I_GU = (D / 64) * (EH / 32), I_DN = (EH / 64) * (D / 32);
    constexpr int NIT = I_IN + I_OUT + (WITH_MOE ? NE * (2 * I_GU + I_DN) : 0);
    auto decode = [&](int it) -> TrItem {
        int r = it;
        if (r < I_IN) return TrItem{p.in[I_WIN], (bf16*)(p.ws + W_WINT), D, INW, 0, r}; r -= I_IN;
        if (r < I_OUT) return TrItem{p.in[I_WOUT], (bf16*)(p.ws + W_WOUTT), D, D, 0, r}; r -= I_OUT;
        return moe_item(p, r);
    };
    float tvA[32], tvB[32];
    TrItem cur = decode(gw < NIT ? gw : 0);
    if (gw < NIT) p0_tr_load(cur, tvA, lane);
    { constexpr int NLT = 1536 * 256, NWC = 8 * 128 * 128, NRW = 2 * 2 * 48 * 520;
      const int i0 = bid * NTHR + tid, st = nb * NTHR;
      float vlt[3], vwc, vrw[2];
#pragma unroll
      for (int q = 0; q < 3; ++q) { const int i = i0 + q * st, ic = i < NLT ? i : 0, n = ic >> 8, k = ic & 255;
          const float* src = n < 512 ? p.in[I_W2] + (k & 31) * 512 + n : n < 1024 ? p.in[I_A2] + (k & 31) * 512 + (n - 512) : p.in[I_G2] + ((k >= 64 && k < 160) ? k - 64 : 0) * 512 + (n - 1024);
          const bool ok = n < 512 ? k < 32 : n < 1024 ? (k >= 32 && k < 64) : (k >= 64 && k < 160);
          const float v = *src; vlt[q] = ok ? v : 0.f; }
      { const int ic = i0 < NWC ? i0 : 0, s = ic & 127, t = (ic >> 7) & 127; const float v = p.in[I_GWS][ic]; vwc = (s <= t) ? v : 0.f; }
#pragma unroll
      for (int q = 0; q < 2; ++q) { const int i = i0 + q * st, ic = i < NRW ? i : 0; const int kl = ic % 520, qq = (ic / 520) % 48, kh = ic / (520 * 48 * 2); const int k = kh * 512 + (kl < 512 ? kl : 0);
          const float* src = qq < 4 ? p.in[I_RGW] + k * 4 + qq : p.in[I_REW] + k * 32 + (qq < 36 ? qq - 4 : 0);
          const float v = *src; vrw[q] = (kl < 512 && qq < 36) ? v : 0.f; }
      bf16* lt = (bf16*)(p.ws + W_LORAT); bf16* wc = (bf16*)(p.ws + W_WC); bf16* rw = (bf16*)(p.ws + W_RW);
#pragma unroll
      for (int q = 0; q < 3; ++q) { const int i = i0 + q * st; if (i < NLT) lt[i] = (bf16)f2bf(vlt[q]); }
      if (i0 < NWC) wc[i0] = (bf16)f2bf(vwc);
#pragma unroll
      for (int q = 0; q < 2; ++q) { const int i = i0 + q * st; if (i < NRW) { const int hl = (i / (520 * 48)) & 1; const unsigned hi = f2bf(vrw[q]); rw[i] = hl ? (bf16)f2bf(vrw[q] - bflo(hi)) : (bf16)hi; } }
      static_assert(NLT <= 3 * 256 * NTHR && NWC <= 256 * NTHR && NRW <= 2 * 256 * NTHR, "table loops assume a 256-workgroup grid");
      bf16* wpad = (bf16*)(p.ws + W_WINT) + (size_t)INW * D;
      for (int i = i0; i < (ZLD - INW) * D; i += st) wpad[i] = 0; }
#ifndef P0DUP
#define P0DUP 0
#endif
#pragma unroll 1
    for (int it = bid; it < 192; it += nb) p0_mod_item(p, (LAS float*)lds, it);
    { int it = gw;
    if (it < NIT) {
#pragma unroll 1
        for (;;) {
            const int itn = it + NGW; TrItem nxt = cur;
            if (itn < NIT) { nxt = decode(itn); p0_tr_load(nxt, tvB, lane); }
            p0_tr_store(cur, tvA, scr, lane);
            if (itn >= NIT) break;
            const int itn2 = itn + NGW; cur = nxt;
            if (itn2 < NIT) { cur = decode(itn2); p0_tr_load(cur, tvA, lane); }
            p0_tr_store(nxt, tvB, scr, lane);
            if (itn2 >= NIT) break;
            it = itn2;
        } }
    }
}
constexpr int CONV_J0 = 18;
__device__ __forceinline__ void p2_conv_share(PRef p, LAS unsigned char* lds, int bid, int nb) {
    if (bid < nb / 2) return;
    const int tid = otid(), lane = tid & 63, wave = __builtin_amdgcn_readfirstlane(tid >> 6);
    asm volatile("s_waitcnt vmcnt(0)" ::: "memory"); __syncthreads();
    LAS float* scr = (LAS float*)(lds + wave * 16384);
    const int g = (bid - nb / 2) * 8 + wave;
    float tvA[32], tvB[32];
    TrItem cur = moe_item(p, g + CONV_J0 * (MOE_ITEMS / 24)); p0_tr_load(cur, tvA, lane);
#pragma unroll 1
    for (int j = CONV_J0; j < 24; j += 2) {
        TrItem nxt = moe_item(p, g + (j + 1) * (MOE_ITEMS / 24)); p0_tr_load(nxt, tvB, lane);
        p0_tr_store(cur, tvA, scr, lane);
        if (j + 2 < 24) { cur = moe_item(p, g + (j + 2) * (MOE_ITEMS / 24)); p0_tr_load(cur, tvA, lane); }
        p0_tr_store(nxt, tvB, scr, lane);
    }
}
__device__ __forceinline__ void p1_h1(PRef p, int bid, int nb) {
    const float* __restrict__ x = p.in[I_X]; const float* __restrict__ g = p.in[I_N1G]; const float* mod = (const float*)(p.ws + W_MOD);
    bf16* H1 = (bf16*)(p.ws + W_H1);
    const int tid_ = otid(), lane = tid_ & 63, wv = tid_ >> 6;
    { float* ra = (float*)(p.ws + W_RA);
      for (int i = bid * NTHR + tid_; i < BATCH * D; i += nb * NTHR) { const int b = i >> 10, k = i & 1023; ra[i] = p.in[I_N2G][k] * (1.0f + mod[b * 6 * D + 4 * D + k]); } }
#pragma unroll 1
    for (int gw = bid * 8 + wv; gw < NTOK / 16; gw += nb * 8) {
        const int b = gw >> 8, row0 = b * SEQ + (gw & 255) * 2;
        const float* sh = mod + b * 6 * D; const float* sc = mod + b * 6 * D + D;
        f32x4 mm[4], hh[4];
#pragma unroll
        for (int j = 0; j < 4; ++j) { const int c0 = (lane + 64 * j) * 4; const f32x4 gg = *(const f32x4*)(g + c0), ss = *(const f32x4*)(sc + c0); hh[j] = *(const f32x4*)(sh + c0);
#pragma unroll
            for (int q = 0; q < 4; ++q) mm[j][q] = gg[q] * (1.0f + ss[q]); }
        const f32x4* xr = (const f32x4*)(x + (size_t)row0 * D) + lane;
        u32x2* o = (u32x2*)(H1 + (size_t)row0 * D) + lane;
        f32x4 va[2][4], vb[2][4];
        auto ld = [&](f32x4 (&v)[2][4], int s) __attribute__((always_inline)) {
#pragma unroll
            for (int j = 0; j < 4; ++j) { v[0][j] = __builtin_nontemporal_load(xr + s * (512 * 256) + 64 * j); v[1][j] = __builtin_nontemporal_load(xr + s * (512 * 256) + 256 + 64 * j); } };
        auto proc = [&](const f32x4 (&v)[2][4], int s) __attribute__((always_inline)) {
            float s0 = 0.f, s1 = 0.f;
#pragma unroll
            for (int j = 0; j < 4; ++j) { s0 += (v[0][j][0] * v[0][j][0] + v[0][j][1] * v[0][j][1]) + (v[0][j][2] * v[0][j][2] + v[0][j][3] * v[0][j][3]);
                                          s1 += (v[1][j][0] * v[1][j][0] + v[1][j][1] * v[1][j][1]) + (v[1][j][2] * v[1][j][2] + v[1][j][3] * v[1][j][3]); }
            const float r0 = rsqrtf(wave_sum_dpp(s0) * (1.0f / D) + 1e-6f), r1 = rsqrtf(wave_sum_dpp(s1) * (1.0f / D) + 1e-6f);
#pragma unroll
            for (int j = 0; j < 4; ++j) {
                f32x4 y0, y1;
#pragma unroll
                for (int q = 0; q < 4; ++q) { y0[q] = v[0][j][q] * r0 * mm[j][q] + hh[j][q]; y1[q] = v[1][j][q] * r1 * mm[j][q] + hh[j][q]; }
                u32x2 w0, w1; w0.x = pk2(y0[0], y0[1]); w0.y = pk2(y0[2], y0[3]); w1.x = pk2(y1[0], y1[1]); w1.y = pk2(y1[2], y1[3]);
                o[s * (512 * 256) + 64 * j] = w0; o[s * (512 * 256) + 256 + 64 * j] = w1;
            } };
        ld(va, 0);
#pragma unroll 1
        for (int s = 0; s < 8; s += 2) {
            ld(vb, s + 1);
            proc(va, s);
            ld(va, s + 2 < 8 ? s + 2 : 7);
            proc(vb, s + 1);
        }
    }
}
struct EpiZ {
    static constexpr bool PERM = true, AFTER_DRAIN = false;
    bf16* Z;
    __device__ __forceinline__ void operator()(const f32x4 (&acc)[2][2][4][2], const pg8::Unit& u, int wr, int wc, int fr, int fq) const {
        const int row0 = u.pm * 256 + wr * 64 + fr, col0 = u.pn * 256 + wc * 32 + 8 * fq;
        const bool act = u.pn < 4;
#pragma unroll
        for (int ai = 0; ai < 2; ++ai)
#pragma unroll
            for (int m = 0; m < 4; ++m) { bf16* rowp = Z + (size_t)(row0 + ai * 128 + m * 16) * ZLD + col0;
#pragma unroll
                for (int bj = 0; bj < 2; ++bj) { f32x4 v0 = acc[ai][bj][m][0], v1 = acc[ai][bj][m][1];
                    if (act) {
#pragma unroll
                        for (int q = 0; q < 4; ++q) { v0[q] = gelu_fast(v0[q]); v1[q] = gelu_fast(v1[q]); } }
                    u32x4 w; w.x = pg8::cvt_pk_bf16(v0[0], v0[1]); w.y = pg8::cvt_pk_bf16(v0[2], v0[3]); w.z = pg8::cvt_pk_bf16(v1[0], v1[1]); w.w = pg8::cvt_pk_bf16(v1[2], v1[3]);
                    *(u32x4*)(rowp + bj * 128) = w; } }
    }
};
constexpr int VNT_PITCH = 272;
__device__ __forceinline__ void p3_gmlp_unit(PRef p, LAS unsigned char* lds, int chunk) {
    typedef short bf16x8 __attribute__((ext_vector_type(8)));
    const int tid = otid(), lane = tid & 63, wave = __builtin_amdgcn_readfirstlane(tid >> 6);
    const bf16* Z = (const bf16*)(p.ws + W_Z); bf16* ycat = (bf16*)(p.ws + W_YCAT);
    const int t0 = chunk * CHUNK;
    { float lw[8], lb[8];
#pragma unroll
      for (int j = 0; j < 8; ++j) { lw[j] = p.in[I_GLNW][lane + 64 * j]; lb[j] = p.in[I_GLNB][lane + 64 * j]; }
      unsigned short raw[16][8];
      { const bf16* vp = Z + (size_t)(t0 + wave * 16) * ZLD + 512 + lane;
#pragma unroll
        for (int u = 0; u < 16; ++u)
#pragma unroll
            for (int j = 0; j < 8; ++j) raw[u][j] = vp[u * ZLD + 64 * j]; }
#pragma unroll
      for (int pr = 0; pr < 8; ++pr) {
          const int s = wave * 16 + pr * 2;
          float a[8], b[8]; float sa = 0.f, sb = 0.f;
#pragma unroll
          for (int j = 0; j < 8; ++j) { a[j] = bf2f(raw[pr * 2][j]); b[j] = bf2f(raw[pr * 2 + 1][j]); sa += a[j]; sb += b[j]; }
          const float ma = wave_sum_dpp(sa) * (1.f / 512.f), mb = wave_sum_dpp(sb) * (1.f / 512.f); float qa = 0.f, qb = 0.f;
#pragma unroll
          for (int j = 0; j < 8; ++j) { a[j] -= ma; b[j] -= mb; qa += a[j] * a[j]; qb += b[j] * b[j]; }
          const float ra = rsqrtf(wave_sum_dpp(qa) * (1.f / 512.f) + 1e-5f), rb = rsqrtf(wave_sum_dpp(qb) * (1.f / 512.f) + 1e-5f);
#pragma unroll
          for (int j = 0; j < 8; ++j) { const unsigned w = pk2(a[j] * ra * lw[j] + lb[j], b[j] * rb * lw[j] + lb[j]);
              *(LAS unsigned*)(lds + (lane + 64 * j) * VNT_PITCH + s * 2) = w; }
      } }
    const bf16* Wc = (const bf16*)(p.ws + W_WC) + (size_t)wave * CHUNK * CHUNK;
    const int fr = lane & 15, fq = lane >> 4;
    const LAS unsigned char* abase = lds + (wave * 64 + fr) * VNT_PITCH + fq * 16;
    bf16x8 bfr[20]; u32x2 uw[8][4]; float bsv[8];
    { int fi = 0;
#pragma unroll
      for (int tt = 0; tt < 8; ++tt) { const int nks = ((tt * 16 + 15) >> 5) + 1;
#pragma unroll
          for (int ks = 0; ks < nks; ++ks) bfr[fi++] = *(const bf16x8*)(Wc + (tt * 16 + fr) * CHUNK + ks * 32 + fq * 8); } }
    { const bf16* zu = Z + (size_t)(t0 + fr) * ZLD + wave * 64 + fq * 4;
#pragma unroll
      for (int tt = 0; tt < 8; ++tt) { bsv[tt] = p.in[I_GBS][wave * CHUNK + tt * 16 + fr];
#pragma unroll
          for (int dt = 0; dt < 4; ++dt) uw[tt][dt] = *(const u32x2*)(zu + tt * 16 * ZLD + dt * 16); } }
    __syncthreads();
    { int fi = 0;
      bf16* yo = ycat + (size_t)(t0 + fr) * 1024 + wave * 64 + fq * 4;
#pragma unroll
      for (int tt = 0; tt < 8; ++tt) {
        f32x4 acc[4];
#pragma unroll
        for (int dt = 0; dt < 4; ++dt) acc[dt] = (f32x4){0.f, 0.f, 0.f, 0.f};
        const int nks = ((tt * 16 + 15) >> 5) + 1;
#pragma unroll
        for (int ks = 0; ks < nks; ++ks) {
#pragma unroll
            for (int dt = 0; dt < 4; ++dt) {
                const bf16x8 afr = *(const LAS bf16x8*)(abase + dt * 16 * VNT_PITCH + ks * 64);
                acc[dt] = __builtin_amdgcn_mfma_f32_16x16x32_bf16(afr, bfr[fi], acc[dt], 0, 0, 0);
            }
            ++fi;
        }
#pragma unroll
        for (int dt = 0; dt < 4; ++dt) {
            const u32x2 w2 = uw[tt][dt];
            u32x2 o; o.x = pk2(bflo(w2.x) * (acc[dt][0] + bsv[tt]), bfhi(w2.x) * (acc[dt][1] + bsv[tt])); o.y = pk2(bflo(w2.y) * (acc[dt][2] + bsv[tt]), bfhi(w2.y) * (acc[dt][3] + bsv[tt]));
            *(u32x2*)(yo + tt * 16 * 1024 + dt * 16) = o;
        }
      } }
    __syncthreads();
}
constexpr size_t W_X1B = 240 * MiB;
struct EpiX1 {
    static constexpr bool PERM = true, AFTER_DRAIN = false;
    const float* x; const float* mod; bf16* x1;
    __device__ __forceinline__ void operator()(const f32x4 (&acc)[2][2][4][2], const pg8::Unit& u, int wr, int wc, int fr, int fq) const {
        const int row0 = u.pm * 256 + wr * 64 + fr, col0 = u.pn * 256 + wc * 32 + 8 * fq;
        const int b = (u.pm * 256) / SEQ;
        const float* gt = mod + b * 6 * D + 2 * D;
#pragma unroll
        for (int bj = 0; bj < 2; ++bj) { const f32x4 g0 = *(const f32x4*)(gt + col0 + bj * 128), g1 = *(const f32x4*)(gt + col0 + bj * 128 + 4);
#pragma unroll
            for (int ai = 0; ai < 2; ++ai)
#pragma unroll
                for (int m = 0; m < 4; ++m) { const size_t off = (size_t)(row0 + ai * 128 + m * 16) * D + col0 + bj * 128;
                    const f32x4 x0 = *(const f32x4*)(x + off), xb = *(const f32x4*)(x + off + 4);
                    const f32x4 v0 = x0 + g0 * acc[ai][bj][m][0], v1 = xb + g1 * acc[ai][bj][m][1];
                    u32x4 w; w.x = pg8::cvt_pk_bf16(v0[0], v0[1]); w.y = pg8::cvt_pk_bf16(v0[2], v0[3]); w.z = pg8::cvt_pk_bf16(v1[0], v1[1]); w.w = pg8::cvt_pk_bf16(v1[2], v1[3]);
                    *(u32x4*)(x1 + off) = w; } }
    }
};
constexpr size_t W_A2 = 112 * MiB;
constexpr size_t W_Q = 112 * MiB;
constexpr size_t W_Y2 = 144 * MiB;
constexpr size_t T_RK = W_TAB + 4 * MiB;
constexpr size_t O_M = 0, O_N = 64 * MiB;
constexpr size_t W_S = 176 * MiB;
constexpr int SCL = 64, NCH = SEQ / SCL;

__device__ __forceinline__ float sigmoid_fast(float x) { return __builtin_amdgcn_rcpf(1.0f + __builtin_amdgcn_exp2f(-1.4426950409f * x)); }
__device__ __forceinline__ void p3_lorain(PRef p, int bid, int nb) {
    const bf16* Z = (const bf16*)(p.ws + W_Z); bf16* A2 = (bf16*)(p.ws + W_A2);
    const int tid = otid(), j = tid & 255, sub = tid >> 8;
    const int jc = j < 160 ? j : 159;
    const float muj = p.in[I_MU][1536 + jc];
    const float sm = j < 32 ? 2.f : 1.f, sa = j < 32 ? 2.f : (j >= 64 && j < 160) ? 1.f : 0.f, sb = j < 32 ? -1.f : 0.f, sl = (j >= 32 && j < 64) ? 1.f : 0.f;
#pragma unroll 1
    for (int blk = bid; blk < NTOK / 128; blk += nb) {
        const int ts = blk * 128 + sub * 64;
        const bf16* zp = Z + (size_t)ts * ZLD + 2560 + jc; bf16* ap = A2 + (size_t)ts * 256 + j;
        unsigned short raw[64];
        const unsigned short pv = zp[(ts % SEQ == 0) ? 0 : -ZLD];
#pragma unroll
        for (int t = 0; t < 64; ++t) raw[t] = zp[t * ZLD];
        float prev = (ts % SEQ == 0) ? 0.f : bf2f(pv);
#pragma unroll
        for (int t = 0; t < 64; ++t) { const float cur = bf2f(raw[t]); const float v = cur + (prev - cur) * muj; prev = cur;
            ap[t * 256] = (bf16)f2bf(sa * sigmoid_fast(sm * v) + sb + sl * v); }
    }
}
struct EpiLO {
    static constexpr bool PERM = true, AFTER_DRAIN = false;
    bf16* LO; const float* w0; const float* a0;
    __device__ __forceinline__ void operator()(const f32x4 (&acc)[2][2][4][2], const pg8::Unit& u, int wr, int wc, int fr, int fq) const {
        const int row0 = u.pm * 256 + wr * 64 + fr, col0 = u.pn * 256 + wc * 32 + 8 * fq, kind = u.pn >> 1;
#pragma unroll
        for (int bj = 0; bj < 2; ++bj) {
            f32x4 bv[2];
#pragma unroll
            for (int n = 0; n < 2; ++n) { const int ch = col0 + bj * 128 + 4 * n - kind * 512;
                bv[n] = kind == 0 ? *(const f32x4*)(w0 + ch) : kind == 1 ? *(const f32x4*)(a0 + ch) : (f32x4){0.f, 0.f, 0.f, 0.f}; }
#pragma unroll
            for (int ai = 0; ai < 2; ++ai)
#pragma unroll
                for (int m = 0; m < 4; ++m) { bf16* rowp = LO + (size_t)(row0 + ai * 128 + m * 16) * 1536 + col0 + bj * 128;
                    f32x4 v0 = acc[ai][bj][m][0] + bv[0], v1 = acc[ai][bj][m][1] + bv[1];
                    if (kind < 2) { const float sc = kind == 0 ? -0.6065306597f : 1.0f;
#pragma unroll
                        for (int q = 0; q < 4; ++q) { v0[q] = sc * sigmoid_fast(v0[q]); v1[q] = sc * sigmoid_fast(v1[q]); } }
                    u32x4 w; w.x = pg8::cvt_pk_bf16(v0[0], v0[1]); w.y = pg8::cvt_pk_bf16(v0[2], v0[3]); w.z = pg8::cvt_pk_bf16(v1[0], v1[1]); w.w = pg8::cvt_pk_bf16(v1[2], v1[3]);
                    *(u32x4*)rowp = w;
                    asm volatile("" ::: "memory"); }
        }
    }
};
constexpr int SC_TS = 8;
__device__ __forceinline__ void p5a_chunk(PRef p, LAS unsigned char* lds, int q) {
    typedef float f32x2 __attribute__((ext_vector_type(2)));
    const int tid_ = otid(), lane = tid_ & 63, wave = __builtin_amdgcn_readfirstlane(tid_ >> 6);
    const int seq = q / NCH, c = q % NCH, b = seq >> 3, h = seq & 7;
    const int tb = b * SEQ + c * SCL, hc = h * 64 + lane;
    const bf16* Z = (const bf16*)(p.ws + W_Z); const bf16* LO = (const bf16*)(p.ws + W_LO);
    bf16* Qo = (bf16*)(p.ws + W_Q); bf16* Y2o = (bf16*)(p.ws + W_Y2); bf16* VLo = (bf16*)(p.ws + W_YCAT); float* RKo = (float*)(p.ws + T_RK);
    LAS float* vec = (LAS float*)(lds + wave * (SC_TS * 6 * 256));
    const float mur = p.in[I_MU][hc], muk = p.in[I_MU][512 + hc], muv = p.in[I_MU][1024 + hc];
    const float kkc = p.in[I_KK][hc], kac = p.in[I_KA][hc], rkc = p.in[I_RK][hc];
    float rp = 0.f, kp = 0.f, vp = 0.f;
    if (c != 0) { const bf16* zp = Z + (size_t)(tb - 1) * ZLD + 1024 + hc; rp = bf2f(zp[0]); kp = bf2f(zp[512]); vp = bf2f(zp[1024]); }
    f32x2 Mr[32], Nr[32];
#pragma unroll
    for (int k = 0; k < 32; ++k) { Mr[k] = (f32x2){(2 * k == lane) ? 1.f : 0.f, (2 * k + 1 == lane) ? 1.f : 0.f}; Nr[k] = (f32x2){0.f, 0.f}; }
    for (int sb = 0; sb < SCL / SC_TS; ++sb) {
        const int t0 = tb + sb * SC_TS;
#pragma unroll 1
        for (int sg = 0; sg < SC_TS; sg += 4) { float zr[4], zk[4], zv[4], lw[4], as[4];
          const bf16* zp0 = Z + (unsigned)((t0 + sg) * ZLD + 1024 + hc); const bf16* lp0 = LO + (unsigned)((t0 + sg) * 1536 + hc);
#pragma unroll
          for (int s = 0; s < 4; ++s) { const bf16* zp = zp0 + s * ZLD; const bf16* lp = lp0 + s * 1536;
              zr[s] = bf2f(zp[0]); zk[s] = bf2f(zp[512]); zv[s] = bf2f(zp[1024]); lw[s] = bf2f(lp[0]); as[s] = bf2f(lp[512]); }
#pragma unroll
          for (int s = 0; s < 4; ++s) {
              const float r = zr[s] + (rp - zr[s]) * mur, k = zk[s] + (kp - zk[s]) * muk, v = zv[s] + (vp - zv[s]) * muv;
              rp = zr[s]; kp = zk[s]; vp = zv[s];
              const float kkv = k * kkc;
              const float nrm = sqrtf(wave_sum_dpp(kkv * kkv));
              const float kk = kkv / fmaxf(nrm, 1e-12f);
              const float k2 = k * (1.0f + (as[s] - 1.0f) * kac);
              const float rk = wave_sum_dpp(r * k2 * rkc);
              LAS float* o = vec + (sg + s) * 384 + lane;
              o[0] = __builtin_amdgcn_exp2f(1.4426950409f * lw[s]); o[64] = -kk; o[128] = kk * as[s]; o[192] = k2; o[256] = r; o[320] = v;
              VLo[(unsigned)((t0 + sg + s) * 1024 + 512 + hc)] = (bf16)f2bf(v);
              if (lane == 0) RKo[(unsigned)((t0 + sg + s) * 8 + h)] = rk;
          } }
        asm volatile("s_waitcnt lgkmcnt(0)" ::: "memory");
        for (int s = 0; s < SC_TS; ++s) {
            const LAS float* vs = vec + s * 384;
            const float vi = vs[320 + lane];
            f32x2 saM = {0.f, 0.f}, saN = {0.f, 0.f};
#pragma unroll
            for (int k4 = 0; k4 < 16; ++k4) { const f32x4 a4 = *(const LAS f32x4*)(vs + 64 + 4 * k4);
                const f32x2 a0 = {a4[0], a4[1]}, a1 = {a4[2], a4[3]};
                saM += Mr[2 * k4] * a0; saN += Nr[2 * k4] * a0; saM += Mr[2 * k4 + 1] * a1; saN += Nr[2 * k4 + 1] * a1;
                if ((k4 & 3) == 3) asm volatile("" ::: "memory"); }
            const float sM = saM[0] + saM[1], sN = saN[0] + saN[1];
            const f32x2 sM2 = {sM, sM}, sN2 = {sN, sN}, vi2 = {vi, vi};
            f32x2 yM = {0.f, 0.f}, yN = {0.f, 0.f};
#pragma unroll
            for (int k4 = 0; k4 < 16; ++k4) {
                const f32x4 w4 = *(const LAS f32x4*)(vs + 4 * k4), b4 = *(const LAS f32x4*)(vs + 128 + 4 * k4), k4v = *(const LAS f32x4*)(vs + 192 + 4 * k4), r4 = *(const LAS f32x4*)(vs + 256 + 4 * k4);
#pragma unroll
                for (int hh = 0; hh < 2; ++hh) {
                    const f32x2 w2 = {w4[2 * hh], w4[2 * hh + 1]}, b2 = {b4[2 * hh], b4[2 * hh + 1]}, k2 = {k4v[2 * hh], k4v[2 * hh + 1]}, r2 = {r4[2 * hh], r4[2 * hh + 1]};
                    const int kx = 2 * k4 + hh;
                    Mr[kx] = Mr[kx] * w2 + sM2 * b2;
                    Nr[kx] = Nr[kx] * w2 + (sN2 * b2 + vi2 * k2);
                    yM += Mr[kx] * r2; yN += Nr[kx] * r2;
                }
                asm volatile("" ::: "memory");
            }
            const unsigned oo = (unsigned)((t0 + s) * 512 + hc);
            Qo[oo] = (bf16)f2bf(yM[0] + yM[1]); Y2o[oo] = (bf16)f2bf(yN[0] + yN[1]);
        }
        asm volatile("s_waitcnt lgkmcnt(0)" ::: "memory");
    }
    f32x4* Mo = (f32x4*)((unsigned char*)p.out + O_M + (size_t)q * 16384 + lane * 256);
    f32x4* No = (f32x4*)((unsigned char*)p.out + O_N + (size_t)q * 16384 + lane * 256);
#pragma unroll
    for (int k4 = 0; k4 < 16; ++k4) { Mo[k4] = (f32x4){Mr[2 * k4][0], Mr[2 * k4][1], Mr[2 * k4 + 1][0], Mr[2 * k4 + 1][1]}; No[k4] = (f32x4){Nr[2 * k4][0], Nr[2 * k4][1], Nr[2 * k4 + 1][0], Nr[2 * k4 + 1][1]}; }
}
__device__ __forceinline__ void p5b_chain(PRef p, LAS unsigned char* lds, int item) {
    typedef float f32x2 __attribute__((ext_vector_type(2)));
    const int tid = otid(), r = tid >> 5, j0 = (tid & 31) * 2, seq = (item & 7) + 8 * (item >> 5), rg = (item >> 3) & 3;
    const unsigned char* Mb = (const unsigned char*)p.out + O_M + (size_t)seq * NCH * 16384;
    const unsigned char* Nb = (const unsigned char*)p.out + O_N + (size_t)seq * NCH * 16384 + (size_t)(rg * 16 + r) * 256 + j0 * 4;
    unsigned char* Sb = p.ws + W_S + (size_t)seq * NCH * 16384 + (size_t)(rg * 16 + r) * 256 + j0 * 4;
    f32x2 sreg = {0.f, 0.f};
    f32x4 m0[2], m1[2], m2[2], m3[2]; f32x2 n0, n1, n2, n3;
#define P5B_LOAD(mm, nn, cc) do { const f32x4* mp = (const f32x4*)(Mb + (size_t)(cc) * 16384) + tid; mm[0] = mp[0]; mm[1] = mp[512]; nn = *(const f32x2*)(Nb + (size_t)(cc) * 16384); } while (0)
#define P5B_BAR() do { asm volatile("s_waitcnt lgkmcnt(0)" ::: "memory"); __builtin_amdgcn_s_barrier(); asm volatile("" ::: "memory"); } while (0)
#define P5B_STEP(mm, nn, cc) do { \
        LAS float* Sl = (LAS float*)(lds + ((cc) & 1) * 20480); LAS float* Ml = Sl + 1024; \
        *(LAS f32x4*)(Ml + tid * 4) = mm[0]; *(LAS f32x4*)(Ml + 2048 + tid * 4) = mm[1]; *(LAS f32x2*)(Sl + r * 64 + j0) = sreg; \
        *(f32x2*)(Sb + (size_t)(cc) * 16384) = sreg; \
        f32x2 acc = nn; \
        P5B_BAR(); \
        if ((cc) + 4 < NCH) P5B_LOAD(mm, nn, (cc) + 4); \
        _Pragma("unroll 16") for (int i = 0; i < 64; ++i) { const float sv = Sl[r * 64 + i]; const f32x2 mv = *(const LAS f32x2*)(Ml + i * 64 + j0); acc += (f32x2){sv, sv} * mv; } \
        sreg = acc; } while (0)
    __syncthreads();
    P5B_LOAD(m0, n0, 0); P5B_LOAD(m1, n1, 1); P5B_LOAD(m2, n2, 2); P5B_LOAD(m3, n3, 3);
    for (int c = 0; c < NCH; c += 4) { P5B_STEP(m0, n0, c); P5B_STEP(m1, n1, c + 1); P5B_STEP(m2, n2, c + 2); P5B_STEP(m3, n3, c + 3); }
    __syncthreads();
#undef P5B_LOAD
#undef P5B_STEP
#undef P5B_BAR
}
#ifndef P5C_MASK
#define P5C_MASK(c, h, tt) true
#endif
struct P5cOps { short __attribute__((ext_vector_type(8))) qb0, qb1; u32x4 y2a, y2b, vla, vlb, ga, gbv; float rk; };
__device__ __forceinline__ void p5c_chunk(PRef p, LAS unsigned char* lds, int q) {
    typedef short bf16x8 __attribute__((ext_vector_type(8)));
    const int tid_ = otid(), lane = tid_ & 63, wave = __builtin_amdgcn_readfirstlane(tid_ >> 6), fr = lane & 15, fq = lane >> 4;
    const int tk = lane >> 2, pc = lane & 3;
    const int seq = q / NCH, c = q % NCH, b = seq >> 3, h = seq & 7, tb = b * SEQ + c * SCL;
    const bf16* Qi = (const bf16*)(p.ws + W_Q); const bf16* Y2i = (const bf16*)(p.ws + W_Y2);
    const float* RKi = (const float*)(p.ws + T_RK); const bf16* LO = (const bf16*)(p.ws + W_LO); bf16* ycat = (bf16*)(p.ws + W_YCAT);
    const bf16* Sc = (const bf16*)(p.ws + W_S + (size_t)q * 8192);
    LAS float* yt = (LAS float*)(lds + wave * 4352);
    bf16x8 sa[4][2];
#pragma unroll
    for (int vt = 0; vt < 4; ++vt)
#pragma unroll
        for (int ks = 0; ks < 2; ++ks) sa[vt][ks] = *(const bf16x8*)(Sc + (vt * 16 + fr) * 64 + ks * 32 + fq * 8);
    auto ld = [&](P5cOps& o, int tt) __attribute__((always_inline)) {
        const unsigned tq = (unsigned)((tb + tt * 16 + fr) * 512 + h * 64);
        o.qb0 = *(const bf16x8*)(Qi + (tq + fq * 8)); o.qb1 = *(const bf16x8*)(Qi + (tq + 32 + fq * 8));
        const int t = tb + tt * 16 + tk;
        const unsigned o512 = (unsigned)(t * 512 + h * 64 + pc * 16), o1024 = (unsigned)(t * 1024 + 512 + h * 64 + pc * 16), olo = (unsigned)(t * 1536 + 1024 + h * 64 + pc * 16);
        o.y2a = *(const u32x4*)(Y2i + o512); o.y2b = *(const u32x4*)(Y2i + o512 + 8);
        o.vla = *(const u32x4*)(ycat + o1024); o.vlb = *(const u32x4*)(ycat + o1024 + 8);
        o.ga = *(const u32x4*)(LO + olo); o.gbv = *(const u32x4*)(LO + olo + 8);
        o.rk = RKi[(unsigned)(t * 8 + h)]; };
    P5cOps oa, ob; ld(oa, 0);
    f32x4 gw[4], gb[4];
#pragma unroll
    for (int i = 0; i < 4; ++i) { gw[i] = *(const f32x4*)(p.in[I_GNW] + h * 64 + pc * 16 + i * 4); gb[i] = *(const f32x4*)(p.in[I_GNB] + h * 64 + pc * 16 + i * 4); }
    auto proc = [&](const P5cOps& o, int tt) __attribute__((always_inline)) {
        const unsigned o1024 = (unsigned)((tb + tt * 16 + tk) * 1024 + 512 + h * 64 + pc * 16);
#pragma unroll
        for (int vt = 0; vt < 4; ++vt) {
            f32x4 a = {0.f, 0.f, 0.f, 0.f};
            a = __builtin_amdgcn_mfma_f32_16x16x32_bf16(sa[vt][0], o.qb0, a, 0, 0, 0);
            a = __builtin_amdgcn_mfma_f32_16x16x32_bf16(sa[vt][1], o.qb1, a, 0, 0, 0);
            *(LAS f32x4*)(yt + fr * 68 + vt * 16 + 4 * fq) = a;
        }
        asm volatile("s_waitcnt lgkmcnt(0)" ::: "memory");
        f32x4 y[4];
#pragma unroll
        for (int i = 0; i < 4; ++i) y[i] = *(const LAS f32x4*)(yt + tk * 68 + pc * 16 + i * 4);
        asm volatile("s_waitcnt lgkmcnt(0)" ::: "memory");
        const unsigned y2w[8] = {o.y2a.x, o.y2a.y, o.y2a.z, o.y2a.w, o.y2b.x, o.y2b.y, o.y2b.z, o.y2b.w};
        float s = 0.f;
#pragma unroll
        for (int i = 0; i < 4; ++i) { y[i][0] += bflo(y2w[2 * i]); y[i][1] += bfhi(y2w[2 * i]); y[i][2] += bflo(y2w[2 * i + 1]); y[i][3] += bfhi(y2w[2 * i + 1]); s += (y[i][0] + y[i][1]) + (y[i][2] + y[i][3]); }
        DPP_ADD(s, 0xB1); DPP_ADD(s, 0x4E);
        const float m = s * (1.f / 64.f); float qq = 0.f;
#pragma unroll
        for (int i = 0; i < 4; ++i) { y[i] = y[i] - m; qq += (y[i][0] * y[i][0] + y[i][1] * y[i][1]) + (y[i][2] * y[i][2] + y[i][3] * y[i][3]); }
        DPP_ADD(qq, 0xB1); DPP_ADD(qq, 0x4E);
        const float rs = rsqrtf(qq * (1.f / 64.f) + 64e-5f);
        const unsigned vw[8] = {o.vla.x, o.vla.y, o.vla.z, o.vla.w, o.vlb.x, o.vlb.y, o.vlb.z, o.vlb.w}, gwd[8] = {o.ga.x, o.ga.y, o.ga.z, o.ga.w, o.gbv.x, o.gbv.y, o.gbv.z, o.gbv.w};
        unsigned ow[8];
#pragma unroll
        for (int i = 0; i < 4; ++i) {
            const f32x4 vv = {bflo(vw[2 * i]), bfhi(vw[2 * i]), bflo(vw[2 * i + 1]), bfhi(vw[2 * i + 1])}, gg = {bflo(gwd[2 * i]), bfhi(gwd[2 * i]), bflo(gwd[2 * i + 1]), bfhi(gwd[2 * i + 1])};
            const f32x4 ov = (y[i] * rs * gw[i] + gb[i] + vv * o.rk) * gg;
            ow[2 * i] = pg8::cvt_pk_bf16(ov[0], ov[1]); ow[2 * i + 1] = pg8::cvt_pk_bf16(ov[2], ov[3]); }
        *(u32x4*)(ycat + o1024) = (u32x4){ow[0], ow[1], ow[2], ow[3]}; *(u32x4*)(ycat + o1024 + 8) = (u32x4){ow[4], ow[5], ow[6], ow[7]}; };
#pragma unroll 1
    for (int tt = 0; tt < SCL / 16; tt += 2) { ld(ob, tt + 1); proc(oa, tt); ld(oa, tt + 2 < SCL / 16 ? tt + 2 : tt + 1); proc(ob, tt + 1); }
}
constexpr size_t W_H2 = 112 * MiB;
constexpr size_t W_XS = 176 * MiB;
constexpr size_t W_HB = 320 * MiB;
constexpr int PROWS = NTOK * 2 + NE * 256, PTILES = PROWS / 256;
constexpr size_t T_HIST = W_TAB + 3 * 1024 * 1024 + 8192;
constexpr size_t T_NT = W_TAB + 3 * 1024 * 1024 + 4096;
constexpr size_t T_BQ = W_TAB + 3 * 1024 * 1024 + 65536;
constexpr int TPW = NTOK / 256;

__device__ __forceinline__ void p1_bq(PRef p, LAS float* red, int b) {
    const int tid = otid();
    const float* sh = (const float*)(p.ws + W_MOD) + b * 6 * D + 3 * D;
    if (tid < 288) { const int q = tid % 36, part = tid / 36; float s = 0.f;
        for (int c = part * 128; c < part * 128 + 128; ++c) s = fmaf(sh[c], q < 4 ? p.in[I_RGW][c * 4 + q] : p.in[I_REW][c * 32 + q - 4], s);
        red[part * 36 + q] = s; }
    __syncthreads();
    if (tid < 36) { float s = 0.f;
#pragma unroll
        for (int k = 0; k < 8; ++k) s += red[k * 36 + tid];
        ((float*)(p.ws + T_BQ))[b * 36 + tid] = s + (tid < 4 ? p.in[I_RGB][tid] : p.in[I_REB][tid - 4]); }
    __syncthreads();
}
__device__ __forceinline__ void p7_route(PRef p, LAS unsigned char* lds, int bid) {
    const int tid = otid(), lane = tid & 63, wave = __builtin_amdgcn_readfirstlane(tid >> 6);
    const float* x1 = p.out; bf16* H2 = (bf16*)(p.ws + W_H2);
    LAS int* hist = (LAS int*)(lds + 147456);
    const int b = (bid * TPW) / SEQ;
    const float* mod = (const float*)(p.ws + W_MOD) + b * 6 * D;
    const float* n2g = p.in[I_N2G];
    for (int ch = tid; ch < 1024 * 8; ch += NTHR) { const int c = ch >> 3, i = ch & 7;
        *(LAS f32x4*)(lds + c * 128 + 16 * (i ^ ((c >> 1) & 7))) = *(const f32x4*)(p.in[I_REW] + c * 32 + i * 4); }
    for (int c = tid; c < 1024; c += NTHR) *(LAS f32x4*)(lds + 131072 + c * 16) = *(const f32x4*)(p.in[I_RGW] + c * 4);
    if (tid < 32) hist[tid] = 0;
    if (tid < 36) *(LAS float*)(lds + 147456 + 128 + 4 * tid) = tid < 4 ? p.in[I_RGB][tid] : p.in[I_REB][tid - 4];
    __syncthreads();
    const int sw = (lane >> 1) & 7;
#pragma unroll 1
    for (int tp = 0; tp < TPW / 8; tp += 2) {
        const int t0 = bid * TPW + wave * (TPW / 8) + tp;
        const float* xr0 = x1 + (size_t)t0 * D; bf16* hr0 = H2 + (size_t)t0 * D;
        float r0, r1;
        { float pa[16], pb[16];
#pragma unroll
          for (int j = 0; j < 16; ++j) { pa[j] = xr0[lane + 64 * j]; pb[j] = xr0[D + lane + 64 * j]; }
          float ss0 = 0.f, ss1 = 0.f;
#pragma unroll
          for (int j = 0; j < 16; ++j) { ss0 = fmaf(pa[j], pa[j], ss0); ss1 = fmaf(pb[j], pb[j], ss1); }
          r0 = rsqrtf(wave_sum_v(ss0) * (1.0f / D) + 1e-6f); r1 = rsqrtf(wave_sum_v(ss1) * (1.0f / D) + 1e-6f); }
        float acc[2][36];
#pragma unroll
        for (int u = 0; u < 2; ++u)
#pragma unroll
            for (int q = 0; q < 36; ++q) acc[u][q] = 0.f;
#pragma unroll 1
        for (int j0 = 0; j0 < 16; j0 += 4) {
            float xa[4], xb[4], gv[4], sv[4];
#pragma unroll
            for (int jj = 0; jj < 4; ++jj) { const int c = lane + 64 * (j0 + jj); xa[jj] = xr0[c]; xb[jj] = xr0[D + c]; gv[jj] = n2g[c] * (1.0f + mod[4 * D + c]); sv[jj] = mod[3 * D + c]; }
#pragma unroll
            for (int jj = 0; jj < 4; ++jj) {
                const int c = lane + 64 * (j0 + jj);
                const float a0 = xa[jj] * r0 * gv[jj] + sv[jj], a1 = xb[jj] * r1 * gv[jj] + sv[jj];
                hr0[c] = (bf16)f2bf(a0); hr0[D + c] = (bf16)f2bf(a1);
                const LAS unsigned char* rowp = lds + c * 128;
                { const f32x4 w = *(const LAS f32x4*)(lds + 131072 + c * 16);
#pragma unroll
                  for (int q = 0; q < 4; ++q) { acc[0][q] = fmaf(a0, w[q], acc[0][q]); acc[1][q] = fmaf(a1, w[q], acc[1][q]); } }
#pragma unroll
                for (int i = 0; i < 8; ++i) { const f32x4 w = *(const LAS f32x4*)(rowp + 16 * (i ^ sw));
#pragma unroll
                    for (int q = 0; q < 4; ++q) { acc[0][4 + 4 * i + q] = fmaf(a0, w[q], acc[0][4 + 4 * i + q]); acc[1][4 + 4 * i + q] = fmaf(a1, w[q], acc[1][4 + 4 * i + q]); } }
            }
        }
#pragma unroll
        for (int u = 0; u < 2; ++u) {
            float lg[36];
#pragma unroll
            for (int q = 0; q < 36; ++q) { lg[q] = wave_sum_v(acc[u][q]); if ((q & 3) == 3) __builtin_amdgcn_sched_barrier(0); }
            unsigned bqo = 147456u + 128u; asm volatile("" : "+v"(bqo));
#pragma unroll
            for (int q = 0; q < 36; ++q) lg[q] += *(const LAS float*)(lds + bqo + 4 * q);
            int gi = 0; float gm = lg[0];
#pragma unroll
            for (int q = 1; q < 4; ++q) if (lg[q] > gm) { gm = lg[q]; gi = q; }
            float gsum = 0.f;
#pragma unroll
            for (int q = 0; q < 4; ++q) gsum += expf(lg[q] - gm);
            const float gp = 1.0f / gsum;
            float el[8];
#pragma unroll
            for (int q = 0; q < 8; ++q) el[q] = gi == 0 ? lg[4 + q] : gi == 1 ? lg[12 + q] : gi == 2 ? lg[20 + q] : lg[28 + q];
            int i0 = 0; float m0 = el[0];
#pragma unroll
            for (int q = 1; q < 8; ++q) if (el[q] > m0) { m0 = el[q]; i0 = q; }
            int i1 = -1; float m1 = -3.0e38f;
#pragma unroll
            for (int q = 0; q < 8; ++q) if (q != i0 && el[q] > m1) { m1 = el[q]; i1 = q; }
            const float p1 = expf(m1 - m0);
            const float w0 = gp / (1.0f + p1), w1 = gp * p1 / (1.0f + p1);
            if (lane == 0) { const int t = t0 + u, e0 = gi * 8 + i0, e1 = gi * 8 + i1;
                int* toke = (int*)(p.ws + T_TOKE); float* tokw = (float*)(p.ws + T_TOKW);
                toke[t * 2] = e0; toke[t * 2 + 1] = e1; tokw[t * 2] = w0; tokw[t * 2 + 1] = w1;
                __hip_atomic_fetch_add(&hist[e0], 1, __ATOMIC_RELAXED, __HIP_MEMORY_SCOPE_WORKGROUP); __hip_atomic_fetch_add(&hist[e1], 1, __ATOMIC_RELAXED, __HIP_MEMORY_SCOPE_WORKGROUP); }
        }
    }
    __syncthreads();
    if (tid < 32) ((int*)(p.ws + T_HIST))[bid * 32 + tid] = hist[tid];
    __syncthreads();
}
__device__ __forceinline__ void p8_place(PRef p, LAS unsigned char* lds, int bid) {
    const int tid = otid(), lane = tid & 63, wave = __builtin_amdgcn_readfirstlane(tid >> 6);
    LAS int* ptot = (LAS int*)lds;
    LAS int* pbef = ptot + 512;
    LAS int* base = pbef + 512;
    LAS int* lcur = base + 32;
    LAS int* posl = lcur + 32;
    LAS int* padb = posl + 256;
    const int* hist = (const int*)(p.ws + T_HIST);
    const int a_pre = bid * 256 + (tid & 255); const int e_pre = ((const int*)(p.ws + T_TOKE))[a_pre]; const float w_pre = ((const float*)(p.ws + T_TOKW))[a_pre];
    { const int e = tid & 31, part = tid >> 5; int tot = 0, bef = 0; int hc[16];
#pragma unroll
      for (int w = 0; w < 16; ++w) hc[w] = hist[(part * 16 + w) * 32 + e];
#pragma unroll
      for (int w = 0; w < 16; ++w) { tot += hc[w]; bef += (part * 16 + w < bid) ? hc[w] : 0; }
      ptot[part * 32 + e] = tot; pbef[part * 32 + e] = bef; }
    __syncthreads();
    if (tid < 32) { int tot = 0, bef = 0;
#pragma unroll
        for (int k = 0; k < 16; ++k) { tot += ptot[k * 32 + tid]; bef += pbef[k * 32 + tid]; }
        ptot[tid] = tot; pbef[tid] = bef; lcur[tid] = 0; }
    __syncthreads();
    if (tid == 0) { int row = 0;
        for (int e = 0; e < NE; ++e) { const int cnt = ptot[e], nt = (cnt + 255) >> 8; base[e] = row + pbef[e]; padb[e] = row + cnt; padb[32 + e] = row + nt * 256;
            if (bid == 0) { int* te = (int*)(p.ws + T_TILEE); for (int k = 0; k < nt; ++k) te[(row >> 8) + k] = e; }
            row += nt * 256; }
        if (bid == 0) *(int*)(p.ws + T_NT) = row >> 8; }
    __syncthreads();
    int* rowaid = (int*)(p.ws + T_ROWAID); float* roww = (float*)(p.ws + T_ROWW);
    if (tid < 256) { const int a = a_pre, e = e_pre;
        const int pos = base[e] + __hip_atomic_fetch_add(&lcur[e], 1, __ATOMIC_RELAXED, __HIP_MEMORY_SCOPE_WORKGROUP);
        posl[tid] = pos; rowaid[pos] = a; roww[pos] = w_pre; }
    if (bid < NE) for (int r = padb[bid] + tid; r < padb[32 + bid]; r += NTHR) { rowaid[r] = -1; roww[r] = 0.f; }
    __syncthreads();
    __syncthreads();
}
template <bool GATHER_>
struct MoeOrder {
    static constexpr bool GATHER = GATHER_;
    const int* tile_e; const int* rowaid; int nM, G, c;
    __device__ __forceinline__ int rowsrc(int row) const { const int a = rowaid[row]; return (a < 0 ? 0 : a) >> 1; }
    __device__ __forceinline__ bool next(int i, pg8::Unit& u) const {
        const int nwg = nM * 4; const long L = (long)i * G + c; if (L >= nwg) return false;
        int wgid = (int)L; { const int q = nwg / 8, r = nwg % 8, xcd = wgid % 8, off = wgid / 8; wgid = (xcd < r ? xcd * (q + 1) : r * (q + 1) + (xcd - r) * q) + off; }
        const int nig = 8 * 4, gid = wgid / nig, fm = gid * 8, gsz = (nM - fm) < 8 ? (nM - fm) : 8;
        u.pm = fm + ((wgid % nig) % gsz); u.pn = (wgid % nig) / gsz; u.pb = tile_e[u.pm] * 4 + u.pn; return true;
    }
    __device__ __forceinline__ void a_ready(const pg8::Unit&) const {}
    __device__ __forceinline__ void done(const pg8::Unit&) const {}
};
__device__ __forceinline__ float silu_fast(float x) { return x * __builtin_amdgcn_rcpf(1.0f + __builtin_amdgcn_exp2f(-1.4426950409f * x)); }
struct EpiH {
    static constexpr bool PERM = true, AFTER_DRAIN = false;
    bf16* H;
    __device__ __forceinline__ void operator()(const f32x4 (&acc)[2][2][4][2], const pg8::Unit& u, int wr, int wc, int fr, int fq) const {
        const int row0 = u.pm * 256 + wr * 64 + fr, col0 = u.pn * 128 + wc * 32 + 8 * fq;
#pragma unroll
        for (int ai = 0; ai < 2; ++ai)
#pragma unroll
            for (int m = 0; m < 4; ++m) { const f32x4 g0 = acc[ai][0][m][0], g1 = acc[ai][0][m][1], u0 = acc[ai][1][m][0], u1 = acc[ai][1][m][1];
                f32x4 h0, h1;
#pragma unroll
                for (int q = 0; q < 4; ++q) { h0[q] = silu_fast(g0[q]) * u0[q]; h1[q] = silu_fast(g1[q]) * u1[q]; }
                u32x4 w; w.x = pg8::cvt_pk_bf16(h0[0], h0[1]); w.y = pg8::cvt_pk_bf16(h0[2], h0[3]); w.z = pg8::cvt_pk_bf16(h1[0], h1[1]); w.w = pg8::cvt_pk_bf16(h1[2], h1[3]);
                *(u32x4*)(H + (size_t)(row0 + ai * 128 + m * 16) * EH + col0) = w; }
    }
};
struct EpiY {
    static constexpr bool PERM = true, AFTER_DRAIN = false;
    bf16* YB; const int* rowaid; const float* roww;
    __device__ __forceinline__ void operator()(const f32x4 (&acc)[2][2][4][2], const pg8::Unit& u, int wr, int wc, int fr, int fq) const {
        const int row0 = u.pm * 256 + wr * 64 + fr, col0 = u.pn * 256 + wc * 32 + 8 * fq;
#pragma unroll
        for (int ai = 0; ai < 2; ++ai)
#pragma unroll
            for (int m = 0; m < 4; ++m) { const int row = row0 + ai * 128 + m * 16; const int a = rowaid[row]; const float w = roww[row];
                if (a >= 0) {
#pragma unroll
                    for (int bj = 0; bj < 2; ++bj) { const f32x4 v0 = acc[ai][bj][m][0] * w, v1 = acc[ai][bj][m][1] * w;
                        u32x4 o; o.x = pg8::cvt_pk_bf16(v0[0], v0[1]); o.y = pg8::cvt_pk_bf16(v0[2], v0[3]); o.z = pg8::cvt_pk_bf16(v1[0], v1[1]); o.w = pg8::cvt_pk_bf16(v1[2], v1[3]);
                        *(u32x4*)(YB + (size_t)a * D + col0 + bj * 128) = o; } } }
    }
};
__device__ __forceinline__ void p11_final(PRef p, int bid, int nb) {
    const int tid_ = otid(), lane = tid_ & 63, wv = tid_ >> 6;
    const float* mod = (const float*)(p.ws + W_MOD); const bf16* YB = (const bf16*)p.out; const bf16* X1 = (const bf16*)(p.ws + W_X1B); float* out = p.out; const float* g = p.in[I_FNG];
#pragma unroll 1
    for (int gw = bid * 8 + wv; gw < NTOK / 16; gw += nb * 8) {
        const int b = gw >> 8, row0 = b * SEQ + (gw & 255);
        const float* gt = mod + b * 6 * D + 5 * D;
        f32x4 gv[4], fg[4];
#pragma unroll
        for (int j = 0; j < 4; ++j) { const int c0 = (lane + 64 * j) * 4; gv[j] = *(const f32x4*)(gt + c0); fg[j] = *(const f32x4*)(g + c0); }
        struct Ops { u32x2 xw[4], a[4], b[4]; };
        auto ld = [&](Ops& o, int s) __attribute__((always_inline)) { const size_t row = (size_t)(row0 + s * 256);
#pragma unroll
            for (int j = 0; j < 4; ++j) { const int c0 = (lane + 64 * j) * 4;
                o.xw[j] = *(const u32x2*)(X1 + row * D + c0); o.a[j] = *(const u32x2*)(YB + 2 * row * D + c0); o.b[j] = *(const u32x2*)(YB + (2 * row + 1) * D + c0); } };
        auto proc = [&](const Ops& o, int s) __attribute__((always_inline)) { const size_t row = (size_t)(row0 + s * 256);
            f32x4 v[4]; float sq = 0.f;
#pragma unroll
            for (int j = 0; j < 4; ++j) { const u32x2 xw = o.xw[j], a = o.a[j], bb = o.b[j];
                const f32x4 xv = {bflo(xw.x), bfhi(xw.x), bflo(xw.y), bfhi(xw.y)};
                const f32x4 y = {bflo(a.x) + bflo(bb.x), bfhi(a.x) + bfhi(bb.x), bflo(a.y) + bflo(bb.y), bfhi(a.y) + bfhi(bb.y)};
                v[j] = xv + gv[j] * y; sq += (v[j][0] * v[j][0] + v[j][1] * v[j][1]) + (v[j][2] * v[j][2] + v[j][3] * v[j][3]); }
            const float r = rsqrtf(wave_sum_dpp(sq) * (1.0f / D) + 1e-6f);
#pragma unroll
            for (int j = 0; j < 4; ++j) { const int c0 = (lane + 64 * j) * 4; *(f32x4*)(out + row * D + c0) = v[j] * r * fg[j]; } };
        Ops oa, ob; ld(oa, 0);
#pragma unroll 1
        for (int s = 0; s < 16; s += 2) { ld(ob, s + 1); proc(oa, s); ld(oa, s + 2 < 16 ? s + 2 : 15); proc(ob, s + 1); }
    }
}
constexpr int PM_PB = 144, PM_MAT = 64 * PM_PB;
enum { PM_AT = 0, PM_RT, PM_BT, PM_KT, PM_VT, PM_BPT, PM_KPT, PM_AAK, PM_ARB, PM_ARK, PM_W1T, PM_U2T, PM_NMAT };
constexpr int PM_AAB = PM_NMAT * PM_MAT, PM_P = PM_AAB + 16384, PM_TOT = PM_P + 16384, PM_G = PM_TOT + 2048, PM_AABB = PM_G + 256, PM_XS = PM_AABB + PM_MAT, PM_END = PM_XS + 8192;
static_assert(PM_END <= LDS_BYTES, "pass-A LDS map");
#ifndef PMPROBE
#define PMPROBE -1
#endif
struct PmRaw { float zr[9], zk[9], zv[9], lw[8], as[8], par[6]; unsigned long long tacc, tlast; };
#define PMT(k) do { if (PMPROBE >= 0) { const unsigned long long n_ = __builtin_amdgcn_s_memrealtime(); if ((k) == PMPROBE) R.tacc += n_ - R.tlast; R.tlast = n_; } } while (0)
__device__ __forceinline__ void p5m_load(PRef p, PmRaw& R, int q, int wave, int lane) {
    const int seq = q / NCH, c = q % NCH, b = seq >> 3, h = seq & 7, tg = b * SEQ + c * SCL + wave * 8, hc = h * 64 + lane;
    const bf16* Z = (const bf16*)(p.ws + W_Z); const bf16* LO = (const bf16*)(p.ws + W_LO);
    const float pm = (wave == 0 && c == 0) ? 0.f : 1.f;
    const bf16* zp0 = Z + (size_t)(tg - (pm != 0.f ? 1 : 0)) * ZLD + 1024 + hc;
    R.zr[0] = bf2f(zp0[0]) * pm; R.zk[0] = bf2f(zp0[512]) * pm; R.zv[0] = bf2f(zp0[1024]) * pm;
#pragma unroll
    for (int s = 0; s < 8; ++s) { const bf16* zp = Z + (size_t)(tg + s) * ZLD + 1024 + hc; const bf16* lp = LO + (size_t)(tg + s) * 1536 + hc;
        R.zr[s + 1] = bf2f(zp[0]); R.zk[s + 1] = bf2f(zp[512]); R.zv[s + 1] = bf2f(zp[1024]); R.lw[s] = bf2f(lp[0]); R.as[s] = bf2f(lp[512]); }
    R.par[0] = p.in[I_MU][hc]; R.par[1] = p.in[I_MU][512 + hc]; R.par[2] = p.in[I_MU][1024 + hc]; R.par[3] = p.in[I_KK][hc]; R.par[4] = p.in[I_KA][hc]; R.par[5] = p.in[I_RK][hc];
}
template <bool ISW1>
__device__ __forceinline__ void p5m_solve(LAS unsigned char* lds, int wave, int lane) {
    typedef short bf16x8 __attribute__((ext_vector_type(8)));
    const int fr = lane & 15, fq = lane >> 4;
#define PMAT(i) (lds + (i) * PM_MAT)
#define PFRAG(mat, row, ks) (*(const LAS bf16x8*)((mat) + (row) * PM_PB + ((ks) * 32 + fq * 8) * 2))

        const int colb = (wave & 3) * 16, cl = lane >> 2, part = lane & 3, col = colb + cl;
        if constexpr (!ISW1) {
            const bf16x8 vb0 = PFRAG(PMAT(PM_VT), colb + fr, 0), vb1 = PFRAG(PMAT(PM_VT), colb + fr, 1);
#pragma unroll
            for (int tt = 0; tt < 4; ++tt) { f32x4 acc = {0.f, 0.f, 0.f, 0.f};
                acc = __builtin_amdgcn_mfma_f32_16x16x32_bf16(PFRAG(PMAT(PM_AAK), tt * 16 + fr, 0), vb0, acc, 0, 0, 0);
                acc = __builtin_amdgcn_mfma_f32_16x16x32_bf16(PFRAG(PMAT(PM_AAK), tt * 16 + fr, 1), vb1, acc, 0, 0, 0);
#pragma unroll
                for (int rg = 0; rg < 4; ++rg) *(LAS float*)(lds + PM_P + ((tt * 16 + 4 * fq + rg) * 64 + colb + fr) * 4) = acc[rg]; }
            asm volatile("s_waitcnt lgkmcnt(0)" ::: "memory");
        }
        LAS unsigned char* XT = PMAT(ISW1 ? PM_W1T : PM_U2T);
        { const u32x4 z = {0u, 0u, 0u, 0u}; LAS unsigned char* zp = XT + (colb + (lane >> 2)) * PM_PB + (lane & 3) * 32; *(LAS u32x4*)zp = z; *(LAS u32x4*)(zp + 16) = z; }
        LAS float* xs = (LAS float*)(lds + PM_XS + wave * 1024);
        const LAS unsigned char* arow = lds + PM_AAB + part * 64;
#pragma unroll
        for (int I = 0; I < 4; ++I) {
            f32x4 a4[16]; float rhv[16], cf[4][6]; bf16x8 af0, af1;
#pragma unroll
            for (int tl = 0; tl < 16; ++tl) { const int t = 16 * I + tl;
                if ((tl >> 2) > 0) a4[tl] = *(const LAS f32x4*)(arow + t * 256 + I * 16);
                rhv[tl] = ISW1 ? bf2f(*(const LAS bf16*)(PMAT(PM_AT) + t * PM_PB + col * 2)) : *(const LAS float*)(lds + PM_P + (t * 64 + col) * 4); }
#pragma unroll
            for (int gp = 0; gp < 4; ++gp) { const int tq = 16 * I + 4 * gp; const LAS unsigned char* cb = lds + PM_AAB + (4 * I + gp) * 4;
                cf[gp][0] = *(const LAS float*)(cb + (tq + 1) * 256); cf[gp][1] = *(const LAS float*)(cb + (tq + 2) * 256); cf[gp][2] = *(const LAS float*)(cb + (tq + 2) * 256 + 64);
                cf[gp][3] = *(const LAS float*)(cb + (tq + 3) * 256); cf[gp][4] = *(const LAS float*)(cb + (tq + 3) * 256 + 64); cf[gp][5] = *(const LAS float*)(cb + (tq + 3) * 256 + 128); }
            if (I > 0) { af0 = *(const LAS bf16x8*)(lds + PM_AABB + (16 * I + fr) * PM_PB + (fq * 8) * 2); if (I == 3) af1 = *(const LAS bf16x8*)(lds + PM_AABB + (16 * I + fr) * PM_PB + (32 + fq * 8) * 2); }
            f32x4 cr[4];
#pragma unroll
            for (int gp = 0; gp < 4; ++gp) cr[gp] = (f32x4){0.f, 0.f, 0.f, 0.f};
            if (I > 0) {
                f32x4 acc = {0.f, 0.f, 0.f, 0.f};
                acc = __builtin_amdgcn_mfma_f32_16x16x32_bf16(af0, *(const LAS bf16x8*)(XT + (colb + fr) * PM_PB + (fq * 8) * 2), acc, 0, 0, 0);
                if (I == 3) acc = __builtin_amdgcn_mfma_f32_16x16x32_bf16(af1, *(const LAS bf16x8*)(XT + (colb + fr) * PM_PB + (32 + fq * 8) * 2), acc, 0, 0, 0);
                *(LAS f32x4*)(xs + fr * 16 + 4 * fq) = acc;
                asm volatile("s_waitcnt lgkmcnt(0)" ::: "memory");
#pragma unroll
                for (int gp = 0; gp < 4; ++gp) cr[gp] = *(const LAS f32x4*)(xs + cl * 16 + 4 * gp);
            }
            float Xq[4];
#pragma unroll
            for (int gp = 0; gp < 4; ++gp) {
                const int tq = 16 * I + 4 * gp;
                float sm[4];
#pragma unroll
                for (int r = 0; r < 4; ++r) { float s = 0.f;
#pragma unroll
                    for (int i = 0; i < 4; ++i) if (i < gp) s = fmaf(a4[4 * gp + r][i], Xq[i], s);
                    sm[r] = s; }
                if (gp > 0) {
#pragma unroll
                    for (int r = 0; r < 4; ++r) { DPP_ADD(sm[r], 0xB1); DPP_ADD(sm[r], 0x4E); } }
                const float x0 = rhv[4 * gp] + cr[gp][0] + sm[0];
                const float x1 = fmaf(cf[gp][0], x0, rhv[4 * gp + 1] + cr[gp][1] + sm[1]);
                const float x2 = fmaf(cf[gp][2], x1, fmaf(cf[gp][1], x0, rhv[4 * gp + 2] + cr[gp][2] + sm[2]));
                const float x3 = fmaf(cf[gp][5], x2, fmaf(cf[gp][4], x1, fmaf(cf[gp][3], x0, rhv[4 * gp + 3] + cr[gp][3] + sm[3])));
                { float y0 = x0, y1 = x1, y2 = x2, y3 = x3;
                  asm volatile("" : "+v"(y0), "+v"(y1), "+v"(y2), "+v"(y3));
                  const float lo_ = (part & 1) ? y1 : y0, hi_ = (part & 1) ? y3 : y2;
                  Xq[gp] = (part & 2) ? hi_ : lo_; }
                *(LAS bf16*)(XT + col * PM_PB + (tq + part) * 2) = (bf16)(pg8::cvt_pk_bf16(Xq[gp], 0.f) & 0xffffu);
            }
        }

#undef PMAT
#undef PFRAG
}
#define PM_BAR() do { asm volatile("s_waitcnt lgkmcnt(0)" ::: "memory"); __builtin_amdgcn_s_barrier(); asm volatile("" ::: "memory"); } while (0)
__device__ __forceinline__ void p5m_chunk(PRef p, LAS unsigned char* lds, int q, int qnext, PmRaw& R) {
    typedef short bf16x8 __attribute__((ext_vector_type(8)));
    const int tid = otid(), lane = tid & 63, wave = __builtin_amdgcn_readfirstlane(tid >> 6), fr = lane & 15, fq = lane >> 4;
    const int seq = q / NCH, c = q % NCH, b = seq >> 3, h = seq & 7, tb = b * SEQ + c * SCL, hc = h * 64 + lane;
#define PMAT(i) (lds + (i) * PM_MAT)
#define PFRAG(mat, row, ks) (*(const LAS bf16x8*)((mat) + (row) * PM_PB + ((ks) * 32 + fq * 8) * 2))
    if (PMPROBE >= 0) R.tlast = __builtin_amdgcn_s_memrealtime();
#ifndef PM_DUP
#define PM_DUP 0
#endif
#pragma unroll 1
    for (int d0 = 0; d0 < ((PM_DUP >> 3) & 1) + 1; ++d0) { if (d0) PM_BAR();
        const int t8 = wave * 8, tg = tb + t8;
        float (&zr)[9] = R.zr; float (&zk)[9] = R.zk; float (&zv)[9] = R.zv; float (&lw)[8] = R.lw; float (&as)[8] = R.as;
        float cl[8]; { float run = 0.f;
#pragma unroll
          for (int s = 0; s < 8; ++s) { run += lw[s]; cl[s] = run; } }
        *(LAS float*)(lds + PM_TOT + (wave * 64 + lane) * 4) = cl[7];
        PM_BAR();
        float off = 0.f, lcL = 0.f;
#pragma unroll
        for (int w = 0; w < 8; ++w) { const float tv = *(const LAS float*)(lds + PM_TOT + (w * 64 + lane) * 4); lcL += tv; off += (w < wave) ? tv : 0.f; }
        if (wave == 0) *(LAS float*)(lds + PM_G + lane * 4) = __builtin_amdgcn_exp2f(1.4426950409f * lcL);
        const float mur = R.par[0], muk = R.par[1], muv = R.par[2], kkc = R.par[3], kac = R.par[4], rkc = R.par[5];
        bf16* VLo = (bf16*)(p.ws + W_YCAT); float* RKo = (float*)(p.ws + T_RK);
        unsigned pv[4], pbp[4], pkp[4]; float rkv = 0.f;
#pragma unroll
        for (int s = 0; s < 8; ++s) {
            const float r = zr[s + 1] + (zr[s] - zr[s + 1]) * mur, k = zk[s + 1] + (zk[s] - zk[s + 1]) * muk, v = zv[s + 1] + (zv[s] - zv[s + 1]) * muv;
            const float kkv = k * kkc;
            const float kk = kkv * rsqrtf(fmaxf(wave_sum_dpp(kkv * kkv), 1e-24f));
            const float k2 = k * (1.0f + (as[s] - 1.0f) * kac);
            const float rk = wave_sum_dpp(r * k2 * rkc);
            const float bb = kk * as[s];
            const float lc = off + cl[s], lcp = lc - lw[s];
            const float e_lc = __builtin_amdgcn_exp2f(1.4426950409f * lc), e_lcp = __builtin_amdgcn_exp2f(1.4426950409f * lcp);
            const float e_nlc = __builtin_amdgcn_exp2f(-1.4426950409f * lc), e_l = __builtin_amdgcn_exp2f(1.4426950409f * (lcL - lc));
            const int t = t8 + s;
            { const unsigned w0 = pg8::cvt_pk_bf16(-kk * e_lcp, r * e_lc), w1 = pg8::cvt_pk_bf16(bb * e_nlc, k2 * e_nlc);
              *(LAS bf16*)(PMAT(PM_AT) + t * PM_PB + lane * 2) = (bf16)(w0 & 0xffffu); *(LAS bf16*)(PMAT(PM_RT) + t * PM_PB + lane * 2) = (bf16)(w0 >> 16);
              *(LAS bf16*)(PMAT(PM_BT) + t * PM_PB + lane * 2) = (bf16)(w1 & 0xffffu); *(LAS bf16*)(PMAT(PM_KT) + t * PM_PB + lane * 2) = (bf16)(w1 >> 16); }
            const unsigned w2 = pg8::cvt_pk_bf16(v, bb * e_l);
            const unsigned vb = w2 & 0xffffu, bpb = w2 >> 16, kpb = pg8::cvt_pk_bf16(k2 * e_l, 0.f) & 0xffffu;
            if (s & 1) { pv[s >> 1] |= vb << 16; pbp[s >> 1] |= bpb << 16; pkp[s >> 1] |= kpb << 16; } else { pv[s >> 1] = vb; pbp[s >> 1] = bpb; pkp[s >> 1] = kpb; }
            VLo[(unsigned)((tg + s) * 1024 + 512 + hc)] = (bf16)vb;
            rkv = (lane == s) ? rk : rkv;
        }
        if (lane < 8) RKo[(unsigned)((tg + lane) * 8 + h)] = rkv;
        *(LAS u32x4*)(PMAT(PM_VT) + lane * PM_PB + wave * 16) = (u32x4){pv[0], pv[1], pv[2], pv[3]};
        *(LAS u32x4*)(PMAT(PM_BPT) + lane * PM_PB + wave * 16) = (u32x4){pbp[0], pbp[1], pbp[2], pbp[3]};
        *(LAS u32x4*)(PMAT(PM_KPT) + lane * PM_PB + wave * 16) = (u32x4){pkp[0], pkp[1], pkp[2], pkp[3]};
    }
    if (qnext >= 0) p5m_load(p, R, qnext, wave, lane);
    PM_BAR(); PMT(0);
#pragma unroll 1
    for (int d1 = 0; d1 < ((PM_DUP >> 0) & 1) + 1; ++d1) {
        const int pp = wave >> 1, half = wave & 1;
        const LAS unsigned char* Xm = PMAT(pp < 2 ? PM_AT : PM_RT);
        const LAS unsigned char* Ym = PMAT((pp & 1) ? PM_KT : PM_BT);
#pragma unroll
        for (int ti = 0; ti < 2; ++ti) {
            const int tt = half ? (1 + ti) : (3 * ti);
            const bf16x8 xb0 = PFRAG(Xm, tt * 16 + fr, 0), xb1 = PFRAG(Xm, tt * 16 + fr, 1);
            const int t = tt * 16 + fr;
#pragma unroll
            for (int jt = 0; jt < 4; ++jt) {
                f32x4 acc = {0.f, 0.f, 0.f, 0.f};
                if (jt <= tt) { acc = __builtin_amdgcn_mfma_f32_16x16x32_bf16(PFRAG(Ym, jt * 16 + fr, 0), xb0, acc, 0, 0, 0);
                                acc = __builtin_amdgcn_mfma_f32_16x16x32_bf16(PFRAG(Ym, jt * 16 + fr, 1), xb1, acc, 0, 0, 0); }
                const int j0 = jt * 16 + 4 * fq;
#pragma unroll
                for (int rg = 0; rg < 4; ++rg) { const bool keep = (pp < 2) ? (j0 + rg < t) : (j0 + rg <= t); acc[rg] = keep ? acc[rg] : 0.f; }
                if (pp == 0) {
#pragma unroll
                    for (int rg = 0; rg < 4; ++rg) *(LAS float*)(lds + PM_AAB + (t * 64 + rg * 16 + jt * 4 + fq) * 4) = acc[rg];
                    { u32x2 w; w.x = pk2(acc[0], acc[1]); w.y = pk2(acc[2], acc[3]); *(LAS u32x2*)(lds + PM_AABB + t * PM_PB + j0 * 2) = w; }
                } else {
                    u32x2 w; w.x = pk2(acc[0], acc[1]); w.y = pk2(acc[2], acc[3]);
                    *(LAS u32x2*)(PMAT(PM_AAK + pp - 1) + t * PM_PB + j0 * 2) = w;
                }
            }
        }
    }
    PM_BAR(); PMT(1);
#pragma unroll 1
    for (int d2 = 0; d2 < ((PM_DUP >> 1) & 1) + 1; ++d2) {
        if (wave < 4) p5m_solve<true>(lds, wave, lane); else p5m_solve<false>(lds, wave, lane);
    }
    PM_BAR(); PMT(2);
#pragma unroll 1
    for (int d3 = 0; d3 < ((PM_DUP >> 2) & 1) + 1; ++d3) {
        float* Mo = (float*)((unsigned char*)p.out + O_M + (size_t)q * 16384); float* No = (float*)((unsigned char*)p.out + O_N + (size_t)q * 16384);
        bf16* Qo = (bf16*)(p.ws + W_Q); bf16* Y2o = (bf16*)(p.ws + W_Y2);
#pragma unroll
        for (int ti = 0; ti < 2; ++ti) {
            const int idx = wave * 2 + ti, rt = idx >> 2, ct = idx & 3;
            {
                f32x4 acc = {0.f, 0.f, 0.f, 0.f};
#pragma unroll
                for (int ks = 0; ks < 2; ++ks) acc = __builtin_amdgcn_mfma_f32_16x16x32_bf16(PFRAG(PMAT(PM_BPT), ct * 16 + fr, ks), PFRAG(PMAT(PM_W1T), rt * 16 + fr, ks), acc, 0, 0, 0);
                const int i = rt * 16 + fr, c0 = ct * 16 + 4 * fq;
#pragma unroll
                for (int rg = 0; rg < 4; ++rg) if (c0 + rg == i) acc[rg] += *(const LAS float*)(lds + PM_G + i * 4);
                *(f32x4*)(Mo + i * 64 + c0) = acc; }
            {
                f32x4 acc = {0.f, 0.f, 0.f, 0.f};
#pragma unroll
                for (int ks = 0; ks < 2; ++ks) { acc = __builtin_amdgcn_mfma_f32_16x16x32_bf16(PFRAG(PMAT(PM_BPT), ct * 16 + fr, ks), PFRAG(PMAT(PM_U2T), rt * 16 + fr, ks), acc, 0, 0, 0);
                                                  acc = __builtin_amdgcn_mfma_f32_16x16x32_bf16(PFRAG(PMAT(PM_KPT), ct * 16 + fr, ks), PFRAG(PMAT(PM_VT), rt * 16 + fr, ks), acc, 0, 0, 0); }
                *(f32x4*)(No + (rt * 16 + fr) * 64 + ct * 16 + 4 * fq) = acc; }
            {
                f32x4 acc = {0.f, 0.f, 0.f, 0.f};
#pragma unroll
                for (int ks = 0; ks < 2; ++ks) acc = __builtin_amdgcn_mfma_f32_16x16x32_bf16(PFRAG(PMAT(PM_W1T), ct * 16 + fr, ks), PFRAG(PMAT(PM_ARB), rt * 16 + fr, ks), acc, 0, 0, 0);
                const int t = rt * 16 + fr, i0 = ct * 16 + 4 * fq;
                const u32x2 rw = *(const LAS u32x2*)(PMAT(PM_RT) + t * PM_PB + i0 * 2);
                u32x2 o; o.x = pk2(acc[0] + bflo(rw.x), acc[1] + bfhi(rw.x)); o.y = pk2(acc[2] + bflo(rw.y), acc[3] + bfhi(rw.y));
                *(u32x2*)(Qo + (unsigned)((tb + t) * 512 + h * 64 + i0)) = o; }
            {
                f32x4 acc = {0.f, 0.f, 0.f, 0.f};
#pragma unroll
                for (int ks = 0; ks < 2; ++ks) { acc = __builtin_amdgcn_mfma_f32_16x16x32_bf16(PFRAG(PMAT(PM_U2T), ct * 16 + fr, ks), PFRAG(PMAT(PM_ARB), rt * 16 + fr, ks), acc, 0, 0, 0);
                                                  acc = __builtin_amdgcn_mfma_f32_16x16x32_bf16(PFRAG(PMAT(PM_VT), ct * 16 + fr, ks), PFRAG(PMAT(PM_ARK), rt * 16 + fr, ks), acc, 0, 0, 0); }
                const int t = rt * 16 + fr, v0 = ct * 16 + 4 * fq;
                u32x2 o; o.x = pk2(acc[0], acc[1]); o.y = pk2(acc[2], acc[3]);
                *(u32x2*)(Y2o + (unsigned)((tb + t) * 512 + h * 64 + v0)) = o; }
        }
    }
    PM_BAR(); PMT(3);
#undef PMAT
#undef PFRAG
}

__device__ __forceinline__ void p5m_run(PRef p, LAS unsigned char* lds, int bid, int nb) {
    const int tid = otid(), lane = tid & 63, wave = __builtin_amdgcn_readfirstlane(tid >> 6);
    PmRaw R; R.tacc = 0; R.tlast = 0;
    if (bid < BATCH * 8 * NCH) p5m_load(p, R, bid, wave, lane);
#pragma unroll 1
    for (int q = bid; q < BATCH * 8 * NCH; q += nb) p5m_chunk(p, lds, q, (q + nb < BATCH * 8 * NCH) ? q + nb : -1, R);
    if (PMPROBE >= 0 && bid == 0 && tid == 0) { const unsigned long long t0_ = __builtin_amdgcn_s_memrealtime(), w_ = R.tacc * 4ull; while (__builtin_amdgcn_s_memrealtime() - t0_ < w_) __builtin_amdgcn_s_sleep(8); }
}
constexpr int R7_WP = 1040, R7_WSZ = 48 * R7_WP, R7_AP = 144, R7_ASZ = 16 * R7_AP;
constexpr int R7_WAVE0 = 2 * R7_WSZ, R7_WAVESZ = 2 * R7_ASZ + 3072, R7_HIST = R7_WAVE0 + 8 * R7_WAVESZ;
static_assert(R7_HIST + 256 <= LDS_BYTES, "router LDS map");
struct R7Ops { u32x4 xa, xb; f32x4 av[4], sv[4]; };
__device__ __forceinline__ void r7_load(R7Ops& o, const bf16* xrow, const float* ra, const float* sh, int k0) {
    o.xa = *(const u32x4*)(xrow + k0); o.xb = *(const u32x4*)(xrow + k0 + 8);
#pragma unroll
    for (int i = 0; i < 4; ++i) { o.av[i] = *(const f32x4*)(ra + k0 + i * 4); o.sv[i] = *(const f32x4*)(sh + k0 + i * 4); }
}
__device__ __forceinline__ void p7m_route(PRef p, LAS unsigned char* lds, int bid) {
    typedef short bf16x8 __attribute__((ext_vector_type(8)));
    const int tid = otid(), lane = tid & 63, wave = __builtin_amdgcn_readfirstlane(tid >> 6), fr = lane & 15, fq = lane >> 4;
    const int tok = lane >> 2, sub = lane & 3;
    const bf16* x1 = (const bf16*)(p.ws + W_X1B); bf16* H2 = (bf16*)(p.ws + W_H2);
    LAS int* hist = (LAS int*)(lds + R7_HIST);
    const int b = (bid * TPW) / SEQ, t0 = bid * TPW + wave * 16;
    const float* sh = (const float*)(p.ws + W_MOD) + b * 6 * D + 3 * D + sub * 16;
    const float* ra = (const float*)(p.ws + W_RA) + b * D + sub * 16;
    LAS unsigned char* Ahi = lds + R7_WAVE0 + wave * R7_WAVESZ; LAS unsigned char* Alo = Ahi + R7_ASZ; LAS float* Lw = (LAS float*)(Alo + R7_ASZ);
    if (tid < 32) hist[tid] = 0;
    constexpr int WCH = 2 * R7_WSZ / 16, WTR = (WCH + NTHR - 1) / NTHR;
    u32x4 wreg[WTR];
    { const u32x4* gi = (const u32x4*)(p.ws + W_RW);
#pragma unroll
      for (int i = 0; i < WTR; ++i) { const int c = tid + i * NTHR; wreg[i] = gi[c < WCH ? c : WCH - 1]; } }
    const bf16* xrow = x1 + (size_t)(t0 + tok) * D + sub * 16;
    float ss = 0.f;
    { u32x4 v[32];
#pragma unroll
      for (int s = 0; s < 16; ++s) { v[s * 2] = *(const u32x4*)(xrow + s * 64); v[s * 2 + 1] = *(const u32x4*)(xrow + s * 64 + 8); }
#pragma unroll
      for (int i = 0; i < 32; ++i)
#pragma unroll
          for (int q = 0; q < 4; ++q) { const float a = bflo(v[i][q]), bq = bfhi(v[i][q]); ss = fmaf(a, a, fmaf(bq, bq, ss)); } }
    DPP_ADD(ss, 0xB1); DPP_ADD(ss, 0x4E);
    const float r = rsqrtf(ss * (1.0f / D) + 1e-6f);
    f32x4 acc[3];
    { const float b0 = fr < 4 ? p.in[I_RGB][fr & 3] : p.in[I_REB][fr >= 4 ? fr - 4 : 0], b1 = p.in[I_REB][12 + fr], b2 = fr < 4 ? p.in[I_REB][28 + (fr & 3)] : 0.f;
      acc[0] = (f32x4){b0, b0, b0, b0}; acc[1] = (f32x4){b1, b1, b1, b1}; acc[2] = (f32x4){b2, b2, b2, b2}; }
    R7Ops oa, ob; r7_load(oa, xrow, ra, sh, 0);
    bf16* hrow0 = H2 + (size_t)(t0 + tok) * D + sub * 16;
    auto slice = [&](const R7Ops& cur, int gs) __attribute__((always_inline)) {
        const int k0 = gs * 64, sl = gs & 7;
        f32x4 xv[4];
        { const u32x4 xa = cur.xa, xb = cur.xb;
          xv[0] = (f32x4){bflo(xa.x), bfhi(xa.x), bflo(xa.y), bfhi(xa.y)}; xv[1] = (f32x4){bflo(xa.z), bfhi(xa.z), bflo(xa.w), bfhi(xa.w)};
          xv[2] = (f32x4){bflo(xb.x), bfhi(xb.x), bflo(xb.y), bfhi(xb.y)}; xv[3] = (f32x4){bflo(xb.z), bfhi(xb.z), bflo(xb.w), bfhi(xb.w)}; }
        unsigned hi[8], lo[8];
#pragma unroll
        for (int i = 0; i < 4; ++i)
#pragma unroll
            for (int j = 0; j < 4; j += 2) { const float h0 = xv[i][j] * r * cur.av[i][j] + cur.sv[i][j], h1 = xv[i][j + 1] * r * cur.av[i][j + 1] + cur.sv[i][j + 1];
                const unsigned a0 = f2bf(h0), a1 = f2bf(h1); hi[i * 2 + (j >> 1)] = a0 | (a1 << 16); lo[i * 2 + (j >> 1)] = f2bf(h0 - bflo(a0)) | (f2bf(h1 - bflo(a1)) << 16); }
        bf16* hrow = hrow0 + k0;
        *(u32x4*)hrow = (u32x4){hi[0], hi[1], hi[2], hi[3]}; *(u32x4*)(hrow + 8) = (u32x4){hi[4], hi[5], hi[6], hi[7]};
        *(LAS u32x4*)(Ahi + tok * R7_AP + sub * 32) = (u32x4){hi[0], hi[1], hi[2], hi[3]}; *(LAS u32x4*)(Ahi + tok * R7_AP + sub * 32 + 16) = (u32x4){hi[4], hi[5], hi[6], hi[7]};
        *(LAS u32x4*)(Alo + tok * R7_AP + sub * 32) = (u32x4){lo[0], lo[1], lo[2], lo[3]}; *(LAS u32x4*)(Alo + tok * R7_AP + sub * 32 + 16) = (u32x4){lo[4], lo[5], lo[6], lo[7]};
        asm volatile("s_waitcnt lgkmcnt(0)" ::: "memory");
#pragma unroll
        for (int ks = 0; ks < 2; ++ks) {
            const bf16x8 ah = *(const LAS bf16x8*)(Ahi + fr * R7_AP + (ks * 32 + fq * 8) * 2), al = *(const LAS bf16x8*)(Alo + fr * R7_AP + (ks * 32 + fq * 8) * 2);
#pragma unroll
            for (int qt = 0; qt < 3; ++qt) { const int wo = (qt * 16 + fr) * R7_WP + (sl * 64 + ks * 32 + fq * 8) * 2;
                const bf16x8 bh = *(const LAS bf16x8*)(lds + wo), bl = *(const LAS bf16x8*)(lds + R7_WSZ + wo);
                acc[qt] = __builtin_amdgcn_mfma_f32_16x16x32_bf16(ah, bh, acc[qt], 0, 0, 0);
                acc[qt] = __builtin_amdgcn_mfma_f32_16x16x32_bf16(al, bh, acc[qt], 0, 0, 0);
                acc[qt] = __builtin_amdgcn_mfma_f32_16x16x32_bf16(ah, bl, acc[qt], 0, 0, 0); } }
        asm volatile("s_waitcnt lgkmcnt(0)" ::: "memory");
    };
#pragma unroll 1
    for (int kh = 0; kh < 2; ++kh) {
        __syncthreads();
#pragma unroll
        for (int i = 0; i < WTR; ++i) { const int c = tid + i * NTHR; if (c < WCH) *(LAS u32x4*)(lds + c * 16) = wreg[i]; }
        if (kh == 0) {
            const u32x4* gi = (const u32x4*)(p.ws + W_RW) + WCH;
#pragma unroll
            for (int i = 0; i < WTR; ++i) { const int c = tid + i * NTHR; wreg[i] = gi[c < WCH ? c : WCH - 1]; } }
        __syncthreads();
#pragma unroll 1
        for (int sl = 0; sl < 8; sl += 2) {
            const int gs = kh * 8 + sl;
            r7_load(ob, xrow, ra, sh, (gs + 1) * 64);
            slice(oa, gs);
            r7_load(oa, xrow, ra, sh, (gs + 2 < 16 ? gs + 2 : 15) * 64);
            slice(ob, gs + 1);
        }
    }
#pragma unroll
    for (int qt = 0; qt < 3; ++qt)
#pragma unroll
        for (int rg = 0; rg < 4; ++rg) Lw[(4 * fq + rg) * 48 + qt * 16 + fr] = acc[qt][rg];
    asm volatile("s_waitcnt lgkmcnt(0)" ::: "memory");
    if (lane < 16) {
        const LAS float* lg = Lw + lane * 48;
        int gi = 0; float gm = lg[0];
#pragma unroll
        for (int q = 1; q < 4; ++q) { const float v = lg[q]; if (v > gm) { gm = v; gi = q; } }
        float gsum = 0.f;
#pragma unroll
        for (int q = 0; q < 4; ++q) gsum += expf(lg[q] - gm);
        const float gp = 1.0f / gsum;
        const LAS float* el = lg + 4 + gi * 8;
        int i0 = 0; float m0 = el[0];
#pragma unroll
        for (int q = 1; q < 8; ++q) { const float v = el[q]; if (v > m0) { m0 = v; i0 = q; } }
        int i1 = -1; float m1 = -3.0e38f;
#pragma unroll
        for (int q = 0; q < 8; ++q) { const float v = el[q]; if (q != i0 && v > m1) { m1 = v; i1 = q; } }
        const float p1 = expf(m1 - m0);
        const float w0 = gp / (1.0f + p1), w1 = gp * p1 / (1.0f + p1);
        const int t = t0 + lane, e0 = gi * 8 + i0, e1 = gi * 8 + i1;
        int* toke = (int*)(p.ws + T_TOKE); float* tokw = (float*)(p.ws + T_TOKW);
        toke[t * 2] = e0; toke[t * 2 + 1] = e1; tokw[t * 2] = w0; tokw[t * 2 + 1] = w1;
        __hip_atomic_fetch_add(&hist[e0], 1, __ATOMIC_RELAXED, __HIP_MEMORY_SCOPE_WORKGROUP); __hip_atomic_fetch_add(&hist[e1], 1, __ATOMIC_RELAXED, __HIP_MEMORY_SCOPE_WORKGROUP);
    }
    __syncthreads();
    if (tid < 32) ((int*)(p.ws + T_HIST))[bid * 32 + tid] = hist[tid];
    __syncthreads();
}
constexpr int PB_PITCH = 68;
constexpr int PB_ML = 0, PB_SL = 64 * PB_PITCH * 4, PB_NL = PB_SL + 16 * PB_PITCH * 4, PB_IMG = PB_NL + 16 * PB_PITCH * 4;
__device__ __forceinline__ void p5b_chain_mfma(PRef p, LAS unsigned char* lds, int item) {
    const int tid = otid(), lane = tid & 63, wave = __builtin_amdgcn_readfirstlane(tid >> 6), fr = lane & 15, fq = lane >> 4;
    const int seq = (item & 7) + 8 * (item >> 5), rg = (item >> 3) & 3;
    const bool mm = wave < 4; const int ct = wave & 3, t2 = tid & 255, nrow = t2 >> 4, ncol = (t2 & 15) * 4;
    const unsigned char* Mb = (const unsigned char*)p.out + O_M + (size_t)seq * NCH * 16384;
    const unsigned char* Nb = (const unsigned char*)p.out + O_N + (size_t)seq * NCH * 16384 + (size_t)((rg * 16 + nrow) * 64 + ncol) * 4;
    unsigned char* Sb = p.ws + W_S + (size_t)seq * NCH * 8192 + (size_t)((rg * 16 + nrow) * 64 + ncol) * 2;
    const int mrow = tid >> 4, mcol = (tid & 15) * 4;
    f32x4 acc = {0.f, 0.f, 0.f, 0.f};
    float tv[32]; TrItem citem = TrItem{nullptr, nullptr, 0, 0, 0, 0}, bitem = citem;
    LAS float* cscr = (LAS float*)(lds + 2 * PB_IMG + (wave & 3) * 8704);
    const int gcw = item * 4 + (wave & 3);
#define PBM_CONV(cc) do { if (!mm && (cc) < (CONV_J0 / 3) * 8) { const int ph_ = (cc) & 7, i3_ = ((cc) >> 3) * 3; \
          \
        if (ph_ == 2 || ph_ == 4 || ph_ == 6) { p0_tr_store_half(citem, tv, cscr, lane, 0); bitem = citem; } \
        if (ph_ == 3 || ph_ == 5 || ph_ == 7) p0_tr_store_half(bitem, tv, cscr, lane, 1); \
        if (ph_ == 0 || ph_ == 2 || ph_ == 4) { citem = moe_item(p, gcw + (i3_ + (ph_ >> 1)) * (MOE_ITEMS / 24)); p0_tr_load(citem, tv, lane); } } } while (0)
    f32x4 m0[2], m1[2], m2[2], m3[2], n0, n1, n2, n3;
#define PBM_LOAD(mmr, nn, cc) do { const f32x4* mp = (const f32x4*)(Mb + (size_t)(cc) * 16384) + tid; mmr[0] = mp[0]; mmr[1] = mp[512]; if (!mm) nn = *(const f32x4*)(Nb + (size_t)(cc) * 16384); } while (0)
#define PBM_STEP(mmr, nn, cc) do { \
        LAS unsigned char* img = lds + ((cc) & 1) * PB_IMG; \
        *(LAS f32x4*)(img + PB_ML + (mrow * PB_PITCH + mcol) * 4) = mmr[0]; *(LAS f32x4*)(img + PB_ML + ((mrow + 32) * PB_PITCH + mcol) * 4) = mmr[1]; \
        if (mm) { _Pragma("unroll") for (int rg_ = 0; rg_ < 4; ++rg_) *(LAS float*)(img + PB_SL + ((4 * fq + rg_) * PB_PITCH + ct * 16 + fr) * 4) = acc[rg_]; } \
        else *(LAS f32x4*)(img + PB_NL + (nrow * PB_PITCH + ncol) * 4) = nn; \
        asm volatile("s_waitcnt lgkmcnt(0)" ::: "memory"); __builtin_amdgcn_s_barrier(); asm volatile("" ::: "memory"); \
        if ((cc) + 4 < NCH) PBM_LOAD(mmr, nn, (cc) + 4); \
        if (mm) { \
            _Pragma("unroll") for (int rg_ = 0; rg_ < 4; ++rg_) acc[rg_] = *(const LAS float*)(img + PB_NL + ((4 * fq + rg_) * PB_PITCH + ct * 16 + fr) * 4); \
            _Pragma("unroll") for (int ks = 0; ks < 16; ++ks) { \
                const float a_ = *(const LAS float*)(img + PB_SL + (fr * PB_PITCH + ks * 4 + fq) * 4), b_ = *(const LAS float*)(img + PB_ML + ((ks * 4 + fq) * PB_PITCH + ct * 16 + fr) * 4); \
                acc = __builtin_amdgcn_mfma_f32_16x16x4f32(a_, b_, acc, 0, 0, 0); } \
        } else { const f32x4 sv = *(const LAS f32x4*)(img + PB_SL + (nrow * PB_PITCH + ncol) * 4); u32x2 sw_; sw_.x = pg8::cvt_pk_bf16(sv[0], sv[1]); sw_.y = pg8::cvt_pk_bf16(sv[2], sv[3]); *(u32x2*)(Sb + (size_t)(cc) * 8192) = sw_; } \
        PBM_CONV(cc); \
    } while (0)
    __syncthreads();
    PBM_LOAD(m0, n0, 0); PBM_LOAD(m1, n1, 1); PBM_LOAD(m2, n2, 2); PBM_LOAD(m3, n3, 3);
#pragma unroll 1
    for (int c = 0; c < NCH; c += 4) { PBM_STEP(m0, n0, c); PBM_STEP(m1, n1, c + 1); PBM_STEP(m2, n2, c + 2); PBM_STEP(m3, n3, c + 3); }
    __syncthreads();
#undef PBM_LOAD
#undef PBM_STEP
#undef PBM_CONV
}
__global__ void __launch_bounds__(NTHR, 2) k_mega(Params p_unused) {
    extern __shared__ __attribute__((aligned(16))) unsigned char lds_raw[];
    PPtr kp = (PPtr)__builtin_amdgcn_kernarg_segment_ptr();
#define p (*opq(kp))
    cg::grid_group grid = cg::this_grid();
    const int bid = blockIdx.x, nb = gridDim.x;
    LAS unsigned char* lds = (LAS unsigned char*)lds_raw;
    volatile LAS unsigned* bst = (volatile LAS unsigned*)(lds + LDS_BYTES - 64);
    if (otid() < 2) bst[otid()] = 0u;
    __syncthreads();
    XcdBarrier xb = xcd_barrier_post((unsigned*)(p.ws + T_BAR), bst);
#define GSYNC() xcd_barrier(xb)
    p0_prep<false>(p, lds, bid, nb); grid.sync();
#ifdef GS2PROBE
    grid.sync(); grid.sync(); grid.sync(); grid.sync();
#endif
    p1_h1(p, bid, nb); GSYNC();
    { pg8::Gemm g{(const pg8::bf16_t*)(p.ws + W_H1), (const pg8::bf16_t*)(p.ws + W_WINT), NTOK, ZLD, D}; pg8::StaticOrder S; S.init(NTOK, ZLD, nb, bid);
      EpiZ E{(bf16*)(p.ws + W_Z)};
      pg8::gemm_phase<EpiZ, pg8::StaticOrder, true, true>(lds, g, S, E); }
    p2_conv_share(p, lds, bid, nb);
    GSYNC();
#pragma unroll 1
    for (int ch = bid; ch < NTOK / CHUNK; ch += nb) p3_gmlp_unit(p, lds, ch);
    p3_lorain(p, bid, nb);
    GSYNC();
    { int kop = 256; asm volatile("" : "+s"(kop));
      pg8::Gemm g{(const pg8::bf16_t*)(p.ws + W_A2), (const pg8::bf16_t*)(p.ws + W_LORAT), NTOK, 1536, kop}; pg8::StaticOrder S; S.init(NTOK, 1536, nb, bid);
      EpiLO E{(bf16*)(p.ws + W_LO), p.in[I_W0], p.in[I_A0]};
      pg8::gemm_phase<EpiLO, pg8::StaticOrder, true, true>(lds, g, S, E); }
    GSYNC();
    p5m_run(p, lds, bid, nb);
    GSYNC();
#pragma unroll 1
    for (int it = bid; it < BATCH * 8 * 4; it += nb) p5b_chain_mfma(p, lds, it);
    GSYNC();
#pragma unroll 1
    for (int q = bid * 8 + __builtin_amdgcn_readfirstlane(otid() >> 6); q < BATCH * 8 * NCH; q += nb * 8) p5c_chunk(p, lds, q);
    GSYNC();
    { pg8::Gemm g{(const pg8::bf16_t*)(p.ws + W_YCAT), (const pg8::bf16_t*)(p.ws + W_WOUTT), NTOK, D, D}; pg8::StaticOrder S; S.init(NTOK, D, nb, bid);
      EpiX1 E{p.in[I_X], (const float*)(p.ws + W_MOD), (bf16*)(p.ws + W_X1B)};
      pg8::gemm_phase<EpiX1, pg8::StaticOrder, true, true>(lds, g, S, E); }
    GSYNC();
    p7m_route(p, lds, bid); GSYNC();
    p8_place(p, lds, bid); GSYNC();
    { const int nM = *(const int*)(p.ws + T_NT);
      pg8::Gemm g{(const pg8::bf16_t*)(p.ws + W_H2), (const pg8::bf16_t*)(p.ws + W_WGUT), PROWS, 1024, D}; MoeOrder<true> S{(const int*)(p.ws + T_TILEE), (const int*)(p.ws + T_ROWAID), nM, nb, bid};
      EpiH E{(bf16*)(p.ws + W_HB)};
      pg8::gemm_phase<EpiH, MoeOrder<true>, true, true>(lds, g, S, E); }
    GSYNC();
    { const int nM = *(const int*)(p.ws + T_NT);
      pg8::Gemm g{(const pg8::bf16_t*)(p.ws + W_HB), (const pg8::bf16_t*)(p.ws + W_WDT), PROWS, 1024, EH}; MoeOrder<false> S{(const int*)(p.ws + T_TILEE), (const int*)(p.ws + T_ROWAID), nM, nb, bid};
      EpiY E{(bf16*)p.out, (const int*)(p.ws + T_ROWAID), (const float*)(p.ws + T_ROWW)};
      pg8::gemm_phase<EpiY, MoeOrder<false>, true, true>(lds, g, S, E); }
    GSYNC();
    p11_final(p, bid, nb);
#undef GSYNC
#undef p
}
extern "C" void kernel_launch(void* const* d_in, const int* in_sizes, int n_in, void* d_out, int out_size, void* d_ws, size_t ws_size, hipStream_t stream) {
    if (n_in != 31 || ws_size < WS_NEED || out_size != NTOK * D) { fprintf(stderr, "kernel_launch: unexpected sizes n_in %d ws %zu out %d\n", n_in, ws_size, out_size); return; }
    static int grid_blocks = 0;
    if (!grid_blocks) {
        int dev = 0, cus = 0, per_cu = 0;
        (void)hipGetDevice(&dev);
        (void)hipDeviceGetAttribute(&cus, hipDeviceAttributeMultiprocessorCount, dev);
        (void)hipFuncSetAttribute((const void*)k_mega, hipFuncAttributeMaxDynamicSharedMemorySize, LDS_BYTES);
        (void)hipOccupancyMaxActiveBlocksPerMultiprocessor(&per_cu, (const void*)k_mega, NTHR, LDS_BYTES);
        if (per_cu < 1) fprintf(stderr, "kernel_launch: occupancy query says %d blocks/CU\n", per_cu);
        grid_blocks = cus;
    }
    Params p{};
    for (int i = 0; i < 31; ++i) p.in[i] = (const float*)d_in[i];
    p.out = (float*)d_out; p.ws = (unsigned char*)d_ws;
    (void)hipMemsetAsync((char*)d_ws + T_BAR, 0, 16384, stream);
    void* args[] = {&p};
    hipError_t e = hipLaunchCooperativeKernel((void*)k_mega, dim3(grid_blocks), dim3(NTHR), args, LDS_BYTES, stream);
    if (e != hipSuccess) fprintf(stderr, "cooperative launch failed: %s (grid %d)\n", hipGetErrorString(e), grid_blocks);
}
```

```cpp
#include <hip/hip_runtime.h>
#include <hip/hip_cooperative_groups.h>
#include <cstdio>
#include <cstdint>
namespace cg = cooperative_groups;
__device__ __forceinline__ int otid() { int t = threadIdx.x; asm volatile("" : "+v"(t)); return t; }

namespace pg8 {
#define PG8_LAS __attribute__((address_space(3)))
typedef unsigned short bf16_t;
typedef short bf16x8 __attribute__((ext_vector_type(8)));
typedef float f32x4 __attribute__((ext_vector_type(4)));
typedef unsigned u32x4 __attribute__((ext_vector_type(4)));
constexpr int BM = 256, BK = 64, HALF = 128, HTB = HALF * BK * 2  , STAGE_BYTES = 8 * HTB, NXCD = 8, WGM = 8;

__host__ __device__ __forceinline__ int lds_byte(int r, int c) { const int st = (r >> 4) * 2 + (c >> 5), rr = r & 15, cc = c & 31, ob = rr * 64 + cc * 2; return st * 1024 + (ob ^ (((ob >> 9) & 1) << 5)); }
__host__ __device__ __forceinline__ void stage_rc(int b, int& R, int& C) { const int st = b / 1024, sb = b % 1024, swz = sb ^ (((sb >> 9) & 1) << 5); R = (st >> 1) * 16 + swz / 64; C = (st & 1) * 32 + (swz % 64) / 2; }
__host__ __device__ __forceinline__ int perm32(int rho) { const int n = rho >> 4, i = rho & 15; return 8 * (i >> 2) + 4 * n + (i & 3); }

struct Unit { int pm, pn, pb; };
struct Gemm { const bf16_t* A; const bf16_t* Bt; int M, N, K; };

struct StaticOrder {
    static constexpr bool GATHER = false;
    int nM, nN, nwg, G, c;
    __device__ __forceinline__ int rowsrc(int) const { return 0; }
    __host__ __device__ void init(int M, int N, int G_, int c_) { nM = M / BM; nN = N / BM; nwg = nM * nN; G = G_; c = c_; }
    __host__ __device__ bool next(int i, Unit& u) const {
        const long L = (long)i * G + c; if (L >= nwg) return false;
        int wgid = (int)L; { const int q = nwg / NXCD, r = nwg % NXCD, xcd = wgid % NXCD, off = wgid / NXCD; wgid = (xcd < r ? xcd * (q + 1) : r * (q + 1) + (xcd - r) * q) + off; }
        const int nig = WGM * nN, gid = wgid / nig, fm = gid * WGM, gsz = (nM - fm) < WGM ? (nM - fm) : WGM;
        u.pm = fm + ((wgid % nig) % gsz); u.pn = (wgid % nig) / gsz; u.pb = u.pn; return true;
    }
    __device__ __forceinline__ void a_ready(const Unit&) const {}
    __device__ __forceinline__ void done(const Unit&) const {}
};

__device__ __forceinline__ unsigned cvt_pk_bf16(float lo, float hi) { unsigned r; asm volatile("v_cvt_pk_bf16_f32 %0, %1, %2" : "=v"(r) : "v"(lo), "v"(hi)); return r; }
typedef float f32x2 __attribute__((ext_vector_type(2)));
template <class Epi, class Sched, bool ALIGN_EPI = false, bool SP2 = false>
__device__ __forceinline__ void gemm_phase(PG8_LAS unsigned char* lds, const Gemm g, const Sched& S, const Epi& E) {
    const int tid = otid(), wid = __builtin_amdgcn_readfirstlane(tid >> 6), lane = tid & 63, wr = wid >> 2, wc = wid & 3, fr = lane & 15, fq = lane >> 4;
    const int K = g.K, nt = K / BK;
    unsigned voffA[2], voffB[2];
#pragma unroll
    for (int i = 0; i < 2; ++i) { int R, C; stage_rc(tid * 16 + i * 8192, R, C); const int Rb = Epi::PERM ? ((R & ~31) + perm32(R & 31)) : R;
        voffA[i] = (unsigned)(R * K + C) * 2u; voffB[i] = (unsigned)(Rb * K + C) * 2u; }
    const size_t kstep = (size_t)(BK * 2);
    const size_t hstep = (size_t)HALF * K * 2;
    const size_t tstep = 2 * hstep;
    unsigned vA0[2], vA1[2], nA0[2], nA1[2];
    PG8_LAS int* rtab = (PG8_LAS int*)(lds + STAGE_BYTES);
    auto fillA = [&](int ui_, unsigned (&o0)[2], unsigned (&o1)[2]) {
#pragma unroll
        for (int i = 0; i < 2; ++i) {
            if constexpr (Sched::GATHER) { int R, C; stage_rc(tid * 16 + i * 8192, R, C);
                o0[i] = (unsigned)(rtab[ui_ * 256 + R] * K + C) * 2u; o1[i] = (unsigned)(rtab[ui_ * 256 + 128 + R] * K + C) * 2u; }
            else { o0[i] = voffA[i]; o1[i] = voffA[i] + (unsigned)hstep; } } };
    const unsigned ldsw = (unsigned)wid * 1024u;
    const int aoff = lds_byte(wr * 64 + fr, fq * 8), boff = lds_byte(wc * 32 + fr, fq * 8);
#define PG8_SA(b, h) (((b) * 2 + (h)) * HTB)
#define PG8_SB(b, h) ((4 + (b) * 2 + (h)) * HTB)
#define PG8_STAGE(bufoff, gbase, voff) do { _Pragma("unroll") for (int _i = 0; _i < 2; ++_i) \
        __builtin_amdgcn_global_load_lds((const unsigned*)((const char*)(gbase) + (voff)[_i]), (PG8_LAS unsigned*)(lds + (bufoff) + ldsw + _i * 8192), 16, 0, 0); } while (0)
#define PG8_LDA(dst, b, h) do { _Pragma("unroll") for (int m = 0; m < 4; ++m) _Pragma("unroll") for (int k = 0; k < 2; ++k) dst[m][k] = *(const PG8_LAS bf16x8*)(lds + PG8_SA(b, h) + aoff + m * 2048 + k * 1024); } while (0)
#define PG8_LDB(dst, b, h) do { _Pragma("unroll") for (int n = 0; n < 2; ++n) _Pragma("unroll") for (int k = 0; k < 2; ++k) dst[n][k] = *(const PG8_LAS bf16x8*)(lds + PG8_SB(b, h) + boff + n * 2048 + k * 1024); } while (0)
#define PG8_MMA(ai, bj, At, Bt) do { __builtin_amdgcn_s_setprio(1); _Pragma("unroll") for (int m = 0; m < 4; ++m) _Pragma("unroll") for (int n = 0; n < 2; ++n) _Pragma("unroll") for (int k = 0; k < 2; ++k) \
        acc[ai][bj][m][n] = __builtin_amdgcn_mfma_f32_16x16x32_bf16(Bt[n][k], At[m][k], acc[ai][bj][m][n], 0, 0, 0); __builtin_amdgcn_s_setprio(0); } while (0)
#define PG8_WAIT_V(n) asm volatile("s_waitcnt vmcnt(" #n ")" ::: "memory")
#define PG8_WAIT_L(n) asm volatile("s_waitcnt lgkmcnt(" #n ")" ::: "memory")
#define PG8_BAR __builtin_amdgcn_s_barrier()
#define PG8_SCHED __builtin_amdgcn_sched_barrier(0)
    Unit cur, nxt; int ui = 0;
    if (!S.next(0, cur)) return;
    f32x4 acc[2][2][4][2];
#pragma unroll
    for (int a = 0; a < 2; ++a)
#pragma unroll
        for (int b = 0; b < 2; ++b)
#pragma unroll
            for (int m = 0; m < 4; ++m)
#pragma unroll
                for (int n = 0; n < 2; ++n) acc[a][b][m][n] = (f32x4){0.f, 0.f, 0.f, 0.f};
    bf16x8 At[4][2], B0[2][2], B1[2][2];
    if constexpr (Sched::GATHER) {
        for (int ui_ = 0; ; ++ui_) { Unit u_; if (!S.next(ui_, u_)) break; if (tid < 256) rtab[ui_ * 256 + tid] = S.rowsrc(u_.pm * 256 + tid); }
        __syncthreads();
    }
    fillA(0, vA0, vA1);
    const char* cA = Sched::GATHER ? (const char*)g.A : (const char*)g.A + (size_t)cur.pm * tstep; const char* cB = (const char*)g.Bt + (size_t)cur.pb * tstep;
    S.a_ready(cur);
    if constexpr (SP2) {
        PG8_STAGE(PG8_SB(0, 0), cB, voffB); PG8_STAGE(PG8_SB(0, 1), cB + hstep, voffB); PG8_STAGE(PG8_SA(0, 0), cA, vA0); PG8_STAGE(PG8_SA(0, 1), cA, vA1);
        if (wr == 1) PG8_BAR;
        PG8_WAIT_V(2); PG8_BAR;
        PG8_STAGE(PG8_SB(1, 0), cB + kstep, voffB); PG8_STAGE(PG8_SA(1, 0), cA + kstep, vA0); PG8_STAGE(PG8_SB(1, 1), cB + hstep + kstep, voffB);
        PG8_WAIT_V(6); PG8_BAR;
    } else {
        PG8_STAGE(PG8_SB(0, 0), cB, voffB); PG8_STAGE(PG8_SA(0, 0), cA, vA0); PG8_STAGE(PG8_SB(0, 1), cB + hstep, voffB); PG8_STAGE(PG8_SA(0, 1), cA, vA1);
        if (wr == 1) PG8_BAR;
        PG8_WAIT_V(4); PG8_BAR;
        PG8_STAGE(PG8_SB(1, 0), cB + kstep, voffB); PG8_STAGE(PG8_SA(1, 0), cA + kstep, vA0); PG8_STAGE(PG8_SB(1, 1), cB + hstep + kstep, voffB);
        PG8_WAIT_V(6); PG8_BAR;
    }
    for (;;) {
        const bool has_next = S.next(ui + 1, nxt);
        const char* nA = has_next ? (Sched::GATHER ? (const char*)g.A : (const char*)g.A + (size_t)nxt.pm * tstep) : cA; const char* nB = has_next ? (const char*)g.Bt + (size_t)nxt.pb * tstep : cB;
        if (has_next) fillA(ui + 1, nA0, nA1); else {
#pragma unroll
            for (int i = 0; i < 2; ++i) { nA0[i] = vA0[i]; nA1[i] = vA1[i]; } }
        for (int t = 0; t < nt; t += 2) {
            const bool last = (t == nt - 2);
            const char* a1 = cA + (size_t)(t + 1) * kstep;
            const char* a2 = last ? nA : cA + (size_t)(t + 2) * kstep; const char* b2 = last ? nB : cB + (size_t)(t + 2) * kstep;
            const char* a3 = a2 + kstep; const char* b3 = b2 + kstep;
            unsigned sA0[2], sA1[2];
#pragma unroll
            for (int i = 0; i < 2; ++i) { sA0[i] = last ? nA0[i] : vA0[i]; sA1[i] = last ? nA1[i] : vA1[i]; }
            if (last && has_next) S.a_ready(nxt);
            if constexpr (SP2) {
            PG8_LDB(B0, 0, 0); PG8_LDB(B1, 0, 1); PG8_SCHED; PG8_LDA(At, 0, 0); PG8_STAGE(PG8_SA(1, 1), a1, vA1);
            PG8_WAIT_V(8); PG8_WAIT_L(0); PG8_BAR; PG8_MMA(0, 0, At, B0); PG8_MMA(0, 1, At, B1); PG8_BAR; PG8_SCHED;
            PG8_LDA(At, 0, 1); PG8_STAGE(PG8_SB(0, 0), b2, voffB); PG8_STAGE(PG8_SB(0, 1), b2 + hstep, voffB); PG8_STAGE(PG8_SA(0, 0), a2, sA0);
            PG8_WAIT_V(8); PG8_WAIT_L(0); PG8_BAR; PG8_MMA(1, 0, At, B0); PG8_MMA(1, 1, At, B1); PG8_BAR; PG8_SCHED;
            PG8_LDB(B0, 1, 0); PG8_LDB(B1, 1, 1); PG8_SCHED; PG8_LDA(At, 1, 0); PG8_STAGE(PG8_SA(0, 1), a2, sA1);
            PG8_WAIT_V(8); PG8_WAIT_L(0); PG8_BAR; PG8_MMA(0, 0, At, B0); PG8_MMA(0, 1, At, B1); PG8_BAR; PG8_SCHED;
            PG8_LDA(At, 1, 1); PG8_STAGE(PG8_SB(1, 0), b3, voffB); PG8_STAGE(PG8_SB(1, 1), b3 + hstep, voffB); PG8_STAGE(PG8_SA(1, 0), a3, sA0);
            PG8_WAIT_V(8); PG8_WAIT_L(0); PG8_BAR; PG8_MMA(1, 0, At, B0); PG8_MMA(1, 1, At, B1); PG8_BAR; PG8_SCHED;
            } else {
            PG8_LDB(B0, 0, 0); PG8_SCHED; PG8_LDA(At, 0, 0); PG8_STAGE(PG8_SA(1, 1), a1, vA1);
            PG8_WAIT_L(8); PG8_BAR; PG8_WAIT_L(0); PG8_MMA(0, 0, At, B0); PG8_BAR; PG8_SCHED;
            PG8_LDB(B1, 0, 1); PG8_STAGE(PG8_SB(0, 0), b2, voffB);
            PG8_BAR; PG8_WAIT_L(0); PG8_MMA(0, 1, At, B1); PG8_BAR;
            PG8_LDA(At, 0, 1); PG8_STAGE(PG8_SA(0, 0), a2, sA0);
            PG8_BAR; PG8_WAIT_L(0); PG8_MMA(1, 0, At, B0); PG8_BAR; PG8_SCHED;
            PG8_STAGE(PG8_SB(0, 1), b2 + hstep, voffB);
            PG8_WAIT_V(6); PG8_BAR; PG8_MMA(1, 1, At, B1); PG8_BAR;
            PG8_LDB(B0, 1, 0); PG8_SCHED; PG8_LDA(At, 1, 0); PG8_STAGE(PG8_SA(0, 1), a2, sA1);
            PG8_WAIT_L(8); PG8_BAR; PG8_WAIT_L(0); PG8_MMA(0, 0, At, B0); PG8_BAR; PG8_SCHED;
            PG8_LDB(B1, 1, 1); PG8_STAGE(PG8_SB(1, 0), b3, voffB);
            PG8_BAR; PG8_WAIT_L(0); PG8_MMA(0, 1, At, B1); PG8_BAR;
            PG8_LDA(At, 1, 1); PG8_STAGE(PG8_SA(1, 0), a3, sA0);
            PG8_BAR; PG8_WAIT_L(0); PG8_MMA(1, 0, At, B0); PG8_BAR; PG8_SCHED;
            PG8_STAGE(PG8_SB(1, 1), b3 + hstep, voffB);
            PG8_WAIT_V(6); PG8_BAR; PG8_MMA(1, 1, At, B1); PG8_BAR;
            }
        }
        if constexpr (ALIGN_EPI) { if (wr == 0) PG8_BAR; }
        if constexpr (!Epi::AFTER_DRAIN) { E(acc, cur, wr, wc, fr, fq); S.done(cur); }
        if (!has_next) break;
#pragma unroll
        for (int a = 0; a < 2; ++a)
#pragma unroll
            for (int b = 0; b < 2; ++b)
#pragma unroll
                for (int m = 0; m < 4; ++m)
#pragma unroll
                    for (int n = 0; n < 2; ++n) acc[a][b][m][n] = (f32x4){0.f, 0.f, 0.f, 0.f};
        cur = nxt; cA = nA; cB = nB; ++ui;
#pragma unroll
        for (int i = 0; i < 2; ++i) { vA0[i] = nA0[i]; vA1[i] = nA1[i]; }
        if constexpr (ALIGN_EPI) { if (wr == 1) PG8_BAR; }
    }
    PG8_WAIT_V(0);
    if constexpr (!ALIGN_EPI) { if (wr == 0) PG8_BAR; }
    PG8_BAR;
    if constexpr (Epi::AFTER_DRAIN) { E.fused(acc, cur, wr, wc, fr, fq, lds, wid, lane); S.done(cur); }
#undef PG8_SA
#undef PG8_SB
#undef PG8_STAGE
#undef PG8_LDA
#undef PG8_LDB
#undef PG8_MMA
#undef PG8_WAIT_V
#undef PG8_WAIT_L
#undef PG8_BAR
#undef PG8_SCHED
}
}
constexpr int D = 1024, BATCH = 8, SEQ = 4096, NTOK = BATCH * SEQ;
constexpr int GW = 512, RW = 512, HD = 64, CHUNK = 128;
constexpr int RPROJ = 1696, INW = 2720, ZLD = 2816;
constexpr int NG = 4, EPG = 8, NE = 32, EH = 512;
constexpr int NTHR = 512;
constexpr int LDS_BYTES = 163840;

typedef float f32x16 __attribute__((ext_vector_type(16)));
typedef float f32x4 __attribute__((ext_vector_type(4)));
typedef unsigned u32x4 __attribute__((ext_vector_type(4)));
typedef unsigned u32x2 __attribute__((ext_vector_type(2)));
typedef unsigned short bf16;
#define LAS __attribute__((address_space(3)))

constexpr size_t MiB = 1u << 20;
constexpr size_t W_WINT = 0;
constexpr size_t W_WOUTT = 6 * MiB;
constexpr size_t W_LORAT = 8 * MiB;
constexpr size_t W_WC = 9 * MiB;
constexpr size_t W_MOD = 10 * MiB;
constexpr size_t W_RA = W_MOD + 256 * 1024;
constexpr size_t W_RW = W_MOD + 512 * 1024;
constexpr size_t W_TAB = 11 * MiB;
constexpr size_t W_WGUT = 16 * MiB;
constexpr size_t W_WDT = 80 * MiB;
constexpr size_t W_H1 = 112 * MiB;
constexpr size_t W_Z = 176 * MiB;
constexpr size_t W_YCAT = 352 * MiB;
constexpr size_t W_LO = 416 * MiB;
constexpr size_t WS_NEED = 512 * MiB;
constexpr size_t T_TOKE = W_TAB;
constexpr size_t T_TOKW = W_TAB + 512 * 1024;
constexpr size_t T_ROWTOK = W_TAB + 1024 * 1024;
constexpr size_t T_ROWAID = W_TAB + 1536 * 1024;
constexpr size_t T_ROWW = W_TAB + 2048 * 1024;
constexpr size_t T_TILEE = W_TAB + 2560 * 1024;
constexpr size_t T_CTL = W_TAB + 3072 * 1024;
constexpr size_t T_BAR = W_TAB + 3584 * 1024;

struct Params {
    const float* in[31];
    float* out;
    unsigned char* ws;
};
typedef const __attribute__((address_space(4))) Params& PRef;
typedef const __attribute__((address_space(4))) Params* PPtr;
__device__ __forceinline__ PPtr opq(PPtr k) { asm volatile("" : "+s"(k)); return k; }
enum { I_X = 0, I_C, I_ADAW, I_ADAB, I_N1G, I_WIN, I_GLNW, I_GLNB, I_GWS, I_GBS, I_MU, I_W0, I_W2, I_A0, I_A2, I_G2, I_KK, I_KA, I_RK, I_GNW, I_GNB, I_WOUT, I_N2G, I_RGW, I_RGB, I_REW, I_REB, I_WG, I_WU, I_WD, I_FNG };

__device__ __forceinline__ float wave_sum(float v) {
#pragma unroll
    for (int o = 1; o < 64; o <<= 1) v += __shfl_xor(v, o);
    return v;
}
#define DPP_ADD(v, ctrl) v += __builtin_bit_cast(float, __builtin_amdgcn_update_dpp(0, __builtin_bit_cast(int, v), ctrl, 0xf, 0xf, false))
__device__ __forceinline__ float wave_sum_dpp(float v) {
    DPP_ADD(v, 0xB1); DPP_ADD(v, 0x4E); DPP_ADD(v, 0x141); DPP_ADD(v, 0x140);
    const int iv = __builtin_bit_cast(int, v);
    const float a = __builtin_bit_cast(float, __builtin_amdgcn_readlane(iv, 0)), b = __builtin_bit_cast(float, __builtin_amdgcn_readlane(iv, 16));
    const float c = __builtin_bit_cast(float, __builtin_amdgcn_readlane(iv, 32)), d = __builtin_bit_cast(float, __builtin_amdgcn_readlane(iv, 48));
    return (a + b) + (c + d);
}
__device__ __forceinline__ float xsum4(float s) {
    s += __builtin_bit_cast(float, __builtin_amdgcn_ds_swizzle(__builtin_bit_cast(int, s), 0x401F));
    float a = s, b = s;
    asm volatile("s_nop 1\n\tv_permlane32_swap_b32 %0, %1\n\ts_nop 1" : "+v"(a), "+v"(b));
    return a + b;
}
__device__ __forceinline__ float wave_sum_v(float v) {
    DPP_ADD(v, 0xB1); DPP_ADD(v, 0x4E); DPP_ADD(v, 0x141); DPP_ADD(v, 0x140);
    return xsum4(v);
}
__device__ __forceinline__ float gelu_tanh(float x) {
    const float u = 0.7978845608028654f * (x + 0.044715f * x * x * x);
    return 0.5f * x * (1.0f + tanhf(u));
}
__device__ __forceinline__ float gelu_fast(float x) {
    const float u2 = -2.302208198f * (x + 0.044715f * x * x * x);
    return x * __builtin_amdgcn_rcpf(1.0f + __builtin_amdgcn_exp2f(u2));
}
__device__ __forceinline__ float sigmoidf_(float x) { return 1.0f / (1.0f + expf(-x)); }
__device__ __forceinline__ float softplusf_(float x) { return fmaxf(x, 0.f) + log1pf(expf(-fabsf(x))); }
__device__ __forceinline__ float bf2f(unsigned short b) { return __uint_as_float(((unsigned)b) << 16); }
__device__ __forceinline__ float bflo(unsigned w) { return __uint_as_float(w << 16); }
__device__ __forceinline__ float bfhi(unsigned w) { return __uint_as_float(w & 0xffff0000u); }
__device__ __forceinline__ unsigned f2bf(float f) { unsigned u = __float_as_uint(f); return (u + 0x7fffu + ((u >> 16) & 1u)) >> 16; }
__device__ __forceinline__ unsigned pk2(float lo, float hi) { return f2bf(lo) | (f2bf(hi) << 16); }
#define XB_TMO      128
#define XB_XCNT(j)  (256  + 64 * (j))
#define XB_XSUB(j)  (1280 + 64 * (j))
#define XB_XGEN(j)  (2304 + 64 * (j))
#define XB_TOP      3328
#define XB_TOPGEN   3392
#define XCD_BAR_WORDS 3456
#define XB_SPIN_CAP (1u << 18)

__device__ __forceinline__ unsigned xb_ld(unsigned* p)              { return __hip_atomic_load(p, __ATOMIC_RELAXED, __HIP_MEMORY_SCOPE_AGENT); }
__device__ __forceinline__ unsigned xb_add(unsigned* p, unsigned v) { return __hip_atomic_fetch_add(p, v, __ATOMIC_RELAXED, __HIP_MEMORY_SCOPE_AGENT); }
__device__ __forceinline__ unsigned xb_xcc_id() { return (unsigned)__builtin_amdgcn_s_getreg((3 << 11) | 20) & 0xFu; }
#define XB_SPIN(cond, bar) do { unsigned _sp = 0; while (cond) { __builtin_amdgcn_s_sleep(1); \
    if ((++_sp & 255u) == 0u) { if (xb_ld(&(bar)[XB_TMO])) break; if (_sp > XB_SPIN_CAP) { atomicAdd(&(bar)[XB_TMO], 1u); break; } } } } while (0)

struct XcdBarrier {
    unsigned* bar; unsigned x;
    volatile LAS unsigned* st;
};

__device__ __forceinline__ XcdBarrier xcd_barrier_post(unsigned* bar, volatile LAS unsigned* st) {
    XcdBarrier b; b.bar = bar; b.x = xb_xcc_id(); b.st = st;
    if (threadIdx.x == 0) (void)xb_add(&bar[XB_XCNT(b.x)], 1u);
    return b;
}
__device__ __forceinline__ void xcd_barrier_complete(unsigned* bar, unsigned x, unsigned& nloc, unsigned& nx) {
    const unsigned G = gridDim.x * gridDim.y * gridDim.z;
    unsigned sum, cnt, mine, sp = 0u;
    for (;;) {
        sum = 0u; cnt = 0u; mine = 0u;
#pragma unroll
        for (unsigned j = 0; j < 16; ++j) { const unsigned c = xb_ld(&bar[XB_XCNT(j)]); sum += c; cnt += (c > 0u) ? 1u : 0u; mine = (j == x) ? c : mine; }
        if (sum == G) break;
        __builtin_amdgcn_s_sleep(1);
        if ((++sp & 255u) == 0u) { if (xb_ld(&bar[XB_TMO])) break; if (sp > XB_SPIN_CAP) { atomicAdd(&bar[XB_TMO], 1u); break; } }
    }
    nloc = mine > 0u ? mine : 1u; nx = cnt > 0u ? cnt : 1u;
}

__device__ __forceinline__ void xcd_barrier(const XcdBarrier& b) {
    asm volatile("s_waitcnt vmcnt(0)" ::: "memory");
    __syncthreads();
    if (threadIdx.x == 0) {
        unsigned* bar = b.bar;
        __builtin_amdgcn_s_waitcnt(0);
        unsigned nloc = b.st[0], nx = b.st[1];
        if (nloc == 0u) { xcd_barrier_complete(bar, b.x, nloc, nx); b.st[0] = nloc; b.st[1] = nx; }
        const unsigned old = xb_add(&bar[XB_XSUB(b.x)], 1u);
        const unsigned gen = old / nloc;
        if (old + 1u == (gen + 1u) * nloc) {
            __builtin_amdgcn_fence(__ATOMIC_RELEASE, "agent");
            asm volatile("s_waitcnt vmcnt(0)" ::: "memory");
            const unsigned og = xb_add(&bar[XB_TOP], 1u);
            const unsigned tg = og / nx;
            if (og + 1u == (tg + 1u) * nx) xb_add(&bar[XB_TOPGEN], 1u);
            else XB_SPIN(xb_ld(&bar[XB_TOPGEN]) == tg, bar);
            __builtin_amdgcn_fence(__ATOMIC_ACQUIRE, "agent");
            xb_add(&bar[XB_XGEN(b.x)], 1u);
            asm volatile("s_waitcnt vmcnt(0)" ::: "memory");
        } else {
            XB_SPIN(xb_ld(&bar[XB_XGEN(b.x)]) == gen, bar);
            __builtin_amdgcn_fence(__ATOMIC_ACQUIRE, "agent");
            asm volatile("s_waitcnt vmcnt(0)" ::: "memory");
        }
    }
    __syncthreads();
}
struct TrItem { const float* W; bf16* WT; int K, N; long row_off; int item; };
__device__ __forceinline__ void p0_tr_load(const TrItem& it, float (&tv)[32], int lane) {
    const int nblk = it.N / 32, kb = it.item / nblk, nb = it.item % nblk, k0 = 64 * kb, n0 = 32 * nb;
#pragma unroll
    for (int i = 0; i < 32; ++i) tv[i] = it.W[(size_t)(k0 + 2 * i + (lane >> 5)) * it.N + n0 + (lane & 31)];
}
__device__ __forceinline__ void p0_tr_store(const TrItem& it, const float (&tv)[32], LAS float* scr, int lane) {
    const int nblk = it.N / 32, kb = it.item / nblk, nb = it.item % nblk, k0 = 64 * kb, n0 = 32 * nb;
#pragma unroll
    for (int i = 0; i < 32; ++i) scr[(2 * i + (lane >> 5)) * 33 + (lane & 31)] = tv[i];
    asm volatile("s_waitcnt lgkmcnt(0)" ::: "memory");
    const int c = lane & 7;
#pragma unroll
    for (int j = 0; j < 4; ++j) { const int n = (lane >> 3) + 8 * j; const LAS float* s = scr + (8 * c) * 33 + n;
        u32x4 o; o.x = pk2(s[0 * 33], s[1 * 33]); o.y = pk2(s[2 * 33], s[3 * 33]); o.z = pk2(s[4 * 33], s[5 * 33]); o.w = pk2(s[6 * 33], s[7 * 33]);
        *(u32x4*)(it.WT + (size_t)(it.row_off + n0 + n) * it.K + k0 + 8 * c) = o; }
    asm volatile("s_waitcnt lgkmcnt(0)" ::: "memory");
}
__device__ __forceinline__ void p0_tr_store_half(const TrItem& it, const float (&tv)[32], LAS float* scr, int lane, int half) {
    const int nblk = it.N / 32, kb = it.item / nblk, nb = it.item % nblk, k0 = 64 * kb, n0 = 32 * nb;
    if (half == 0) {
#pragma unroll
        for (int i = 0; i < 32; ++i) scr[(2 * i + (lane >> 5)) * 33 + (lane & 31)] = tv[i];
        asm volatile("s_waitcnt lgkmcnt(0)" ::: "memory"); }
    const int c = lane & 7;
#pragma unroll
    for (int jj = 0; jj < 2; ++jj) { const int j = half * 2 + jj; const int n = (lane >> 3) + 8 * j; const LAS float* s = scr + (8 * c) * 33 + n;
        u32x4 o; o.x = pk2(s[0 * 33], s[1 * 33]); o.y = pk2(s[2 * 33], s[3 * 33]); o.z = pk2(s[4 * 33], s[5 * 33]); o.w = pk2(s[6 * 33], s[7 * 33]);
        *(u32x4*)(it.WT + (size_t)(it.row_off + n0 + n) * it.K + k0 + 8 * c) = o; }
    asm volatile("s_waitcnt lgkmcnt(0)" ::: "memory");
}
__device__ __forceinline__ void p0_tr_store_reg(const TrItem& it, const float (&tv)[32], int lane) {
    const int nblk = it.N / 32, kb = it.item / nblk, nb = it.item % nblk, k0 = 64 * kb, n0 = 32 * nb;
    unsigned w[16];
#pragma unroll
    for (int i = 0; i < 16; ++i) { float a = tv[i], b = tv[i + 16];
        asm volatile("s_nop 1\n\tv_permlane32_swap_b32 %0, %1\n\ts_nop 1" : "+v"(a), "+v"(b));
        w[i] = pg8::cvt_pk_bf16(a, b); }
    bf16* dst = it.WT + (size_t)(it.row_off + n0 + (lane & 31)) * it.K + k0 + 32 * (lane >> 5);
#pragma unroll
    for (int j = 0; j < 4; ++j) *(u32x4*)(dst + 8 * j) = (u32x4){w[4 * j], w[4 * j + 1], w[4 * j + 2], w[4 * j + 3]};
}
__device__ __forceinline__ void p0_tr_load16(const TrItem& it, f32x4 (&tv)[8], int lane) {
    const int nblk = it.N / 32, kb = it.item / nblk, nb = it.item % nblk, k0 = 64 * kb, n0 = 32 * nb;
    const float* src = it.W + (size_t)(k0 + 8 * (lane >> 3)) * it.N + n0 + 4 * (lane & 7);
#pragma unroll
    for (int i = 0; i < 8; ++i) tv[i] = *(const f32x4*)(src + (size_t)i * it.N);
}
__device__ __forceinline__ void p0_tr_store16(const TrItem& it, const f32x4 (&tv)[8], int lane) {
    const int nblk = it.N / 32, kb = it.item / nblk, nb = it.item % nblk, k0 = 64 * kb, n0 = 32 * nb;
    bf16* dst = it.WT + (size_t)(it.row_off + n0 + 4 * (lane & 7)) * it.K + k0 + 8 * (lane >> 3);
#pragma unroll
    for (int j = 0; j < 4; ++j) { u32x4 o; o.x = pg8::cvt_pk_bf16(tv[0][j], tv[1][j]); o.y = pg8::cvt_pk_bf16(tv[2][j], tv[3][j]); o.z = pg8::cvt_pk_bf16(tv[4][j], tv[5][j]); o.w = pg8::cvt_pk_bf16(tv[6][j], tv[7][j]);
        *(u32x4*)(dst + (size_t)j * it.K) = o; }
}
constexpr int MOE_I_GU = (D / 64) * (EH / 32), MOE_I_DN = (EH / 64) * (D / 32), MOE_ITEMS = NE * (2 * MOE_I_GU + MOE_I_DN);
__device__ __forceinline__ TrItem moe_item(PRef p, int r) {
    const int e = r / (2 * MOE_I_GU + MOE_I_DN); r -= e * (2 * MOE_I_GU + MOE_I_DN);
    if (r < 2 * MOE_I_GU) {
        const int up = r >= MOE_I_GU; if (up) r -= MOE_I_GU;
        const int nbk = r % (EH / 32), hb = nbk * 32;
        const long row_off = (long)e * 1024 + (hb / 128) * 256 + up * 128 + (hb % 128) - hb;
        return TrItem{(up ? p.in[I_WU] : p.in[I_WG]) + (size_t)e * D * EH, (bf16*)(p.ws + W_WGUT), D, EH, row_off, r}; }
    r -= 2 * MOE_I_GU;
    return TrItem{p.in[I_WD] + (size_t)e * EH * D, (bf16*)(p.ws + W_WDT), EH, D, (long)e * 1024, r};
}
__device__ __forceinline__ void p0_mod_item(PRef p, LAS float* lf, int item) {
    const int tid = otid(), cg = tid & 7, kq = tid >> 3;
    const float* __restrict__ c = p.in[I_C]; const float* w = p.in[I_ADAW] + (size_t)(kq * 16) * (6 * D) + item * 32 + cg * 4;
    f32x4 wv[16];
#pragma unroll
    for (int i = 0; i < 16; ++i) wv[i] = *(const f32x4*)(w + (size_t)i * (6 * D));
    LAS float* cs = lf; LAS float* red = lf + BATCH * D;
#pragma unroll
    for (int q = 0; q < 4; ++q) { const int idx = (tid + q * NTHR) * 4; *(LAS f32x4*)(cs + idx) = *(const f32x4*)(c + idx); }
    __syncthreads();
    f32x4 acc[8];
#pragma unroll
    for (int b = 0; b < 8; ++b) { acc[b] = (f32x4){0.f, 0.f, 0.f, 0.f};
#pragma unroll
        for (int i4 = 0; i4 < 4; ++i4) { const f32x4 cv = *(const LAS f32x4*)(cs + b * D + kq * 16 + i4 * 4);
#pragma unroll
            for (int j = 0; j < 4; ++j) acc[b] += wv[i4 * 4 + j] * cv[j]; } }
#pragma unroll
    for (int b = 0; b < 8; ++b) *(LAS f32x4*)(red + (kq * 8 + b) * 32 + cg * 4) = acc[b];
    __syncthreads();
    if (tid < 256) { const int b = tid >> 5, col = tid & 31; float s = 0.f;
#pragma unroll 16
      for (int q = 0; q < 64; ++q) s += red[(q * 8 + b) * 32 + col];
      ((float*)(p.ws + W_MOD))[b * 6 * D + item * 32 + col] = s + p.in[I_ADAB][item * 32 + col]; }
    __syncthreads();
}
template <bool WITH_MOE>
__device__ __forceinline__ void p0_prep(PRef p, LAS unsigned char* lds, int bid, int nb) {
    const int tid = otid(), lane = tid & 63, wave = __builtin_amdgcn_readfirstlane(tid >> 6);
    LAS float* scr = (LAS float*)(lds + wave * 16384);
    const int gw = bid * 8 + wave, NGW = nb * 8;
    constexpr int I_IN = (D / 64) * (INW / 32), I_OUT = (D / 64) * (D / 32), I_GU = (D / 64) * (EH / 32), I_DN = (EH / 64) * (D / 32);
    constexpr int NIT = I_IN + I_OUT + (WITH_MOE ? NE * (2 * I_GU + I_DN) : 0);
    auto decode = [&](int it) -> TrItem {
        int r = it;
        if (r < I_IN) return TrItem{p.in[I_WIN], (bf16*)(p.ws + W_WINT), D, INW, 0, r}; r -= I_IN;
        if (r < I_OUT) return TrItem{p.in[I_WOUT], (bf16*)(p.ws + W_WOUTT), D, D, 0, r}; r -= I_OUT;
        return moe_item(p, r);
    };
    f32x4 tvA[8], tvB[8];
    TrItem cur = decode(gw < NIT ? gw : 0);
    if (gw < NIT) p0_tr_load16(cur, tvA, lane);
    { constexpr int NLT = 1536 * 256, NWC = 8 * 128 * 128, NRW = 2 * 2 * 48 * 520;
      const int i0 = bid * NTHR + tid, st = nb * NTHR;
      float vlt[3], vwc, vrw[2];
#pragma unroll
      for (int q = 0; q < 3; ++q) { const int i = i0 + q * st, ic = i < NLT ? i : 0, n = ic >> 8, k = ic & 255;
          const float* src = n < 512 ? p.in[I_W2] + (k & 31) * 512 + n : n < 1024 ? p.in[I_A2] + (k & 31) * 512 + (n - 512) : p.in[I_G2] + ((k >= 64 && k < 160) ? k - 64 : 0) * 512 + (n - 1024);
          const bool ok = n < 512 ? k < 32 : n < 1024 ? (k >= 32 && k < 64) : (k >= 64 && k < 160);
          const float v = *src; vlt[q] = ok ? v : 0.f; }
      { const int ic = i0 < NWC ? i0 : 0, s = ic & 127, t = (ic >> 7) & 127; const float v = p.in[I_GWS][ic]; vwc = (s <= t) ? v : 0.f; }
#pragma unroll
      for (int q = 0; q < 2; ++q) { const int i = i0 + q * st, ic = i < NRW ? i : 0; const int kl = ic % 520, qq = (ic / 520) % 48, kh = ic / (520 * 48 * 2); const int k = kh * 512 + (kl < 512 ? kl : 0);
          const float* src = qq < 4 ? p.in[I_RGW] + k * 4 + qq : p.in[I_REW] + k * 32 + (qq < 36 ? qq - 4 : 0);
          const float v = *src; vrw[q] = (kl < 512 && qq < 36) ? v : 0.f; }
      bf16* lt = (bf16*)(p.ws + W_LORAT); bf16* wc = (bf16*)(p.ws + W_WC); bf16* rw = (bf16*)(p.ws + W_RW);
#pragma unroll
      for (int q = 0; q < 3; ++q) { const int i = i0 + q * st; if (i < NLT) lt[i] = (bf16)f2bf(vlt[q]); }
      if (i0 < NWC) wc[i0] = (bf16)f2bf(vwc);
#pragma unroll
      for (int q = 0; q < 2; ++q) { const int i = i0 + q * st; if (i < NRW) { const int hl = (i / (520 * 48)) & 1; const unsigned hi = f2bf(vrw[q]); rw[i] = hl ? (bf16)f2bf(vrw[q] - bflo(hi)) : (bf16)hi; } }
      static_assert(NLT <= 3 * 256 * NTHR && NWC <= 256 * NTHR && NRW <= 2 * 256 * NTHR, "table loops assume a 256-workgroup grid");
      bf16* wpad = (bf16*)(p.ws + W_WINT) + (size_t)INW * D;
      for (int i = i0; i < (ZLD - INW) * D; i += st) wpad[i] = 0; }
#ifndef P0DUP
#define P0DUP 0
#endif
#pragma unroll 1
    for (int it = bid; it < 192; it += nb) p0_mod_item(p, (LAS float*)lds, it);
    { int it = gw;
    if (it < NIT) {
#pragma unroll 1
        for (;;) {
            const int itn = it + NGW; TrItem nxt = cur;
            if (itn < NIT) { nxt = decode(itn); p0_tr_load16(nxt, tvB, lane); }
            p0_tr_store16(cur, tvA, lane);
            if (itn >= NIT) break;
            const int itn2 = itn + NGW; cur = nxt;
            if (itn2 < NIT) { cur = decode(itn2); p0_tr_load16(cur, tvA, lane); }
            p0_tr_store16(nxt, tvB, lane);
            if (itn2 >= NIT) break;
            it = itn2;
        } }
    }
}
constexpr int CONV_J0 = 18, CONV_P8 = 16;
__device__ __forceinline__ void p2_conv_share(PRef p, LAS unsigned char* lds, int bid, int nb) {
    if (bid < nb / 2) return;
    const int tid = otid(), lane = tid & 63, wave = __builtin_amdgcn_readfirstlane(tid >> 6);
    const int g = (bid - nb / 2) * 8 + wave;
    f32x4 tvA[8], tvB[8];
    TrItem cur = moe_item(p, g + CONV_J0 * (MOE_ITEMS / 24)), nxt = cur; p0_tr_load16(cur, tvA, lane);
#pragma unroll 1
    for (int j = CONV_J0; j < 24; j += 2) {
        if (j + 1 < 24) { nxt = moe_item(p, g + (j + 1) * (MOE_ITEMS / 24)); p0_tr_load16(nxt, tvB, lane); }
        p0_tr_store16(cur, tvA, lane);
        if (j + 1 >= 24) break;
        if (j + 2 < 24) { cur = moe_item(p, g + (j + 2) * (MOE_ITEMS / 24)); p0_tr_load16(cur, tvA, lane); }
        p0_tr_store16(nxt, tvB, lane);
    }
}
__device__ __forceinline__ void p1_h1(PRef p, int bid, int nb) {
    const float* __restrict__ x = p.in[I_X]; const float* __restrict__ g = p.in[I_N1G]; const float* mod = (const float*)(p.ws + W_MOD);
    bf16* H1 = (bf16*)(p.ws + W_H1);
    const int tid_ = otid(), lane = tid_ & 63, wv = tid_ >> 6;
    { float* ra = (float*)(p.ws + W_RA);
      for (int i = bid * NTHR + tid_; i < BATCH * D; i += nb * NTHR) { const int b = i >> 10, k = i & 1023; ra[i] = p.in[I_N2G][k] * (1.0f + mod[b * 6 * D + 4 * D + k]); } }
#pragma unroll 1
    for (int gw = bid * 8 + wv; gw < NTOK / 16; gw += nb * 8) {
        const int b = gw >> 8, row0 = b * SEQ + (gw & 255) * 2;
        const float* sh = mod + b * 6 * D; const float* sc = mod + b * 6 * D + D;
        f32x4 mm[4], hh[4];
#pragma unroll
        for (int j = 0; j < 4; ++j) { const int c0 = (lane + 64 * j) * 4; const f32x4 gg = *(const f32x4*)(g + c0), ss = *(const f32x4*)(sc + c0); hh[j] = *(const f32x4*)(sh + c0);
#pragma unroll
            for (int q = 0; q < 4; ++q) mm[j][q] = gg[q] * (1.0f + ss[q]); }
        const f32x4* xr = (const f32x4*)(x + (size_t)row0 * D) + lane;
        u32x2* o = (u32x2*)(H1 + (size_t)row0 * D) + lane;
        f32x4 va[2][4], vb[2][4];
        auto ld = [&](f32x4 (&v)[2][4], int s) __attribute__((always_inline)) {
#pragma unroll
            for (int j = 0; j < 4; ++j) { v[0][j] = __builtin_nontemporal_load(xr + s * (512 * 256) + 64 * j); v[1][j] = __builtin_nontemporal_load(xr + s * (512 * 256) + 256 + 64 * j); } };
        auto proc = [&](const f32x4 (&v)[2][4], int s) __attribute__((always_inline)) {
            float s0 = 0.f, s1 = 0.f;
#pragma unroll
            for (int j = 0; j < 4; ++j) { s0 += (v[0][j][0] * v[0][j][0] + v[0][j][1] * v[0][j][1]) + (v[0][j][2] * v[0][j][2] + v[0][j][3] * v[0][j][3]);
                                          s1 += (v[1][j][0] * v[1][j][0] + v[1][j][1] * v[1][j][1]) + (v[1][j][2] * v[1][j][2] + v[1][j][3] * v[1][j][3]); }
            const float r0 = rsqrtf(wave_sum_dpp(s0) * (1.0f / D) + 1e-6f), r1 = rsqrtf(wave_sum_dpp(s1) * (1.0f / D) + 1e-6f);
#pragma unroll
            for (int j = 0; j < 4; ++j) {
                f32x4 y0, y1;
#pragma unroll
                for (int q = 0; q < 4; ++q) { y0[q] = v[0][j][q] * r0 * mm[j][q] + hh[j][q]; y1[q] = v[1][j][q] * r1 * mm[j][q] + hh[j][q]; }
                u32x2 w0, w1; w0.x = pk2(y0[0], y0[1]); w0.y = pk2(y0[2], y0[3]); w1.x = pk2(y1[0], y1[1]); w1.y = pk2(y1[2], y1[3]);
                o[s * (512 * 256) + 64 * j] = w0; o[s * (512 * 256) + 256 + 64 * j] = w1;
            } };
        ld(va, 0);
#pragma unroll 1
        for (int s = 0; s < 8; s += 2) {
            ld(vb, s + 1);
            proc(va, s);
            ld(va, s + 2 < 8 ? s + 2 : 7);
            proc(vb, s + 1);
        }
    }
}
struct EpiZ {
    static constexpr bool PERM = true, AFTER_DRAIN = false;
    bf16* Z;
    __device__ __forceinline__ void operator()(const f32x4 (&acc)[2][2][4][2], const pg8::Unit& u, int wr, int wc, int fr, int fq) const {
        const int row0 = u.pm * 256 + wr * 64 + fr, col0 = u.pn * 256 + wc * 32 + 8 * fq;
        const bool act = u.pn < 4;
#pragma unroll
        for (int ai = 0; ai < 2; ++ai)
#pragma unroll
            for (int m = 0; m < 4; ++m) { bf16* rowp = Z + (size_t)(row0 + ai * 128 + m * 16) * ZLD + col0;
#pragma unroll
                for (int bj = 0; bj < 2; ++bj) { f32x4 v0 = acc[ai][bj][m][0], v1 = acc[ai][bj][m][1];
                    if (act) {
#pragma unroll
                        for (int q = 0; q < 4; ++q) { v0[q] = gelu_fast(v0[q]); v1[q] = gelu_fast(v1[q]); } }
                    u32x4 w; w.x = pg8::cvt_pk_bf16(v0[0], v0[1]); w.y = pg8::cvt_pk_bf16(v0[2], v0[3]); w.z = pg8::cvt_pk_bf16(v1[0], v1[1]); w.w = pg8::cvt_pk_bf16(v1[2], v1[3]);
                    *(u32x4*)(rowp + bj * 128) = w; } }
    }
};
constexpr int VNT_PITCH = 272;
__device__ __forceinline__ void p3_gmlp_unit(PRef p, LAS unsigned char* lds, int chunk) {
    typedef short bf16x8 __attribute__((ext_vector_type(8)));
    const int tid = otid(), lane = tid & 63, wave = __builtin_amdgcn_readfirstlane(tid >> 6);
    const bf16* Z = (const bf16*)(p.ws + W_Z); bf16* ycat = (bf16*)(p.ws + W_YCAT);
    const int t0 = chunk * CHUNK;
    { float lw[8], lb[8];
#pragma unroll
      for (int j = 0; j < 8; ++j) { lw[j] = p.in[I_GLNW][lane + 64 * j]; lb[j] = p.in[I_GLNB][lane + 64 * j]; }
      unsigned short raw[16][8];
      { const bf16* vp = Z + (size_t)(t0 + wave * 16) * ZLD + 512 + lane;
#pragma unroll
        for (int u = 0; u < 16; ++u)
#pragma unroll
            for (int j = 0; j < 8; ++j) raw[u][j] = vp[u * ZLD + 64 * j]; }
#pragma unroll
      for (int pr = 0; pr < 8; ++pr) {
          const int s = wave * 16 + pr * 2;
          float a[8], b[8]; float sa = 0.f, sb = 0.f;
#pragma unroll
          for (int j = 0; j < 8; ++j) { a[j] = bf2f(raw[pr * 2][j]); b[j] = bf2f(raw[pr * 2 + 1][j]); sa += a[j]; sb += b[j]; }
          const float ma = wave_sum_dpp(sa) * (1.f / 512.f), mb = wave_sum_dpp(sb) * (1.f / 512.f); float qa = 0.f, qb = 0.f;
#pragma unroll
          for (int j = 0; j < 8; ++j) { a[j] -= ma; b[j] -= mb; qa += a[j] * a[j]; qb += b[j] * b[j]; }
          const float ra = rsqrtf(wave_sum_dpp(qa) * (1.f / 512.f) + 1e-5f), rb = rsqrtf(wave_sum_dpp(qb) * (1.f / 512.f) + 1e-5f);
#pragma unroll
          for (int j = 0; j < 8; ++j) { const unsigned w = pk2(a[j] * ra * lw[j] + lb[j], b[j] * rb * lw[j] + lb[j]);
              *(LAS unsigned*)(lds + (lane + 64 * j) * VNT_PITCH + s * 2) = w; }
      } }
    const bf16* Wc = (const bf16*)(p.ws + W_WC) + (size_t)wave * CHUNK * CHUNK;
    const int fr = lane & 15, fq = lane >> 4;
    const LAS unsigned char* abase = lds + (wave * 64 + 8 * (fr >> 2) + (fr & 3)) * VNT_PITCH + fq * 16;
    bf16x8 bfr[20]; u32x4 uw[8][2]; float bsv[8];
    { int fi = 0;
#pragma unroll
      for (int tt = 0; tt < 8; ++tt) { const int nks = ((tt * 16 + 15) >> 5) + 1;
#pragma unroll
          for (int ks = 0; ks < nks; ++ks) bfr[fi++] = *(const bf16x8*)(Wc + (tt * 16 + fr) * CHUNK + ks * 32 + fq * 8); } }
    { const bf16* zu = Z + (size_t)(t0 + fr) * ZLD + wave * 64 + fq * 8;
#pragma unroll
      for (int tt = 0; tt < 8; ++tt) { bsv[tt] = p.in[I_GBS][wave * CHUNK + tt * 16 + fr];
#pragma unroll
          for (int pp = 0; pp < 2; ++pp) uw[tt][pp] = *(const u32x4*)(zu + tt * 16 * ZLD + pp * 32); } }
    __syncthreads();
    { int fi = 0;
      bf16* yo = ycat + (size_t)(t0 + fr) * 1024 + wave * 64 + fq * 8;
#pragma unroll
      for (int tt = 0; tt < 8; ++tt) {
        f32x4 acc[4];
#pragma unroll
        for (int dt = 0; dt < 4; ++dt) acc[dt] = (f32x4){0.f, 0.f, 0.f, 0.f};
        const int nks = ((tt * 16 + 15) >> 5) + 1;
#pragma unroll
        for (int ks = 0; ks < nks; ++ks) {
#pragma unroll
            for (int dt = 0; dt < 4; ++dt) {
                const bf16x8 afr = *(const LAS bf16x8*)(abase + (32 * (dt >> 1) + 4 * (dt & 1)) * VNT_PITCH + ks * 64);
                acc[dt] = __builtin_amdgcn_mfma_f32_16x16x32_bf16(afr, bfr[fi], acc[dt], 0, 0, 0);
            }
            ++fi;
        }
#pragma unroll
        for (int pp = 0; pp < 2; ++pp) {
            const u32x4 w4 = uw[tt][pp]; const f32x4 a0 = acc[2 * pp], a1 = acc[2 * pp + 1]; const float bs = bsv[tt];
            u32x4 o; o.x = pk2(bflo(w4.x) * (a0[0] + bs), bfhi(w4.x) * (a0[1] + bs)); o.y = pk2(bflo(w4.y) * (a0[2] + bs), bfhi(w4.y) * (a0[3] + bs));
            o.z = pk2(bflo(w4.z) * (a1[0] + bs), bfhi(w4.z) * (a1[1] + bs)); o.w = pk2(bflo(w4.w) * (a1[2] + bs), bfhi(w4.w) * (a1[3] + bs));
            *(u32x4*)(yo + tt * 16 * 1024 + pp * 32) = o;
        }
      } }
    __syncthreads();
}
constexpr size_t W_X1B = 240 * MiB;
struct EpiX1 {
    static constexpr bool PERM = true, AFTER_DRAIN = false;
    const float* x; const float* mod; bf16* x1;
    __device__ __forceinline__ void operator()(const f32x4 (&acc)[2][2][4][2], const pg8::Unit& u, int wr, int wc, int fr, int fq) const {
        const int row0 = u.pm * 256 + wr * 64 + fr, col0 = u.pn * 256 + wc * 32 + 8 * fq;
        const int b = (u.pm * 256) / SEQ;
        const float* gt = mod + b * 6 * D + 2 * D;
#pragma unroll
        for (int bj = 0; bj < 2; ++bj) { const f32x4 g0 = *(const f32x4*)(gt + col0 + bj * 128), g1 = *(const f32x4*)(gt + col0 + bj * 128 + 4);
#pragma unroll
            for (int ai = 0; ai < 2; ++ai)
#pragma unroll
                for (int m = 0; m < 4; ++m) { const size_t off = (size_t)(row0 + ai * 128 + m * 16) * D + col0 + bj * 128;
                    const f32x4 x0 = *(const f32x4*)(x + off), xb = *(const f32x4*)(x + off + 4);
                    const f32x4 v0 = x0 + g0 * acc[ai][bj][m][0], v1 = xb + g1 * acc[ai][bj][m][1];
                    u32x4 w; w.x = pg8::cvt_pk_bf16(v0[0], v0[1]); w.y = pg8::cvt_pk_bf16(v0[2], v0[3]); w.z = pg8::cvt_pk_bf16(v1[0], v1[1]); w.w = pg8::cvt_pk_bf16(v1[2], v1[3]);
                    *(u32x4*)(x1 + off) = w; } }
    }
};
constexpr size_t W_A2 = 112 * MiB;
constexpr size_t W_Q = 112 * MiB;
constexpr size_t W_Y2 = 144 * MiB;
constexpr size_t T_RK = W_TAB + 4 * MiB;
constexpr size_t O_M = 0, O_N = 64 * MiB;
constexpr size_t W_S = 176 * MiB;
constexpr int SCL = 64, NCH = SEQ / SCL;

__device__ __forceinline__ float sigmoid_fast(float x) { return __builtin_amdgcn_rcpf(1.0f + __builtin_amdgcn_exp2f(-1.4426950409f * x)); }
__device__ __forceinline__ void p3_lorain(PRef p, int bid, int nb) {
    const bf16* Z = (const bf16*)(p.ws + W_Z); bf16* A2 = (bf16*)(p.ws + W_A2);
    const int tid = otid(), j = tid & 255, sub = tid >> 8;
    const int jc = j < 160 ? j : 159;
    const float muj = p.in[I_MU][1536 + jc];
    const float sm = j < 32 ? 2.f : 1.f, sa = j < 32 ? 2.f : (j >= 64 && j < 160) ? 1.f : 0.f, sb = j < 32 ? -1.f : 0.f, sl = (j >= 32 && j < 64) ? 1.f : 0.f;
#pragma unroll 1
    for (int blk = bid; blk < NTOK / 128; blk += nb) {
        const int ts = blk * 128 + sub * 64;
        const bf16* zp = Z + (size_t)ts * ZLD + 2560 + jc; bf16* ap = A2 + (size_t)ts * 256 + j;
        unsigned short raw[64];
        const unsigned short pv = zp[(ts % SEQ == 0) ? 0 : -ZLD];
#pragma unroll
        for (int t = 0; t < 64; ++t) raw[t] = zp[t * ZLD];
        float prev = (ts % SEQ == 0) ? 0.f : bf2f(pv);
#pragma unroll
        for (int t = 0; t < 64; ++t) { const float cur = bf2f(raw[t]); const float v = cur + (prev - cur) * muj; prev = cur;
            ap[t * 256] = (bf16)f2bf(sa * sigmoid_fast(sm * v) + sb + sl * v); }
    }
}
struct EpiLO {
    static constexpr bool PERM = true, AFTER_DRAIN = false;
    bf16* LO; const float* w0; const float* a0;
    __device__ __forceinline__ void operator()(const f32x4 (&acc)[2][2][4][2], const pg8::Unit& u, int wr, int wc, int fr, int fq) const {
        const int row0 = u.pm * 256 + wr * 64 + fr, col0 = u.pn * 256 + wc * 32 + 8 * fq, kind = u.pn >> 1;
#pragma unroll
        for (int bj = 0; bj < 2; ++bj) {
            f32x4 bv[2];
#pragma unroll
            for (int n = 0; n < 2; ++n) { const int ch = col0 + bj * 128 + 4 * n - kind * 512;
                bv[n] = kind == 0 ? *(const f32x4*)(w0 + ch) : kind == 1 ? *(const f32x4*)(a0 + ch) : (f32x4){0.f, 0.f, 0.f, 0.f}; }
#pragma unroll
            for (int ai = 0; ai < 2; ++ai)
#pragma unroll
                for (int m = 0; m < 4; ++m) { bf16* rowp = LO + (size_t)(row0 + ai * 128 + m * 16) * 1536 + col0 + bj * 128;
                    f32x4 v0 = acc[ai][bj][m][0] + bv[0], v1 = acc[ai][bj][m][1] + bv[1];
                    if (kind < 2) { const float sc = kind == 0 ? -0.6065306597f : 1.0f;
#pragma unroll
                        for (int q = 0; q < 4; ++q) { v0[q] = sc * sigmoid_fast(v0[q]); v1[q] = sc * sigmoid_fast(v1[q]); } }
                    u32x4 w; w.x = pg8::cvt_pk_bf16(v0[0], v0[1]); w.y = pg8::cvt_pk_bf16(v0[2], v0[3]); w.z = pg8::cvt_pk_bf16(v1[0], v1[1]); w.w = pg8::cvt_pk_bf16(v1[2], v1[3]);
                    *(u32x4*)rowp = w;
                    asm volatile("" ::: "memory"); }
        }
    }
};
constexpr int SC_TS = 8;
__device__ __forceinline__ void p5a_chunk(PRef p, LAS unsigned char* lds, int q) {
    typedef float f32x2 __attribute__((ext_vector_type(2)));
    const int tid_ = otid(), lane = tid_ & 63, wave = __builtin_amdgcn_readfirstlane(tid_ >> 6);
    const int seq = q / NCH, c = q % NCH, b = seq >> 3, h = seq & 7;
    const int tb = b * SEQ + c * SCL, hc = h * 64 + lane;
    const bf16* Z = (const bf16*)(p.ws + W_Z); const bf16* LO = (const bf16*)(p.ws + W_LO);
    bf16* Qo = (bf16*)(p.ws + W_Q); bf16* Y2o = (bf16*)(p.ws + W_Y2); bf16* VLo = (bf16*)(p.ws + W_YCAT); float* RKo = (float*)(p.ws + T_RK);
    LAS float* vec = (LAS float*)(lds + wave * (SC_TS * 6 * 256));
    const float mur = p.in[I_MU][hc], muk = p.in[I_MU][512 + hc], muv = p.in[I_MU][1024 + hc];
    const float kkc = p.in[I_KK][hc], kac = p.in[I_KA][hc], rkc = p.in[I_RK][hc];
    float rp = 0.f, kp = 0.f, vp = 0.f;
    if (c != 0) { const bf16* zp = Z + (size_t)(tb - 1) * ZLD + 1024 + hc; rp = bf2f(zp[0]); kp = bf2f(zp[512]); vp = bf2f(zp[1024]); }
    f32x2 Mr[32], Nr[32];
#pragma unroll
    for (int k = 0; k < 32; ++k) { Mr[k] = (f32x2){(2 * k == lane) ? 1.f : 0.f, (2 * k + 1 == lane) ? 1.f : 0.f}; Nr[k] = (f32x2){0.f, 0.f}; }
    for (int sb = 0; sb < SCL / SC_TS; ++sb) {
        const int t0 = tb + sb * SC_TS;
#pragma unroll 1
        for (int sg = 0; sg < SC_TS; sg += 4) { float zr[4], zk[4], zv[4], lw[4], as[4];
          const bf16* zp0 = Z + (unsigned)((t0 + sg) * ZLD + 1024 + hc); const bf16* lp0 = LO + (unsigned)((t0 + sg) * 1536 + hc);
#pragma unroll
          for (int s = 0; s < 4; ++s) { const bf16* zp = zp0 + s * ZLD; const bf16* lp = lp0 + s * 1536;
              zr[s] = bf2f(zp[0]); zk[s] = bf2f(zp[512]); zv[s] = bf2f(zp[1024]); lw[s] = bf2f(lp[0]); as[s] = bf2f(lp[512]); }
#pragma unroll
          for (int s = 0; s < 4; ++s) {
              const float r = zr[s] + (rp - zr[s]) * mur, k = zk[s] + (kp - zk[s]) * muk, v = zv[s] + (vp - zv[s]) * muv;
              rp = zr[s]; kp = zk[s]; vp = zv[s];
              const float kkv = k * kkc;
              const float nrm = sqrtf(wave_sum_dpp(kkv * kkv));
              const float kk = kkv / fmaxf(nrm, 1e-12f);
              const float k2 = k * (1.0f + (as[s] - 1.0f) * kac);
              const float rk = wave_sum_dpp(r * k2 * rkc);
              LAS float* o = vec + (sg + s) * 384 + lane;
              o[0] = __builtin_amdgcn_exp2f(1.4426950409f * lw[s]); o[64] = -kk; o[128] = kk * as[s]; o[192] = k2; o[256] = r; o[320] = v;
              VLo[(unsigned)((t0 + sg + s) * 1024 + 512 + hc)] = (bf16)f2bf(v);
              if (lane == 0) RKo[(unsigned)((t0 + sg + s) * 8 + h)] = rk;
          } }
        asm volatile("s_waitcnt lgkmcnt(0)" ::: "memory");
        for (int s = 0; s < SC_TS; ++s) {
            const LAS float* vs = vec + s * 384;
            const float vi = vs[320 + lane];
            f32x2 saM = {0.f, 0.f}, saN = {0.f, 0.f};
#pragma unroll
            for (int k4 = 0; k4 < 16; ++k4) { const f32x4 a4 = *(const LAS f32x4*)(vs + 64 + 4 * k4);
                const f32x2 a0 = {a4[0], a4[1]}, a1 = {a4[2], a4[3]};
                saM += Mr[2 * k4] * a0; saN += Nr[2 * k4] * a0; saM += Mr[2 * k4 + 1] * a1; saN += Nr[2 * k4 + 1] * a1;
                if ((k4 & 3) == 3) asm volatile("" ::: "memory"); }
            const float sM = saM[0] + saM[1], sN = saN[0] + saN[1];
            const f32x2 sM2 = {sM, sM}, sN2 = {sN, sN}, vi2 = {vi, vi};
            f32x2 yM = {0.f, 0.f}, yN = {0.f, 0.f};
#pragma unroll
            for (int k4 = 0; k4 < 16; ++k4) {
                const f32x4 w4 = *(const LAS f32x4*)(vs + 4 * k4), b4 = *(const LAS f32x4*)(vs + 128 + 4 * k4), k4v = *(const LAS f32x4*)(vs + 192 + 4 * k4), r4 = *(const LAS f32x4*)(vs + 256 + 4 * k4);
#pragma unroll
                for (int hh = 0; hh < 2; ++hh) {
                    const f32x2 w2 = {w4[2 * hh], w4[2 * hh + 1]}, b2 = {b4[2 * hh], b4[2 * hh + 1]}, k2 = {k4v[2 * hh], k4v[2 * hh + 1]}, r2 = {r4[2 * hh], r4[2 * hh + 1]};
                    const int kx = 2 * k4 + hh;
                    Mr[kx] = Mr[kx] * w2 + sM2 * b2;
                    Nr[kx] = Nr[kx] * w2 + (sN2 * b2 + vi2 * k2);
                    yM += Mr[kx] * r2; yN += Nr[kx] * r2;
                }
                asm volatile("" ::: "memory");
            }
            const unsigned oo = (unsigned)((t0 + s) * 512 + hc);
            Qo[oo] = (bf16)f2bf(yM[0] + yM[1]); Y2o[oo] = (bf16)f2bf(yN[0] + yN[1]);
        }
        asm volatile("s_waitcnt lgkmcnt(0)" ::: "memory");
    }
    f32x4* Mo = (f32x4*)((unsigned char*)p.out + O_M + (size_t)q * 16384 + lane * 256);
    f32x4* No = (f32x4*)((unsigned char*)p.out + O_N + (size_t)q * 16384 + lane * 256);
#pragma unroll
    for (int k4 = 0; k4 < 16; ++k4) { Mo[k4] = (f32x4){Mr[2 * k4][0], Mr[2 * k4][1], Mr[2 * k4 + 1][0], Mr[2 * k4 + 1][1]}; No[k4] = (f32x4){Nr[2 * k4][0], Nr[2 * k4][1], Nr[2 * k4 + 1][0], Nr[2 * k4 + 1][1]}; }
}
__device__ __forceinline__ void p5b_chain(PRef p, LAS unsigned char* lds, int item) {
    typedef float f32x2 __attribute__((ext_vector_type(2)));
    const int tid = otid(), r = tid >> 5, j0 = (tid & 31) * 2, seq = (item & 7) + 8 * (item >> 5), rg = (item >> 3) & 3;
    const unsigned char* Mb = (const unsigned char*)p.out + O_M + (size_t)seq * NCH * 16384;
    const unsigned char* Nb = (const unsigned char*)p.out + O_N + (size_t)seq * NCH * 16384 + (size_t)(rg * 16 + r) * 256 + j0 * 4;
    unsigned char* Sb = p.ws + W_S + (size_t)seq * NCH * 16384 + (size_t)(rg * 16 + r) * 256 + j0 * 4;
    f32x2 sreg = {0.f, 0.f};
    f32x4 m0[2], m1[2], m2[2], m3[2]; f32x2 n0, n1, n2, n3;
#define P5B_LOAD(mm, nn, cc) do { const f32x4* mp = (const f32x4*)(Mb + (size_t)(cc) * 16384) + tid; mm[0] = mp[0]; mm[1] = mp[512]; nn = *(const f32x2*)(Nb + (size_t)(cc) * 16384); } while (0)
#define P5B_BAR() do { asm volatile("s_waitcnt lgkmcnt(0)" ::: "memory"); __builtin_amdgcn_s_barrier(); asm volatile("" ::: "memory"); } while (0)
#define P5B_STEP(mm, nn, cc) do { \
        LAS float* Sl = (LAS float*)(lds + ((cc) & 1) * 20480); LAS float* Ml = Sl + 1024; \
        *(LAS f32x4*)(Ml + tid * 4) = mm[0]; *(LAS f32x4*)(Ml + 2048 + tid * 4) = mm[1]; *(LAS f32x2*)(Sl + r * 64 + j0) = sreg; \
        *(f32x2*)(Sb + (size_t)(cc) * 16384) = sreg; \
        f32x2 acc = nn; \
        P5B_BAR(); \
        if ((cc) + 4 < NCH) P5B_LOAD(mm, nn, (cc) + 4); \
        _Pragma("unroll 16") for (int i = 0; i < 64; ++i) { const float sv = Sl[r * 64 + i]; const f32x2 mv = *(const LAS f32x2*)(Ml + i * 64 + j0); acc += (f32x2){sv, sv} * mv; } \
        sreg = acc; } while (0)
    __syncthreads();
    P5B_LOAD(m0, n0, 0); P5B_LOAD(m1, n1, 1); P5B_LOAD(m2, n2, 2); P5B_LOAD(m3, n3, 3);
    for (int c = 0; c < NCH; c += 4) { P5B_STEP(m0, n0, c); P5B_STEP(m1, n1, c + 1); P5B_STEP(m2, n2, c + 2); P5B_STEP(m3, n3, c + 3); }
    __syncthreads();
#undef P5B_LOAD
#undef P5B_STEP
#undef P5B_BAR
}
#ifndef P5C_MASK
#define P5C_MASK(c, h, tt) true
#endif
__device__ __forceinline__ void p5c_stage_g2(PRef p, LAS unsigned char* lds, int h) {
    typedef short bf16x8 __attribute__((ext_vector_type(8)));
    const int tid = otid(), lane = tid & 63, wave = __builtin_amdgcn_readfirstlane(tid >> 6), fr = lane & 15, fq = lane >> 4;
    const bf16* LT = (const bf16*)(p.ws + W_LORAT);
    for (int f = wave; f < 12; f += 8) { const int vt = f / 3, ks = f % 3;
        *(LAS bf16x8*)(lds + 8 * 4352 + (f * 64 + lane) * 16) = *(const bf16x8*)(LT + (1024 + h * 64 + vt * 16 + fr) * 256 + 64 + ks * 32 + fq * 8); }
    __syncthreads();
}
struct P5cOps { short __attribute__((ext_vector_type(8))) qb0, qb1, ag0, ag1, ag2; u32x4 y2a, y2b, zca, zcb, zpa, zpb; float rk; };
__device__ __forceinline__ void p5c_chunk(PRef p, LAS unsigned char* lds, int q) {
    typedef short bf16x8 __attribute__((ext_vector_type(8)));
    const int tid_ = otid(), lane = tid_ & 63, wave = __builtin_amdgcn_readfirstlane(tid_ >> 6), fr = lane & 15, fq = lane >> 4;
    const int tk = lane >> 2, pc = lane & 3;
    const int seq = q / NCH, c = q % NCH, b = seq >> 3, h = seq & 7, tb = b * SEQ + c * SCL;
    const bf16* Qi = (const bf16*)(p.ws + W_Q); const bf16* Y2i = (const bf16*)(p.ws + W_Y2);
    const float* RKi = (const float*)(p.ws + T_RK); const bf16* LO = (const bf16*)(p.ws + W_LO); bf16* ycat = (bf16*)(p.ws + W_YCAT);
    const bf16* Sc = (const bf16*)(p.ws + W_YCAT) + (size_t)tb * 1024 + 512 + h * 64;
    LAS float* yt = (LAS float*)(lds + wave * 4352);
    bf16x8 sa[4][2];
#pragma unroll
    for (int vt = 0; vt < 4; ++vt)
#pragma unroll
        for (int ks = 0; ks < 2; ++ks) sa[vt][ks] = *(const bf16x8*)(Sc + (vt * 16 + fr) * 1024 + ks * 32 + fq * 8);
    auto ld = [&](P5cOps& o, int tt) __attribute__((always_inline)) {
        const unsigned tq = (unsigned)((tb + tt * 16 + fr) * 512 + h * 64);
        o.qb0 = *(const bf16x8*)(Qi + (tq + fq * 8)); o.qb1 = *(const bf16x8*)(Qi + (tq + 32 + fq * 8));
        const int t = tb + tt * 16 + tk;
        const unsigned o512 = (unsigned)(t * 512 + h * 64 + pc * 16), o1024 = (unsigned)(t * 1024 + 512 + h * 64 + pc * 16), olo = (unsigned)(t * 1536 + 1024 + h * 64 + pc * 16);
        o.y2a = *(const u32x4*)(Y2i + o512); o.y2b = *(const u32x4*)(Y2i + o512 + 8);
        { const bf16* Z = (const bf16*)(p.ws + W_Z); const unsigned oz = (unsigned)(t * ZLD + 2048 + h * 64 + pc * 16);
          o.zca = *(const u32x4*)(Z + oz); o.zcb = *(const u32x4*)(Z + oz + 8);
          o.zpa = (u32x4){0u, 0u, 0u, 0u}; o.zpb = o.zpa;
          if (tk == 0 && (t % SEQ)) { o.zpa = *(const u32x4*)(Z + oz - ZLD); o.zpb = *(const u32x4*)(Z + oz - ZLD + 8); } }
        { const unsigned og = (unsigned)((tb + tt * 16 + fr) * 1536 + 1024 + fq * 8);
          o.ag0 = *(const bf16x8*)(LO + og); o.ag1 = *(const bf16x8*)(LO + og + 32); o.ag2 = *(const bf16x8*)(LO + og + 64); }
        o.rk = RKi[(unsigned)(t * 8 + h)]; };
    LAS unsigned char* g2l = lds + 8 * 4352 + lane * 16;
    P5cOps oa, ob; ld(oa, 0);
    f32x4 gw[4], gb[4];
#pragma unroll
    for (int i = 0; i < 4; ++i) { gw[i] = *(const f32x4*)(p.in[I_GNW] + h * 64 + pc * 16 + i * 4); gb[i] = *(const f32x4*)(p.in[I_GNB] + h * 64 + pc * 16 + i * 4); }
    f32x4 muv[4];
#pragma unroll
    for (int i = 0; i < 4; ++i) muv[i] = *(const f32x4*)(p.in[I_MU] + 1024 + h * 64 + pc * 16 + i * 4);
    auto proc = [&](const P5cOps& o, int tt) __attribute__((always_inline)) {
        const float pmk = ((tb + tt * 16 + tk) % SEQ) ? 1.f : 0.f;
        const unsigned o1024 = (unsigned)((tb + tt * 16 + tk) * 1024 + 512 + h * 64 + pc * 16);
#pragma unroll
        for (int vt = 0; vt < 4; ++vt) {
            f32x4 a = {0.f, 0.f, 0.f, 0.f};
            a = __builtin_amdgcn_mfma_f32_16x16x32_bf16(sa[vt][0], o.qb0, a, 0, 0, 0);
            a = __builtin_amdgcn_mfma_f32_16x16x32_bf16(sa[vt][1], o.qb1, a, 0, 0, 0);
            *(LAS f32x4*)(yt + fr * 68 + vt * 16 + 4 * fq) = a;
        }
        asm volatile("s_waitcnt lgkmcnt(0)" ::: "memory");
        f32x4 y[4];
#pragma unroll
        for (int i = 0; i < 4; ++i) y[i] = *(const LAS f32x4*)(yt + tk * 68 + pc * 16 + i * 4);
        asm volatile("s_waitcnt lgkmcnt(0)" ::: "memory");
        f32x4 gq[4];
        {
#pragma unroll
          for (int vt = 0; vt < 4; ++vt) {
              f32x4 a = {0.f, 0.f, 0.f, 0.f};
              a = __builtin_amdgcn_mfma_f32_16x16x32_bf16(*(const LAS bf16x8*)(g2l + (vt * 3 + 0) * 1024), o.ag0, a, 0, 0, 0);
              a = __builtin_amdgcn_mfma_f32_16x16x32_bf16(*(const LAS bf16x8*)(g2l + (vt * 3 + 1) * 1024), o.ag1, a, 0, 0, 0);
              a = __builtin_amdgcn_mfma_f32_16x16x32_bf16(*(const LAS bf16x8*)(g2l + (vt * 3 + 2) * 1024), o.ag2, a, 0, 0, 0);
              *(LAS f32x4*)(yt + fr * 68 + vt * 16 + 4 * fq) = a; }
          asm volatile("s_waitcnt lgkmcnt(0)" ::: "memory");
#pragma unroll
          for (int i = 0; i < 4; ++i) gq[i] = *(const LAS f32x4*)(yt + tk * 68 + pc * 16 + i * 4);
          asm volatile("s_waitcnt lgkmcnt(0)" ::: "memory"); }
        const unsigned y2w[8] = {o.y2a.x, o.y2a.y, o.y2a.z, o.y2a.w, o.y2b.x, o.y2b.y, o.y2b.z, o.y2b.w};
        float s = 0.f;
#pragma unroll
        for (int i = 0; i < 4; ++i) { y[i][0] += bflo(y2w[2 * i]); y[i][1] += bfhi(y2w[2 * i]); y[i][2] += bflo(y2w[2 * i + 1]); y[i][3] += bfhi(y2w[2 * i + 1]); s += (y[i][0] + y[i][1]) + (y[i][2] + y[i][3]); }
        DPP_ADD(s, 0xB1); DPP_ADD(s, 0x4E);
        const float m = s * (1.f / 64.f); float qq = 0.f;
#pragma unroll
        for (int i = 0; i < 4; ++i) { y[i] = y[i] - m; qq += (y[i][0] * y[i][0] + y[i][1] * y[i][1]) + (y[i][2] * y[i][2] + y[i][3] * y[i][3]); }
        DPP_ADD(qq, 0xB1); DPP_ADD(qq, 0x4E);
        const float rs = rsqrtf(qq * (1.f / 64.f) + 64e-5f);
        const unsigned zcw[8] = {o.zca.x, o.zca.y, o.zca.z, o.zca.w, o.zcb.x, o.zcb.y, o.zcb.z, o.zcb.w}, zp0[8] = {o.zpa.x, o.zpa.y, o.zpa.z, o.zpa.w, o.zpb.x, o.zpb.y, o.zpb.z, o.zpb.w};
        unsigned zpw[8];
#pragma unroll
        for (int i = 0; i < 8; ++i) { const unsigned sh_ = (unsigned)__builtin_amdgcn_ds_bpermute(((lane - 4) & 63) * 4, (int)zcw[i]); zpw[i] = tk == 0 ? zp0[i] : sh_; }
        unsigned ow[8];
#pragma unroll
        for (int i = 0; i < 4; ++i) {
            const f32x4 zc4 = {bflo(zcw[2 * i]), bfhi(zcw[2 * i]), bflo(zcw[2 * i + 1]), bfhi(zcw[2 * i + 1])}, zp4 = {bflo(zpw[2 * i]), bfhi(zpw[2 * i]), bflo(zpw[2 * i + 1]), bfhi(zpw[2 * i + 1])};
            const f32x4 vv = zc4 + (zp4 * pmk - zc4) * muv[i];
            const f32x4 ov = (y[i] * rs * gw[i] + gb[i] + vv * o.rk) * gq[i];
            ow[2 * i] = pg8::cvt_pk_bf16(ov[0], ov[1]); ow[2 * i + 1] = pg8::cvt_pk_bf16(ov[2], ov[3]); }
        *(u32x4*)(ycat + o1024) = (u32x4){ow[0], ow[1], ow[2], ow[3]}; *(u32x4*)(ycat + o1024 + 8) = (u32x4){ow[4], ow[5], ow[6], ow[7]}; };
#pragma unroll 1
    for (int tt = 0; tt < SCL / 16; tt += 2) { ld(ob, tt + 1); proc(oa, tt); ld(oa, tt + 2 < SCL / 16 ? tt + 2 : tt + 1); proc(ob, tt + 1); }
}
constexpr size_t W_H2 = 112 * MiB;
constexpr size_t W_XS = 176 * MiB;
constexpr size_t W_HB = 320 * MiB;
constexpr int PROWS = NTOK * 2 + NE * 256, PTILES = PROWS / 256;
constexpr size_t T_HIST = W_TAB + 3 * 1024 * 1024 + 8192;
constexpr size_t T_NT = W_TAB + 3 * 1024 * 1024 + 4096;
constexpr size_t T_BQ = W_TAB + 3 * 1024 * 1024 + 65536;
constexpr int TPW = NTOK / 256;

__device__ __forceinline__ void p1_bq(PRef p, LAS float* red, int b) {
    const int tid = otid();
    const float* sh = (const float*)(p.ws + W_MOD) + b * 6 * D + 3 * D;
    if (tid < 288) { const int q = tid % 36, part = tid / 36; float s = 0.f;
        for (int c = part * 128; c < part * 128 + 128; ++c) s = fmaf(sh[c], q < 4 ? p.in[I_RGW][c * 4 + q] : p.in[I_REW][c * 32 + q - 4], s);
        red[part * 36 + q] = s; }
    __syncthreads();
    if (tid < 36) { float s = 0.f;
#pragma unroll
        for (int k = 0; k < 8; ++k) s += red[k * 36 + tid];
        ((float*)(p.ws + T_BQ))[b * 36 + tid] = s + (tid < 4 ? p.in[I_RGB][tid] : p.in[I_REB][tid - 4]); }
    __syncthreads();
}
__device__ __forceinline__ void p7_route(PRef p, LAS unsigned char* lds, int bid) {
    const int tid = otid(), lane = tid & 63, wave = __builtin_amdgcn_readfirstlane(tid >> 6);
    const float* x1 = p.out; bf16* H2 = (bf16*)(p.ws + W_H2);
    LAS int* hist = (LAS int*)(lds + 147456);
    const int b = (bid * TPW) / SEQ;
    const float* mod = (const float*)(p.ws + W_MOD) + b * 6 * D;
    const float* n2g = p.in[I_N2G];
    for (int ch = tid; ch < 1024 * 8; ch += NTHR) { const int c = ch >> 3, i = ch & 7;
        *(LAS f32x4*)(lds + c * 128 + 16 * (i ^ ((c >> 1) & 7))) = *(const f32x4*)(p.in[I_REW] + c * 32 + i * 4); }
    for (int c = tid; c < 1024; c += NTHR) *(LAS f32x4*)(lds + 131072 + c * 16) = *(const f32x4*)(p.in[I_RGW] + c * 4);
    if (tid < 32) hist[tid] = 0;
    if (tid < 36) *(LAS float*)(lds + 147456 + 128 + 4 * tid) = tid < 4 ? p.in[I_RGB][tid] : p.in[I_REB][tid - 4];
    __syncthreads();
    const int sw = (lane >> 1) & 7;
#pragma unroll 1
    for (int tp = 0; tp < TPW / 8; tp += 2) {
        const int t0 = bid * TPW + wave * (TPW / 8) + tp;
        const float* xr0 = x1 + (size_t)t0 * D; bf16* hr0 = H2 + (size_t)t0 * D;
        float r0, r1;
        { float pa[16], pb[16];
#pragma unroll
          for (int j = 0; j < 16; ++j) { pa[j] = xr0[lane + 64 * j]; pb[j] = xr0[D + lane + 64 * j]; }
          float ss0 = 0.f, ss1 = 0.f;
#pragma unroll
          for (int j = 0; j < 16; ++j) { ss0 = fmaf(pa[j], pa[j], ss0); ss1 = fmaf(pb[j], pb[j], ss1); }
          r0 = rsqrtf(wave_sum_v(ss0) * (1.0f / D) + 1e-6f); r1 = rsqrtf(wave_sum_v(ss1) * (1.0f / D) + 1e-6f); }
        float acc[2][36];
#pragma unroll
        for (int u = 0; u < 2; ++u)
#pragma unroll
            for (int q = 0; q < 36; ++q) acc[u][q] = 0.f;
#pragma unroll 1
        for (int j0 = 0; j0 < 16; j0 += 4) {
            float xa[4], xb[4], gv[4], sv[4];
#pragma unroll
            for (int jj = 0; jj < 4; ++jj) { const int c = lane + 64 * (j0 + jj); xa[jj] = xr0[c]; xb[jj] = xr0[D + c]; gv[jj] = n2g[c] * (1.0f + mod[4 * D + c]); sv[jj] = mod[3 * D + c]; }
#pragma unroll
            for (int jj = 0; jj < 4; ++jj) {
                const int c = lane + 64 * (j0 + jj);
                const float a0 = xa[jj] * r0 * gv[jj] + sv[jj], a1 = xb[jj] * r1 * gv[jj] + sv[jj];
                hr0[c] = (bf16)f2bf(a0); hr0[D + c] = (bf16)f2bf(a1);
                const LAS unsigned char* rowp = lds + c * 128;
                { const f32x4 w = *(const LAS f32x4*)(lds + 131072 + c * 16);
#pragma unroll
                  for (int q = 0; q < 4; ++q) { acc[0][q] = fmaf(a0, w[q], acc[0][q]); acc[1][q] = fmaf(a1, w[q], acc[1][q]); } }
#pragma unroll
                for (int i = 0; i < 8; ++i) { const f32x4 w = *(const LAS f32x4*)(rowp + 16 * (i ^ sw));
#pragma unroll
                    for (int q = 0; q < 4; ++q) { acc[0][4 + 4 * i + q] = fmaf(a0, w[q], acc[0][4 + 4 * i + q]); acc[1][4 + 4 * i + q] = fmaf(a1, w[q], acc[1][4 + 4 * i + q]); } }
            }
        }
#pragma unroll
        for (int u = 0; u < 2; ++u) {
            float lg[36];
#pragma unroll
            for (int q = 0; q < 36; ++q) { lg[q] = wave_sum_v(acc[u][q]); if ((q & 3) == 3) __builtin_amdgcn_sched_barrier(0); }
            unsigned bqo = 147456u + 128u; asm volatile("" : "+v"(bqo));
#pragma unroll
            for (int q = 0; q < 36; ++q) lg[q] += *(const LAS float*)(lds + bqo + 4 * q);
            int gi = 0; float gm = lg[0];
#pragma unroll
            for (int q = 1; q < 4; ++q) if (lg[q] > gm) { gm = lg[q]; gi = q; }
            float gsum = 0.f;
#pragma unroll
            for (int q = 0; q < 4; ++q) gsum += expf(lg[q] - gm);
            const float gp = 1.0f / gsum;
            float el[8];
#pragma unroll
            for (int q = 0; q < 8; ++q) el[q] = gi == 0 ? lg[4 + q] : gi == 1 ? lg[12 + q] : gi == 2 ? lg[20 + q] : lg[28 + q];
            int i0 = 0; float m0 = el[0];
#pragma unroll
            for (int q = 1; q < 8; ++q) if (el[q] > m0) { m0 = el[q]; i0 = q; }
            int i1 = -1; float m1 = -3.0e38f;
#pragma unroll
            for (int q = 0; q < 8; ++q) if (q != i0 && el[q] > m1) { m1 = el[q]; i1 = q; }
            const float p1 = expf(m1 - m0);
            const float w0 = gp / (1.0f + p1), w1 = gp * p1 / (1.0f + p1);
            if (lane == 0) { const int t = t0 + u, e0 = gi * 8 + i0, e1 = gi * 8 + i1;
                int* toke = (int*)(p.ws + T_TOKE); float* tokw = (float*)(p.ws + T_TOKW);
                toke[t * 2] = e0; toke[t * 2 + 1] = e1; tokw[t * 2] = w0; tokw[t * 2 + 1] = w1;
                __hip_atomic_fetch_add(&hist[e0], 1, __ATOMIC_RELAXED, __HIP_MEMORY_SCOPE_WORKGROUP); __hip_atomic_fetch_add(&hist[e1], 1, __ATOMIC_RELAXED, __HIP_MEMORY_SCOPE_WORKGROUP); }
        }
    }
    __syncthreads();
    if (tid < 32) ((int*)(p.ws + T_HIST))[bid * 32 + tid] = hist[tid];
    __syncthreads();
}
__device__ __forceinline__ void p8_place(PRef p, LAS unsigned char* lds, int bid) {
    const int tid = otid(), lane = tid & 63, wave = __builtin_amdgcn_readfirstlane(tid >> 6);
    f32x4 ctv[8]; const TrItem citem = moe_item(p, CONV_P8 * (MOE_ITEMS / 24) + bid * 8 + wave); p0_tr_load16(citem, ctv, lane);
    LAS int* ptot = (LAS int*)lds;
    LAS int* pbef = ptot + 512;
    LAS int* base = pbef + 512;
    LAS int* lcur = base + 32;
    LAS int* posl = lcur + 32;
    LAS int* padb = posl + 256;
    const int* hist = (const int*)(p.ws + T_HIST);
    const int a_pre = bid * 256 + (tid & 255); const int e_pre = ((const int*)(p.ws + T_TOKE))[a_pre]; const float w_pre = ((const float*)(p.ws + T_TOKW))[a_pre];
    { const int e = tid & 31, part = tid >> 5; int tot = 0, bef = 0; int hc[16];
#pragma unroll
      for (int w = 0; w < 16; ++w) hc[w] = hist[(part * 16 + w) * 32 + e];
#pragma unroll
      for (int w = 0; w < 16; ++w) { tot += hc[w]; bef += (part * 16 + w < bid) ? hc[w] : 0; }
      ptot[part * 32 + e] = tot; pbef[part * 32 + e] = bef; }
    __syncthreads();
    if (tid < 32) { int tot = 0, bef = 0;
#pragma unroll
        for (int k = 0; k < 16; ++k) { tot += ptot[k * 32 + tid]; bef += pbef[k * 32 + tid]; }
        ptot[tid] = tot; pbef[tid] = bef; lcur[tid] = 0; }
    __syncthreads();
    if (tid == 0) { int row = 0;
        for (int e = 0; e < NE; ++e) { const int cnt = ptot[e], nt = (cnt + 255) >> 8; base[e] = row + pbef[e]; padb[e] = row + cnt; padb[32 + e] = row + nt * 256;
            if (bid == 0) { int* te = (int*)(p.ws + T_TILEE); for (int k = 0; k < nt; ++k) te[(row >> 8) + k] = e; }
            row += nt * 256; }
        if (bid == 0) *(int*)(p.ws + T_NT) = row >> 8; }
    __syncthreads();
    int* rowaid = (int*)(p.ws + T_ROWAID); float* roww = (float*)(p.ws + T_ROWW);
    if (tid < 256) { const int a = a_pre, e = e_pre;
        const int pos = base[e] + __hip_atomic_fetch_add(&lcur[e], 1, __ATOMIC_RELAXED, __HIP_MEMORY_SCOPE_WORKGROUP);
        posl[tid] = pos; rowaid[pos] = a; roww[pos] = w_pre; }
    if (bid < NE) for (int r = padb[bid] + tid; r < padb[32 + bid]; r += NTHR) { rowaid[r] = -1; roww[r] = 0.f; }
    p0_tr_store16(citem, ctv, lane);
    __syncthreads();
}
template <bool GATHER_>
struct MoeOrder {
    static constexpr bool GATHER = GATHER_;
    const int* tile_e; const int* rowaid; int nM, G, c;
    __device__ __forceinline__ int rowsrc(int row) const { const int a = rowaid[row]; return (a < 0 ? 0 : a) >> 1; }
    __device__ __forceinline__ bool next(int i, pg8::Unit& u) const {
        const int nwg = nM * 4; const long L = (long)i * G + c; if (L >= nwg) return false;
        int wgid = (int)L; { const int q = nwg / 8, r = nwg % 8, xcd = wgid % 8, off = wgid / 8; wgid = (xcd < r ? xcd * (q + 1) : r * (q + 1) + (xcd - r) * q) + off; }
        const int nig = 8 * 4, gid = wgid / nig, fm = gid * 8, gsz = (nM - fm) < 8 ? (nM - fm) : 8;
        u.pm = fm + ((wgid % nig) % gsz); u.pn = (wgid % nig) / gsz; u.pb = tile_e[u.pm] * 4 + u.pn; return true;
    }
    __device__ __forceinline__ void a_ready(const pg8::Unit&) const {}
    __device__ __forceinline__ void done(const pg8::Unit&) const {}
};
__device__ __forceinline__ float silu_fast(float x) { return x * __builtin_amdgcn_rcpf(1.0f + __builtin_amdgcn_exp2f(-1.4426950409f * x)); }
struct EpiH {
    static constexpr bool PERM = true, AFTER_DRAIN = false;
    bf16* H;
    __device__ __forceinline__ void operator()(const f32x4 (&acc)[2][2][4][2], const pg8::Unit& u, int wr, int wc, int fr, int fq) const {
        const int row0 = u.pm * 256 + wr * 64 + fr, col0 = u.pn * 128 + wc * 32 + 8 * fq;
#pragma unroll
        for (int ai = 0; ai < 2; ++ai)
#pragma unroll
            for (int m = 0; m < 4; ++m) { const f32x4 g0 = acc[ai][0][m][0], g1 = acc[ai][0][m][1], u0 = acc[ai][1][m][0], u1 = acc[ai][1][m][1];
                f32x4 h0, h1;
#pragma unroll
                for (int q = 0; q < 4; ++q) { h0[q] = silu_fast(g0[q]) * u0[q]; h1[q] = silu_fast(g1[q]) * u1[q]; }
                u32x4 w; w.x = pg8::cvt_pk_bf16(h0[0], h0[1]); w.y = pg8::cvt_pk_bf16(h0[2], h0[3]); w.z = pg8::cvt_pk_bf16(h1[0], h1[1]); w.w = pg8::cvt_pk_bf16(h1[2], h1[3]);
                *(u32x4*)(H + (size_t)(row0 + ai * 128 + m * 16) * EH + col0) = w; }
    }
};
struct EpiY {
    static constexpr bool PERM = true, AFTER_DRAIN = false;
    bf16* YB; const int* rowaid; const float* roww;
    __device__ __forceinline__ void operator()(const f32x4 (&acc)[2][2][4][2], const pg8::Unit& u, int wr, int wc, int fr, int fq) const {
        const int row0 = u.pm * 256 + wr * 64 + fr, col0 = u.pn * 256 + wc * 32 + 8 * fq;
#pragma unroll
        for (int ai = 0; ai < 2; ++ai)
#pragma unroll
            for (int m = 0; m < 4; ++m) { const int row = row0 + ai * 128 + m * 16; const int a = rowaid[row]; const float w = roww[row];
                if (a >= 0) {
#pragma unroll
                    for (int bj = 0; bj < 2; ++bj) { const f32x4 v0 = acc[ai][bj][m][0] * w, v1 = acc[ai][bj][m][1] * w;
                        u32x4 o; o.x = pg8::cvt_pk_bf16(v0[0], v0[1]); o.y = pg8::cvt_pk_bf16(v0[2], v0[3]); o.z = pg8::cvt_pk_bf16(v1[0], v1[1]); o.w = pg8::cvt_pk_bf16(v1[2], v1[3]);
                        *(u32x4*)(YB + (size_t)a * D + col0 + bj * 128) = o; } } }
    }
};
__device__ __forceinline__ void p11_final(PRef p, int bid, int nb) {
    const int tid_ = otid(), lane = tid_ & 63, wv = tid_ >> 6;
    const float* mod = (const float*)(p.ws + W_MOD); const bf16* YB = (const bf16*)p.out; const bf16* X1 = (const bf16*)(p.ws + W_X1B); float* out = p.out; const float* g = p.in[I_FNG];
#pragma unroll 1
    for (int gw = bid * 8 + wv; gw < NTOK / 16; gw += nb * 8) {
        const int b = gw >> 8, row0 = b * SEQ + (gw & 255);
        const float* gt = mod + b * 6 * D + 5 * D;
        f32x4 gv[4], fg[4];
#pragma unroll
        for (int j = 0; j < 4; ++j) { const int c0 = (lane + 64 * j) * 4; gv[j] = *(const f32x4*)(gt + c0); fg[j] = *(const f32x4*)(g + c0); }
        struct Ops { u32x2 xw[4], a[4], b[4]; };
        auto ld = [&](Ops& o, int s) __attribute__((always_inline)) { const size_t row = (size_t)(row0 + s * 256);
#pragma unroll
            for (int j = 0; j < 4; ++j) { const int c0 = (lane + 64 * j) * 4;
                o.xw[j] = *(const u32x2*)(X1 + row * D + c0); o.a[j] = *(const u32x2*)(YB + 2 * row * D + c0); o.b[j] = *(const u32x2*)(YB + (2 * row + 1) * D + c0); } };
        auto proc = [&](const Ops& o, int s) __attribute__((always_inline)) { const size_t row = (size_t)(row0 + s * 256);
            f32x4 v[4]; float sq = 0.f;
#pragma unroll
            for (int j = 0; j < 4; ++j) { const u32x2 xw = o.xw[j], a = o.a[j], bb = o.b[j];
                const f32x4 xv = {bflo(xw.x), bfhi(xw.x), bflo(xw.y), bfhi(xw.y)};
                const f32x4 y = {bflo(a.x) + bflo(bb.x), bfhi(a.x) + bfhi(bb.x), bflo(a.y) + bflo(bb.y), bfhi(a.y) + bfhi(bb.y)};
                v[j] = xv + gv[j] * y; sq += (v[j][0] * v[j][0] + v[j][1] * v[j][1]) + (v[j][2] * v[j][2] + v[j][3] * v[j][3]); }
            const float r = rsqrtf(wave_sum_dpp(sq) * (1.0f / D) + 1e-6f);
#pragma unroll
            for (int j = 0; j < 4; ++j) { const int c0 = (lane + 64 * j) * 4; *(f32x4*)(out + row * D + c0) = v[j] * r * fg[j]; } };
        Ops oa, ob; ld(oa, 0);
#pragma unroll 1
        for (int s = 0; s < 16; s += 2) { ld(ob, s + 1); proc(oa, s); ld(oa, s + 2 < 16 ? s + 2 : 15); proc(ob, s + 1); }
    }
}
constexpr int PM_PB = 144, PM_MAT = 64 * PM_PB;
enum { PM_AT = 0, PM_RT, PM_BT, PM_KT, PM_VT, PM_BPT, PM_KPT, PM_AAK, PM_ARB, PM_ARK, PM_W1T, PM_U2T, PM_NMAT };
constexpr int PM_AAB = PM_NMAT * PM_MAT, PM_P = PM_AAB + 16384, PM_TOT = PM_P + 16384, PM_G = PM_TOT + 2048, PM_AABB = PM_G + 256, PM_XS = PM_AABB + PM_MAT, PM_END = PM_XS + 8192;
static_assert(PM_END <= LDS_BYTES, "pass-A LDS map");
#ifndef PMPROBE
#define PMPROBE -1
#endif
struct PmRaw { unsigned zr[9], zk[9], zv[9], lw[8], as[8]; float par[6];
                unsigned long long tacc, tlast; f32x4 ctv[8]; TrItem citem; bool cvon; };
#define PMT(k) do { if (PMPROBE >= 0) { const unsigned long long n_ = __builtin_amdgcn_s_memrealtime(); if ((k) == PMPROBE) R.tacc += n_ - R.tlast; R.tlast = n_; } } while (0)
__device__ __forceinline__ void p5m_load(PRef p, PmRaw& R, int q, int wave, int lane) {
    const int seq = q / NCH, c = q % NCH, b = seq >> 3, h = seq & 7, tg = b * SEQ + c * SCL + wave * 8, hc = h * 64 + lane;
    const bf16* Z = (const bf16*)(p.ws + W_Z); const bf16* LO = (const bf16*)(p.ws + W_LO);
    const bool hasprev = !(wave == 0 && c == 0);
    const bf16* zp0 = Z + (size_t)(tg - (hasprev ? 1 : 0)) * ZLD + 1024 + hc;
    R.zr[0] = zp0[0]; R.zk[0] = zp0[512]; R.zv[0] = zp0[1024];
#pragma unroll
    for (int s = 0; s < 8; ++s) { const bf16* zp = Z + (size_t)(tg + s) * ZLD + 1024 + hc; const bf16* lp = LO + (size_t)(tg + s) * 1536 + hc;
        R.zr[s + 1] = zp[0]; R.zk[s + 1] = zp[512]; R.zv[s + 1] = zp[1024]; R.lw[s] = lp[0]; R.as[s] = lp[512]; }
    R.par[0] = p.in[I_MU][hc]; R.par[1] = p.in[I_MU][512 + hc]; R.par[2] = p.in[I_MU][1024 + hc]; R.par[3] = p.in[I_KK][hc]; R.par[4] = p.in[I_KA][hc]; R.par[5] = p.in[I_RK][hc];
}
template <bool ISW1>
__device__ __forceinline__ void p5m_solve(LAS unsigned char* lds, int wave, int lane) {
    typedef short bf16x8 __attribute__((ext_vector_type(8)));
    const int fr = lane & 15, fq = lane >> 4;
#define PMAT(i) (lds + (i) * PM_MAT)
#define PFRAG(mat, row, ks) (*(const LAS bf16x8*)((mat) + (row) * PM_PB + ((ks) * 32 + fq * 8) * 2))

        const int colb = (wave & 3) * 16, cl = lane >> 2, part = lane & 3, col = colb + cl;
        if constexpr (!ISW1) {
            const bf16x8 vb0 = PFRAG(PMAT(PM_VT), colb + fr, 0), vb1 = PFRAG(PMAT(PM_VT), colb + fr, 1);
#pragma unroll
            for (int tt = 0; tt < 4; ++tt) { f32x4 acc = {0.f, 0.f, 0.f, 0.f};
                acc = __builtin_amdgcn_mfma_f32_16x16x32_bf16(PFRAG(PMAT(PM_AAK), tt * 16 + fr, 0), vb0, acc, 0, 0, 0);
                acc = __builtin_amdgcn_mfma_f32_16x16x32_bf16(PFRAG(PMAT(PM_AAK), tt * 16 + fr, 1), vb1, acc, 0, 0, 0);
#pragma unroll
                for (int rg = 0; rg < 4; ++rg) *(LAS float*)(lds + PM_P + ((tt * 16 + 4 * fq + rg) * 64 + colb + fr) * 4) = acc[rg]; }
            asm volatile("s_waitcnt lgkmcnt(0)" ::: "memory");
        }
        LAS unsigned char* XT = PMAT(ISW1 ? PM_W1T : PM_U2T);
        { const u32x4 z = {0u, 0u, 0u, 0u}; LAS unsigned char* zp = XT + (colb + (lane >> 2)) * PM_PB + (lane & 3) * 32; *(LAS u32x4*)zp = z; *(LAS u32x4*)(zp + 16) = z; }
        LAS float* xs = (LAS float*)(lds + PM_XS + wave * 1024);
        const LAS unsigned char* arow = lds + PM_AAB + part * 64;
#pragma unroll
        for (int I = 0; I < 4; ++I) {
            f32x4 a4[16]; float rhv[16], cf[4][6]; bf16x8 af0, af1;
#pragma unroll
            for (int tl = 0; tl < 16; ++tl) { const int t = 16 * I + tl;
                if ((tl >> 2) > 0) a4[tl] = *(const LAS f32x4*)(arow + t * 256 + I * 16);
                rhv[tl] = ISW1 ? bf2f(*(const LAS bf16*)(PMAT(PM_AT) + t * PM_PB + col * 2)) : *(const LAS float*)(lds + PM_P + (t * 64 + col) * 4); }
#pragma unroll
            for (int gp = 0; gp < 4; ++gp) { const int tq = 16 * I + 4 * gp; const LAS unsigned char* cb = lds + PM_AAB + (4 * I + gp) * 4;
                cf[gp][0] = *(const LAS float*)(cb + (tq + 1) * 256); cf[gp][1] = *(const LAS float*)(cb + (tq + 2) * 256); cf[gp][2] = *(const LAS float*)(cb + (tq + 2) * 256 + 64);
                cf[gp][3] = *(const LAS float*)(cb + (tq + 3) * 256); cf[gp][4] = *(const LAS float*)(cb + (tq + 3) * 256 + 64); cf[gp][5] = *(const LAS float*)(cb + (tq + 3) * 256 + 128); }
            if (I > 0) { af0 = *(const LAS bf16x8*)(lds + PM_AABB + (16 * I + fr) * PM_PB + (fq * 8) * 2); if (I == 3) af1 = *(const LAS bf16x8*)(lds + PM_AABB + (16 * I + fr) * PM_PB + (32 + fq * 8) * 2); }
            f32x4 cr[4];
#pragma unroll
            for (int gp = 0; gp < 4; ++gp) cr[gp] = (f32x4){0.f, 0.f, 0.f, 0.f};
            if (I > 0) {
                f32x4 acc = {0.f, 0.f, 0.f, 0.f};
                acc = __builtin_amdgcn_mfma_f32_16x16x32_bf16(af0, *(const LAS bf16x8*)(XT + (colb + fr) * PM_PB + (fq * 8) * 2), acc, 0, 0, 0);
                if (I == 3) acc = __builtin_amdgcn_mfma_f32_16x16x32_bf16(af1, *(const LAS bf16x8*)(XT + (colb + fr) * PM_PB + (32 + fq * 8) * 2), acc, 0, 0, 0);
                *(LAS f32x4*)(xs + fr * 16 + 4 * fq) = acc;
                asm volatile("s_waitcnt lgkmcnt(0)" ::: "memory");
#pragma unroll
                for (int gp = 0; gp < 4; ++gp) cr[gp] = *(const LAS f32x4*)(xs + cl * 16 + 4 * gp);
            }
            float Xq[4];
#pragma unroll
            for (int gp = 0; gp < 4; ++gp) {
                const int tq = 16 * I + 4 * gp;
                float sm[4];
#pragma unroll
                for (int r = 0; r < 4; ++r) { float s = 0.f;
#pragma unroll
                    for (int i = 0; i < 4; ++i) if (i < gp) s = fmaf(a4[4 * gp + r][i], Xq[i], s);
                    sm[r] = s; }
                if (gp > 0) {
#pragma unroll
                    for (int r = 0; r < 4; ++r) { DPP_ADD(sm[r], 0xB1); DPP_ADD(sm[r], 0x4E); } }
                const float x0 = rhv[4 * gp] + cr[gp][0] + sm[0];
                const float x1 = fmaf(cf[gp][0], x0, rhv[4 * gp + 1] + cr[gp][1] + sm[1]);
                const float x2 = fmaf(cf[gp][2], x1, fmaf(cf[gp][1], x0, rhv[4 * gp + 2] + cr[gp][2] + sm[2]));
                const float x3 = fmaf(cf[gp][5], x2, fmaf(cf[gp][4], x1, fmaf(cf[gp][3], x0, rhv[4 * gp + 3] + cr[gp][3] + sm[3])));
                { float y0 = x0, y1 = x1, y2 = x2, y3 = x3;
                  asm volatile("" : "+v"(y0), "+v"(y1), "+v"(y2), "+v"(y3));
                  const float lo_ = (part & 1) ? y1 : y0, hi_ = (part & 1) ? y3 : y2;
                  Xq[gp] = (part & 2) ? hi_ : lo_; }
                *(LAS bf16*)(XT + col * PM_PB + (tq + part) * 2) = (bf16)(pg8::cvt_pk_bf16(Xq[gp], 0.f) & 0xffffu);
            }
        }

#undef PMAT
#undef PFRAG
}
__device__ __forceinline__ void p5m_tinv(LAS unsigned char* lds, int I, int lane) {
    if (lane >= 16) return;
    const int j = lane & 15;
    float tc[16];
#pragma unroll
    for (int i = 0; i < 16; ++i) tc[i] = (i == j) ? 1.f : 0.f;
    const LAS unsigned char* lb = lds + PM_AAB + (16 * I * 64) * 4;
#define PT_ROW(i, lr) do { float s_[4] = {0.f, 0.f, 0.f, 0.f}; \
        _Pragma("unroll") for (int k = 0; k < (i); ++k) s_[k & 3] = fmaf(lr[k >> 2][k & 3], tc[k], s_[k & 3]); \
        tc[i] += (s_[0] + s_[1]) + (s_[2] + s_[3]); } while (0)
#define PT_LD(i, f) (*(const LAS f32x4*)(lb + ((i) * 64 + (((4 * I + (f)) ^ (i)) << 2)) * 4))
    { f32x4 lr[7][4];
#pragma unroll
      for (int i = 1; i < 8; ++i) { lr[i - 1][0] = PT_LD(i, 0); lr[i - 1][1] = PT_LD(i, 1); lr[i - 1][2] = (f32x4){0.f, 0.f, 0.f, 0.f}; lr[i - 1][3] = lr[i - 1][2]; }
#pragma unroll
      for (int i = 1; i < 8; ++i) PT_ROW(i, lr[i - 1]); }
#pragma unroll
    for (int b = 2; b < 4; ++b) { f32x4 lr[4][4];
#pragma unroll
      for (int ii = 0; ii < 4; ++ii)
#pragma unroll
          for (int f = 0; f < 4; ++f) lr[ii][f] = PT_LD(4 * b + ii, f);
#pragma unroll
      for (int ii = 0; ii < 4; ++ii) PT_ROW(4 * b + ii, lr[ii]); }
#undef PT_LD
#undef PT_ROW
    LAS float* ts = (LAS float*)(lds + PM_XS + I * 1024);
#pragma unroll
    for (int i = 0; i < 16; ++i) ts[i * 16 + j] = tc[i];
}
template <bool ISW1>
__device__ __forceinline__ void p5m_solve2(LAS unsigned char* lds, int wave, int lane) {
    typedef short bf16x8 __attribute__((ext_vector_type(8)));
    const int fr = lane & 15, fq = lane >> 4, colb = (wave & 3) * 16;
#define PMAT(i) (lds + (i) * PM_MAT)
    LAS unsigned char* XT = PMAT(ISW1 ? PM_W1T : PM_U2T);
    { const u32x4 z = {0u, 0u, 0u, 0u}; LAS unsigned char* zp = XT + (colb + (lane >> 2)) * PM_PB + (lane & 3) * 32; *(LAS u32x4*)zp = z; *(LAS u32x4*)(zp + 16) = z; }
    f32x4 rh[4], tf[4]; bf16x8 af[4];
#pragma unroll
    for (int I = 0; I < 4; ++I) {
#pragma unroll
        for (int r = 0; r < 4; ++r) { const int t = 16 * I + 4 * fq + r;
            rh[I][r] = ISW1 ? bf2f(*(const LAS bf16*)(PMAT(PM_AT) + t * PM_PB + (colb + fr) * 2)) : *(const LAS float*)(lds + PM_P + (t * 64 + ((colb + fr) ^ (fq << 4))) * 4); }
        tf[I] = *(const LAS f32x4*)(lds + PM_XS + I * 1024 + (fr * 16 + 4 * fq) * 4);
    }
    af[0] = *(const LAS bf16x8*)(lds + PM_AABB + (16 + fr) * PM_PB + (fq * 8) * 2); af[1] = *(const LAS bf16x8*)(lds + PM_AABB + (32 + fr) * PM_PB + (fq * 8) * 2);
    af[2] = *(const LAS bf16x8*)(lds + PM_AABB + (48 + fr) * PM_PB + (fq * 8) * 2); af[3] = *(const LAS bf16x8*)(lds + PM_AABB + (48 + fr) * PM_PB + (32 + fq * 8) * 2);
    asm volatile("s_waitcnt lgkmcnt(0)" ::: "memory");
#pragma unroll
    for (int I = 0; I < 4; ++I) {
        f32x4 acc = rh[I];
        if (I > 0) {
            acc = __builtin_amdgcn_mfma_f32_16x16x32_bf16(af[I - 1], *(const LAS bf16x8*)(XT + (colb + fr) * PM_PB + (fq * 8) * 2), acc, 0, 0, 0);
            if (I == 3) acc = __builtin_amdgcn_mfma_f32_16x16x32_bf16(af[3], *(const LAS bf16x8*)(XT + (colb + fr) * PM_PB + (32 + fq * 8) * 2), acc, 0, 0, 0);
        }
        f32x4 x = {0.f, 0.f, 0.f, 0.f};
#pragma unroll
        for (int m = 0; m < 4; ++m) x = __builtin_amdgcn_mfma_f32_16x16x4f32(tf[I][m], acc[m], x, 0, 0, 0);
        u32x2 w; w.x = pg8::cvt_pk_bf16(x[0], x[1]); w.y = pg8::cvt_pk_bf16(x[2], x[3]);
        *(LAS u32x2*)(XT + (colb + fr) * PM_PB + (16 * I + 4 * fq) * 2) = w;
        asm volatile("s_waitcnt lgkmcnt(0)" ::: "memory");
    }
#undef PMAT
}
#define PM_BAR() do { asm volatile("s_waitcnt lgkmcnt(0)" ::: "memory"); __builtin_amdgcn_s_barrier(); asm volatile("" ::: "memory"); } while (0)
__device__ __forceinline__ void p5m_chunk(PRef p, LAS unsigned char* lds, int q, int qnext, PmRaw& R) {
    typedef short bf16x8 __attribute__((ext_vector_type(8)));
    const int tid = otid(), lane = tid & 63, wave = __builtin_amdgcn_readfirstlane(tid >> 6), fr = lane & 15, fq = lane >> 4;
    const int seq = q / NCH, c = q % NCH, b = seq >> 3, h = seq & 7, tb = b * SEQ + c * SCL, hc = h * 64 + lane;
#define PMAT(i) (lds + (i) * PM_MAT)
#define PFRAG(mat, row, ks) (*(const LAS bf16x8*)((mat) + (row) * PM_PB + ((ks) * 32 + fq * 8) * 2))
    if (PMPROBE >= 0) R.tlast = __builtin_amdgcn_s_memrealtime();
#ifndef PM_DUP
#define PM_DUP 0
#endif
#pragma unroll 1
    for (int d0 = 0; d0 < ((PM_DUP >> 3) & 1) + 1; ++d0) { if (d0) PM_BAR();
        const int t8 = wave * 8, tg = tb + t8;
        float zr[9], zk[9], zv[9], lw[8], as[8];
        { const float pm = (wave == 0 && c == 0) ? 0.f : 1.f;
#pragma unroll
          for (int s = 0; s < 9; ++s) { zr[s] = __uint_as_float(R.zr[s] << 16); zk[s] = __uint_as_float(R.zk[s] << 16); zv[s] = __uint_as_float(R.zv[s] << 16); }
          zr[0] *= pm; zk[0] *= pm; zv[0] *= pm;
#pragma unroll
          for (int s = 0; s < 8; ++s) { lw[s] = __uint_as_float(R.lw[s] << 16); as[s] = __uint_as_float(R.as[s] << 16); } }
        float cl[8]; { float run = 0.f;
#pragma unroll
          for (int s = 0; s < 8; ++s) { run += lw[s]; cl[s] = run; } }
        *(LAS float*)(lds + PM_TOT + (wave * 64 + lane) * 4) = cl[7];
        PM_BAR();
        float off = 0.f, lcL = 0.f;
#pragma unroll
        for (int w = 0; w < 8; ++w) { const float tv = *(const LAS float*)(lds + PM_TOT + (w * 64 + lane) * 4); lcL += tv; off += (w < wave) ? tv : 0.f; }
        if (wave == 0) *(LAS float*)(lds + PM_G + lane * 4) = __builtin_amdgcn_exp2f(1.4426950409f * lcL);
        const float mur = R.par[0], muk = R.par[1], muv = R.par[2], kkc = R.par[3], kac = R.par[4], rkc = R.par[5];
        bf16* VLo = (bf16*)(p.ws + W_YCAT); float* RKo = (float*)(p.ws + T_RK);
        unsigned pv[4], pbp[4], pkp[4]; float rkv = 0.f;
#ifdef S0OLD
#pragma unroll
        for (int s = 0; s < 8; ++s) {
            const float r = zr[s + 1] + (zr[s] - zr[s + 1]) * mur, k = zk[s + 1] + (zk[s] - zk[s + 1]) * muk, v = zv[s + 1] + (zv[s] - zv[s + 1]) * muv;
            const float kkv = k * kkc;
            const float kk = kkv * rsqrtf(fmaxf(wave_sum_dpp(kkv * kkv), 1e-24f));
            const float k2 = k * (1.0f + (as[s] - 1.0f) * kac);
            const float rk = wave_sum_dpp(r * k2 * rkc);
            const float bb = kk * as[s];
            const float lc = off + cl[s], lcp = lc - lw[s];
            const float e_lc = __builtin_amdgcn_exp2f(1.4426950409f * lc), e_lcp = __builtin_amdgcn_exp2f(1.4426950409f * lcp);
            const float e_nlc = __builtin_amdgcn_exp2f(-1.4426950409f * lc), e_l = __builtin_amdgcn_exp2f(1.4426950409f * (lcL - lc));
            const int t = t8 + s;
            { const unsigned w0 = pg8::cvt_pk_bf16(-kk * e_lcp, r * e_lc), w1 = pg8::cvt_pk_bf16(bb * e_nlc, k2 * e_nlc);
              *(LAS bf16*)(PMAT(PM_AT) + t * PM_PB + lane * 2) = (bf16)(w0 & 0xffffu); *(LAS bf16*)(PMAT(PM_RT) + t * PM_PB + lane * 2) = (bf16)(w0 >> 16);
              *(LAS bf16*)(PMAT(PM_BT) + t * PM_PB + lane * 2) = (bf16)(w1 & 0xffffu); *(LAS bf16*)(PMAT(PM_KT) + t * PM_PB + lane * 2) = (bf16)(w1 >> 16); }
            const unsigned w2 = pg8::cvt_pk_bf16(v, bb * e_l);
            const unsigned vb = w2 & 0xffffu, bpb = w2 >> 16, kpb = pg8::cvt_pk_bf16(k2 * e_l, 0.f) & 0xffffu;
            if (s & 1) { pv[s >> 1] |= vb << 16; pbp[s >> 1] |= bpb << 16; pkp[s >> 1] |= kpb << 16; } else { pv[s >> 1] = vb; pbp[s >> 1] = bpb; pkp[s >> 1] = kpb; }
            VLo[(unsigned)((tg + s) * 1024 + 512 + hc)] = (bf16)vb;
            rkv = (lane == s) ? rk : rkv;
        }
#else
        typedef pg8::f32x2 F2;
#pragma unroll
        for (int sp = 0; sp < 4; ++sp) {
            const int s = 2 * sp, t = t8 + s;
            const F2 zrc = {zr[s + 1], zr[s + 2]}, zrp = {zr[s], zr[s + 1]}, zkc = {zk[s + 1], zk[s + 2]}, zkp = {zk[s], zk[s + 1]}, zvc = {zv[s + 1], zv[s + 2]}, zvp = {zv[s], zv[s + 1]};
            const F2 r = zrc + (zrp - zrc) * mur, k = zkc + (zkp - zkc) * muk, v = zvc + (zvp - zvc) * muv;
            const F2 kkv = k * kkc, sq = kkv * kkv;
            const F2 nrm = {rsqrtf(fmaxf(wave_sum_dpp(sq[0]), 1e-24f)), rsqrtf(fmaxf(wave_sum_dpp(sq[1]), 1e-24f))};
            const F2 kk = kkv * nrm;
            const F2 as2 = {as[s], as[s + 1]}, lw2 = {lw[s], lw[s + 1]}, cl2 = {cl[s], cl[s + 1]};
            const F2 k2 = k * (1.0f + (as2 - 1.0f) * kac);
            const F2 rkp = r * k2 * rkc;
            const float rk0 = wave_sum_dpp(rkp[0]), rk1 = wave_sum_dpp(rkp[1]);
            const F2 bb = kk * as2;
            const F2 lc = off + cl2, lcp = lc - lw2;
            const F2 a_lc = lc * 1.4426950409f, a_lcp = lcp * 1.4426950409f, a_l = (lcL - lc) * 1.4426950409f;
            const F2 e_lc = {__builtin_amdgcn_exp2f(a_lc[0]), __builtin_amdgcn_exp2f(a_lc[1])}, e_lcp = {__builtin_amdgcn_exp2f(a_lcp[0]), __builtin_amdgcn_exp2f(a_lcp[1])};
            const F2 e_nlc = {__builtin_amdgcn_exp2f(-a_lc[0]), __builtin_amdgcn_exp2f(-a_lc[1])}, e_l = {__builtin_amdgcn_exp2f(a_l[0]), __builtin_amdgcn_exp2f(a_l[1])};
            const F2 xa = -(kk * e_lcp), xr = r * e_lc, xb = bb * e_nlc, xk = k2 * e_nlc, xbp = bb * e_l, xkp = k2 * e_l;
            { const unsigned wa = pg8::cvt_pk_bf16(xa[0], xa[1]), wr = pg8::cvt_pk_bf16(xr[0], xr[1]), wb = pg8::cvt_pk_bf16(xb[0], xb[1]), wk = pg8::cvt_pk_bf16(xk[0], xk[1]);
              *(LAS bf16*)(PMAT(PM_AT) + t * PM_PB + lane * 2) = (bf16)(wa & 0xffffu); *(LAS bf16*)(PMAT(PM_AT) + (t + 1) * PM_PB + lane * 2) = (bf16)(wa >> 16);
              *(LAS bf16*)(PMAT(PM_RT) + t * PM_PB + lane * 2) = (bf16)(wr & 0xffffu); *(LAS bf16*)(PMAT(PM_RT) + (t + 1) * PM_PB + lane * 2) = (bf16)(wr >> 16);
              *(LAS bf16*)(PMAT(PM_BT) + t * PM_PB + lane * 2) = (bf16)(wb & 0xffffu); *(LAS bf16*)(PMAT(PM_BT) + (t + 1) * PM_PB + lane * 2) = (bf16)(wb >> 16);
              *(LAS bf16*)(PMAT(PM_KT) + t * PM_PB + lane * 2) = (bf16)(wk & 0xffffu); *(LAS bf16*)(PMAT(PM_KT) + (t + 1) * PM_PB + lane * 2) = (bf16)(wk >> 16); }
            pv[sp] = pg8::cvt_pk_bf16(v[0], v[1]); pbp[sp] = pg8::cvt_pk_bf16(xbp[0], xbp[1]); pkp[sp] = pg8::cvt_pk_bf16(xkp[0], xkp[1]);
            rkv = (lane == s) ? rk0 : rkv; rkv = (lane == s + 1) ? rk1 : rkv;
        }
#endif
        if (lane < 8) RKo[(unsigned)((tg + lane) * 8 + h)] = rkv;
        *(LAS u32x4*)(PMAT(PM_VT) + lane * PM_PB + wave * 16) = (u32x4){pv[0], pv[1], pv[2], pv[3]};
        *(LAS u32x4*)(PMAT(PM_BPT) + lane * PM_PB + wave * 16) = (u32x4){pbp[0], pbp[1], pbp[2], pbp[3]};
        *(LAS u32x4*)(PMAT(PM_KPT) + lane * PM_PB + wave * 16) = (u32x4){pkp[0], pkp[1], pkp[2], pkp[3]};
    }
    if (qnext >= 0) p5m_load(p, R, qnext, wave, lane);
    PM_BAR(); PMT(0);
#pragma unroll 1
    for (int d1 = 0; d1 < ((PM_DUP >> 0) & 1) + 1; ++d1) {
        const int pp = wave >> 1, half = wave & 1;
        const LAS unsigned char* Xm = PMAT(pp < 2 ? PM_AT : PM_RT);
        const LAS unsigned char* Ym = PMAT((pp & 1) ? PM_KT : PM_BT);
#pragma unroll
        for (int ti = 0; ti < 2; ++ti) {
            const int tt = half ? (1 + ti) : (3 * ti);
            const bf16x8 xb0 = PFRAG(Xm, tt * 16 + fr, 0), xb1 = PFRAG(Xm, tt * 16 + fr, 1);
            const int t = tt * 16 + fr;
#pragma unroll
            for (int jt = 0; jt < 4; ++jt) {
                f32x4 acc = {0.f, 0.f, 0.f, 0.f};
                if (jt <= tt) { acc = __builtin_amdgcn_mfma_f32_16x16x32_bf16(PFRAG(Ym, jt * 16 + fr, 0), xb0, acc, 0, 0, 0);
                                acc = __builtin_amdgcn_mfma_f32_16x16x32_bf16(PFRAG(Ym, jt * 16 + fr, 1), xb1, acc, 0, 0, 0); }
                const int j0 = jt * 16 + 4 * fq;
#pragma unroll
                for (int rg = 0; rg < 4; ++rg) { const bool keep = (pp < 2) ? (j0 + rg < t) : (j0 + rg <= t); acc[rg] = keep ? acc[rg] : 0.f; }
                if (pp == 0) {
                    if (jt == tt) *(LAS f32x4*)(lds + PM_AAB + (t * 64 + (((jt * 4 + fq) ^ (t & 15)) << 2)) * 4) = acc;
                    { u32x2 w; w.x = pk2(acc[0], acc[1]); w.y = pk2(acc[2], acc[3]); *(LAS u32x2*)(lds + PM_AABB + t * PM_PB + j0 * 2) = w; }
                } else {
                    u32x2 w; w.x = pk2(acc[0], acc[1]); w.y = pk2(acc[2], acc[3]);
                    *(LAS u32x2*)(PMAT(PM_AAK + pp - 1) + t * PM_PB + j0 * 2) = w;
                }
            }
        }
    }
    PM_BAR(); PMT(1);
#pragma unroll 1
    for (int d2 = 0; d2 < ((PM_DUP >> 1) & 1) + 1; ++d2) {
#ifdef S2OLD
        if (wave < 4) p5m_solve<true>(lds, wave, lane); else p5m_solve<false>(lds, wave, lane);
#else
        if (wave < 4) p5m_tinv(lds, wave, lane);
        else {
            const int colb = (wave & 3) * 16;
            const bf16x8 vb0 = PFRAG(PMAT(PM_VT), colb + fr, 0), vb1 = PFRAG(PMAT(PM_VT), colb + fr, 1);
#pragma unroll
            for (int tt = 0; tt < 4; ++tt) { f32x4 acc = {0.f, 0.f, 0.f, 0.f};
                acc = __builtin_amdgcn_mfma_f32_16x16x32_bf16(PFRAG(PMAT(PM_AAK), tt * 16 + fr, 0), vb0, acc, 0, 0, 0);
                acc = __builtin_amdgcn_mfma_f32_16x16x32_bf16(PFRAG(PMAT(PM_AAK), tt * 16 + fr, 1), vb1, acc, 0, 0, 0);
#pragma unroll
                for (int rg = 0; rg < 4; ++rg) *(LAS float*)(lds + PM_P + ((tt * 16 + 4 * fq + rg) * 64 + ((colb + fr) ^ (fq << 4))) * 4) = acc[rg]; }
            if (R.cvon) p0_tr_store16(R.citem, R.ctv, lane);
            { const int cvi = q * 4 + (wave - 4); R.cvon = cvi < CONV_P8 * (MOE_ITEMS / 24); R.citem = moe_item(p, R.cvon ? cvi : 0); if (R.cvon) p0_tr_load16(R.citem, R.ctv, lane); }
        }
        PM_BAR(); PMT(4);
        if (wave < 4) p5m_solve2<true>(lds, wave, lane); else p5m_solve2<false>(lds, wave, lane);
#endif
    }
    PM_BAR(); PMT(2);
#pragma unroll 1
    for (int d3 = 0; d3 < ((PM_DUP >> 2) & 1) + 1; ++d3) {
        float* Mo = (float*)((unsigned char*)p.out + O_M + (size_t)q * 16384); float* No = (float*)((unsigned char*)p.out + O_N + (size_t)q * 16384);
        bf16* Qo = (bf16*)(p.ws + W_Q); bf16* Y2o = (bf16*)(p.ws + W_Y2);
        {
            typedef _Float16 f16x8s __attribute__((ext_vector_type(8)));
            const int arow = 8 * (fr >> 2) + (fr & 3);
            const int rt = wave >> 1, cp = wave & 1;
            const int bcol = rt * 16 + fr, a0 = cp * 32 + arow, e0 = cp * 32 + 8 * fq;
            {
                const int cm = wave & 3, rp = wave >> 2, c = cm * 16 + fr, ia = rp * 32 + arow, i0 = rp * 32 + 8 * fq;
                f32x4 ax = {0.f, 0.f, 0.f, 0.f}, ay = ax;
#pragma unroll
                for (int ks = 0; ks < 2; ++ks) { const bf16x8 bq = PFRAG(PMAT(PM_BPT), c, ks);
                    ax = __builtin_amdgcn_mfma_f32_16x16x32_bf16(PFRAG(PMAT(PM_W1T), ia, ks), bq, ax, 0, 0, 0); ay = __builtin_amdgcn_mfma_f32_16x16x32_bf16(PFRAG(PMAT(PM_W1T), ia + 4, ks), bq, ay, 0, 0, 0); }
                const float gd = *(const LAS float*)(lds + PM_G + c * 4);
#pragma unroll
                for (int rg = 0; rg < 4; ++rg) { if (i0 + rg == c) ax[rg] += gd; if (i0 + 4 + rg == c) ay[rg] += gd; }
                const f16x8s hv = {(_Float16)ax[0], (_Float16)ax[1], (_Float16)ax[2], (_Float16)ax[3], (_Float16)ay[0], (_Float16)ay[1], (_Float16)ay[2], (_Float16)ay[3]};
                *(f16x8s*)((_Float16*)((unsigned char*)p.out + O_M + (size_t)q * 8192) + c * 64 + i0) = hv; }
            {
                f32x4 ax = {0.f, 0.f, 0.f, 0.f}, ay = ax;
#pragma unroll
                for (int ks = 0; ks < 2; ++ks) { const bf16x8 bu = PFRAG(PMAT(PM_U2T), bcol, ks), bv = PFRAG(PMAT(PM_VT), bcol, ks);
                    ax = __builtin_amdgcn_mfma_f32_16x16x32_bf16(PFRAG(PMAT(PM_BPT), a0, ks), bu, ax, 0, 0, 0); ax = __builtin_amdgcn_mfma_f32_16x16x32_bf16(PFRAG(PMAT(PM_KPT), a0, ks), bv, ax, 0, 0, 0);
                    ay = __builtin_amdgcn_mfma_f32_16x16x32_bf16(PFRAG(PMAT(PM_BPT), a0 + 4, ks), bu, ay, 0, 0, 0); ay = __builtin_amdgcn_mfma_f32_16x16x32_bf16(PFRAG(PMAT(PM_KPT), a0 + 4, ks), bv, ay, 0, 0, 0); }
                const f16x8s nv = {(_Float16)ax[0], (_Float16)ax[1], (_Float16)ax[2], (_Float16)ax[3], (_Float16)ay[0], (_Float16)ay[1], (_Float16)ay[2], (_Float16)ay[3]};
                *(f16x8s*)((_Float16*)((unsigned char*)p.out + O_N + (size_t)q * 8192) + bcol * 64 + e0) = nv; }
            {
                f32x4 ax = {0.f, 0.f, 0.f, 0.f}, ay = ax;
#pragma unroll
                for (int ks = 0; ks < 2; ++ks) { const bf16x8 bq = PFRAG(PMAT(PM_ARB), bcol, ks);
                    ax = __builtin_amdgcn_mfma_f32_16x16x32_bf16(PFRAG(PMAT(PM_W1T), a0, ks), bq, ax, 0, 0, 0); ay = __builtin_amdgcn_mfma_f32_16x16x32_bf16(PFRAG(PMAT(PM_W1T), a0 + 4, ks), bq, ay, 0, 0, 0); }
                const u32x4 rw = *(const LAS u32x4*)(PMAT(PM_RT) + bcol * PM_PB + e0 * 2);
                u32x4 o; o.x = pk2(ax[0] + bflo(rw.x), ax[1] + bfhi(rw.x)); o.y = pk2(ax[2] + bflo(rw.y), ax[3] + bfhi(rw.y)); o.z = pk2(ay[0] + bflo(rw.z), ay[1] + bfhi(rw.z)); o.w = pk2(ay[2] + bflo(rw.w), ay[3] + bfhi(rw.w));
                *(u32x4*)(Qo + (unsigned)((tb + bcol) * 512 + h * 64 + e0)) = o; }
            {
                f32x4 ax = {0.f, 0.f, 0.f, 0.f}, ay = ax;
#pragma unroll
                for (int ks = 0; ks < 2; ++ks) { const bf16x8 bb = PFRAG(PMAT(PM_ARB), bcol, ks), bk = PFRAG(PMAT(PM_ARK), bcol, ks);
                    ax = __builtin_amdgcn_mfma_f32_16x16x32_bf16(PFRAG(PMAT(PM_U2T), a0, ks), bb, ax, 0, 0, 0); ax = __builtin_amdgcn_mfma_f32_16x16x32_bf16(PFRAG(PMAT(PM_VT), a0, ks), bk, ax, 0, 0, 0);
                    ay = __builtin_amdgcn_mfma_f32_16x16x32_bf16(PFRAG(PMAT(PM_U2T), a0 + 4, ks), bb, ay, 0, 0, 0); ay = __builtin_amdgcn_mfma_f32_16x16x32_bf16(PFRAG(PMAT(PM_VT), a0 + 4, ks), bk, ay, 0, 0, 0); }
                u32x4 o; o.x = pk2(ax[0], ax[1]); o.y = pk2(ax[2], ax[3]); o.z = pk2(ay[0], ay[1]); o.w = pk2(ay[2], ay[3]);
                *(u32x4*)(Y2o + (unsigned)((tb + bcol) * 512 + h * 64 + e0)) = o; }
        }
    }
    PM_BAR(); PMT(3);
#undef PMAT
#undef PFRAG
}

__device__ __forceinline__ void p5m_run(PRef p, LAS unsigned char* lds, int bid, int nb) {
    const int tid = otid(), lane = tid & 63, wave = __builtin_amdgcn_readfirstlane(tid >> 6);
    PmRaw R; R.tacc = 0; R.tlast = 0; R.cvon = false; R.citem = TrItem{nullptr, nullptr, 0, 0, 0, 0};
    if (bid < BATCH * 8 * NCH) p5m_load(p, R, bid, wave, lane);
#pragma unroll 1
    for (int q = bid; q < BATCH * 8 * NCH; q += nb) p5m_chunk(p, lds, q, (q + nb < BATCH * 8 * NCH) ? q + nb : -1, R);
    if (R.cvon) p0_tr_store16(R.citem, R.ctv, lane);
    if (PMPROBE >= 0 && bid == 0 && tid == 0) { const unsigned long long t0_ = __builtin_amdgcn_s_memrealtime(), w_ = R.tacc * 4ull; while (__builtin_amdgcn_s_memrealtime() - t0_ < w_) __builtin_amdgcn_s_sleep(8); }
}
constexpr int R7_WP = 1040, R7_WSZ = 48 * R7_WP, R7_AP = 144, R7_ASZ = 16 * R7_AP;
constexpr int R7_WAVE0 = 2 * R7_WSZ, R7_WAVESZ = 2 * R7_ASZ + 3072, R7_HIST = R7_WAVE0 + 8 * R7_WAVESZ;
static_assert(R7_HIST + 256 <= LDS_BYTES, "router LDS map");
struct R7Ops { u32x4 xa, xb; f32x4 av[4], sv[4]; };
__device__ __forceinline__ void r7_load(R7Ops& o, const bf16* xrow, const float* ra, const float* sh, int k0) {
    o.xa = *(const u32x4*)(xrow + k0); o.xb = *(const u32x4*)(xrow + k0 + 8);
#pragma unroll
    for (int i = 0; i < 4; ++i) { o.av[i] = *(const f32x4*)(ra + k0 + i * 4); o.sv[i] = *(const f32x4*)(sh + k0 + i * 4); }
}
__device__ __forceinline__ void p7m_route(PRef p, LAS unsigned char* lds, int bid) {
    typedef short bf16x8 __attribute__((ext_vector_type(8)));
    const int tid = otid(), lane = tid & 63, wave = __builtin_amdgcn_readfirstlane(tid >> 6), fr = lane & 15, fq = lane >> 4;
    const int tok = lane >> 2, sub = lane & 3;
    const bf16* x1 = (const bf16*)(p.ws + W_X1B); bf16* H2 = (bf16*)(p.ws + W_H2);
    LAS int* hist = (LAS int*)(lds + R7_HIST);
    const int b = (bid * TPW) / SEQ, t0 = bid * TPW + wave * 16;
    const float* sh = (const float*)(p.ws + W_MOD) + b * 6 * D + 3 * D + sub * 16;
    const float* ra = (const float*)(p.ws + W_RA) + b * D + sub * 16;
    LAS unsigned char* Ahi = lds + R7_WAVE0 + wave * R7_WAVESZ; LAS unsigned char* Alo = Ahi + R7_ASZ; LAS float* Lw = (LAS float*)(Alo + R7_ASZ);
    if (tid < 32) hist[tid] = 0;
    constexpr int WPART = R7_WSZ / 16, WROW36 = 36 * (R7_WP / 16), WCH = 2 * WROW36, WTR = (WCH + NTHR - 1) / NTHR;
#define R7_CH(d) (((d) / WROW36) * WPART + (d) % WROW36)
    for (int z = tid; z < 2 * (WPART - WROW36); z += NTHR) { const int zc = (z / (WPART - WROW36)) * WPART + WROW36 + z % (WPART - WROW36); *(LAS u32x4*)(lds + zc * 16) = (u32x4){0u, 0u, 0u, 0u}; }
    u32x4 wreg[WTR];
    { const u32x4* gi = (const u32x4*)(p.ws + W_RW);
#pragma unroll
      for (int i = 0; i < WTR; ++i) { const int d = tid + i * NTHR; wreg[i] = gi[R7_CH(d < WCH ? d : WCH - 1)]; } }
    const bf16* xrow = x1 + (size_t)(t0 + tok) * D + sub * 16;
    float ss = 0.f;
    { u32x4 v[32];
#pragma unroll
      for (int s = 0; s < 16; ++s) { v[s * 2] = *(const u32x4*)(xrow + s * 64); v[s * 2 + 1] = *(const u32x4*)(xrow + s * 64 + 8); }
#pragma unroll
      for (int i = 0; i < 32; ++i)
#pragma unroll
          for (int q = 0; q < 4; ++q) { const float a = bflo(v[i][q]), bq = bfhi(v[i][q]); ss = fmaf(a, a, fmaf(bq, bq, ss)); } }
    DPP_ADD(ss, 0xB1); DPP_ADD(ss, 0x4E);
    const float r = rsqrtf(ss * (1.0f / D) + 1e-6f);
    f32x4 acc[3];
    { const float b0 = fr < 4 ? p.in[I_RGB][fr & 3] : p.in[I_REB][fr >= 4 ? fr - 4 : 0], b1 = p.in[I_REB][12 + fr], b2 = fr < 4 ? p.in[I_REB][28 + (fr & 3)] : 0.f;
      acc[0] = (f32x4){b0, b0, b0, b0}; acc[1] = (f32x4){b1, b1, b1, b1}; acc[2] = (f32x4){b2, b2, b2, b2}; }
    R7Ops oa, ob; r7_load(oa, xrow, ra, sh, 0);
    bf16* hrow0 = H2 + (size_t)(t0 + tok) * D + sub * 16;
    auto slice = [&](const R7Ops& cur, int gs) __attribute__((always_inline)) {
        const int k0 = gs * 64, sl = gs & 7;
        f32x4 xv[4];
        { const u32x4 xa = cur.xa, xb = cur.xb;
          xv[0] = (f32x4){bflo(xa.x), bfhi(xa.x), bflo(xa.y), bfhi(xa.y)}; xv[1] = (f32x4){bflo(xa.z), bfhi(xa.z), bflo(xa.w), bfhi(xa.w)};
          xv[2] = (f32x4){bflo(xb.x), bfhi(xb.x), bflo(xb.y), bfhi(xb.y)}; xv[3] = (f32x4){bflo(xb.z), bfhi(xb.z), bflo(xb.w), bfhi(xb.w)}; }
        unsigned hi[8], lo[8];
#pragma unroll
        for (int i = 0; i < 4; ++i)
#pragma unroll
            for (int j = 0; j < 4; j += 2) { const float h0 = xv[i][j] * r * cur.av[i][j] + cur.sv[i][j], h1 = xv[i][j + 1] * r * cur.av[i][j + 1] + cur.sv[i][j + 1];
                const unsigned a0 = f2bf(h0), a1 = f2bf(h1); hi[i * 2 + (j >> 1)] = a0 | (a1 << 16); lo[i * 2 + (j >> 1)] = f2bf(h0 - bflo(a0)) | (f2bf(h1 - bflo(a1)) << 16); }
        bf16* hrow = hrow0 + k0;
        *(u32x4*)hrow = (u32x4){hi[0], hi[1], hi[2], hi[3]}; *(u32x4*)(hrow + 8) = (u32x4){hi[4], hi[5], hi[6], hi[7]};
        *(LAS u32x4*)(Ahi + tok * R7_AP + sub * 32) = (u32x4){hi[0], hi[1], hi[2], hi[3]}; *(LAS u32x4*)(Ahi + tok * R7_AP + sub * 32 + 16) = (u32x4){hi[4], hi[5], hi[6], hi[7]};
        *(LAS u32x4*)(Alo + tok * R7_AP + sub * 32) = (u32x4){lo[0], lo[1], lo[2], lo[3]}; *(LAS u32x4*)(Alo + tok * R7_AP + sub * 32 + 16) = (u32x4){lo[4], lo[5], lo[6], lo[7]};
        asm volatile("s_waitcnt lgkmcnt(0)" ::: "memory");
#pragma unroll
        for (int ks = 0; ks < 2; ++ks) {
            const bf16x8 ah = *(const LAS bf16x8*)(Ahi + fr * R7_AP + (ks * 32 + fq * 8) * 2), al = *(const LAS bf16x8*)(Alo + fr * R7_AP + (ks * 32 + fq * 8) * 2);
#pragma unroll
            for (int qt = 0; qt < 3; ++qt) { const int wo = (qt * 16 + fr) * R7_WP + (sl * 64 + ks * 32 + fq * 8) * 2;
                const bf16x8 bh = *(const LAS bf16x8*)(lds + wo), bl = *(const LAS bf16x8*)(lds + R7_WSZ + wo);
                acc[qt] = __builtin_amdgcn_mfma_f32_16x16x32_bf16(ah, bh, acc[qt], 0, 0, 0);
                acc[qt] = __builtin_amdgcn_mfma_f32_16x16x32_bf16(al, bh, acc[qt], 0, 0, 0);
                acc[qt] = __builtin_amdgcn_mfma_f32_16x16x32_bf16(ah, bl, acc[qt], 0, 0, 0); } }
        asm volatile("s_waitcnt lgkmcnt(0)" ::: "memory");
    };
#pragma unroll 1
    for (int kh = 0; kh < 2; ++kh) {
        __syncthreads();
#pragma unroll
        for (int i = 0; i < WTR; ++i) { const int d = tid + i * NTHR; if (d < WCH) *(LAS u32x4*)(lds + R7_CH(d) * 16) = wreg[i]; }
        if (kh == 0) {
            const u32x4* gi = (const u32x4*)(p.ws + W_RW) + 2 * WPART;
#pragma unroll
            for (int i = 0; i < WTR; ++i) { const int d = tid + i * NTHR; wreg[i] = gi[R7_CH(d < WCH ? d : WCH - 1)]; } }
        __syncthreads();
#pragma unroll 1
        for (int sl = 0; sl < 8; sl += 2) {
            const int gs = kh * 8 + sl;
            r7_load(ob, xrow, ra, sh, (gs + 1) * 64);
            slice(oa, gs);
            r7_load(oa, xrow, ra, sh, (gs + 2 < 16 ? gs + 2 : 15) * 64);
            slice(ob, gs + 1);
        }
    }
#pragma unroll
    for (int qt = 0; qt < 3; ++qt)
#pragma unroll
        for (int rg = 0; rg < 4; ++rg) Lw[(4 * fq + rg) * 48 + qt * 16 + fr] = acc[qt][rg];
    asm volatile("s_waitcnt lgkmcnt(0)" ::: "memory");
    if (lane < 16) {
        const LAS float* lg = Lw + lane * 48;
        int gi = 0; float gm = lg[0];
#pragma unroll
        for (int q = 1; q < 4; ++q) { const float v = lg[q]; if (v > gm) { gm = v; gi = q; } }
        float gsum = 0.f;
#pragma unroll
        for (int q = 0; q < 4; ++q) gsum += expf(lg[q] - gm);
        const float gp = 1.0f / gsum;
        const LAS float* el = lg + 4 + gi * 8;
        int i0 = 0; float m0 = el[0];
#pragma unroll
        for (int q = 1; q < 8; ++q) { const float v = el[q]; if (v > m0) { m0 = v; i0 = q; } }
        int i1 = -1; float m1 = -3.0e38f;
#pragma unroll
        for (int q = 0; q < 8; ++q) { const float v = el[q]; if (q != i0 && v > m1) { m1 = v; i1 = q; } }
        const float p1 = expf(m1 - m0);
        const float w0 = gp / (1.0f + p1), w1 = gp * p1 / (1.0f + p1);
        const int t = t0 + lane, e0 = gi * 8 + i0, e1 = gi * 8 + i1;
        int* toke = (int*)(p.ws + T_TOKE); float* tokw = (float*)(p.ws + T_TOKW);
        toke[t * 2] = e0; toke[t * 2 + 1] = e1; tokw[t * 2] = w0; tokw[t * 2 + 1] = w1;
        __hip_atomic_fetch_add(&hist[e0], 1, __ATOMIC_RELAXED, __HIP_MEMORY_SCOPE_WORKGROUP); __hip_atomic_fetch_add(&hist[e1], 1, __ATOMIC_RELAXED, __HIP_MEMORY_SCOPE_WORKGROUP);
    }
    __syncthreads();
    if (tid < 32) ((int*)(p.ws + T_HIST))[bid * 32 + tid] = hist[tid];
    __syncthreads();
}
constexpr int PB_PITCH = 68;
constexpr int PB_ML = 0, PB_SL = 64 * PB_PITCH * 4, PB_NL = PB_SL + 16 * PB_PITCH * 4, PB_IMG = PB_NL + 16 * PB_PITCH * 4;
__device__ __forceinline__ void p5b_chain_mfma(PRef p, LAS unsigned char* lds, int item) {
    const int tid = otid(), lane = tid & 63, wave = __builtin_amdgcn_readfirstlane(tid >> 6), fr = lane & 15, fq = lane >> 4;
    const int seq = (item & 7) + 8 * (item >> 5), rg = (item >> 3) & 3;
    const bool mm = wave < 4; const int ct = wave & 3, t2 = tid & 255, nrow = t2 >> 4, ncol = (t2 & 15) * 4;
    const unsigned char* Mb = (const unsigned char*)p.out + O_M + (size_t)seq * NCH * 16384;
    const unsigned char* Nb = (const unsigned char*)p.out + O_N + (size_t)seq * NCH * 16384 + (size_t)((rg * 16 + nrow) * 64 + ncol) * 4;
    unsigned char* Sb = p.ws + W_YCAT + ((size_t)((seq >> 3) * SEQ + rg * 16 + nrow) * 1024 + 512 + (seq & 7) * 64 + ncol) * 2;
    const int mrow = tid >> 4, mcol = (tid & 15) * 4;
    f32x4 acc = {0.f, 0.f, 0.f, 0.f};
    float tv[32]; TrItem citem = TrItem{nullptr, nullptr, 0, 0, 0, 0}, bitem = citem;
    LAS float* cscr = (LAS float*)(lds + 2 * PB_IMG + (wave & 3) * 8704);
    const int gcw = item * 4 + (wave & 3);
#define PBM_CONV(cc) do { if (false) { const int ph_ = (cc) & 7, i3_ = ((cc) >> 3) * 3; \
          \
        if (ph_ == 2 || ph_ == 4 || ph_ == 6) { p0_tr_store_half(citem, tv, cscr, lane, 0); bitem = citem; } \
        if (ph_ == 3 || ph_ == 5 || ph_ == 7) p0_tr_store_half(bitem, tv, cscr, lane, 1); \
        if (ph_ == 0 || ph_ == 2 || ph_ == 4) { citem = moe_item(p, gcw + (i3_ + (ph_ >> 1)) * (MOE_ITEMS / 24)); p0_tr_load(citem, tv, lane); } } } while (0)
    f32x4 m0[2], m1[2], m2[2], m3[2], m4[2], m5[2], m6[2], m7[2], n0, n1, n2, n3, n4, n5, n6, n7;
#define PBM_LOAD(mmr, nn, cc) do { const f32x4* mp = (const f32x4*)(Mb + (size_t)(cc) * 16384) + tid; mmr[0] = mp[0]; mmr[1] = mp[512]; if (!mm) nn = *(const f32x4*)(Nb + (size_t)(cc) * 16384); } while (0)
#define PBM_STEP(mmr, nn, cc) do { \
        LAS unsigned char* img = lds + ((cc) & 1) * PB_IMG; \
        *(LAS f32x4*)(img + PB_ML + (mrow * PB_PITCH + mcol) * 4) = mmr[0]; *(LAS f32x4*)(img + PB_ML + ((mrow + 32) * PB_PITCH + mcol) * 4) = mmr[1]; \
        if (mm) { _Pragma("unroll") for (int rg_ = 0; rg_ < 4; ++rg_) *(LAS float*)(img + PB_SL + ((4 * fq + rg_) * PB_PITCH + ct * 16 + fr) * 4) = acc[rg_]; } \
        else *(LAS f32x4*)(img + PB_NL + (nrow * PB_PITCH + ncol) * 4) = nn; \
        asm volatile("s_waitcnt lgkmcnt(0)" ::: "memory"); PBT_PRE(); __builtin_amdgcn_s_barrier(); asm volatile("" ::: "memory"); PBT_POST(); \
        if ((cc) + 8 < NCH) PBM_LOAD(mmr, nn, (cc) + 8); \
        if (mm) { \
            _Pragma("unroll") for (int rg_ = 0; rg_ < 4; ++rg_) acc[rg_] = *(const LAS float*)(img + PB_NL + ((4 * fq + rg_) * PB_PITCH + ct * 16 + fr) * 4); \
            _Pragma("unroll") for (int ks = 0; ks < 16; ++ks) { \
                const float a_ = *(const LAS float*)(img + PB_SL + (fr * PB_PITCH + ks * 4 + fq) * 4), b_ = *(const LAS float*)(img + PB_ML + ((ks * 4 + fq) * PB_PITCH + ct * 16 + fr) * 4); \
                acc = __builtin_amdgcn_mfma_f32_16x16x4f32(a_, b_, acc, 0, 0, 0); } \
            __builtin_amdgcn_sched_group_barrier(0x100, 36, 0); __builtin_amdgcn_sched_group_barrier(0x008, 16, 0);     \
        } else { const f32x4 sv = *(const LAS f32x4*)(img + PB_SL + (nrow * PB_PITCH + ncol) * 4); u32x2 sw_; sw_.x = pg8::cvt_pk_bf16(sv[0], sv[1]); sw_.y = pg8::cvt_pk_bf16(sv[2], sv[3]); *(u32x2*)(Sb + (size_t)(cc) * (SCL * 1024 * 2)) = sw_; } \
        PBM_CONV(cc); \
    } while (0)
#ifdef PBPROBE
    unsigned long long pbt_last = __builtin_amdgcn_s_memrealtime(), pbt_work = 0, pbt_wait = 0;
#define PBT_PRE()  do { const unsigned long long n_ = __builtin_amdgcn_s_memrealtime(); pbt_work += n_ - pbt_last; pbt_last = n_; } while (0)
#define PBT_POST() do { const unsigned long long n_ = __builtin_amdgcn_s_memrealtime(); pbt_wait += n_ - pbt_last; pbt_last = n_; } while (0)
#else
#define PBT_PRE() do {} while (0)
#define PBT_POST() do {} while (0)
#endif
    __syncthreads();
    PBM_LOAD(m0, n0, 0); PBM_LOAD(m1, n1, 1); PBM_LOAD(m2, n2, 2); PBM_LOAD(m3, n3, 3); PBM_LOAD(m4, n4, 4); PBM_LOAD(m5, n5, 5); PBM_LOAD(m6, n6, 6); PBM_LOAD(m7, n7, 7);
#pragma unroll 1
    for (int c = 0; c < NCH; c += 8) { PBM_STEP(m0, n0, c); PBM_STEP(m1, n1, c + 1); PBM_STEP(m2, n2, c + 2); PBM_STEP(m3, n3, c + 3); PBM_STEP(m4, n4, c + 4); PBM_STEP(m5, n5, c + 5); PBM_STEP(m6, n6, c + 6); PBM_STEP(m7, n7, c + 7); }
#ifdef PBPROBE
    if (blockIdx.x == 0 && tid == PBPROBE_TID) { unsigned long long* tp = (unsigned long long*)(p.ws + T_CTL + 1024); tp[0] = 0; tp[1] = (PBPROBE == 0) ? pbt_work : pbt_wait; }
#endif
    __syncthreads();
#undef PBM_LOAD
#undef PBM_STEP
#undef PBM_CONV
}
constexpr int PC_ML = 0, PC_SL = 64 * PB_PITCH * 4, PC_NL = PC_SL + 32 * PB_PITCH * 4, PC_IMG = PC_NL + 32 * PB_PITCH * 4;
__device__ __forceinline__ void p5b_chain2(PRef p, LAS unsigned char* lds, int item) {
    const int tid = otid(), lane = tid & 63, wave = __builtin_amdgcn_readfirstlane(tid >> 6), fr = lane & 15, fq = lane >> 4;
    const int seq = (item & 7) + 8 * (item >> 4), half = (item >> 3) & 1;
    const int rgw = wave >> 2, ct = wave & 3, nrow = tid >> 4, ncol = (tid & 15) * 4;
    const unsigned char* Mb = (const unsigned char*)p.out + O_M + (size_t)seq * NCH * 16384;
    const unsigned char* Nb = (const unsigned char*)p.out + O_N + (size_t)seq * NCH * 16384 + (size_t)((half * 32 + nrow) * 64 + ncol) * 4;
    unsigned char* Sb = p.ws + W_YCAT + ((size_t)((seq >> 3) * SEQ + half * 32 + nrow) * 1024 + 512 + (seq & 7) * 64 + ncol) * 2;
    const int mrow = tid >> 4, mcol = (tid & 15) * 4;
    f32x4 acc = {0.f, 0.f, 0.f, 0.f};
    f32x4 m0[2], m1[2], m2[2], m3[2], m4[2], m5[2], m6[2], m7[2], n0, n1, n2, n3, n4, n5, n6, n7;
#define PCM_LOAD(mmr, nn, cc) do { const f32x4* mp = (const f32x4*)(Mb + (size_t)(cc) * 16384) + tid; mmr[0] = mp[0]; mmr[1] = mp[512]; nn = *(const f32x4*)(Nb + (size_t)(cc) * 16384); } while (0)
#define PCM_STEP(mmr, nn, cc) do { \
        LAS unsigned char* img = lds + ((cc) & 1) * PC_IMG; \
        *(LAS f32x4*)(img + PC_ML + (mrow * PB_PITCH + mcol) * 4) = mmr[0]; *(LAS f32x4*)(img + PC_ML + ((mrow + 32) * PB_PITCH + mcol) * 4) = mmr[1]; \
        _Pragma("unroll") for (int rg_ = 0; rg_ < 4; ++rg_) *(LAS float*)(img + PC_SL + ((rgw * 16 + 4 * fq + rg_) * PB_PITCH + ct * 16 + fr) * 4) = acc[rg_]; \
        *(LAS f32x4*)(img + PC_NL + (nrow * PB_PITCH + ncol) * 4) = nn; \
        asm volatile("s_waitcnt lgkmcnt(0)" ::: "memory"); __builtin_amdgcn_s_barrier(); asm volatile("" ::: "memory"); \
        if ((cc) + 8 < NCH) PCM_LOAD(mmr, nn, (cc) + 8); \
        _Pragma("unroll") for (int rg_ = 0; rg_ < 4; ++rg_) acc[rg_] = *(const LAS float*)(img + PC_NL + ((rgw * 16 + 4 * fq + rg_) * PB_PITCH + ct * 16 + fr) * 4); \
        { const f32x4 sv = *(const LAS f32x4*)(img + PC_SL + (nrow * PB_PITCH + ncol) * 4); u32x2 sw_; sw_.x = pg8::cvt_pk_bf16(sv[0], sv[1]); sw_.y = pg8::cvt_pk_bf16(sv[2], sv[3]); *(u32x2*)(Sb + (size_t)(cc) * (SCL * 1024 * 2)) = sw_; } \
        _Pragma("unroll") for (int ks = 0; ks < 16; ++ks) { \
            const float a_ = *(const LAS float*)(img + PC_SL + ((rgw * 16 + fr) * PB_PITCH + ks * 4 + fq) * 4), b_ = *(const LAS float*)(img + PC_ML + ((ks * 4 + fq) * PB_PITCH + ct * 16 + fr) * 4); \
            acc = __builtin_amdgcn_mfma_f32_16x16x4f32(a_, b_, acc, 0, 0, 0); } \
    } while (0)
    __syncthreads();
    PCM_LOAD(m0, n0, 0); PCM_LOAD(m1, n1, 1); PCM_LOAD(m2, n2, 2); PCM_LOAD(m3, n3, 3); PCM_LOAD(m4, n4, 4); PCM_LOAD(m5, n5, 5); PCM_LOAD(m6, n6, 6); PCM_LOAD(m7, n7, 7);
#pragma unroll 1
    for (int c = 0; c < NCH; c += 8) { PCM_STEP(m0, n0, c); PCM_STEP(m1, n1, c + 1); PCM_STEP(m2, n2, c + 2); PCM_STEP(m3, n3, c + 3); PCM_STEP(m4, n4, c + 4); PCM_STEP(m5, n5, c + 5); PCM_STEP(m6, n6, c + 6); PCM_STEP(m7, n7, c + 7); }
    __syncthreads();
#undef PCM_LOAD
#undef PCM_STEP
}
constexpr int CONV_JC = CONV_P8;
__device__ __forceinline__ void p5b_conv_static(PRef p, LAS unsigned char* lds, int g, int j0, int j1) {
    if (j0 >= j1) return;
    const int tid = otid(), lane = tid & 63, wave = __builtin_amdgcn_readfirstlane(tid >> 6);
    LAS float* scr = (LAS float*)(lds + wave * 16384);
    float tvA[32], tvB[32];
    TrItem cur = moe_item(p, g + j0 * (MOE_ITEMS / 24)), nxt = cur; p0_tr_load(cur, tvA, lane);
#pragma unroll 1
    for (int j = j0; j < j1; j += 2) {
        if (j + 1 < j1) { nxt = moe_item(p, g + (j + 1) * (MOE_ITEMS / 24)); p0_tr_load(nxt, tvB, lane); }
        p0_tr_store(cur, tvA, scr, lane);
        if (j + 1 >= j1) break;
        if (j + 2 < j1) { cur = moe_item(p, g + (j + 2) * (MOE_ITEMS / 24)); p0_tr_load(cur, tvA, lane); }
        p0_tr_store(nxt, tvB, scr, lane);
    }
}
constexpr int LF_PITCH = 336;
template <int KIND>
__device__ __forceinline__ void lf_pairs(PRef p, const LAS unsigned char* a2, int tb, int pair0, int pair1, int lane) {
    typedef short bf16x8 __attribute__((ext_vector_type(8)));
    constexpr int NK = KIND == 2 ? 3 : 1, KB = KIND == 0 ? 0 : KIND == 1 ? 32 : 64;
    if (pair0 >= pair1) return;
    const int fr = lane & 15, fq = lane >> 4;
    const bf16* LT = (const bf16*)(p.ws + W_LORAT); bf16* LO = (bf16*)(p.ws + W_LO);
    bf16x8 bfrag[8][NK];
#pragma unroll
    for (int rt = 0; rt < 8; ++rt)
#pragma unroll
        for (int ks = 0; ks < NK; ++ks) bfrag[rt][ks] = *(const LAS bf16x8*)(a2 + (rt * 16 + fr) * LF_PITCH + (KB + ks * 32 + fq * 8) * 2);
#pragma unroll 1
    for (int pr = pair0; pr < pair1; ++pr) {
        const int n0 = pr * 32, nA = n0 + 8 * (fr >> 2) + (fr & 3);
        bf16x8 wa[NK], wb[NK];
#pragma unroll
        for (int ks = 0; ks < NK; ++ks) { wa[ks] = *(const bf16x8*)(LT + nA * 256 + KB + ks * 32 + fq * 8); wb[ks] = *(const bf16x8*)(LT + (nA + 4) * 256 + KB + ks * 32 + fq * 8); }
        f32x4 ba = {0.f, 0.f, 0.f, 0.f}, bb = ba;
        if (KIND < 2) { const float* bp = (KIND == 0 ? p.in[I_W0] : p.in[I_A0]) + (n0 - KIND * 512) + 8 * fq; ba = *(const f32x4*)bp; bb = *(const f32x4*)(bp + 4); }
        bf16* orow = LO + (size_t)(tb + fr) * 1536 + n0 + 8 * fq;
#pragma unroll
        for (int rt = 0; rt < 8; ++rt) {
            f32x4 ca = ba, cb = bb;
#pragma unroll
            for (int ks = 0; ks < NK; ++ks) { ca = __builtin_amdgcn_mfma_f32_16x16x32_bf16(wa[ks], bfrag[rt][ks], ca, 0, 0, 0); cb = __builtin_amdgcn_mfma_f32_16x16x32_bf16(wb[ks], bfrag[rt][ks], cb, 0, 0, 0); }
            if (KIND < 2) { const float sc = KIND == 0 ? -0.6065306597f : 1.0f;
#pragma unroll
                for (int q = 0; q < 4; ++q) { ca[q] = sc * sigmoid_fast(ca[q]); cb[q] = sc * sigmoid_fast(cb[q]); } }
            u32x4 w; w.x = pg8::cvt_pk_bf16(ca[0], ca[1]); w.y = pg8::cvt_pk_bf16(ca[2], ca[3]); w.z = pg8::cvt_pk_bf16(cb[0], cb[1]); w.w = pg8::cvt_pk_bf16(cb[2], cb[3]);
            *(u32x4*)(orow + (size_t)rt * 16 * 1536) = w;
        }
    }
}
__device__ __forceinline__ void p4_lora_fused(PRef p, LAS unsigned char* lds, int blk) {
    const bf16* Z = (const bf16*)(p.ws + W_Z);
    const int tid = otid(), lane = tid & 63, wave = __builtin_amdgcn_readfirstlane(tid >> 6), j = tid & 255, sub = tid >> 8;
    { const int jc = j < 160 ? j : 159;
      const float muj = p.in[I_MU][1536 + jc];
      const float sm = j < 32 ? 2.f : 1.f, sa = j < 32 ? 2.f : 1.f, sb = j < 32 ? -1.f : 0.f, sl = (j >= 32 && j < 64) ? 1.f : 0.f, sa2 = (j >= 32 && j < 64) ? 0.f : sa;
      const int ts = blk * 128 + sub * 64;
      const bf16* zp = Z + (size_t)ts * ZLD + 2560 + jc;
      unsigned short raw[64];
      const unsigned short pv = zp[(ts % SEQ == 0) ? 0 : -ZLD];
#pragma unroll
      for (int t = 0; t < 64; ++t) raw[t] = zp[t * ZLD];
      float prev = (ts % SEQ == 0) ? 0.f : bf2f(pv);
      LAS unsigned char* ap = lds + (sub * 64) * LF_PITCH + jc * 2;
#pragma unroll
      for (int t = 0; t < 64; ++t) { const float cur = bf2f(raw[t]); const float v = cur + (prev - cur) * muj; prev = cur;
          const bf16 o = (bf16)f2bf(sa2 * sigmoid_fast(sm * v) + sb + sl * v);
          if (j < 160) *(LAS bf16*)(ap + t * LF_PITCH) = o; } }
    __syncthreads();
    { bf16* LO = (bf16*)(p.ws + W_LO);
#pragma unroll
      for (int q3 = 0; q3 < 3; ++q3) { const int cidx = tid + q3 * NTHR, tok = cidx / 12, part = cidx % 12;
          *(u32x4*)(LO + (size_t)(blk * 128 + tok) * 1536 + 1024 + part * 8) = *(const LAS u32x4*)(lds + tok * LF_PITCH + (64 + part * 8) * 2); } }
    { const int p0 = wave * 4, p1 = p0 + 4, tb = blk * 128;
      lf_pairs<0>(p, lds, tb, p0, p1 < 16 ? p1 : 16, lane);
      lf_pairs<1>(p, lds, tb, p0 > 16 ? p0 : 16, p1, lane); }
    __syncthreads();
}
constexpr int PS_PB = 144;
constexpr int PS_MH = 0, PS_SH = 64 * PS_PB, PS_SLO = PS_SH + 16 * PS_PB, PS_N = PS_SLO + 16 * PS_PB, PS_IMG = PS_N + 16 * 68 * 4;
__device__ __forceinline__ void p5b_chain_split(PRef p, LAS unsigned char* lds, int item) {
    typedef _Float16 f16x8 __attribute__((ext_vector_type(8))); typedef _Float16 f16x2 __attribute__((ext_vector_type(2))); typedef _Float16 f16x4c __attribute__((ext_vector_type(4)));
    const int tid = otid(), lane = tid & 63, wave = __builtin_amdgcn_readfirstlane(tid >> 6), fr = lane & 15, fq = lane >> 4;
    const int seq = (item & 7) + 8 * (item >> 5), rg = (item >> 3) & 3;
    const bool mm = wave < 4; const int ct = wave & 3, t2 = tid & 255, nrow = t2 >> 4, ncol = (t2 & 15) * 4;
    const unsigned char* Mb = (const unsigned char*)p.out + O_M + (size_t)seq * NCH * 8192;
    const unsigned char* Nb = (const unsigned char*)p.out + O_N + (size_t)seq * NCH * 8192 + (size_t)((rg * 16 + nrow) * 64 + ncol) * 2;
    unsigned char* Sb = p.ws + W_YCAT + ((size_t)((seq >> 3) * SEQ + rg * 16 + nrow) * 1024 + 512 + (seq & 7) * 64 + ncol) * 2;
    const int mrow = tid >> 3, mcol = (tid & 7) * 8;
    f32x4 acc = {0.f, 0.f, 0.f, 0.f};
    u32x4 m0[1], m1[1], m2[1], m3[1], m4[1], m5[1], m6[1], m7[1]; f16x4c n0, n1, n2, n3, n4, n5, n6, n7;
#define PSM_LOAD(mmr, nn, cc) do { const u32x4* mp = (const u32x4*)(Mb + (size_t)(cc) * 8192) + tid; mmr[0] = mp[0]; if (!mm) nn = *(const f16x4c*)(Nb + (size_t)(cc) * 8192); } while (0)
#define PSM_STEP(mmr, nn, cc) do { \
        LAS unsigned char* img = lds + ((cc) & 1) * PS_IMG; \
        *(LAS u32x4*)(img + PS_MH + mrow * PS_PB + mcol * 2) = mmr[0]; \
        if (mm) {   \
            LAS unsigned char* sh = img + PS_SH + (4 * fq) * PS_PB + (ct * 16 + fr) * 2; LAS unsigned char* sl = sh + (PS_SLO - PS_SH); \
            _Pragma("unroll") for (int r_ = 0; r_ < 4; ++r_) { const _Float16 h_ = (_Float16)acc[r_]; const _Float16 l_ = (_Float16)(acc[r_] - (float)h_); *(LAS _Float16*)(sh + r_ * PS_PB) = h_; *(LAS _Float16*)(sl + r_ * PS_PB) = l_; } } \
        else *(LAS f32x4*)(img + PS_N + (nrow * 68 + ncol) * 4) = (f32x4){(float)nn[0], (float)nn[1], (float)nn[2], (float)nn[3]}; \
        asm volatile("s_waitcnt lgkmcnt(0)" ::: "memory"); __builtin_amdgcn_s_barrier(); asm volatile("" ::: "memory"); \
        if ((cc) + 8 < NCH) PSM_LOAD(mmr, nn, (cc) + 8); \
        if (mm) { \
            _Pragma("unroll") for (int rg_ = 0; rg_ < 4; ++rg_) acc[rg_] = *(const LAS float*)(img + PS_N + ((4 * fq + rg_) * 68 + ct * 16 + fr) * 4); \
            _Pragma("unroll") for (int ks = 0; ks < 2; ++ks) { \
                const f16x8 ah = *(const LAS f16x8*)(img + PS_SH + fr * PS_PB + (ks * 32 + fq * 8) * 2), al = *(const LAS f16x8*)(img + PS_SLO + fr * PS_PB + (ks * 32 + fq * 8) * 2); \
                const f16x8 bh = *(const LAS f16x8*)(img + PS_MH + (ct * 16 + fr) * PS_PB + (ks * 32 + fq * 8) * 2); \
                acc = __builtin_amdgcn_mfma_f32_16x16x32_f16(ah, bh, acc, 0, 0, 0); acc = __builtin_amdgcn_mfma_f32_16x16x32_f16(al, bh, acc, 0, 0, 0); } \
        } else {   \
            const LAS f16x2* hp = (const LAS f16x2*)(img + PS_SH + nrow * PS_PB + ncol * 2); const LAS f16x2* lp = (const LAS f16x2*)(img + PS_SLO + nrow * PS_PB + ncol * 2); \
            const f16x2 h0 = hp[0], h1 = hp[1], l0 = lp[0], l1 = lp[1]; \
            u32x2 sv; sv.x = pg8::cvt_pk_bf16((float)h0[0] + (float)l0[0], (float)h0[1] + (float)l0[1]); sv.y = pg8::cvt_pk_bf16((float)h1[0] + (float)l1[0], (float)h1[1] + (float)l1[1]); \
            *(u32x2*)(Sb + (size_t)(cc) * (SCL * 1024 * 2)) = sv; } \
    } while (0)
    __syncthreads();
    PSM_LOAD(m0, n0, 0); PSM_LOAD(m1, n1, 1); PSM_LOAD(m2, n2, 2); PSM_LOAD(m3, n3, 3); PSM_LOAD(m4, n4, 4); PSM_LOAD(m5, n5, 5); PSM_LOAD(m6, n6, 6); PSM_LOAD(m7, n7, 7);
#pragma unroll 1
    for (int c = 0; c < NCH; c += 8) { PSM_STEP(m0, n0, c); PSM_STEP(m1, n1, c + 1); PSM_STEP(m2, n2, c + 2); PSM_STEP(m3, n3, c + 3); PSM_STEP(m4, n4, c + 4); PSM_STEP(m5, n5, c + 5); PSM_STEP(m6, n6, c + 6); PSM_STEP(m7, n7, c + 7); }
    __syncthreads();
#undef PSM_LOAD
#undef PSM_STEP
}
__global__ void __launch_bounds__(NTHR, 2) k_mega(Params p_unused) {
    extern __shared__ __attribute__((aligned(16))) unsigned char lds_raw[];
    PPtr kp = (PPtr)__builtin_amdgcn_kernarg_segment_ptr();
#define p (*opq(kp))
    cg::grid_group grid = cg::this_grid();
    const int bid = blockIdx.x, nb = gridDim.x;
    LAS unsigned char* lds = (LAS unsigned char*)lds_raw;
    volatile LAS unsigned* bst = (volatile LAS unsigned*)(lds + LDS_BYTES - 64);
    if (otid() < 2) bst[otid()] = 0u;
    __syncthreads();
    XcdBarrier xb = xcd_barrier_post((unsigned*)(p.ws + T_BAR), bst);
#define GSYNC() xcd_barrier(xb)
    p0_prep<false>(p, lds, bid, nb); GSYNC();
#ifdef GS2PROBE
    grid.sync(); grid.sync(); grid.sync(); grid.sync();
#endif
    p1_h1(p, bid, nb); GSYNC();
    { pg8::Gemm g{(const pg8::bf16_t*)(p.ws + W_H1), (const pg8::bf16_t*)(p.ws + W_WINT), NTOK, ZLD, D}; pg8::StaticOrder S; S.init(NTOK, ZLD, nb, bid);
      EpiZ E{(bf16*)(p.ws + W_Z)};
      pg8::gemm_phase<EpiZ, pg8::StaticOrder, true, true>(lds, g, S, E); }
    p2_conv_share(p, lds, bid, nb);
    GSYNC();
#pragma unroll 1
    for (int ch = bid; ch < NTOK / CHUNK; ch += nb) p3_gmlp_unit(p, lds, ch);
#pragma unroll 1
    for (int blk = bid; blk < NTOK / 128; blk += nb) p4_lora_fused(p, lds, blk);
    GSYNC();
    p5m_run(p, lds, bid, nb);
    GSYNC();
#pragma unroll 1
#ifndef CHAIN2
#ifdef CHAIN_F32
    for (int it = bid; it < BATCH * 8 * 4; it += nb) p5b_chain_mfma(p, lds, it);
#else
    for (int it = bid; it < BATCH * 8 * 4; it += nb) p5b_chain_split(p, lds, it);
#endif
#else
    for (int it = bid; it < BATCH * 8 * 2; it += nb) p5b_chain2(p, lds, it);
#endif
    GSYNC();
    p5c_stage_g2(p, lds, ((bid * 8) / NCH) & 7);
#pragma unroll 1
    for (int q = bid * 8 + __builtin_amdgcn_readfirstlane(otid() >> 6); q < BATCH * 8 * NCH; q += nb * 8) p5c_chunk(p, lds, q);
    GSYNC();
    { pg8::Gemm g{(const pg8::bf16_t*)(p.ws + W_YCAT), (const pg8::bf16_t*)(p.ws + W_WOUTT), NTOK, D, D}; pg8::StaticOrder S; S.init(NTOK, D, nb, bid);
      EpiX1 E{p.in[I_X], (const float*)(p.ws + W_MOD), (bf16*)(p.ws + W_X1B)};
      pg8::gemm_phase<EpiX1, pg8::StaticOrder, true, true>(lds, g, S, E); }
    GSYNC();
    p7m_route(p, lds, bid); GSYNC();
    p8_place(p, lds, bid); GSYNC();
    { const int nM = *(const int*)(p.ws + T_NT);
      pg8::Gemm g{(const pg8::bf16_t*)(p.ws + W_H2), (const pg8::bf16_t*)(p.ws + W_WGUT), PROWS, 1024, D}; MoeOrder<true> S{(const int*)(p.ws + T_TILEE), (const int*)(p.ws + T_ROWAID), nM, nb, bid};
      EpiH E{(bf16*)(p.ws + W_HB)};
      pg8::gemm_phase<EpiH, MoeOrder<true>, true, true>(lds, g, S, E); }
    grid.sync();
    { const int nM = *(const int*)(p.ws + T_NT);
      pg8::Gemm g{(const pg8::bf16_t*)(p.ws + W_HB), (const pg8::bf16_t*)(p.ws + W_WDT), PROWS, 1024, EH}; MoeOrder<false> S{(const int*)(p.ws + T_TILEE), (const int*)(p.ws + T_ROWAID), nM, nb, bid};
      EpiY E{(bf16*)p.out, (const int*)(p.ws + T_ROWAID), (const float*)(p.ws + T_ROWW)};
      pg8::gemm_phase<EpiY, MoeOrder<false>, true, true>(lds, g, S, E); }
    GSYNC();
    p11_final(p, bid, nb);
#undef GSYNC
#undef p
}
extern "C" void kernel_launch(void* const* d_in, const int* in_sizes, int n_in, void* d_out, int out_size, void* d_ws, size_t ws_size, hipStream_t stream) {
    if (n_in != 31 || ws_size < WS_NEED || out_size != NTOK * D) { fprintf(stderr, "kernel_launch: unexpected sizes n_in %d ws %zu out %d\n", n_in, ws_size, out_size); return; }
    static int grid_blocks = 0;
    if (!grid_blocks) {
        int dev = 0, cus = 0, per_cu = 0;
        (void)hipGetDevice(&dev);
        (void)hipDeviceGetAttribute(&cus, hipDeviceAttributeMultiprocessorCount, dev);
        (void)hipFuncSetAttribute((const void*)k_mega, hipFuncAttributeMaxDynamicSharedMemorySize, LDS_BYTES);
        (void)hipOccupancyMaxActiveBlocksPerMultiprocessor(&per_cu, (const void*)k_mega, NTHR, LDS_BYTES);
        if (per_cu < 1) fprintf(stderr, "kernel_launch: occupancy query says %d blocks/CU\n", per_cu);
        grid_blocks = cus;
    }
    Params p{};
    for (int i = 0; i < 31; ++i) p.in[i] = (const float*)d_in[i];
    p.out = (float*)d_out; p.ws = (unsigned char*)d_ws;
    (void)hipMemsetAsync((char*)d_ws + T_BAR, 0, 16384, stream);
    void* args[] = {&p};
    hipError_t e = hipLaunchCooperativeKernel((void*)k_mega, dim3(grid_blocks), dim3(NTHR), args, LDS_BYTES, stream);
    if (e != hipSuccess) fprintf(stderr, "cooperative launch failed: %s (grid %d)\n", hipGetErrorString(e), grid_blocks);
}
```
